# Optimizing an MI355X kernel written in HIP

```python
import jax
import jax.numpy as jnp
from jax import lax
import numpy as np

D_MODEL = 1024
BATCH = 8
SEQ = 4096
DEPTH = 4

HEAD_DIM = 64
D_MIX = D_MODEL
GROUP_WIDTH = D_MIX // 4
SWA_HEADS = GROUP_WIDTH // HEAD_DIM
SWA_KV_HEADS = 2
SWA_WINDOW = 128
ROPE_THETA = 10000.0
GLA_HEADS = 4
GLA_DK = 32
GLA_DV = GROUP_WIDTH // GLA_HEADS
GLA_LOW_RANK = 16
GLA_TAU = 16.0
GLA_CHUNK = 64
SB_HEADS = GROUP_WIDTH // HEAD_DIM
SB_BLOCK = 128
RWKV_HEADS = GROUP_WIDTH // HEAD_DIM
RWKV_DECAY_LORA = 64
RWKV_A_LORA = 64
RWKV_GATE_LORA = 128
RWKV_DECAY_SCALE = 0.6065306597126334
RWKV_GN_EPS = 64e-5
D_FF = 2816
N_EXPERTS = 8
TOP_K = 2
D_FF_EXPERT = 1408
NORM_EPS = 1e-6
N_DENSE_LAYERS = (DEPTH + 1) // 2
N_MOE_LAYERS = DEPTH // 2

A_Q = SWA_HEADS * HEAD_DIM
A_KV = SWA_KV_HEADS * HEAD_DIM
A_COLS = A_Q + 2 * A_KV
B_QK = GLA_HEADS * GLA_DK
B_V = GLA_HEADS * GLA_DV
B_COLS = 2 * B_QK + 2 * B_V + GLA_LOW_RANK
C_COLS = 3 * GROUP_WIDTH
D_COLS = 3 * GROUP_WIDTH + RWKV_DECAY_LORA + RWKV_A_LORA + RWKV_GATE_LORA
IN_COLS = A_COLS + B_COLS + C_COLS + D_COLS

kernel_name = 'hymba_style_four_mixer_hybrid'

F32 = jnp.float32


def rmsnorm(x, g, eps=NORM_EPS):
    xf = x.astype(F32)
    y = xf * lax.rsqrt(jnp.mean(xf * xf, axis=-1, keepdims=True) + eps)
    return (y * g.astype(F32)).astype(x.dtype)


def rope_tables(positions):
    inv_freq = ROPE_THETA ** (-jnp.arange(0, HEAD_DIM, 2, dtype=F32) / HEAD_DIM)
    ang = positions.astype(F32)[..., None] * inv_freq
    return jnp.cos(ang), jnp.sin(ang)


def apply_rope(x, cos, sin):
    xf = x.astype(F32)
    x1, x2 = jnp.split(xf, 2, axis=-1)
    c, s = cos[:, :, None], sin[:, :, None]
    return jnp.concatenate([x1 * c - x2 * s, x2 * c + x1 * s], axis=-1).astype(x.dtype)


def swa_sink_attention(q, k, v, sinks):
    dtype = q.dtype
    b_, s_ = q.shape[:2]
    nb = s_ // SWA_WINDOW
    grp = SWA_HEADS // SWA_KV_HEADS
    qb = q.astype(F32).reshape(b_, nb, SWA_WINDOW, SWA_KV_HEADS, grp, HEAD_DIM)

    def band(t):
        tb = t.astype(F32).reshape(b_, nb, SWA_WINDOW, SWA_KV_HEADS, HEAD_DIM)
        prev = jnp.concatenate([jnp.zeros_like(tb[:, :1]), tb[:, :-1]], axis=1)
        return jnp.concatenate([prev, tb], axis=2)

    kw, vw = band(k), band(v)
    scores = jnp.einsum('bnqhgd,bnjhd->bnhgqj', qb, kw) * HEAD_DIM ** -0.5
    i = jnp.arange(SWA_WINDOW)[:, None]
    j = jnp.arange(2 * SWA_WINDOW)[None, :]
    in_band = (j > i) & (j <= i + SWA_WINDOW)
    blk = jnp.arange(nb)[:, None, None]
    valid = in_band[None] & ((blk > 0) | (j[None] >= SWA_WINDOW))
    scores = jnp.where(valid[None, :, None, None], scores, -jnp.inf)
    sink = sinks.astype(F32).reshape(SWA_KV_HEADS, grp)[None, None, :, :, None, None]
    m = jnp.maximum(scores.max(axis=-1, keepdims=True), sink)
    p = jnp.exp(scores - m)
    w = p / (p.sum(axis=-1, keepdims=True) + jnp.exp(sink - m))
    o = jnp.einsum('bnhgqj,bnjhd->bnqhgd', w, vw)
    return o.reshape(b_, s_, SWA_HEADS, HEAD_DIM).astype(dtype)


def gla_chunked(q, k, v, log_a):
    dtype = v.dtype
    b_, s_, h, dk = q.shape
    dv = v.shape[-1]
    nc = s_ // GLA_CHUNK

    def chunks(t):
        return t.astype(F32).reshape(b_, nc, GLA_CHUNK, h, t.shape[-1]).transpose(0, 3, 1, 2, 4)

    q, k, v, la = chunks(q) * dk ** -0.5, chunks(k), chunks(v), chunks(log_a)
    b = jnp.cumsum(la, axis=3)
    b_ref = b[:, :, :, GLA_CHUNK // 2 - 1:GLA_CHUNK // 2]
    b_last = b[:, :, :, -1:]
    causal = jnp.tril(jnp.ones((GLA_CHUNK, GLA_CHUNK), dtype=bool))
    att = jnp.einsum('bhnte,bhnse->bhnts', q * jnp.exp(b - b_ref), k * jnp.exp(b_ref - b))
    att = jnp.where(causal, att, 0.0)
    o = jnp.einsum('bhnts,bhnsf->bhntf', att, v)
    kv = jnp.einsum('bhnse,bhnsf->bhnef', k * jnp.exp(b_last - b), v)
    decay = jnp.exp(b_last[:, :, :, 0])

    def step(state, inp):
        dec, kv_n = inp
        return dec[..., None] * state + kv_n, state

    _, s_prev = lax.scan(step, jnp.zeros((b_, h, dk, dv), F32),
                         (jnp.moveaxis(decay, 2, 0), jnp.moveaxis(kv, 2, 0)))
    o = o + jnp.einsum('bhnte,nbhef->bhntf', q * jnp.exp(b), s_prev)
    return o.transpose(0, 2, 3, 1, 4).reshape(b_, s_, h, dv).astype(dtype)


def stick_breaking_attention(q, k, v):
    dtype = v.dtype
    b_, s_, h, dh = q.shape
    q, k, v = (t.astype(F32).transpose(0, 2, 1, 3) for t in (q, k, v))
    outs = []
    for blk in range(s_ // SB_BLOCK):
        start, stop = blk * SB_BLOCK, (blk + 1) * SB_BLOCK
        z = jnp.einsum('bhtd,bhsd->bhts', q[:, :, start:stop], k[:, :, :stop]) * dh ** -0.5
        strict = jnp.arange(stop)[None, :] < jnp.arange(start, stop)[:, None]
        log_1mb = jnp.where(strict, jax.nn.log_sigmoid(-z), 0.0)
        between = lax.cumsum(log_1mb, axis=3, reverse=True) - log_1mb
        attn = jnp.where(strict, jnp.exp(jax.nn.log_sigmoid(z) + between), 0.0)
        outs.append(jnp.einsum('bhts,bhsd->bhtd', attn, v[:, :, :stop]))
    o = jnp.concatenate(outs, axis=2)
    return o.transpose(0, 2, 1, 3).astype(dtype)


def rwkv7_time_mix(pd, mu, w0, w2, a0, a2, g2, k_k, k_a, r_k, ln_w, ln_b):
    dtype = pd.dtype
    b_, s_, _ = pd.shape
    pd = pd.astype(F32)
    shifted = jnp.concatenate([jnp.zeros_like(pd[:, :1]), pd[:, :-1]], axis=1)
    pd = pd + (shifted - pd) * mu
    gw = GROUP_WIDTH
    r, k, v, wl, al, gl = jnp.split(
        pd, [gw, 2 * gw, 3 * gw, 3 * gw + RWKV_DECAY_LORA, 3 * gw + RWKV_DECAY_LORA + RWKV_A_LORA], axis=-1)
    log_w = -RWKV_DECAY_SCALE * jax.nn.sigmoid(w0 + jnp.tanh(wl) @ w2)
    a = jax.nn.sigmoid(a0 + al @ a2)
    g = jax.nn.sigmoid(gl) @ g2

    def heads(t):
        return t.reshape(b_, s_, RWKV_HEADS, HEAD_DIM)

    kk = heads(k * k_k)
    kk = kk * lax.rsqrt(jnp.sum(kk * kk, axis=-1, keepdims=True) + 1e-12)
    k = k * (1.0 + (a - 1.0) * k_a)
    r, k, v, a, decay = heads(r), heads(k), heads(v), heads(a), heads(jnp.exp(log_w))

    def step(state, inp):
        r_t, w_t, k_t, v_t, kk_t, b_t = inp
        sa = jnp.einsum('bhvk,bhk->bhv', state, kk_t)
        state = (state * w_t[:, :, None, :] - sa[..., None] * b_t[:, :, None, :]
                 + v_t[..., None] * k_t[:, :, None, :])
        return state, jnp.einsum('bhvk,bhk->bhv', state, r_t)

    seq_first = lambda t: jnp.moveaxis(t, 1, 0)
    _, y = lax.scan(step, jnp.zeros((b_, RWKV_HEADS, HEAD_DIM, HEAD_DIM), F32),
                    (seq_first(r), seq_first(decay), seq_first(k), seq_first(v), seq_first(kk), seq_first(kk * a)))
    y = jnp.moveaxis(y, 0, 1)
    mean = jnp.mean(y, axis=-1, keepdims=True)
    var = jnp.mean(jnp.square(y - mean), axis=-1, keepdims=True)
    y = (y - mean) * lax.rsqrt(var + RWKV_GN_EPS) * ln_w + ln_b
    y = y + jnp.sum(r * k * r_k, axis=-1, keepdims=True) * v
    return (y.reshape(b_, s_, GROUP_WIDTH) * g).astype(dtype)


def swiglu(h, w1, w3, w2):
    return (jax.nn.silu(h @ w1) * (h @ w3)) @ w2


def moe_swiglu(h, router, w1, w3, w2):
    logits = (h @ router).astype(F32)
    top_vals, top_idx = lax.top_k(logits, TOP_K)
    gates = jax.nn.softmax(top_vals, axis=-1)
    combine = jnp.sum(jax.nn.one_hot(top_idx, N_EXPERTS, dtype=F32) * gates[..., None], axis=-2)
    out = jnp.zeros_like(h)
    for e in range(N_EXPERTS):
        out = out + combine[..., e:e + 1].astype(h.dtype) * swiglu(h, w1[e], w3[e], w2[e])
    return out


def setup_inputs(seed: int = 0) -> dict:
    key = jax.random.key(seed)
    ks = iter(jax.random.split(key, 48))
    L = DEPTH

    def nrm(shape, scale):
        return jax.random.normal(next(ks), shape, F32) * scale

    def gain(shape):
        return 1.0 + nrm(shape, 0.02)

    x = nrm((BATCH, SEQ, D_MODEL), 1.0)
    offsets = jax.random.randint(next(ks), (BATCH, 1), 0, 1024, dtype=jnp.int32)
    positions = offsets + jnp.arange(SEQ, dtype=jnp.int32)[None, :]
    return {
        'x': x,
        'positions': positions,
        'attn_norm': gain((L, D_MODEL)),
        'w_in': nrm((L, D_MODEL, IN_COLS), D_MODEL ** -0.5),
        'swa_sinks': nrm((L, SWA_HEADS), 0.5),
        'swa_out_norm': gain((L, SWA_HEADS, HEAD_DIM)),
        'gla_w_a2': nrm((L, GLA_LOW_RANK, B_QK), GLA_LOW_RANK ** -0.5),
        'gla_b_a': 1.0 + nrm((L, B_QK), 0.5),
        'gla_out_norm': gain((L, GLA_HEADS, GLA_DV)),
        'sb_out_norm': gain((L, SB_HEADS, HEAD_DIM)),
        'rwkv_mu': jax.random.uniform(next(ks), (L, D_COLS), F32),
        'rwkv_w0': nrm((L, GROUP_WIDTH), 0.5),
        'rwkv_w2': nrm((L, RWKV_DECAY_LORA, GROUP_WIDTH), 0.5 * RWKV_DECAY_LORA ** -0.5),
        'rwkv_a0': nrm((L, GROUP_WIDTH), 0.5),
        'rwkv_a2': nrm((L, RWKV_A_LORA, GROUP_WIDTH), 0.5 * RWKV_A_LORA ** -0.5),
        'rwkv_g2': nrm((L, RWKV_GATE_LORA, GROUP_WIDTH), RWKV_GATE_LORA ** -0.5),
        'rwkv_k_k': 0.85 + nrm((L, GROUP_WIDTH), 0.05),
        'rwkv_k_a': 1.0 + nrm((L, GROUP_WIDTH), 0.05),
        'rwkv_r_k': nrm((L, RWKV_HEADS, HEAD_DIM), 0.1),
        'rwkv_ln_w': gain((L, RWKV_HEADS, HEAD_DIM)),
        'rwkv_ln_b': nrm((L, RWKV_HEADS, HEAD_DIM), 0.02),
        'w_out': nrm((L, D_MIX, D_MODEL), D_MIX ** -0.5),
        'ffn_norm': gain((L, D_MODEL)),
        'ffn_w1': nrm((N_DENSE_LAYERS, D_MODEL, D_FF), D_MODEL ** -0.5),
        'ffn_w3': nrm((N_DENSE_LAYERS, D_MODEL, D_FF), D_MODEL ** -0.5),
        'ffn_w2': nrm((N_DENSE_LAYERS, D_FF, D_MODEL), D_FF ** -0.5),
        'router': nrm((N_MOE_LAYERS, D_MODEL, N_EXPERTS), D_MODEL ** -0.5),
        'moe_w1': nrm((N_MOE_LAYERS, N_EXPERTS, D_MODEL, D_FF_EXPERT), D_MODEL ** -0.5),
        'moe_w3': nrm((N_MOE_LAYERS, N_EXPERTS, D_MODEL, D_FF_EXPERT), D_MODEL ** -0.5),
        'moe_w2': nrm((N_MOE_LAYERS, N_EXPERTS, D_FF_EXPERT, D_MODEL), D_FF_EXPERT ** -0.5),
        'final_norm': gain((D_MODEL,)),
    }


def reference(x, positions, attn_norm, w_in, swa_sinks, swa_out_norm, gla_w_a2, gla_b_a, gla_out_norm,
              sb_out_norm, rwkv_mu, rwkv_w0, rwkv_w2, rwkv_a0, rwkv_a2, rwkv_g2, rwkv_k_k, rwkv_k_a,
              rwkv_r_k, rwkv_ln_w, rwkv_ln_b, w_out, ffn_norm, ffn_w1, ffn_w3, ffn_w2, router,
              moe_w1, moe_w3, moe_w2, final_norm):
    b_, s_, _ = x.shape
    cos, sin = rope_tables(positions)
    for l in range(DEPTH):
        h = rmsnorm(x, attn_norm[l])
        proj = h @ w_in[l]
        pa, pb, pc, pd = jnp.split(proj, [A_COLS, A_COLS + B_COLS, A_COLS + B_COLS + C_COLS], axis=-1)

        qa, ka, va = jnp.split(pa, [A_Q, A_Q + A_KV], axis=-1)
        qa = apply_rope(qa.reshape(b_, s_, SWA_HEADS, HEAD_DIM), cos, sin)
        ka = apply_rope(ka.reshape(b_, s_, SWA_KV_HEADS, HEAD_DIM), cos, sin)
        oa = swa_sink_attention(qa, ka, va.reshape(b_, s_, SWA_KV_HEADS, HEAD_DIM), swa_sinks[l])
        oa = rmsnorm(oa, swa_out_norm[l]).reshape(b_, s_, GROUP_WIDTH)

        qb, kb, vb, gb, lrb = jnp.split(pb, [B_QK, 2 * B_QK, 2 * B_QK + B_V, 2 * B_QK + 2 * B_V], axis=-1)
        log_a = jax.nn.log_sigmoid((lrb @ gla_w_a2[l] + gla_b_a[l]).astype(F32)) / GLA_TAU
        ob = gla_chunked(qb.reshape(b_, s_, GLA_HEADS, GLA_DK), kb.reshape(b_, s_, GLA_HEADS, GLA_DK),
                         vb.reshape(b_, s_, GLA_HEADS, GLA_DV), log_a.reshape(b_, s_, GLA_HEADS, GLA_DK))
        ob = rmsnorm(ob, gla_out_norm[l]).reshape(b_, s_, GROUP_WIDTH) * jax.nn.silu(gb)

        qc, kc, vc = jnp.split(pc, 3, axis=-1)
        oc = stick_breaking_attention(qc.reshape(b_, s_, SB_HEADS, HEAD_DIM), kc.reshape(b_, s_, SB_HEADS, HEAD_DIM),
                                      vc.reshape(b_, s_, SB_HEADS, HEAD_DIM))
        oc = rmsnorm(oc, sb_out_norm[l]).reshape(b_, s_, GROUP_WIDTH)

        od = rwkv7_time_mix(pd, rwkv_mu[l], rwkv_w0[l], rwkv_w2[l], rwkv_a0[l], rwkv_a2[l], rwkv_g2[l],
                            rwkv_k_k[l], rwkv_k_a[l], rwkv_r_k[l], rwkv_ln_w[l], rwkv_ln_b[l])

        mix = jnp.concatenate([oa, ob, oc, od], axis=-1).astype(x.dtype)
        x = x + mix @ w_out[l]

        h = rmsnorm(x, ffn_norm[l])
        if l % 2 == 0:
            x = x + swiglu(h, ffn_w1[l // 2], ffn_w3[l // 2], ffn_w2[l // 2])
        else:
            x = x + moe_swiglu(h, router[l // 2], moe_w1[l // 2], moe_w3[l // 2], moe_w2[l // 2])
    return rmsnorm(x, final_norm)
```

```cpp
#include <hip/hip_runtime.h>
#include <cstdio>
#include <cstdint>

#define LAS __attribute__((address_space(3)))
#define GAS __attribute__((address_space(1)))
typedef unsigned short bf16_t;
typedef short bf16x8 __attribute__((ext_vector_type(8)));
typedef float f32x4 __attribute__((ext_vector_type(4)));
typedef float f32x2 __attribute__((ext_vector_type(2)));
typedef unsigned u32x4 __attribute__((ext_vector_type(4)));
typedef unsigned u32x2 __attribute__((ext_vector_type(2)));

#ifndef N_LAUNCHES_ONE
#define N_LAUNCHES_ONE 1
#endif

constexpr int BATCH = 8, SEQ = 4096, DM = 1024, NTOK = BATCH * SEQ, DEPTH = 4;
constexpr int IN_COLS = 3088, NPROJ = 3328;
constexpr int D_FF = 2816, N_EXP = 8, D_FFE = 1408;
constexpr int KP8 = 1536;
constexpr int PA_Q = 0, PA_K = 256, PA_V = 384;
constexpr int PB_Q = 512, PB_K = 640, PB_V = 768, PB_G = 1024;
constexpr int PC_Q = 1280, PC_K = 1536, PC_V = 1792;
constexpr int PD = 2048;
constexpr int PB_LR = 3072;
constexpr float NORM_EPS = 1e-6f;
constexpr int MOE_ROWS = NTOK * 2 + N_EXP * 256;

constexpr size_t MiB = 1u << 20;
constexpr size_t WS_CTL = 0, CTL_ZERO_BYTES = 1 * MiB;
constexpr size_t WS_ROPE_C = 2 * MiB, WS_ROPE_S = 6 * MiB;
constexpr size_t WS_WIN = 10 * MiB, WS_WOUT = 17 * MiB, WS_W13 = 19 * MiB, WS_W2 = 63 * MiB;
constexpr size_t WS_H = 86 * MiB;
constexpr size_t WS_PROJ = 150 * MiB;
constexpr size_t WS_MIX = 358 * MiB;
constexpr size_t WS_SCR = 422 * MiB;
constexpr size_t WS_RWM = WS_H;
constexpr size_t WS_RW_V = WS_SCR, WS_RW_G = WS_SCR + 16 * MiB, WS_RW_S = WS_SCR + 32 * MiB;
constexpr size_t WS_GLA_KV = 470 * MiB, WS_GLA_DEC = 1 * MiB;
constexpr size_t WS_RKR = 486 * MiB;
constexpr size_t WS_RW_X = 488 * MiB;
constexpr size_t WS_SMALLW = 85 * MiB;
constexpr size_t WS_YRAW = 488 * MiB;
constexpr size_t WS_Y = 358 * MiB;
constexpr size_t WS_TOK_E = 520 * MiB, WS_TOK_G = WS_TOK_E + 256 * 1024, WS_TOK_SLOT = WS_TOK_G + 256 * 1024, WS_TOK_ROW = WS_TOK_SLOT + 256 * 1024, WS_ROWMAP = 521 * MiB;
constexpr size_t WS_END = 522 * MiB;
static_assert(WS_Y + (size_t)MOE_ROWS * 2048 <= WS_TOK_E && WS_YRAW + (size_t)NTOK * 256 * 4 <= WS_TOK_E && WS_W2 + 22 * MiB <= WS_H, "ws map");
constexpr int CW_BAR = 4096;
constexpr int CW_ATTNQ = 12288;
constexpr int CW_MOECNT = 8192;

constexpr size_t XB_OFF = 64 * MiB;
constexpr int LDS_BYTES = 147456;
constexpr int MISC_OFF = 131072 + 8192;

__device__ __forceinline__ float bf2f(unsigned short u) { return __uint_as_float((unsigned)u << 16); }
__device__ __forceinline__ float bflo(unsigned w) { return __uint_as_float(w << 16); }
__device__ __forceinline__ float bfhi(unsigned w) { return __uint_as_float(w & 0xffff0000u); }
__device__ __forceinline__ unsigned short f2bf(float f) { unsigned u = __float_as_uint(f); return (unsigned short)((u + 0x7fffu + ((u >> 16) & 1u)) >> 16); }
__device__ __forceinline__ unsigned pk2(float lo, float hi) { return (unsigned)f2bf(lo) | ((unsigned)f2bf(hi) << 16); }
__device__ __forceinline__ float wave_sum(float v) {
#pragma unroll
    for (int o = 1; o < 64; o <<= 1) v += __shfl_xor(v, o);
    return v;
}
__device__ __forceinline__ float sigmoid_f(float x) { return 1.f / (1.f + __expf(-x)); }
__device__ __forceinline__ float softplus_f(float z) { return fmaxf(z, 0.f) + __logf(1.f + __expf(-fabsf(z))); }
__device__ __forceinline__ float logsigmoid_f(float x) { return fminf(x, 0.f) - __logf(1.f + __expf(-fabsf(x))); }
namespace pg8 {
constexpr int BM = 256, BK = 64, HALF = 128, HTB = HALF * BK * 2  , STAGE_BYTES = 8 * HTB, NXCD = 8, WGM = 8;

__host__ __device__ __forceinline__ int lds_byte(int r, int c) { const int st = (r >> 4) * 2 + (c >> 5), rr = r & 15, cc = c & 31, ob = rr * 64 + cc * 2; return st * 1024 + (ob ^ (((ob >> 9) & 1) << 5)); }
__host__ __device__ __forceinline__ void stage_rc(int b, int& R, int& C) { const int st = b / 1024, sb = b % 1024, swz = sb ^ (((sb >> 9) & 1) << 5); R = (st >> 1) * 16 + swz / 64; C = (st & 1) * 32 + (swz % 64) / 2; }
__host__ __device__ __forceinline__ int perm32(int rho) { const int n = rho >> 4, i = rho & 15; return 8 * (i >> 2) + 4 * n + (i & 3); }

struct Unit { int pm, pn, pc; };
struct Gemm { const bf16_t* A; const bf16_t* Bt; int K; const int* rowmap; };

struct StaticOrder {
    int nM, nN, nwg, G, c;
    __device__ void init(int M, int N, int G_, int c_) { nM = M / BM; nN = N / BM; nwg = nM * nN; G = G_; c = c_; }
    __device__ bool next(int i, Unit& u) const {
        const long L = (long)i * G + c; if (L >= nwg) return false;
        int wgid = (int)L; { const int q = nwg / NXCD, r = nwg % NXCD, xcd = wgid % NXCD, off = wgid / NXCD; wgid = (xcd < r ? xcd * (q + 1) : r * (q + 1) + (xcd - r) * q) + off; }
        const int nig = WGM * nN, gid = wgid / nig, fm = gid * WGM, gsz = (nM - fm) < WGM ? (nM - fm) : WGM;
        u.pm = fm + ((wgid % nig) % gsz); u.pn = (wgid % nig) / gsz; u.pc = u.pn; return true;
    }
};
struct MoeOrder {
    int ntiles, nNe, G, c; int tb[9];
    __device__ bool next(int i, Unit& u) const {
        const long L = (long)i * G + c; if (L >= (long)ntiles * nNe) return false;
        const int pm = (int)(L / nNe), pl = (int)(L % nNe); int e = 0;
#pragma unroll
        for (int j = 1; j < 8; ++j) e += (pm >= tb[j]) ? 1 : 0;
        u.pm = pm; u.pn = e * nNe + pl; u.pc = pl; return true;
    }
};

typedef __bf16 bf16pair_t __attribute__((ext_vector_type(2)));
__device__ __forceinline__ unsigned cvt_pk_c(float lo, float hi) { bf16pair_t v; v[0] = (__bf16)lo; v[1] = (__bf16)hi; return __builtin_bit_cast(unsigned, v); }
__device__ __forceinline__ unsigned cvt_pk_bf16(float lo, float hi) { unsigned r; asm volatile("v_cvt_pk_bf16_f32 %0, %1, %2" : "=v"(r) : "v"(lo), "v"(hi)); return r; }

struct EpiBf16 {
    static constexpr bool PERM = true;
    bf16_t* O; int ldc; float sc = 1.f;
    __device__ __forceinline__ void operator()(const f32x4 (&acc)[2][2][4][2], const Unit& u, int wr, int wc, int fr, int fq) const {
        const int row0 = u.pm * BM + wr * 64 + fr; const int col0 = u.pc * BM + wc * 32 + 8 * fq;
#pragma unroll
        for (int ai = 0; ai < 2; ++ai)
#pragma unroll
            for (int m = 0; m < 4; ++m) { bf16_t* rowp = O + (size_t)(row0 + ai * HALF + m * 16) * ldc + col0;
#pragma unroll
                for (int bj = 0; bj < 2; ++bj) { const f32x4 v0 = acc[ai][bj][m][0] * sc, v1 = acc[ai][bj][m][1] * sc;
                    u32x4 w; w.x = cvt_pk_bf16(v0[0], v0[1]); w.y = cvt_pk_bf16(v0[2], v0[3]); w.z = cvt_pk_bf16(v1[0], v1[1]); w.w = cvt_pk_bf16(v1[2], v1[3]);
                    *(u32x4*)(rowp + bj * HALF) = w; } }
    }
};
struct EpiSwiglu {
    static constexpr bool PERM = true;
    bf16_t* O; int ldc; float sc;
    __device__ __forceinline__ void operator()(const f32x4 (&acc)[2][2][4][2], const Unit& u, int wr, int wc, int fr, int fq) const {
        const int row0 = u.pm * BM + wr * 64 + fr; const int col0 = u.pc * HALF + wc * 32 + 8 * fq;
#pragma unroll
        for (int ai = 0; ai < 2; ++ai)
#pragma unroll
            for (int m = 0; m < 4; ++m) { bf16_t* rowp = O + (size_t)(row0 + ai * HALF + m * 16) * ldc + col0;
                float r[8];
#pragma unroll
                for (int n = 0; n < 2; ++n)
#pragma unroll
                    for (int j = 0; j < 4; ++j) { const float g = acc[ai][0][m][n][j] * sc, up = acc[ai][1][m][n][j] * sc; r[n * 4 + j] = g * __builtin_amdgcn_rcpf(1.f + __expf(-g)) * up; }
                u32x4 w; w.x = cvt_pk_bf16(r[0], r[1]); w.y = cvt_pk_bf16(r[2], r[3]); w.z = cvt_pk_bf16(r[4], r[5]); w.w = cvt_pk_bf16(r[6], r[7]);
                *(u32x4*)rowp = w; }
    }
};
__device__ __forceinline__ unsigned pk4_fp8c(float a, float b, float c, float d) { unsigned w = 0u;
    a = __builtin_fminf(__builtin_fmaxf(a, -448.f), 448.f); b = __builtin_fminf(__builtin_fmaxf(b, -448.f), 448.f); c = __builtin_fminf(__builtin_fmaxf(c, -448.f), 448.f); d = __builtin_fminf(__builtin_fmaxf(d, -448.f), 448.f);
    w = __builtin_amdgcn_cvt_pk_fp8_f32(a, b, w, false); w = __builtin_amdgcn_cvt_pk_fp8_f32(c, d, w, true); return w; }
struct EpiSwiglu8 {
    static constexpr bool PERM = true;
    unsigned char* O8; int ldc; float sc;
    __device__ __forceinline__ void operator()(const f32x4 (&acc)[2][2][4][2], const Unit& u, int wr, int wc, int fr, int fq) const {
        const int row0 = u.pm * BM + wr * 64 + fr; const int col0 = u.pc * HALF + wc * 32 + 8 * fq;
#pragma unroll
        for (int ai = 0; ai < 2; ++ai)
#pragma unroll
            for (int m = 0; m < 4; ++m) { unsigned char* rowp = O8 + (size_t)(row0 + ai * HALF + m * 16) * ldc + col0;
                float r[8];
#pragma unroll
                for (int n = 0; n < 2; ++n)
#pragma unroll
                    for (int j = 0; j < 4; ++j) { const float g = acc[ai][0][m][n][j] * sc, up = acc[ai][1][m][n][j] * sc; r[n * 4 + j] = g * __builtin_amdgcn_rcpf(1.f + __expf(-g)) * up; }
                u32x2 w; w.x = pk4_fp8c(r[0], r[1], r[2], r[3]); w.y = pk4_fp8c(r[4], r[5], r[6], r[7]);
                *(u32x2*)rowp = w; }
    }
};
template <bool BASE_F32> struct EpiResidB {
    static constexpr bool PERM = true;
    const void* base; bf16_t* out; int ldc; float sc = 1.f;
    __device__ __forceinline__ void operator()(const f32x4 (&acc)[2][2][4][2], const Unit& u, int wr, int wc, int fr, int fq) const {
        const int row0 = u.pm * BM + wr * 64 + fr; const int col0 = u.pc * BM + wc * 32 + 8 * fq;
#pragma unroll
        for (int ai = 0; ai < 2; ++ai)
#pragma unroll
            for (int m = 0; m < 4; ++m) { const size_t off = (size_t)(row0 + ai * HALF + m * 16) * ldc + col0;
#pragma unroll
                for (int bj = 0; bj < 2; ++bj) { f32x4 v0 = acc[ai][bj][m][0] * sc, v1 = acc[ai][bj][m][1] * sc;
                    if (BASE_F32) { const float* bp = (const float*)base + off + bj * HALF; v0 += *(const f32x4*)bp; v1 += *(const f32x4*)(bp + 4); }
                    else { const u32x4 w = *(const u32x4*)((const bf16_t*)base + off + bj * HALF);
                        v0[0] += __uint_as_float(w.x << 16); v0[1] += __uint_as_float(w.x & 0xffff0000u); v0[2] += __uint_as_float(w.y << 16); v0[3] += __uint_as_float(w.y & 0xffff0000u);
                        v1[0] += __uint_as_float(w.z << 16); v1[1] += __uint_as_float(w.z & 0xffff0000u); v1[2] += __uint_as_float(w.w << 16); v1[3] += __uint_as_float(w.w & 0xffff0000u); }
                    u32x4 o; o.x = cvt_pk_bf16(v0[0], v0[1]); o.y = cvt_pk_bf16(v0[2], v0[3]); o.z = cvt_pk_bf16(v1[0], v1[1]); o.w = cvt_pk_bf16(v1[2], v1[3]);
                    *(u32x4*)(out + off + bj * HALF) = o; } }
    }
};

typedef int i32x8 __attribute__((ext_vector_type(8)));
typedef int i32x4g __attribute__((ext_vector_type(4)));
__device__ __forceinline__ i32x8 cat8(const bf16x8 a, const bf16x8 b) { return __builtin_shufflevector(__builtin_bit_cast(i32x4g, a), __builtin_bit_cast(i32x4g, b), 0, 1, 2, 3, 4, 5, 6, 7); }
template <class Epi, class Sched, bool GATHER, bool F8 = false>
__device__ __forceinline__ void gemm_phase(const int tid, LAS unsigned char* lds, const Gemm g, const Sched& S, const Epi& E) {
    const int wid = __builtin_amdgcn_readfirstlane(tid >> 6), lane = tid & 63, wr = wid >> 2, wc = wid & 3, fr = lane & 15, fq = lane >> 4;
    const int K = g.K, nt = K / BK;
    unsigned voffA, voffB;
    { int R, C; stage_rc(tid * 16, R, C); const int Rb = Epi::PERM ? ((R & ~31) + perm32(R & 31)) : R; voffA = (unsigned)(R * K + C) * 2u; voffB = (unsigned)(Rb * K + C) * 2u; }
    const size_t kstep = (size_t)(BK * 2);
    const size_t hstep = (size_t)HALF * K * 2;
    const size_t tstep = 2 * hstep;
    const unsigned ldsw = (unsigned)wid * 1024u;
    const int aoff = lds_byte(wr * 64 + fr, fq * 8), boff = lds_byte(wc * 32 + fr, fq * 8);
#define PG8_SA(b, h) (((b) * 2 + (h)) * HTB)
#define PG8_SB(b, h) ((4 + (b) * 2 + (h)) * HTB)
#define PG8_STAGE2(bufoff, gbase, v0, v1) do { _Pragma("unroll") for (int _i = 0; _i < 2; ++_i) { unsigned _v = _i ? (v1) : (v0); asm volatile("" : "+v"(_v)); \
        __builtin_amdgcn_global_load_lds((const unsigned*)((const char*)(gbase) + _v), (LAS unsigned*)(lds + (bufoff) + ldsw + _i * 8192), 16, 0, 0); } } while (0)
#define PG8_STAGE(bufoff, gbase, voff) PG8_STAGE2(bufoff, gbase, (voff), (voff) + (unsigned)(128 * K))
#define PG8_STAGE_A(bufoff, kb, h, nx) do { if constexpr (GATHER) { PG8_STAGE2(bufoff, (const char*)g.A + (kb), offC[h][0], offC[h][1]); }   \
        else { PG8_STAGE(bufoff, ((nx) ? nA : cA) + (kb) + (h) * hstep, voffA); } } while (0)
#define PG8_LDA(dst, b, h) do { _Pragma("unroll") for (int m = 0; m < 4; ++m) _Pragma("unroll") for (int k = 0; k < 2; ++k) dst[m][k] = *(const LAS bf16x8*)(lds + PG8_SA(b, h) + aoff + m * 2048 + k * 1024); } while (0)
#define PG8_LDB(dst, b, h) do { _Pragma("unroll") for (int n = 0; n < 2; ++n) _Pragma("unroll") for (int k = 0; k < 2; ++k) dst[n][k] = *(const LAS bf16x8*)(lds + PG8_SB(b, h) + boff + n * 2048 + k * 1024); } while (0)
#define PG8_MMA(ai, bj, At, Bt) do { __builtin_amdgcn_s_setprio(1); _Pragma("unroll") for (int m = 0; m < 4; ++m) _Pragma("unroll") for (int n = 0; n < 2; ++n) { \
        if constexpr (F8) acc[ai][bj][m][n] = __builtin_amdgcn_mfma_scale_f32_16x16x128_f8f6f4(cat8(Bt[n][0], Bt[n][1]), cat8(At[m][0], At[m][1]), acc[ai][bj][m][n], 0, 0, 0, 0, 0, 0);   \
        else { _Pragma("unroll") for (int k = 0; k < 2; ++k) acc[ai][bj][m][n] = __builtin_amdgcn_mfma_f32_16x16x32_bf16(Bt[n][k], At[m][k], acc[ai][bj][m][n], 0, 0, 0); } } __builtin_amdgcn_s_setprio(0); } while (0)
#define PG8_WAIT_V(n) asm volatile("s_waitcnt vmcnt(" #n ")" ::: "memory")
#define PG8_WAIT_L(n) asm volatile("s_waitcnt lgkmcnt(" #n ")" ::: "memory")
#define PG8_BAR __builtin_amdgcn_s_barrier()
#define PG8_SCHED __builtin_amdgcn_sched_barrier(0)
#define PG8_LOADOFF(dst, u) do { _Pragma("unroll") for (int _h = 0; _h < 2; ++_h) _Pragma("unroll") for (int _i = 0; _i < 2; ++_i) { \
        int _R, _C; { int _t = tid; asm volatile("" : "+v"(_t)); stage_rc(_t * 16, _R, _C); } const int _row = g.rowmap[(u).pm * BM + _h * HALF + _R + 64 * _i]; dst[_h][_i] = (unsigned)(_row * K + _C) * 2u; } } while (0)
    Unit cur, nxt; int ui = 0;
    if (!S.next(0, cur)) return;
    f32x4 acc[2][2][4][2];
#pragma unroll
    for (int a = 0; a < 2; ++a)
#pragma unroll
        for (int b = 0; b < 2; ++b)
#pragma unroll
            for (int m = 0; m < 4; ++m)
#pragma unroll
                for (int n = 0; n < 2; ++n) acc[a][b][m][n] = (f32x4){0.f, 0.f, 0.f, 0.f};
    bf16x8 At[4][2], B0[2][2], B1[2][2];
    unsigned offC[2][2] = {{0u, 0u}, {0u, 0u}};
    LAS u32x4* offslot = (LAS u32x4*)(lds + STAGE_BYTES) + tid;
    const char* cA = (const char*)g.A + (GATHER ? (size_t)0 : (size_t)cur.pm * tstep); const char* cB = (const char*)g.Bt + (size_t)cur.pn * tstep;
    const char* nA = cA;
    if constexpr (GATHER) { PG8_LOADOFF(offC, cur); }
    PG8_STAGE(PG8_SB(0, 0), cB, voffB); PG8_STAGE(PG8_SB(0, 1), cB + hstep, voffB); PG8_STAGE_A(PG8_SA(0, 0), 0, 0, false); PG8_STAGE_A(PG8_SA(0, 1), 0, 1, false);
    if (wr == 1) PG8_BAR;
    PG8_WAIT_V(2); PG8_BAR;
    PG8_STAGE(PG8_SB(1, 0), cB + kstep, voffB); PG8_STAGE_A(PG8_SA(1, 0), kstep, 0, false); PG8_STAGE(PG8_SB(1, 1), cB + hstep + kstep, voffB);
    PG8_WAIT_V(6); PG8_BAR;
    for (;;) {
        const bool has_next = S.next(ui + 1, nxt);
        nA = has_next ? (const char*)g.A + (GATHER ? (size_t)0 : (size_t)nxt.pm * tstep) : cA; const char* nB = has_next ? (const char*)g.Bt + (size_t)nxt.pn * tstep : cB;
        if constexpr (GATHER) { unsigned offN[2][2];
            if (has_next) { PG8_LOADOFF(offN, nxt); } else {
#pragma unroll
                for (int h = 0; h < 2; ++h) { offN[h][0] = offC[h][0]; offN[h][1] = offC[h][1]; } }
            *offslot = (u32x4){offN[0][0], offN[0][1], offN[1][0], offN[1][1]}; }
#pragma unroll 1
        for (int t = 0; t < nt; t += 2) {
            const bool last = (t == nt - 2);
            const size_t k1 = (size_t)(t + 1) * kstep;
            const size_t k2 = last ? (size_t)0 : (size_t)(t + 2) * kstep, k3 = k2 + kstep;
            const char* b2 = last ? nB : cB + (size_t)(t + 2) * kstep; const char* b3 = b2 + kstep;
            PG8_LDB(B0, 0, 0); PG8_LDB(B1, 0, 1); PG8_SCHED; PG8_LDA(At, 0, 0); PG8_STAGE_A(PG8_SA(1, 1), k1, 1, false);
            if constexpr (GATHER) { if (last) { const u32x4 o_ = *offslot; offC[0][0] = o_.x; offC[0][1] = o_.y; offC[1][0] = o_.z; offC[1][1] = o_.w; } }
            PG8_WAIT_V(8); PG8_WAIT_L(0); PG8_BAR; PG8_MMA(0, 0, At, B0); PG8_MMA(0, 1, At, B1); PG8_BAR; PG8_SCHED;
            PG8_LDA(At, 0, 1); PG8_STAGE(PG8_SB(0, 0), b2, voffB); PG8_STAGE(PG8_SB(0, 1), b2 + hstep, voffB); PG8_STAGE_A(PG8_SA(0, 0), k2, 0, last);
            PG8_WAIT_V(8); PG8_WAIT_L(0); PG8_BAR; PG8_MMA(1, 0, At, B0); PG8_MMA(1, 1, At, B1); PG8_BAR; PG8_SCHED;
            PG8_LDB(B0, 1, 0); PG8_LDB(B1, 1, 1); PG8_SCHED; PG8_LDA(At, 1, 0); PG8_STAGE_A(PG8_SA(0, 1), k2, 1, last);
            PG8_WAIT_V(8); PG8_WAIT_L(0); PG8_BAR; PG8_MMA(0, 0, At, B0); PG8_MMA(0, 1, At, B1); PG8_BAR; PG8_SCHED;
            PG8_LDA(At, 1, 1); PG8_STAGE(PG8_SB(1, 0), b3, voffB); PG8_STAGE(PG8_SB(1, 1), b3 + hstep, voffB); PG8_STAGE_A(PG8_SA(1, 0), k3, 0, last);
            PG8_WAIT_V(8); PG8_WAIT_L(0); PG8_BAR; PG8_MMA(1, 0, At, B0); PG8_MMA(1, 1, At, B1); PG8_BAR; PG8_SCHED;
        }
        if (wr == 0) PG8_BAR;
        asm volatile("s_nop 15\n\ts_nop 15" ::: "memory");
        { unsigned m_ = ~0u; asm volatile("" : "+s"(m_)); const int ln_ = (int)__builtin_amdgcn_mbcnt_hi(m_, __builtin_amdgcn_mbcnt_lo(m_, 0u));
          E(acc, cur, wr, wc, ln_ & 15, ln_ >> 4); }
        if (!has_next) break;
#pragma unroll
        for (int a = 0; a < 2; ++a)
#pragma unroll
            for (int b = 0; b < 2; ++b)
#pragma unroll
                for (int m = 0; m < 4; ++m)
#pragma unroll
                    for (int n = 0; n < 2; ++n) acc[a][b][m][n] = (f32x4){0.f, 0.f, 0.f, 0.f};
        cur = nxt; cA = nA; cB = nB; ++ui;
        if (wr == 1) PG8_BAR;
    }
    PG8_WAIT_V(0);
    PG8_BAR;
#undef PG8_SA
#undef PG8_SB
#undef PG8_STAGE
#undef PG8_STAGE2
#undef PG8_STAGE_A
#undef PG8_LDA
#undef PG8_LDB
#undef PG8_MMA
#undef PG8_WAIT_V
#undef PG8_WAIT_L
#undef PG8_BAR
#undef PG8_SCHED
#undef PG8_LOADOFF
}
}
#define XB_TMO      128
#define XB_XCNT(j)  (256  + 64 * (j))
#define XB_XSUB(j)  (1280 + 64 * (j))
#define XB_XGEN(j)  (2304 + 64 * (j))
#define XB_TOP      3328
#define XB_TOPGEN   3392
#define XCD_BAR_WORDS 3456
#define XB_SPIN_CAP (1u << 18)

__device__ __forceinline__ unsigned xb_ld(unsigned* p)              { return __hip_atomic_load(p, __ATOMIC_RELAXED, __HIP_MEMORY_SCOPE_AGENT); }
__device__ __forceinline__ unsigned xb_add(unsigned* p, unsigned v) { return __hip_atomic_fetch_add(p, v, __ATOMIC_RELAXED, __HIP_MEMORY_SCOPE_AGENT); }
__device__ __forceinline__ unsigned xb_xcc_id() { return (unsigned)__builtin_amdgcn_s_getreg((3 << 11) | 20) & 0xFu; }
#define XB_SPIN(cond, bar) do { unsigned _sp = 0; while (cond) { __builtin_amdgcn_s_sleep(1); \
    if ((++_sp & 255u) == 0u) { if (xb_ld(&(bar)[XB_TMO])) break; if (_sp > XB_SPIN_CAP) { atomicAdd(&(bar)[XB_TMO], 1u); break; } } } } while (0)

struct XcdBarrier {
    unsigned* bar; unsigned x;
    volatile LAS unsigned* st;
};

__device__ __forceinline__ XcdBarrier xcd_barrier_post(unsigned* bar, volatile LAS unsigned* st) {
    XcdBarrier b; b.bar = bar; b.x = xb_xcc_id(); b.st = st;
    if (threadIdx.x == 0) (void)xb_add(&bar[XB_XCNT(b.x)], 1u);
    return b;
}
__device__ __forceinline__ void xcd_barrier_complete(unsigned* bar, unsigned x, unsigned& nloc, unsigned& nx) {
    const unsigned G = gridDim.x * gridDim.y * gridDim.z;
    unsigned sum, cnt, mine, sp = 0u;
    for (;;) {
        sum = 0u; cnt = 0u; mine = 0u;
#pragma unroll
        for (unsigned j = 0; j < 16; ++j) { const unsigned c = xb_ld(&bar[XB_XCNT(j)]); sum += c; cnt += (c > 0u) ? 1u : 0u; mine = (j == x) ? c : mine; }
        if (sum == G) break;
        __builtin_amdgcn_s_sleep(1);
        if ((++sp & 255u) == 0u) { if (xb_ld(&bar[XB_TMO])) break; if (sp > XB_SPIN_CAP) { atomicAdd(&bar[XB_TMO], 1u); break; } }
    }
    nloc = mine > 0u ? mine : 1u; nx = cnt > 0u ? cnt : 1u;
}

__device__ __forceinline__ void xcd_barrier(const XcdBarrier& b, const bool leader) {
    asm volatile("s_waitcnt vmcnt(0)" ::: "memory");
    __syncthreads();
    if (leader) {
        unsigned* bar = b.bar;
        __builtin_amdgcn_s_waitcnt(0);
        unsigned nloc = b.st[0], nx = b.st[1];
        if (nloc == 0u) { xcd_barrier_complete(bar, b.x, nloc, nx); b.st[0] = nloc; b.st[1] = nx; }
        const unsigned old = xb_add(&bar[XB_XSUB(b.x)], 1u);
        const unsigned gen = old / nloc;
        if (old + 1u == (gen + 1u) * nloc) {
            __builtin_amdgcn_fence(__ATOMIC_RELEASE, "agent");
            asm volatile("s_waitcnt vmcnt(0)" ::: "memory");
            const unsigned og = xb_add(&bar[XB_TOP], 1u);
            const unsigned tg = og / nx;
            if (og + 1u == (tg + 1u) * nx) xb_add(&bar[XB_TOPGEN], 1u);
            else XB_SPIN(xb_ld(&bar[XB_TOPGEN]) == tg, bar);
            __builtin_amdgcn_fence(__ATOMIC_ACQUIRE, "agent");
            xb_add(&bar[XB_XGEN(b.x)], 1u);
            asm volatile("s_waitcnt vmcnt(0)" ::: "memory");
        } else {
            XB_SPIN(xb_ld(&bar[XB_XGEN(b.x)]) == gen, bar);
            __builtin_amdgcn_fence(__ATOMIC_ACQUIRE, "agent");
            asm volatile("s_waitcnt vmcnt(0)" ::: "memory");
        }
    }
    __syncthreads();
}
struct Frame {
    LAS unsigned char* lds;
    unsigned* ctl;
    unsigned char* ws;
    int tid, lane, wave, bid, G;
    float* out;
};
enum InIdx { I_X = 0, I_POS, I_ATTN_NORM, I_W_IN, I_SINKS, I_SWA_ON, I_GLA_WA2, I_GLA_BA, I_GLA_ON, I_SB_ON, I_MU, I_W0, I_W2, I_A0, I_A2, I_G2, I_KK, I_KA, I_RK, I_LNW, I_LNB,
             I_W_OUT, I_FFN_NORM, I_FFN_W1, I_FFN_W3, I_FFN_W2, I_ROUTER, I_MOE_W1, I_MOE_W3, I_MOE_W2, I_FINAL_NORM, N_IN };
constexpr int PTR_OFF = MISC_OFF + 64;
__device__ __forceinline__ const void* in_ptr(const Frame& F, int i) {
    const unsigned long long v = ((const LAS unsigned long long*)(F.lds + PTR_OFF))[i];
    const unsigned lo = __builtin_amdgcn_readfirstlane((unsigned)v), hi = __builtin_amdgcn_readfirstlane((unsigned)(v >> 32));
    return (const void*)(GAS const void*)(((unsigned long long)hi << 32) | lo);
}
#define INF(F, i) ((const float*)in_ptr(F, i))

template <class Map>
__device__ __forceinline__ void transpose_item(const float* W, int K, int N, bf16_t* WT, const Map& dst, LAS float* scr, int item, int lane) {
    const int nblk = (N + 31) / 32, kb = item / nblk, nb = item % nblk, k0 = 64 * kb, n0 = 32 * nb;
    const int nl = n0 + (lane & 31);
#pragma unroll 8
    for (int i = 0; i < 32; ++i) { const int kk = 2 * i + (lane >> 5); scr[kk * 33 + (lane & 31)] = (nl < N) ? W[(size_t)(k0 + kk) * N + nl] : 0.f; }
    asm volatile("s_waitcnt lgkmcnt(0)" ::: "memory");
    const int c = lane & 7;
#pragma unroll
    for (int j = 0; j < 4; ++j) { const int n = (lane >> 3) + 8 * j; const LAS float* s = scr + (8 * c) * 33 + n;
        u32x4 o; o.x = pk2(s[0 * 33], s[1 * 33]); o.y = pk2(s[2 * 33], s[3 * 33]); o.z = pk2(s[4 * 33], s[5 * 33]); o.w = pk2(s[6 * 33], s[7 * 33]);
        if (n0 + n < N) *(u32x4*)(WT + (size_t)dst(n0 + n) * K + k0 + 8 * c) = o; }
    asm volatile("s_waitcnt lgkmcnt(0)" ::: "memory");
}
__device__ __forceinline__ unsigned pk4_fp8(float a, float b, float c, float d) { unsigned w = 0u; w = __builtin_amdgcn_cvt_pk_fp8_f32(a, b, w, false); w = __builtin_amdgcn_cvt_pk_fp8_f32(c, d, w, true); return w; }
template <class Map>
__device__ __forceinline__ void transpose_item8(const float* W, int K, int N, unsigned char* WT, const Map& dst, LAS float* scr, int item, int lane, int pitch = 0) {
    const int nblk = (N + 31) / 32, kb = item / nblk, nb = item % nblk, k0 = 64 * kb, n0 = 32 * nb;
    const int nl = n0 + (lane & 31);
#pragma unroll 8
    for (int i = 0; i < 32; ++i) { const int kk = 2 * i + (lane >> 5); scr[kk * 33 + (lane & 31)] = (nl < N) ? W[(size_t)(k0 + kk) * N + nl] * 64.f : 0.f; }
    asm volatile("s_waitcnt lgkmcnt(0)" ::: "memory");
    const int c = lane & 7;
#pragma unroll
    for (int j = 0; j < 4; ++j) { const int n = (lane >> 3) + 8 * j; const LAS float* s = scr + (8 * c) * 33 + n;
        u32x2 o; o.x = pk4_fp8(s[0 * 33], s[1 * 33], s[2 * 33], s[3 * 33]); o.y = pk4_fp8(s[4 * 33], s[5 * 33], s[6 * 33], s[7 * 33]);
        if (n0 + n < N) *(u32x2*)(WT + (size_t)dst(n0 + n) * (pitch ? pitch : K) + k0 + 8 * c) = o; }
    asm volatile("s_waitcnt lgkmcnt(0)" ::: "memory");
}
struct MapIn { __device__ int operator()(int n) const { return n < 1280 ? n : (n < 1296 ? 3072 + (n - 1280) : n - 16); } };
struct MapId { int off; __device__ int operator()(int n) const { return off + n; } };
struct MapGU { int off; __device__ int operator()(int n) const { return off + 256 * (n >> 7) + (n & 127); } };

__device__ __forceinline__ void phase_convert_weights(Frame& F, int l) {
    LAS float* scr = (LAS float*)(F.lds + F.wave * 16384);
    const int gw = F.bid * 8 + F.wave, NGW = F.G * 8;
    bf16_t* WIN = (bf16_t*)(F.ws + WS_WIN); bf16_t* WOUT = (bf16_t*)(F.ws + WS_WOUT); bf16_t* W13 = (bf16_t*)(F.ws + WS_W13); bf16_t* W2 = (bf16_t*)(F.ws + WS_W2);
    const bool moe = (l & 1) != 0; const int li = l >> 1;
    const int I_IN = (DM / 64) * ((IN_COLS + 31) / 32), I_OUT = (DM / 64) * (DM / 32);
    const int I_UP = moe ? (DM / 64) * (D_FFE / 32) : (DM / 64) * (D_FF / 32);
    const int I_DN = moe ? (D_FFE / 64) * (DM / 32) : (D_FF / 64) * (DM / 32);
    const int NE = moe ? N_EXP : 1;
    const int total = I_IN + I_OUT + NE * (2 * I_UP + I_DN);
    for (int it = gw; it < total; it += NGW) {
        int r = it;
        if (r < I_IN) { transpose_item(INF(F, I_W_IN) + (size_t)l * DM * IN_COLS, DM, IN_COLS, WIN, MapIn{}, scr, r, F.lane); continue; } r -= I_IN;
        if (r < I_OUT) { transpose_item(INF(F, I_W_OUT) + (size_t)l * DM * DM, DM, DM, WOUT, MapId{0}, scr, r, F.lane); continue; } r -= I_OUT;
        const int per_e = 2 * I_UP + I_DN, e = r / per_e; r -= e * per_e;
        if (!moe) {
            if (r < I_UP) { transpose_item8(INF(F, I_FFN_W1) + (size_t)li * DM * D_FF, DM, D_FF, (unsigned char*)W13, MapGU{0}, scr, r, F.lane); continue; } r -= I_UP;
            if (r < I_UP) { transpose_item8(INF(F, I_FFN_W3) + (size_t)li * DM * D_FF, DM, D_FF, (unsigned char*)W13, MapGU{128}, scr, r, F.lane); continue; } r -= I_UP;
            transpose_item8(INF(F, I_FFN_W2) + (size_t)li * D_FF * DM, D_FF, DM, (unsigned char*)W2, MapId{0}, scr, r, F.lane);
        } else {
            const size_t eo = (size_t)(li * N_EXP + e);
            if (r < I_UP) { transpose_item8(INF(F, I_MOE_W1) + eo * DM * D_FFE, DM, D_FFE, (unsigned char*)W13, MapGU{e * 2 * D_FFE}, scr, r, F.lane); continue; } r -= I_UP;
            if (r < I_UP) { transpose_item8(INF(F, I_MOE_W3) + eo * DM * D_FFE, DM, D_FFE, (unsigned char*)W13, MapGU{e * 2 * D_FFE + 128}, scr, r, F.lane); continue; } r -= I_UP;
            transpose_item8(INF(F, I_MOE_W2) + eo * D_FFE * DM, D_FFE, DM, (unsigned char*)W2, MapId{e * DM}, scr, r, F.lane, KP8);
        }
    }
    if (moe) {
        unsigned zz = 0u; asm volatile("" : "+v"(zz));
        for (int i = F.bid * 512 + F.tid; i < N_EXP * DM * ((KP8 - D_FFE) / 16); i += F.G * 512) { const int row = i >> 3, c = i & 7; *(u32x4*)((unsigned char*)W2 + (size_t)row * KP8 + D_FFE + 16 * c) = (u32x4){zz, zz, zz, zz}; }
    }
}

__device__ __forceinline__ void phase_rope_tables(Frame& F) {
    float* C = (float*)(F.ws + WS_ROPE_C); float* S = (float*)(F.ws + WS_ROPE_S); const int* pos = (const int*)in_ptr(F, I_POS);
    for (int idx = F.bid * 512 + F.tid; idx < NTOK * 32; idx += F.G * 512) {
        const int tok = idx >> 5, i = idx & 31;
        const float invf = exp2f(-(float)(2 * i) * (13.287712379549449f / 64.f));
        const float angf = (float)pos[tok] * invf;
        const double a = (double)angf;
        const double n = rint(a * 0.15915494309189535);
        const double r = a - n * 6.283185307179586;
        const double r2 = r * r;
        double s = -1.0 / 51090942171709440000.0;
        s = s * r2 + 1.0 / 121645100408832000.0;  s = s * r2 - 1.0 / 355687428096000.0; s = s * r2 + 1.0 / 1307674368000.0; s = s * r2 - 1.0 / 6227020800.0;
        s = s * r2 + 1.0 / 39916800.0; s = s * r2 - 1.0 / 362880.0; s = s * r2 + 1.0 / 5040.0; s = s * r2 - 1.0 / 120.0; s = s * r2 + 1.0 / 6.0; s = s * r2 - 1.0; s = -s * r;
        double c = 1.0 / 1124000727777607680000.0;
        c = c * r2 - 1.0 / 2432902008176640000.0; c = c * r2 + 1.0 / 6402373705728000.0; c = c * r2 - 1.0 / 20922789888000.0; c = c * r2 + 1.0 / 87178291200.0;
        c = c * r2 - 1.0 / 479001600.0; c = c * r2 + 1.0 / 3628800.0; c = c * r2 - 1.0 / 40320.0; c = c * r2 + 1.0 / 720.0; c = c * r2 - 1.0 / 24.0; c = c * r2 + 0.5; c = 1.0 - c * r2;
        C[idx] = (float)c; S[idx] = (float)s;
    }
}

template <int MODE, bool XF32>
__device__ __forceinline__ void phase_norm(Frame& F, const void* xin, const float* gain, bool comb, int moe_slot) {
    bf16_t* HB = (bf16_t*)(F.ws + WS_H); bf16_t* XB = (bf16_t*)((unsigned char*)F.out + XB_OFF);
    const bf16_t* Y = (const bf16_t*)(F.ws + WS_Y);
    const int* TOK_ROW = (const int*)(F.ws + WS_TOK_ROW); const float* TOK_G = (const float*)(F.ws + WS_TOK_G);
    LAS float* rts = (LAS float*)F.lds;
    LAS int* te = (LAS int*)(F.lds + 32768);
    LAS float* tg = (LAS float*)(F.lds + 32768 + 1024);
    LAS int* tl = (LAS int*)(F.lds + 32768 + 2048);
    LAS int* lcnt = (LAS int*)(F.lds + 32768 + 3072);
    if (MODE == 1) {
        const float* router = INF(F, I_ROUTER) + (size_t)moe_slot * DM * N_EXP;
        for (int i = F.tid; i < DM * N_EXP; i += 512) { const int c = i >> 3, e = i & 7; rts[e * DM + c] = router[i]; }
        if (F.tid < 16) lcnt[F.tid] = 0;
        __syncthreads();
    }
    f32x4 gv[2][2];
#pragma unroll
    for (int j = 0; j < 2; ++j) { gv[j][0] = *(const f32x4*)(gain + 8 * F.lane + 512 * j); gv[j][1] = *(const f32x4*)(gain + 8 * F.lane + 512 * j + 4); }
    for (int rr = 0; rr < 16; ++rr) {
        const int rloc = F.wave * 16 + rr; const int row = F.bid * 128 + rloc;
        if (row >= NTOK) break;
        float v[2][8];
#pragma unroll
        for (int j = 0; j < 2; ++j) {
            if (XF32) { const float* xr = (const float*)xin + (size_t)row * DM + 8 * F.lane + 512 * j; const f32x4 a = *(const f32x4*)xr, b = *(const f32x4*)(xr + 4);
                v[j][0] = a[0]; v[j][1] = a[1]; v[j][2] = a[2]; v[j][3] = a[3]; v[j][4] = b[0]; v[j][5] = b[1]; v[j][6] = b[2]; v[j][7] = b[3]; }
            else { const u32x4 w = *(const u32x4*)((const bf16_t*)xin + (size_t)row * DM + 8 * F.lane + 512 * j);
                v[j][0] = bflo(w.x); v[j][1] = bfhi(w.x); v[j][2] = bflo(w.y); v[j][3] = bfhi(w.y); v[j][4] = bflo(w.z); v[j][5] = bfhi(w.z); v[j][6] = bflo(w.w); v[j][7] = bfhi(w.w); } }
        if (comb) {
            const int r0 = TOK_ROW[row * 2], r1 = TOK_ROW[row * 2 + 1]; const float g0 = TOK_G[row * 2], g1 = TOK_G[row * 2 + 1];
#pragma unroll
            for (int j = 0; j < 2; ++j) {
                const u32x4 a = *(const u32x4*)(Y + (size_t)r0 * DM + 8 * F.lane + 512 * j), b = *(const u32x4*)(Y + (size_t)r1 * DM + 8 * F.lane + 512 * j);
                v[j][0] += g0 * bflo(a.x) + g1 * bflo(b.x); v[j][1] += g0 * bfhi(a.x) + g1 * bfhi(b.x); v[j][2] += g0 * bflo(a.y) + g1 * bflo(b.y); v[j][3] += g0 * bfhi(a.y) + g1 * bfhi(b.y);
                v[j][4] += g0 * bflo(a.z) + g1 * bflo(b.z); v[j][5] += g0 * bfhi(a.z) + g1 * bfhi(b.z); v[j][6] += g0 * bflo(a.w) + g1 * bflo(b.w); v[j][7] += g0 * bfhi(a.w) + g1 * bfhi(b.w);
                if (MODE != 2) { u32x4 o; o.x = pk2(v[j][0], v[j][1]); o.y = pk2(v[j][2], v[j][3]); o.z = pk2(v[j][4], v[j][5]); o.w = pk2(v[j][6], v[j][7]); *(u32x4*)(XB + (size_t)row * DM + 8 * F.lane + 512 * j) = o; }
            }
        }
        float ss = 0.f;
#pragma unroll
        for (int j = 0; j < 2; ++j)
#pragma unroll
            for (int i = 0; i < 8; ++i) ss += v[j][i] * v[j][i];
        const float rstd = rsqrtf(wave_sum(ss) * (1.f / DM) + NORM_EPS);
#pragma unroll
        for (int j = 0; j < 2; ++j)
#pragma unroll
            for (int i = 0; i < 8; ++i) v[j][i] = v[j][i] * rstd * gv[j][i >> 2][i & 3];
        if (MODE == 2) {
            float* dst = (row < NTOK / 2) ? F.out + (size_t)row * DM : (float*)(F.ws + WS_PROJ) + (size_t)(row - NTOK / 2) * DM;
#pragma unroll
            for (int j = 0; j < 2; ++j) { *(f32x4*)(dst + 8 * F.lane + 512 * j) = (f32x4){v[j][0], v[j][1], v[j][2], v[j][3]}; *(f32x4*)(dst + 8 * F.lane + 512 * j + 4) = (f32x4){v[j][4], v[j][5], v[j][6], v[j][7]}; }
        } else {
#pragma unroll
            for (int j = 0; j < 2; ++j) {
                if (MODE == 0 || MODE == 1) { u32x2 o; o.x = pk4_fp8(v[j][0], v[j][1], v[j][2], v[j][3]); o.y = pk4_fp8(v[j][4], v[j][5], v[j][6], v[j][7]); *(u32x2*)((unsigned char*)HB + (size_t)row * DM + 8 * F.lane + 512 * j) = o; }
                else { u32x4 o; o.x = pk2(v[j][0], v[j][1]); o.y = pk2(v[j][2], v[j][3]); o.z = pk2(v[j][4], v[j][5]); o.w = pk2(v[j][6], v[j][7]); *(u32x4*)(HB + (size_t)row * DM + 8 * F.lane + 512 * j) = o; } }
        }
        if (MODE == 1) {
            float lg[8];
#pragma unroll
            for (int e = 0; e < 8; ++e) { float a = 0.f;
#pragma unroll
                for (int j = 0; j < 2; ++j) { const f32x4 w0 = *(const LAS f32x4*)(rts + e * DM + 8 * F.lane + 512 * j), w1 = *(const LAS f32x4*)(rts + e * DM + 8 * F.lane + 512 * j + 4);
                    a += (v[j][0] * w0[0] + v[j][1] * w0[1]) + (v[j][2] * w0[2] + v[j][3] * w0[3]) + (v[j][4] * w1[0] + v[j][5] * w1[1]) + (v[j][6] * w1[2] + v[j][7] * w1[3]); }
                lg[e] = wave_sum(a); }
            int i0 = 0; float v0 = lg[0];
#pragma unroll
            for (int e = 1; e < 8; ++e) if (lg[e] > v0) { v0 = lg[e]; i0 = e; }
            int i1 = -1; float v1 = -3.0e38f;
#pragma unroll
            for (int e = 0; e < 8; ++e) if (e != i0 && lg[e] > v1) { v1 = lg[e]; i1 = e; }
            const float g0 = 1.f / (1.f + __expf(v1 - v0));
            if (F.lane == 0) { te[rloc * 2] = i0; te[rloc * 2 + 1] = i1; tg[rloc * 2] = g0; tg[rloc * 2 + 1] = 1.f - g0; }
        }
    }
    if (MODE == 1) {
        __syncthreads();
        int e = 0, li = 0;
        if (F.tid < 256) { e = te[F.tid]; li = atomicAdd((int*)&lcnt[e], 1); tl[F.tid] = li; }
        __syncthreads();
        if (F.tid < 8) lcnt[8 + F.tid] = (int)atomicAdd(F.ctl + CW_MOECNT + 64 * moe_slot + F.tid, (unsigned)lcnt[F.tid]);
        __syncthreads();
        if (F.tid < 256) {
            const int tok = F.bid * 128 + (F.tid >> 1), k = F.tid & 1;
            ((int*)(F.ws + WS_TOK_E))[tok * 2 + k] = e;
            ((int*)(F.ws + WS_TOK_SLOT))[tok * 2 + k] = lcnt[8 + e] + li;
            ((float*)(F.ws + WS_TOK_G))[tok * 2 + k] = tg[F.tid];
        }
    }
}
constexpr int NL_PITCH = 1032;
template <bool XF32, bool COMB>
__device__ __forceinline__ void phase_norm_lr(Frame& F, const void* xin, const float* gain, int l) {
    bf16_t* HB = (bf16_t*)(F.ws + WS_H); bf16_t* XB = (bf16_t*)((unsigned char*)F.out + XB_OFF); bf16_t* PROJ = (bf16_t*)(F.ws + WS_PROJ);
    const bf16_t* Y = (const bf16_t*)(F.ws + WS_Y);
    const int* TOK_ROW = (const int*)(F.ws + WS_TOK_ROW); const float* TOK_G = (const float*)(F.ws + WS_TOK_G);
    LAS bf16_t* WL = (LAS bf16_t*)F.lds;
    LAS float* GL = (LAS float*)(F.lds + 16 * NL_PITCH * 2);
    __syncthreads();
    { const float* wl = INF(F, I_W_IN) + (size_t)l * DM * IN_COLS + 1280;
#pragma unroll 1
      for (int c = F.tid; c < DM; c += 512) { const float* p = wl + (size_t)c * IN_COLS;
          const f32x4 a = *(const f32x4*)p, b = *(const f32x4*)(p + 4), cc = *(const f32x4*)(p + 8), d = *(const f32x4*)(p + 12);
#pragma unroll
          for (int j = 0; j < 4; ++j) { WL[j * NL_PITCH + c] = f2bf(a[j]); WL[(4 + j) * NL_PITCH + c] = f2bf(b[j]); WL[(8 + j) * NL_PITCH + c] = f2bf(cc[j]); WL[(12 + j) * NL_PITCH + c] = f2bf(d[j]); }
          GL[c] = gain[c]; } }
    __syncthreads();
    const int r16 = F.lane & 15, kq = F.lane >> 4;
    const int row = F.bid * 128 + F.wave * 16 + r16;
    u32x4 xs[32]; float ss = 0.f, sb = 0.f;
    if (XF32) {
        const float* xr = (const float*)xin + (size_t)row * DM + 8 * kq;
#pragma unroll
        for (int s = 0; s < 32; ++s) { const f32x4 a = *(const f32x4*)(xr + 32 * s), b = *(const f32x4*)(xr + 32 * s + 4);
            ss = __builtin_fmaf(a[0], a[0], ss); sb = __builtin_fmaf(a[1], a[1], sb); ss = __builtin_fmaf(a[2], a[2], ss); sb = __builtin_fmaf(a[3], a[3], sb); ss = __builtin_fmaf(b[0], b[0], ss); sb = __builtin_fmaf(b[1], b[1], sb); ss = __builtin_fmaf(b[2], b[2], ss); sb = __builtin_fmaf(b[3], b[3], sb);
            xs[s].x = pg8::cvt_pk_c(a[0], a[1]); xs[s].y = pg8::cvt_pk_c(a[2], a[3]); xs[s].z = pg8::cvt_pk_c(b[0], b[1]); xs[s].w = pg8::cvt_pk_c(b[2], b[3]);
            if ((s & 7) == 7) __builtin_amdgcn_sched_barrier(0); }
    } else if (!COMB) {
        const bf16_t* xr = (const bf16_t*)xin + (size_t)row * DM + 8 * kq;
#pragma unroll
        for (int s = 0; s < 32; ++s) xs[s] = *(const u32x4*)(xr + 32 * s);
#pragma unroll
        for (int s = 0; s < 32; ++s) { const u32x4 w = xs[s];
            ss = __builtin_fmaf(bflo(w.x), bflo(w.x), ss); sb = __builtin_fmaf(bfhi(w.x), bfhi(w.x), sb); ss = __builtin_fmaf(bflo(w.y), bflo(w.y), ss); sb = __builtin_fmaf(bfhi(w.y), bfhi(w.y), sb);
            ss = __builtin_fmaf(bflo(w.z), bflo(w.z), ss); sb = __builtin_fmaf(bfhi(w.z), bfhi(w.z), sb); ss = __builtin_fmaf(bflo(w.w), bflo(w.w), ss); sb = __builtin_fmaf(bfhi(w.w), bfhi(w.w), sb); }
    } else {
        const int r0 = TOK_ROW[row * 2], r1 = TOK_ROW[row * 2 + 1]; const float g0 = TOK_G[row * 2], g1 = TOK_G[row * 2 + 1];
        const bf16_t* xr = (const bf16_t*)xin + (size_t)row * DM + 8 * kq; const bf16_t* ya = Y + (size_t)r0 * DM + 8 * kq; const bf16_t* yb = Y + (size_t)r1 * DM + 8 * kq;
        bf16_t* xo = XB + (size_t)row * DM + 8 * kq;
#pragma unroll
        for (int s = 0; s < 32; ++s) { const u32x4 w = *(const u32x4*)(xr + 32 * s), a = *(const u32x4*)(ya + 32 * s), b = *(const u32x4*)(yb + 32 * s);
            float v[8];
            v[0] = bflo(w.x) + g0 * bflo(a.x) + g1 * bflo(b.x); v[1] = bfhi(w.x) + g0 * bfhi(a.x) + g1 * bfhi(b.x); v[2] = bflo(w.y) + g0 * bflo(a.y) + g1 * bflo(b.y); v[3] = bfhi(w.y) + g0 * bfhi(a.y) + g1 * bfhi(b.y);
            v[4] = bflo(w.z) + g0 * bflo(a.z) + g1 * bflo(b.z); v[5] = bfhi(w.z) + g0 * bfhi(a.z) + g1 * bfhi(b.z); v[6] = bflo(w.w) + g0 * bflo(a.w) + g1 * bflo(b.w); v[7] = bfhi(w.w) + g0 * bfhi(a.w) + g1 * bfhi(b.w);
#pragma unroll
            for (int j = 0; j < 8; j += 2) { ss = __builtin_fmaf(v[j], v[j], ss); sb = __builtin_fmaf(v[j + 1], v[j + 1], sb); }
            xs[s].x = pg8::cvt_pk_c(v[0], v[1]); xs[s].y = pg8::cvt_pk_c(v[2], v[3]); xs[s].z = pg8::cvt_pk_c(v[4], v[5]); xs[s].w = pg8::cvt_pk_c(v[6], v[7]);
            *(u32x4*)(xo + 32 * s) = xs[s];
            if ((s & 1) == 1) __builtin_amdgcn_sched_barrier(0); }
    }
    ss += sb; ss += __shfl_xor(ss, 16); ss += __shfl_xor(ss, 32);
    const float rstd = rsqrtf(ss * (1.f / DM) + NORM_EPS);
#pragma unroll
    for (int s = 0; s < 32; ++s) asm volatile("" : "+v"(xs[s].x), "+v"(xs[s].y), "+v"(xs[s].z), "+v"(xs[s].w));
    f32x4 acc = {0.f, 0.f, 0.f, 0.f};
    bf16_t* ho = HB + (size_t)row * DM + 8 * kq;
#pragma unroll
    for (int s = 0; s < 32; ++s) { const int c0 = 32 * s + 8 * kq; const f32x4 ga = *(const LAS f32x4*)(GL + c0), gb = *(const LAS f32x4*)(GL + c0 + 4); const u32x4 w = xs[s];
        u32x4 hw; hw.x = pg8::cvt_pk_c(bflo(w.x) * rstd * ga[0], bfhi(w.x) * rstd * ga[1]); hw.y = pg8::cvt_pk_c(bflo(w.y) * rstd * ga[2], bfhi(w.y) * rstd * ga[3]);
        hw.z = pg8::cvt_pk_c(bflo(w.z) * rstd * gb[0], bfhi(w.z) * rstd * gb[1]); hw.w = pg8::cvt_pk_c(bflo(w.w) * rstd * gb[2], bfhi(w.w) * rstd * gb[3]);
        *(u32x4*)(ho + 32 * s) = hw;
        acc = __builtin_amdgcn_mfma_f32_16x16x32_bf16(*(const LAS bf16x8*)(WL + r16 * NL_PITCH + c0), __builtin_bit_cast(bf16x8, hw), acc, 0, 0, 0);
        if ((s & 3) == 3) __builtin_amdgcn_sched_barrier(0); }
    { u32x2 o; o.x = pg8::cvt_pk_c(acc[0], acc[1]); o.y = pg8::cvt_pk_c(acc[2], acc[3]); *(u32x2*)(PROJ + (size_t)row * NPROJ + PB_LR + 4 * kq) = o; }
}
__device__ __forceinline__ void phase_final_copy(Frame& F) {
    const f32x4* src = (const f32x4*)(F.ws + WS_PROJ); f32x4* dst = (f32x4*)(F.out + (size_t)(NTOK / 2) * DM);
    for (int i = F.bid * 512 + F.tid; i < NTOK / 2 * DM / 4; i += F.G * 512) dst[i] = src[i];
}

__device__ __forceinline__ void moe_bases(const unsigned* cnt, int (&tb)[9]) {
    tb[0] = 0;
#pragma unroll
    for (int e = 0; e < 8; ++e) tb[e + 1] = tb[e] + __builtin_amdgcn_readfirstlane((int)((__hip_atomic_load(cnt + e, __ATOMIC_RELAXED, __HIP_MEMORY_SCOPE_AGENT) + 255u) >> 8));
}
__device__ __forceinline__ void phase_moe_map(Frame& F, int moe_slot) {
    int tb[9]; moe_bases(F.ctl + CW_MOECNT + 64 * moe_slot, tb);
    const int* TE = (const int*)(F.ws + WS_TOK_E); const int* TS = (const int*)(F.ws + WS_TOK_SLOT); int* TR = (int*)(F.ws + WS_TOK_ROW); int* RM = (int*)(F.ws + WS_ROWMAP);
    for (int a = F.bid * 512 + F.tid; a < NTOK * 2; a += F.G * 512) {
        const int e = TE[a]; int base = 0;
#pragma unroll
        for (int j = 0; j < 8; ++j) base = (e == j) ? tb[j] : base;
        const int row = base * 256 + TS[a]; TR[a] = row; RM[row] = a >> 1;
    }
    { unsigned zz = 0u; asm volatile("" : "+v"(zz)); unsigned char* A8 = F.ws + WS_PROJ;
      for (int i = F.bid * 512 + F.tid; i < tb[8] * 256 * ((KP8 - D_FFE) / 16); i += F.G * 512) { const int row = i >> 3, c = i & 7; *(u32x4*)(A8 + (size_t)row * KP8 + D_FFE + 16 * c) = (u32x4){zz, zz, zz, zz}; } }
    for (int i = F.bid * 512 + F.tid; i < N_EXP * 256; i += F.G * 512) {
        const int e = i >> 8, j = i & 255; int b0 = 0, b1 = 0;
#pragma unroll
        for (int q = 0; q < 8; ++q) { b0 = (e == q) ? tb[q] : b0; b1 = (e == q) ? tb[q + 1] : b1; }
        const int cnt = (int)__hip_atomic_load(F.ctl + CW_MOECNT + 64 * moe_slot + e, __ATOMIC_RELAXED, __HIP_MEMORY_SCOPE_AGENT);
        const int row = b0 * 256 + cnt + j; if (row < b1 * 256) RM[row] = 0;
    }
}
__device__ __forceinline__ void swa_unit(Frame& F, int l, int unit) {
    const bf16_t* P = (const bf16_t*)(F.ws + WS_PROJ); bf16_t* MIX = (bf16_t*)(F.ws + WS_MIX);
    const float* RC = (const float*)(F.ws + WS_ROPE_C); const float* RS = (const float*)(F.ws + WS_ROPE_S);
    const int qblk = unit & 31, kvh = (unit >> 5) & 1, b = unit >> 6;
    LAS float* Ks = (LAS float*)F.lds;
    LAS float* Vs = (LAS float*)(F.lds + 65536);
    const int tok0 = b * SEQ + qblk * 128;
    __syncthreads();
#pragma unroll 1
    for (int it = 0; it < 16; ++it) {
        const int idx = it * 512 + F.tid, j = idx >> 5, d = idx & 31; const int pos = qblk * 128 - 128 + j;
        float o1 = 0.f, o2 = 0.f;
        if (pos >= 0) { const int tok = b * SEQ + pos; const bf16_t* kp = P + (size_t)tok * NPROJ + PA_K + kvh * 64;
            const float k1 = bf2f(kp[d]), k2 = bf2f(kp[d + 32]), c = RC[tok * 32 + d], s = RS[tok * 32 + d]; o1 = k1 * c - k2 * s; o2 = k2 * c + k1 * s; }
        Ks[j * 64 + d] = o1; Ks[j * 64 + d + 32] = o2;
    }
#pragma unroll 1
    for (int it = 0; it < 32; ++it) {
        const int idx = it * 512 + F.tid, j = idx >> 6, d = idx & 63; const int pos = qblk * 128 - 128 + j;
        Vs[idx] = (pos >= 0) ? bf2f(P[(size_t)(b * SEQ + pos) * NPROJ + PA_V + kvh * 64 + d]) : 0.f;
    }
    const int part = F.tid >> 8, qv = F.tid & 255, g = qv >> 7, i = qv & 127, hq = kvh * 2 + g;
    const int tok = tok0 + i;
    float q[64];
    { const bf16_t* qp = P + (size_t)tok * NPROJ + PA_Q + hq * 64;
#pragma unroll
      for (int d = 0; d < 32; ++d) { const float q1 = bf2f(qp[d]), q2 = bf2f(qp[d + 32]), c = RC[tok * 32 + d], s = RS[tok * 32 + d]; q[d] = (q1 * c - q2 * s) * 0.125f; q[d + 32] = (q2 * c + q1 * s) * 0.125f; } }
    const float sink = INF(F, I_SINKS)[l * 4 + hq];
    float m = sink, lsum = (part == 0) ? 1.f : 0.f, acc[64];
#pragma unroll
    for (int d = 0; d < 64; ++d) acc[d] = 0.f;
    __syncthreads();
    for (int jj = 0; jj < 128; ++jj) {
        const int j = part * 128 + jj;
        const bool valid = (j > i) && (j <= i + 128) && (qblk > 0 || j >= 128);
        float s = 0.f;
#pragma unroll
        for (int d4 = 0; d4 < 16; ++d4) { const f32x4 kv = *(const LAS f32x4*)(Ks + j * 64 + d4 * 4); s += (q[d4 * 4] * kv[0] + q[d4 * 4 + 1] * kv[1]) + (q[d4 * 4 + 2] * kv[2] + q[d4 * 4 + 3] * kv[3]); }
        if (!valid) s = -INFINITY;
        const float mn = fmaxf(m, s), sc = __expf(m - mn), p = __expf(s - mn);
        lsum = lsum * sc + p; m = mn;
#pragma unroll
        for (int d4 = 0; d4 < 16; ++d4) { const f32x4 vv = *(const LAS f32x4*)(Vs + j * 64 + d4 * 4);
            acc[d4 * 4] = acc[d4 * 4] * sc + p * vv[0]; acc[d4 * 4 + 1] = acc[d4 * 4 + 1] * sc + p * vv[1]; acc[d4 * 4 + 2] = acc[d4 * 4 + 2] * sc + p * vv[2]; acc[d4 * 4 + 3] = acc[d4 * 4 + 3] * sc + p * vv[3]; }
    }
    __syncthreads();
    LAS float* MB = (LAS float*)F.lds;
    if (part == 1) { MB[qv * 66] = m; MB[qv * 66 + 1] = lsum;
#pragma unroll
        for (int d = 0; d < 64; ++d) MB[qv * 66 + 2 + d] = acc[d]; }
    __syncthreads();
    if (part == 0) {
        const float m1 = MB[qv * 66], l1 = MB[qv * 66 + 1]; const float M = fmaxf(m, m1), s0 = __expf(m - M), s1 = __expf(m1 - M);
        const float inv = 1.f / (lsum * s0 + l1 * s1); float ss = 0.f;
#pragma unroll
        for (int d = 0; d < 64; ++d) { acc[d] = (acc[d] * s0 + MB[qv * 66 + 2 + d] * s1) * inv; ss += acc[d] * acc[d]; }
        const float rstd = rsqrtf(ss * (1.f / 64.f) + NORM_EPS); const float* gn = INF(F, I_SWA_ON) + l * 256 + hq * 64;
        bf16_t* op = MIX + (size_t)tok * DM + hq * 64;
#pragma unroll
        for (int d8 = 0; d8 < 8; ++d8) { u32x4 w;
            w.x = pk2(acc[d8 * 8] * rstd * gn[d8 * 8], acc[d8 * 8 + 1] * rstd * gn[d8 * 8 + 1]); w.y = pk2(acc[d8 * 8 + 2] * rstd * gn[d8 * 8 + 2], acc[d8 * 8 + 3] * rstd * gn[d8 * 8 + 3]);
            w.z = pk2(acc[d8 * 8 + 4] * rstd * gn[d8 * 8 + 4], acc[d8 * 8 + 5] * rstd * gn[d8 * 8 + 5]); w.w = pk2(acc[d8 * 8 + 6] * rstd * gn[d8 * 8 + 6], acc[d8 * 8 + 7] * rstd * gn[d8 * 8 + 7]);
            *(u32x4*)(op + d8 * 8) = w; }
    }
}

__device__ __forceinline__ void sb_waveunit(Frame& F, int l, int wu) {
    const bf16_t* P = (const bf16_t*)(F.ws + WS_PROJ); bf16_t* MIX = (bf16_t*)(F.ws + WS_MIX);
    const int tb = wu & 63, h = (wu >> 6) & 3, b = wu >> 8;
    const int t0 = tb * 64, t = t0 + F.lane;
    float q[64], o[64];
    { const u32x4* qp = (const u32x4*)(P + (size_t)(b * SEQ + t) * NPROJ + PC_Q + h * 64);
#pragma unroll
      for (int d8 = 0; d8 < 8; ++d8) { const u32x4 w = qp[d8];
          q[d8 * 8] = bflo(w.x) * 0.125f; q[d8 * 8 + 1] = bfhi(w.x) * 0.125f; q[d8 * 8 + 2] = bflo(w.y) * 0.125f; q[d8 * 8 + 3] = bfhi(w.y) * 0.125f;
          q[d8 * 8 + 4] = bflo(w.z) * 0.125f; q[d8 * 8 + 5] = bfhi(w.z) * 0.125f; q[d8 * 8 + 6] = bflo(w.w) * 0.125f; q[d8 * 8 + 7] = bfhi(w.w) * 0.125f; } }
#pragma unroll
    for (int d = 0; d < 64; ++d) o[d] = 0.f;
    float R = 0.f;
    for (int s = t0 + 62; s >= 0; --s) {
        if (s < t0) { if (__all(R < -80.f)) break; }
        const size_t rowoff = (size_t)__builtin_amdgcn_readfirstlane(b * SEQ + s) * NPROJ;
        const u32x4* kp = (const u32x4*)(P + rowoff + PC_K + h * 64); const u32x4* vp = (const u32x4*)(P + rowoff + PC_V + h * 64);
        float z = 0.f;
#pragma unroll
        for (int d8 = 0; d8 < 8; ++d8) { const u32x4 w = kp[d8];
            z += (q[d8 * 8] * bflo(w.x) + q[d8 * 8 + 1] * bfhi(w.x)) + (q[d8 * 8 + 2] * bflo(w.y) + q[d8 * 8 + 3] * bfhi(w.y))
               + (q[d8 * 8 + 4] * bflo(w.z) + q[d8 * 8 + 5] * bfhi(w.z)) + (q[d8 * 8 + 6] * bflo(w.w) + q[d8 * 8 + 7] * bfhi(w.w)); }
        const bool valid = s < t;
        const float sp = softplus_f(z);
        const float p = valid ? __expf((z - sp) + R) : 0.f;
        R += valid ? -sp : 0.f;
#pragma unroll
        for (int d8 = 0; d8 < 8; ++d8) { const u32x4 w = vp[d8];
            o[d8 * 8] += p * bflo(w.x); o[d8 * 8 + 1] += p * bfhi(w.x); o[d8 * 8 + 2] += p * bflo(w.y); o[d8 * 8 + 3] += p * bfhi(w.y);
            o[d8 * 8 + 4] += p * bflo(w.z); o[d8 * 8 + 5] += p * bfhi(w.z); o[d8 * 8 + 6] += p * bflo(w.w); o[d8 * 8 + 7] += p * bfhi(w.w); }
    }
    float ss = 0.f;
#pragma unroll
    for (int d = 0; d < 64; ++d) ss += o[d] * o[d];
    const float rstd = rsqrtf(ss * (1.f / 64.f) + NORM_EPS); const float* gn = INF(F, I_SB_ON) + l * 256 + h * 64;
    bf16_t* op = MIX + (size_t)(b * SEQ + t) * DM + 512 + h * 64;
#pragma unroll
    for (int d8 = 0; d8 < 8; ++d8) { u32x4 w;
        w.x = pk2(o[d8 * 8] * rstd * gn[d8 * 8], o[d8 * 8 + 1] * rstd * gn[d8 * 8 + 1]); w.y = pk2(o[d8 * 8 + 2] * rstd * gn[d8 * 8 + 2], o[d8 * 8 + 3] * rstd * gn[d8 * 8 + 3]);
        w.z = pk2(o[d8 * 8 + 4] * rstd * gn[d8 * 8 + 4], o[d8 * 8 + 5] * rstd * gn[d8 * 8 + 5]); w.w = pk2(o[d8 * 8 + 6] * rstd * gn[d8 * 8 + 6], o[d8 * 8 + 7] * rstd * gn[d8 * 8 + 7]);
        *(u32x4*)(op + d8 * 8) = w; }
}

__device__ __forceinline__ void gla_decay_cumsum(Frame& F, int l, int b, int h, int n, LAS float* Bc) {
    const bf16_t* P = (const bf16_t*)(F.ws + WS_PROJ);
    const float* wa2 = INF(F, I_GLA_WA2) + l * 16 * 128; const float* ba = INF(F, I_GLA_BA) + l * 128;
    const int tok0 = b * SEQ + n * 64;
#pragma unroll
    for (int it = 0; it < 4; ++it) { const int idx = it * 512 + F.tid, t = idx >> 5, e = idx & 31;
        const bf16_t* lr = P + (size_t)(tok0 + t) * NPROJ + PB_LR; float a = ba[h * 32 + e];
#pragma unroll
        for (int r = 0; r < 16; ++r) a += bf2f(lr[r]) * wa2[r * 128 + h * 32 + e];
        Bc[idx] = logsigmoid_f(a) * (1.f / 16.f); }
    __syncthreads();
    if (F.tid < 32) { float c = 0.f; for (int t = 0; t < 64; ++t) { c += Bc[t * 32 + F.tid]; Bc[t * 32 + F.tid] = c; } }
    __syncthreads();
}
__device__ __forceinline__ void gla_kv_unit(Frame& F, int l, int unit) {
    const bf16_t* P = (const bf16_t*)(F.ws + WS_PROJ);
    float* KV = (float*)(F.ws + WS_GLA_KV) + (size_t)unit * 2048; float* DEC = (float*)(F.ws + WS_GLA_DEC) + unit * 32;
    const int n = unit & 63, h = (unit >> 6) & 3, b = unit >> 8, tok0 = b * SEQ + n * 64;
    LAS float* Bc = (LAS float*)F.lds; LAS float* Ke = (LAS float*)(F.lds + 8192); LAS float* Vs = (LAS float*)(F.lds + 16384);
    __syncthreads();
    gla_decay_cumsum(F, l, b, h, n, Bc);
#pragma unroll
    for (int it = 0; it < 4; ++it) { const int idx = it * 512 + F.tid, s = idx >> 5, e = idx & 31;
        Ke[idx] = bf2f(P[(size_t)(tok0 + s) * NPROJ + PB_K + h * 32 + e]) * __expf(Bc[63 * 32 + e] - Bc[idx]); }
#pragma unroll
    for (int it = 0; it < 8; ++it) { const int idx = it * 512 + F.tid, s = idx >> 6, f = idx & 63; Vs[idx] = bf2f(P[(size_t)(tok0 + s) * NPROJ + PB_V + h * 64 + f]); }
    __syncthreads();
    { const int e = F.tid >> 4, f0 = (F.tid & 15) * 4; f32x4 a = {0.f, 0.f, 0.f, 0.f};
      for (int s = 0; s < 64; ++s) { const float ke = Ke[s * 32 + e]; const f32x4 vv = *(const LAS f32x4*)(Vs + s * 64 + f0); a += ke * vv; }
      *(f32x4*)(KV + e * 64 + f0) = a; }
    if (F.tid < 32) DEC[F.tid] = __expf(Bc[63 * 32 + F.tid]);
}
__device__ __forceinline__ void gla_scan(Frame& F, int gtid) {
    const int f = gtid & 63, e = (gtid >> 6) & 31, bh = gtid >> 11;
    float* KV = (float*)(F.ws + WS_GLA_KV) + (size_t)bh * 64 * 2048 + e * 64 + f; const float* DEC = (const float*)(F.ws + WS_GLA_DEC) + bh * 64 * 32 + e;
    float st = 0.f;
#pragma unroll 8
    for (int n = 0; n < 64; ++n) { const float kv = KV[(size_t)n * 2048], d = DEC[n * 32]; KV[(size_t)n * 2048] = st; st = d * st + kv; }
}
__device__ __forceinline__ void gla_out_unit(Frame& F, int l, int unit) {
    const bf16_t* P = (const bf16_t*)(F.ws + WS_PROJ); bf16_t* MIX = (bf16_t*)(F.ws + WS_MIX);
    const float* SP = (const float*)(F.ws + WS_GLA_KV) + (size_t)unit * 2048;
    const int n = unit & 63, h = (unit >> 6) & 3, b = unit >> 8, tok0 = b * SEQ + n * 64;
    LAS float* Bc = (LAS float*)F.lds; LAS float* Qe = (LAS float*)(F.lds + 8192); LAS float* Ke = (LAS float*)(F.lds + 16384); LAS float* Qb = (LAS float*)(F.lds + 25088);
    LAS float* Vs = (LAS float*)(F.lds + 33792); LAS float* Ss = (LAS float*)(F.lds + 50176); LAS float* At = (LAS float*)(F.lds + 58368);
    __syncthreads();
    gla_decay_cumsum(F, l, b, h, n, Bc);
    const float qs = 0.17677669529663687f;
#pragma unroll
    for (int it = 0; it < 4; ++it) { const int idx = it * 512 + F.tid, t = idx >> 5, e = idx & 31;
        const float bt = Bc[idx], br = Bc[31 * 32 + e];
        const float qv = bf2f(P[(size_t)(tok0 + t) * NPROJ + PB_Q + h * 32 + e]) * qs, kv = bf2f(P[(size_t)(tok0 + t) * NPROJ + PB_K + h * 32 + e]);
        Qe[idx] = qv * __expf(bt - br); Ke[t * 33 + e] = kv * __expf(br - bt); Qb[idx] = qv * __expf(bt); }
#pragma unroll
    for (int it = 0; it < 8; ++it) { const int idx = it * 512 + F.tid, s = idx >> 6, f = idx & 63; Vs[idx] = bf2f(P[(size_t)(tok0 + s) * NPROJ + PB_V + h * 64 + f]); }
#pragma unroll
    for (int it = 0; it < 4; ++it) { const int idx = it * 512 + F.tid; Ss[idx] = SP[idx]; }
    __syncthreads();
#pragma unroll
    for (int it = 0; it < 8; ++it) { const int idx = it * 512 + F.tid, t = idx >> 6, s = idx & 63; float a = 0.f;
        if (s <= t) {
#pragma unroll
            for (int e = 0; e < 32; ++e) a += Qe[t * 32 + e] * Ke[s * 33 + e]; }
        At[t * 65 + s] = a; }
    __syncthreads();
    { const int t = F.tid >> 3, f0 = (F.tid & 7) * 8; float o[8];
#pragma unroll
      for (int j = 0; j < 8; ++j) o[j] = 0.f;
      for (int s = 0; s <= t; ++s) { const float a = At[t * 65 + s]; const f32x4 v0 = *(const LAS f32x4*)(Vs + s * 64 + f0), v1 = *(const LAS f32x4*)(Vs + s * 64 + f0 + 4);
          o[0] += a * v0[0]; o[1] += a * v0[1]; o[2] += a * v0[2]; o[3] += a * v0[3]; o[4] += a * v1[0]; o[5] += a * v1[1]; o[6] += a * v1[2]; o[7] += a * v1[3]; }
#pragma unroll
      for (int e = 0; e < 32; ++e) { const float a = Qb[t * 32 + e]; const f32x4 v0 = *(const LAS f32x4*)(Ss + e * 64 + f0), v1 = *(const LAS f32x4*)(Ss + e * 64 + f0 + 4);
          o[0] += a * v0[0]; o[1] += a * v0[1]; o[2] += a * v0[2]; o[3] += a * v0[3]; o[4] += a * v1[0]; o[5] += a * v1[1]; o[6] += a * v1[2]; o[7] += a * v1[3]; }
      float ss = 0.f;
#pragma unroll
      for (int j = 0; j < 8; ++j) ss += o[j] * o[j];
      ss += __shfl_xor(ss, 1); ss += __shfl_xor(ss, 2); ss += __shfl_xor(ss, 4);
      const float rstd = rsqrtf(ss * (1.f / 64.f) + NORM_EPS); const float* gn = INF(F, I_GLA_ON) + l * 256 + h * 64 + f0;
      const u32x4 gw = *(const u32x4*)(P + (size_t)(tok0 + t) * NPROJ + PB_G + h * 64 + f0);
      float gb[8] = {bflo(gw.x), bfhi(gw.x), bflo(gw.y), bfhi(gw.y), bflo(gw.z), bfhi(gw.z), bflo(gw.w), bfhi(gw.w)};
      float r[8];
#pragma unroll
      for (int j = 0; j < 8; ++j) r[j] = o[j] * rstd * gn[j] * (gb[j] * sigmoid_f(gb[j]));
      u32x4 w; w.x = pk2(r[0], r[1]); w.y = pk2(r[2], r[3]); w.z = pk2(r[4], r[5]); w.w = pk2(r[6], r[7]);
      *(u32x4*)(MIX + (size_t)(tok0 + t) * DM + 256 + h * 64 + f0) = w; }
}

template <int CTRL> __device__ __forceinline__ float dpp_add(float v) { return v + __builtin_bit_cast(float, __builtin_amdgcn_update_dpp(0, __builtin_bit_cast(int, v), CTRL, 0xf, 0xf, false)); }
__device__ __forceinline__ float sum16(float v) { v = dpp_add<0xB1>(v); v = dpp_add<0x4E>(v); v = dpp_add<0x141>(v); v = dpp_add<0x140>(v); return v; }
typedef float f32x16 __attribute__((ext_vector_type(16)));
__device__ __forceinline__ float other_half(float x, int hh) {
    auto t = __builtin_amdgcn_permlane32_swap(__float_as_uint(x), __float_as_uint(x), false, false);
    return __uint_as_float(hh ? t[0] : t[1]);
}
__device__ __forceinline__ unsigned cvt_pk(float lo, float hi) { unsigned r; asm volatile("v_cvt_pk_bf16_f32 %0, %1, %2" : "=v"(r) : "v"(lo), "v"(hi)); return r; }
__device__ __forceinline__ bf16x8 pack8(float p0, float p1, float p2, float p3, float p4, float p5, float p6, float p7) {
    u32x4 w; w.x = cvt_pk(p0, p1); w.y = cvt_pk(p2, p3); w.z = cvt_pk(p4, p5); w.w = cvt_pk(p6, p7); return __builtin_bit_cast(bf16x8, w);
}
#define PACK8(a, o) pack8(a[(o)], a[(o) + 1], a[(o) + 2], a[(o) + 3], a[(o) + 4], a[(o) + 5], a[(o) + 6], a[(o) + 7])
__device__ __forceinline__ bf16x8 load_vt(const bf16_t* P, size_t vrow0, int vcol, int db, int ko, int r, int hh) {
    const bf16_t* p = P + (vrow0 + 32 * db + r) * NPROJ + vcol + ko + 4 * hh;
    const u32x2 a = *(const u32x2*)p, b = *(const u32x2*)(p + 8);
    u32x4 w; w.x = a.x; w.y = a.y; w.z = b.x; w.w = b.y; return __builtin_bit_cast(bf16x8, w);
}
__device__ __forceinline__ void store_ot(bf16_t* orow, const f32x16& o0, const f32x16& o1, float rs, const float* gn, int hh) {
#pragma unroll
    for (int db = 0; db < 2; ++db)
#pragma unroll
        for (int g4 = 0; g4 < 4; ++g4) { const int d = 32 * db + 8 * g4 + 4 * hh; const f32x4 gv = *(const f32x4*)(gn + d);
            const f32x16& o = db ? o1 : o0;
            u32x2 w; w.x = cvt_pk(o[4 * g4] * rs * gv[0], o[4 * g4 + 1] * rs * gv[1]); w.y = cvt_pk(o[4 * g4 + 2] * rs * gv[2], o[4 * g4 + 3] * rs * gv[3]);
            *(u32x2*)(orow + d) = w; }
}

__device__ __forceinline__ void attn_prep_block(Frame& F, int blk) {
    bf16_t* P = (bf16_t*)(F.ws + WS_PROJ);
    const float* RC = (const float*)(F.ws + WS_ROPE_C); const float* RS = (const float*)(F.ws + WS_ROPE_S);
    LAS unsigned* T = (LAS unsigned*)F.lds;
    const int tok0 = blk * 64;
    for (int it = 0; it < 24; ++it) { const int idx = it * 512 + F.tid, d = idx & 31, hd = (idx >> 5) % 6, tt = idx / 192; const int tok = tok0 + tt;
        bf16_t* p = P + (size_t)tok * NPROJ + (hd < 4 ? PA_Q + hd * 64 : PA_K + (hd - 4) * 64); const float sc = hd < 4 ? 0.18033688011112042f : 1.f;
        const float x1 = bf2f(p[d]), x2 = bf2f(p[d + 32]), c = RC[tok * 32 + d], s = RS[tok * 32 + d];
        p[d] = f2bf((x1 * c - x2 * s) * sc); p[d + 32] = f2bf((x2 * c + x1 * s) * sc); }
    for (int vt = 0; vt < 6; ++vt) {
        const int vcol = vt < 2 ? PA_V + vt * 64 : PC_V + (vt - 2) * 64;
        __syncthreads();
        { const int tt = F.tid >> 3, c8 = F.tid & 7; const u32x4 w = *(const u32x4*)(P + (size_t)(tok0 + tt) * NPROJ + vcol + c8 * 8);
          T[tt * 33 + c8 * 4] = w.x; T[tt * 33 + c8 * 4 + 1] = w.y; T[tt * 33 + c8 * 4 + 2] = w.z; T[tt * 33 + c8 * 4 + 3] = w.w; }
        __syncthreads();
        { const int d = F.tid >> 3, t8 = F.tid & 7; unsigned e[8];
#pragma unroll
          for (int i = 0; i < 8; ++i) { const unsigned w = T[(t8 * 8 + i) * 33 + (d >> 1)]; e[i] = (d & 1) ? (w >> 16) : (w & 0xffffu); }
          u32x4 o; o.x = e[0] | (e[1] << 16); o.y = e[2] | (e[3] << 16); o.z = e[4] | (e[5] << 16); o.w = e[6] | (e[7] << 16);
          *(u32x4*)(P + (size_t)(tok0 + d) * NPROJ + vcol + t8 * 8) = o; }
    }
}

__device__ __forceinline__ void sb_task(Frame& F, int l, int task) {
    const bf16_t* P = (const bf16_t*)(F.ws + WS_PROJ); bf16_t* MIX = (bf16_t*)(F.ws + WS_MIX);
    const int qb = task & 127, h = (task >> 7) & 3, b = task >> 9;
    const int q0 = qb * 32, r = F.lane & 31, hh = F.lane >> 5, t = q0 + r;
    const size_t rowb = (size_t)b * SEQ;
    bf16x8 qf[4];
    { const bf16_t* qp = P + (rowb + t) * NPROJ + PC_Q + h * 64 + 8 * hh;
#pragma unroll
      for (int s = 0; s < 4; ++s) qf[s] = *(const bf16x8*)(qp + 16 * s); }
    f32x16 o0, o1;
#pragma unroll
    for (int i = 0; i < 16; ++i) { o0[i] = 0.f; o1[i] = 0.f; }
    float R = 0.f;
    bf16x8 kf[2][4];
#define SB_LOADK(kt_) do { _Pragma("unroll") for (int kb = 0; kb < 2; ++kb) { const bf16_t* kp = P + (rowb + 64 * (kt_) + 32 * kb + r) * NPROJ + PC_K + h * 64 + 8 * hh; \
        _Pragma("unroll") for (int s = 0; s < 4; ++s) kf[kb][s] = *(const bf16x8*)(kp + 16 * s); } } while (0)
    SB_LOADK((q0 + 30) >> 6);
    for (int kt = (q0 + 30) >> 6; kt >= 0; --kt) {
        const size_t krow0 = rowb + 64 * kt;
        bf16x8 vf[2][2][2];
#pragma unroll
        for (int kb = 0; kb < 2; ++kb)
#pragma unroll
            for (int s = 0; s < 2; ++s) { vf[0][kb][s] = load_vt(P, krow0, PC_V + h * 64, 0, 32 * kb + 16 * s, r, hh); vf[1][kb][s] = load_vt(P, krow0, PC_V + h * 64, 1, 32 * kb + 16 * s, r, hh); }
        __builtin_amdgcn_sched_barrier(0);
        f32x16 st[2];
#pragma unroll
        for (int kb = 0; kb < 2; ++kb) { f32x16 a;
#pragma unroll
            for (int i = 0; i < 16; ++i) a[i] = 0.f;
#pragma unroll
            for (int s = 0; s < 4; ++s) a = __builtin_amdgcn_mfma_f32_32x32x16_bf16(kf[kb][s], qf[s], a, 0, 0, 0);
            st[kb] = a; }
        bf16x8 kn[2][4];
        { const int ktn = kt > 0 ? kt - 1 : 0;
#pragma unroll
          for (int kb = 0; kb < 2; ++kb) { const bf16_t* kp = P + (rowb + 64 * ktn + 32 * kb + r) * NPROJ + PC_K + h * 64 + 8 * hh;
#pragma unroll
              for (int s = 0; s < 4; ++s) kn[kb][s] = *(const bf16x8*)(kp + 16 * s); } }
        float Rb = R;
#pragma unroll
        for (int kb = 1; kb >= 0; --kb) {
            float lv[16], zz[16], p[16];
#pragma unroll
            for (int i = 0; i < 16; ++i) { const int key = 64 * kt + 32 * kb + (i & 3) + 8 * (i >> 2) + 4 * hh; const float z = st[kb][i] * 0.18033688011112042f; const bool valid = key < t;
                const float sp = fmaxf(z, 0.f) + __builtin_amdgcn_logf(1.f + __builtin_amdgcn_exp2f(-fabsf(z))); lv[i] = valid ? -sp : 0.f; zz[i] = valid ? (z - sp) : -INFINITY; }
            float gown[4], suf[16];
#pragma unroll
            for (int g = 0; g < 4; ++g) { const float s3 = lv[4 * g + 3], s2 = s3 + lv[4 * g + 2], s1 = s2 + lv[4 * g + 1]; gown[g] = s1 + lv[4 * g];
                suf[4 * g + 3] = 0.f; suf[4 * g + 2] = s3; suf[4 * g + 1] = s2; suf[4 * g] = s1; }
            float run = 0.f, above[4];
#pragma unroll
            for (int g = 3; g >= 0; --g) { const float go = other_half(gown[g], hh); above[g] = run + (hh == 0 ? go : 0.f); run += gown[g] + go; }
#pragma unroll
            for (int i = 0; i < 16; ++i) p[i] = __builtin_amdgcn_exp2f(zz[i] + (Rb + above[i >> 2] + suf[i]));
            Rb += run;
#pragma unroll
            for (int s = 0; s < 2; ++s) { const bf16x8 pf = PACK8(p, 8 * s);
                o0 = __builtin_amdgcn_mfma_f32_32x32x16_bf16(vf[0][kb][s], pf, o0, 0, 0, 0);
                o1 = __builtin_amdgcn_mfma_f32_32x32x16_bf16(vf[1][kb][s], pf, o1, 0, 0, 0); }
        }
        R = Rb;
#pragma unroll
        for (int kb = 0; kb < 2; ++kb)
#pragma unroll
            for (int s = 0; s < 4; ++s) kf[kb][s] = kn[kb][s];
        if (__all(R < -115.5f)) break;
    }
#undef SB_LOADK
    float ss = 0.f;
#pragma unroll
    for (int i = 0; i < 16; ++i) ss += o0[i] * o0[i] + o1[i] * o1[i];
    ss += other_half(ss, hh);
    const float rstd = rsqrtf(ss * (1.f / 64.f) + NORM_EPS);
    store_ot(MIX + (rowb + t) * DM + 512 + h * 64, o0, o1, rstd, INF(F, I_SB_ON) + l * 256 + h * 64, hh);
}

__device__ __forceinline__ void swa_task(Frame& F, int l, int task) {
    const bf16_t* P = (const bf16_t*)(F.ws + WS_PROJ); bf16_t* MIX = (bf16_t*)(F.ws + WS_MIX);
    const int qb = task & 127, hq = (task >> 7) & 3, b = task >> 9, kvh = hq >> 1;
    const int q0 = qb * 32, r = F.lane & 31, hh = F.lane >> 5, t = q0 + r;
    const size_t rowb = (size_t)b * SEQ;
    bf16x8 qf[4];
    { const bf16_t* qp = P + (rowb + t) * NPROJ + PA_Q + hq * 64 + 8 * hh;
#pragma unroll
      for (int s = 0; s < 4; ++s) qf[s] = *(const bf16x8*)(qp + 16 * s); }
    f32x16 o0, o1;
#pragma unroll
    for (int i = 0; i < 16; ++i) { o0[i] = 0.f; o1[i] = 0.f; }
    float m = INF(F, I_SINKS)[l * 4 + hq], lsum = 1.f;
    const int ktlo = (q0 >= 127) ? ((q0 - 127) >> 6) : 0;
    for (int kt = (q0 + 31) >> 6; kt >= ktlo; --kt) {
        const size_t krow0 = rowb + 64 * kt;
        float sv[32];
        float tmax = -INFINITY;
#pragma unroll
        for (int kb = 0; kb < 2; ++kb) { const bf16_t* kp = P + (krow0 + 32 * kb + r) * NPROJ + PA_K + kvh * 64 + 8 * hh;
            f32x16 a;
#pragma unroll
            for (int i = 0; i < 16; ++i) a[i] = 0.f;
#pragma unroll
            for (int s = 0; s < 4; ++s) a = __builtin_amdgcn_mfma_f32_32x32x16_bf16(*(const bf16x8*)(kp + 16 * s), qf[s], a, 0, 0, 0);
#pragma unroll
            for (int i = 0; i < 16; ++i) { const int key = 64 * kt + 32 * kb + (i & 3) + 8 * (i >> 2) + 4 * hh; const bool valid = (key <= t) && (key + 127 >= t);
                sv[kb * 16 + i] = valid ? a[i] : -INFINITY; tmax = fmaxf(tmax, sv[kb * 16 + i]); } }
        tmax = fmaxf(tmax, other_half(tmax, hh));
        const float mn = fmaxf(m, tmax), sc = __expf(m - mn);
        float psum = 0.f;
#pragma unroll
        for (int i = 0; i < 32; ++i) { sv[i] = __expf(sv[i] - mn); psum += sv[i]; }
        psum += other_half(psum, hh);
        lsum = lsum * sc + psum; m = mn;
#pragma unroll
        for (int i = 0; i < 16; ++i) { o0[i] *= sc; o1[i] *= sc; }
#pragma unroll
        for (int kb = 0; kb < 2; ++kb)
#pragma unroll
            for (int s = 0; s < 2; ++s) { const bf16x8 pf = PACK8(sv, kb * 16 + 8 * s);
                o0 = __builtin_amdgcn_mfma_f32_32x32x16_bf16(load_vt(P, krow0, PA_V + kvh * 64, 0, 32 * kb + 16 * s, r, hh), pf, o0, 0, 0, 0);
                o1 = __builtin_amdgcn_mfma_f32_32x32x16_bf16(load_vt(P, krow0, PA_V + kvh * 64, 1, 32 * kb + 16 * s, r, hh), pf, o1, 0, 0, 0); }
    }
    const float inv = 1.f / lsum;
    float ss = 0.f;
#pragma unroll
    for (int i = 0; i < 16; ++i) { o0[i] *= inv; o1[i] *= inv; ss += o0[i] * o0[i] + o1[i] * o1[i]; }
    ss += other_half(ss, hh);
    const float rstd = rsqrtf(ss * (1.f / 64.f) + NORM_EPS);
    store_ot(MIX + (rowb + t) * DM + hq * 64, o0, o1, rstd, INF(F, I_SWA_ON) + l * 256 + hq * 64, hh);
}

__device__ __forceinline__ unsigned short hw(const u32x4& w, int j) { const unsigned d = (j >> 1) == 0 ? w.x : ((j >> 1) == 1 ? w.y : ((j >> 1) == 2 ? w.z : w.w)); return (unsigned short)((j & 1) ? (d >> 16) : (d & 0xffffu)); }
template <int V> struct IC { static constexpr int value = V; };
template <bool SWA>
__device__ __forceinline__ void attn_block(Frame& F, int l, int bt) {
    const bf16_t* P = (const bf16_t*)(F.ws + WS_PROJ); bf16_t* MIX = (bf16_t*)(F.ws + WS_MIX);
    const int qblk = bt & 15, h = (bt >> 4) & 3, b = bt >> 6;
    const int q0b = qblk * 256, q0 = q0b + 32 * F.wave, r = F.lane & 31, hh = F.lane >> 5, t = q0 + r;
    const size_t rowb = (size_t)b * SEQ;
    const int qcol = SWA ? PA_Q + h * 64 : PC_Q + h * 64, kcol = SWA ? PA_K + (h >> 1) * 64 : PC_K + h * 64, vcol = SWA ? PA_V + (h >> 1) * 64 : PC_V + h * 64;
    LAS bf16_t* Ks = (LAS bf16_t*)F.lds; LAS bf16_t* Vs = (LAS bf16_t*)(F.lds + 2 * 9216);
    const float* RC = (const float*)(F.ws + WS_ROPE_C); const float* RS = (const float*)(F.ws + WS_ROPE_S);
    bf16x8 qf[4];
    { const bf16_t* qp = P + (rowb + t) * NPROJ + qcol + 8 * hh; u32x4 qw[4];
#pragma unroll
      for (int s = 0; s < 4; ++s) qw[s] = *(const u32x4*)(qp + 16 * s);
      if (SWA) {
#pragma unroll
          for (int s = 0; s < 2; ++s) { const float* cp = RC + (rowb + t) * 32 + 16 * s + 8 * hh; const float* sp = RS + (rowb + t) * 32 + 16 * s + 8 * hh;
              const f32x4 c0 = *(const f32x4*)cp, c1 = *(const f32x4*)(cp + 4), s0 = *(const f32x4*)sp, s1 = *(const f32x4*)(sp + 4);
              const unsigned a[4] = {qw[s].x, qw[s].y, qw[s].z, qw[s].w}, bq[4] = {qw[s + 2].x, qw[s + 2].y, qw[s + 2].z, qw[s + 2].w}; float o1[8], o2[8];
#pragma unroll
              for (int j = 0; j < 8; ++j) { const float x1 = (j & 1) ? bfhi(a[j >> 1]) : bflo(a[j >> 1]), x2 = (j & 1) ? bfhi(bq[j >> 1]) : bflo(bq[j >> 1]), cc = j < 4 ? c0[j & 3] : c1[j & 3], sn = j < 4 ? s0[j & 3] : s1[j & 3];
                  o1[j] = (x1 * cc - x2 * sn) * 0.18033688011112042f; o2[j] = (x2 * cc + x1 * sn) * 0.18033688011112042f; }
              qw[s] = (u32x4){cvt_pk(o1[0], o1[1]), cvt_pk(o1[2], o1[3]), cvt_pk(o1[4], o1[5]), cvt_pk(o1[6], o1[7])}; qw[s + 2] = (u32x4){cvt_pk(o2[0], o2[1]), cvt_pk(o2[2], o2[3]), cvt_pk(o2[4], o2[5]), cvt_pk(o2[6], o2[7])}; } }
#pragma unroll
      for (int s = 0; s < 4; ++s) qf[s] = __builtin_bit_cast(bf16x8, qw[s]); }
    f32x16 o0, o1;
#pragma unroll
    for (int i = 0; i < 16; ++i) { o0[i] = 0.f; o1[i] = 0.f; }
    float R = 0.f;
    float m = SWA ? INF(F, I_SINKS)[l * 4 + h] * 1.4426950408889634f : 0.f, lsum = 1.f;
    const int kt_top = SWA ? (q0b + 255) >> 6 : (q0b + 254) >> 6;
    const int kt_lo = SWA ? ((q0b >= 127) ? ((q0b - 127) >> 6) : 0) : 0;
    const int ktw = SWA ? (q0 + 31) >> 6 : (q0 + 30) >> 6;
    const int ktl = SWA ? ((q0 >= 127) ? ((q0 - 127) >> 6) : 0) : 0;
    bool fin = false;
    const bool kside = F.wave < 4; const int srow = (F.tid & 255) >> 2, q4 = F.tid & 3;
    u32x4 pa_[2], pb_[2]; f32x4 rc0_[2], rc1_[2], rs0_[2], rs1_[2];
#pragma unroll
    for (int i_ = 0; i_ < 2; ++i_) { rc0_[i_] = (f32x4){0.f, 0.f, 0.f, 0.f}; rc1_[i_] = rc0_[i_]; rs0_[i_] = rc0_[i_]; rs1_[i_] = rc0_[i_]; }
#define AT_FETCH(kt_, S_) do { const size_t tk_ = rowb + 64 * (kt_) + srow; \
        if (kside) { const bf16_t* p_ = P + tk_ * NPROJ + kcol + 8 * q4; pa_[S_] = *(const u32x4*)p_; pb_[S_] = *(const u32x4*)(p_ + 32); \
            if (SWA) { const float* c_ = RC + tk_ * 32 + 8 * q4; const float* s_ = RS + tk_ * 32 + 8 * q4; rc0_[S_] = *(const f32x4*)c_; rc1_[S_] = *(const f32x4*)(c_ + 4); rs0_[S_] = *(const f32x4*)s_; rs1_[S_] = *(const f32x4*)(s_ + 4); } } \
        else { const bf16_t* p_ = P + tk_ * NPROJ + vcol + 16 * q4; pa_[S_] = *(const u32x4*)p_; pb_[S_] = *(const u32x4*)(p_ + 8); } } while (0)
#define AT_STORE(bufi, S_) do { if (kside) { LAS bf16_t* d_ = Ks + (bufi) * 4608 + srow * 72 + 8 * q4; \
            if (SWA) { const unsigned a_[4] = {pa_[S_].x, pa_[S_].y, pa_[S_].z, pa_[S_].w}, b_[4] = {pb_[S_].x, pb_[S_].y, pb_[S_].z, pb_[S_].w}; float o1_[8], o2_[8]; \
                _Pragma("unroll") for (int j = 0; j < 8; ++j) { const float x1 = (j & 1) ? bfhi(a_[j >> 1]) : bflo(a_[j >> 1]), x2 = (j & 1) ? bfhi(b_[j >> 1]) : bflo(b_[j >> 1]), cc = j < 4 ? rc0_[S_][j & 3] : rc1_[S_][j & 3], sn = j < 4 ? rs0_[S_][j & 3] : rs1_[S_][j & 3]; \
                    o1_[j] = x1 * cc - x2 * sn; o2_[j] = x2 * cc + x1 * sn; } \
                pa_[S_] = (u32x4){cvt_pk(o1_[0], o1_[1]), cvt_pk(o1_[2], o1_[3]), cvt_pk(o1_[4], o1_[5]), cvt_pk(o1_[6], o1_[7])}; pb_[S_] = (u32x4){cvt_pk(o2_[0], o2_[1]), cvt_pk(o2_[2], o2_[3]), cvt_pk(o2_[4], o2_[5]), cvt_pk(o2_[6], o2_[7])}; } \
            *(LAS u32x4*)d_ = pa_[S_]; *(LAS u32x4*)(d_ + 32) = pb_[S_]; } \
        else { LAS bf16_t* d_ = Vs + (bufi) * 4608 + (16 * q4) * 72 + srow; \
            _Pragma("unroll") for (int j = 0; j < 8; ++j) { d_[j * 72] = hw(pa_[S_], j); d_[(8 + j) * 72] = hw(pb_[S_], j); } } } while (0)
    volatile LAS int* vote = (volatile LAS int*)(F.lds + MISC_OFF + 16);
    __syncthreads();
    if (F.tid < 3) vote[F.tid] = 0;
    AT_FETCH(kt_top, 0); AT_STORE(0, 0);
    if (kt_top > kt_lo) AT_FETCH(kt_top - 1, 1);
    __syncthreads();
    int buf = 0, slot = 0;
    auto trip = [&](const int kt, auto fs_tag) -> bool {
        constexpr int FS_ = decltype(fs_tag)::value;
        const bool mine = !fin && kt <= ktw && kt >= ktl;
        if (mine && F.lane == 0) vote[slot] = 1;
        __syncthreads();
        const int any = vote[slot];
        if (F.tid == 0) vote[slot == 0 ? 2 : slot - 1] = 0;
        slot = slot == 2 ? 0 : slot + 1;
        if (any == 0 && kt < ((SWA ? (q0b + 31) : (q0b + 30)) >> 6)) return false;
        if (kt - 2 >= kt_lo) AT_FETCH(kt - 2, FS_);
        if (mine) {
            const LAS bf16_t* Kb = Ks + buf * 4608; const LAS bf16_t* Vb = Vs + buf * 4608;
            f32x16 st[2];
#pragma unroll
            for (int kb = 0; kb < 2; ++kb) { f32x16 a;
#pragma unroll
                for (int i = 0; i < 16; ++i) a[i] = 0.f;
#pragma unroll
                for (int s = 0; s < 4; ++s) a = __builtin_amdgcn_mfma_f32_32x32x16_bf16(*(const LAS bf16x8*)(Kb + (32 * kb + r) * 72 + 16 * s + 8 * hh), qf[s], a, 0, 0, 0);
                st[kb] = a; }
            if (!SWA) {
                float Rb = R;
#pragma unroll
                for (int kb = 1; kb >= 0; --kb) {
                    float e[16], u[16], p[16];
#pragma unroll
                    for (int i = 0; i < 16; ++i) { const int key = 64 * kt + 32 * kb + (i & 3) + 8 * (i >> 2) + 4 * hh; const float z = fminf(st[kb][i] * 0.18033688011112042f, 30.f); const bool valid = key < t;
                        const float ez = __builtin_amdgcn_exp2f(z); e[i] = valid ? ez : 0.f; u[i] = valid ? 1.f + ez : 1.f; }
                    float gown[4], iq[16];
#pragma unroll
                    for (int g = 0; g < 4; ++g) { const float q32 = u[4 * g + 3] * u[4 * g + 2], q10 = u[4 * g + 1] * u[4 * g]; gown[g] = q32 * q10;
                        const float r0 = __builtin_amdgcn_rcpf(gown[g]);
                        iq[4 * g] = r0; iq[4 * g + 1] = r0 * u[4 * g]; iq[4 * g + 2] = r0 * q10; iq[4 * g + 3] = r0 * q10 * u[4 * g + 2]; }
                    float run = 1.f, ia[4]; const float sc2 = __builtin_amdgcn_exp2f(Rb);
#pragma unroll
                    for (int g = 3; g >= 0; --g) { const float go = other_half(gown[g], hh); ia[g] = sc2 * __builtin_amdgcn_rcpf(run * (hh == 0 ? go : 1.f)); run *= gown[g] * go; }
#pragma unroll
                    for (int i = 0; i < 16; ++i) p[i] = e[i] * (iq[i] * ia[i >> 2]);
                    Rb -= __builtin_amdgcn_logf(run);
#pragma unroll
                    for (int s = 0; s < 2; ++s) { const bf16x8 pf = PACK8(p, 8 * s); const int ko = 32 * kb + 16 * s + 4 * hh;
                        const u32x2 a0 = *(const LAS u32x2*)(Vb + r * 72 + ko), a1 = *(const LAS u32x2*)(Vb + r * 72 + ko + 8), c0 = *(const LAS u32x2*)(Vb + (32 + r) * 72 + ko), c1 = *(const LAS u32x2*)(Vb + (32 + r) * 72 + ko + 8);
                        o0 = __builtin_amdgcn_mfma_f32_32x32x16_bf16(__builtin_bit_cast(bf16x8, (u32x4){a0.x, a0.y, a1.x, a1.y}), pf, o0, 0, 0, 0);
                        o1 = __builtin_amdgcn_mfma_f32_32x32x16_bf16(__builtin_bit_cast(bf16x8, (u32x4){c0.x, c0.y, c1.x, c1.y}), pf, o1, 0, 0, 0); }
                }
                R = Rb;
                fin = __all(R < -115.5f) != 0;
            } else {
                float sv[32]; float tmax = -INFINITY;
#pragma unroll
                for (int kb = 0; kb < 2; ++kb)
#pragma unroll
                    for (int i = 0; i < 16; ++i) { const int key = 64 * kt + 32 * kb + (i & 3) + 8 * (i >> 2) + 4 * hh; const bool valid = (key <= t) && (key + 127 >= t);
                        sv[kb * 16 + i] = valid ? st[kb][i] : -INFINITY; tmax = fmaxf(tmax, sv[kb * 16 + i]); }
                tmax = fmaxf(tmax, other_half(tmax, hh));
                const float mn = fmaxf(m, tmax), sc = __builtin_amdgcn_exp2f(m - mn);
                float psum = 0.f;
#pragma unroll
                for (int i = 0; i < 32; ++i) { sv[i] = __builtin_amdgcn_exp2f(sv[i] - mn); psum += sv[i]; }
                psum += other_half(psum, hh);
                lsum = lsum * sc + psum; m = mn;
#pragma unroll
                for (int i = 0; i < 16; ++i) { o0[i] *= sc; o1[i] *= sc; }
#pragma unroll
                for (int kb = 0; kb < 2; ++kb)
#pragma unroll
                    for (int s = 0; s < 2; ++s) { const bf16x8 pf = PACK8(sv, kb * 16 + 8 * s); const int ko = 32 * kb + 16 * s + 4 * hh;
                        const u32x2 a0 = *(const LAS u32x2*)(Vb + r * 72 + ko), a1 = *(const LAS u32x2*)(Vb + r * 72 + ko + 8), c0 = *(const LAS u32x2*)(Vb + (32 + r) * 72 + ko), c1 = *(const LAS u32x2*)(Vb + (32 + r) * 72 + ko + 8);
                        o0 = __builtin_amdgcn_mfma_f32_32x32x16_bf16(__builtin_bit_cast(bf16x8, (u32x4){a0.x, a0.y, a1.x, a1.y}), pf, o0, 0, 0, 0);
                        o1 = __builtin_amdgcn_mfma_f32_32x32x16_bf16(__builtin_bit_cast(bf16x8, (u32x4){c0.x, c0.y, c1.x, c1.y}), pf, o1, 0, 0, 0); }
            }
        }
        buf ^= 1;
        if (kt > kt_lo) AT_STORE(buf, 1 - FS_);
        return true;
    };
    for (int kt = kt_top; kt >= kt_lo; kt -= 2) {
        if (!trip(kt, IC<0>{})) break;
        if (kt - 1 < kt_lo) break;
        if (!trip(kt - 1, IC<1>{})) break;
    }
    if (SWA) { const float inv = 1.f / lsum;
#pragma unroll
        for (int i = 0; i < 16; ++i) { o0[i] *= inv; o1[i] *= inv; } }
    float ss = 0.f;
#pragma unroll
    for (int i = 0; i < 16; ++i) ss += o0[i] * o0[i] + o1[i] * o1[i];
    ss += other_half(ss, hh);
    const float rstd = rsqrtf(ss * (1.f / 64.f) + NORM_EPS);
    store_ot(MIX + (rowb + t) * DM + (SWA ? 0 : 512) + h * 64, o0, o1, rstd, INF(F, SWA ? I_SWA_ON : I_SB_ON) + l * 256 + h * 64, hh);
#undef AT_FETCH
#undef AT_STORE
}
__device__ __forceinline__ void rwkv_convert_small(Frame& F, int l) {
    bf16_t* W2T = (bf16_t*)(F.ws + WS_SMALLW); bf16_t* A2T = W2T + 256 * 64; bf16_t* G2T = A2T + 256 * 64;
    const float* w2 = INF(F, I_W2) + l * 64 * 256; const float* a2 = INF(F, I_A2) + l * 64 * 256; const float* g2 = INF(F, I_G2) + l * 128 * 256;
    for (int idx = F.bid * 512 + F.tid; idx < 256 * 64; idx += F.G * 512) { const int c = idx >> 6, i = idx & 63; W2T[idx] = f2bf(w2[i * 256 + c]); A2T[idx] = f2bf(a2[i * 256 + c]); }
    for (int idx = F.bid * 512 + F.tid; idx < 256 * 128; idx += F.G * 512) { const int c = idx >> 7, i = idx & 127; G2T[idx] = f2bf(g2[i * 256 + c]); }
}
__device__ __forceinline__ float tanh_f(float x) { return 1.f - 2.f * __builtin_amdgcn_rcpf(__expf(2.f * x) + 1.f); }
constexpr int LP = 72, LPG = 136;
template <int PITCH, int KS>
__device__ __forceinline__ void mm64p(f32x4 (&acc)[2], const LAS bf16_t* A, const LAS bf16_t* B, int mt, int nt0, int lane) {
    const int r16 = lane & 15, kq = lane >> 4;
#pragma unroll
    for (int s = 0; s < KS; ++s) {
        const bf16x8 a = *(const LAS bf16x8*)(A + (16 * mt + r16) * PITCH + 32 * s + 8 * kq);
#pragma unroll
        for (int j = 0; j < 2; ++j) { const bf16x8 b = *(const LAS bf16x8*)(B + (16 * (nt0 + j) + r16) * PITCH + 32 * s + 8 * kq);
            acc[j] = __builtin_amdgcn_mfma_f32_16x16x32_bf16(a, b, acc[j], 0, 0, 0); }
    }
}
__device__ __forceinline__ void mm64(f32x4 (&acc)[2], const LAS bf16_t* A, const LAS bf16_t* B, int mt, int nt0, int lane) { mm64p<LP, 2>(acc, A, B, mt, nt0, lane); }
__device__ __forceinline__ float quad_sum(float v) { v = dpp_add<0xB1>(v); v = dpp_add<0x4E>(v); return v; }
template <int CTRL> __device__ __forceinline__ float quad_bcast(float v) { return __builtin_bit_cast(float, __builtin_amdgcn_update_dpp(0, __builtin_bit_cast(int, v), CTRL, 0xf, 0xf, false)); }
__device__ __forceinline__ float oct_sum(float v) { v = dpp_add<0xB1>(v); v = dpp_add<0x4E>(v); v = dpp_add<0x141>(v); return v; }
__device__ __forceinline__ bf16_t* rw_mat(Frame& F, int unit, int q) { return (bf16_t*)(F.ws + WS_RWM) + (size_t)unit * 16384 + q * 4096; }
__device__ __forceinline__ void rw_lerp8(float (&x)[8], const bf16_t* pc, bool hasprev, const float* mu, int col) {
    const u32x4 c = *(const u32x4*)(pc + col); u32x4 p = (u32x4){0u, 0u, 0u, 0u}; if (hasprev) p = *(const u32x4*)(pc - NPROJ + col);
    const f32x4 m0 = *(const f32x4*)(mu + col), m1 = *(const f32x4*)(mu + col + 4);
    x[0] = bflo(c.x) + (bflo(p.x) - bflo(c.x)) * m0[0]; x[1] = bfhi(c.x) + (bfhi(p.x) - bfhi(c.x)) * m0[1]; x[2] = bflo(c.y) + (bflo(p.y) - bflo(c.y)) * m0[2]; x[3] = bfhi(c.y) + (bfhi(p.y) - bfhi(c.y)) * m0[3];
    x[4] = bflo(c.z) + (bflo(p.z) - bflo(c.z)) * m1[0]; x[5] = bfhi(c.z) + (bfhi(p.z) - bfhi(c.z)) * m1[1]; x[6] = bflo(c.w) + (bflo(p.w) - bflo(c.w)) * m1[2]; x[7] = bfhi(c.w) + (bfhi(p.w) - bfhi(c.w)) * m1[3];
}
struct RwRaw { u32x4 c[7], p[7]; };
__device__ __forceinline__ void rw_load_raw(Frame& F, RwRaw& raw, int unit) {
    const int n = unit & 63, h = (unit >> 6) & 3, b = unit >> 8, tokc = b * SEQ + n * 64 + (F.tid >> 3), k0 = (F.tid & 7) * 8; const bool hasprev = (tokc & (SEQ - 1)) != 0;
    const bf16_t* pc = (const bf16_t*)(F.ws + WS_PROJ) + (size_t)tokc * NPROJ + PD + k0;
    const int col[7] = {768, 832, 896, 960, h * 64, 256 + h * 64, 512 + h * 64};
#pragma unroll
    for (int g = 0; g < 7; ++g) { raw.c[g] = *(const u32x4*)(pc + col[g]); raw.p[g] = (u32x4){0u, 0u, 0u, 0u}; if (hasprev) raw.p[g] = *(const u32x4*)(pc - NPROJ + col[g]); }
}
__device__ __forceinline__ void rw_lerp8r(float (&x)[8], const u32x4 c, const u32x4 p, const LAS float* mu, int col) {
    const f32x4 m0 = *(const LAS f32x4*)(mu + col), m1 = *(const LAS f32x4*)(mu + col + 4);
    x[0] = bflo(c.x) + (bflo(p.x) - bflo(c.x)) * m0[0]; x[1] = bfhi(c.x) + (bfhi(p.x) - bfhi(c.x)) * m0[1]; x[2] = bflo(c.y) + (bflo(p.y) - bflo(c.y)) * m0[2]; x[3] = bfhi(c.y) + (bfhi(p.y) - bfhi(c.y)) * m0[3];
    x[4] = bflo(c.z) + (bflo(p.z) - bflo(c.z)) * m1[0]; x[5] = bfhi(c.z) + (bfhi(p.z) - bfhi(c.z)) * m1[1]; x[6] = bflo(c.w) + (bflo(p.w) - bflo(c.w)) * m1[2]; x[7] = bfhi(c.w) + (bfhi(p.w) - bfhi(c.w)) * m1[3];
}
__device__ __forceinline__ u32x4 pack8v(const float (&x)[8]) { u32x4 w; w.x = cvt_pk(x[0], x[1]); w.y = cvt_pk(x[2], x[3]); w.z = cvt_pk(x[4], x[5]); w.w = cvt_pk(x[6], x[7]); return w; }

constexpr int R1_TAB = 125440;
__device__ __forceinline__ void rwkv_r1_tables(Frame& F, int l) {
    LAS float* T = (LAS float*)(F.lds + R1_TAB);
    const float* mu = INF(F, I_MU) + l * 1024; const float* w0 = INF(F, I_W0) + l * 256; const float* a0 = INF(F, I_A0) + l * 256; const float* kk = INF(F, I_KK) + l * 256; const float* ka = INF(F, I_KA) + l * 256; const float* rk = INF(F, I_RK) + l * 256;
    T[F.tid] = mu[F.tid]; T[512 + F.tid] = mu[512 + F.tid];
    if (F.tid < 256) { T[1024 + F.tid] = w0[F.tid]; T[1280 + F.tid] = a0[F.tid]; T[1536 + F.tid] = kk[F.tid]; T[1792 + F.tid] = ka[F.tid]; T[2048 + F.tid] = rk[F.tid]; }
    __syncthreads();
}
__device__ __forceinline__ void rwkv_r1_unit(Frame& F, int l, int unit, int stop = 0) {
    const int n = unit & 63, h = (unit >> 6) & 3, b = unit >> 8, tok0 = b * SEQ + n * 64;
#define SLOT(i) ((LAS bf16_t*)(F.lds + (i) * 9216))
    LAS float* F0 = (LAS float*)(F.lds + 92160); LAS float* F1 = (LAS float*)(F.lds + 92160 + 16384); LAS float* GC = (LAS float*)(F.lds + 137216);
    LAS bf16_t* L10 = (LAS bf16_t*)(F.lds + 134656);
    LAS float* F2 = (LAS float*)F.lds;
    LAS bf16_t* XG = (LAS bf16_t*)(F.lds + 55296); LAS bf16_t* WG2 = (LAS bf16_t*)(F.lds + 72704);
    const int w = F.wave, mt = w & 3, nt0 = (w >> 2) * 2, r16 = F.lane & 15, kq = F.lane >> 4;
    const int t = F.tid >> 3, k0 = (F.tid & 7) * 8;
    const LAS float* TAB = (const LAS float*)(F.lds + R1_TAB); const LAS float* mu = TAB;
    const int tokc = tok0 + t;
    float r8[8], k8[8], v8[8], lw8[8], kk8[8], b8[8];
    RwRaw raw; rw_load_raw(F, raw, unit);
    __syncthreads();
    { float x[8];
      rw_lerp8r(x, raw.c[0], raw.p[0], mu, 768 + k0);
#pragma unroll
      for (int j = 0; j < 8; ++j) x[j] = tanh_f(x[j]);
      *(LAS u32x4*)(SLOT(2) + t * LP + k0) = pack8v(x);
      rw_lerp8r(x, raw.c[1], raw.p[1], mu, 832 + k0); *(LAS u32x4*)(SLOT(3) + t * LP + k0) = pack8v(x);
#pragma unroll
      for (int hf = 0; hf < 2; ++hf) { rw_lerp8r(x, raw.c[2 + hf], raw.p[2 + hf], mu, 896 + 64 * hf + k0);
#pragma unroll
          for (int j = 0; j < 8; ++j) x[j] = sigmoid_f(x[j]);
          *(LAS u32x4*)(XG + t * LPG + 64 * hf + k0) = pack8v(x); }
      const bf16_t* W2T = (const bf16_t*)(F.ws + WS_SMALLW); const bf16_t* A2T = W2T + 256 * 64; const bf16_t* G2T = A2T + 256 * 64;
      *(LAS u32x4*)(SLOT(4) + t * LP + k0) = *(const u32x4*)(W2T + (h * 64 + t) * 64 + k0); *(LAS u32x4*)(SLOT(5) + t * LP + k0) = *(const u32x4*)(A2T + (h * 64 + t) * 64 + k0);
      *(LAS u32x4*)(WG2 + t * LPG + k0) = *(const u32x4*)(G2T + (h * 64 + t) * 128 + k0); *(LAS u32x4*)(WG2 + t * LPG + 64 + k0) = *(const u32x4*)(G2T + (h * 64 + t) * 128 + 64 + k0);
      rw_lerp8r(r8, raw.c[4], raw.p[4], mu, h * 64 + k0); rw_lerp8r(k8, raw.c[5], raw.p[5], mu, 256 + h * 64 + k0); rw_lerp8r(v8, raw.c[6], raw.p[6], mu, 512 + h * 64 + k0); }
    __syncthreads();
    if (stop == 1) return;
    { f32x4 a0[2] = {{0.f, 0.f, 0.f, 0.f}, {0.f, 0.f, 0.f, 0.f}}, a1[2] = {{0.f, 0.f, 0.f, 0.f}, {0.f, 0.f, 0.f, 0.f}}, a2[2] = {{0.f, 0.f, 0.f, 0.f}, {0.f, 0.f, 0.f, 0.f}};
      mm64(a0, SLOT(2), SLOT(4), mt, nt0, F.lane); mm64(a1, SLOT(3), SLOT(5), mt, nt0, F.lane); mm64p<LPG, 4>(a2, XG, WG2, mt, nt0, F.lane);
      __syncthreads();
#pragma unroll
      for (int j = 0; j < 2; ++j)
#pragma unroll
          for (int rg = 0; rg < 4; ++rg) { const int o = (16 * mt + 4 * kq + rg) * 64 + 16 * (nt0 + j) + r16; F0[o] = a0[j][rg]; F1[o] = a1[j][rg]; F2[o] = a2[j][rg]; } }
    __syncthreads();
    if (stop == 2) return;
    { const int col = h * 64 + k0;
      const f32x4 w0a = *(const LAS f32x4*)(TAB + 1024 + col), w0b = *(const LAS f32x4*)(TAB + 1024 + col + 4), a0a = *(const LAS f32x4*)(TAB + 1280 + col), a0b = *(const LAS f32x4*)(TAB + 1280 + col + 4);
      const f32x4 kka = *(const LAS f32x4*)(TAB + 1536 + col), kkb = *(const LAS f32x4*)(TAB + 1536 + col + 4), kaa = *(const LAS f32x4*)(TAB + 1792 + col), kab = *(const LAS f32x4*)(TAB + 1792 + col + 4);
      const f32x4 rka = *(const LAS f32x4*)(TAB + 2048 + col), rkb = *(const LAS f32x4*)(TAB + 2048 + col + 4);
      const f32x4 p0a = *(const LAS f32x4*)(F0 + t * 64 + k0), p0b = *(const LAS f32x4*)(F0 + t * 64 + k0 + 4), p1a = *(const LAS f32x4*)(F1 + t * 64 + k0), p1b = *(const LAS f32x4*)(F1 + t * 64 + k0 + 4);
      const f32x4 p2a = *(const LAS f32x4*)(F2 + t * 64 + k0), p2b = *(const LAS f32x4*)(F2 + t * 64 + k0 + 4);
      float g8[8], ssq = 0.f, srkr = 0.f;
#pragma unroll
      for (int j = 0; j < 8; ++j) { const float w0 = j < 4 ? w0a[j & 3] : w0b[j & 3], a0 = j < 4 ? a0a[j & 3] : a0b[j & 3], k_k = j < 4 ? kka[j & 3] : kkb[j & 3], k_a = j < 4 ? kaa[j & 3] : kab[j & 3], r_k = j < 4 ? rka[j & 3] : rkb[j & 3];
          const float pw = j < 4 ? p0a[j & 3] : p0b[j & 3], pa = j < 4 ? p1a[j & 3] : p1b[j & 3]; g8[j] = j < 4 ? p2a[j & 3] : p2b[j & 3];
          const float a = sigmoid_f(a0 + pa); lw8[j] = bf2f(f2bf(-0.6065306597126334f * sigmoid_f(w0 + pw)));
          kk8[j] = k8[j] * k_k; const float km = k8[j] * (1.f + (a - 1.f) * k_a); b8[j] = kk8[j] * a; k8[j] = km;
          ssq += kk8[j] * kk8[j]; srkr += r8[j] * km * r_k; }
      ssq = oct_sum(ssq); srkr = oct_sum(srkr);
      const float rs = rsqrtf(ssq + 1e-12f);
#pragma unroll
      for (int j = 0; j < 8; ++j) { kk8[j] *= rs; b8[j] *= rs; }
      *(u32x4*)((bf16_t*)(F.ws + WS_RW_V) + (size_t)tokc * 256 + col) = pack8v(v8); *(u32x4*)((bf16_t*)(F.ws + WS_RW_G) + (size_t)tokc * 256 + col) = pack8v(g8);
      if ((F.tid & 7) == 0) ((float*)(F.ws + WS_RKR))[(size_t)tokc * 4 + h] = srkr; }
    __syncthreads();
    if (stop == 3) return;
#pragma unroll
    for (int j = 0; j < 8; ++j) { SLOT(0)[(k0 + j) * LP + t] = f2bf(lw8[j]); SLOT(1)[t * LP + k0 + j] = (k0 + j <= t) ? (bf16_t)0x3F80 : (bf16_t)0; }
    __syncthreads();
    { f32x4 acc[2] = {{0.f, 0.f, 0.f, 0.f}, {0.f, 0.f, 0.f, 0.f}}; mm64(acc, SLOT(1), SLOT(0), mt, nt0, F.lane);
#pragma unroll
      for (int j = 0; j < 2; ++j)
#pragma unroll
          for (int rg = 0; rg < 4; ++rg) F0[(16 * mt + 4 * kq + rg) * 64 + 16 * (nt0 + j) + r16] = acc[j][rg]; }
    __syncthreads();
    { const f32x4 c0 = *(const LAS f32x4*)(F0 + t * 64 + k0), c1 = *(const LAS f32x4*)(F0 + t * 64 + k0 + 4);
      const float cum[8] = {c0[0], c0[1], c0[2], c0[3], c1[0], c1[1], c1[2], c1[3]};
      float ka[8], bt[8], kt[8], rt[8];
#pragma unroll
      for (int j = 0; j < 8; ++j) { const float epos = __expf(cum[j]), eneg = __expf(-cum[j]), eprev = __expf(cum[j] - lw8[j]);
          ka[j] = kk8[j] * eprev; bt[j] = b8[j] * eneg; kt[j] = k8[j] * eneg; rt[j] = r8[j] * epos;
          if (t == 63) GC[k0 + j] = epos; }
      const u32x4 pka = pack8v(ka), pb = pack8v(bt), pq = pack8v(kt), prr = pack8v(rt), pv = pack8v(v8);
      *(LAS u32x4*)(SLOT(0) + t * LP + k0) = pka; *(LAS u32x4*)(SLOT(1) + t * LP + k0) = pb; *(LAS u32x4*)(SLOT(2) + t * LP + k0) = pq; *(LAS u32x4*)(SLOT(3) + t * LP + k0) = prr;
#pragma unroll
      for (int j = 0; j < 8; ++j) { SLOT(4)[(k0 + j) * LP + t] = hw(pb, j); SLOT(5)[(k0 + j) * LP + t] = hw(pq, j); SLOT(6)[(k0 + j) * LP + t] = hw(pv, j); } }
    __syncthreads();
    if (stop == 4) return;
    { f32x4 aLb[2] = {{0.f, 0.f, 0.f, 0.f}, {0.f, 0.f, 0.f, 0.f}}, aLk[2] = {{0.f, 0.f, 0.f, 0.f}, {0.f, 0.f, 0.f, 0.f}}, aMb[2] = {{0.f, 0.f, 0.f, 0.f}, {0.f, 0.f, 0.f, 0.f}}, aMk[2] = {{0.f, 0.f, 0.f, 0.f}, {0.f, 0.f, 0.f, 0.f}};
      mm64(aLb, SLOT(0), SLOT(1), mt, nt0, F.lane); mm64(aLk, SLOT(0), SLOT(2), mt, nt0, F.lane); mm64(aMb, SLOT(3), SLOT(1), mt, nt0, F.lane); mm64(aMk, SLOT(3), SLOT(2), mt, nt0, F.lane);
#pragma unroll
      for (int j = 0; j < 2; ++j)
#pragma unroll
          for (int rg = 0; rg < 4; ++rg) { const int tt = 16 * mt + 4 * kq + rg, ii = 16 * (nt0 + j) + r16;
              F0[tt * 64 + (ii & 3) * 16 + (ii >> 2)] = (ii < tt) ? aLb[j][rg] : 0.f;
              if (tt >= 32 && ii < 32) L10[(tt - 32) * 40 + ii] = f2bf(aLb[j][rg]);
              SLOT(7)[tt * LP + ii] = f2bf((ii < tt) ? aLk[j][rg] : 0.f); SLOT(8)[tt * LP + ii] = f2bf((ii <= tt) ? aMb[j][rg] : 0.f); SLOT(9)[tt * LP + ii] = f2bf((ii <= tt) ? aMk[j][rg] : 0.f); } }
    __syncthreads();
    if (stop == 5) return;
    { f32x4 acc[2] = {{0.f, 0.f, 0.f, 0.f}, {0.f, 0.f, 0.f, 0.f}}; mm64(acc, SLOT(7), SLOT(6), mt, nt0, F.lane);
#pragma unroll
      for (int j = 0; j < 2; ++j)
#pragma unroll
          for (int rg = 0; rg < 4; ++rg) F1[(16 * mt + 4 * kq + rg) * 64 + 16 * (nt0 + j) + r16] = acc[j][rg]; }
    __syncthreads();
    if (stop == 6) return;
    { const int col = F.tid >> 2, jq = F.tid & 3; float x[16], rhs[16];
#pragma unroll
      for (int m = 0; m < 16; ++m) { x[m] = 0.f; rhs[m] = (col < 64) ? bf2f(SLOT(0)[(4 * m + jq) * LP + col]) : F1[(4 * m + jq) * 64 + (col - 64)]; }
      LAS bf16_t* dst = (col < 64) ? (SLOT(7) + col * LP) : (SLOT(1) + (col - 64) * LP);
      LAS float* CORR = F1;
#define RW_ROUND(m, M4LO) do { float pa[4] = {0.f, 0.f, 0.f, 0.f}; \
          _Pragma("unroll") for (int a = 0; a < 4; ++a) \
              _Pragma("unroll") for (int m4 = (M4LO); 4 * m4 < (m); ++m4) { const f32x4 lq = *(const LAS f32x4*)(F0 + (4 * (m) + a) * 64 + jq * 16 + 4 * m4); \
                  _Pragma("unroll") for (int e = 0; e < 4; ++e) if (4 * m4 + e < (m)) pa[a] += lq[e] * x[4 * m4 + e]; } \
          const float t0 = quad_sum(pa[0]), t1 = quad_sum(pa[1]), t2 = quad_sum(pa[2]), t3 = quad_sum(pa[3]); \
          const LAS float* lrow = F0 + (4 * (m) + jq) * 64 + (m);                  \
          const float c0 = lrow[0], c1 = lrow[16], c2 = lrow[32]; \
          float y = rhs[m] - (jq == 0 ? t0 : (jq == 1 ? t1 : (jq == 2 ? t2 : t3))); \
          y -= c0 * quad_bcast<0x00>(y); y -= c1 * quad_bcast<0x55>(y); y -= c2 * quad_bcast<0xAA>(y); \
          x[m] = y; } while (0)
#pragma unroll
      for (int m = 0; m < 8; ++m) RW_ROUND(m, 0);
#pragma unroll
      for (int m = 0; m < 8; ++m) dst[4 * m + jq] = f2bf(-x[m]);
      __syncthreads();
      { const LAS bf16_t* xb = (w < 4 ? SLOT(7) + (16 * w + r16) * LP : SLOT(1) + (16 * (w - 4) + r16) * LP) + 8 * kq;
        const bf16x8 bx = *(const LAS bf16x8*)xb;
#pragma unroll
        for (int rt = 0; rt < 2; ++rt) { f32x4 acc = {0.f, 0.f, 0.f, 0.f};
            acc = __builtin_amdgcn_mfma_f32_16x16x32_bf16(*(const LAS bf16x8*)(L10 + (16 * rt + r16) * 40 + 8 * kq), bx, acc, 0, 0, 0);
#pragma unroll
            for (int rg = 0; rg < 4; ++rg) CORR[(16 * rt + 4 * kq + rg) * 132 + 16 * w + r16] = acc[rg]; } }
      __syncthreads();
#pragma unroll
      for (int m = 8; m < 16; ++m) rhs[m] += CORR[(4 * (m - 8) + jq) * 132 + col];
#pragma unroll
      for (int m = 8; m < 16; ++m) RW_ROUND(m, 2);
#undef RW_ROUND
#pragma unroll
      for (int m = 8; m < 16; ++m) dst[4 * m + jq] = f2bf(-x[m]); }
    __syncthreads();
    if (stop == 7) return;
    { f32x4 aG[2] = {{0.f, 0.f, 0.f, 0.f}, {0.f, 0.f, 0.f, 0.f}}, aH[2] = {{0.f, 0.f, 0.f, 0.f}, {0.f, 0.f, 0.f, 0.f}}, aR[2] = {{0.f, 0.f, 0.f, 0.f}, {0.f, 0.f, 0.f, 0.f}}, aY[2] = {{0.f, 0.f, 0.f, 0.f}, {0.f, 0.f, 0.f, 0.f}};
      mm64(aG, SLOT(7), SLOT(4), mt, nt0, F.lane);
      mm64(aH, SLOT(5), SLOT(6), mt, nt0, F.lane); mm64(aH, SLOT(4), SLOT(1), mt, nt0, F.lane);
      mm64(aR, SLOT(7), SLOT(8), mt, nt0, F.lane);
      mm64(aY, SLOT(9), SLOT(6), mt, nt0, F.lane); mm64(aY, SLOT(8), SLOT(1), mt, nt0, F.lane);
      bf16_t* MG = rw_mat(F, unit, 0); bf16_t* MR = rw_mat(F, unit, 1); bf16_t* MH = rw_mat(F, unit, 2); bf16_t* MY = rw_mat(F, unit, 3);
#pragma unroll
      for (int j = 0; j < 2; ++j) { const int cc = 16 * (nt0 + j) + r16, r0 = 16 * mt + 4 * kq;
          const float gcc = GC[cc]; const u32x2 rtw = *(const LAS u32x2*)(SLOT(3) + cc * LP + r0);
          float gv[4], hv[4], rv[4], yv[4];
#pragma unroll
          for (int rg = 0; rg < 4; ++rg) { gv[rg] = gcc * ((r0 + rg == cc ? 1.f : 0.f) + aG[j][rg]); hv[rg] = GC[r0 + rg] * aH[j][rg]; yv[rg] = aY[j][rg] * 1.0f; }
          rv[0] = bflo(rtw.x) + aR[j][0]; rv[1] = bfhi(rtw.x) + aR[j][1]; rv[2] = bflo(rtw.y) + aR[j][2]; rv[3] = bfhi(rtw.y) + aR[j][3];
          u32x2 o; o.x = pg8::cvt_pk_c(gv[0], gv[1]); o.y = pg8::cvt_pk_c(gv[2], gv[3]); *(u32x2*)(MG + cc * 64 + r0) = o;
          o.x = pg8::cvt_pk_c(rv[0], rv[1]); o.y = pg8::cvt_pk_c(rv[2], rv[3]); *(u32x2*)(MR + cc * 64 + r0) = o;
          o.x = pg8::cvt_pk_c(hv[0], hv[1]); o.y = pg8::cvt_pk_c(hv[2], hv[3]); *(u32x2*)(MH + cc * 64 + r0) = o;
          o.x = pg8::cvt_pk_c(yv[0], yv[1]); o.y = pg8::cvt_pk_c(yv[2], yv[3]); *(u32x2*)(MY + cc * 64 + r0) = o; } }
#undef SLOT
}

__device__ __forceinline__ void rwkv_r2_block(Frame& F, int bh) {
    LAS bf16_t* Sx = (LAS bf16_t*)F.lds; LAS bf16_t* Gs = (LAS bf16_t*)(F.lds + 9216);
    bf16_t* SG = (bf16_t*)(F.ws + WS_RW_S);
    const int w = F.wave, mt = w & 3, nt0 = (w >> 2) * 2, r16 = F.lane & 15, kq = F.lane >> 4;
    const int grow = F.tid >> 3, gc0 = (F.tid & 7) * 8;
    f32x4 st[2] = {{0.f, 0.f, 0.f, 0.f}, {0.f, 0.f, 0.f, 0.f}};
    constexpr int PF = 4;
    u32x4 gq[PF]; u32x2 hq[PF][2];
#define R2_FETCH(slot, n_) do { const int u_ = bh * 64 + (n_); gq[slot] = *(const u32x4*)(rw_mat(F, u_, 0) + grow * 64 + gc0); \
        _Pragma("unroll") for (int j_ = 0; j_ < 2; ++j_) hq[slot][j_] = *(const u32x2*)(rw_mat(F, u_, 2) + (16 * (nt0 + j_) + r16) * 64 + 16 * mt + 4 * kq); } while (0)
#pragma unroll
    for (int i = 0; i < PF; ++i) R2_FETCH(i, i);
    __syncthreads();
    for (int n0 = 0; n0 < 64; n0 += PF) {
#pragma unroll
        for (int i = 0; i < PF; ++i) { const int n = n0 + i; const int unit = bh * 64 + n;
#pragma unroll
            for (int j = 0; j < 2; ++j) { u32x2 ps; ps.x = pg8::cvt_pk_c(st[j][0], st[j][1]); ps.y = pg8::cvt_pk_c(st[j][2], st[j][3]);
                const int vv = 16 * (nt0 + j) + r16, kk0 = 16 * mt + 4 * kq;
                *(LAS u32x2*)(Sx + vv * LP + kk0) = ps; *(u32x2*)(SG + (size_t)unit * 4096 + vv * 64 + kk0) = ps; }
            *(LAS u32x4*)(Gs + grow * LP + gc0) = gq[i];
            f32x4 acc[2];
#pragma unroll
            for (int j = 0; j < 2; ++j) { acc[j][0] = bflo(hq[i][j].x); acc[j][1] = bfhi(hq[i][j].x); acc[j][2] = bflo(hq[i][j].y); acc[j][3] = bfhi(hq[i][j].y); }
            if (n + PF < 64) R2_FETCH(i, n + PF);
            __syncthreads();
            mm64(acc, Gs, Sx, mt, nt0, F.lane);
            st[0] = acc[0]; st[1] = acc[1];
            __syncthreads();
        }
    }
#undef R2_FETCH
}

__device__ __forceinline__ void rwkv_r3_task(Frame& F, int l, int unit) {
    const int n = unit & 63, h = (unit >> 6) & 3, b = unit >> 8, tok0 = b * SEQ + n * 64;
    const int r16 = F.lane & 15, kq = F.lane >> 4;
    const bf16_t* SG = (const bf16_t*)(F.ws + WS_RW_S) + (size_t)unit * 4096;
    const bf16_t* MR = rw_mat(F, unit, 1); const bf16_t* MY = rw_mat(F, unit, 3);
    bf16x8 sb[4][2];
#pragma unroll
    for (int nt = 0; nt < 4; ++nt)
#pragma unroll
        for (int s = 0; s < 2; ++s) sb[nt][s] = *(const bf16x8*)(SG + (16 * nt + r16) * 64 + 32 * s + 8 * kq);
    const float* lnw = INF(F, I_LNW) + l * 256 + h * 64; const float* lnb = INF(F, I_LNB) + l * 256 + h * 64;
    float lw4[4], lb4[4];
#pragma unroll
    for (int nt = 0; nt < 4; ++nt) { lw4[nt] = lnw[16 * nt + r16]; lb4[nt] = lnb[16 * nt + r16]; }
    const bf16_t* SV = (const bf16_t*)(F.ws + WS_RW_V); const bf16_t* SGt = (const bf16_t*)(F.ws + WS_RW_G); const float* RKR = (const float*)(F.ws + WS_RKR);
    bf16_t* MIX = (bf16_t*)(F.ws + WS_MIX);
#pragma unroll 1
    for (int mt = 0; mt < 4; ++mt) {
        f32x4 acc[4];
#pragma unroll
        for (int nt = 0; nt < 4; ++nt) { const u32x2 y0 = *(const u32x2*)(MY + (16 * nt + r16) * 64 + 16 * mt + 4 * kq); acc[nt][0] = bflo(y0.x); acc[nt][1] = bfhi(y0.x); acc[nt][2] = bflo(y0.y); acc[nt][3] = bfhi(y0.y); }
#pragma unroll
        for (int s = 0; s < 2; ++s) { const bf16x8 a = *(const bf16x8*)(MR + (16 * mt + r16) * 64 + 32 * s + 8 * kq);
#pragma unroll
            for (int nt = 0; nt < 4; ++nt) acc[nt] = __builtin_amdgcn_mfma_f32_16x16x32_bf16(a, sb[nt][s], acc[nt], 0, 0, 0); }
#pragma unroll
        for (int rg = 0; rg < 4; ++rg) { const int tok = tok0 + 16 * mt + 4 * kq + rg;
            const float mean = sum16((acc[0][rg] + acc[1][rg]) + (acc[2][rg] + acc[3][rg])) * (1.f / 64.f);
            float d[4], q = 0.f;
#pragma unroll
            for (int nt = 0; nt < 4; ++nt) { d[nt] = acc[nt][rg] - mean; q += d[nt] * d[nt]; }
            const float rstd = rsqrtf(sum16(q) * (1.f / 64.f) + 64e-5f);
            const float rkr = RKR[(size_t)tok * 4 + h];
#pragma unroll
            for (int nt = 0; nt < 4; ++nt) { const int col = h * 64 + 16 * nt + r16;
                const float vv = bf2f(SV[(size_t)tok * 256 + col]), gg = bf2f(SGt[(size_t)tok * 256 + col]);
                MIX[(size_t)tok * DM + 768 + col] = f2bf((d[nt] * rstd * lw4[nt] + lb4[nt] + rkr * vv) * gg); } }
    }
}
template <int PITCH, int KS>
__device__ __forceinline__ void mm_tile(f32x4& acc, const LAS bf16_t* A, const LAS bf16_t* B, int mt, int nt, int lane) {
    const int r16 = lane & 15, kq = lane >> 4;
#pragma unroll
    for (int s = 0; s < KS; ++s)
        acc = __builtin_amdgcn_mfma_f32_16x16x32_bf16(*(const LAS bf16x8*)(A + (16 * mt + r16) * PITCH + 32 * s + 8 * kq), *(const LAS bf16x8*)(B + (16 * nt + r16) * PITCH + 32 * s + 8 * kq), acc, 0, 0, 0);
}
constexpr int GP = 40;
__device__ __forceinline__ void gla_cum(Frame& F, int l, int h, int tok0, LAS bf16_t* LAhi, LAS bf16_t* LAlo, LAS float* Fc) {
    const bf16_t* P = (const bf16_t*)(F.ws + WS_PROJ);
    const float* wa2 = INF(F, I_GLA_WA2) + l * 16 * 128 + h * 32; const float* ba = INF(F, I_GLA_BA) + l * 128 + h * 32;
    const int t = F.tid >> 3, e4 = (F.tid & 7) * 4;
    { const u32x4 l0 = *(const u32x4*)(P + (size_t)(tok0 + t) * NPROJ + PB_LR), l1 = *(const u32x4*)(P + (size_t)(tok0 + t) * NPROJ + PB_LR + 8);
      const float lr[16] = {bflo(l0.x), bfhi(l0.x), bflo(l0.y), bfhi(l0.y), bflo(l0.z), bfhi(l0.z), bflo(l0.w), bfhi(l0.w), bflo(l1.x), bfhi(l1.x), bflo(l1.y), bfhi(l1.y), bflo(l1.z), bfhi(l1.z), bflo(l1.w), bfhi(l1.w)};
      f32x4 a = *(const f32x4*)(ba + e4);
#pragma unroll
      for (int r = 0; r < 16; ++r) a += lr[r] * *(const f32x4*)(wa2 + r * 128 + e4);
#pragma unroll
      for (int j = 0; j < 4; ++j) { const float la = logsigmoid_f(a[j]) * (1.f / 16.f); const bf16_t hi = f2bf(la); const bf16_t lo = f2bf(la - bf2f(hi));
          LAhi[(e4 + j) * LP + t] = hi; LAlo[(e4 + j) * LP + t] = lo; } }
    __syncthreads();
    { const int w = F.wave, mt = w & 3, nt = w >> 2, r16 = F.lane & 15, kq = F.lane >> 4; f32x4 acc = {0.f, 0.f, 0.f, 0.f};
#pragma unroll
      for (int s = 0; s < 2; ++s) { bf16x8 tri;
#pragma unroll
          for (int j = 0; j < 8; ++j) tri[j] = (32 * s + 8 * kq + j <= 16 * mt + r16) ? (short)0x3F80 : (short)0;
          acc = __builtin_amdgcn_mfma_f32_16x16x32_bf16(tri, *(const LAS bf16x8*)(LAhi + (16 * nt + r16) * LP + 32 * s + 8 * kq), acc, 0, 0, 0);
          acc = __builtin_amdgcn_mfma_f32_16x16x32_bf16(tri, *(const LAS bf16x8*)(LAlo + (16 * nt + r16) * LP + 32 * s + 8 * kq), acc, 0, 0, 0); }
#pragma unroll
      for (int rg = 0; rg < 4; ++rg) Fc[(16 * mt + 4 * kq + rg) * 32 + 16 * nt + r16] = acc[rg]; }
    __syncthreads();
}
__device__ __forceinline__ void gla_kv2(Frame& F, int l, int unit) {
    const bf16_t* P = (const bf16_t*)(F.ws + WS_PROJ);
    float* KV = (float*)(F.ws + WS_GLA_KV) + (size_t)unit * 2048; float* DEC = (float*)(F.ws + WS_GLA_DEC) + unit * 32;
    const int n = unit & 63, h = (unit >> 6) & 3, b = unit >> 8, tok0 = b * SEQ + n * 64;
    LAS bf16_t* LAhi = (LAS bf16_t*)F.lds; LAS bf16_t* LAlo = (LAS bf16_t*)(F.lds + 4608); LAS float* Fc = (LAS float*)(F.lds + 9216);
    LAS bf16_t* Ke = (LAS bf16_t*)(F.lds + 17408); LAS bf16_t* Vf = (LAS bf16_t*)(F.lds + 22016);
    const int t = F.tid >> 3, c8 = F.tid & 7;
    __syncthreads();
    gla_cum(F, l, h, tok0, LAhi, LAlo, Fc);
    { const u32x2 kw = *(const u32x2*)(P + (size_t)(tok0 + t) * NPROJ + PB_K + h * 32 + c8 * 4); const u32x4 vw = *(const u32x4*)(P + (size_t)(tok0 + t) * NPROJ + PB_V + h * 64 + c8 * 8);
      const f32x4 ct = *(const LAS f32x4*)(Fc + t * 32 + c8 * 4), cl = *(const LAS f32x4*)(Fc + 63 * 32 + c8 * 4);
      const float kf[4] = {bflo(kw.x), bfhi(kw.x), bflo(kw.y), bfhi(kw.y)};
#pragma unroll
      for (int j = 0; j < 4; ++j) { Ke[(c8 * 4 + j) * LP + t] = f2bf(kf[j] * __expf(cl[j] - ct[j])); if (t == 63) DEC[c8 * 4 + j] = __expf(cl[j]); }
#pragma unroll
      for (int j = 0; j < 8; ++j) Vf[(c8 * 8 + j) * LP + t] = hw(vw, j); }
    __syncthreads();
    { const int w = F.wave, mt = w & 1, nt = w >> 1, r16 = F.lane & 15, kq = F.lane >> 4; f32x4 acc = {0.f, 0.f, 0.f, 0.f};
      mm_tile<LP, 2>(acc, Ke, Vf, mt, nt, F.lane);
#pragma unroll
      for (int rg = 0; rg < 4; ++rg) KV[(16 * mt + 4 * kq + rg) * 64 + 16 * nt + r16] = acc[rg]; }
}
__device__ __forceinline__ void gla_out2(Frame& F, int l, int unit) {
    const bf16_t* P = (const bf16_t*)(F.ws + WS_PROJ); bf16_t* MIX = (bf16_t*)(F.ws + WS_MIX);
    const float* SP = (const float*)(F.ws + WS_GLA_KV) + (size_t)unit * 2048;
    const int n = unit & 63, h = (unit >> 6) & 3, b = unit >> 8, tok0 = b * SEQ + n * 64;
    LAS bf16_t* LAhi = (LAS bf16_t*)F.lds; LAS bf16_t* LAlo = (LAS bf16_t*)(F.lds + 4608); LAS float* Fc = (LAS float*)(F.lds + 9216);
    LAS bf16_t* Qe = (LAS bf16_t*)(F.lds + 17408); LAS bf16_t* Ke = (LAS bf16_t*)(F.lds + 22528); LAS bf16_t* Qb = (LAS bf16_t*)(F.lds + 27648); LAS bf16_t* Sf = (LAS bf16_t*)(F.lds + 32768);
    LAS bf16_t* Vf = (LAS bf16_t*)(F.lds + 37888); LAS bf16_t* At = (LAS bf16_t*)(F.lds + 47104); LAS float* Of = (LAS float*)(F.lds + 56320);
    const int t = F.tid >> 3, c8 = F.tid & 7, w = F.wave, mt = w & 3, nt0 = (w >> 2) * 2, r16 = F.lane & 15, kq = F.lane >> 4;
    __syncthreads();
    gla_cum(F, l, h, tok0, LAhi, LAlo, Fc);
    { const u32x2 qw = *(const u32x2*)(P + (size_t)(tok0 + t) * NPROJ + PB_Q + h * 32 + c8 * 4), kw = *(const u32x2*)(P + (size_t)(tok0 + t) * NPROJ + PB_K + h * 32 + c8 * 4);
      const u32x4 vw = *(const u32x4*)(P + (size_t)(tok0 + t) * NPROJ + PB_V + h * 64 + c8 * 8);
      const f32x4 ct = *(const LAS f32x4*)(Fc + t * 32 + c8 * 4), cr = *(const LAS f32x4*)(Fc + 31 * 32 + c8 * 4);
      const float qs = 0.17677669529663687f;
      const float qf[4] = {bflo(qw.x) * qs, bfhi(qw.x) * qs, bflo(qw.y) * qs, bfhi(qw.y) * qs}, kf[4] = {bflo(kw.x), bfhi(kw.x), bflo(kw.y), bfhi(kw.y)};
      float qe[4], ke[4], qb[4];
#pragma unroll
      for (int j = 0; j < 4; ++j) { qe[j] = qf[j] * __expf(ct[j] - cr[j]); ke[j] = kf[j] * __expf(cr[j] - ct[j]); qb[j] = qf[j] * __expf(ct[j]); }
      u32x2 o; o.x = cvt_pk(qe[0], qe[1]); o.y = cvt_pk(qe[2], qe[3]); *(LAS u32x2*)(Qe + t * GP + c8 * 4) = o;
      o.x = cvt_pk(ke[0], ke[1]); o.y = cvt_pk(ke[2], ke[3]); *(LAS u32x2*)(Ke + t * GP + c8 * 4) = o;
      o.x = cvt_pk(qb[0], qb[1]); o.y = cvt_pk(qb[2], qb[3]); *(LAS u32x2*)(Qb + t * GP + c8 * 4) = o;
#pragma unroll
      for (int j = 0; j < 8; ++j) Vf[(c8 * 8 + j) * LP + t] = hw(vw, j);
      const int e = F.tid >> 4, f4 = (F.tid & 15) * 4; const f32x4 sv = *(const f32x4*)(SP + e * 64 + f4);
#pragma unroll
      for (int j = 0; j < 4; ++j) Sf[(f4 + j) * GP + e] = f2bf(sv[j]); }
    __syncthreads();
    { f32x4 acc[2] = {{0.f, 0.f, 0.f, 0.f}, {0.f, 0.f, 0.f, 0.f}}; mm64p<GP, 1>(acc, Qe, Ke, mt, nt0, F.lane);
#pragma unroll
      for (int j = 0; j < 2; ++j)
#pragma unroll
          for (int rg = 0; rg < 4; ++rg) { const int tt = 16 * mt + 4 * kq + rg, ss = 16 * (nt0 + j) + r16; At[tt * LP + ss] = f2bf(ss <= tt ? acc[j][rg] : 0.f); } }
    __syncthreads();
    { f32x4 acc[2] = {{0.f, 0.f, 0.f, 0.f}, {0.f, 0.f, 0.f, 0.f}}; mm64p<LP, 2>(acc, At, Vf, mt, nt0, F.lane); mm64p<GP, 1>(acc, Qb, Sf, mt, nt0, F.lane);
#pragma unroll
      for (int j = 0; j < 2; ++j)
#pragma unroll
          for (int rg = 0; rg < 4; ++rg) Of[(16 * mt + 4 * kq + rg) * 64 + 16 * (nt0 + j) + r16] = acc[j][rg]; }
    __syncthreads();
    { const int f0 = c8 * 8; const f32x4 o0 = *(const LAS f32x4*)(Of + t * 64 + f0), o1 = *(const LAS f32x4*)(Of + t * 64 + f0 + 4);
      const float o[8] = {o0[0], o0[1], o0[2], o0[3], o1[0], o1[1], o1[2], o1[3]};
      float ss = 0.f;
#pragma unroll
      for (int j = 0; j < 8; ++j) ss += o[j] * o[j];
      ss = oct_sum(ss);
      const float rstd = rsqrtf(ss * (1.f / 64.f) + NORM_EPS); const float* gn = INF(F, I_GLA_ON) + l * 256 + h * 64 + f0;
      const f32x4 g0 = *(const f32x4*)gn, g1 = *(const f32x4*)(gn + 4);
      const u32x4 gw = *(const u32x4*)(P + (size_t)(tok0 + t) * NPROJ + PB_G + h * 64 + f0);
      const float gb[8] = {bflo(gw.x), bfhi(gw.x), bflo(gw.y), bfhi(gw.y), bflo(gw.z), bfhi(gw.z), bflo(gw.w), bfhi(gw.w)};
      float r[8];
#pragma unroll
      for (int j = 0; j < 8; ++j) r[j] = o[j] * rstd * (j < 4 ? g0[j & 3] : g1[j & 3]) * (gb[j] * sigmoid_f(gb[j]));
      *(u32x4*)(MIX + (size_t)(tok0 + t) * DM + 256 + h * 64 + f0) = pack8v(r); }
}
struct Args { const void* in[N_IN]; float* out; unsigned char* ws; int ph_lo, ph_hi, sub, pad; };
constexpr int PH_PER_LAYER = 10, PH_FINAL = DEPTH * PH_PER_LAYER, PH_END = PH_FINAL + 2;
#ifndef EN_MASK
#define EN_MASK 0xFFFF
#endif
#define EN(b) ((EN_MASK >> (b)) & 1)
#ifndef DUP_MASK
#define DUP_MASK 0
#endif
#define NREP(b) (1 + ((DUP_MASK >> (b)) & 1))
enum Phase { P_PREP = 0, P_INPROJ, P_MIX1, P_MIX2, P_MIX3, P_OUTPROJ, P_NORM2, P_MAP, P_UP, P_DOWN };

__global__ void __launch_bounds__(512, 2) fwd_kernel(Args args) {
    extern __shared__ __attribute__((aligned(16))) unsigned char lds_raw[];
    Frame F;
    F.lds = (LAS unsigned char*)lds_raw;
    F.tid = threadIdx.x; F.lane = F.tid & 63; F.wave = __builtin_amdgcn_readfirstlane(F.tid >> 6);
    F.bid = blockIdx.x; F.G = gridDim.x;
    F.ws = args.ws; F.ctl = (unsigned*)(args.ws + WS_CTL); F.out = args.out;
    if (F.tid < N_IN) ((LAS unsigned long long*)(F.lds + PTR_OFF))[F.tid] = (unsigned long long)args.in[F.tid];
    volatile LAS unsigned* MISC = (volatile LAS unsigned*)(F.lds + MISC_OFF);
    if (F.tid < 8) MISC[F.tid] = 0u;
    __syncthreads();
    const int lo = args.ph_lo, hi = args.ph_hi, sub = args.sub;
    const int wave_sgpr = F.wave;
    XcdBarrier bar; bar.bar = F.ctl + CW_BAR; bar.x = 0; bar.st = MISC;
    if (hi - lo > 1) bar = xcd_barrier_post(F.ctl + CW_BAR, MISC);
#define HB ((bf16_t*)(F.ws + WS_H))
#define PROJ ((bf16_t*)(F.ws + WS_PROJ))
#define MIXB ((bf16_t*)(F.ws + WS_MIX))
#define ACT ((bf16_t*)(F.ws + WS_PROJ))
#define XBUF ((bf16_t*)((unsigned char*)F.out + XB_OFF))
#define IN(k) (lo <= (k) && (k) < hi)
#define PH_BEGIN() do { int w_i = wave_sgpr; asm volatile("" : "+s"(w_i)); unsigned m_i = ~0u; asm volatile("" : "+s"(m_i)); int l_i = (int)__builtin_amdgcn_mbcnt_hi(m_i, __builtin_amdgcn_mbcnt_lo(m_i, 0u)); asm volatile("" : "+v"(l_i)); F.wave = w_i; F.lane = l_i; F.tid = w_i * 64 + l_i; \
        GAS unsigned char* w_ = (GAS unsigned char*)args.ws; asm volatile("" : "+s"(w_)); F.ws = (unsigned char*)w_; F.ctl = (unsigned*)((unsigned char*)w_ + WS_CTL); F.out = (float*)(GAS float*)args.out; F.lds = (LAS unsigned char*)lds_raw; } while (0)
#define SEAM(k) do { if ((k) + 1 < hi) { GAS unsigned* bp_ = (GAS unsigned*)(F.ctl + CW_BAR); asm volatile("" : "+s"(bp_)); bar.bar = (unsigned*)bp_; unsigned bx_ = bar.x; asm volatile("" : "+s"(bx_)); bar.x = bx_; int w_j = wave_sgpr; asm volatile("" : "+s"(w_j)); unsigned m_j = ~0u; asm volatile("" : "+s"(m_j)); const int l_j = (int)__builtin_amdgcn_mbcnt_hi(m_j, __builtin_amdgcn_mbcnt_lo(m_j, 0u)); xcd_barrier(bar, w_j == 0 && l_j == 0); } } while (0)

    if (EN(0) && IN(0)) { PH_BEGIN(); phase_rope_tables(F); }
    { constexpr int l = 0;
        const int pb = l * PH_PER_LAYER; const bool moe = (l & 1) != 0; const int ms = l >> 1;

        if (EN(0) && IN(pb + P_PREP)) { PH_BEGIN();
            if (sub & 1) { phase_convert_weights(F, l); rwkv_convert_small(F, l); }
            __syncthreads();
            if (sub & 2) { if (l == 0) phase_norm_lr<true, false>(F, INF(F, I_X), INF(F, I_ATTN_NORM) + l * DM, l); else if (((l - 1) & 1) != 0) phase_norm_lr<false, true>(F, XBUF, INF(F, I_ATTN_NORM) + l * DM, l); else phase_norm_lr<false, false>(F, XBUF, INF(F, I_ATTN_NORM) + l * DM, l); }
            SEAM(pb + P_PREP);
        }
        if (EN(1) && IN(pb + P_INPROJ)) { PH_BEGIN();
            pg8::Gemm g{HB, (const bf16_t*)(F.ws + WS_WIN), DM, nullptr}; pg8::StaticOrder S; S.init(NTOK, 3072, F.G, F.bid);
            pg8::EpiBf16 E{PROJ, NPROJ};
            pg8::gemm_phase<pg8::EpiBf16, pg8::StaticOrder, false>(F.tid, F.lds, g, S, E);
            SEAM(pb + P_INPROJ);
        }
        if (EN(2) && IN(pb + P_MIX1)) { PH_BEGIN();
            if (sub & 1) { rwkv_r1_tables(F, l); for (int unit = F.bid; unit < 2048; unit += F.G) rwkv_r1_unit(F, l, unit, (sub >> 8) & 15); }
            if (sub & 2) for (int unit = F.bid; unit < 2048; unit += F.G) gla_kv2(F, l, unit);
            SEAM(pb + P_MIX1);
        }
        if (EN(3) && IN(pb + P_MIX2)) { PH_BEGIN();
            if (F.bid < 32) { if (sub & 1) rwkv_r2_block(F, F.bid); }
            else { const int ob = F.bid - 32, NO = F.G - 32;
                if (sub & 2) for (int gt = ob * 512 + F.tid; gt < 65536; gt += NO * 512) gla_scan(F, gt); }
            if (sub & 12) {
                volatile LAS int* qw = (volatile LAS int*)(F.lds + MISC_OFF + 28);
                unsigned* qctr = F.ctl + CW_ATTNQ + 64 * l + ((sub >> 4) & 1) * 32;
                int nxt = 0;
                if (F.tid == 0) nxt = (int)atomicAdd(qctr, 1u);
                for (;;) {
                    __syncthreads();
                    if (F.tid == 0) *qw = nxt;
                    __syncthreads();
                    const int task = *qw;
                    if (task >= 1024) break;
                    if (F.tid == 0) nxt = (int)atomicAdd(qctr, 1u);
                    if (task < 512) { if (sub & 4) attn_block<false>(F, l, task); } else if (sub & 8) attn_block<true>(F, l, task - 512);
                }
            }
            SEAM(pb + P_MIX2);
        }
        if (EN(4) && IN(pb + P_MIX3)) { PH_BEGIN();
            if (sub & 1) for (int unit = F.bid; unit < 2048; unit += F.G) gla_out2(F, l, unit);
            if (sub & 2) for (int unit = F.bid * 8 + F.wave; unit < 2048; unit += F.G * 8) rwkv_r3_task(F, l, unit);
            SEAM(pb + P_MIX3);
        }
        if (EN(5) && IN(pb + P_OUTPROJ)) { PH_BEGIN();
            __syncthreads();
            pg8::Gemm g{MIXB, (const bf16_t*)(F.ws + WS_WOUT), DM, nullptr}; pg8::StaticOrder S; S.init(NTOK, DM, F.G, F.bid);
            if (l == 0) { pg8::EpiResidB<true> E{INF(F, I_X), XBUF, DM}; pg8::gemm_phase<pg8::EpiResidB<true>, pg8::StaticOrder, false>(F.tid, F.lds, g, S, E); }
            else { pg8::EpiResidB<false> E{XBUF, XBUF, DM}; pg8::gemm_phase<pg8::EpiResidB<false>, pg8::StaticOrder, false>(F.tid, F.lds, g, S, E); }
            SEAM(pb + P_OUTPROJ);
        }
        if (EN(6) && IN(pb + P_NORM2)) { PH_BEGIN();
            if (moe) phase_norm<1, false>(F, XBUF, INF(F, I_FFN_NORM) + l * DM, false, ms);
            else phase_norm<0, false>(F, XBUF, INF(F, I_FFN_NORM) + l * DM, false, 0);
            SEAM(pb + P_NORM2);
        }
        if (EN(7) && IN(pb + P_MAP)) { PH_BEGIN();
            if (moe) { phase_moe_map(F, ms); SEAM(pb + P_MAP); }
        }
        if (EN(8) && IN(pb + P_UP)) { PH_BEGIN();
            __syncthreads();
            if (!moe) {
                pg8::Gemm g{HB, (const bf16_t*)(F.ws + WS_W13), DM / 2, nullptr}; pg8::StaticOrder S; S.init(NTOK, 2 * D_FF, F.G, F.bid);
                pg8::EpiSwiglu8 E{(unsigned char*)ACT, D_FF, 0.015625f};
                pg8::gemm_phase<pg8::EpiSwiglu8, pg8::StaticOrder, false, true>(F.tid, F.lds, g, S, E);
            } else {
                pg8::MoeOrder S; moe_bases(F.ctl + CW_MOECNT + 64 * ms, S.tb); S.ntiles = S.tb[8]; S.nNe = 2 * D_FFE / 256; S.G = F.G; S.c = F.bid;
                pg8::Gemm g{HB, (const bf16_t*)(F.ws + WS_W13), DM / 2, (const int*)(F.ws + WS_ROWMAP)};
                pg8::EpiSwiglu8 E{(unsigned char*)ACT, KP8, 0.015625f};
                pg8::gemm_phase<pg8::EpiSwiglu8, pg8::MoeOrder, true, true>(F.tid, F.lds, g, S, E);
            }
            SEAM(pb + P_UP);
        }
        if (EN(9) && IN(pb + P_DOWN)) { PH_BEGIN();
            __syncthreads();
            if (!moe) {
                pg8::Gemm g{ACT, (const bf16_t*)(F.ws + WS_W2), D_FF / 2, nullptr}; pg8::StaticOrder S; S.init(NTOK, DM, F.G, F.bid);
                pg8::EpiResidB<false> E{XBUF, XBUF, DM, 0.015625f};
                pg8::gemm_phase<pg8::EpiResidB<false>, pg8::StaticOrder, false, true>(F.tid, F.lds, g, S, E);
            } else {
                pg8::MoeOrder S; moe_bases(F.ctl + CW_MOECNT + 64 * ms, S.tb); S.ntiles = S.tb[8]; S.nNe = DM / 256; S.G = F.G; S.c = F.bid;
                pg8::Gemm g{ACT, (const bf16_t*)(F.ws + WS_W2), KP8 / 2, nullptr};
                pg8::EpiBf16 E{(bf16_t*)(F.ws + WS_Y), DM, 0.015625f};
                pg8::gemm_phase<pg8::EpiBf16, pg8::MoeOrder, false, true>(F.tid, F.lds, g, S, E);
            }
            SEAM(pb + P_DOWN);
        }
        }
    { constexpr int l = 1;
        const int pb = l * PH_PER_LAYER; const bool moe = (l & 1) != 0; const int ms = l >> 1;

        if (EN(0) && IN(pb + P_PREP)) { PH_BEGIN();
            if (sub & 1) { phase_convert_weights(F, l); rwkv_convert_small(F, l); }
            __syncthreads();
            if (sub & 2) { if (l == 0) phase_norm_lr<true, false>(F, INF(F, I_X), INF(F, I_ATTN_NORM) + l * DM, l); else if (((l - 1) & 1) != 0) phase_norm_lr<false, true>(F, XBUF, INF(F, I_ATTN_NORM) + l * DM, l); else phase_norm_lr<false, false>(F, XBUF, INF(F, I_ATTN_NORM) + l * DM, l); }
            SEAM(pb + P_PREP);
        }
        if (EN(1) && IN(pb + P_INPROJ)) { PH_BEGIN();
            pg8::Gemm g{HB, (const bf16_t*)(F.ws + WS_WIN), DM, nullptr}; pg8::StaticOrder S; S.init(NTOK, 3072, F.G, F.bid);
            pg8::EpiBf16 E{PROJ, NPROJ};
            pg8::gemm_phase<pg8::EpiBf16, pg8::StaticOrder, false>(F.tid, F.lds, g, S, E);
            SEAM(pb + P_INPROJ);
        }
        if (EN(2) && IN(pb + P_MIX1)) { PH_BEGIN();
            if (sub & 1) { rwkv_r1_tables(F, l); for (int unit = F.bid; unit < 2048; unit += F.G) rwkv_r1_unit(F, l, unit, (sub >> 8) & 15); }
            if (sub & 2) for (int unit = F.bid; unit < 2048; unit += F.G) gla_kv2(F, l, unit);
            SEAM(pb + P_MIX1);
        }
        if (EN(3) && IN(pb + P_MIX2)) { PH_BEGIN();
            if (F.bid < 32) { if (sub & 1) rwkv_r2_block(F, F.bid); }
            else { const int ob = F.bid - 32, NO = F.G - 32;
                if (sub & 2) for (int gt = ob * 512 + F.tid; gt < 65536; gt += NO * 512) gla_scan(F, gt); }
            if (sub & 12) {
                volatile LAS int* qw = (volatile LAS int*)(F.lds + MISC_OFF + 28);
                unsigned* qctr = F.ctl + CW_ATTNQ + 64 * l + ((sub >> 4) & 1) * 32;
                int nxt = 0;
                if (F.tid == 0) nxt = (int)atomicAdd(qctr, 1u);
                for (;;) {
                    __syncthreads();
                    if (F.tid == 0) *qw = nxt;
                    __syncthreads();
                    const int task = *qw;
                    if (task >= 1024) break;
                    if (F.tid == 0) nxt = (int)atomicAdd(qctr, 1u);
                    if (task < 512) { if (sub & 4) attn_block<false>(F, l, task); } else if (sub & 8) attn_block<true>(F, l, task - 512);
                }
            }
            SEAM(pb + P_MIX2);
        }
        if (EN(4) && IN(pb + P_MIX3)) { PH_BEGIN();
            if (sub & 1) for (int unit = F.bid; unit < 2048; unit += F.G) gla_out2(F, l, unit);
            if (sub & 2) for (int unit = F.bid * 8 + F.wave; unit < 2048; unit += F.G * 8) rwkv_r3_task(F, l, unit);
            SEAM(pb + P_MIX3);
        }
        if (EN(5) && IN(pb + P_OUTPROJ)) { PH_BEGIN();
            __syncthreads();
            pg8::Gemm g{MIXB, (const bf16_t*)(F.ws + WS_WOUT), DM, nullptr}; pg8::StaticOrder S; S.init(NTOK, DM, F.G, F.bid);
            if (l == 0) { pg8::EpiResidB<true> E{INF(F, I_X), XBUF, DM}; pg8::gemm_phase<pg8::EpiResidB<true>, pg8::StaticOrder, false>(F.tid, F.lds, g, S, E); }
            else { pg8::EpiResidB<false> E{XBUF, XBUF, DM}; pg8::gemm_phase<pg8::EpiResidB<false>, pg8::StaticOrder, false>(F.tid, F.lds, g, S, E); }
            SEAM(pb + P_OUTPROJ);
        }
        if (EN(6) && IN(pb + P_NORM2)) { PH_BEGIN();
            if (moe) phase_norm<1, false>(F, XBUF, INF(F, I_FFN_NORM) + l * DM, false, ms);
            else phase_norm<0, false>(F, XBUF, INF(F, I_FFN_NORM) + l * DM, false, 0);
            SEAM(pb + P_NORM2);
        }
        if (EN(7) && IN(pb + P_MAP)) { PH_BEGIN();
            if (moe) { phase_moe_map(F, ms); SEAM(pb + P_MAP); }
        }
        if (EN(8) && IN(pb + P_UP)) { PH_BEGIN();
            __syncthreads();
            if (!moe) {
                pg8::Gemm g{HB, (const bf16_t*)(F.ws + WS_W13), DM / 2, nullptr}; pg8::StaticOrder S; S.init(NTOK, 2 * D_FF, F.G, F.bid);
                pg8::EpiSwiglu8 E{(unsigned char*)ACT, D_FF, 0.015625f};
                pg8::gemm_phase<pg8::EpiSwiglu8, pg8::StaticOrder, false, true>(F.tid, F.lds, g, S, E);
            } else {
                pg8::MoeOrder S; moe_bases(F.ctl + CW_MOECNT + 64 * ms, S.tb); S.ntiles = S.tb[8]; S.nNe = 2 * D_FFE / 256; S.G = F.G; S.c = F.bid;
                pg8::Gemm g{HB, (const bf16_t*)(F.ws + WS_W13), DM / 2, (const int*)(F.ws + WS_ROWMAP)};
                pg8::EpiSwiglu8 E{(unsigned char*)ACT, KP8, 0.015625f};
                pg8::gemm_phase<pg8::EpiSwiglu8, pg8::MoeOrder, true, true>(F.tid, F.lds, g, S, E);
            }
            SEAM(pb + P_UP);
        }
        if (EN(9) && IN(pb + P_DOWN)) { PH_BEGIN();
            __syncthreads();
            if (!moe) {
                pg8::Gemm g{ACT, (const bf16_t*)(F.ws + WS_W2), D_FF / 2, nullptr}; pg8::StaticOrder S; S.init(NTOK, DM, F.G, F.bid);
                pg8::EpiResidB<false> E{XBUF, XBUF, DM, 0.015625f};
                pg8::gemm_phase<pg8::EpiResidB<false>, pg8::StaticOrder, false, true>(F.tid, F.lds, g, S, E);
            } else {
                pg8::MoeOrder S; moe_bases(F.ctl + CW_MOECNT + 64 * ms, S.tb); S.ntiles = S.tb[8]; S.nNe = DM / 256; S.G = F.G; S.c = F.bid;
                pg8::Gemm g{ACT, (const bf16_t*)(F.ws + WS_W2), KP8 / 2, nullptr};
                pg8::EpiBf16 E{(bf16_t*)(F.ws + WS_Y), DM, 0.015625f};
                pg8::gemm_phase<pg8::EpiBf16, pg8::MoeOrder, false, true>(F.tid, F.lds, g, S, E);
            }
            SEAM(pb + P_DOWN);
        }
        }
    { constexpr int l = 2;
        const int pb = l * PH_PER_LAYER; const bool moe = (l & 1) != 0; const int ms = l >> 1;

        if (EN(0) && IN(pb + P_PREP)) { PH_BEGIN();
            if (sub & 1) { phase_convert_weights(F, l); rwkv_convert_small(F, l); }
            __syncthreads();
            if (sub & 2) { if (l == 0) phase_norm_lr<true, false>(F, INF(F, I_X), INF(F, I_ATTN_NORM) + l * DM, l); else if (((l - 1) & 1) != 0) phase_norm_lr<false, true>(F, XBUF, INF(F, I_ATTN_NORM) + l * DM, l); else phase_norm_lr<false, false>(F, XBUF, INF(F, I_ATTN_NORM) + l * DM, l); }
            SEAM(pb + P_PREP);
        }
        if (EN(1) && IN(pb + P_INPROJ)) { PH_BEGIN();
            pg8::Gemm g{HB, (const bf16_t*)(F.ws + WS_WIN), DM, nullptr}; pg8::StaticOrder S; S.init(NTOK, 3072, F.G, F.bid);
            pg8::EpiBf16 E{PROJ, NPROJ};
            pg8::gemm_phase<pg8::EpiBf16, pg8::StaticOrder, false>(F.tid, F.lds, g, S, E);
            SEAM(pb + P_INPROJ);
        }
        if (EN(2) && IN(pb + P_MIX1)) { PH_BEGIN();
            if (sub & 1) { rwkv_r1_tables(F, l); for (int unit = F.bid; unit < 2048; unit += F.G) rwkv_r1_unit(F, l, unit, (sub >> 8) & 15); }
            if (sub & 2) for (int unit = F.bid; unit < 2048; unit += F.G) gla_kv2(F, l, unit);
            SEAM(pb + P_MIX1);
        }
        if (EN(3) && IN(pb + P_MIX2)) { PH_BEGIN();
            if (F.bid < 32) { if (sub & 1) rwkv_r2_block(F, F.bid); }
            else { const int ob = F.bid - 32, NO = F.G - 32;
                if (sub & 2) for (int gt = ob * 512 + F.tid; gt < 65536; gt += NO * 512) gla_scan(F, gt); }
            if (sub & 12) {
                volatile LAS int* qw = (volatile LAS int*)(F.lds + MISC_OFF + 28);
                unsigned* qctr = F.ctl + CW_ATTNQ + 64 * l + ((sub >> 4) & 1) * 32;
                int nxt = 0;
                if (F.tid == 0) nxt = (int)atomicAdd(qctr, 1u);
                for (;;) {
                    __syncthreads();
                    if (F.tid == 0) *qw = nxt;
                    __syncthreads();
                    const int task = *qw;
                    if (task >= 1024) break;
                    if (F.tid == 0) nxt = (int)atomicAdd(qctr, 1u);
                    if (task < 512) { if (sub & 4) attn_block<false>(F, l, task); } else if (sub & 8) attn_block<true>(F, l, task - 512);
                }
            }
            SEAM(pb + P_MIX2);
        }
        if (EN(4) && IN(pb + P_MIX3)) { PH_BEGIN();
            if (sub & 1) for (int unit = F.bid; unit < 2048; unit += F.G) gla_out2(F, l, unit);
            if (sub & 2) for (int unit = F.bid * 8 + F.wave; unit < 2048; unit += F.G * 8) rwkv_r3_task(F, l, unit);
            SEAM(pb + P_MIX3);
        }
        if (EN(5) && IN(pb + P_OUTPROJ)) { PH_BEGIN();
            __syncthreads();
            pg8::Gemm g{MIXB, (const bf16_t*)(F.ws + WS_WOUT), DM, nullptr}; pg8::StaticOrder S; S.init(NTOK, DM, F.G, F.bid);
            if (l == 0) { pg8::EpiResidB<true> E{INF(F, I_X), XBUF, DM}; pg8::gemm_phase<pg8::EpiResidB<true>, pg8::StaticOrder, false>(F.tid, F.lds, g, S, E); }
            else { pg8::EpiResidB<false> E{XBUF, XBUF, DM}; pg8::gemm_phase<pg8::EpiResidB<false>, pg8::StaticOrder, false>(F.tid, F.lds, g, S, E); }
            SEAM(pb + P_OUTPROJ);
        }
        if (EN(6) && IN(pb + P_NORM2)) { PH_BEGIN();
            if (moe) phase_norm<1, false>(F, XBUF, INF(F, I_FFN_NORM) + l * DM, false, ms);
            else phase_norm<0, false>(F, XBUF, INF(F, I_FFN_NORM) + l * DM, false, 0);
            SEAM(pb + P_NORM2);
        }
        if (EN(7) && IN(pb + P_MAP)) { PH_BEGIN();
            if (moe) { phase_moe_map(F, ms); SEAM(pb + P_MAP); }
        }
        if (EN(8) && IN(pb + P_UP)) { PH_BEGIN();
            __syncthreads();
            if (!moe) {
                pg8::Gemm g{HB, (const bf16_t*)(F.ws + WS_W13), DM / 2, nullptr}; pg8::StaticOrder S; S.init(NTOK, 2 * D_FF, F.G, F.bid);
                pg8::EpiSwiglu8 E{(unsigned char*)ACT, D_FF, 0.015625f};
                pg8::gemm_phase<pg8::EpiSwiglu8, pg8::StaticOrder, false, true>(F.tid, F.lds, g, S, E);
            } else {
                pg8::MoeOrder S; moe_bases(F.ctl + CW_MOECNT + 64 * ms, S.tb); S.ntiles = S.tb[8]; S.nNe = 2 * D_FFE / 256; S.G = F.G; S.c = F.bid;
                pg8::Gemm g{HB, (const bf16_t*)(F.ws + WS_W13), DM / 2, (const int*)(F.ws + WS_ROWMAP)};
                pg8::EpiSwiglu8 E{(unsigned char*)ACT, KP8, 0.015625f};
                pg8::gemm_phase<pg8::EpiSwiglu8, pg8::MoeOrder, true, true>(F.tid, F.lds, g, S, E);
            }
            SEAM(pb + P_UP);
        }
        if (EN(9) && IN(pb + P_DOWN)) { PH_BEGIN();
            __syncthreads();
            if (!moe) {
                pg8::Gemm g{ACT, (const bf16_t*)(F.ws + WS_W2), D_FF / 2, nullptr}; pg8::StaticOrder S; S.init(NTOK, DM, F.G, F.bid);
                pg8::EpiResidB<false> E{XBUF, XBUF, DM, 0.015625f};
                pg8::gemm_phase<pg8::EpiResidB<false>, pg8::StaticOrder, false, true>(F.tid, F.lds, g, S, E);
            } else {
                pg8::MoeOrder S; moe_bases(F.ctl + CW_MOECNT + 64 * ms, S.tb); S.ntiles = S.tb[8]; S.nNe = DM / 256; S.G = F.G; S.c = F.bid;
                pg8::Gemm g{ACT, (const bf16_t*)(F.ws + WS_W2), KP8 / 2, nullptr};
                pg8::EpiBf16 E{(bf16_t*)(F.ws + WS_Y), DM, 0.015625f};
                pg8::gemm_phase<pg8::EpiBf16, pg8::MoeOrder, false, true>(F.tid, F.lds, g, S, E);
            }
            SEAM(pb + P_DOWN);
        }
        }
    { constexpr int l = 3;
        const int pb = l * PH_PER_LAYER; const bool moe = (l & 1) != 0; const int ms = l >> 1;

        if (EN(0) && IN(pb + P_PREP)) { PH_BEGIN();
            if (sub & 1) { phase_convert_weights(F, l); rwkv_convert_small(F, l); }
            __syncthreads();
            if (sub & 2) { if (l == 0) phase_norm_lr<true, false>(F, INF(F, I_X), INF(F, I_ATTN_NORM) + l * DM, l); else if (((l - 1) & 1) != 0) phase_norm_lr<false, true>(F, XBUF, INF(F, I_ATTN_NORM) + l * DM, l); else phase_norm_lr<false, false>(F, XBUF, INF(F, I_ATTN_NORM) + l * DM, l); }
            SEAM(pb + P_PREP);
        }
        if (EN(1) && IN(pb + P_INPROJ)) { PH_BEGIN();
            pg8::Gemm g{HB, (const bf16_t*)(F.ws + WS_WIN), DM, nullptr}; pg8::StaticOrder S; S.init(NTOK, 3072, F.G, F.bid);
            pg8::EpiBf16 E{PROJ, NPROJ};
            pg8::gemm_phase<pg8::EpiBf16, pg8::StaticOrder, false>(F.tid, F.lds, g, S, E);
            SEAM(pb + P_INPROJ);
        }
        if (EN(2) && IN(pb + P_MIX1)) { PH_BEGIN();
            if (sub & 1) { rwkv_r1_tables(F, l); for (int unit = F.bid; unit < 2048; unit += F.G) rwkv_r1_unit(F, l, unit, (sub >> 8) & 15); }
            if (sub & 2) for (int unit = F.bid; unit < 2048; unit += F.G) gla_kv2(F, l, unit);
            SEAM(pb + P_MIX1);
        }
        if (EN(3) && IN(pb + P_MIX2)) { PH_BEGIN();
            if (F.bid < 32) { if (sub & 1) rwkv_r2_block(F, F.bid); }
            else { const int ob = F.bid - 32, NO = F.G - 32;
                if (sub & 2) for (int gt = ob * 512 + F.tid; gt < 65536; gt += NO * 512) gla_scan(F, gt); }
            if (sub & 12) {
                volatile LAS int* qw = (volatile LAS int*)(F.lds + MISC_OFF + 28);
                unsigned* qctr = F.ctl + CW_ATTNQ + 64 * l + ((sub >> 4) & 1) * 32;
                int nxt = 0;
                if (F.tid == 0) nxt = (int)atomicAdd(qctr, 1u);
                for (;;) {
                    __syncthreads();
                    if (F.tid == 0) *qw = nxt;
                    __syncthreads();
                    const int task = *qw;
                    if (task >= 1024) break;
                    if (F.tid == 0) nxt = (int)atomicAdd(qctr, 1u);
                    if (task < 512) { if (sub & 4) attn_block<false>(F, l, task); } else if (sub & 8) attn_block<true>(F, l, task - 512);
                }
            }
            SEAM(pb + P_MIX2);
        }
        if (EN(4) && IN(pb + P_MIX3)) { PH_BEGIN();
            if (sub & 1) for (int unit = F.bid; unit < 2048; unit += F.G) gla_out2(F, l, unit);
            if (sub & 2) for (int unit = F.bid * 8 + F.wave; unit < 2048; unit += F.G * 8) rwkv_r3_task(F, l, unit);
            SEAM(pb + P_MIX3);
        }
        if (EN(5) && IN(pb + P_OUTPROJ)) { PH_BEGIN();
            __syncthreads();
            pg8::Gemm g{MIXB, (const bf16_t*)(F.ws + WS_WOUT), DM, nullptr}; pg8::StaticOrder S; S.init(NTOK, DM, F.G, F.bid);
            if (l == 0) { pg8::EpiResidB<true> E{INF(F, I_X), XBUF, DM}; pg8::gemm_phase<pg8::EpiResidB<true>, pg8::StaticOrder, false>(F.tid, F.lds, g, S, E); }
            else { pg8::EpiResidB<false> E{XBUF, XBUF, DM}; pg8::gemm_phase<pg8::EpiResidB<false>, pg8::StaticOrder, false>(F.tid, F.lds, g, S, E); }
            SEAM(pb + P_OUTPROJ);
        }
        if (EN(6) && IN(pb + P_NORM2)) { PH_BEGIN();
            if (moe) phase_norm<1, false>(F, XBUF, INF(F, I_FFN_NORM) + l * DM, false, ms);
            else phase_norm<0, false>(F, XBUF, INF(F, I_FFN_NORM) + l * DM, false, 0);
            SEAM(pb + P_NORM2);
        }
        if (EN(7) && IN(pb + P_MAP)) { PH_BEGIN();
            if (moe) { phase_moe_map(F, ms); SEAM(pb + P_MAP); }
        }
        if (EN(8) && IN(pb + P_UP)) { PH_BEGIN();
            __syncthreads();
            if (!moe) {
                pg8::Gemm g{HB, (const bf16_t*)(F.ws + WS_W13), DM / 2, nullptr}; pg8::StaticOrder S; S.init(NTOK, 2 * D_FF, F.G, F.bid);
                pg8::EpiSwiglu8 E{(unsigned char*)ACT, D_FF, 0.015625f};
                pg8::gemm_phase<pg8::EpiSwiglu8, pg8::StaticOrder, false, true>(F.tid, F.lds, g, S, E);
            } else {
                pg8::MoeOrder S; moe_bases(F.ctl + CW_MOECNT + 64 * ms, S.tb); S.ntiles = S.tb[8]; S.nNe = 2 * D_FFE / 256; S.G = F.G; S.c = F.bid;
                pg8::Gemm g{HB, (const bf16_t*)(F.ws + WS_W13), DM / 2, (const int*)(F.ws + WS_ROWMAP)};
                pg8::EpiSwiglu8 E{(unsigned char*)ACT, KP8, 0.015625f};
                pg8::gemm_phase<pg8::EpiSwiglu8, pg8::MoeOrder, true, true>(F.tid, F.lds, g, S, E);
            }
            SEAM(pb + P_UP);
        }
        if (EN(9) && IN(pb + P_DOWN)) { PH_BEGIN();
            __syncthreads();
            if (!moe) {
                pg8::Gemm g{ACT, (const bf16_t*)(F.ws + WS_W2), D_FF / 2, nullptr}; pg8::StaticOrder S; S.init(NTOK, DM, F.G, F.bid);
                pg8::EpiResidB<false> E{XBUF, XBUF, DM, 0.015625f};
                pg8::gemm_phase<pg8::EpiResidB<false>, pg8::StaticOrder, false, true>(F.tid, F.lds, g, S, E);
            } else {
                pg8::MoeOrder S; moe_bases(F.ctl + CW_MOECNT + 64 * ms, S.tb); S.ntiles = S.tb[8]; S.nNe = DM / 256; S.G = F.G; S.c = F.bid;
                pg8::Gemm g{ACT, (const bf16_t*)(F.ws + WS_W2), KP8 / 2, nullptr};
                pg8::EpiBf16 E{(bf16_t*)(F.ws + WS_Y), DM, 0.015625f};
                pg8::gemm_phase<pg8::EpiBf16, pg8::MoeOrder, false, true>(F.tid, F.lds, g, S, E);
            }
            SEAM(pb + P_DOWN);
        }
        }
    if (EN(10) && IN(PH_FINAL)) { PH_BEGIN();
        __syncthreads();
        phase_norm<2, false>(F, XBUF, INF(F, I_FINAL_NORM), true, 0);
        SEAM(PH_FINAL);
    }
    if (EN(10) && IN(PH_FINAL + 1)) { PH_BEGIN(); phase_final_copy(F); }
#undef IN
#undef XBUF
#undef HB
#undef PROJ
#undef MIXB
#undef ACT
#undef PH_BEGIN
#undef SEAM
}

extern "C" void kernel_launch(void* const* d_in, const int* in_sizes, int n_in, void* d_out, int out_size, void* d_ws, size_t ws_size, hipStream_t stream) {
    static int ready = 0;
    if (ready == 0) {
        if (n_in != N_IN || in_sizes[0] != NTOK * DM || out_size != NTOK * DM || ws_size < WS_END) {
            fprintf(stderr, "kernel_launch: unexpected shapes (n_in %d, in0 %d, out %d, ws %zu); nothing launched\n", n_in, n_in > 0 ? in_sizes[0] : -1, out_size, ws_size); ready = -1; return; }
        if (hipFuncSetAttribute((const void*)fwd_kernel, hipFuncAttributeMaxDynamicSharedMemorySize, LDS_BYTES) != hipSuccess) { fprintf(stderr, "kernel_launch: hipFuncSetAttribute failed\n"); ready = -1; return; }
        int per_cu = 0;
        if (hipOccupancyMaxActiveBlocksPerMultiprocessor(&per_cu, (const void*)fwd_kernel, 512, LDS_BYTES) != hipSuccess || per_cu < 1)
            fprintf(stderr, "kernel_launch: note: occupancy query reports %d workgroups per CU\n", per_cu);
        (void)hipGetLastError();
        ready = 1;
    }
    if (ready < 0) return;
    const int grid = 256;
    if (hipMemsetAsync((char*)d_ws + WS_CTL, 0, CTL_ZERO_BYTES, stream) != hipSuccess) { fprintf(stderr, "kernel_launch: memset failed\n"); return; }
    Args a{};
    for (int i = 0; i < N_IN; ++i) a.in[i] = d_in[i];
    a.out = (float*)d_out; a.ws = (unsigned char*)d_ws; a.sub = 0xF;
#if N_LAUNCHES_ONE
    a.ph_lo = 0; a.ph_hi = PH_END;
    hipLaunchKernelGGL(fwd_kernel, dim3(grid), dim3(512), LDS_BYTES, stream, a);
#else
    for (int p = 0; p < PH_END; ++p) {
        if (p < PH_FINAL && (p % PH_PER_LAYER) == P_MAP && (((p / PH_PER_LAYER) & 1) == 0)) continue;
        a.ph_lo = p; a.ph_hi = p + 1; a.sub = 0xF;
        hipLaunchKernelGGL(fwd_kernel, dim3(grid), dim3(512), LDS_BYTES, stream, a);
#if defined(PROBE_PHASE)
        if (p < PH_FINAL && (p % PH_PER_LAYER) == PROBE_PHASE && ((PROBE_LMASK >> (p / PH_PER_LAYER)) & 1)) { a.sub = PROBE_SUB; hipLaunchKernelGGL(fwd_kernel, dim3(grid), dim3(512), LDS_BYTES, stream, a); }
#endif
    }
#endif
    const hipError_t le = hipPeekAtLastError();
    if (le != hipSuccess) fprintf(stderr, "kernel_launch: launch failed: %s\n", hipGetErrorName(le));
}
```

```cpp
#include <hip/hip_runtime.h>
#include <cstdio>
#include <cstdint>

#define LAS __attribute__((address_space(3)))
#define GAS __attribute__((address_space(1)))
typedef unsigned short bf16_t;
typedef short bf16x8 __attribute__((ext_vector_type(8)));
typedef float f32x4 __attribute__((ext_vector_type(4)));
typedef float f32x2 __attribute__((ext_vector_type(2)));
typedef unsigned u32x4 __attribute__((ext_vector_type(4)));
typedef unsigned u32x2 __attribute__((ext_vector_type(2)));

#ifndef N_LAUNCHES_ONE
#define N_LAUNCHES_ONE 1
#endif

constexpr int BATCH = 8, SEQ = 4096, DM = 1024, NTOK = BATCH * SEQ, DEPTH = 4;
constexpr int IN_COLS = 3088, NPROJ = 3328;
constexpr int D_FF = 2816, N_EXP = 8, D_FFE = 1408;
constexpr int KP8 = 1536;
constexpr int PA_Q = 0, PA_K = 256, PA_V = 384;
constexpr int PB_Q = 512, PB_K = 640, PB_V = 768, PB_G = 1024;
constexpr int PC_Q = 1280, PC_K = 1536, PC_V = 1792;
constexpr int PD = 2048;
constexpr int PB_LR = 3072;
constexpr float NORM_EPS = 1e-6f;
constexpr int MOE_ROWS = NTOK * 2 + N_EXP * 256;

constexpr size_t MiB = 1u << 20;
constexpr size_t WS_CTL = 0, CTL_ZERO_BYTES = 1 * MiB;
constexpr size_t WS_ROPE_C = 2 * MiB, WS_ROPE_S = 6 * MiB;
constexpr size_t WS_WIN = 10 * MiB, WS_WOUT = 17 * MiB, WS_W13 = 19 * MiB, WS_W2 = 63 * MiB;
constexpr size_t WS_H = 86 * MiB;
constexpr size_t WS_PROJ = 150 * MiB;
constexpr size_t WS_MIX = 358 * MiB;
constexpr size_t WS_SCR = 422 * MiB;
constexpr size_t WS_RWM = WS_H;
constexpr size_t WS_RW_V = WS_SCR, WS_RW_G = WS_SCR + 16 * MiB, WS_RW_S = WS_SCR + 32 * MiB;
constexpr size_t WS_GLA_KV = 470 * MiB, WS_GLA_DEC = 1 * MiB;
constexpr size_t WS_RKR = 486 * MiB;
constexpr size_t WS_RW_X = 488 * MiB;
constexpr size_t WS_SMALLW = 85 * MiB;
constexpr size_t WS_YRAW = 488 * MiB;
constexpr size_t WS_Y = 358 * MiB;
constexpr size_t WS_TOK_E = 520 * MiB, WS_TOK_G = WS_TOK_E + 256 * 1024, WS_TOK_SLOT = WS_TOK_G + 256 * 1024, WS_TOK_ROW = WS_TOK_SLOT + 256 * 1024, WS_ROWMAP = 521 * MiB;
constexpr size_t WS_END = 522 * MiB;
static_assert(WS_Y + (size_t)MOE_ROWS * 2048 <= WS_TOK_E && WS_YRAW + (size_t)NTOK * 256 * 4 <= WS_TOK_E && WS_W2 + 22 * MiB <= WS_H, "ws map");
constexpr int CW_BAR = 4096;
constexpr int CW_ATTNQ = 12288;
constexpr int CW_MOECNT = 8192;

constexpr size_t XB_OFF = 64 * MiB;
constexpr int LDS_BYTES = 147456;
constexpr int MISC_OFF = 131072 + 8192;

__device__ __forceinline__ float bf2f(unsigned short u) { return __uint_as_float((unsigned)u << 16); }
__device__ __forceinline__ float bflo(unsigned w) { return __uint_as_float(w << 16); }
__device__ __forceinline__ float bfhi(unsigned w) { return __uint_as_float(w & 0xffff0000u); }
__device__ __forceinline__ unsigned short f2bf(float f) { unsigned u = __float_as_uint(f); return (unsigned short)((u + 0x7fffu + ((u >> 16) & 1u)) >> 16); }
__device__ __forceinline__ unsigned pk2(float lo, float hi) { return (unsigned)f2bf(lo) | ((unsigned)f2bf(hi) << 16); }
__device__ __forceinline__ float wave_sum(float v) {
#pragma unroll
    for (int o = 1; o < 64; o <<= 1) v += __shfl_xor(v, o);
    return v;
}
__device__ __forceinline__ float sigmoid_f(float x) { return 1.f / (1.f + __expf(-x)); }
__device__ __forceinline__ float softplus_f(float z) { return fmaxf(z, 0.f) + __logf(1.f + __expf(-fabsf(z))); }
__device__ __forceinline__ float logsigmoid_f(float x) { return fminf(x, 0.f) - __logf(1.f + __expf(-fabsf(x))); }
namespace pg8 {
constexpr int BM = 256, BK = 64, HALF = 128, HTB = HALF * BK * 2  , STAGE_BYTES = 8 * HTB, NXCD = 8, WGM = 8;

__host__ __device__ __forceinline__ int lds_byte(int r, int c) { const int st = (r >> 4) * 2 + (c >> 5), rr = r & 15, cc = c & 31, ob = rr * 64 + cc * 2; return st * 1024 + (ob ^ (((ob >> 9) & 1) << 5)); }
__host__ __device__ __forceinline__ void stage_rc(int b, int& R, int& C) { const int st = b / 1024, sb = b % 1024, swz = sb ^ (((sb >> 9) & 1) << 5); R = (st >> 1) * 16 + swz / 64; C = (st & 1) * 32 + (swz % 64) / 2; }
__host__ __device__ __forceinline__ int perm32(int rho) { const int n = rho >> 4, i = rho & 15; return 8 * (i >> 2) + 4 * n + (i & 3); }

struct Unit { int pm, pn, pc; };
struct Gemm { const bf16_t* A; const bf16_t* Bt; int K; const int* rowmap; };

struct StaticOrder {
    int nM, nN, nwg, G, c;
    __device__ void init(int M, int N, int G_, int c_) { nM = M / BM; nN = N / BM; nwg = nM * nN; G = G_; c = c_; }
    __device__ bool next(int i, Unit& u) const {
        const long L = (long)i * G + c; if (L >= nwg) return false;
        int wgid = (int)L; { const int q = nwg / NXCD, r = nwg % NXCD, xcd = wgid % NXCD, off = wgid / NXCD; wgid = (xcd < r ? xcd * (q + 1) : r * (q + 1) + (xcd - r) * q) + off; }
        const int nig = WGM * nN, gid = wgid / nig, fm = gid * WGM, gsz = (nM - fm) < WGM ? (nM - fm) : WGM;
        u.pm = fm + ((wgid % nig) % gsz); u.pn = (wgid % nig) / gsz; u.pc = u.pn; return true;
    }
};
struct MoeOrder {
    int ntiles, nNe, G, c; int tb[9];
    __device__ bool next(int i, Unit& u) const {
        const long L = (long)i * G + c; if (L >= (long)ntiles * nNe) return false;
        const int pm = (int)(L / nNe), pl = (int)(L % nNe); int e = 0;
#pragma unroll
        for (int j = 1; j < 8; ++j) e += (pm >= tb[j]) ? 1 : 0;
        u.pm = pm; u.pn = e * nNe + pl; u.pc = pl; return true;
    }
};

typedef __bf16 bf16pair_t __attribute__((ext_vector_type(2)));
__device__ __forceinline__ unsigned cvt_pk_c(float lo, float hi) { bf16pair_t v; v[0] = (__bf16)lo; v[1] = (__bf16)hi; return __builtin_bit_cast(unsigned, v); }
__device__ __forceinline__ unsigned cvt_pk_bf16(float lo, float hi) { unsigned r; asm volatile("v_cvt_pk_bf16_f32 %0, %1, %2" : "=v"(r) : "v"(lo), "v"(hi)); return r; }

struct EpiBf16 {
    static constexpr bool PERM = true;
    bf16_t* O; int ldc; float sc = 1.f;
    __device__ __forceinline__ void operator()(const f32x4 (&acc)[2][2][4][2], const Unit& u, int wr, int wc, int fr, int fq) const {
        const int row0 = u.pm * BM + wr * 64 + fr; const int col0 = u.pc * BM + wc * 32 + 8 * fq;
#pragma unroll
        for (int ai = 0; ai < 2; ++ai)
#pragma unroll
            for (int m = 0; m < 4; ++m) { bf16_t* rowp = O + (size_t)(row0 + ai * HALF + m * 16) * ldc + col0;
#pragma unroll
                for (int bj = 0; bj < 2; ++bj) { const f32x4 v0 = acc[ai][bj][m][0] * sc, v1 = acc[ai][bj][m][1] * sc;
                    u32x4 w; w.x = cvt_pk_bf16(v0[0], v0[1]); w.y = cvt_pk_bf16(v0[2], v0[3]); w.z = cvt_pk_bf16(v1[0], v1[1]); w.w = cvt_pk_bf16(v1[2], v1[3]);
                    *(u32x4*)(rowp + bj * HALF) = w; } }
    }
};
struct EpiSwiglu {
    static constexpr bool PERM = true;
    bf16_t* O; int ldc; float sc;
    __device__ __forceinline__ void operator()(const f32x4 (&acc)[2][2][4][2], const Unit& u, int wr, int wc, int fr, int fq) const {
        const int row0 = u.pm * BM + wr * 64 + fr; const int col0 = u.pc * HALF + wc * 32 + 8 * fq;
#pragma unroll
        for (int ai = 0; ai < 2; ++ai)
#pragma unroll
            for (int m = 0; m < 4; ++m) { bf16_t* rowp = O + (size_t)(row0 + ai * HALF + m * 16) * ldc + col0;
                float r[8];
#pragma unroll
                for (int n = 0; n < 2; ++n)
#pragma unroll
                    for (int j = 0; j < 4; ++j) { const float g = acc[ai][0][m][n][j] * sc, up = acc[ai][1][m][n][j] * sc; r[n * 4 + j] = g * __builtin_amdgcn_rcpf(1.f + __expf(-g)) * up; }
                u32x4 w; w.x = cvt_pk_bf16(r[0], r[1]); w.y = cvt_pk_bf16(r[2], r[3]); w.z = cvt_pk_bf16(r[4], r[5]); w.w = cvt_pk_bf16(r[6], r[7]);
                *(u32x4*)rowp = w; }
    }
};
__device__ __forceinline__ unsigned pk4_fp8c(float a, float b, float c, float d) { unsigned w = 0u;
    a = __builtin_fminf(__builtin_fmaxf(a, -448.f), 448.f); b = __builtin_fminf(__builtin_fmaxf(b, -448.f), 448.f); c = __builtin_fminf(__builtin_fmaxf(c, -448.f), 448.f); d = __builtin_fminf(__builtin_fmaxf(d, -448.f), 448.f);
    w = __builtin_amdgcn_cvt_pk_fp8_f32(a, b, w, false); w = __builtin_amdgcn_cvt_pk_fp8_f32(c, d, w, true); return w; }
struct EpiSwiglu8 {
    static constexpr bool PERM = true;
    unsigned char* O8; int ldc; float sc;
    __device__ __forceinline__ void operator()(const f32x4 (&acc)[2][2][4][2], const Unit& u, int wr, int wc, int fr, int fq) const {
        const int row0 = u.pm * BM + wr * 64 + fr; const int col0 = u.pc * HALF + wc * 32 + 8 * fq;
#pragma unroll
        for (int ai = 0; ai < 2; ++ai)
#pragma unroll
            for (int m = 0; m < 4; ++m) { unsigned char* rowp = O8 + (size_t)(row0 + ai * HALF + m * 16) * ldc + col0;
                float r[8];
#pragma unroll
                for (int n = 0; n < 2; ++n)
#pragma unroll
                    for (int j = 0; j < 4; ++j) { const float g = acc[ai][0][m][n][j] * sc, up = acc[ai][1][m][n][j] * sc; r[n * 4 + j] = g * __builtin_amdgcn_rcpf(1.f + __expf(-g)) * up; }
                u32x2 w; w.x = pk4_fp8c(r[0], r[1], r[2], r[3]); w.y = pk4_fp8c(r[4], r[5], r[6], r[7]);
                *(u32x2*)rowp = w; }
    }
};
template <bool BASE_F32> struct EpiResidB {
    static constexpr bool PERM = true;
    const void* base; bf16_t* out; int ldc; float sc = 1.f;
    __device__ __forceinline__ void operator()(const f32x4 (&acc)[2][2][4][2], const Unit& u, int wr, int wc, int fr, int fq) const {
        const int row0 = u.pm * BM + wr * 64 + fr; const int col0 = u.pc * BM + wc * 32 + 8 * fq;
#pragma unroll
        for (int ai = 0; ai < 2; ++ai)
#pragma unroll
            for (int m = 0; m < 4; ++m) { const size_t off = (size_t)(row0 + ai * HALF + m * 16) * ldc + col0;
#pragma unroll
                for (int bj = 0; bj < 2; ++bj) { f32x4 v0 = acc[ai][bj][m][0] * sc, v1 = acc[ai][bj][m][1] * sc;
                    if (BASE_F32) { const float* bp = (const float*)base + off + bj * HALF; v0 += *(const f32x4*)bp; v1 += *(const f32x4*)(bp + 4); }
                    else { const u32x4 w = *(const u32x4*)((const bf16_t*)base + off + bj * HALF);
                        v0[0] += __uint_as_float(w.x << 16); v0[1] += __uint_as_float(w.x & 0xffff0000u); v0[2] += __uint_as_float(w.y << 16); v0[3] += __uint_as_float(w.y & 0xffff0000u);
                        v1[0] += __uint_as_float(w.z << 16); v1[1] += __uint_as_float(w.z & 0xffff0000u); v1[2] += __uint_as_float(w.w << 16); v1[3] += __uint_as_float(w.w & 0xffff0000u); }
                    u32x4 o; o.x = cvt_pk_bf16(v0[0], v0[1]); o.y = cvt_pk_bf16(v0[2], v0[3]); o.z = cvt_pk_bf16(v1[0], v1[1]); o.w = cvt_pk_bf16(v1[2], v1[3]);
                    *(u32x4*)(out + off + bj * HALF) = o; } }
    }
};

typedef int i32x8 __attribute__((ext_vector_type(8)));
typedef int i32x4g __attribute__((ext_vector_type(4)));
__device__ __forceinline__ i32x8 cat8(const bf16x8 a, const bf16x8 b) { return __builtin_shufflevector(__builtin_bit_cast(i32x4g, a), __builtin_bit_cast(i32x4g, b), 0, 1, 2, 3, 4, 5, 6, 7); }
template <class Epi, class Sched, bool GATHER, bool F8 = false>
__device__ __forceinline__ void gemm_phase(const int tid, LAS unsigned char* lds, const Gemm g, const Sched& S, const Epi& E) {
    const int wid = __builtin_amdgcn_readfirstlane(tid >> 6), lane = tid & 63, wr = wid >> 2, wc = wid & 3, fr = lane & 15, fq = lane >> 4;
    const int K = g.K, nt = K / BK;
    unsigned voffA, voffB;
    { int R, C; stage_rc(tid * 16, R, C); const int Rb = Epi::PERM ? ((R & ~31) + perm32(R & 31)) : R; voffA = (unsigned)(R * K + C) * 2u; voffB = (unsigned)(Rb * K + C) * 2u; }
    const size_t kstep = (size_t)(BK * 2);
    const size_t hstep = (size_t)HALF * K * 2;
    const size_t tstep = 2 * hstep;
    const unsigned ldsw = (unsigned)wid * 1024u;
    const int aoff = lds_byte(wr * 64 + fr, fq * 8), boff = lds_byte(wc * 32 + fr, fq * 8);
#define PG8_SA(b, h) (((b) * 2 + (h)) * HTB)
#define PG8_SB(b, h) ((4 + (b) * 2 + (h)) * HTB)
#define PG8_STAGE2(bufoff, gbase, v0, v1) do { _Pragma("unroll") for (int _i = 0; _i < 2; ++_i) { unsigned _v = _i ? (v1) : (v0); asm volatile("" : "+v"(_v)); \
        __builtin_amdgcn_global_load_lds((const unsigned*)((const char*)(gbase) + _v), (LAS unsigned*)(lds + (bufoff) + ldsw + _i * 8192), 16, 0, 0); } } while (0)
#define PG8_STAGE(bufoff, gbase, voff) PG8_STAGE2(bufoff, gbase, (voff), (voff) + (unsigned)(128 * K))
#define PG8_STAGE_A(bufoff, kb, h, nx) do { if constexpr (GATHER) { PG8_STAGE2(bufoff, (const char*)g.A + (kb), offC[h][0], offC[h][1]); }   \
        else { PG8_STAGE(bufoff, ((nx) ? nA : cA) + (kb) + (h) * hstep, voffA); } } while (0)
#define PG8_LDA(dst, b, h) do { _Pragma("unroll") for (int m = 0; m < 4; ++m) _Pragma("unroll") for (int k = 0; k < 2; ++k) dst[m][k] = *(const LAS bf16x8*)(lds + PG8_SA(b, h) + aoff + m * 2048 + k * 1024); } while (0)
#define PG8_LDB(dst, b, h) do { _Pragma("unroll") for (int n = 0; n < 2; ++n) _Pragma("unroll") for (int k = 0; k < 2; ++k) dst[n][k] = *(const LAS bf16x8*)(lds + PG8_SB(b, h) + boff + n * 2048 + k * 1024); } while (0)
#define PG8_MMA(ai, bj, At, Bt) do { __builtin_amdgcn_s_setprio(1); _Pragma("unroll") for (int m = 0; m < 4; ++m) _Pragma("unroll") for (int n = 0; n < 2; ++n) { \
        if constexpr (F8) acc[ai][bj][m][n] = __builtin_amdgcn_mfma_scale_f32_16x16x128_f8f6f4(cat8(Bt[n][0], Bt[n][1]), cat8(At[m][0], At[m][1]), acc[ai][bj][m][n], 0, 0, 0, 0, 0, 0);   \
        else { _Pragma("unroll") for (int k = 0; k < 2; ++k) acc[ai][bj][m][n] = __builtin_amdgcn_mfma_f32_16x16x32_bf16(Bt[n][k], At[m][k], acc[ai][bj][m][n], 0, 0, 0); } } __builtin_amdgcn_s_setprio(0); } while (0)
#define PG8_WAIT_V(n) asm volatile("s_waitcnt vmcnt(" #n ")" ::: "memory")
#define PG8_WAIT_L(n) asm volatile("s_waitcnt lgkmcnt(" #n ")" ::: "memory")
#define PG8_BAR __builtin_amdgcn_s_barrier()
#define PG8_SCHED __builtin_amdgcn_sched_barrier(0)
#define PG8_LOADOFF(dst, u) do { _Pragma("unroll") for (int _h = 0; _h < 2; ++_h) _Pragma("unroll") for (int _i = 0; _i < 2; ++_i) { \
        int _R, _C; { int _t = tid; asm volatile("" : "+v"(_t)); stage_rc(_t * 16, _R, _C); } const int _row = g.rowmap[(u).pm * BM + _h * HALF + _R + 64 * _i]; dst[_h][_i] = (unsigned)(_row * K + _C) * 2u; } } while (0)
    Unit cur, nxt; int ui = 0;
    if (!S.next(0, cur)) return;
    f32x4 acc[2][2][4][2];
#pragma unroll
    for (int a = 0; a < 2; ++a)
#pragma unroll
        for (int b = 0; b < 2; ++b)
#pragma unroll
            for (int m = 0; m < 4; ++m)
#pragma unroll
                for (int n = 0; n < 2; ++n) acc[a][b][m][n] = (f32x4){0.f, 0.f, 0.f, 0.f};
    bf16x8 At[4][2], B0[2][2], B1[2][2];
    unsigned offC[2][2] = {{0u, 0u}, {0u, 0u}};
    LAS u32x4* offslot = (LAS u32x4*)(lds + STAGE_BYTES) + tid;
    const char* cA = (const char*)g.A + (GATHER ? (size_t)0 : (size_t)cur.pm * tstep); const char* cB = (const char*)g.Bt + (size_t)cur.pn * tstep;
    const char* nA = cA;
    if constexpr (GATHER) { PG8_LOADOFF(offC, cur); }
    PG8_STAGE(PG8_SB(0, 0), cB, voffB); PG8_STAGE(PG8_SB(0, 1), cB + hstep, voffB); PG8_STAGE_A(PG8_SA(0, 0), 0, 0, false); PG8_STAGE_A(PG8_SA(0, 1), 0, 1, false);
    if (wr == 1) PG8_BAR;
    PG8_WAIT_V(2); PG8_BAR;
    PG8_STAGE(PG8_SB(1, 0), cB + kstep, voffB); PG8_STAGE_A(PG8_SA(1, 0), kstep, 0, false); PG8_STAGE(PG8_SB(1, 1), cB + hstep + kstep, voffB);
    PG8_WAIT_V(6); PG8_BAR;
    for (;;) {
        const bool has_next = S.next(ui + 1, nxt);
        nA = has_next ? (const char*)g.A + (GATHER ? (size_t)0 : (size_t)nxt.pm * tstep) : cA; const char* nB = has_next ? (const char*)g.Bt + (size_t)nxt.pn * tstep : cB;
        if constexpr (GATHER) { unsigned offN[2][2];
            if (has_next) { PG8_LOADOFF(offN, nxt); } else {
#pragma unroll
                for (int h = 0; h < 2; ++h) { offN[h][0] = offC[h][0]; offN[h][1] = offC[h][1]; } }
            *offslot = (u32x4){offN[0][0], offN[0][1], offN[1][0], offN[1][1]}; }
#pragma unroll 1
        for (int t = 0; t < nt; t += 2) {
            const bool last = (t == nt - 2);
            const size_t k1 = (size_t)(t + 1) * kstep;
            const size_t k2 = last ? (size_t)0 : (size_t)(t + 2) * kstep, k3 = k2 + kstep;
            const char* b2 = last ? nB : cB + (size_t)(t + 2) * kstep; const char* b3 = b2 + kstep;
            PG8_LDB(B0, 0, 0); PG8_LDB(B1, 0, 1); PG8_SCHED; PG8_LDA(At, 0, 0); PG8_STAGE_A(PG8_SA(1, 1), k1, 1, false);
            if constexpr (GATHER) { if (last) { const u32x4 o_ = *offslot; offC[0][0] = o_.x; offC[0][1] = o_.y; offC[1][0] = o_.z; offC[1][1] = o_.w; } }
            PG8_WAIT_V(8); PG8_WAIT_L(0); PG8_BAR; PG8_MMA(0, 0, At, B0); PG8_MMA(0, 1, At, B1); PG8_BAR; PG8_SCHED;
            PG8_LDA(At, 0, 1); PG8_STAGE(PG8_SB(0, 0), b2, voffB); PG8_STAGE(PG8_SB(0, 1), b2 + hstep, voffB); PG8_STAGE_A(PG8_SA(0, 0), k2, 0, last);
            PG8_WAIT_V(8); PG8_WAIT_L(0); PG8_BAR; PG8_MMA(1, 0, At, B0); PG8_MMA(1, 1, At, B1); PG8_BAR; PG8_SCHED;
            PG8_LDB(B0, 1, 0); PG8_LDB(B1, 1, 1); PG8_SCHED; PG8_LDA(At, 1, 0); PG8_STAGE_A(PG8_SA(0, 1), k2, 1, last);
            PG8_WAIT_V(8); PG8_WAIT_L(0); PG8_BAR; PG8_MMA(0, 0, At, B0); PG8_MMA(0, 1, At, B1); PG8_BAR; PG8_SCHED;
            PG8_LDA(At, 1, 1); PG8_STAGE(PG8_SB(1, 0), b3, voffB); PG8_STAGE(PG8_SB(1, 1), b3 + hstep, voffB); PG8_STAGE_A(PG8_SA(1, 0), k3, 0, last);
            PG8_WAIT_V(8); PG8_WAIT_L(0); PG8_BAR; PG8_MMA(1, 0, At, B0); PG8_MMA(1, 1, At, B1); PG8_BAR; PG8_SCHED;
        }
        if (wr == 0) PG8_BAR;
        asm volatile("s_nop 15\n\ts_nop 15" ::: "memory");
        { unsigned m_ = ~0u; asm volatile("" : "+s"(m_)); const int ln_ = (int)__builtin_amdgcn_mbcnt_hi(m_, __builtin_amdgcn_mbcnt_lo(m_, 0u));
          E(acc, cur, wr, wc, ln_ & 15, ln_ >> 4); }
        if (!has_next) break;
#pragma unroll
        for (int a = 0; a < 2; ++a)
#pragma unroll
            for (int b = 0; b < 2; ++b)
#pragma unroll
                for (int m = 0; m < 4; ++m)
#pragma unroll
                    for (int n = 0; n < 2; ++n) acc[a][b][m][n] = (f32x4){0.f, 0.f, 0.f, 0.f};
        cur = nxt; cA = nA; cB = nB; ++ui;
        if (wr == 1) PG8_BAR;
    }
    PG8_WAIT_V(0);
    PG8_BAR;
#undef PG8_SA
#undef PG8_SB
#undef PG8_STAGE
#undef PG8_STAGE2
#undef PG8_STAGE_A
#undef PG8_LDA
#undef PG8_LDB
#undef PG8_MMA
#undef PG8_WAIT_V
#undef PG8_WAIT_L
#undef PG8_BAR
#undef PG8_SCHED
#undef PG8_LOADOFF
}
}
#define XB_TMO      128
#define XB_XCNT(j)  (256  + 64 * (j))
#define XB_XSUB(j)  (1280 + 64 * (j))
#define XB_XGEN(j)  (2304 + 64 * (j))
#define XB_TOP      3328
#define XB_TOPGEN   3392
#define XCD_BAR_WORDS 3456
#define XB_SPIN_CAP (1u << 18)

__device__ __forceinline__ unsigned xb_ld(unsigned* p)              { return __hip_atomic_load(p, __ATOMIC_RELAXED, __HIP_MEMORY_SCOPE_AGENT); }
__device__ __forceinline__ unsigned xb_add(unsigned* p, unsigned v) { return __hip_atomic_fetch_add(p, v, __ATOMIC_RELAXED, __HIP_MEMORY_SCOPE_AGENT); }
__device__ __forceinline__ unsigned xb_xcc_id() { return (unsigned)__builtin_amdgcn_s_getreg((3 << 11) | 20) & 0xFu; }
#define XB_SPIN(cond, bar) do { unsigned _sp = 0; while (cond) { __builtin_amdgcn_s_sleep(1); \
    if ((++_sp & 255u) == 0u) { if (xb_ld(&(bar)[XB_TMO])) break; if (_sp > XB_SPIN_CAP) { atomicAdd(&(bar)[XB_TMO], 1u); break; } } } } while (0)

struct XcdBarrier {
    unsigned* bar; unsigned x;
    volatile LAS unsigned* st;
};

__device__ __forceinline__ XcdBarrier xcd_barrier_post(unsigned* bar, volatile LAS unsigned* st) {
    XcdBarrier b; b.bar = bar; b.x = xb_xcc_id(); b.st = st;
    if (threadIdx.x == 0) (void)xb_add(&bar[XB_XCNT(b.x)], 1u);
    return b;
}
__device__ __forceinline__ void xcd_barrier_complete(unsigned* bar, unsigned x, unsigned& nloc, unsigned& nx) {
    const unsigned G = gridDim.x * gridDim.y * gridDim.z;
    unsigned sum, cnt, mine, sp = 0u;
    for (;;) {
        sum = 0u; cnt = 0u; mine = 0u;
#pragma unroll
        for (unsigned j = 0; j < 16; ++j) { const unsigned c = xb_ld(&bar[XB_XCNT(j)]); sum += c; cnt += (c > 0u) ? 1u : 0u; mine = (j == x) ? c : mine; }
        if (sum == G) break;
        __builtin_amdgcn_s_sleep(1);
        if ((++sp & 255u) == 0u) { if (xb_ld(&bar[XB_TMO])) break; if (sp > XB_SPIN_CAP) { atomicAdd(&bar[XB_TMO], 1u); break; } }
    }
    nloc = mine > 0u ? mine : 1u; nx = cnt > 0u ? cnt : 1u;
}

__device__ __forceinline__ void xcd_barrier(const XcdBarrier& b, const bool leader) {
    asm volatile("s_waitcnt vmcnt(0)" ::: "memory");
    __syncthreads();
    if (leader) {
        unsigned* bar = b.bar;
        __builtin_amdgcn_s_waitcnt(0);
        unsigned nloc = b.st[0], nx = b.st[1];
        if (nloc == 0u) { xcd_barrier_complete(bar, b.x, nloc, nx); b.st[0] = nloc; b.st[1] = nx; }
        const unsigned old = xb_add(&bar[XB_XSUB(b.x)], 1u);
        const unsigned gen = old / nloc;
        if (old + 1u == (gen + 1u) * nloc) {
            __builtin_amdgcn_fence(__ATOMIC_RELEASE, "agent");
            asm volatile("s_waitcnt vmcnt(0)" ::: "memory");
            const unsigned og = xb_add(&bar[XB_TOP], 1u);
            const unsigned tg = og / nx;
            if (og + 1u == (tg + 1u) * nx) xb_add(&bar[XB_TOPGEN], 1u);
            else XB_SPIN(xb_ld(&bar[XB_TOPGEN]) == tg, bar);
            __builtin_amdgcn_fence(__ATOMIC_ACQUIRE, "agent");
            xb_add(&bar[XB_XGEN(b.x)], 1u);
            asm volatile("s_waitcnt vmcnt(0)" ::: "memory");
        } else {
            XB_SPIN(xb_ld(&bar[XB_XGEN(b.x)]) == gen, bar);
            __builtin_amdgcn_fence(__ATOMIC_ACQUIRE, "agent");
            asm volatile("s_waitcnt vmcnt(0)" ::: "memory");
        }
    }
    __syncthreads();
}
struct Frame {
    LAS unsigned char* lds;
    unsigned* ctl;
    unsigned char* ws;
    int tid, lane, wave, bid, G;
    float* out;
};
enum InIdx { I_X = 0, I_POS, I_ATTN_NORM, I_W_IN, I_SINKS, I_SWA_ON, I_GLA_WA2, I_GLA_BA, I_GLA_ON, I_SB_ON, I_MU, I_W0, I_W2, I_A0, I_A2, I_G2, I_KK, I_KA, I_RK, I_LNW, I_LNB,
             I_W_OUT, I_FFN_NORM, I_FFN_W1, I_FFN_W3, I_FFN_W2, I_ROUTER, I_MOE_W1, I_MOE_W3, I_MOE_W2, I_FINAL_NORM, N_IN };
constexpr int PTR_OFF = MISC_OFF + 64;
__device__ __forceinline__ const void* in_ptr(const Frame& F, int i) {
    const unsigned long long v = ((const LAS unsigned long long*)(F.lds + PTR_OFF))[i];
    const unsigned lo = __builtin_amdgcn_readfirstlane((unsigned)v), hi = __builtin_amdgcn_readfirstlane((unsigned)(v >> 32));
    return (const void*)(GAS const void*)(((unsigned long long)hi << 32) | lo);
}
#define INF(F, i) ((const float*)in_ptr(F, i))

template <class Map>
__device__ __forceinline__ void transpose_item(const float* W, int K, int N, bf16_t* WT, const Map& dst, LAS float* scr, int item, int lane) {
    const int nblk = (N + 31) / 32, kb = item / nblk, nb = item % nblk, k0 = 64 * kb, n0 = 32 * nb;
    const int nl = n0 + (lane & 31);
#pragma unroll 8
    for (int i = 0; i < 32; ++i) { const int kk = 2 * i + (lane >> 5); scr[kk * 33 + (lane & 31)] = (nl < N) ? W[(size_t)(k0 + kk) * N + nl] : 0.f; }
    asm volatile("s_waitcnt lgkmcnt(0)" ::: "memory");
    const int c = lane & 7;
#pragma unroll
    for (int j = 0; j < 4; ++j) { const int n = (lane >> 3) + 8 * j; const LAS float* s = scr + (8 * c) * 33 + n;
        u32x4 o; o.x = pk2(s[0 * 33], s[1 * 33]); o.y = pk2(s[2 * 33], s[3 * 33]); o.z = pk2(s[4 * 33], s[5 * 33]); o.w = pk2(s[6 * 33], s[7 * 33]);
        if (n0 + n < N) *(u32x4*)(WT + (size_t)dst(n0 + n) * K + k0 + 8 * c) = o; }
    asm volatile("s_waitcnt lgkmcnt(0)" ::: "memory");
}
__device__ __forceinline__ unsigned pk4_fp8(float a, float b, float c, float d) { unsigned w = 0u; w = __builtin_amdgcn_cvt_pk_fp8_f32(a, b, w, false); w = __builtin_amdgcn_cvt_pk_fp8_f32(c, d, w, true); return w; }
template <class Map>
__device__ __forceinline__ void transpose_item8(const float* W, int K, int N, unsigned char* WT, const Map& dst, LAS float* scr, int item, int lane, int pitch = 0) {
    const int nblk = (N + 31) / 32, kb = item / nblk, nb = item % nblk, k0 = 64 * kb, n0 = 32 * nb;
    const int nl = n0 + (lane & 31);
#pragma unroll 8
    for (int i = 0; i < 32; ++i) { const int kk = 2 * i + (lane >> 5); scr[kk * 33 + (lane & 31)] = (nl < N) ? W[(size_t)(k0 + kk) * N + nl] * 64.f : 0.f; }
    asm volatile("s_waitcnt lgkmcnt(0)" ::: "memory");
    const int c = lane & 7;
#pragma unroll
    for (int j = 0; j < 4; ++j) { const int n = (lane >> 3) + 8 * j; const LAS float* s = scr + (8 * c) * 33 + n;
        u32x2 o; o.x = pk4_fp8(s[0 * 33], s[1 * 33], s[2 * 33], s[3 * 33]); o.y = pk4_fp8(s[4 * 33], s[5 * 33], s[6 * 33], s[7 * 33]);
        if (n0 + n < N) *(u32x2*)(WT + (size_t)dst(n0 + n) * (pitch ? pitch : K) + k0 + 8 * c) = o; }
    asm volatile("s_waitcnt lgkmcnt(0)" ::: "memory");
}
struct MapIn { __device__ int operator()(int n) const { return n < 1280 ? n : (n < 1296 ? 3072 + (n - 1280) : n - 16); } };
struct MapId { int off; __device__ int operator()(int n) const { return off + n; } };
struct MapGU { int off; __device__ int operator()(int n) const { return off + 256 * (n >> 7) + (n & 127); } };

__device__ __forceinline__ void phase_convert_weights(Frame& F, int l) {
    LAS float* scr = (LAS float*)(F.lds + F.wave * 16384);
    const int gw = F.bid * 8 + F.wave, NGW = F.G * 8;
    bf16_t* WIN = (bf16_t*)(F.ws + WS_WIN); bf16_t* WOUT = (bf16_t*)(F.ws + WS_WOUT); bf16_t* W13 = (bf16_t*)(F.ws + WS_W13); bf16_t* W2 = (bf16_t*)(F.ws + WS_W2);
    const bool moe = (l & 1) != 0; const int li = l >> 1;
    const int I_IN = (DM / 64) * ((IN_COLS + 31) / 32), I_OUT = (DM / 64) * (DM / 32);
    const int I_UP = moe ? (DM / 64) * (D_FFE / 32) : (DM / 64) * (D_FF / 32);
    const int I_DN = moe ? (D_FFE / 64) * (DM / 32) : (D_FF / 64) * (DM / 32);
    const int NE = moe ? N_EXP : 1;
    const int total = I_IN + I_OUT + NE * (2 * I_UP + I_DN);
    for (int it = gw; it < total; it += NGW) {
        int r = it;
        if (r < I_IN) { transpose_item(INF(F, I_W_IN) + (size_t)l * DM * IN_COLS, DM, IN_COLS, WIN, MapIn{}, scr, r, F.lane); continue; } r -= I_IN;
        if (r < I_OUT) { transpose_item(INF(F, I_W_OUT) + (size_t)l * DM * DM, DM, DM, WOUT, MapId{0}, scr, r, F.lane); continue; } r -= I_OUT;
        const int per_e = 2 * I_UP + I_DN, e = r / per_e; r -= e * per_e;
        if (!moe) {
            if (r < I_UP) { transpose_item8(INF(F, I_FFN_W1) + (size_t)li * DM * D_FF, DM, D_FF, (unsigned char*)W13, MapGU{0}, scr, r, F.lane); continue; } r -= I_UP;
            if (r < I_UP) { transpose_item8(INF(F, I_FFN_W3) + (size_t)li * DM * D_FF, DM, D_FF, (unsigned char*)W13, MapGU{128}, scr, r, F.lane); continue; } r -= I_UP;
            transpose_item8(INF(F, I_FFN_W2) + (size_t)li * D_FF * DM, D_FF, DM, (unsigned char*)W2, MapId{0}, scr, r, F.lane);
        } else {
            const size_t eo = (size_t)(li * N_EXP + e);
            if (r < I_UP) { transpose_item8(INF(F, I_MOE_W1) + eo * DM * D_FFE, DM, D_FFE, (unsigned char*)W13, MapGU{e * 2 * D_FFE}, scr, r, F.lane); continue; } r -= I_UP;
            if (r < I_UP) { transpose_item8(INF(F, I_MOE_W3) + eo * DM * D_FFE, DM, D_FFE, (unsigned char*)W13, MapGU{e * 2 * D_FFE + 128}, scr, r, F.lane); continue; } r -= I_UP;
            transpose_item8(INF(F, I_MOE_W2) + eo * D_FFE * DM, D_FFE, DM, (unsigned char*)W2, MapId{e * DM}, scr, r, F.lane, KP8);
        }
    }
    if (moe) {
        unsigned zz = 0u; asm volatile("" : "+v"(zz));
        for (int i = F.bid * 512 + F.tid; i < N_EXP * DM * ((KP8 - D_FFE) / 16); i += F.G * 512) { const int row = i >> 3, c = i & 7; *(u32x4*)((unsigned char*)W2 + (size_t)row * KP8 + D_FFE + 16 * c) = (u32x4){zz, zz, zz, zz}; }
    }
}

__device__ __forceinline__ void phase_rope_tables(Frame& F) {
    float* C = (float*)(F.ws + WS_ROPE_C); float* S = (float*)(F.ws + WS_ROPE_S); const int* pos = (const int*)in_ptr(F, I_POS);
    for (int idx = F.bid * 512 + F.tid; idx < NTOK * 32; idx += F.G * 512) {
        const int tok = idx >> 5, i = idx & 31;
        const float invf = exp2f(-(float)(2 * i) * (13.287712379549449f / 64.f));
        const float angf = (float)pos[tok] * invf;
        const double a = (double)angf;
        const double n = rint(a * 0.15915494309189535);
        const double r = a - n * 6.283185307179586;
        const double r2 = r * r;
        double s = -1.0 / 51090942171709440000.0;
        s = s * r2 + 1.0 / 121645100408832000.0;  s = s * r2 - 1.0 / 355687428096000.0; s = s * r2 + 1.0 / 1307674368000.0; s = s * r2 - 1.0 / 6227020800.0;
        s = s * r2 + 1.0 / 39916800.0; s = s * r2 - 1.0 / 362880.0; s = s * r2 + 1.0 / 5040.0; s = s * r2 - 1.0 / 120.0; s = s * r2 + 1.0 / 6.0; s = s * r2 - 1.0; s = -s * r;
        double c = 1.0 / 1124000727777607680000.0;
        c = c * r2 - 1.0 / 2432902008176640000.0; c = c * r2 + 1.0 / 6402373705728000.0; c = c * r2 - 1.0 / 20922789888000.0; c = c * r2 + 1.0 / 87178291200.0;
        c = c * r2 - 1.0 / 479001600.0; c = c * r2 + 1.0 / 3628800.0; c = c * r2 - 1.0 / 40320.0; c = c * r2 + 1.0 / 720.0; c = c * r2 - 1.0 / 24.0; c = c * r2 + 0.5; c = 1.0 - c * r2;
        C[idx] = (float)c; S[idx] = (float)s;
    }
}

template <int MODE, bool XF32>
__device__ __forceinline__ void phase_norm(Frame& F, const void* xin, const float* gain, bool comb, int moe_slot) {
    bf16_t* HB = (bf16_t*)(F.ws + WS_H); bf16_t* XB = (bf16_t*)((unsigned char*)F.out + XB_OFF);
    const bf16_t* Y = (const bf16_t*)(F.ws + WS_Y);
    const int* TOK_ROW = (const int*)(F.ws + WS_TOK_ROW); const float* TOK_G = (const float*)(F.ws + WS_TOK_G);
    LAS float* rts = (LAS float*)F.lds;
    LAS int* te = (LAS int*)(F.lds + 32768);
    LAS float* tg = (LAS float*)(F.lds + 32768 + 1024);
    LAS int* tl = (LAS int*)(F.lds + 32768 + 2048);
    LAS int* lcnt = (LAS int*)(F.lds + 32768 + 3072);
    if (MODE == 1) {
        const float* router = INF(F, I_ROUTER) + (size_t)moe_slot * DM * N_EXP;
        for (int i = F.tid; i < DM * N_EXP; i += 512) { const int c = i >> 3, e = i & 7; rts[e * DM + c] = router[i]; }
        if (F.tid < 16) lcnt[F.tid] = 0;
        __syncthreads();
    }
    f32x4 gv[2][2];
#pragma unroll
    for (int j = 0; j < 2; ++j) { gv[j][0] = *(const f32x4*)(gain + 8 * F.lane + 512 * j); gv[j][1] = *(const f32x4*)(gain + 8 * F.lane + 512 * j + 4); }
    for (int rr = 0; rr < 16; ++rr) {
        const int rloc = F.wave * 16 + rr; const int row = F.bid * 128 + rloc;
        if (row >= NTOK) break;
        float v[2][8];
#pragma unroll
        for (int j = 0; j < 2; ++j) {
            if (XF32) { const float* xr = (const float*)xin + (size_t)row * DM + 8 * F.lane + 512 * j; const f32x4 a = *(const f32x4*)xr, b = *(const f32x4*)(xr + 4);
                v[j][0] = a[0]; v[j][1] = a[1]; v[j][2] = a[2]; v[j][3] = a[3]; v[j][4] = b[0]; v[j][5] = b[1]; v[j][6] = b[2]; v[j][7] = b[3]; }
            else { const u32x4 w = *(const u32x4*)((const bf16_t*)xin + (size_t)row * DM + 8 * F.lane + 512 * j);
                v[j][0] = bflo(w.x); v[j][1] = bfhi(w.x); v[j][2] = bflo(w.y); v[j][3] = bfhi(w.y); v[j][4] = bflo(w.z); v[j][5] = bfhi(w.z); v[j][6] = bflo(w.w); v[j][7] = bfhi(w.w); } }
        if (comb) {
            const int r0 = TOK_ROW[row * 2], r1 = TOK_ROW[row * 2 + 1]; const float g0 = TOK_G[row * 2], g1 = TOK_G[row * 2 + 1];
#pragma unroll
            for (int j = 0; j < 2; ++j) {
                const u32x4 a = *(const u32x4*)(Y + (size_t)r0 * DM + 8 * F.lane + 512 * j), b = *(const u32x4*)(Y + (size_t)r1 * DM + 8 * F.lane + 512 * j);
                v[j][0] += g0 * bflo(a.x) + g1 * bflo(b.x); v[j][1] += g0 * bfhi(a.x) + g1 * bfhi(b.x); v[j][2] += g0 * bflo(a.y) + g1 * bflo(b.y); v[j][3] += g0 * bfhi(a.y) + g1 * bfhi(b.y);
                v[j][4] += g0 * bflo(a.z) + g1 * bflo(b.z); v[j][5] += g0 * bfhi(a.z) + g1 * bfhi(b.z); v[j][6] += g0 * bflo(a.w) + g1 * bflo(b.w); v[j][7] += g0 * bfhi(a.w) + g1 * bfhi(b.w);
                if (MODE != 2) { u32x4 o; o.x = pk2(v[j][0], v[j][1]); o.y = pk2(v[j][2], v[j][3]); o.z = pk2(v[j][4], v[j][5]); o.w = pk2(v[j][6], v[j][7]); *(u32x4*)(XB + (size_t)row * DM + 8 * F.lane + 512 * j) = o; }
            }
        }
        float ss = 0.f;
#pragma unroll
        for (int j = 0; j < 2; ++j)
#pragma unroll
            for (int i = 0; i < 8; ++i) ss += v[j][i] * v[j][i];
        const float rstd = rsqrtf(wave_sum(ss) * (1.f / DM) + NORM_EPS);
#pragma unroll
        for (int j = 0; j < 2; ++j)
#pragma unroll
            for (int i = 0; i < 8; ++i) v[j][i] = v[j][i] * rstd * gv[j][i >> 2][i & 3];
        if (MODE == 2) {
            float* dst = (row < NTOK / 2) ? F.out + (size_t)row * DM : (float*)(F.ws + WS_PROJ) + (size_t)(row - NTOK / 2) * DM;
#pragma unroll
            for (int j = 0; j < 2; ++j) { *(f32x4*)(dst + 8 * F.lane + 512 * j) = (f32x4){v[j][0], v[j][1], v[j][2], v[j][3]}; *(f32x4*)(dst + 8 * F.lane + 512 * j + 4) = (f32x4){v[j][4], v[j][5], v[j][6], v[j][7]}; }
        } else {
#pragma unroll
            for (int j = 0; j < 2; ++j) {
                if (MODE == 0 || MODE == 1) { u32x2 o; o.x = pk4_fp8(v[j][0], v[j][1], v[j][2], v[j][3]); o.y = pk4_fp8(v[j][4], v[j][5], v[j][6], v[j][7]); *(u32x2*)((unsigned char*)HB + (size_t)row * DM + 8 * F.lane + 512 * j) = o; }
                else { u32x4 o; o.x = pk2(v[j][0], v[j][1]); o.y = pk2(v[j][2], v[j][3]); o.z = pk2(v[j][4], v[j][5]); o.w = pk2(v[j][6], v[j][7]); *(u32x4*)(HB + (size_t)row * DM + 8 * F.lane + 512 * j) = o; } }
        }
        if (MODE == 1) {
            float lg[8];
#pragma unroll
            for (int e = 0; e < 8; ++e) { float a = 0.f;
#pragma unroll
                for (int j = 0; j < 2; ++j) { const f32x4 w0 = *(const LAS f32x4*)(rts + e * DM + 8 * F.lane + 512 * j), w1 = *(const LAS f32x4*)(rts + e * DM + 8 * F.lane + 512 * j + 4);
                    a += (v[j][0] * w0[0] + v[j][1] * w0[1]) + (v[j][2] * w0[2] + v[j][3] * w0[3]) + (v[j][4] * w1[0] + v[j][5] * w1[1]) + (v[j][6] * w1[2] + v[j][7] * w1[3]); }
                lg[e] = wave_sum(a); }
            int i0 = 0; float v0 = lg[0];
#pragma unroll
            for (int e = 1; e < 8; ++e) if (lg[e] > v0) { v0 = lg[e]; i0 = e; }
            int i1 = -1; float v1 = -3.0e38f;
#pragma unroll
            for (int e = 0; e < 8; ++e) if (e != i0 && lg[e] > v1) { v1 = lg[e]; i1 = e; }
            const float g0 = 1.f / (1.f + __expf(v1 - v0));
            if (F.lane == 0) { te[rloc * 2] = i0; te[rloc * 2 + 1] = i1; tg[rloc * 2] = g0; tg[rloc * 2 + 1] = 1.f - g0; }
        }
    }
    if (MODE == 1) {
        __syncthreads();
        int e = 0, li = 0;
        if (F.tid < 256) { e = te[F.tid]; li = atomicAdd((int*)&lcnt[e], 1); tl[F.tid] = li; }
        __syncthreads();
        if (F.tid < 8) lcnt[8 + F.tid] = (int)atomicAdd(F.ctl + CW_MOECNT + 64 * moe_slot + F.tid, (unsigned)lcnt[F.tid]);
        __syncthreads();
        if (F.tid < 256) {
            const int tok = F.bid * 128 + (F.tid >> 1), k = F.tid & 1;
            ((int*)(F.ws + WS_TOK_E))[tok * 2 + k] = e;
            ((int*)(F.ws + WS_TOK_SLOT))[tok * 2 + k] = lcnt[8 + e] + li;
            ((float*)(F.ws + WS_TOK_G))[tok * 2 + k] = tg[F.tid];
        }
    }
}
constexpr int NL_PITCH = 1032;
template <bool XF32, bool COMB>
__device__ __forceinline__ void phase_norm_lr(Frame& F, const void* xin, const float* gain, int l) {
    bf16_t* HB = (bf16_t*)(F.ws + WS_H); bf16_t* XB = (bf16_t*)((unsigned char*)F.out + XB_OFF); bf16_t* PROJ = (bf16_t*)(F.ws + WS_PROJ);
    const bf16_t* Y = (const bf16_t*)(F.ws + WS_Y);
    const int* TOK_ROW = (const int*)(F.ws + WS_TOK_ROW); const float* TOK_G = (const float*)(F.ws + WS_TOK_G);
    LAS bf16_t* WL = (LAS bf16_t*)F.lds;
    LAS float* GL = (LAS float*)(F.lds + 16 * NL_PITCH * 2);
    __syncthreads();
    { const float* wl = INF(F, I_W_IN) + (size_t)l * DM * IN_COLS + 1280;
#pragma unroll 1
      for (int c = F.tid; c < DM; c += 512) { const float* p = wl + (size_t)c * IN_COLS;
          const f32x4 a = *(const f32x4*)p, b = *(const f32x4*)(p + 4), cc = *(const f32x4*)(p + 8), d = *(const f32x4*)(p + 12);
#pragma unroll
          for (int j = 0; j < 4; ++j) { WL[j * NL_PITCH + c] = f2bf(a[j]); WL[(4 + j) * NL_PITCH + c] = f2bf(b[j]); WL[(8 + j) * NL_PITCH + c] = f2bf(cc[j]); WL[(12 + j) * NL_PITCH + c] = f2bf(d[j]); }
          GL[c] = gain[c]; } }
    __syncthreads();
    const int r16 = F.lane & 15, kq = F.lane >> 4;
    const int row = F.bid * 128 + F.wave * 16 + r16;
    u32x4 xs[32]; float ss = 0.f, sb = 0.f;
    if (XF32) {
        const float* xr = (const float*)xin + (size_t)row * DM + 8 * kq;
#pragma unroll
        for (int s = 0; s < 32; ++s) { const f32x4 a = *(const f32x4*)(xr + 32 * s), b = *(const f32x4*)(xr + 32 * s + 4);
            ss = __builtin_fmaf(a[0], a[0], ss); sb = __builtin_fmaf(a[1], a[1], sb); ss = __builtin_fmaf(a[2], a[2], ss); sb = __builtin_fmaf(a[3], a[3], sb); ss = __builtin_fmaf(b[0], b[0], ss); sb = __builtin_fmaf(b[1], b[1], sb); ss = __builtin_fmaf(b[2], b[2], ss); sb = __builtin_fmaf(b[3], b[3], sb);
            xs[s].x = pg8::cvt_pk_c(a[0], a[1]); xs[s].y = pg8::cvt_pk_c(a[2], a[3]); xs[s].z = pg8::cvt_pk_c(b[0], b[1]); xs[s].w = pg8::cvt_pk_c(b[2], b[3]);
            if ((s & 7) == 7) __builtin_amdgcn_sched_barrier(0); }
    } else if (!COMB) {
        const bf16_t* xr = (const bf16_t*)xin + (size_t)row * DM + 8 * kq;
#pragma unroll
        for (int s = 0; s < 32; ++s) xs[s] = *(const u32x4*)(xr + 32 * s);
#pragma unroll
        for (int s = 0; s < 32; ++s) { const u32x4 w = xs[s];
            ss = __builtin_fmaf(bflo(w.x), bflo(w.x), ss); sb = __builtin_fmaf(bfhi(w.x), bfhi(w.x), sb); ss = __builtin_fmaf(bflo(w.y), bflo(w.y), ss); sb = __builtin_fmaf(bfhi(w.y), bfhi(w.y), sb);
            ss = __builtin_fmaf(bflo(w.z), bflo(w.z), ss); sb = __builtin_fmaf(bfhi(w.z), bfhi(w.z), sb); ss = __builtin_fmaf(bflo(w.w), bflo(w.w), ss); sb = __builtin_fmaf(bfhi(w.w), bfhi(w.w), sb); }
    } else {
        const int r0 = TOK_ROW[row * 2], r1 = TOK_ROW[row * 2 + 1]; const float g0 = TOK_G[row * 2], g1 = TOK_G[row * 2 + 1];
        const bf16_t* xr = (const bf16_t*)xin + (size_t)row * DM + 8 * kq; const bf16_t* ya = Y + (size_t)r0 * DM + 8 * kq; const bf16_t* yb = Y + (size_t)r1 * DM + 8 * kq;
        bf16_t* xo = XB + (size_t)row * DM + 8 * kq;
#pragma unroll
        for (int s = 0; s < 32; ++s) { const u32x4 w = *(const u32x4*)(xr + 32 * s), a = *(const u32x4*)(ya + 32 * s), b = *(const u32x4*)(yb + 32 * s);
            float v[8];
            v[0] = bflo(w.x) + g0 * bflo(a.x) + g1 * bflo(b.x); v[1] = bfhi(w.x) + g0 * bfhi(a.x) + g1 * bfhi(b.x); v[2] = bflo(w.y) + g0 * bflo(a.y) + g1 * bflo(b.y); v[3] = bfhi(w.y) + g0 * bfhi(a.y) + g1 * bfhi(b.y);
            v[4] = bflo(w.z) + g0 * bflo(a.z) + g1 * bflo(b.z); v[5] = bfhi(w.z) + g0 * bfhi(a.z) + g1 * bfhi(b.z); v[6] = bflo(w.w) + g0 * bflo(a.w) + g1 * bflo(b.w); v[7] = bfhi(w.w) + g0 * bfhi(a.w) + g1 * bfhi(b.w);
#pragma unroll
            for (int j = 0; j < 8; j += 2) { ss = __builtin_fmaf(v[j], v[j], ss); sb = __builtin_fmaf(v[j + 1], v[j + 1], sb); }
            xs[s].x = pg8::cvt_pk_c(v[0], v[1]); xs[s].y = pg8::cvt_pk_c(v[2], v[3]); xs[s].z = pg8::cvt_pk_c(v[4], v[5]); xs[s].w = pg8::cvt_pk_c(v[6], v[7]);
            *(u32x4*)(xo + 32 * s) = xs[s];
            if ((s & 1) == 1) __builtin_amdgcn_sched_barrier(0); }
    }
    ss += sb; ss += __shfl_xor(ss, 16); ss += __shfl_xor(ss, 32);
    const float rstd = rsqrtf(ss * (1.f / DM) + NORM_EPS);
#pragma unroll
    for (int s = 0; s < 32; ++s) asm volatile("" : "+v"(xs[s].x), "+v"(xs[s].y), "+v"(xs[s].z), "+v"(xs[s].w));
    f32x4 acc = {0.f, 0.f, 0.f, 0.f};
    bf16_t* ho = HB + (size_t)row * DM + 8 * kq;
#pragma unroll
    for (int s = 0; s < 32; ++s) { const int c0 = 32 * s + 8 * kq; const f32x4 ga = *(const LAS f32x4*)(GL + c0), gb = *(const LAS f32x4*)(GL + c0 + 4); const u32x4 w = xs[s];
        u32x4 hw; hw.x = pg8::cvt_pk_c(bflo(w.x) * rstd * ga[0], bfhi(w.x) * rstd * ga[1]); hw.y = pg8::cvt_pk_c(bflo(w.y) * rstd * ga[2], bfhi(w.y) * rstd * ga[3]);
        hw.z = pg8::cvt_pk_c(bflo(w.z) * rstd * gb[0], bfhi(w.z) * rstd * gb[1]); hw.w = pg8::cvt_pk_c(bflo(w.w) * rstd * gb[2], bfhi(w.w) * rstd * gb[3]);
        *(u32x4*)(ho + 32 * s) = hw;
        acc = __builtin_amdgcn_mfma_f32_16x16x32_bf16(*(const LAS bf16x8*)(WL + r16 * NL_PITCH + c0), __builtin_bit_cast(bf16x8, hw), acc, 0, 0, 0);
        if ((s & 3) == 3) __builtin_amdgcn_sched_barrier(0); }
    { u32x2 o; o.x = pg8::cvt_pk_c(acc[0], acc[1]); o.y = pg8::cvt_pk_c(acc[2], acc[3]); *(u32x2*)(PROJ + (size_t)row * NPROJ + PB_LR + 4 * kq) = o; }
}
__device__ __forceinline__ void phase_final_copy(Frame& F) {
    const f32x4* src = (const f32x4*)(F.ws + WS_PROJ); f32x4* dst = (f32x4*)(F.out + (size_t)(NTOK / 2) * DM);
    for (int i = F.bid * 512 + F.tid; i < NTOK / 2 * DM / 4; i += F.G * 512) dst[i] = src[i];
}

__device__ __forceinline__ void moe_bases(const unsigned* cnt, int (&tb)[9]) {
    tb[0] = 0;
#pragma unroll
    for (int e = 0; e < 8; ++e) tb[e + 1] = tb[e] + __builtin_amdgcn_readfirstlane((int)((__hip_atomic_load(cnt + e, __ATOMIC_RELAXED, __HIP_MEMORY_SCOPE_AGENT) + 255u) >> 8));
}
__device__ __forceinline__ void phase_moe_map(Frame& F, int moe_slot) {
    int tb[9]; moe_bases(F.ctl + CW_MOECNT + 64 * moe_slot, tb);
    const int* TE = (const int*)(F.ws + WS_TOK_E); const int* TS = (const int*)(F.ws + WS_TOK_SLOT); int* TR = (int*)(F.ws + WS_TOK_ROW); int* RM = (int*)(F.ws + WS_ROWMAP);
    for (int a = F.bid * 512 + F.tid; a < NTOK * 2; a += F.G * 512) {
        const int e = TE[a]; int base = 0;
#pragma unroll
        for (int j = 0; j < 8; ++j) base = (e == j) ? tb[j] : base;
        const int row = base * 256 + TS[a]; TR[a] = row; RM[row] = a >> 1;
    }
    { unsigned zz = 0u; asm volatile("" : "+v"(zz)); unsigned char* A8 = F.ws + WS_PROJ;
      for (int i = F.bid * 512 + F.tid; i < tb[8] * 256 * ((KP8 - D_FFE) / 16); i += F.G * 512) { const int row = i >> 3, c = i & 7; *(u32x4*)(A8 + (size_t)row * KP8 + D_FFE + 16 * c) = (u32x4){zz, zz, zz, zz}; } }
    for (int i = F.bid * 512 + F.tid; i < N_EXP * 256; i += F.G * 512) {
        const int e = i >> 8, j = i & 255; int b0 = 0, b1 = 0;
#pragma unroll
        for (int q = 0; q < 8; ++q) { b0 = (e == q) ? tb[q] : b0; b1 = (e == q) ? tb[q + 1] : b1; }
        const int cnt = (int)__hip_atomic_load(F.ctl + CW_MOECNT + 64 * moe_slot + e, __ATOMIC_RELAXED, __HIP_MEMORY_SCOPE_AGENT);
        const int row = b0 * 256 + cnt + j; if (row < b1 * 256) RM[row] = 0;
    }
}
__device__ __forceinline__ void swa_unit(Frame& F, int l, int unit) {
    const bf16_t* P = (const bf16_t*)(F.ws + WS_PROJ); bf16_t* MIX = (bf16_t*)(F.ws + WS_MIX);
    const float* RC = (const float*)(F.ws + WS_ROPE_C); const float* RS = (const float*)(F.ws + WS_ROPE_S);
    const int qblk = unit & 31, kvh = (unit >> 5) & 1, b = unit >> 6;
    LAS float* Ks = (LAS float*)F.lds;
    LAS float* Vs = (LAS float*)(F.lds + 65536);
    const int tok0 = b * SEQ + qblk * 128;
    __syncthreads();
#pragma unroll 1
    for (int it = 0; it < 16; ++it) {
        const int idx = it * 512 + F.tid, j = idx >> 5, d = idx & 31; const int pos = qblk * 128 - 128 + j;
        float o1 = 0.f, o2 = 0.f;
        if (pos >= 0) { const int tok = b * SEQ + pos; const bf16_t* kp = P + (size_t)tok * NPROJ + PA_K + kvh * 64;
            const float k1 = bf2f(kp[d]), k2 = bf2f(kp[d + 32]), c = RC[tok * 32 + d], s = RS[tok * 32 + d]; o1 = k1 * c - k2 * s; o2 = k2 * c + k1 * s; }
        Ks[j * 64 + d] = o1; Ks[j * 64 + d + 32] = o2;
    }
#pragma unroll 1
    for (int it = 0; it < 32; ++it) {
        const int idx = it * 512 + F.tid, j = idx >> 6, d = idx & 63; const int pos = qblk * 128 - 128 + j;
        Vs[idx] = (pos >= 0) ? bf2f(P[(size_t)(b * SEQ + pos) * NPROJ + PA_V + kvh * 64 + d]) : 0.f;
    }
    const int part = F.tid >> 8, qv = F.tid & 255, g = qv >> 7, i = qv & 127, hq = kvh * 2 + g;
    const int tok = tok0 + i;
    float q[64];
    { const bf16_t* qp = P + (size_t)tok * NPROJ + PA_Q + hq * 64;
#pragma unroll
      for (int d = 0; d < 32; ++d) { const float q1 = bf2f(qp[d]), q2 = bf2f(qp[d + 32]), c = RC[tok * 32 + d], s = RS[tok * 32 + d]; q[d] = (q1 * c - q2 * s) * 0.125f; q[d + 32] = (q2 * c + q1 * s) * 0.125f; } }
    const float sink = INF(F, I_SINKS)[l * 4 + hq];
    float m = sink, lsum = (part == 0) ? 1.f : 0.f, acc[64];
#pragma unroll
    for (int d = 0; d < 64; ++d) acc[d] = 0.f;
    __syncthreads();
    for (int jj = 0; jj < 128; ++jj) {
        const int j = part * 128 + jj;
        const bool valid = (j > i) && (j <= i + 128) && (qblk > 0 || j >= 128);
        float s = 0.f;
#pragma unroll
        for (int d4 = 0; d4 < 16; ++d4) { const f32x4 kv = *(const LAS f32x4*)(Ks + j * 64 + d4 * 4); s += (q[d4 * 4] * kv[0] + q[d4 * 4 + 1] * kv[1]) + (q[d4 * 4 + 2] * kv[2] + q[d4 * 4 + 3] * kv[3]); }
        if (!valid) s = -INFINITY;
        const float mn = fmaxf(m, s), sc = __expf(m - mn), p = __expf(s - mn);
        lsum = lsum * sc + p; m = mn;
#pragma unroll
        for (int d4 = 0; d4 < 16; ++d4) { const f32x4 vv = *(const LAS f32x4*)(Vs + j * 64 + d4 * 4);
            acc[d4 * 4] = acc[d4 * 4] * sc + p * vv[0]; acc[d4 * 4 + 1] = acc[d4 * 4 + 1] * sc + p * vv[1]; acc[d4 * 4 + 2] = acc[d4 * 4 + 2] * sc + p * vv[2]; acc[d4 * 4 + 3] = acc[d4 * 4 + 3] * sc + p * vv[3]; }
    }
    __syncthreads();
    LAS float* MB = (LAS float*)F.lds;
    if (part == 1) { MB[qv * 66] = m; MB[qv * 66 + 1] = lsum;
#pragma unroll
        for (int d = 0; d < 64; ++d) MB[qv * 66 + 2 + d] = acc[d]; }
    __syncthreads();
    if (part == 0) {
        const float m1 = MB[qv * 66], l1 = MB[qv * 66 + 1]; const float M = fmaxf(m, m1), s0 = __expf(m - M), s1 = __expf(m1 - M);
        const float inv = 1.f / (lsum * s0 + l1 * s1); float ss = 0.f;
#pragma unroll
        for (int d = 0; d < 64; ++d) { acc[d] = (acc[d] * s0 + MB[qv * 66 + 2 + d] * s1) * inv; ss += acc[d] * acc[d]; }
        const float rstd = rsqrtf(ss * (1.f / 64.f) + NORM_EPS); const float* gn = INF(F, I_SWA_ON) + l * 256 + hq * 64;
        bf16_t* op = MIX + (size_t)tok * DM + hq * 64;
#pragma unroll
        for (int d8 = 0; d8 < 8; ++d8) { u32x4 w;
            w.x = pk2(acc[d8 * 8] * rstd * gn[d8 * 8], acc[d8 * 8 + 1] * rstd * gn[d8 * 8 + 1]); w.y = pk2(acc[d8 * 8 + 2] * rstd * gn[d8 * 8 + 2], acc[d8 * 8 + 3] * rstd * gn[d8 * 8 + 3]);
            w.z = pk2(acc[d8 * 8 + 4] * rstd * gn[d8 * 8 + 4], acc[d8 * 8 + 5] * rstd * gn[d8 * 8 + 5]); w.w = pk2(acc[d8 * 8 + 6] * rstd * gn[d8 * 8 + 6], acc[d8 * 8 + 7] * rstd * gn[d8 * 8 + 7]);
            *(u32x4*)(op + d8 * 8) = w; }
    }
}

__device__ __forceinline__ void sb_waveunit(Frame& F, int l, int wu) {
    const bf16_t* P = (const bf16_t*)(F.ws + WS_PROJ); bf16_t* MIX = (bf16_t*)(F.ws + WS_MIX);
    const int tb = wu & 63, h = (wu >> 6) & 3, b = wu >> 8;
    const int t0 = tb * 64, t = t0 + F.lane;
    float q[64], o[64];
    { const u32x4* qp = (const u32x4*)(P + (size_t)(b * SEQ + t) * NPROJ + PC_Q + h * 64);
#pragma unroll
      for (int d8 = 0; d8 < 8; ++d8) { const u32x4 w = qp[d8];
          q[d8 * 8] = bflo(w.x) * 0.125f; q[d8 * 8 + 1] = bfhi(w.x) * 0.125f; q[d8 * 8 + 2] = bflo(w.y) * 0.125f; q[d8 * 8 + 3] = bfhi(w.y) * 0.125f;
          q[d8 * 8 + 4] = bflo(w.z) * 0.125f; q[d8 * 8 + 5] = bfhi(w.z) * 0.125f; q[d8 * 8 + 6] = bflo(w.w) * 0.125f; q[d8 * 8 + 7] = bfhi(w.w) * 0.125f; } }
#pragma unroll
    for (int d = 0; d < 64; ++d) o[d] = 0.f;
    float R = 0.f;
    for (int s = t0 + 62; s >= 0; --s) {
        if (s < t0) { if (__all(R < -80.f)) break; }
        const size_t rowoff = (size_t)__builtin_amdgcn_readfirstlane(b * SEQ + s) * NPROJ;
        const u32x4* kp = (const u32x4*)(P + rowoff + PC_K + h * 64); const u32x4* vp = (const u32x4*)(P + rowoff + PC_V + h * 64);
        float z = 0.f;
#pragma unroll
        for (int d8 = 0; d8 < 8; ++d8) { const u32x4 w = kp[d8];
            z += (q[d8 * 8] * bflo(w.x) + q[d8 * 8 + 1] * bfhi(w.x)) + (q[d8 * 8 + 2] * bflo(w.y) + q[d8 * 8 + 3] * bfhi(w.y))
               + (q[d8 * 8 + 4] * bflo(w.z) + q[d8 * 8 + 5] * bfhi(w.z)) + (q[d8 * 8 + 6] * bflo(w.w) + q[d8 * 8 + 7] * bfhi(w.w)); }
        const bool valid = s < t;
        const float sp = softplus_f(z);
        const float p = valid ? __expf((z - sp) + R) : 0.f;
        R += valid ? -sp : 0.f;
#pragma unroll
        for (int d8 = 0; d8 < 8; ++d8) { const u32x4 w = vp[d8];
            o[d8 * 8] += p * bflo(w.x); o[d8 * 8 + 1] += p * bfhi(w.x); o[d8 * 8 + 2] += p * bflo(w.y); o[d8 * 8 + 3] += p * bfhi(w.y);
            o[d8 * 8 + 4] += p * bflo(w.z); o[d8 * 8 + 5] += p * bfhi(w.z); o[d8 * 8 + 6] += p * bflo(w.w); o[d8 * 8 + 7] += p * bfhi(w.w); }
    }
    float ss = 0.f;
#pragma unroll
    for (int d = 0; d < 64; ++d) ss += o[d] * o[d];
    const float rstd = rsqrtf(ss * (1.f / 64.f) + NORM_EPS); const float* gn = INF(F, I_SB_ON) + l * 256 + h * 64;
    bf16_t* op = MIX + (size_t)(b * SEQ + t) * DM + 512 + h * 64;
#pragma unroll
    for (int d8 = 0; d8 < 8; ++d8) { u32x4 w;
        w.x = pk2(o[d8 * 8] * rstd * gn[d8 * 8], o[d8 * 8 + 1] * rstd * gn[d8 * 8 + 1]); w.y = pk2(o[d8 * 8 + 2] * rstd * gn[d8 * 8 + 2], o[d8 * 8 + 3] * rstd * gn[d8 * 8 + 3]);
        w.z = pk2(o[d8 * 8 + 4] * rstd * gn[d8 * 8 + 4], o[d8 * 8 + 5] * rstd * gn[d8 * 8 + 5]); w.w = pk2(o[d8 * 8 + 6] * rstd * gn[d8 * 8 + 6], o[d8 * 8 + 7] * rstd * gn[d8 * 8 + 7]);
        *(u32x4*)(op + d8 * 8) = w; }
}

__device__ __forceinline__ void gla_decay_cumsum(Frame& F, int l, int b, int h, int n, LAS float* Bc) {
    const bf16_t* P = (const bf16_t*)(F.ws + WS_PROJ);
    const float* wa2 = INF(F, I_GLA_WA2) + l * 16 * 128; const float* ba = INF(F, I_GLA_BA) + l * 128;
    const int tok0 = b * SEQ + n * 64;
#pragma unroll
    for (int it = 0; it < 4; ++it) { const int idx = it * 512 + F.tid, t = idx >> 5, e = idx & 31;
        const bf16_t* lr = P + (size_t)(tok0 + t) * NPROJ + PB_LR; float a = ba[h * 32 + e];
#pragma unroll
        for (int r = 0; r < 16; ++r) a += bf2f(lr[r]) * wa2[r * 128 + h * 32 + e];
        Bc[idx] = logsigmoid_f(a) * (1.f / 16.f); }
    __syncthreads();
    if (F.tid < 32) { float c = 0.f; for (int t = 0; t < 64; ++t) { c += Bc[t * 32 + F.tid]; Bc[t * 32 + F.tid] = c; } }
    __syncthreads();
}
__device__ __forceinline__ void gla_kv_unit(Frame& F, int l, int unit) {
    const bf16_t* P = (const bf16_t*)(F.ws + WS_PROJ);
    float* KV = (float*)(F.ws + WS_GLA_KV) + (size_t)unit * 2048; float* DEC = (float*)(F.ws + WS_GLA_DEC) + unit * 32;
    const int n = unit & 63, h = (unit >> 6) & 3, b = unit >> 8, tok0 = b * SEQ + n * 64;
    LAS float* Bc = (LAS float*)F.lds; LAS float* Ke = (LAS float*)(F.lds + 8192); LAS float* Vs = (LAS float*)(F.lds + 16384);
    __syncthreads();
    gla_decay_cumsum(F, l, b, h, n, Bc);
#pragma unroll
    for (int it = 0; it < 4; ++it) { const int idx = it * 512 + F.tid, s = idx >> 5, e = idx & 31;
        Ke[idx] = bf2f(P[(size_t)(tok0 + s) * NPROJ + PB_K + h * 32 + e]) * __expf(Bc[63 * 32 + e] - Bc[idx]); }
#pragma unroll
    for (int it = 0; it < 8; ++it) { const int idx = it * 512 + F.tid, s = idx >> 6, f = idx & 63; Vs[idx] = bf2f(P[(size_t)(tok0 + s) * NPROJ + PB_V + h * 64 + f]); }
    __syncthreads();
    { const int e = F.tid >> 4, f0 = (F.tid & 15) * 4; f32x4 a = {0.f, 0.f, 0.f, 0.f};
      for (int s = 0; s < 64; ++s) { const float ke = Ke[s * 32 + e]; const f32x4 vv = *(const LAS f32x4*)(Vs + s * 64 + f0); a += ke * vv; }
      *(f32x4*)(KV + e * 64 + f0) = a; }
    if (F.tid < 32) DEC[F.tid] = __expf(Bc[63 * 32 + F.tid]);
}
__device__ __forceinline__ void gla_scan(Frame& F, int gtid) {
    const int f = gtid & 63, e = (gtid >> 6) & 31, bh = gtid >> 11;
    float* KV = (float*)(F.ws + WS_GLA_KV) + (size_t)bh * 64 * 2048 + e * 64 + f; const float* DEC = (const float*)(F.ws + WS_GLA_DEC) + bh * 64 * 32 + e;
    float st = 0.f;
#pragma unroll 8
    for (int n = 0; n < 64; ++n) { const float kv = KV[(size_t)n * 2048], d = DEC[n * 32]; KV[(size_t)n * 2048] = st; st = d * st + kv; }
}
__device__ __forceinline__ void gla_out_unit(Frame& F, int l, int unit) {
    const bf16_t* P = (const bf16_t*)(F.ws + WS_PROJ); bf16_t* MIX = (bf16_t*)(F.ws + WS_MIX);
    const float* SP = (const float*)(F.ws + WS_GLA_KV) + (size_t)unit * 2048;
    const int n = unit & 63, h = (unit >> 6) & 3, b = unit >> 8, tok0 = b * SEQ + n * 64;
    LAS float* Bc = (LAS float*)F.lds; LAS float* Qe = (LAS float*)(F.lds + 8192); LAS float* Ke = (LAS float*)(F.lds + 16384); LAS float* Qb = (LAS float*)(F.lds + 25088);
    LAS float* Vs = (LAS float*)(F.lds + 33792); LAS float* Ss = (LAS float*)(F.lds + 50176); LAS float* At = (LAS float*)(F.lds + 58368);
    __syncthreads();
    gla_decay_cumsum(F, l, b, h, n, Bc);
    const float qs = 0.17677669529663687f;
#pragma unroll
    for (int it = 0; it < 4; ++it) { const int idx = it * 512 + F.tid, t = idx >> 5, e = idx & 31;
        const float bt = Bc[idx], br = Bc[31 * 32 + e];
        const float qv = bf2f(P[(size_t)(tok0 + t) * NPROJ + PB_Q + h * 32 + e]) * qs, kv = bf2f(P[(size_t)(tok0 + t) * NPROJ + PB_K + h * 32 + e]);
        Qe[idx] = qv * __expf(bt - br); Ke[t * 33 + e] = kv * __expf(br - bt); Qb[idx] = qv * __expf(bt); }
#pragma unroll
    for (int it = 0; it < 8; ++it) { const int idx = it * 512 + F.tid, s = idx >> 6, f = idx & 63; Vs[idx] = bf2f(P[(size_t)(tok0 + s) * NPROJ + PB_V + h * 64 + f]); }
#pragma unroll
    for (int it = 0; it < 4; ++it) { const int idx = it * 512 + F.tid; Ss[idx] = SP[idx]; }
    __syncthreads();
#pragma unroll
    for (int it = 0; it < 8; ++it) { const int idx = it * 512 + F.tid, t = idx >> 6, s = idx & 63; float a = 0.f;
        if (s <= t) {
#pragma unroll
            for (int e = 0; e < 32; ++e) a += Qe[t * 32 + e] * Ke[s * 33 + e]; }
        At[t * 65 + s] = a; }
    __syncthreads();
    { const int t = F.tid >> 3, f0 = (F.tid & 7) * 8; float o[8];
#pragma unroll
      for (int j = 0; j < 8; ++j) o[j] = 0.f;
      for (int s = 0; s <= t; ++s) { const float a = At[t * 65 + s]; const f32x4 v0 = *(const LAS f32x4*)(Vs + s * 64 + f0), v1 = *(const LAS f32x4*)(Vs + s * 64 + f0 + 4);
          o[0] += a * v0[0]; o[1] += a * v0[1]; o[2] += a * v0[2]; o[3] += a * v0[3]; o[4] += a * v1[0]; o[5] += a * v1[1]; o[6] += a * v1[2]; o[7] += a * v1[3]; }
#pragma unroll
      for (int e = 0; e < 32; ++e) { const float a = Qb[t * 32 + e]; const f32x4 v0 = *(const LAS f32x4*)(Ss + e * 64 + f0), v1 = *(const LAS f32x4*)(Ss + e * 64 + f0 + 4);
          o[0] += a * v0[0]; o[1] += a * v0[1]; o[2] += a * v0[2]; o[3] += a * v0[3]; o[4] += a * v1[0]; o[5] += a * v1[1]; o[6] += a * v1[2]; o[7] += a * v1[3]; }
      float ss = 0.f;
#pragma unroll
      for (int j = 0; j < 8; ++j) ss += o[j] * o[j];
      ss += __shfl_xor(ss, 1); ss += __shfl_xor(ss, 2); ss += __shfl_xor(ss, 4);
      const float rstd = rsqrtf(ss * (1.f / 64.f) + NORM_EPS); const float* gn = INF(F, I_GLA_ON) + l * 256 + h * 64 + f0;
      const u32x4 gw = *(const u32x4*)(P + (size_t)(tok0 + t) * NPROJ + PB_G + h * 64 + f0);
      float gb[8] = {bflo(gw.x), bfhi(gw.x), bflo(gw.y), bfhi(gw.y), bflo(gw.z), bfhi(gw.z), bflo(gw.w), bfhi(gw.w)};
      float r[8];
#pragma unroll
      for (int j = 0; j < 8; ++j) r[j] = o[j] * rstd * gn[j] * (gb[j] * sigmoid_f(gb[j]));
      u32x4 w; w.x = pk2(r[0], r[1]); w.y = pk2(r[2], r[3]); w.z = pk2(r[4], r[5]); w.w = pk2(r[6], r[7]);
      *(u32x4*)(MIX + (size_t)(tok0 + t) * DM + 256 + h * 64 + f0) = w; }
}

template <int CTRL> __device__ __forceinline__ float dpp_add(float v) { return v + __builtin_bit_cast(float, __builtin_amdgcn_update_dpp(0, __builtin_bit_cast(int, v), CTRL, 0xf, 0xf, false)); }
__device__ __forceinline__ float sum16(float v) { v = dpp_add<0xB1>(v); v = dpp_add<0x4E>(v); v = dpp_add<0x141>(v); v = dpp_add<0x140>(v); return v; }
typedef float f32x16 __attribute__((ext_vector_type(16)));
__device__ __forceinline__ float other_half(float x, int hh) {
    auto t = __builtin_amdgcn_permlane32_swap(__float_as_uint(x), __float_as_uint(x), false, false);
    return __uint_as_float(hh ? t[0] : t[1]);
}
__device__ __forceinline__ unsigned cvt_pk(float lo, float hi) { unsigned r; asm volatile("v_cvt_pk_bf16_f32 %0, %1, %2" : "=v"(r) : "v"(lo), "v"(hi)); return r; }
__device__ __forceinline__ bf16x8 pack8(float p0, float p1, float p2, float p3, float p4, float p5, float p6, float p7) {
    u32x4 w; w.x = cvt_pk(p0, p1); w.y = cvt_pk(p2, p3); w.z = cvt_pk(p4, p5); w.w = cvt_pk(p6, p7); return __builtin_bit_cast(bf16x8, w);
}
#define PACK8(a, o) pack8(a[(o)], a[(o) + 1], a[(o) + 2], a[(o) + 3], a[(o) + 4], a[(o) + 5], a[(o) + 6], a[(o) + 7])
__device__ __forceinline__ bf16x8 load_vt(const bf16_t* P, size_t vrow0, int vcol, int db, int ko, int r, int hh) {
    const bf16_t* p = P + (vrow0 + 32 * db + r) * NPROJ + vcol + ko + 4 * hh;
    const u32x2 a = *(const u32x2*)p, b = *(const u32x2*)(p + 8);
    u32x4 w; w.x = a.x; w.y = a.y; w.z = b.x; w.w = b.y; return __builtin_bit_cast(bf16x8, w);
}
__device__ __forceinline__ void store_ot(bf16_t* orow, const f32x16& o0, const f32x16& o1, float rs, const float* gn, int hh) {
#pragma unroll
    for (int db = 0; db < 2; ++db)
#pragma unroll
        for (int g4 = 0; g4 < 4; ++g4) { const int d = 32 * db + 8 * g4 + 4 * hh; const f32x4 gv = *(const f32x4*)(gn + d);
            const f32x16& o = db ? o1 : o0;
            u32x2 w; w.x = cvt_pk(o[4 * g4] * rs * gv[0], o[4 * g4 + 1] * rs * gv[1]); w.y = cvt_pk(o[4 * g4 + 2] * rs * gv[2], o[4 * g4 + 3] * rs * gv[3]);
            *(u32x2*)(orow + d) = w; }
}

__device__ __forceinline__ void attn_prep_block(Frame& F, int blk) {
    bf16_t* P = (bf16_t*)(F.ws + WS_PROJ);
    const float* RC = (const float*)(F.ws + WS_ROPE_C); const float* RS = (const float*)(F.ws + WS_ROPE_S);
    LAS unsigned* T = (LAS unsigned*)F.lds;
    const int tok0 = blk * 64;
    for (int it = 0; it < 24; ++it) { const int idx = it * 512 + F.tid, d = idx & 31, hd = (idx >> 5) % 6, tt = idx / 192; const int tok = tok0 + tt;
        bf16_t* p = P + (size_t)tok * NPROJ + (hd < 4 ? PA_Q + hd * 64 : PA_K + (hd - 4) * 64); const float sc = hd < 4 ? 0.18033688011112042f : 1.f;
        const float x1 = bf2f(p[d]), x2 = bf2f(p[d + 32]), c = RC[tok * 32 + d], s = RS[tok * 32 + d];
        p[d] = f2bf((x1 * c - x2 * s) * sc); p[d + 32] = f2bf((x2 * c + x1 * s) * sc); }
    for (int vt = 0; vt < 6; ++vt) {
        const int vcol = vt < 2 ? PA_V + vt * 64 : PC_V + (vt - 2) * 64;
        __syncthreads();
        { const int tt = F.tid >> 3, c8 = F.tid & 7; const u32x4 w = *(const u32x4*)(P + (size_t)(tok0 + tt) * NPROJ + vcol + c8 * 8);
          T[tt * 33 + c8 * 4] = w.x; T[tt * 33 + c8 * 4 + 1] = w.y; T[tt * 33 + c8 * 4 + 2] = w.z; T[tt * 33 + c8 * 4 + 3] = w.w; }
        __syncthreads();
        { const int d = F.tid >> 3, t8 = F.tid & 7; unsigned e[8];
#pragma unroll
          for (int i = 0; i < 8; ++i) { const unsigned w = T[(t8 * 8 + i) * 33 + (d >> 1)]; e[i] = (d & 1) ? (w >> 16) : (w & 0xffffu); }
          u32x4 o; o.x = e[0] | (e[1] << 16); o.y = e[2] | (e[3] << 16); o.z = e[4] | (e[5] << 16); o.w = e[6] | (e[7] << 16);
          *(u32x4*)(P + (size_t)(tok0 + d) * NPROJ + vcol + t8 * 8) = o; }
    }
}

__device__ __forceinline__ void sb_task(Frame& F, int l, int task) {
    const bf16_t* P = (const bf16_t*)(F.ws + WS_PROJ); bf16_t* MIX = (bf16_t*)(F.ws + WS_MIX);
    const int qb = task & 127, h = (task >> 7) & 3, b = task >> 9;
    const int q0 = qb * 32, r = F.lane & 31, hh = F.lane >> 5, t = q0 + r;
    const size_t rowb = (size_t)b * SEQ;
    bf16x8 qf[4];
    { const bf16_t* qp = P + (rowb + t) * NPROJ + PC_Q + h * 64 + 8 * hh;
#pragma unroll
      for (int s = 0; s < 4; ++s) qf[s] = *(const bf16x8*)(qp + 16 * s); }
    f32x16 o0, o1;
#pragma unroll
    for (int i = 0; i < 16; ++i) { o0[i] = 0.f; o1[i] = 0.f; }
    float R = 0.f;
    bf16x8 kf[2][4];
#define SB_LOADK(kt_) do { _Pragma("unroll") for (int kb = 0; kb < 2; ++kb) { const bf16_t* kp = P + (rowb + 64 * (kt_) + 32 * kb + r) * NPROJ + PC_K + h * 64 + 8 * hh; \
        _Pragma("unroll") for (int s = 0; s < 4; ++s) kf[kb][s] = *(const bf16x8*)(kp + 16 * s); } } while (0)
    SB_LOADK((q0 + 30) >> 6);
    for (int kt = (q0 + 30) >> 6; kt >= 0; --kt) {
        const size_t krow0 = rowb + 64 * kt;
        bf16x8 vf[2][2][2];
#pragma unroll
        for (int kb = 0; kb < 2; ++kb)
#pragma unroll
            for (int s = 0; s < 2; ++s) { vf[0][kb][s] = load_vt(P, krow0, PC_V + h * 64, 0, 32 * kb + 16 * s, r, hh); vf[1][kb][s] = load_vt(P, krow0, PC_V + h * 64, 1, 32 * kb + 16 * s, r, hh); }
        __builtin_amdgcn_sched_barrier(0);
        f32x16 st[2];
#pragma unroll
        for (int kb = 0; kb < 2; ++kb) { f32x16 a;
#pragma unroll
            for (int i = 0; i < 16; ++i) a[i] = 0.f;
#pragma unroll
            for (int s = 0; s < 4; ++s) a = __builtin_amdgcn_mfma_f32_32x32x16_bf16(kf[kb][s], qf[s], a, 0, 0, 0);
            st[kb] = a; }
        bf16x8 kn[2][4];
        { const int ktn = kt > 0 ? kt - 1 : 0;
#pragma unroll
          for (int kb = 0; kb < 2; ++kb) { const bf16_t* kp = P + (rowb + 64 * ktn + 32 * kb + r) * NPROJ + PC_K + h * 64 + 8 * hh;
#pragma unroll
              for (int s = 0; s < 4; ++s) kn[kb][s] = *(const bf16x8*)(kp + 16 * s); } }
        float Rb = R;
#pragma unroll
        for (int kb = 1; kb >= 0; --kb) {
            float lv[16], zz[16], p[16];
#pragma unroll
            for (int i = 0; i < 16; ++i) { const int key = 64 * kt + 32 * kb + (i & 3) + 8 * (i >> 2) + 4 * hh; const float z = st[kb][i] * 0.18033688011112042f; const bool valid = key < t;
                const float sp = fmaxf(z, 0.f) + __builtin_amdgcn_logf(1.f + __builtin_amdgcn_exp2f(-fabsf(z))); lv[i] = valid ? -sp : 0.f; zz[i] = valid ? (z - sp) : -INFINITY; }
            float gown[4], suf[16];
#pragma unroll
            for (int g = 0; g < 4; ++g) { const float s3 = lv[4 * g + 3], s2 = s3 + lv[4 * g + 2], s1 = s2 + lv[4 * g + 1]; gown[g] = s1 + lv[4 * g];
                suf[4 * g + 3] = 0.f; suf[4 * g + 2] = s3; suf[4 * g + 1] = s2; suf[4 * g] = s1; }
            float run = 0.f, above[4];
#pragma unroll
            for (int g = 3; g >= 0; --g) { const float go = other_half(gown[g], hh); above[g] = run + (hh == 0 ? go : 0.f); run += gown[g] + go; }
#pragma unroll
            for (int i = 0; i < 16; ++i) p[i] = __builtin_amdgcn_exp2f(zz[i] + (Rb + above[i >> 2] + suf[i]));
            Rb += run;
#pragma unroll
            for (int s = 0; s < 2; ++s) { const bf16x8 pf = PACK8(p, 8 * s);
                o0 = __builtin_amdgcn_mfma_f32_32x32x16_bf16(vf[0][kb][s], pf, o0, 0, 0, 0);
                o1 = __builtin_amdgcn_mfma_f32_32x32x16_bf16(vf[1][kb][s], pf, o1, 0, 0, 0); }
        }
        R = Rb;
#pragma unroll
        for (int kb = 0; kb < 2; ++kb)
#pragma unroll
            for (int s = 0; s < 4; ++s) kf[kb][s] = kn[kb][s];
        if (__all(R < -115.5f)) break;
    }
#undef SB_LOADK
    float ss = 0.f;
#pragma unroll
    for (int i = 0; i < 16; ++i) ss += o0[i] * o0[i] + o1[i] * o1[i];
    ss += other_half(ss, hh);
    const float rstd = rsqrtf(ss * (1.f / 64.f) + NORM_EPS);
    store_ot(MIX + (rowb + t) * DM + 512 + h * 64, o0, o1, rstd, INF(F, I_SB_ON) + l * 256 + h * 64, hh);
}

__device__ __forceinline__ void swa_task(Frame& F, int l, int task) {
    const bf16_t* P = (const bf16_t*)(F.ws + WS_PROJ); bf16_t* MIX = (bf16_t*)(F.ws + WS_MIX);
    const int qb = task & 127, hq = (task >> 7) & 3, b = task >> 9, kvh = hq >> 1;
    const int q0 = qb * 32, r = F.lane & 31, hh = F.lane >> 5, t = q0 + r;
    const size_t rowb = (size_t)b * SEQ;
    bf16x8 qf[4];
    { const bf16_t* qp = P + (rowb + t) * NPROJ + PA_Q + hq * 64 + 8 * hh;
#pragma unroll
      for (int s = 0; s < 4; ++s) qf[s] = *(const bf16x8*)(qp + 16 * s); }
    f32x16 o0, o1;
#pragma unroll
    for (int i = 0; i < 16; ++i) { o0[i] = 0.f; o1[i] = 0.f; }
    float m = INF(F, I_SINKS)[l * 4 + hq], lsum = 1.f;
    const int ktlo = (q0 >= 127) ? ((q0 - 127) >> 6) : 0;
    for (int kt = (q0 + 31) >> 6; kt >= ktlo; --kt) {
        const size_t krow0 = rowb + 64 * kt;
        float sv[32];
        float tmax = -INFINITY;
#pragma unroll
        for (int kb = 0; kb < 2; ++kb) { const bf16_t* kp = P + (krow0 + 32 * kb + r) * NPROJ + PA_K + kvh * 64 + 8 * hh;
            f32x16 a;
#pragma unroll
            for (int i = 0; i < 16; ++i) a[i] = 0.f;
#pragma unroll
            for (int s = 0; s < 4; ++s) a = __builtin_amdgcn_mfma_f32_32x32x16_bf16(*(const bf16x8*)(kp + 16 * s), qf[s], a, 0, 0, 0);
#pragma unroll
            for (int i = 0; i < 16; ++i) { const int key = 64 * kt + 32 * kb + (i & 3) + 8 * (i >> 2) + 4 * hh; const bool valid = (key <= t) && (key + 127 >= t);
                sv[kb * 16 + i] = valid ? a[i] : -INFINITY; tmax = fmaxf(tmax, sv[kb * 16 + i]); } }
        tmax = fmaxf(tmax, other_half(tmax, hh));
        const float mn = fmaxf(m, tmax), sc = __expf(m - mn);
        float psum = 0.f;
#pragma unroll
        for (int i = 0; i < 32; ++i) { sv[i] = __expf(sv[i] - mn); psum += sv[i]; }
        psum += other_half(psum, hh);
        lsum = lsum * sc + psum; m = mn;
#pragma unroll
        for (int i = 0; i < 16; ++i) { o0[i] *= sc; o1[i] *= sc; }
#pragma unroll
        for (int kb = 0; kb < 2; ++kb)
#pragma unroll
            for (int s = 0; s < 2; ++s) { const bf16x8 pf = PACK8(sv, kb * 16 + 8 * s);
                o0 = __builtin_amdgcn_mfma_f32_32x32x16_bf16(load_vt(P, krow0, PA_V + kvh * 64, 0, 32 * kb + 16 * s, r, hh), pf, o0, 0, 0, 0);
                o1 = __builtin_amdgcn_mfma_f32_32x32x16_bf16(load_vt(P, krow0, PA_V + kvh * 64, 1, 32 * kb + 16 * s, r, hh), pf, o1, 0, 0, 0); }
    }
    const float inv = 1.f / lsum;
    float ss = 0.f;
#pragma unroll
    for (int i = 0; i < 16; ++i) { o0[i] *= inv; o1[i] *= inv; ss += o0[i] * o0[i] + o1[i] * o1[i]; }
    ss += other_half(ss, hh);
    const float rstd = rsqrtf(ss * (1.f / 64.f) + NORM_EPS);
    store_ot(MIX + (rowb + t) * DM + hq * 64, o0, o1, rstd, INF(F, I_SWA_ON) + l * 256 + hq * 64, hh);
}

__device__ __forceinline__ unsigned short hw(const u32x4& w, int j) { const unsigned d = (j >> 1) == 0 ? w.x : ((j >> 1) == 1 ? w.y : ((j >> 1) == 2 ? w.z : w.w)); return (unsigned short)((j & 1) ? (d >> 16) : (d & 0xffffu)); }
template <int V> struct IC { static constexpr int value = V; };
template <bool SWA>
__device__ __forceinline__ void attn_block(Frame& F, int l, int bt) {
    const bf16_t* P = (const bf16_t*)(F.ws + WS_PROJ); bf16_t* MIX = (bf16_t*)(F.ws + WS_MIX);
    const int qblk = bt & 15, h = (bt >> 4) & 3, b = bt >> 6;
    const int q0b = qblk * 256, q0 = q0b + 32 * F.wave, r = F.lane & 31, hh = F.lane >> 5, t = q0 + r;
    const size_t rowb = (size_t)b * SEQ;
    const int qcol = SWA ? PA_Q + h * 64 : PC_Q + h * 64, kcol = SWA ? PA_K + (h >> 1) * 64 : PC_K + h * 64, vcol = SWA ? PA_V + (h >> 1) * 64 : PC_V + h * 64;
    LAS bf16_t* Ks = (LAS bf16_t*)F.lds; LAS bf16_t* Vs = (LAS bf16_t*)(F.lds + 2 * 9216);
    const float* RC = (const float*)(F.ws + WS_ROPE_C); const float* RS = (const float*)(F.ws + WS_ROPE_S);
    bf16x8 qf[4];
    { const bf16_t* qp = P + (rowb + t) * NPROJ + qcol + 8 * hh; u32x4 qw[4];
#pragma unroll
      for (int s = 0; s < 4; ++s) qw[s] = *(const u32x4*)(qp + 16 * s);
      if (SWA) {
#pragma unroll
          for (int s = 0; s < 2; ++s) { const float* cp = RC + (rowb + t) * 32 + 16 * s + 8 * hh; const float* sp = RS + (rowb + t) * 32 + 16 * s + 8 * hh;
              const f32x4 c0 = *(const f32x4*)cp, c1 = *(const f32x4*)(cp + 4), s0 = *(const f32x4*)sp, s1 = *(const f32x4*)(sp + 4);
              const unsigned a[4] = {qw[s].x, qw[s].y, qw[s].z, qw[s].w}, bq[4] = {qw[s + 2].x, qw[s + 2].y, qw[s + 2].z, qw[s + 2].w}; float o1[8], o2[8];
#pragma unroll
              for (int j = 0; j < 8; ++j) { const float x1 = (j & 1) ? bfhi(a[j >> 1]) : bflo(a[j >> 1]), x2 = (j & 1) ? bfhi(bq[j >> 1]) : bflo(bq[j >> 1]), cc = j < 4 ? c0[j & 3] : c1[j & 3], sn = j < 4 ? s0[j & 3] : s1[j & 3];
                  o1[j] = (x1 * cc - x2 * sn) * 0.18033688011112042f; o2[j] = (x2 * cc + x1 * sn) * 0.18033688011112042f; }
              qw[s] = (u32x4){cvt_pk(o1[0], o1[1]), cvt_pk(o1[2], o1[3]), cvt_pk(o1[4], o1[5]), cvt_pk(o1[6], o1[7])}; qw[s + 2] = (u32x4){cvt_pk(o2[0], o2[1]), cvt_pk(o2[2], o2[3]), cvt_pk(o2[4], o2[5]), cvt_pk(o2[6], o2[7])}; } }
#pragma unroll
      for (int s = 0; s < 4; ++s) qf[s] = __builtin_bit_cast(bf16x8, qw[s]); }
    f32x16 o0, o1;
#pragma unroll
    for (int i = 0; i < 16; ++i) { o0[i] = 0.f; o1[i] = 0.f; }
    float R = 0.f;
    float m = SWA ? INF(F, I_SINKS)[l * 4 + h] * 1.4426950408889634f : 0.f, lsum = 1.f;
    const int kt_top = SWA ? (q0b + 255) >> 6 : (q0b + 254) >> 6;
    const int kt_lo = SWA ? ((q0b >= 127) ? ((q0b - 127) >> 6) : 0) : 0;
    const int ktw = SWA ? (q0 + 31) >> 6 : (q0 + 30) >> 6;
    const int ktl = SWA ? ((q0 >= 127) ? ((q0 - 127) >> 6) : 0) : 0;
    bool fin = false;
    const bool kside = F.wave < 4; const int srow = (F.tid & 255) >> 2, q4 = F.tid & 3;
    u32x4 pa_[2], pb_[2]; f32x4 rc0_[2], rc1_[2], rs0_[2], rs1_[2];
#pragma unroll
    for (int i_ = 0; i_ < 2; ++i_) { rc0_[i_] = (f32x4){0.f, 0.f, 0.f, 0.f}; rc1_[i_] = rc0_[i_]; rs0_[i_] = rc0_[i_]; rs1_[i_] = rc0_[i_]; }
#define AT_FETCH(kt_, S_) do { const size_t tk_ = rowb + 64 * (kt_) + srow; \
        if (kside) { const bf16_t* p_ = P + tk_ * NPROJ + kcol + 8 * q4; pa_[S_] = *(const u32x4*)p_; pb_[S_] = *(const u32x4*)(p_ + 32); \
            if (SWA) { const float* c_ = RC + tk_ * 32 + 8 * q4; const float* s_ = RS + tk_ * 32 + 8 * q4; rc0_[S_] = *(const f32x4*)c_; rc1_[S_] = *(const f32x4*)(c_ + 4); rs0_[S_] = *(const f32x4*)s_; rs1_[S_] = *(const f32x4*)(s_ + 4); } } \
        else { const bf16_t* p_ = P + tk_ * NPROJ + vcol + 16 * q4; pa_[S_] = *(const u32x4*)p_; pb_[S_] = *(const u32x4*)(p_ + 8); } } while (0)
#define AT_STORE(bufi, S_) do { if (kside) { LAS bf16_t* d_ = Ks + (bufi) * 4608 + srow * 72 + 8 * q4; \
            if (SWA) { const unsigned a_[4] = {pa_[S_].x, pa_[S_].y, pa_[S_].z, pa_[S_].w}, b_[4] = {pb_[S_].x, pb_[S_].y, pb_[S_].z, pb_[S_].w}; float o1_[8], o2_[8]; \
                _Pragma("unroll") for (int j = 0; j < 8; ++j) { const float x1 = (j & 1) ? bfhi(a_[j >> 1]) : bflo(a_[j >> 1]), x2 = (j & 1) ? bfhi(b_[j >> 1]) : bflo(b_[j >> 1]), cc = j < 4 ? rc0_[S_][j & 3] : rc1_[S_][j & 3], sn = j < 4 ? rs0_[S_][j & 3] : rs1_[S_][j & 3]; \
                    o1_[j] = x1 * cc - x2 * sn; o2_[j] = x2 * cc + x1 * sn; } \
                pa_[S_] = (u32x4){cvt_pk(o1_[0], o1_[1]), cvt_pk(o1_[2], o1_[3]), cvt_pk(o1_[4], o1_[5]), cvt_pk(o1_[6], o1_[7])}; pb_[S_] = (u32x4){cvt_pk(o2_[0], o2_[1]), cvt_pk(o2_[2], o2_[3]), cvt_pk(o2_[4], o2_[5]), cvt_pk(o2_[6], o2_[7])}; } \
            *(LAS u32x4*)d_ = pa_[S_]; *(LAS u32x4*)(d_ + 32) = pb_[S_]; } \
        else { LAS bf16_t* d_ = Vs + (bufi) * 4608 + (16 * q4) * 72 + srow; \
            _Pragma("unroll") for (int j = 0; j < 8; ++j) { d_[j * 72] = hw(pa_[S_], j); d_[(8 + j) * 72] = hw(pb_[S_], j); } } } while (0)
    volatile LAS int* vote = (volatile LAS int*)(F.lds + MISC_OFF + 16);
    __syncthreads();
    if (F.tid < 3) vote[F.tid] = 0;
    AT_FETCH(kt_top, 0); AT_STORE(0, 0);
    if (kt_top > kt_lo) AT_FETCH(kt_top - 1, 1);
    __syncthreads();
    int buf = 0, slot = 0;
    auto trip = [&](const int kt, auto fs_tag) -> bool {
        constexpr int FS_ = decltype(fs_tag)::value;
        const bool mine = !fin && kt <= ktw && kt >= ktl;
        if (mine && F.lane == 0) vote[slot] = 1;
        __syncthreads();
        const int any = vote[slot];
        if (F.tid == 0) vote[slot == 0 ? 2 : slot - 1] = 0;
        slot = slot == 2 ? 0 : slot + 1;
        if (any == 0 && kt < ((SWA ? (q0b + 31) : (q0b + 30)) >> 6)) return false;
        if (kt - 2 >= kt_lo) AT_FETCH(kt - 2, FS_);
        if (mine) {
            const LAS bf16_t* Kb = Ks + buf * 4608; const LAS bf16_t* Vb = Vs + buf * 4608;
            f32x16 st[2];
#pragma unroll
            for (int kb = 0; kb < 2; ++kb) { f32x16 a;
#pragma unroll
                for (int i = 0; i < 16; ++i) a[i] = 0.f;
#pragma unroll
                for (int s = 0; s < 4; ++s) a = __builtin_amdgcn_mfma_f32_32x32x16_bf16(*(const LAS bf16x8*)(Kb + (32 * kb + r) * 72 + 16 * s + 8 * hh), qf[s], a, 0, 0, 0);
                st[kb] = a; }
            if (!SWA) {
                float Rb = R;
#pragma unroll
                for (int kb = 1; kb >= 0; --kb) {
                    float e[16], u[16], p[16];
#pragma unroll
                    for (int i = 0; i < 16; ++i) { const int key = 64 * kt + 32 * kb + (i & 3) + 8 * (i >> 2) + 4 * hh; const float z = fminf(st[kb][i] * 0.18033688011112042f, 30.f); const bool valid = key < t;
                        const float ez = __builtin_amdgcn_exp2f(z); e[i] = valid ? ez : 0.f; u[i] = valid ? 1.f + ez : 1.f; }
                    float gown[4], iq[16];
#pragma unroll
                    for (int g = 0; g < 4; ++g) { const float q32 = u[4 * g + 3] * u[4 * g + 2], q10 = u[4 * g + 1] * u[4 * g]; gown[g] = q32 * q10;
                        const float r0 = __builtin_amdgcn_rcpf(gown[g]);
                        iq[4 * g] = r0; iq[4 * g + 1] = r0 * u[4 * g]; iq[4 * g + 2] = r0 * q10; iq[4 * g + 3] = r0 * q10 * u[4 * g + 2]; }
                    float run = 1.f, ia[4]; const float sc2 = __builtin_amdgcn_exp2f(Rb);
#pragma unroll
                    for (int g = 3; g >= 0; --g) { const float go = other_half(gown[g], hh); ia[g] = sc2 * __builtin_amdgcn_rcpf(run * (hh == 0 ? go : 1.f)); run *= gown[g] * go; }
#pragma unroll
                    for (int i = 0; i < 16; ++i) p[i] = e[i] * (iq[i] * ia[i >> 2]);
                    Rb -= __builtin_amdgcn_logf(run);
#pragma unroll
                    for (int s = 0; s < 2; ++s) { const bf16x8 pf = PACK8(p, 8 * s); const int ko = 32 * kb + 16 * s + 4 * hh;
                        const u32x2 a0 = *(const LAS u32x2*)(Vb + r * 72 + ko), a1 = *(const LAS u32x2*)(Vb + r * 72 + ko + 8), c0 = *(const LAS u32x2*)(Vb + (32 + r) * 72 + ko), c1 = *(const LAS u32x2*)(Vb + (32 + r) * 72 + ko + 8);
                        o0 = __builtin_amdgcn_mfma_f32_32x32x16_bf16(__builtin_bit_cast(bf16x8, (u32x4){a0.x, a0.y, a1.x, a1.y}), pf, o0, 0, 0, 0);
                        o1 = __builtin_amdgcn_mfma_f32_32x32x16_bf16(__builtin_bit_cast(bf16x8, (u32x4){c0.x, c0.y, c1.x, c1.y}), pf, o1, 0, 0, 0); }
                }
                R = Rb;
                fin = __all(R < -115.5f) != 0;
            } else {
                float sv[32]; float tmax = -INFINITY;
#pragma unroll
                for (int kb = 0; kb < 2; ++kb)
#pragma unroll
                    for (int i = 0; i < 16; ++i) { const int key = 64 * kt + 32 * kb + (i & 3) + 8 * (i >> 2) + 4 * hh; const bool valid = (key <= t) && (key + 127 >= t);
                        sv[kb * 16 + i] = valid ? st[kb][i] : -INFINITY; tmax = fmaxf(tmax, sv[kb * 16 + i]); }
                tmax = fmaxf(tmax, other_half(tmax, hh));
                const float mn = fmaxf(m, tmax), sc = __builtin_amdgcn_exp2f(m - mn);
                float psum = 0.f;
#pragma unroll
                for (int i = 0; i < 32; ++i) { sv[i] = __builtin_amdgcn_exp2f(sv[i] - mn); psum += sv[i]; }
                psum += other_half(psum, hh);
                lsum = lsum * sc + psum; m = mn;
#pragma unroll
                for (int i = 0; i < 16; ++i) { o0[i] *= sc; o1[i] *= sc; }
#pragma unroll
                for (int kb = 0; kb < 2; ++kb)
#pragma unroll
                    for (int s = 0; s < 2; ++s) { const bf16x8 pf = PACK8(sv, kb * 16 + 8 * s); const int ko = 32 * kb + 16 * s + 4 * hh;
                        const u32x2 a0 = *(const LAS u32x2*)(Vb + r * 72 + ko), a1 = *(const LAS u32x2*)(Vb + r * 72 + ko + 8), c0 = *(const LAS u32x2*)(Vb + (32 + r) * 72 + ko), c1 = *(const LAS u32x2*)(Vb + (32 + r) * 72 + ko + 8);
                        o0 = __builtin_amdgcn_mfma_f32_32x32x16_bf16(__builtin_bit_cast(bf16x8, (u32x4){a0.x, a0.y, a1.x, a1.y}), pf, o0, 0, 0, 0);
                        o1 = __builtin_amdgcn_mfma_f32_32x32x16_bf16(__builtin_bit_cast(bf16x8, (u32x4){c0.x, c0.y, c1.x, c1.y}), pf, o1, 0, 0, 0); }
            }
        }
        buf ^= 1;
        if (kt > kt_lo) AT_STORE(buf, 1 - FS_);
        return true;
    };
    for (int kt = kt_top; kt >= kt_lo; kt -= 2) {
        if (!trip(kt, IC<0>{})) break;
        if (kt - 1 < kt_lo) break;
        if (!trip(kt - 1, IC<1>{})) break;
    }
    if (SWA) { const float inv = 1.f / lsum;
#pragma unroll
        for (int i = 0; i < 16; ++i) { o0[i] *= inv; o1[i] *= inv; } }
    float ss = 0.f;
#pragma unroll
    for (int i = 0; i < 16; ++i) ss += o0[i] * o0[i] + o1[i] * o1[i];
    ss += other_half(ss, hh);
    const float rstd = rsqrtf(ss * (1.f / 64.f) + NORM_EPS);
    store_ot(MIX + (rowb + t) * DM + (SWA ? 0 : 512) + h * 64, o0, o1, rstd, INF(F, SWA ? I_SWA_ON : I_SB_ON) + l * 256 + h * 64, hh);
#undef AT_FETCH
#undef AT_STORE
}
__device__ __forceinline__ void rwkv_convert_small(Frame& F, int l) {
    bf16_t* W2T = (bf16_t*)(F.ws + WS_SMALLW); bf16_t* A2T = W2T + 256 * 64; bf16_t* G2T = A2T + 256 * 64;
    const float* w2 = INF(F, I_W2) + l * 64 * 256; const float* a2 = INF(F, I_A2) + l * 64 * 256; const float* g2 = INF(F, I_G2) + l * 128 * 256;
    for (int idx = F.bid * 512 + F.tid; idx < 256 * 64; idx += F.G * 512) { const int c = idx >> 6, i = idx & 63; W2T[idx] = f2bf(w2[i * 256 + c]); A2T[idx] = f2bf(a2[i * 256 + c]); }
    for (int idx = F.bid * 512 + F.tid; idx < 256 * 128; idx += F.G * 512) { const int c = idx >> 7, i = idx & 127; G2T[idx] = f2bf(g2[i * 256 + c]); }
}
__device__ __forceinline__ float tanh_f(float x) { return 1.f - 2.f * __builtin_amdgcn_rcpf(__expf(2.f * x) + 1.f); }
constexpr int LP = 72, LPG = 136;
template <int PITCH, int KS>
__device__ __forceinline__ void mm64p(f32x4 (&acc)[2], const LAS bf16_t* A, const LAS bf16_t* B, int mt, int nt0, int lane) {
    const int r16 = lane & 15, kq = lane >> 4;
#pragma unroll
    for (int s = 0; s < KS; ++s) {
        const bf16x8 a = *(const LAS bf16x8*)(A + (16 * mt + r16) * PITCH + 32 * s + 8 * kq);
#pragma unroll
        for (int j = 0; j < 2; ++j) { const bf16x8 b = *(const LAS bf16x8*)(B + (16 * (nt0 + j) + r16) * PITCH + 32 * s + 8 * kq);
            acc[j] = __builtin_amdgcn_mfma_f32_16x16x32_bf16(a, b, acc[j], 0, 0, 0); }
    }
}
__device__ __forceinline__ void mm64(f32x4 (&acc)[2], const LAS bf16_t* A, const LAS bf16_t* B, int mt, int nt0, int lane) { mm64p<LP, 2>(acc, A, B, mt, nt0, lane); }
__device__ __forceinline__ float quad_sum(float v) { v = dpp_add<0xB1>(v); v = dpp_add<0x4E>(v); return v; }
template <int CTRL> __device__ __forceinline__ float quad_bcast(float v) { return __builtin_bit_cast(float, __builtin_amdgcn_update_dpp(0, __builtin_bit_cast(int, v), CTRL, 0xf, 0xf, false)); }
__device__ __forceinline__ float oct_sum(float v) { v = dpp_add<0xB1>(v); v = dpp_add<0x4E>(v); v = dpp_add<0x141>(v); return v; }
__device__ __forceinline__ bf16_t* rw_mat(Frame& F, int unit, int q) { return (bf16_t*)(F.ws + WS_RWM) + (size_t)unit * 16384 + q * 4096; }
__device__ __forceinline__ void rw_lerp8(float (&x)[8], const bf16_t* pc, bool hasprev, const float* mu, int col) {
    const u32x4 c = *(const u32x4*)(pc + col); u32x4 p = (u32x4){0u, 0u, 0u, 0u}; if (hasprev) p = *(const u32x4*)(pc - NPROJ + col);
    const f32x4 m0 = *(const f32x4*)(mu + col), m1 = *(const f32x4*)(mu + col + 4);
    x[0] = bflo(c.x) + (bflo(p.x) - bflo(c.x)) * m0[0]; x[1] = bfhi(c.x) + (bfhi(p.x) - bfhi(c.x)) * m0[1]; x[2] = bflo(c.y) + (bflo(p.y) - bflo(c.y)) * m0[2]; x[3] = bfhi(c.y) + (bfhi(p.y) - bfhi(c.y)) * m0[3];
    x[4] = bflo(c.z) + (bflo(p.z) - bflo(c.z)) * m1[0]; x[5] = bfhi(c.z) + (bfhi(p.z) - bfhi(c.z)) * m1[1]; x[6] = bflo(c.w) + (bflo(p.w) - bflo(c.w)) * m1[2]; x[7] = bfhi(c.w) + (bfhi(p.w) - bfhi(c.w)) * m1[3];
}
struct RwRaw { u32x4 c[7], p[7]; };
__device__ __forceinline__ void rw_load_raw(Frame& F, RwRaw& raw, int unit) {
    const int n = unit & 63, h = (unit >> 6) & 3, b = unit >> 8, tokc = b * SEQ + n * 64 + (F.tid >> 3), k0 = (F.tid & 7) * 8; const bool hasprev = (tokc & (SEQ - 1)) != 0;
    const bf16_t* pc = (const bf16_t*)(F.ws + WS_PROJ) + (size_t)tokc * NPROJ + PD + k0;
    const int col[7] = {768, 832, 896, 960, h * 64, 256 + h * 64, 512 + h * 64};
#pragma unroll
    for (int g = 0; g < 7; ++g) { raw.c[g] = *(const u32x4*)(pc + col[g]); raw.p[g] = (u32x4){0u, 0u, 0u, 0u}; if (hasprev) raw.p[g] = *(const u32x4*)(pc - NPROJ + col[g]); }
}
__device__ __forceinline__ void rw_lerp8r(float (&x)[8], const u32x4 c, const u32x4 p, const LAS float* mu, int col) {
    const f32x4 m0 = *(const LAS f32x4*)(mu + col), m1 = *(const LAS f32x4*)(mu + col + 4);
    x[0] = bflo(c.x) + (bflo(p.x) - bflo(c.x)) * m0[0]; x[1] = bfhi(c.x) + (bfhi(p.x) - bfhi(c.x)) * m0[1]; x[2] = bflo(c.y) + (bflo(p.y) - bflo(c.y)) * m0[2]; x[3] = bfhi(c.y) + (bfhi(p.y) - bfhi(c.y)) * m0[3];
    x[4] = bflo(c.z) + (bflo(p.z) - bflo(c.z)) * m1[0]; x[5] = bfhi(c.z) + (bfhi(p.z) - bfhi(c.z)) * m1[1]; x[6] = bflo(c.w) + (bflo(p.w) - bflo(c.w)) * m1[2]; x[7] = bfhi(c.w) + (bfhi(p.w) - bfhi(c.w)) * m1[3];
}
__device__ __forceinline__ u32x4 pack8v(const float (&x)[8]) { u32x4 w; w.x = cvt_pk(x[0], x[1]); w.y = cvt_pk(x[2], x[3]); w.z = cvt_pk(x[4], x[5]); w.w = cvt_pk(x[6], x[7]); return w; }

constexpr int R1_TAB = 125440;
__device__ __forceinline__ void rwkv_r1_tables(Frame& F, int l) {
    LAS float* T = (LAS float*)(F.lds + R1_TAB);
    const float* mu = INF(F, I_MU) + l * 1024; const float* w0 = INF(F, I_W0) + l * 256; const float* a0 = INF(F, I_A0) + l * 256; const float* kk = INF(F, I_KK) + l * 256; const float* ka = INF(F, I_KA) + l * 256; const float* rk = INF(F, I_RK) + l * 256;
    T[F.tid] = mu[F.tid]; T[512 + F.tid] = mu[512 + F.tid];
    if (F.tid < 256) { T[1024 + F.tid] = w0[F.tid]; T[1280 + F.tid] = a0[F.tid]; T[1536 + F.tid] = kk[F.tid]; T[1792 + F.tid] = ka[F.tid]; T[2048 + F.tid] = rk[F.tid]; }
    __syncthreads();
}
__device__ __forceinline__ void rwkv_r1_unit(Frame& F, int l, int unit, int stop = 0) {
    const int n = unit & 63, h = (unit >> 6) & 3, b = unit >> 8, tok0 = b * SEQ + n * 64;
#define SLOT(i) ((LAS bf16_t*)(F.lds + (i) * 9216))
    LAS float* F0 = (LAS float*)(F.lds + 92160); LAS float* F1 = (LAS float*)(F.lds + 92160 + 16384); LAS float* GC = (LAS float*)(F.lds + 92160 + 32768);
    LAS float* F2 = (LAS float*)F.lds;
    LAS bf16_t* XG = (LAS bf16_t*)(F.lds + 55296); LAS bf16_t* WG2 = (LAS bf16_t*)(F.lds + 72704);
    const int w = F.wave, mt = w & 3, nt0 = (w >> 2) * 2, r16 = F.lane & 15, kq = F.lane >> 4;
    const int t = F.tid >> 3, k0 = (F.tid & 7) * 8;
    const LAS float* TAB = (const LAS float*)(F.lds + R1_TAB); const LAS float* mu = TAB;
    const int tokc = tok0 + t;
    float r8[8], k8[8], v8[8], lw8[8], kk8[8], b8[8];
    RwRaw raw; rw_load_raw(F, raw, unit);
    __syncthreads();
    { float x[8];
      rw_lerp8r(x, raw.c[0], raw.p[0], mu, 768 + k0);
#pragma unroll
      for (int j = 0; j < 8; ++j) x[j] = tanh_f(x[j]);
      *(LAS u32x4*)(SLOT(2) + t * LP + k0) = pack8v(x);
      rw_lerp8r(x, raw.c[1], raw.p[1], mu, 832 + k0); *(LAS u32x4*)(SLOT(3) + t * LP + k0) = pack8v(x);
#pragma unroll
      for (int hf = 0; hf < 2; ++hf) { rw_lerp8r(x, raw.c[2 + hf], raw.p[2 + hf], mu, 896 + 64 * hf + k0);
#pragma unroll
          for (int j = 0; j < 8; ++j) x[j] = sigmoid_f(x[j]);
          *(LAS u32x4*)(XG + t * LPG + 64 * hf + k0) = pack8v(x); }
      const bf16_t* W2T = (const bf16_t*)(F.ws + WS_SMALLW); const bf16_t* A2T = W2T + 256 * 64; const bf16_t* G2T = A2T + 256 * 64;
      *(LAS u32x4*)(SLOT(4) + t * LP + k0) = *(const u32x4*)(W2T + (h * 64 + t) * 64 + k0); *(LAS u32x4*)(SLOT(5) + t * LP + k0) = *(const u32x4*)(A2T + (h * 64 + t) * 64 + k0);
      *(LAS u32x4*)(WG2 + t * LPG + k0) = *(const u32x4*)(G2T + (h * 64 + t) * 128 + k0); *(LAS u32x4*)(WG2 + t * LPG + 64 + k0) = *(const u32x4*)(G2T + (h * 64 + t) * 128 + 64 + k0);
      rw_lerp8r(r8, raw.c[4], raw.p[4], mu, h * 64 + k0); rw_lerp8r(k8, raw.c[5], raw.p[5], mu, 256 + h * 64 + k0); rw_lerp8r(v8, raw.c[6], raw.p[6], mu, 512 + h * 64 + k0); }
    __syncthreads();
    if (stop == 1) return;
    { f32x4 a0[2] = {{0.f, 0.f, 0.f, 0.f}, {0.f, 0.f, 0.f, 0.f}}, a1[2] = {{0.f, 0.f, 0.f, 0.f}, {0.f, 0.f, 0.f, 0.f}}, a2[2] = {{0.f, 0.f, 0.f, 0.f}, {0.f, 0.f, 0.f, 0.f}};
      mm64(a0, SLOT(2), SLOT(4), mt, nt0, F.lane); mm64(a1, SLOT(3), SLOT(5), mt, nt0, F.lane); mm64p<LPG, 4>(a2, XG, WG2, mt, nt0, F.lane);
      __syncthreads();
#pragma unroll
      for (int j = 0; j < 2; ++j)
#pragma unroll
          for (int rg = 0; rg < 4; ++rg) { const int o = (16 * mt + 4 * kq + rg) * 64 + 16 * (nt0 + j) + r16; F0[o] = a0[j][rg]; F1[o] = a1[j][rg]; F2[o] = a2[j][rg]; } }
    __syncthreads();
    if (stop == 2) return;
    { const int col = h * 64 + k0;
      const f32x4 w0a = *(const LAS f32x4*)(TAB + 1024 + col), w0b = *(const LAS f32x4*)(TAB + 1024 + col + 4), a0a = *(const LAS f32x4*)(TAB + 1280 + col), a0b = *(const LAS f32x4*)(TAB + 1280 + col + 4);
      const f32x4 kka = *(const LAS f32x4*)(TAB + 1536 + col), kkb = *(const LAS f32x4*)(TAB + 1536 + col + 4), kaa = *(const LAS f32x4*)(TAB + 1792 + col), kab = *(const LAS f32x4*)(TAB + 1792 + col + 4);
      const f32x4 rka = *(const LAS f32x4*)(TAB + 2048 + col), rkb = *(const LAS f32x4*)(TAB + 2048 + col + 4);
      const f32x4 p0a = *(const LAS f32x4*)(F0 + t * 64 + k0), p0b = *(const LAS f32x4*)(F0 + t * 64 + k0 + 4), p1a = *(const LAS f32x4*)(F1 + t * 64 + k0), p1b = *(const LAS f32x4*)(F1 + t * 64 + k0 + 4);
      const f32x4 p2a = *(const LAS f32x4*)(F2 + t * 64 + k0), p2b = *(const LAS f32x4*)(F2 + t * 64 + k0 + 4);
      float g8[8], ssq = 0.f, srkr = 0.f;
#pragma unroll
      for (int j = 0; j < 8; ++j) { const float w0 = j < 4 ? w0a[j & 3] : w0b[j & 3], a0 = j < 4 ? a0a[j & 3] : a0b[j & 3], k_k = j < 4 ? kka[j & 3] : kkb[j & 3], k_a = j < 4 ? kaa[j & 3] : kab[j & 3], r_k = j < 4 ? rka[j & 3] : rkb[j & 3];
          const float pw = j < 4 ? p0a[j & 3] : p0b[j & 3], pa = j < 4 ? p1a[j & 3] : p1b[j & 3]; g8[j] = j < 4 ? p2a[j & 3] : p2b[j & 3];
          const float a = sigmoid_f(a0 + pa); lw8[j] = bf2f(f2bf(-0.6065306597126334f * sigmoid_f(w0 + pw)));
          kk8[j] = k8[j] * k_k; const float km = k8[j] * (1.f + (a - 1.f) * k_a); b8[j] = kk8[j] * a; k8[j] = km;
          ssq += kk8[j] * kk8[j]; srkr += r8[j] * km * r_k; }
      ssq = oct_sum(ssq); srkr = oct_sum(srkr);
      const float rs = rsqrtf(ssq + 1e-12f);
#pragma unroll
      for (int j = 0; j < 8; ++j) { kk8[j] *= rs; b8[j] *= rs; }
      *(u32x4*)((bf16_t*)(F.ws + WS_RW_V) + (size_t)tokc * 256 + col) = pack8v(v8); *(u32x4*)((bf16_t*)(F.ws + WS_RW_G) + (size_t)tokc * 256 + col) = pack8v(g8);
      if ((F.tid & 7) == 0) ((float*)(F.ws + WS_RKR))[(size_t)tokc * 4 + h] = srkr; }
    __syncthreads();
    if (stop == 3) return;
#pragma unroll
    for (int j = 0; j < 8; ++j) { SLOT(0)[(k0 + j) * LP + t] = f2bf(lw8[j]); SLOT(1)[t * LP + k0 + j] = (k0 + j <= t) ? (bf16_t)0x3F80 : (bf16_t)0; }
    __syncthreads();
    { f32x4 acc[2] = {{0.f, 0.f, 0.f, 0.f}, {0.f, 0.f, 0.f, 0.f}}; mm64(acc, SLOT(1), SLOT(0), mt, nt0, F.lane);
#pragma unroll
      for (int j = 0; j < 2; ++j)
#pragma unroll
          for (int rg = 0; rg < 4; ++rg) F0[(16 * mt + 4 * kq + rg) * 64 + 16 * (nt0 + j) + r16] = acc[j][rg]; }
    __syncthreads();
    { const f32x4 c0 = *(const LAS f32x4*)(F0 + t * 64 + k0), c1 = *(const LAS f32x4*)(F0 + t * 64 + k0 + 4);
      const float cum[8] = {c0[0], c0[1], c0[2], c0[3], c1[0], c1[1], c1[2], c1[3]};
      float ka[8], bt[8], kt[8], rt[8];
#pragma unroll
      for (int j = 0; j < 8; ++j) { const float epos = __expf(cum[j]), eneg = __expf(-cum[j]), eprev = __expf(cum[j] - lw8[j]);
          ka[j] = kk8[j] * eprev; bt[j] = b8[j] * eneg; kt[j] = k8[j] * eneg; rt[j] = r8[j] * epos;
          if (t == 63) GC[k0 + j] = epos; }
      const u32x4 pka = pack8v(ka), pb = pack8v(bt), pq = pack8v(kt), prr = pack8v(rt), pv = pack8v(v8);
      *(LAS u32x4*)(SLOT(0) + t * LP + k0) = pka; *(LAS u32x4*)(SLOT(1) + t * LP + k0) = pb; *(LAS u32x4*)(SLOT(2) + t * LP + k0) = pq; *(LAS u32x4*)(SLOT(3) + t * LP + k0) = prr;
#pragma unroll
      for (int j = 0; j < 8; ++j) { SLOT(4)[(k0 + j) * LP + t] = hw(pb, j); SLOT(5)[(k0 + j) * LP + t] = hw(pq, j); SLOT(6)[(k0 + j) * LP + t] = hw(pv, j); } }
    __syncthreads();
    if (stop == 4) return;
    { f32x4 aLb[2] = {{0.f, 0.f, 0.f, 0.f}, {0.f, 0.f, 0.f, 0.f}}, aLk[2] = {{0.f, 0.f, 0.f, 0.f}, {0.f, 0.f, 0.f, 0.f}}, aMb[2] = {{0.f, 0.f, 0.f, 0.f}, {0.f, 0.f, 0.f, 0.f}}, aMk[2] = {{0.f, 0.f, 0.f, 0.f}, {0.f, 0.f, 0.f, 0.f}};
      mm64(aLb, SLOT(0), SLOT(1), mt, nt0, F.lane); mm64(aLk, SLOT(0), SLOT(2), mt, nt0, F.lane); mm64(aMb, SLOT(3), SLOT(1), mt, nt0, F.lane); mm64(aMk, SLOT(3), SLOT(2), mt, nt0, F.lane);
#pragma unroll
      for (int j = 0; j < 2; ++j)
#pragma unroll
          for (int rg = 0; rg < 4; ++rg) { const int tt = 16 * mt + 4 * kq + rg, ii = 16 * (nt0 + j) + r16;
              F0[tt * 64 + (ii & 3) * 16 + (ii >> 2)] = (ii < tt) ? aLb[j][rg] : 0.f;
              SLOT(7)[tt * LP + ii] = f2bf((ii < tt) ? aLk[j][rg] : 0.f); SLOT(8)[tt * LP + ii] = f2bf((ii <= tt) ? aMb[j][rg] : 0.f); SLOT(9)[tt * LP + ii] = f2bf((ii <= tt) ? aMk[j][rg] : 0.f); } }
    __syncthreads();
    if (stop == 5) return;
    { f32x4 acc[2] = {{0.f, 0.f, 0.f, 0.f}, {0.f, 0.f, 0.f, 0.f}}; mm64(acc, SLOT(7), SLOT(6), mt, nt0, F.lane);
#pragma unroll
      for (int j = 0; j < 2; ++j)
#pragma unroll
          for (int rg = 0; rg < 4; ++rg) F1[(16 * mt + 4 * kq + rg) * 64 + 16 * (nt0 + j) + r16] = acc[j][rg]; }
    __syncthreads();
    if (stop == 6) return;
    { const int col = F.tid >> 2, jq = F.tid & 3; float x[16], rhs[16];
#pragma unroll
      for (int m = 0; m < 16; ++m) { x[m] = 0.f; rhs[m] = (col < 64) ? bf2f(SLOT(0)[(4 * m + jq) * LP + col]) : F1[(4 * m + jq) * 64 + (col - 64)]; }
#pragma unroll
      for (int m = 0; m < 16; ++m) { float pa[4] = {0.f, 0.f, 0.f, 0.f};
#pragma unroll
          for (int a = 0; a < 4; ++a)
#pragma unroll
              for (int m4 = 0; 4 * m4 < m; ++m4) { const f32x4 lq = *(const LAS f32x4*)(F0 + (4 * m + a) * 64 + jq * 16 + 4 * m4);
#pragma unroll
                  for (int e = 0; e < 4; ++e) if (4 * m4 + e < m) pa[a] += lq[e] * x[4 * m4 + e]; }
          const float t0 = quad_sum(pa[0]), t1 = quad_sum(pa[1]), t2 = quad_sum(pa[2]), t3 = quad_sum(pa[3]);
          const LAS float* lrow = F0 + (4 * m + jq) * 64 + m;
          const float c0 = lrow[0], c1 = lrow[16], c2 = lrow[32];
          float y = rhs[m] - (jq == 0 ? t0 : (jq == 1 ? t1 : (jq == 2 ? t2 : t3)));
          y -= c0 * quad_bcast<0x00>(y); y -= c1 * quad_bcast<0x55>(y); y -= c2 * quad_bcast<0xAA>(y);
          x[m] = y; }
      LAS bf16_t* dst = (col < 64) ? (SLOT(7) + col * LP) : (SLOT(1) + (col - 64) * LP);
#pragma unroll
      for (int m = 0; m < 16; ++m) dst[4 * m + jq] = f2bf(-x[m]); }
    __syncthreads();
    if (stop == 7) return;
    { f32x4 aG[2] = {{0.f, 0.f, 0.f, 0.f}, {0.f, 0.f, 0.f, 0.f}}, aH[2] = {{0.f, 0.f, 0.f, 0.f}, {0.f, 0.f, 0.f, 0.f}}, aR[2] = {{0.f, 0.f, 0.f, 0.f}, {0.f, 0.f, 0.f, 0.f}}, aY[2] = {{0.f, 0.f, 0.f, 0.f}, {0.f, 0.f, 0.f, 0.f}};
      mm64(aG, SLOT(7), SLOT(4), mt, nt0, F.lane);
      mm64(aH, SLOT(5), SLOT(6), mt, nt0, F.lane); mm64(aH, SLOT(4), SLOT(1), mt, nt0, F.lane);
      mm64(aR, SLOT(7), SLOT(8), mt, nt0, F.lane);
      mm64(aY, SLOT(9), SLOT(6), mt, nt0, F.lane); mm64(aY, SLOT(8), SLOT(1), mt, nt0, F.lane);
      bf16_t* MG = rw_mat(F, unit, 0); bf16_t* MR = rw_mat(F, unit, 1); bf16_t* MH = rw_mat(F, unit, 2); bf16_t* MY = rw_mat(F, unit, 3);
#pragma unroll
      for (int j = 0; j < 2; ++j) { const int cc = 16 * (nt0 + j) + r16, r0 = 16 * mt + 4 * kq;
          const float gcc = GC[cc]; const u32x2 rtw = *(const LAS u32x2*)(SLOT(3) + cc * LP + r0);
          float gv[4], hv[4], rv[4], yv[4];
#pragma unroll
          for (int rg = 0; rg < 4; ++rg) { gv[rg] = gcc * ((r0 + rg == cc ? 1.f : 0.f) + aG[j][rg]); hv[rg] = GC[r0 + rg] * aH[j][rg]; yv[rg] = aY[j][rg] * 1.0f; }
          rv[0] = bflo(rtw.x) + aR[j][0]; rv[1] = bfhi(rtw.x) + aR[j][1]; rv[2] = bflo(rtw.y) + aR[j][2]; rv[3] = bfhi(rtw.y) + aR[j][3];
          u32x2 o; o.x = pg8::cvt_pk_c(gv[0], gv[1]); o.y = pg8::cvt_pk_c(gv[2], gv[3]); *(u32x2*)(MG + cc * 64 + r0) = o;
          o.x = pg8::cvt_pk_c(rv[0], rv[1]); o.y = pg8::cvt_pk_c(rv[2], rv[3]); *(u32x2*)(MR + cc * 64 + r0) = o;
          o.x = pg8::cvt_pk_c(hv[0], hv[1]); o.y = pg8::cvt_pk_c(hv[2], hv[3]); *(u32x2*)(MH + cc * 64 + r0) = o;
          o.x = pg8::cvt_pk_c(yv[0], yv[1]); o.y = pg8::cvt_pk_c(yv[2], yv[3]); *(u32x2*)(MY + cc * 64 + r0) = o; } }
#undef SLOT
}

__device__ __forceinline__ void rwkv_r2_block(Frame& F, int bh) {
    LAS bf16_t* Sx = (LAS bf16_t*)F.lds; LAS bf16_t* Gs = (LAS bf16_t*)(F.lds + 9216);
    bf16_t* SG = (bf16_t*)(F.ws + WS_RW_S);
    const int w = F.wave, mt = w & 3, nt0 = (w >> 2) * 2, r16 = F.lane & 15, kq = F.lane >> 4;
    const int grow = F.tid >> 3, gc0 = (F.tid & 7) * 8;
    f32x4 st[2] = {{0.f, 0.f, 0.f, 0.f}, {0.f, 0.f, 0.f, 0.f}};
    constexpr int PF = 4;
    u32x4 gq[PF]; u32x2 hq[PF][2];
#define R2_FETCH(slot, n_) do { const int u_ = bh * 64 + (n_); gq[slot] = *(const u32x4*)(rw_mat(F, u_, 0) + grow * 64 + gc0); \
        _Pragma("unroll") for (int j_ = 0; j_ < 2; ++j_) hq[slot][j_] = *(const u32x2*)(rw_mat(F, u_, 2) + (16 * (nt0 + j_) + r16) * 64 + 16 * mt + 4 * kq); } while (0)
#pragma unroll
    for (int i = 0; i < PF; ++i) R2_FETCH(i, i);
    __syncthreads();
    for (int n0 = 0; n0 < 64; n0 += PF) {
#pragma unroll
        for (int i = 0; i < PF; ++i) { const int n = n0 + i; const int unit = bh * 64 + n;
#pragma unroll
            for (int j = 0; j < 2; ++j) { u32x2 ps; ps.x = pg8::cvt_pk_c(st[j][0], st[j][1]); ps.y = pg8::cvt_pk_c(st[j][2], st[j][3]);
                const int vv = 16 * (nt0 + j) + r16, kk0 = 16 * mt + 4 * kq;
                *(LAS u32x2*)(Sx + vv * LP + kk0) = ps; *(u32x2*)(SG + (size_t)unit * 4096 + vv * 64 + kk0) = ps; }
            *(LAS u32x4*)(Gs + grow * LP + gc0) = gq[i];
            f32x4 acc[2];
#pragma unroll
            for (int j = 0; j < 2; ++j) { acc[j][0] = bflo(hq[i][j].x); acc[j][1] = bfhi(hq[i][j].x); acc[j][2] = bflo(hq[i][j].y); acc[j][3] = bfhi(hq[i][j].y); }
            if (n + PF < 64) R2_FETCH(i, n + PF);
            __syncthreads();
            mm64(acc, Gs, Sx, mt, nt0, F.lane);
            st[0] = acc[0]; st[1] = acc[1];
            __syncthreads();
        }
    }
#undef R2_FETCH
}

__device__ __forceinline__ void rwkv_r3_task(Frame& F, int l, int unit) {
    const int n = unit & 63, h = (unit >> 6) & 3, b = unit >> 8, tok0 = b * SEQ + n * 64;
    const int r16 = F.lane & 15, kq = F.lane >> 4;
    const bf16_t* SG = (const bf16_t*)(F.ws + WS_RW_S) + (size_t)unit * 4096;
    const bf16_t* MR = rw_mat(F, unit, 1); const bf16_t* MY = rw_mat(F, unit, 3);
    bf16x8 sb[4][2];
#pragma unroll
    for (int nt = 0; nt < 4; ++nt)
#pragma unroll
        for (int s = 0; s < 2; ++s) sb[nt][s] = *(const bf16x8*)(SG + (16 * nt + r16) * 64 + 32 * s + 8 * kq);
    const float* lnw = INF(F, I_LNW) + l * 256 + h * 64; const float* lnb = INF(F, I_LNB) + l * 256 + h * 64;
    float lw4[4], lb4[4];
#pragma unroll
    for (int nt = 0; nt < 4; ++nt) { lw4[nt] = lnw[16 * nt + r16]; lb4[nt] = lnb[16 * nt + r16]; }
    const bf16_t* SV = (const bf16_t*)(F.ws + WS_RW_V); const bf16_t* SGt = (const bf16_t*)(F.ws + WS_RW_G); const float* RKR = (const float*)(F.ws + WS_RKR);
    bf16_t* MIX = (bf16_t*)(F.ws + WS_MIX);
#pragma unroll 1
    for (int mt = 0; mt < 4; ++mt) {
        f32x4 acc[4];
#pragma unroll
        for (int nt = 0; nt < 4; ++nt) { const u32x2 y0 = *(const u32x2*)(MY + (16 * nt + r16) * 64 + 16 * mt + 4 * kq); acc[nt][0] = bflo(y0.x); acc[nt][1] = bfhi(y0.x); acc[nt][2] = bflo(y0.y); acc[nt][3] = bfhi(y0.y); }
#pragma unroll
        for (int s = 0; s < 2; ++s) { const bf16x8 a = *(const bf16x8*)(MR + (16 * mt + r16) * 64 + 32 * s + 8 * kq);
#pragma unroll
            for (int nt = 0; nt < 4; ++nt) acc[nt] = __builtin_amdgcn_mfma_f32_16x16x32_bf16(a, sb[nt][s], acc[nt], 0, 0, 0); }
#pragma unroll
        for (int rg = 0; rg < 4; ++rg) { const int tok = tok0 + 16 * mt + 4 * kq + rg;
            const float mean = sum16((acc[0][rg] + acc[1][rg]) + (acc[2][rg] + acc[3][rg])) * (1.f / 64.f);
            float d[4], q = 0.f;
#pragma unroll
            for (int nt = 0; nt < 4; ++nt) { d[nt] = acc[nt][rg] - mean; q += d[nt] * d[nt]; }
            const float rstd = rsqrtf(sum16(q) * (1.f / 64.f) + 64e-5f);
            const float rkr = RKR[(size_t)tok * 4 + h];
#pragma unroll
            for (int nt = 0; nt < 4; ++nt) { const int col = h * 64 + 16 * nt + r16;
                const float vv = bf2f(SV[(size_t)tok * 256 + col]), gg = bf2f(SGt[(size_t)tok * 256 + col]);
                MIX[(size_t)tok * DM + 768 + col] = f2bf((d[nt] * rstd * lw4[nt] + lb4[nt] + rkr * vv) * gg); } }
    }
}
template <int PITCH, int KS>
__device__ __forceinline__ void mm_tile(f32x4& acc, const LAS bf16_t* A, const LAS bf16_t* B, int mt, int nt, int lane) {
    const int r16 = lane & 15, kq = lane >> 4;
#pragma unroll
    for (int s = 0; s < KS; ++s)
        acc = __builtin_amdgcn_mfma_f32_16x16x32_bf16(*(const LAS bf16x8*)(A + (16 * mt + r16) * PITCH + 32 * s + 8 * kq), *(const LAS bf16x8*)(B + (16 * nt + r16) * PITCH + 32 * s + 8 * kq), acc, 0, 0, 0);
}
constexpr int GP = 40;
__device__ __forceinline__ void gla_cum(Frame& F, int l, int h, int tok0, LAS bf16_t* LAhi, LAS bf16_t* LAlo, LAS float* Fc) {
    const bf16_t* P = (const bf16_t*)(F.ws + WS_PROJ);
    const float* wa2 = INF(F, I_GLA_WA2) + l * 16 * 128 + h * 32; const float* ba = INF(F, I_GLA_BA) + l * 128 + h * 32;
    const int t = F.tid >> 3, e4 = (F.tid & 7) * 4;
    { const u32x4 l0 = *(const u32x4*)(P + (size_t)(tok0 + t) * NPROJ + PB_LR), l1 = *(const u32x4*)(P + (size_t)(tok0 + t) * NPROJ + PB_LR + 8);
      const float lr[16] = {bflo(l0.x), bfhi(l0.x), bflo(l0.y), bfhi(l0.y), bflo(l0.z), bfhi(l0.z), bflo(l0.w), bfhi(l0.w), bflo(l1.x), bfhi(l1.x), bflo(l1.y), bfhi(l1.y), bflo(l1.z), bfhi(l1.z), bflo(l1.w), bfhi(l1.w)};
      f32x4 a = *(const f32x4*)(ba + e4);
#pragma unroll
      for (int r = 0; r < 16; ++r) a += lr[r] * *(const f32x4*)(wa2 + r * 128 + e4);
#pragma unroll
      for (int j = 0; j < 4; ++j) { const float la = logsigmoid_f(a[j]) * (1.f / 16.f); const bf16_t hi = f2bf(la); const bf16_t lo = f2bf(la - bf2f(hi));
          LAhi[(e4 + j) * LP + t] = hi; LAlo[(e4 + j) * LP + t] = lo; } }
    __syncthreads();
    { const int w = F.wave, mt = w & 3, nt = w >> 2, r16 = F.lane & 15, kq = F.lane >> 4; f32x4 acc = {0.f, 0.f, 0.f, 0.f};
#pragma unroll
      for (int s = 0; s < 2; ++s) { bf16x8 tri;
#pragma unroll
          for (int j = 0; j < 8; ++j) tri[j] = (32 * s + 8 * kq + j <= 16 * mt + r16) ? (short)0x3F80 : (short)0;
          acc = __builtin_amdgcn_mfma_f32_16x16x32_bf16(tri, *(const LAS bf16x8*)(LAhi + (16 * nt + r16) * LP + 32 * s + 8 * kq), acc, 0, 0, 0);
          acc = __builtin_amdgcn_mfma_f32_16x16x32_bf16(tri, *(const LAS bf16x8*)(LAlo + (16 * nt + r16) * LP + 32 * s + 8 * kq), acc, 0, 0, 0); }
#pragma unroll
      for (int rg = 0; rg < 4; ++rg) Fc[(16 * mt + 4 * kq + rg) * 32 + 16 * nt + r16] = acc[rg]; }
    __syncthreads();
}
__device__ __forceinline__ void gla_kv2(Frame& F, int l, int unit) {
    const bf16_t* P = (const bf16_t*)(F.ws + WS_PROJ);
    float* KV = (float*)(F.ws + WS_GLA_KV) + (size_t)unit * 2048; float* DEC = (float*)(F.ws + WS_GLA_DEC) + unit * 32;
    const int n = unit & 63, h = (unit >> 6) & 3, b = unit >> 8, tok0 = b * SEQ + n * 64;
    LAS bf16_t* LAhi = (LAS bf16_t*)F.lds; LAS bf16_t* LAlo = (LAS bf16_t*)(F.lds + 4608); LAS float* Fc = (LAS float*)(F.lds + 9216);
    LAS bf16_t* Ke = (LAS bf16_t*)(F.lds + 17408); LAS bf16_t* Vf = (LAS bf16_t*)(F.lds + 22016);
    const int t = F.tid >> 3, c8 = F.tid & 7;
    __syncthreads();
    gla_cum(F, l, h, tok0, LAhi, LAlo, Fc);
    { const u32x2 kw = *(const u32x2*)(P + (size_t)(tok0 + t) * NPROJ + PB_K + h * 32 + c8 * 4); const u32x4 vw = *(const u32x4*)(P + (size_t)(tok0 + t) * NPROJ + PB_V + h * 64 + c8 * 8);
      const f32x4 ct = *(const LAS f32x4*)(Fc + t * 32 + c8 * 4), cl = *(const LAS f32x4*)(Fc + 63 * 32 + c8 * 4);
      const float kf[4] = {bflo(kw.x), bfhi(kw.x), bflo(kw.y), bfhi(kw.y)};
#pragma unroll
      for (int j = 0; j < 4; ++j) { Ke[(c8 * 4 + j) * LP + t] = f2bf(kf[j] * __expf(cl[j] - ct[j])); if (t == 63) DEC[c8 * 4 + j] = __expf(cl[j]); }
#pragma unroll
      for (int j = 0; j < 8; ++j) Vf[(c8 * 8 + j) * LP + t] = hw(vw, j); }
    __syncthreads();
    { const int w = F.wave, mt = w & 1, nt = w >> 1, r16 = F.lane & 15, kq = F.lane >> 4; f32x4 acc = {0.f, 0.f, 0.f, 0.f};
      mm_tile<LP, 2>(acc, Ke, Vf, mt, nt, F.lane);
#pragma unroll
      for (int rg = 0; rg < 4; ++rg) KV[(16 * mt + 4 * kq + rg) * 64 + 16 * nt + r16] = acc[rg]; }
}
__device__ __forceinline__ void gla_out2(Frame& F, int l, int unit) {
    const bf16_t* P = (const bf16_t*)(F.ws + WS_PROJ); bf16_t* MIX = (bf16_t*)(F.ws + WS_MIX);
    const float* SP = (const float*)(F.ws + WS_GLA_KV) + (size_t)unit * 2048;
    const int n = unit & 63, h = (unit >> 6) & 3, b = unit >> 8, tok0 = b * SEQ + n * 64;
    LAS bf16_t* LAhi = (LAS bf16_t*)F.lds; LAS bf16_t* LAlo = (LAS bf16_t*)(F.lds + 4608); LAS float* Fc = (LAS float*)(F.lds + 9216);
    LAS bf16_t* Qe = (LAS bf16_t*)(F.lds + 17408); LAS bf16_t* Ke = (LAS bf16_t*)(F.lds + 22528); LAS bf16_t* Qb = (LAS bf16_t*)(F.lds + 27648); LAS bf16_t* Sf = (LAS bf16_t*)(F.lds + 32768);
    LAS bf16_t* Vf = (LAS bf16_t*)(F.lds + 37888); LAS bf16_t* At = (LAS bf16_t*)(F.lds + 47104); LAS float* Of = (LAS float*)(F.lds + 56320);
    const int t = F.tid >> 3, c8 = F.tid & 7, w = F.wave, mt = w & 3, nt0 = (w >> 2) * 2, r16 = F.lane & 15, kq = F.lane >> 4;
    __syncthreads();
    gla_cum(F, l, h, tok0, LAhi, LAlo, Fc);
    { const u32x2 qw = *(const u32x2*)(P + (size_t)(tok0 + t) * NPROJ + PB_Q + h * 32 + c8 * 4), kw = *(const u32x2*)(P + (size_t)(tok0 + t) * NPROJ + PB_K + h * 32 + c8 * 4);
      const u32x4 vw = *(const u32x4*)(P + (size_t)(tok0 + t) * NPROJ + PB_V + h * 64 + c8 * 8);
      const f32x4 ct = *(const LAS f32x4*)(Fc + t * 32 + c8 * 4), cr = *(const LAS f32x4*)(Fc + 31 * 32 + c8 * 4);
      const float qs = 0.17677669529663687f;
      const float qf[4] = {bflo(qw.x) * qs, bfhi(qw.x) * qs, bflo(qw.y) * qs, bfhi(qw.y) * qs}, kf[4] = {bflo(kw.x), bfhi(kw.x), bflo(kw.y), bfhi(kw.y)};
      float qe[4], ke[4], qb[4];
#pragma unroll
      for (int j = 0; j < 4; ++j) { qe[j] = qf[j] * __expf(ct[j] - cr[j]); ke[j] = kf[j] * __expf(cr[j] - ct[j]); qb[j] = qf[j] * __expf(ct[j]); }
      u32x2 o; o.x = cvt_pk(qe[0], qe[1]); o.y = cvt_pk(qe[2], qe[3]); *(LAS u32x2*)(Qe + t * GP + c8 * 4) = o;
      o.x = cvt_pk(ke[0], ke[1]); o.y = cvt_pk(ke[2], ke[3]); *(LAS u32x2*)(Ke + t * GP + c8 * 4) = o;
      o.x = cvt_pk(qb[0], qb[1]); o.y = cvt_pk(qb[2], qb[3]); *(LAS u32x2*)(Qb + t * GP + c8 * 4) = o;
#pragma unroll
      for (int j = 0; j < 8; ++j) Vf[(c8 * 8 + j) * LP + t] = hw(vw, j);
      const int e = F.tid >> 4, f4 = (F.tid & 15) * 4; const f32x4 sv = *(const f32x4*)(SP + e * 64 + f4);
#pragma unroll
      for (int j = 0; j < 4; ++j) Sf[(f4 + j) * GP + e] = f2bf(sv[j]); }
    __syncthreads();
    { f32x4 acc[2] = {{0.f, 0.f, 0.f, 0.f}, {0.f, 0.f, 0.f, 0.f}}; mm64p<GP, 1>(acc, Qe, Ke, mt, nt0, F.lane);
#pragma unroll
      for (int j = 0; j < 2; ++j)
#pragma unroll
          for (int rg = 0; rg < 4; ++rg) { const int tt = 16 * mt + 4 * kq + rg, ss = 16 * (nt0 + j) + r16; At[tt * LP + ss] = f2bf(ss <= tt ? acc[j][rg] : 0.f); } }
    __syncthreads();
    { f32x4 acc[2] = {{0.f, 0.f, 0.f, 0.f}, {0.f, 0.f, 0.f, 0.f}}; mm64p<LP, 2>(acc, At, Vf, mt, nt0, F.lane); mm64p<GP, 1>(acc, Qb, Sf, mt, nt0, F.lane);
#pragma unroll
      for (int j = 0; j < 2; ++j)
#pragma unroll
          for (int rg = 0; rg < 4; ++rg) Of[(16 * mt + 4 * kq + rg) * 64 + 16 * (nt0 + j) + r16] = acc[j][rg]; }
    __syncthreads();
    { const int f0 = c8 * 8; const f32x4 o0 = *(const LAS f32x4*)(Of + t * 64 + f0), o1 = *(const LAS f32x4*)(Of + t * 64 + f0 + 4);
      const float o[8] = {o0[0], o0[1], o0[2], o0[3], o1[0], o1[1], o1[2], o1[3]};
      float ss = 0.f;
#pragma unroll
      for (int j = 0; j < 8; ++j) ss += o[j] * o[j];
      ss = oct_sum(ss);
      const float rstd = rsqrtf(ss * (1.f / 64.f) + NORM_EPS); const float* gn = INF(F, I_GLA_ON) + l * 256 + h * 64 + f0;
      const f32x4 g0 = *(const f32x4*)gn, g1 = *(const f32x4*)(gn + 4);
      const u32x4 gw = *(const u32x4*)(P + (size_t)(tok0 + t) * NPROJ + PB_G + h * 64 + f0);
      const float gb[8] = {bflo(gw.x), bfhi(gw.x), bflo(gw.y), bfhi(gw.y), bflo(gw.z), bfhi(gw.z), bflo(gw.w), bfhi(gw.w)};
      float r[8];
#pragma unroll
      for (int j = 0; j < 8; ++j) r[j] = o[j] * rstd * (j < 4 ? g0[j & 3] : g1[j & 3]) * (gb[j] * sigmoid_f(gb[j]));
      *(u32x4*)(MIX + (size_t)(tok0 + t) * DM + 256 + h * 64 + f0) = pack8v(r); }
}

__device__ __forceinline__ void gla_cum_a(Frame& F, int l, int h, int tok0, LAS bf16_t* LAhi, LAS bf16_t* LAlo) {
    const bf16_t* P = (const bf16_t*)(F.ws + WS_PROJ);
    const float* wa2 = INF(F, I_GLA_WA2) + l * 16 * 128 + h * 32; const float* ba = INF(F, I_GLA_BA) + l * 128 + h * 32;
    const int t = F.tid >> 3, e4 = (F.tid & 7) * 4;
    const u32x4 l0 = *(const u32x4*)(P + (size_t)(tok0 + t) * NPROJ + PB_LR), l1 = *(const u32x4*)(P + (size_t)(tok0 + t) * NPROJ + PB_LR + 8);
    const float lr[16] = {bflo(l0.x), bfhi(l0.x), bflo(l0.y), bfhi(l0.y), bflo(l0.z), bfhi(l0.z), bflo(l0.w), bfhi(l0.w), bflo(l1.x), bfhi(l1.x), bflo(l1.y), bfhi(l1.y), bflo(l1.z), bfhi(l1.z), bflo(l1.w), bfhi(l1.w)};
    f32x4 a = *(const f32x4*)(ba + e4);
#pragma unroll
    for (int r = 0; r < 16; ++r) a += lr[r] * *(const f32x4*)(wa2 + r * 128 + e4);
#pragma unroll
    for (int j = 0; j < 4; ++j) { const float la = logsigmoid_f(a[j]) * (1.f / 16.f); const bf16_t hi = f2bf(la); const bf16_t lo = f2bf(la - bf2f(hi));
        LAhi[(e4 + j) * LP + t] = hi; LAlo[(e4 + j) * LP + t] = lo; }
}
__device__ __forceinline__ void gla_cum_b(Frame& F, const LAS bf16_t* LAhi, const LAS bf16_t* LAlo, LAS float* Fc) {
    const int w = F.wave, mt = w & 3, nt = w >> 2, r16 = F.lane & 15, kq = F.lane >> 4; f32x4 acc = {0.f, 0.f, 0.f, 0.f};
#pragma unroll
    for (int s = 0; s < 2; ++s) { bf16x8 tri;
#pragma unroll
        for (int j = 0; j < 8; ++j) tri[j] = (32 * s + 8 * kq + j <= 16 * mt + r16) ? (short)0x3F80 : (short)0;
        acc = __builtin_amdgcn_mfma_f32_16x16x32_bf16(tri, *(const LAS bf16x8*)(LAhi + (16 * nt + r16) * LP + 32 * s + 8 * kq), acc, 0, 0, 0);
        acc = __builtin_amdgcn_mfma_f32_16x16x32_bf16(tri, *(const LAS bf16x8*)(LAlo + (16 * nt + r16) * LP + 32 * s + 8 * kq), acc, 0, 0, 0); }
#pragma unroll
    for (int rg = 0; rg < 4; ++rg) Fc[(16 * mt + 4 * kq + rg) * 32 + 16 * nt + r16] = acc[rg];
}
constexpr int GKV_U = 31232, GOUT_U = 56320;
__device__ __forceinline__ void gla_kv2_pair(Frame& F, int l, int unit0) {
    const bf16_t* P = (const bf16_t*)(F.ws + WS_PROJ);
    const int n = unit0 & 63, h = (unit0 >> 6) & 3, t = F.tid >> 3, c8 = F.tid & 7;
#define GKV_PTRS(uu) const int unit = unit0 + 256 * (uu), tok0 = (unit >> 8) * SEQ + n * 64; LAS unsigned char* B_ = F.lds + (uu) * GKV_U; \
        LAS bf16_t* LAhi = (LAS bf16_t*)B_; LAS bf16_t* LAlo = (LAS bf16_t*)(B_ + 4608); LAS float* Fc = (LAS float*)(B_ + 9216); LAS bf16_t* Ke = (LAS bf16_t*)(B_ + 17408); LAS bf16_t* Vf = (LAS bf16_t*)(B_ + 22016); \
        (void)unit; (void)tok0; (void)LAhi; (void)LAlo; (void)Fc; (void)Ke; (void)Vf
    __syncthreads();
#pragma unroll
    for (int uu = 0; uu < 2; ++uu) { GKV_PTRS(uu); gla_cum_a(F, l, h, tok0, LAhi, LAlo); }
    __syncthreads();
#pragma unroll
    for (int uu = 0; uu < 2; ++uu) { GKV_PTRS(uu); gla_cum_b(F, LAhi, LAlo, Fc); }
    __syncthreads();
#pragma unroll
    for (int uu = 0; uu < 2; ++uu) { GKV_PTRS(uu); float* DEC = (float*)(F.ws + WS_GLA_DEC) + unit * 32;
      const u32x2 kw = *(const u32x2*)(P + (size_t)(tok0 + t) * NPROJ + PB_K + h * 32 + c8 * 4); const u32x4 vw = *(const u32x4*)(P + (size_t)(tok0 + t) * NPROJ + PB_V + h * 64 + c8 * 8);
      const f32x4 ct = *(const LAS f32x4*)(Fc + t * 32 + c8 * 4), cl = *(const LAS f32x4*)(Fc + 63 * 32 + c8 * 4);
      const float kf[4] = {bflo(kw.x), bfhi(kw.x), bflo(kw.y), bfhi(kw.y)};
#pragma unroll
      for (int j = 0; j < 4; ++j) { Ke[(c8 * 4 + j) * LP + t] = f2bf(kf[j] * __expf(cl[j] - ct[j])); if (t == 63) DEC[c8 * 4 + j] = __expf(cl[j]); }
#pragma unroll
      for (int j = 0; j < 8; ++j) Vf[(c8 * 8 + j) * LP + t] = hw(vw, j); }
    __syncthreads();
#pragma unroll
    for (int uu = 0; uu < 2; ++uu) { GKV_PTRS(uu); float* KV = (float*)(F.ws + WS_GLA_KV) + (size_t)unit * 2048;
      const int w = F.wave, mt = w & 1, nt = w >> 1, r16 = F.lane & 15, kq = F.lane >> 4; f32x4 acc = {0.f, 0.f, 0.f, 0.f};
      mm_tile<LP, 2>(acc, Ke, Vf, mt, nt, F.lane);
#pragma unroll
      for (int rg = 0; rg < 4; ++rg) KV[(16 * mt + 4 * kq + rg) * 64 + 16 * nt + r16] = acc[rg]; }
#undef GKV_PTRS
}
__device__ __forceinline__ void gla_out2_pair(Frame& F, int l, int unit0) {
    const bf16_t* P = (const bf16_t*)(F.ws + WS_PROJ); bf16_t* MIX = (bf16_t*)(F.ws + WS_MIX);
    const int n = unit0 & 63, h = (unit0 >> 6) & 3;
    const int t = F.tid >> 3, c8 = F.tid & 7, w = F.wave, mt = w & 3, nt0 = (w >> 2) * 2, r16 = F.lane & 15, kq = F.lane >> 4;
#define GOUT_PTRS(uu) const int unit = unit0 + 256 * (uu), tok0 = (unit >> 8) * SEQ + n * 64; LAS unsigned char* B_ = F.lds + (uu) * GOUT_U; \
        LAS bf16_t* LAhi = (LAS bf16_t*)B_; LAS bf16_t* LAlo = (LAS bf16_t*)(B_ + 4608); LAS float* Fc = (LAS float*)(B_ + 9216); LAS float* Of = (LAS float*)B_; \
        LAS bf16_t* Qe = (LAS bf16_t*)(B_ + 17408); LAS bf16_t* Ke = (LAS bf16_t*)(B_ + 22528); LAS bf16_t* Qb = (LAS bf16_t*)(B_ + 27648); LAS bf16_t* Sf = (LAS bf16_t*)(B_ + 32768); \
        LAS bf16_t* Vf = (LAS bf16_t*)(B_ + 37888); LAS bf16_t* At = (LAS bf16_t*)(B_ + 47104); \
        (void)unit; (void)tok0; (void)LAhi; (void)LAlo; (void)Fc; (void)Of; (void)Qe; (void)Ke; (void)Qb; (void)Sf; (void)Vf; (void)At
    __syncthreads();
#pragma unroll
    for (int uu = 0; uu < 2; ++uu) { GOUT_PTRS(uu); gla_cum_a(F, l, h, tok0, LAhi, LAlo); }
    __syncthreads();
#pragma unroll
    for (int uu = 0; uu < 2; ++uu) { GOUT_PTRS(uu); gla_cum_b(F, LAhi, LAlo, Fc); }
    __syncthreads();
#pragma unroll
    for (int uu = 0; uu < 2; ++uu) { GOUT_PTRS(uu); const float* SP = (const float*)(F.ws + WS_GLA_KV) + (size_t)unit * 2048;
      const u32x2 qw = *(const u32x2*)(P + (size_t)(tok0 + t) * NPROJ + PB_Q + h * 32 + c8 * 4), kw = *(const u32x2*)(P + (size_t)(tok0 + t) * NPROJ + PB_K + h * 32 + c8 * 4);
      const u32x4 vw = *(const u32x4*)(P + (size_t)(tok0 + t) * NPROJ + PB_V + h * 64 + c8 * 8);
      const f32x4 ct = *(const LAS f32x4*)(Fc + t * 32 + c8 * 4), cr = *(const LAS f32x4*)(Fc + 31 * 32 + c8 * 4);
      const float qs = 0.17677669529663687f;
      const float qf[4] = {bflo(qw.x) * qs, bfhi(qw.x) * qs, bflo(qw.y) * qs, bfhi(qw.y) * qs}, kf[4] = {bflo(kw.x), bfhi(kw.x), bflo(kw.y), bfhi(kw.y)};
      float qe[4], ke[4], qb[4];
#pragma unroll
      for (int j = 0; j < 4; ++j) { qe[j] = qf[j] * __expf(ct[j] - cr[j]); ke[j] = kf[j] * __expf(cr[j] - ct[j]); qb[j] = qf[j] * __expf(ct[j]); }
      u32x2 o; o.x = cvt_pk(qe[0], qe[1]); o.y = cvt_pk(qe[2], qe[3]); *(LAS u32x2*)(Qe + t * GP + c8 * 4) = o;
      o.x = cvt_pk(ke[0], ke[1]); o.y = cvt_pk(ke[2], ke[3]); *(LAS u32x2*)(Ke + t * GP + c8 * 4) = o;
      o.x = cvt_pk(qb[0], qb[1]); o.y = cvt_pk(qb[2], qb[3]); *(LAS u32x2*)(Qb + t * GP + c8 * 4) = o;
#pragma unroll
      for (int j = 0; j < 8; ++j) Vf[(c8 * 8 + j) * LP + t] = hw(vw, j);
      const int e = F.tid >> 4, f4 = (F.tid & 15) * 4; const f32x4 sv = *(const f32x4*)(SP + e * 64 + f4);
#pragma unroll
      for (int j = 0; j < 4; ++j) Sf[(f4 + j) * GP + e] = f2bf(sv[j]); }
    __syncthreads();
#pragma unroll
    for (int uu = 0; uu < 2; ++uu) { GOUT_PTRS(uu); f32x4 acc[2] = {{0.f, 0.f, 0.f, 0.f}, {0.f, 0.f, 0.f, 0.f}}; mm64p<GP, 1>(acc, Qe, Ke, mt, nt0, F.lane);
#pragma unroll
      for (int j = 0; j < 2; ++j)
#pragma unroll
          for (int rg = 0; rg < 4; ++rg) { const int tt = 16 * mt + 4 * kq + rg, ss = 16 * (nt0 + j) + r16; At[tt * LP + ss] = f2bf(ss <= tt ? acc[j][rg] : 0.f); } }
    __syncthreads();
#pragma unroll
    for (int uu = 0; uu < 2; ++uu) { GOUT_PTRS(uu); f32x4 acc[2] = {{0.f, 0.f, 0.f, 0.f}, {0.f, 0.f, 0.f, 0.f}}; mm64p<LP, 2>(acc, At, Vf, mt, nt0, F.lane); mm64p<GP, 1>(acc, Qb, Sf, mt, nt0, F.lane);
#pragma unroll
      for (int j = 0; j < 2; ++j)
#pragma unroll
          for (int rg = 0; rg < 4; ++rg) Of[(16 * mt + 4 * kq + rg) * 64 + 16 * (nt0 + j) + r16] = acc[j][rg]; }
    __syncthreads();
#pragma unroll
    for (int uu = 0; uu < 2; ++uu) { GOUT_PTRS(uu); const int f0 = c8 * 8; const f32x4 o0 = *(const LAS f32x4*)(Of + t * 64 + f0), o1 = *(const LAS f32x4*)(Of + t * 64 + f0 + 4);
      const float o[8] = {o0[0], o0[1], o0[2], o0[3], o1[0], o1[1], o1[2], o1[3]};
      float ss = 0.f;
#pragma unroll
      for (int j = 0; j < 8; ++j) ss += o[j] * o[j];
      ss = oct_sum(ss);
      const float rstd = rsqrtf(ss * (1.f / 64.f) + NORM_EPS); const float* gn = INF(F, I_GLA_ON) + l * 256 + h * 64 + f0;
      const f32x4 g0 = *(const f32x4*)gn, g1 = *(const f32x4*)(gn + 4);
      const u32x4 gw = *(const u32x4*)(P + (size_t)(tok0 + t) * NPROJ + PB_G + h * 64 + f0);
      const float gb[8] = {bflo(gw.x), bfhi(gw.x), bflo(gw.y), bfhi(gw.y), bflo(gw.z), bfhi(gw.z), bflo(gw.w), bfhi(gw.w)};
      float r[8];
#pragma unroll
      for (int j = 0; j < 8; ++j) r[j] = o[j] * rstd * (j < 4 ? g0[j & 3] : g1[j & 3]) * (gb[j] * sigmoid_f(gb[j]));
      *(u32x4*)(MIX + (size_t)(tok0 + t) * DM + 256 + h * 64 + f0) = pack8v(r); }
#undef GOUT_PTRS
}
struct Args { const void* in[N_IN]; float* out; unsigned char* ws; int ph_lo, ph_hi, sub, pad; };
constexpr int PH_PER_LAYER = 10, PH_FINAL = DEPTH * PH_PER_LAYER, PH_END = PH_FINAL + 2;
#ifndef EN_MASK
#define EN_MASK 0xFFFF
#endif
#define EN(b) ((EN_MASK >> (b)) & 1)
#ifndef DUP_MASK
#define DUP_MASK 0
#endif
#define NREP(b) (1 + ((DUP_MASK >> (b)) & 1))
enum Phase { P_PREP = 0, P_INPROJ, P_MIX1, P_MIX2, P_MIX3, P_OUTPROJ, P_NORM2, P_MAP, P_UP, P_DOWN };

__global__ void __launch_bounds__(512, 2) fwd_kernel(Args args) {
    extern __shared__ __attribute__((aligned(16))) unsigned char lds_raw[];
    Frame F;
    F.lds = (LAS unsigned char*)lds_raw;
    F.tid = threadIdx.x; F.lane = F.tid & 63; F.wave = __builtin_amdgcn_readfirstlane(F.tid >> 6);
    F.bid = blockIdx.x; F.G = gridDim.x;
    F.ws = args.ws; F.ctl = (unsigned*)(args.ws + WS_CTL); F.out = args.out;
    if (F.tid < N_IN) ((LAS unsigned long long*)(F.lds + PTR_OFF))[F.tid] = (unsigned long long)args.in[F.tid];
    volatile LAS unsigned* MISC = (volatile LAS unsigned*)(F.lds + MISC_OFF);
    if (F.tid < 8) MISC[F.tid] = 0u;
    __syncthreads();
    const int lo = args.ph_lo, hi = args.ph_hi, sub = args.sub;
    const int wave_sgpr = F.wave;
    XcdBarrier bar; bar.bar = F.ctl + CW_BAR; bar.x = 0; bar.st = MISC;
    if (hi - lo > 1) bar = xcd_barrier_post(F.ctl + CW_BAR, MISC);
#define HB ((bf16_t*)(F.ws + WS_H))
#define PROJ ((bf16_t*)(F.ws + WS_PROJ))
#define MIXB ((bf16_t*)(F.ws + WS_MIX))
#define ACT ((bf16_t*)(F.ws + WS_PROJ))
#define XBUF ((bf16_t*)((unsigned char*)F.out + XB_OFF))
#define IN(k) (lo <= (k) && (k) < hi)
#define PH_BEGIN() do { int w_i = wave_sgpr; asm volatile("" : "+s"(w_i)); unsigned m_i = ~0u; asm volatile("" : "+s"(m_i)); int l_i = (int)__builtin_amdgcn_mbcnt_hi(m_i, __builtin_amdgcn_mbcnt_lo(m_i, 0u)); asm volatile("" : "+v"(l_i)); F.wave = w_i; F.lane = l_i; F.tid = w_i * 64 + l_i; \
        GAS unsigned char* w_ = (GAS unsigned char*)args.ws; asm volatile("" : "+s"(w_)); F.ws = (unsigned char*)w_; F.ctl = (unsigned*)((unsigned char*)w_ + WS_CTL); F.out = (float*)(GAS float*)args.out; F.lds = (LAS unsigned char*)lds_raw; } while (0)
#define SEAM(k) do { if ((k) + 1 < hi) { GAS unsigned* bp_ = (GAS unsigned*)(F.ctl + CW_BAR); asm volatile("" : "+s"(bp_)); bar.bar = (unsigned*)bp_; unsigned bx_ = bar.x; asm volatile("" : "+s"(bx_)); bar.x = bx_; int w_j = wave_sgpr; asm volatile("" : "+s"(w_j)); unsigned m_j = ~0u; asm volatile("" : "+s"(m_j)); const int l_j = (int)__builtin_amdgcn_mbcnt_hi(m_j, __builtin_amdgcn_mbcnt_lo(m_j, 0u)); xcd_barrier(bar, w_j == 0 && l_j == 0); } } while (0)

    if (EN(0) && IN(0)) { PH_BEGIN(); phase_rope_tables(F); }
    { constexpr int l = 0;
        const int pb = l * PH_PER_LAYER; const bool moe = (l & 1) != 0; const int ms = l >> 1;

        if (EN(0) && IN(pb + P_PREP)) { PH_BEGIN();
            if (sub & 1) { phase_convert_weights(F, l); rwkv_convert_small(F, l); }
            __syncthreads();
            if (sub & 2) { if (l == 0) phase_norm_lr<true, false>(F, INF(F, I_X), INF(F, I_ATTN_NORM) + l * DM, l); else if (((l - 1) & 1) != 0) phase_norm_lr<false, true>(F, XBUF, INF(F, I_ATTN_NORM) + l * DM, l); else phase_norm_lr<false, false>(F, XBUF, INF(F, I_ATTN_NORM) + l * DM, l); }
            SEAM(pb + P_PREP);
        }
        if (EN(1) && IN(pb + P_INPROJ)) { PH_BEGIN();
            pg8::Gemm g{HB, (const bf16_t*)(F.ws + WS_WIN), DM, nullptr}; pg8::StaticOrder S; S.init(NTOK, 3072, F.G, F.bid);
            pg8::EpiBf16 E{PROJ, NPROJ};
            pg8::gemm_phase<pg8::EpiBf16, pg8::StaticOrder, false>(F.tid, F.lds, g, S, E);
            SEAM(pb + P_INPROJ);
        }
        if (EN(2) && IN(pb + P_MIX1)) { PH_BEGIN();
            if (sub & 1) { rwkv_r1_tables(F, l); for (int unit = F.bid; unit < 2048; unit += F.G) rwkv_r1_unit(F, l, unit, (sub >> 8) & 15); }
            if (sub & 2) for (int unit = F.bid; unit < 2048; unit += 2 * F.G) gla_kv2_pair(F, l, unit);
            SEAM(pb + P_MIX1);
        }
        if (EN(3) && IN(pb + P_MIX2)) { PH_BEGIN();
            if (F.bid < 32) { if (sub & 1) rwkv_r2_block(F, F.bid); }
            else { const int ob = F.bid - 32, NO = F.G - 32;
                if (sub & 2) for (int gt = ob * 512 + F.tid; gt < 65536; gt += NO * 512) gla_scan(F, gt); }
            if (sub & 12) {
                volatile LAS int* qw = (volatile LAS int*)(F.lds + MISC_OFF + 28);
                unsigned* qctr = F.ctl + CW_ATTNQ + 64 * l + ((sub >> 4) & 1) * 32;
                int nxt = 0;
                if (F.tid == 0) nxt = (int)atomicAdd(qctr, 1u);
                for (;;) {
                    __syncthreads();
                    if (F.tid == 0) *qw = nxt;
                    __syncthreads();
                    const int task = *qw;
                    if (task >= 1024) break;
                    if (F.tid == 0) nxt = (int)atomicAdd(qctr, 1u);
                    if (task < 512) { if (sub & 4) attn_block<false>(F, l, task); } else if (sub & 8) attn_block<true>(F, l, task - 512);
                }
            }
            SEAM(pb + P_MIX2);
        }
        if (EN(4) && IN(pb + P_MIX3)) { PH_BEGIN();
            if (sub & 1) for (int unit = F.bid; unit < 2048; unit += 2 * F.G) gla_out2_pair(F, l, unit);
            if (sub & 2) for (int unit = F.bid * 8 + F.wave; unit < 2048; unit += F.G * 8) rwkv_r3_task(F, l, unit);
            SEAM(pb + P_MIX3);
        }
        if (EN(5) && IN(pb + P_OUTPROJ)) { PH_BEGIN();
            __syncthreads();
            pg8::Gemm g{MIXB, (const bf16_t*)(F.ws + WS_WOUT), DM, nullptr}; pg8::StaticOrder S; S.init(NTOK, DM, F.G, F.bid);
            if (l == 0) { pg8::EpiResidB<true> E{INF(F, I_X), XBUF, DM}; pg8::gemm_phase<pg8::EpiResidB<true>, pg8::StaticOrder, false>(F.tid, F.lds, g, S, E); }
            else { pg8::EpiResidB<false> E{XBUF, XBUF, DM}; pg8::gemm_phase<pg8::EpiResidB<false>, pg8::StaticOrder, false>(F.tid, F.lds, g, S, E); }
            SEAM(pb + P_OUTPROJ);
        }
        if (EN(6) && IN(pb + P_NORM2)) { PH_BEGIN();
            if (moe) phase_norm<1, false>(F, XBUF, INF(F, I_FFN_NORM) + l * DM, false, ms);
            else phase_norm<0, false>(F, XBUF, INF(F, I_FFN_NORM) + l * DM, false, 0);
            SEAM(pb + P_NORM2);
        }
        if (EN(7) && IN(pb + P_MAP)) { PH_BEGIN();
            if (moe) { phase_moe_map(F, ms); SEAM(pb + P_MAP); }
        }
        if (EN(8) && IN(pb + P_UP)) { PH_BEGIN();
            __syncthreads();
            if (!moe) {
                pg8::Gemm g{HB, (const bf16_t*)(F.ws + WS_W13), DM / 2, nullptr}; pg8::StaticOrder S; S.init(NTOK, 2 * D_FF, F.G, F.bid);
                pg8::EpiSwiglu8 E{(unsigned char*)ACT, D_FF, 0.015625f};
                pg8::gemm_phase<pg8::EpiSwiglu8, pg8::StaticOrder, false, true>(F.tid, F.lds, g, S, E);
            } else {
                pg8::MoeOrder S; moe_bases(F.ctl + CW_MOECNT + 64 * ms, S.tb); S.ntiles = S.tb[8]; S.nNe = 2 * D_FFE / 256; S.G = F.G; S.c = F.bid;
                pg8::Gemm g{HB, (const bf16_t*)(F.ws + WS_W13), DM / 2, (const int*)(F.ws + WS_ROWMAP)};
                pg8::EpiSwiglu8 E{(unsigned char*)ACT, KP8, 0.015625f};
                pg8::gemm_phase<pg8::EpiSwiglu8, pg8::MoeOrder, true, true>(F.tid, F.lds, g, S, E);
            }
            SEAM(pb + P_UP);
        }
        if (EN(9) && IN(pb + P_DOWN)) { PH_BEGIN();
            __syncthreads();
            if (!moe) {
                pg8::Gemm g{ACT, (const bf16_t*)(F.ws + WS_W2), D_FF / 2, nullptr}; pg8::StaticOrder S; S.init(NTOK, DM, F.G, F.bid);
                pg8::EpiResidB<false> E{XBUF, XBUF, DM, 0.015625f};
                pg8::gemm_phase<pg8::EpiResidB<false>, pg8::StaticOrder, false, true>(F.tid, F.lds, g, S, E);
            } else {
                pg8::MoeOrder S; moe_bases(F.ctl + CW_MOECNT + 64 * ms, S.tb); S.ntiles = S.tb[8]; S.nNe = DM / 256; S.G = F.G; S.c = F.bid;
                pg8::Gemm g{ACT, (const bf16_t*)(F.ws + WS_W2), KP8 / 2, nullptr};
                pg8::EpiBf16 E{(bf16_t*)(F.ws + WS_Y), DM, 0.015625f};
                pg8::gemm_phase<pg8::EpiBf16, pg8::MoeOrder, false, true>(F.tid, F.lds, g, S, E);
            }
            SEAM(pb + P_DOWN);
        }
        }
    { constexpr int l = 1;
        const int pb = l * PH_PER_LAYER; const bool moe = (l & 1) != 0; const int ms = l >> 1;

        if (EN(0) && IN(pb + P_PREP)) { PH_BEGIN();
            if (sub & 1) { phase_convert_weights(F, l); rwkv_convert_small(F, l); }
            __syncthreads();
            if (sub & 2) { if (l == 0) phase_norm_lr<true, false>(F, INF(F, I_X), INF(F, I_ATTN_NORM) + l * DM, l); else if (((l - 1) & 1) != 0) phase_norm_lr<false, true>(F, XBUF, INF(F, I_ATTN_NORM) + l * DM, l); else phase_norm_lr<false, false>(F, XBUF, INF(F, I_ATTN_NORM) + l * DM, l); }
            SEAM(pb + P_PREP);
        }
        if (EN(1) && IN(pb + P_INPROJ)) { PH_BEGIN();
            pg8::Gemm g{HB, (const bf16_t*)(F.ws + WS_WIN), DM, nullptr}; pg8::StaticOrder S; S.init(NTOK, 3072, F.G, F.bid);
            pg8::EpiBf16 E{PROJ, NPROJ};
            pg8::gemm_phase<pg8::EpiBf16, pg8::StaticOrder, false>(F.tid, F.lds, g, S, E);
            SEAM(pb + P_INPROJ);
        }
        if (EN(2) && IN(pb + P_MIX1)) { PH_BEGIN();
            if (sub & 1) { rwkv_r1_tables(F, l); for (int unit = F.bid; unit < 2048; unit += F.G) rwkv_r1_unit(F, l, unit, (sub >> 8) & 15); }
            if (sub & 2) for (int unit = F.bid; unit < 2048; unit += 2 * F.G) gla_kv2_pair(F, l, unit);
            SEAM(pb + P_MIX1);
        }
        if (EN(3) && IN(pb + P_MIX2)) { PH_BEGIN();
            if (F.bid < 32) { if (sub & 1) rwkv_r2_block(F, F.bid); }
            else { const int ob = F.bid - 32, NO = F.G - 32;
                if (sub & 2) for (int gt = ob * 512 + F.tid; gt < 65536; gt += NO * 512) gla_scan(F, gt); }
            if (sub & 12) {
                volatile LAS int* qw = (volatile LAS int*)(F.lds + MISC_OFF + 28);
                unsigned* qctr = F.ctl + CW_ATTNQ + 64 * l + ((sub >> 4) & 1) * 32;
                int nxt = 0;
                if (F.tid == 0) nxt = (int)atomicAdd(qctr, 1u);
                for (;;) {
                    __syncthreads();
                    if (F.tid == 0) *qw = nxt;
                    __syncthreads();
                    const int task = *qw;
                    if (task >= 1024) break;
                    if (F.tid == 0) nxt = (int)atomicAdd(qctr, 1u);
                    if (task < 512) { if (sub & 4) attn_block<false>(F, l, task); } else if (sub & 8) attn_block<true>(F, l, task - 512);
                }
            }
            SEAM(pb + P_MIX2);
        }
        if (EN(4) && IN(pb + P_MIX3)) { PH_BEGIN();
            if (sub & 1) for (int unit = F.bid; unit < 2048; unit += 2 * F.G) gla_out2_pair(F, l, unit);
            if (sub & 2) for (int unit = F.bid * 8 + F.wave; unit < 2048; unit += F.G * 8) rwkv_r3_task(F, l, unit);
            SEAM(pb + P_MIX3);
        }
        if (EN(5) && IN(pb + P_OUTPROJ)) { PH_BEGIN();
            __syncthreads();
            pg8::Gemm g{MIXB, (const bf16_t*)(F.ws + WS_WOUT), DM, nullptr}; pg8::StaticOrder S; S.init(NTOK, DM, F.G, F.bid);
            if (l == 0) { pg8::EpiResidB<true> E{INF(F, I_X), XBUF, DM}; pg8::gemm_phase<pg8::EpiResidB<true>, pg8::StaticOrder, false>(F.tid, F.lds, g, S, E); }
            else { pg8::EpiResidB<false> E{XBUF, XBUF, DM}; pg8::gemm_phase<pg8::EpiResidB<false>, pg8::StaticOrder, false>(F.tid, F.lds, g, S, E); }
            SEAM(pb + P_OUTPROJ);
        }
        if (EN(6) && IN(pb + P_NORM2)) { PH_BEGIN();
            if (moe) phase_norm<1, false>(F, XBUF, INF(F, I_FFN_NORM) + l * DM, false, ms);
            else phase_norm<0, false>(F, XBUF, INF(F, I_FFN_NORM) + l * DM, false, 0);
            SEAM(pb + P_NORM2);
        }
        if (EN(7) && IN(pb + P_MAP)) { PH_BEGIN();
            if (moe) { phase_moe_map(F, ms); SEAM(pb + P_MAP); }
        }
        if (EN(8) && IN(pb + P_UP)) { PH_BEGIN();
            __syncthreads();
            if (!moe) {
                pg8::Gemm g{HB, (const bf16_t*)(F.ws + WS_W13), DM / 2, nullptr}; pg8::StaticOrder S; S.init(NTOK, 2 * D_FF, F.G, F.bid);
                pg8::EpiSwiglu8 E{(unsigned char*)ACT, D_FF, 0.015625f};
                pg8::gemm_phase<pg8::EpiSwiglu8, pg8::StaticOrder, false, true>(F.tid, F.lds, g, S, E);
            } else {
                pg8::MoeOrder S; moe_bases(F.ctl + CW_MOECNT + 64 * ms, S.tb); S.ntiles = S.tb[8]; S.nNe = 2 * D_FFE / 256; S.G = F.G; S.c = F.bid;
                pg8::Gemm g{HB, (const bf16_t*)(F.ws + WS_W13), DM / 2, (const int*)(F.ws + WS_ROWMAP)};
                pg8::EpiSwiglu8 E{(unsigned char*)ACT, KP8, 0.015625f};
                pg8::gemm_phase<pg8::EpiSwiglu8, pg8::MoeOrder, true, true>(F.tid, F.lds, g, S, E);
            }
            SEAM(pb + P_UP);
        }
        if (EN(9) && IN(pb + P_DOWN)) { PH_BEGIN();
            __syncthreads();
            if (!moe) {
                pg8::Gemm g{ACT, (const bf16_t*)(F.ws + WS_W2), D_FF / 2, nullptr}; pg8::StaticOrder S; S.init(NTOK, DM, F.G, F.bid);
                pg8::EpiResidB<false> E{XBUF, XBUF, DM, 0.015625f};
                pg8::gemm_phase<pg8::EpiResidB<false>, pg8::StaticOrder, false, true>(F.tid, F.lds, g, S, E);
            } else {
                pg8::MoeOrder S; moe_bases(F.ctl + CW_MOECNT + 64 * ms, S.tb); S.ntiles = S.tb[8]; S.nNe = DM / 256; S.G = F.G; S.c = F.bid;
                pg8::Gemm g{ACT, (const bf16_t*)(F.ws + WS_W2), KP8 / 2, nullptr};
                pg8::EpiBf16 E{(bf16_t*)(F.ws + WS_Y), DM, 0.015625f};
                pg8::gemm_phase<pg8::EpiBf16, pg8::MoeOrder, false, true>(F.tid, F.lds, g, S, E);
            }
            SEAM(pb + P_DOWN);
        }
        }
    { constexpr int l = 2;
        const int pb = l * PH_PER_LAYER; const bool moe = (l & 1) != 0; const int ms = l >> 1;

        if (EN(0) && IN(pb + P_PREP)) { PH_BEGIN();
            if (sub & 1) { phase_convert_weights(F, l); rwkv_convert_small(F, l); }
            __syncthreads();
            if (sub & 2) { if (l == 0) phase_norm_lr<true, false>(F, INF(F, I_X), INF(F, I_ATTN_NORM) + l * DM, l); else if (((l - 1) & 1) != 0) phase_norm_lr<false, true>(F, XBUF, INF(F, I_ATTN_NORM) + l * DM, l); else phase_norm_lr<false, false>(F, XBUF, INF(F, I_ATTN_NORM) + l * DM, l); }
            SEAM(pb + P_PREP);
        }
        if (EN(1) && IN(pb + P_INPROJ)) { PH_BEGIN();
            pg8::Gemm g{HB, (const bf16_t*)(F.ws + WS_WIN), DM, nullptr}; pg8::StaticOrder S; S.init(NTOK, 3072, F.G, F.bid);
            pg8::EpiBf16 E{PROJ, NPROJ};
            pg8::gemm_phase<pg8::EpiBf16, pg8::StaticOrder, false>(F.tid, F.lds, g, S, E);
            SEAM(pb + P_INPROJ);
        }
        if (EN(2) && IN(pb + P_MIX1)) { PH_BEGIN();
            if (sub & 1) { rwkv_r1_tables(F, l); for (int unit = F.bid; unit < 2048; unit += F.G) rwkv_r1_unit(F, l, unit, (sub >> 8) & 15); }
            if (sub & 2) for (int unit = F.bid; unit < 2048; unit += 2 * F.G) gla_kv2_pair(F, l, unit);
            SEAM(pb + P_MIX1);
        }
        if (EN(3) && IN(pb + P_MIX2)) { PH_BEGIN();
            if (F.bid < 32) { if (sub & 1) rwkv_r2_block(F, F.bid); }
            else { const int ob = F.bid - 32, NO = F.G - 32;
                if (sub & 2) for (int gt = ob * 512 + F.tid; gt < 65536; gt += NO * 512) gla_scan(F, gt); }
            if (sub & 12) {
                volatile LAS int* qw = (volatile LAS int*)(F.lds + MISC_OFF + 28);
                unsigned* qctr = F.ctl + CW_ATTNQ + 64 * l + ((sub >> 4) & 1) * 32;
                int nxt = 0;
                if (F.tid == 0) nxt = (int)atomicAdd(qctr, 1u);
                for (;;) {
                    __syncthreads();
                    if (F.tid == 0) *qw = nxt;
                    __syncthreads();
                    const int task = *qw;
                    if (task >= 1024) break;
                    if (F.tid == 0) nxt = (int)atomicAdd(qctr, 1u);
                    if (task < 512) { if (sub & 4) attn_block<false>(F, l, task); } else if (sub & 8) attn_block<true>(F, l, task - 512);
                }
            }
            SEAM(pb + P_MIX2);
        }
        if (EN(4) && IN(pb + P_MIX3)) { PH_BEGIN();
            if (sub & 1) for (int unit = F.bid; unit < 2048; unit += 2 * F.G) gla_out2_pair(F, l, unit);
            if (sub & 2) for (int unit = F.bid * 8 + F.wave; unit < 2048; unit += F.G * 8) rwkv_r3_task(F, l, unit);
            SEAM(pb + P_MIX3);
        }
        if (EN(5) && IN(pb + P_OUTPROJ)) { PH_BEGIN();
            __syncthreads();
            pg8::Gemm g{MIXB, (const bf16_t*)(F.ws + WS_WOUT), DM, nullptr}; pg8::StaticOrder S; S.init(NTOK, DM, F.G, F.bid);
            if (l == 0) { pg8::EpiResidB<true> E{INF(F, I_X), XBUF, DM}; pg8::gemm_phase<pg8::EpiResidB<true>, pg8::StaticOrder, false>(F.tid, F.lds, g, S, E); }
            else { pg8::EpiResidB<false> E{XBUF, XBUF, DM}; pg8::gemm_phase<pg8::EpiResidB<false>, pg8::StaticOrder, false>(F.tid, F.lds, g, S, E); }
            SEAM(pb + P_OUTPROJ);
        }
        if (EN(6) && IN(pb + P_NORM2)) { PH_BEGIN();
            if (moe) phase_norm<1, false>(F, XBUF, INF(F, I_FFN_NORM) + l * DM, false, ms);
            else phase_norm<0, false>(F, XBUF, INF(F, I_FFN_NORM) + l * DM, false, 0);
            SEAM(pb + P_NORM2);
        }
        if (EN(7) && IN(pb + P_MAP)) { PH_BEGIN();
            if (moe) { phase_moe_map(F, ms); SEAM(pb + P_MAP); }
        }
        if (EN(8) && IN(pb + P_UP)) { PH_BEGIN();
            __syncthreads();
            if (!moe) {
                pg8::Gemm g{HB, (const bf16_t*)(F.ws + WS_W13), DM / 2, nullptr}; pg8::StaticOrder S; S.init(NTOK, 2 * D_FF, F.G, F.bid);
                pg8::EpiSwiglu8 E{(unsigned char*)ACT, D_FF, 0.015625f};
                pg8::gemm_phase<pg8::EpiSwiglu8, pg8::StaticOrder, false, true>(F.tid, F.lds, g, S, E);
            } else {
                pg8::MoeOrder S; moe_bases(F.ctl + CW_MOECNT + 64 * ms, S.tb); S.ntiles = S.tb[8]; S.nNe = 2 * D_FFE / 256; S.G = F.G; S.c = F.bid;
                pg8::Gemm g{HB, (const bf16_t*)(F.ws + WS_W13), DM / 2, (const int*)(F.ws + WS_ROWMAP)};
                pg8::EpiSwiglu8 E{(unsigned char*)ACT, KP8, 0.015625f};
                pg8::gemm_phase<pg8::EpiSwiglu8, pg8::MoeOrder, true, true>(F.tid, F.lds, g, S, E);
            }
            SEAM(pb + P_UP);
        }
        if (EN(9) && IN(pb + P_DOWN)) { PH_BEGIN();
            __syncthreads();
            if (!moe) {
                pg8::Gemm g{ACT, (const bf16_t*)(F.ws + WS_W2), D_FF / 2, nullptr}; pg8::StaticOrder S; S.init(NTOK, DM, F.G, F.bid);
                pg8::EpiResidB<false> E{XBUF, XBUF, DM, 0.015625f};
                pg8::gemm_phase<pg8::EpiResidB<false>, pg8::StaticOrder, false, true>(F.tid, F.lds, g, S, E);
            } else {
                pg8::MoeOrder S; moe_bases(F.ctl + CW_MOECNT + 64 * ms, S.tb); S.ntiles = S.tb[8]; S.nNe = DM / 256; S.G = F.G; S.c = F.bid;
                pg8::Gemm g{ACT, (const bf16_t*)(F.ws + WS_W2), KP8 / 2, nullptr};
                pg8::EpiBf16 E{(bf16_t*)(F.ws + WS_Y), DM, 0.015625f};
                pg8::gemm_phase<pg8::EpiBf16, pg8::MoeOrder, false, true>(F.tid, F.lds, g, S, E);
            }
            SEAM(pb + P_DOWN);
        }
        }
    { constexpr int l = 3;
        const int pb = l * PH_PER_LAYER; const bool moe = (l & 1) != 0; const int ms = l >> 1;

        if (EN(0) && IN(pb + P_PREP)) { PH_BEGIN();
            if (sub & 1) { phase_convert_weights(F, l); rwkv_convert_small(F, l); }
            __syncthreads();
            if (sub & 2) { if (l == 0) phase_norm_lr<true, false>(F, INF(F, I_X), INF(F, I_ATTN_NORM) + l * DM, l); else if (((l - 1) & 1) != 0) phase_norm_lr<false, true>(F, XBUF, INF(F, I_ATTN_NORM) + l * DM, l); else phase_norm_lr<false, false>(F, XBUF, INF(F, I_ATTN_NORM) + l * DM, l); }
            SEAM(pb + P_PREP);
        }
        if (EN(1) && IN(pb + P_INPROJ)) { PH_BEGIN();
            pg8::Gemm g{HB, (const bf16_t*)(F.ws + WS_WIN), DM, nullptr}; pg8::StaticOrder S; S.init(NTOK, 3072, F.G, F.bid);
            pg8::EpiBf16 E{PROJ, NPROJ};
            pg8::gemm_phase<pg8::EpiBf16, pg8::StaticOrder, false>(F.tid, F.lds, g, S, E);
            SEAM(pb + P_INPROJ);
        }
        if (EN(2) && IN(pb + P_MIX1)) { PH_BEGIN();
            if (sub & 1) { rwkv_r1_tables(F, l); for (int unit = F.bid; unit < 2048; unit += F.G) rwkv_r1_unit(F, l, unit, (sub >> 8) & 15); }
            if (sub & 2) for (int unit = F.bid; unit < 2048; unit += 2 * F.G) gla_kv2_pair(F, l, unit);
            SEAM(pb + P_MIX1);
        }
        if (EN(3) && IN(pb + P_MIX2)) { PH_BEGIN();
            if (F.bid < 32) { if (sub & 1) rwkv_r2_block(F, F.bid); }
            else { const int ob = F.bid - 32, NO = F.G - 32;
                if (sub & 2) for (int gt = ob * 512 + F.tid; gt < 65536; gt += NO * 512) gla_scan(F, gt); }
            if (sub & 12) {
                volatile LAS int* qw = (volatile LAS int*)(F.lds + MISC_OFF + 28);
                unsigned* qctr = F.ctl + CW_ATTNQ + 64 * l + ((sub >> 4) & 1) * 32;
                int nxt = 0;
                if (F.tid == 0) nxt = (int)atomicAdd(qctr, 1u);
                for (;;) {
                    __syncthreads();
                    if (F.tid == 0) *qw = nxt;
                    __syncthreads();
                    const int task = *qw;
                    if (task >= 1024) break;
                    if (F.tid == 0) nxt = (int)atomicAdd(qctr, 1u);
                    if (task < 512) { if (sub & 4) attn_block<false>(F, l, task); } else if (sub & 8) attn_block<true>(F, l, task - 512);
                }
            }
            SEAM(pb + P_MIX2);
        }
        if (EN(4) && IN(pb + P_MIX3)) { PH_BEGIN();
            if (sub & 1) for (int unit = F.bid; unit < 2048; unit += 2 * F.G) gla_out2_pair(F, l, unit);
            if (sub & 2) for (int unit = F.bid * 8 + F.wave; unit < 2048; unit += F.G * 8) rwkv_r3_task(F, l, unit);
            SEAM(pb + P_MIX3);
        }
        if (EN(5) && IN(pb + P_OUTPROJ)) { PH_BEGIN();
            __syncthreads();
            pg8::Gemm g{MIXB, (const bf16_t*)(F.ws + WS_WOUT), DM, nullptr}; pg8::StaticOrder S; S.init(NTOK, DM, F.G, F.bid);
            if (l == 0) { pg8::EpiResidB<true> E{INF(F, I_X), XBUF, DM}; pg8::gemm_phase<pg8::EpiResidB<true>, pg8::StaticOrder, false>(F.tid, F.lds, g, S, E); }
            else { pg8::EpiResidB<false> E{XBUF, XBUF, DM}; pg8::gemm_phase<pg8::EpiResidB<false>, pg8::StaticOrder, false>(F.tid, F.lds, g, S, E); }
            SEAM(pb + P_OUTPROJ);
        }
        if (EN(6) && IN(pb + P_NORM2)) { PH_BEGIN();
            if (moe) phase_norm<1, false>(F, XBUF, INF(F, I_FFN_NORM) + l * DM, false, ms);
            else phase_norm<0, false>(F, XBUF, INF(F, I_FFN_NORM) + l * DM, false, 0);
            SEAM(pb + P_NORM2);
        }
        if (EN(7) && IN(pb + P_MAP)) { PH_BEGIN();
            if (moe) { phase_moe_map(F, ms); SEAM(pb + P_MAP); }
        }
        if (EN(8) && IN(pb + P_UP)) { PH_BEGIN();
            __syncthreads();
            if (!moe) {
                pg8::Gemm g{HB, (const bf16_t*)(F.ws + WS_W13), DM / 2, nullptr}; pg8::StaticOrder S; S.init(NTOK, 2 * D_FF, F.G, F.bid);
                pg8::EpiSwiglu8 E{(unsigned char*)ACT, D_FF, 0.015625f};
                pg8::gemm_phase<pg8::EpiSwiglu8, pg8::StaticOrder, false, true>(F.tid, F.lds, g, S, E);
            } else {
                pg8::MoeOrder S; moe_bases(F.ctl + CW_MOECNT + 64 * ms, S.tb); S.ntiles = S.tb[8]; S.nNe = 2 * D_FFE / 256; S.G = F.G; S.c = F.bid;
                pg8::Gemm g{HB, (const bf16_t*)(F.ws + WS_W13), DM / 2, (const int*)(F.ws + WS_ROWMAP)};
                pg8::EpiSwiglu8 E{(unsigned char*)ACT, KP8, 0.015625f};
                pg8::gemm_phase<pg8::EpiSwiglu8, pg8::MoeOrder, true, true>(F.tid, F.lds, g, S, E);
            }
            SEAM(pb + P_UP);
        }
        if (EN(9) && IN(pb + P_DOWN)) { PH_BEGIN();
            __syncthreads();
            if (!moe) {
                pg8::Gemm g{ACT, (const bf16_t*)(F.ws + WS_W2), D_FF / 2, nullptr}; pg8::StaticOrder S; S.init(NTOK, DM, F.G, F.bid);
                pg8::EpiResidB<false> E{XBUF, XBUF, DM, 0.015625f};
                pg8::gemm_phase<pg8::EpiResidB<false>, pg8::StaticOrder, false, true>(F.tid, F.lds, g, S, E);
            } else {
                pg8::MoeOrder S; moe_bases(F.ctl + CW_MOECNT + 64 * ms, S.tb); S.ntiles = S.tb[8]; S.nNe = DM / 256; S.G = F.G; S.c = F.bid;
                pg8::Gemm g{ACT, (const bf16_t*)(F.ws + WS_W2), KP8 / 2, nullptr};
                pg8::EpiBf16 E{(bf16_t*)(F.ws + WS_Y), DM, 0.015625f};
                pg8::gemm_phase<pg8::EpiBf16, pg8::MoeOrder, false, true>(F.tid, F.lds, g, S, E);
            }
            SEAM(pb + P_DOWN);
        }
        }
    if (EN(10) && IN(PH_FINAL)) { PH_BEGIN();
        __syncthreads();
        phase_norm<2, false>(F, XBUF, INF(F, I_FINAL_NORM), true, 0);
        SEAM(PH_FINAL);
    }
    if (EN(10) && IN(PH_FINAL + 1)) { PH_BEGIN(); phase_final_copy(F); }
#undef IN
#undef XBUF
#undef HB
#undef PROJ
#undef MIXB
#undef ACT
#undef PH_BEGIN
#undef SEAM
}

extern "C" void kernel_launch(void* const* d_in, const int* in_sizes, int n_in, void* d_out, int out_size, void* d_ws, size_t ws_size, hipStream_t stream) {
    static int ready = 0;
    if (ready == 0) {
        if (n_in != N_IN || in_sizes[0] != NTOK * DM || out_size != NTOK * DM || ws_size < WS_END) {
            fprintf(stderr, "kernel_launch: unexpected shapes (n_in %d, in0 %d, out %d, ws %zu); nothing launched\n", n_in, n_in > 0 ? in_sizes[0] : -1, out_size, ws_size); ready = -1; return; }
        if (hipFuncSetAttribute((const void*)fwd_kernel, hipFuncAttributeMaxDynamicSharedMemorySize, LDS_BYTES) != hipSuccess) { fprintf(stderr, "kernel_launch: hipFuncSetAttribute failed\n"); ready = -1; return; }
        int per_cu = 0;
        if (hipOccupancyMaxActiveBlocksPerMultiprocessor(&per_cu, (const void*)fwd_kernel, 512, LDS_BYTES) != hipSuccess || per_cu < 1)
            fprintf(stderr, "kernel_launch: note: occupancy query reports %d workgroups per CU\n", per_cu);
        (void)hipGetLastError();
        ready = 1;
    }
    if (ready < 0) return;
    const int grid = 256;
    if (hipMemsetAsync((char*)d_ws + WS_CTL, 0, CTL_ZERO_BYTES, stream) != hipSuccess) { fprintf(stderr, "kernel_launch: memset failed\n"); return; }
    Args a{};
    for (int i = 0; i < N_IN; ++i) a.in[i] = d_in[i];
    a.out = (float*)d_out; a.ws = (unsigned char*)d_ws; a.sub = 0xF;
#if N_LAUNCHES_ONE
    a.ph_lo = 0; a.ph_hi = PH_END;
    hipLaunchKernelGGL(fwd_kernel, dim3(grid), dim3(512), LDS_BYTES, stream, a);
#else
    for (int p = 0; p < PH_END; ++p) {
        if (p < PH_FINAL && (p % PH_PER_LAYER) == P_MAP && (((p / PH_PER_LAYER) & 1) == 0)) continue;
        a.ph_lo = p; a.ph_hi = p + 1; a.sub = 0xF;
        hipLaunchKernelGGL(fwd_kernel, dim3(grid), dim3(512), LDS_BYTES, stream, a);
#if defined(PROBE_PHASE)
        if (p < PH_FINAL && (p % PH_PER_LAYER) == PROBE_PHASE && ((PROBE_LMASK >> (p / PH_PER_LAYER)) & 1)) { a.sub = PROBE_SUB; hipLaunchKernelGGL(fwd_kernel, dim3(grid), dim3(512), LDS_BYTES, stream, a); }
#endif
    }
#endif
    const hipError_t le = hipPeekAtLastError();
    if (le != hipSuccess) fprintf(stderr, "kernel_launch: launch failed: %s\n", hipGetErrorName(le));
}
```

```cpp
#include <hip/hip_runtime.h>
#include <cstdio>
#include <cstdint>

#define LAS __attribute__((address_space(3)))
#define GAS __attribute__((address_space(1)))
typedef unsigned short bf16_t;
typedef short bf16x8 __attribute__((ext_vector_type(8)));
typedef float f32x4 __attribute__((ext_vector_type(4)));
typedef float f32x2 __attribute__((ext_vector_type(2)));
typedef unsigned u32x4 __attribute__((ext_vector_type(4)));
typedef unsigned u32x2 __attribute__((ext_vector_type(2)));

#ifndef N_LAUNCHES_ONE
#define N_LAUNCHES_ONE 1
#endif

constexpr int BATCH = 8, SEQ = 4096, DM = 1024, NTOK = BATCH * SEQ, DEPTH = 4;
constexpr int IN_COLS = 3088, NPROJ = 3328;
constexpr int D_FF = 2816, N_EXP = 8, D_FFE = 1408;
constexpr int KP8 = 1536;
constexpr int PA_Q = 0, PA_K = 256, PA_V = 384;
constexpr int PB_Q = 512, PB_K = 640, PB_V = 768, PB_G = 1024;
constexpr int PC_Q = 1280, PC_K = 1536, PC_V = 1792;
constexpr int PD = 2048;
constexpr int PB_LR = 3072;
constexpr float NORM_EPS = 1e-6f;
constexpr int MOE_ROWS = NTOK * 2 + N_EXP * 256;

constexpr size_t MiB = 1u << 20;
constexpr size_t WS_CTL = 0, CTL_ZERO_BYTES = 1 * MiB;
constexpr size_t WS_ROPE_C = 2 * MiB, WS_ROPE_S = 6 * MiB;
constexpr size_t WS_WIN = 10 * MiB, WS_WOUT = 17 * MiB, WS_W13 = 19 * MiB, WS_W2 = 63 * MiB;
constexpr size_t WS_H = 86 * MiB;
constexpr size_t WS_PROJ = 150 * MiB;
constexpr size_t WS_MIX = 358 * MiB;
constexpr size_t WS_SCR = 422 * MiB;
constexpr size_t WS_RWM = WS_H;
constexpr size_t WS_RW_V = WS_SCR, WS_RW_G = WS_SCR + 16 * MiB, WS_RW_S = WS_SCR + 32 * MiB;
constexpr size_t WS_GLA_KV = 470 * MiB, WS_GLA_DEC = 1 * MiB;
constexpr size_t WS_RKR = 486 * MiB;
constexpr size_t WS_RW_X = 488 * MiB;
constexpr size_t WS_SMALLW = 85 * MiB;
constexpr size_t WS_YRAW = 488 * MiB;
constexpr size_t WS_Y = 358 * MiB;
constexpr size_t WS_TOK_E = 520 * MiB, WS_TOK_G = WS_TOK_E + 256 * 1024, WS_TOK_SLOT = WS_TOK_G + 256 * 1024, WS_TOK_ROW = WS_TOK_SLOT + 256 * 1024, WS_ROWMAP = 521 * MiB;
constexpr size_t WS_END = 522 * MiB;
static_assert(WS_Y + (size_t)MOE_ROWS * 2048 <= WS_TOK_E && WS_YRAW + (size_t)NTOK * 256 * 4 <= WS_TOK_E && WS_W2 + 22 * MiB <= WS_H, "ws map");
constexpr int CW_BAR = 4096;
constexpr int CW_ATTNQ = 12288;
constexpr int CW_MOECNT = 8192;

constexpr size_t XB_OFF = 64 * MiB;
constexpr int LDS_BYTES = 147456;
constexpr int MISC_OFF = 131072 + 8192;

__device__ __forceinline__ float bf2f(unsigned short u) { return __uint_as_float((unsigned)u << 16); }
__device__ __forceinline__ float bflo(unsigned w) { return __uint_as_float(w << 16); }
__device__ __forceinline__ float bfhi(unsigned w) { return __uint_as_float(w & 0xffff0000u); }
__device__ __forceinline__ unsigned short f2bf(float f) { unsigned u = __float_as_uint(f); return (unsigned short)((u + 0x7fffu + ((u >> 16) & 1u)) >> 16); }
__device__ __forceinline__ unsigned pk2(float lo, float hi) { return (unsigned)f2bf(lo) | ((unsigned)f2bf(hi) << 16); }
__device__ __forceinline__ float wave_sum(float v) {
#pragma unroll
    for (int o = 1; o < 64; o <<= 1) v += __shfl_xor(v, o);
    return v;
}
__device__ __forceinline__ float sigmoid_f(float x) { return 1.f / (1.f + __expf(-x)); }
__device__ __forceinline__ float softplus_f(float z) { return fmaxf(z, 0.f) + __logf(1.f + __expf(-fabsf(z))); }
__device__ __forceinline__ float logsigmoid_f(float x) { return fminf(x, 0.f) - __logf(1.f + __expf(-fabsf(x))); }
namespace pg8 {
constexpr int BM = 256, BK = 64, HALF = 128, HTB = HALF * BK * 2  , STAGE_BYTES = 8 * HTB, NXCD = 8, WGM = 8;

__host__ __device__ __forceinline__ int lds_byte(int r, int c) { const int st = (r >> 4) * 2 + (c >> 5), rr = r & 15, cc = c & 31, ob = rr * 64 + cc * 2; return st * 1024 + (ob ^ (((ob >> 9) & 1) << 5)); }
__host__ __device__ __forceinline__ void stage_rc(int b, int& R, int& C) { const int st = b / 1024, sb = b % 1024, swz = sb ^ (((sb >> 9) & 1) << 5); R = (st >> 1) * 16 + swz / 64; C = (st & 1) * 32 + (swz % 64) / 2; }
__host__ __device__ __forceinline__ int perm32(int rho) { const int n = rho >> 4, i = rho & 15; return 8 * (i >> 2) + 4 * n + (i & 3); }

struct Unit { int pm, pn, pc; };
struct Gemm { const bf16_t* A; const bf16_t* Bt; int K; const int* rowmap; };

struct StaticOrder {
    int nM, nN, nwg, G, c;
    __device__ void init(int M, int N, int G_, int c_) { nM = M / BM; nN = N / BM; nwg = nM * nN; G = G_; c = c_; }
    __device__ bool next(int i, Unit& u) const {
        const long L = (long)i * G + c; if (L >= nwg) return false;
        int wgid = (int)L; { const int q = nwg / NXCD, r = nwg % NXCD, xcd = wgid % NXCD, off = wgid / NXCD; wgid = (xcd < r ? xcd * (q + 1) : r * (q + 1) + (xcd - r) * q) + off; }
        const int nig = WGM * nN, gid = wgid / nig, fm = gid * WGM, gsz = (nM - fm) < WGM ? (nM - fm) : WGM;
        u.pm = fm + ((wgid % nig) % gsz); u.pn = (wgid % nig) / gsz; u.pc = u.pn; return true;
    }
};
struct MoeOrder {
    int ntiles, nNe, G, c; int tb[9];
    __device__ bool next(int i, Unit& u) const {
        const long L = (long)i * G + c; if (L >= (long)ntiles * nNe) return false;
        const int pm = (int)(L / nNe), pl = (int)(L % nNe); int e = 0;
#pragma unroll
        for (int j = 1; j < 8; ++j) e += (pm >= tb[j]) ? 1 : 0;
        u.pm = pm; u.pn = e * nNe + pl; u.pc = pl; return true;
    }
};

typedef __bf16 bf16pair_t __attribute__((ext_vector_type(2)));
__device__ __forceinline__ unsigned cvt_pk_c(float lo, float hi) { bf16pair_t v; v[0] = (__bf16)lo; v[1] = (__bf16)hi; return __builtin_bit_cast(unsigned, v); }
__device__ __forceinline__ unsigned cvt_pk_bf16(float lo, float hi) { unsigned r; asm volatile("v_cvt_pk_bf16_f32 %0, %1, %2" : "=v"(r) : "v"(lo), "v"(hi)); return r; }

struct EpiBf16 {
    static constexpr bool PERM = true;
    bf16_t* O; int ldc; float sc = 1.f;
    __device__ __forceinline__ void operator()(const f32x4 (&acc)[2][2][4][2], const Unit& u, int wr, int wc, int fr, int fq) const {
        const int row0 = u.pm * BM + wr * 64 + fr; const int col0 = u.pc * BM + wc * 32 + 8 * fq;
#pragma unroll
        for (int ai = 0; ai < 2; ++ai)
#pragma unroll
            for (int m = 0; m < 4; ++m) { bf16_t* rowp = O + (size_t)(row0 + ai * HALF + m * 16) * ldc + col0;
#pragma unroll
                for (int bj = 0; bj < 2; ++bj) { const f32x4 v0 = acc[ai][bj][m][0] * sc, v1 = acc[ai][bj][m][1] * sc;
                    u32x4 w; w.x = cvt_pk_bf16(v0[0], v0[1]); w.y = cvt_pk_bf16(v0[2], v0[3]); w.z = cvt_pk_bf16(v1[0], v1[1]); w.w = cvt_pk_bf16(v1[2], v1[3]);
                    *(u32x4*)(rowp + bj * HALF) = w; } }
    }
};
struct EpiSwiglu {
    static constexpr bool PERM = true;
    bf16_t* O; int ldc; float sc;
    __device__ __forceinline__ void operator()(const f32x4 (&acc)[2][2][4][2], const Unit& u, int wr, int wc, int fr, int fq) const {
        const int row0 = u.pm * BM + wr * 64 + fr; const int col0 = u.pc * HALF + wc * 32 + 8 * fq;
#pragma unroll
        for (int ai = 0; ai < 2; ++ai)
#pragma unroll
            for (int m = 0; m < 4; ++m) { bf16_t* rowp = O + (size_t)(row0 + ai * HALF + m * 16) * ldc + col0;
                float r[8];
#pragma unroll
                for (int n = 0; n < 2; ++n)
#pragma unroll
                    for (int j = 0; j < 4; ++j) { const float g = acc[ai][0][m][n][j] * sc, up = acc[ai][1][m][n][j] * sc; r[n * 4 + j] = g * __builtin_amdgcn_rcpf(1.f + __expf(-g)) * up; }
                u32x4 w; w.x = cvt_pk_bf16(r[0], r[1]); w.y = cvt_pk_bf16(r[2], r[3]); w.z = cvt_pk_bf16(r[4], r[5]); w.w = cvt_pk_bf16(r[6], r[7]);
                *(u32x4*)rowp = w; }
    }
};
__device__ __forceinline__ unsigned pk4_fp8c(float a, float b, float c, float d) { unsigned w = 0u;
    a = __builtin_fminf(__builtin_fmaxf(a, -448.f), 448.f); b = __builtin_fminf(__builtin_fmaxf(b, -448.f), 448.f); c = __builtin_fminf(__builtin_fmaxf(c, -448.f), 448.f); d = __builtin_fminf(__builtin_fmaxf(d, -448.f), 448.f);
    w = __builtin_amdgcn_cvt_pk_fp8_f32(a, b, w, false); w = __builtin_amdgcn_cvt_pk_fp8_f32(c, d, w, true); return w; }
struct EpiSwiglu8 {
    static constexpr bool PERM = true;
    unsigned char* O8; int ldc; float sc;
    __device__ __forceinline__ void operator()(const f32x4 (&acc)[2][2][4][2], const Unit& u, int wr, int wc, int fr, int fq) const {
        const int row0 = u.pm * BM + wr * 64 + fr; const int col0 = u.pc * HALF + wc * 32 + 8 * fq;
#pragma unroll
        for (int ai = 0; ai < 2; ++ai)
#pragma unroll
            for (int m = 0; m < 4; ++m) { unsigned char* rowp = O8 + (size_t)(row0 + ai * HALF + m * 16) * ldc + col0;
                float r[8];
#pragma unroll
                for (int n = 0; n < 2; ++n)
#pragma unroll
                    for (int j = 0; j < 4; ++j) { const float g = acc[ai][0][m][n][j] * sc, up = acc[ai][1][m][n][j] * sc; r[n * 4 + j] = g * __builtin_amdgcn_rcpf(1.f + __expf(-g)) * up; }
                u32x2 w; w.x = pk4_fp8c(r[0], r[1], r[2], r[3]); w.y = pk4_fp8c(r[4], r[5], r[6], r[7]);
                *(u32x2*)rowp = w; }
    }
};
template <bool BASE_F32> struct EpiResidB {
    static constexpr bool PERM = true;
    const void* base; bf16_t* out; int ldc; float sc = 1.f;
    __device__ __forceinline__ void operator()(const f32x4 (&acc)[2][2][4][2], const Unit& u, int wr, int wc, int fr, int fq) const {
        const int row0 = u.pm * BM + wr * 64 + fr; const int col0 = u.pc * BM + wc * 32 + 8 * fq;
#pragma unroll
        for (int ai = 0; ai < 2; ++ai)
#pragma unroll
            for (int m = 0; m < 4; ++m) { const size_t off = (size_t)(row0 + ai * HALF + m * 16) * ldc + col0;
#pragma unroll
                for (int bj = 0; bj < 2; ++bj) { f32x4 v0 = acc[ai][bj][m][0] * sc, v1 = acc[ai][bj][m][1] * sc;
                    if (BASE_F32) { const float* bp = (const float*)base + off + bj * HALF; v0 += *(const f32x4*)bp; v1 += *(const f32x4*)(bp + 4); }
                    else { const u32x4 w = *(const u32x4*)((const bf16_t*)base + off + bj * HALF);
                        v0[0] += __uint_as_float(w.x << 16); v0[1] += __uint_as_float(w.x & 0xffff0000u); v0[2] += __uint_as_float(w.y << 16); v0[3] += __uint_as_float(w.y & 0xffff0000u);
                        v1[0] += __uint_as_float(w.z << 16); v1[1] += __uint_as_float(w.z & 0xffff0000u); v1[2] += __uint_as_float(w.w << 16); v1[3] += __uint_as_float(w.w & 0xffff0000u); }
                    u32x4 o; o.x = cvt_pk_bf16(v0[0], v0[1]); o.y = cvt_pk_bf16(v0[2], v0[3]); o.z = cvt_pk_bf16(v1[0], v1[1]); o.w = cvt_pk_bf16(v1[2], v1[3]);
                    *(u32x4*)(out + off + bj * HALF) = o; } }
    }
};

typedef int i32x8 __attribute__((ext_vector_type(8)));
typedef int i32x4g __attribute__((ext_vector_type(4)));
__device__ __forceinline__ i32x8 cat8(const bf16x8 a, const bf16x8 b) { return __builtin_shufflevector(__builtin_bit_cast(i32x4g, a), __builtin_bit_cast(i32x4g, b), 0, 1, 2, 3, 4, 5, 6, 7); }
template <class Epi, class Sched, bool GATHER, bool F8 = false>
__device__ __forceinline__ void gemm_phase(const int tid, LAS unsigned char* lds, const Gemm g, const Sched& S, const Epi& E) {
    const int wid = __builtin_amdgcn_readfirstlane(tid >> 6), lane = tid & 63, wr = wid >> 2, wc = wid & 3, fr = lane & 15, fq = lane >> 4;
    const int K = g.K, nt = K / BK;
    unsigned voffA, voffB;
    { int R, C; stage_rc(tid * 16, R, C); const int Rb = Epi::PERM ? ((R & ~31) + perm32(R & 31)) : R; voffA = (unsigned)(R * K + C) * 2u; voffB = (unsigned)(Rb * K + C) * 2u; }
    const size_t kstep = (size_t)(BK * 2);
    const size_t hstep = (size_t)HALF * K * 2;
    const size_t tstep = 2 * hstep;
    const unsigned ldsw = (unsigned)wid * 1024u;
    const int aoff = lds_byte(wr * 64 + fr, fq * 8), boff = lds_byte(wc * 32 + fr, fq * 8);
#define PG8_SA(b, h) (((b) * 2 + (h)) * HTB)
#define PG8_SB(b, h) ((4 + (b) * 2 + (h)) * HTB)
#define PG8_STAGE2(bufoff, gbase, v0, v1) do { _Pragma("unroll") for (int _i = 0; _i < 2; ++_i) { unsigned _v = _i ? (v1) : (v0); asm volatile("" : "+v"(_v)); \
        __builtin_amdgcn_global_load_lds((const unsigned*)((const char*)(gbase) + _v), (LAS unsigned*)(lds + (bufoff) + ldsw + _i * 8192), 16, 0, 0); } } while (0)
#define PG8_STAGE(bufoff, gbase, voff) PG8_STAGE2(bufoff, gbase, (voff), (voff) + (unsigned)(128 * K))
#define PG8_STAGE_A(bufoff, kb, h, nx) do { if constexpr (GATHER) { PG8_STAGE2(bufoff, (const char*)g.A + (kb), offC[h][0], offC[h][1]); }   \
        else { PG8_STAGE(bufoff, ((nx) ? nA : cA) + (kb) + (h) * hstep, voffA); } } while (0)
#define PG8_LDA(dst, b, h) do { _Pragma("unroll") for (int m = 0; m < 4; ++m) _Pragma("unroll") for (int k = 0; k < 2; ++k) dst[m][k] = *(const LAS bf16x8*)(lds + PG8_SA(b, h) + aoff + m * 2048 + k * 1024); } while (0)
#define PG8_LDB(dst, b, h) do { _Pragma("unroll") for (int n = 0; n < 2; ++n) _Pragma("unroll") for (int k = 0; k < 2; ++k) dst[n][k] = *(const LAS bf16x8*)(lds + PG8_SB(b, h) + boff + n * 2048 + k * 1024); } while (0)
#define PG8_MMA(ai, bj, At, Bt) do { __builtin_amdgcn_s_setprio(1); _Pragma("unroll") for (int m = 0; m < 4; ++m) _Pragma("unroll") for (int n = 0; n < 2; ++n) { \
        if constexpr (F8) acc[ai][bj][m][n] = __builtin_amdgcn_mfma_scale_f32_16x16x128_f8f6f4(cat8(Bt[n][0], Bt[n][1]), cat8(At[m][0], At[m][1]), acc[ai][bj][m][n], 0, 0, 0, 0, 0, 0);   \
        else { _Pragma("unroll") for (int k = 0; k < 2; ++k) acc[ai][bj][m][n] = __builtin_amdgcn_mfma_f32_16x16x32_bf16(Bt[n][k], At[m][k], acc[ai][bj][m][n], 0, 0, 0); } } __builtin_amdgcn_s_setprio(0); } while (0)
#define PG8_WAIT_V(n) asm volatile("s_waitcnt vmcnt(" #n ")" ::: "memory")
#define PG8_WAIT_L(n) asm volatile("s_waitcnt lgkmcnt(" #n ")" ::: "memory")
#define PG8_BAR __builtin_amdgcn_s_barrier()
#define PG8_SCHED __builtin_amdgcn_sched_barrier(0)
#define PG8_LOADOFF(dst, u) do { _Pragma("unroll") for (int _h = 0; _h < 2; ++_h) _Pragma("unroll") for (int _i = 0; _i < 2; ++_i) { \
        int _R, _C; { int _t = tid; asm volatile("" : "+v"(_t)); stage_rc(_t * 16, _R, _C); } const int _row = g.rowmap[(u).pm * BM + _h * HALF + _R + 64 * _i]; dst[_h][_i] = (unsigned)(_row * K + _C) * 2u; } } while (0)
    Unit cur, nxt; int ui = 0;
    if (!S.next(0, cur)) return;
    f32x4 acc[2][2][4][2];
#pragma unroll
    for (int a = 0; a < 2; ++a)
#pragma unroll
        for (int b = 0; b < 2; ++b)
#pragma unroll
            for (int m = 0; m < 4; ++m)
#pragma unroll
                for (int n = 0; n < 2; ++n) acc[a][b][m][n] = (f32x4){0.f, 0.f, 0.f, 0.f};
    bf16x8 At[4][2], B0[2][2], B1[2][2];
    unsigned offC[2][2] = {{0u, 0u}, {0u, 0u}};
    LAS u32x4* offslot = (LAS u32x4*)(lds + STAGE_BYTES) + tid;
    const char* cA = (const char*)g.A + (GATHER ? (size_t)0 : (size_t)cur.pm * tstep); const char* cB = (const char*)g.Bt + (size_t)cur.pn * tstep;
    const char* nA = cA;
    if constexpr (GATHER) { PG8_LOADOFF(offC, cur); }
    PG8_STAGE(PG8_SB(0, 0), cB, voffB); PG8_STAGE(PG8_SB(0, 1), cB + hstep, voffB); PG8_STAGE_A(PG8_SA(0, 0), 0, 0, false); PG8_STAGE_A(PG8_SA(0, 1), 0, 1, false);
    if (wr == 1) PG8_BAR;
    PG8_WAIT_V(2); PG8_BAR;
    PG8_STAGE(PG8_SB(1, 0), cB + kstep, voffB); PG8_STAGE_A(PG8_SA(1, 0), kstep, 0, false); PG8_STAGE(PG8_SB(1, 1), cB + hstep + kstep, voffB);
    PG8_WAIT_V(6); PG8_BAR;
    for (;;) {
        const bool has_next = S.next(ui + 1, nxt);
        nA = has_next ? (const char*)g.A + (GATHER ? (size_t)0 : (size_t)nxt.pm * tstep) : cA; const char* nB = has_next ? (const char*)g.Bt + (size_t)nxt.pn * tstep : cB;
        if constexpr (GATHER) { unsigned offN[2][2];
            if (has_next) { PG8_LOADOFF(offN, nxt); } else {
#pragma unroll
                for (int h = 0; h < 2; ++h) { offN[h][0] = offC[h][0]; offN[h][1] = offC[h][1]; } }
            *offslot = (u32x4){offN[0][0], offN[0][1], offN[1][0], offN[1][1]}; }
#pragma unroll 1
        for (int t = 0; t < nt; t += 2) {
            const bool last = (t == nt - 2);
            const size_t k1 = (size_t)(t + 1) * kstep;
            const size_t k2 = last ? (size_t)0 : (size_t)(t + 2) * kstep, k3 = k2 + kstep;
            const char* b2 = last ? nB : cB + (size_t)(t + 2) * kstep; const char* b3 = b2 + kstep;
            PG8_LDB(B0, 0, 0); PG8_LDB(B1, 0, 1); PG8_SCHED; PG8_LDA(At, 0, 0); PG8_STAGE_A(PG8_SA(1, 1), k1, 1, false);
            if constexpr (GATHER) { if (last) { const u32x4 o_ = *offslot; offC[0][0] = o_.x; offC[0][1] = o_.y; offC[1][0] = o_.z; offC[1][1] = o_.w; } }
            PG8_WAIT_V(8); PG8_WAIT_L(0); PG8_BAR; PG8_MMA(0, 0, At, B0); PG8_MMA(0, 1, At, B1); PG8_BAR; PG8_SCHED;
            PG8_LDA(At, 0, 1); PG8_STAGE(PG8_SB(0, 0), b2, voffB); PG8_STAGE(PG8_SB(0, 1), b2 + hstep, voffB); PG8_STAGE_A(PG8_SA(0, 0), k2, 0, last);
            PG8_WAIT_V(8); PG8_WAIT_L(0); PG8_BAR; PG8_MMA(1, 0, At, B0); PG8_MMA(1, 1, At, B1); PG8_BAR; PG8_SCHED;
            PG8_LDB(B0, 1, 0); PG8_LDB(B1, 1, 1); PG8_SCHED; PG8_LDA(At, 1, 0); PG8_STAGE_A(PG8_SA(0, 1), k2, 1, last);
            PG8_WAIT_V(8); PG8_WAIT_L(0); PG8_BAR; PG8_MMA(0, 0, At, B0); PG8_MMA(0, 1, At, B1); PG8_BAR; PG8_SCHED;
            PG8_LDA(At, 1, 1); PG8_STAGE(PG8_SB(1, 0), b3, voffB); PG8_STAGE(PG8_SB(1, 1), b3 + hstep, voffB); PG8_STAGE_A(PG8_SA(1, 0), k3, 0, last);
            PG8_WAIT_V(8); PG8_WAIT_L(0); PG8_BAR; PG8_MMA(1, 0, At, B0); PG8_MMA(1, 1, At, B1); PG8_BAR; PG8_SCHED;
        }
        if (wr == 0) PG8_BAR;
        asm volatile("s_nop 15\n\ts_nop 15" ::: "memory");
        { unsigned m_ = ~0u; asm volatile("" : "+s"(m_)); const int ln_ = (int)__builtin_amdgcn_mbcnt_hi(m_, __builtin_amdgcn_mbcnt_lo(m_, 0u));
          E(acc, cur, wr, wc, ln_ & 15, ln_ >> 4); }
        if (!has_next) break;
#pragma unroll
        for (int a = 0; a < 2; ++a)
#pragma unroll
            for (int b = 0; b < 2; ++b)
#pragma unroll
                for (int m = 0; m < 4; ++m)
#pragma unroll
                    for (int n = 0; n < 2; ++n) acc[a][b][m][n] = (f32x4){0.f, 0.f, 0.f, 0.f};
        cur = nxt; cA = nA; cB = nB; ++ui;
        if (wr == 1) PG8_BAR;
    }
    PG8_WAIT_V(0);
    PG8_BAR;
#undef PG8_SA
#undef PG8_SB
#undef PG8_STAGE
#undef PG8_STAGE2
#undef PG8_STAGE_A
#undef PG8_LDA
#undef PG8_LDB
#undef PG8_MMA
#undef PG8_WAIT_V
#undef PG8_WAIT_L
#undef PG8_BAR
#undef PG8_SCHED
#undef PG8_LOADOFF
}
}
#define XB_TMO      128
#define XB_XCNT(j)  (256  + 64 * (j))
#define XB_XSUB(j)  (1280 + 64 * (j))
#define XB_XGEN(j)  (2304 + 64 * (j))
#define XB_TOP      3328
#define XB_TOPGEN   3392
#define XCD_BAR_WORDS 3456
#define XB_SPIN_CAP (1u << 18)

__device__ __forceinline__ unsigned xb_ld(unsigned* p)              { return __hip_atomic_load(p, __ATOMIC_RELAXED, __HIP_MEMORY_SCOPE_AGENT); }
__device__ __forceinline__ unsigned xb_add(unsigned* p, unsigned v) { return __hip_atomic_fetch_add(p, v, __ATOMIC_RELAXED, __HIP_MEMORY_SCOPE_AGENT); }
__device__ __forceinline__ unsigned xb_xcc_id() { return (unsigned)__builtin_amdgcn_s_getreg((3 << 11) | 20) & 0xFu; }
#define XB_SPIN(cond, bar) do { unsigned _sp = 0; while (cond) { __builtin_amdgcn_s_sleep(1); \
    if ((++_sp & 255u) == 0u) { if (xb_ld(&(bar)[XB_TMO])) break; if (_sp > XB_SPIN_CAP) { atomicAdd(&(bar)[XB_TMO], 1u); break; } } } } while (0)

struct XcdBarrier {
    unsigned* bar; unsigned x;
    volatile LAS unsigned* st;
};

__device__ __forceinline__ XcdBarrier xcd_barrier_post(unsigned* bar, volatile LAS unsigned* st) {
    XcdBarrier b; b.bar = bar; b.x = xb_xcc_id(); b.st = st;
    if (threadIdx.x == 0) (void)xb_add(&bar[XB_XCNT(b.x)], 1u);
    return b;
}
__device__ __forceinline__ void xcd_barrier_complete(unsigned* bar, unsigned x, unsigned& nloc, unsigned& nx) {
    const unsigned G = gridDim.x * gridDim.y * gridDim.z;
    unsigned sum, cnt, mine, sp = 0u;
    for (;;) {
        sum = 0u; cnt = 0u; mine = 0u;
#pragma unroll
        for (unsigned j = 0; j < 16; ++j) { const unsigned c = xb_ld(&bar[XB_XCNT(j)]); sum += c; cnt += (c > 0u) ? 1u : 0u; mine = (j == x) ? c : mine; }
        if (sum == G) break;
        __builtin_amdgcn_s_sleep(1);
        if ((++sp & 255u) == 0u) { if (xb_ld(&bar[XB_TMO])) break; if (sp > XB_SPIN_CAP) { atomicAdd(&bar[XB_TMO], 1u); break; } }
    }
    nloc = mine > 0u ? mine : 1u; nx = cnt > 0u ? cnt : 1u;
}

__device__ __forceinline__ void xcd_barrier(const XcdBarrier& b, const bool leader) {
    asm volatile("s_waitcnt vmcnt(0)" ::: "memory");
    __syncthreads();
    if (leader) {
        unsigned* bar = b.bar;
        __builtin_amdgcn_s_waitcnt(0);
        unsigned nloc = b.st[0], nx = b.st[1];
        if (nloc == 0u) { xcd_barrier_complete(bar, b.x, nloc, nx); b.st[0] = nloc; b.st[1] = nx; }
        const unsigned old = xb_add(&bar[XB_XSUB(b.x)], 1u);
        const unsigned gen = old / nloc;
        if (old + 1u == (gen + 1u) * nloc) {
            __builtin_amdgcn_fence(__ATOMIC_RELEASE, "agent");
            asm volatile("s_waitcnt vmcnt(0)" ::: "memory");
            const unsigned og = xb_add(&bar[XB_TOP], 1u);
            const unsigned tg = og / nx;
            if (og + 1u == (tg + 1u) * nx) xb_add(&bar[XB_TOPGEN], 1u);
            else XB_SPIN(xb_ld(&bar[XB_TOPGEN]) == tg, bar);
            __builtin_amdgcn_fence(__ATOMIC_ACQUIRE, "agent");
            xb_add(&bar[XB_XGEN(b.x)], 1u);
            asm volatile("s_waitcnt vmcnt(0)" ::: "memory");
        } else {
            XB_SPIN(xb_ld(&bar[XB_XGEN(b.x)]) == gen, bar);
            __builtin_amdgcn_fence(__ATOMIC_ACQUIRE, "agent");
            asm volatile("s_waitcnt vmcnt(0)" ::: "memory");
        }
    }
    __syncthreads();
}
struct Frame {
    LAS unsigned char* lds;
    unsigned* ctl;
    unsigned char* ws;
    int tid, lane, wave, bid, G;
    float* out;
};
enum InIdx { I_X = 0, I_POS, I_ATTN_NORM, I_W_IN, I_SINKS, I_SWA_ON, I_GLA_WA2, I_GLA_BA, I_GLA_ON, I_SB_ON, I_MU, I_W0, I_W2, I_A0, I_A2, I_G2, I_KK, I_KA, I_RK, I_LNW, I_LNB,
             I_W_OUT, I_FFN_NORM, I_FFN_W1, I_FFN_W3, I_FFN_W2, I_ROUTER, I_MOE_W1, I_MOE_W3, I_MOE_W2, I_FINAL_NORM, N_IN };
constexpr int PTR_OFF = MISC_OFF + 64;
__device__ __forceinline__ const void* in_ptr(const Frame& F, int i) {
    const unsigned long long v = ((const LAS unsigned long long*)(F.lds + PTR_OFF))[i];
    const unsigned lo = __builtin_amdgcn_readfirstlane((unsigned)v), hi = __builtin_amdgcn_readfirstlane((unsigned)(v >> 32));
    return (const void*)(GAS const void*)(((unsigned long long)hi << 32) | lo);
}
#define INF(F, i) ((const float*)in_ptr(F, i))

template <class Map>
__device__ __forceinline__ void transpose_item(const float* W, int K, int N, bf16_t* WT, const Map& dst, LAS float* scr, int item, int lane) {
    const int nblk = (N + 31) / 32, kb = item / nblk, nb = item % nblk, k0 = 64 * kb, n0 = 32 * nb;
    const int nl = n0 + (lane & 31);
#pragma unroll 8
    for (int i = 0; i < 32; ++i) { const int kk = 2 * i + (lane >> 5); scr[kk * 33 + (lane & 31)] = (nl < N) ? W[(size_t)(k0 + kk) * N + nl] : 0.f; }
    asm volatile("s_waitcnt lgkmcnt(0)" ::: "memory");
    const int c = lane & 7;
#pragma unroll
    for (int j = 0; j < 4; ++j) { const int n = (lane >> 3) + 8 * j; const LAS float* s = scr + (8 * c) * 33 + n;
        u32x4 o; o.x = pk2(s[0 * 33], s[1 * 33]); o.y = pk2(s[2 * 33], s[3 * 33]); o.z = pk2(s[4 * 33], s[5 * 33]); o.w = pk2(s[6 * 33], s[7 * 33]);
        if (n0 + n < N) *(u32x4*)(WT + (size_t)dst(n0 + n) * K + k0 + 8 * c) = o; }
    asm volatile("s_waitcnt lgkmcnt(0)" ::: "memory");
}
__device__ __forceinline__ unsigned pk4_fp8(float a, float b, float c, float d) { unsigned w = 0u; w = __builtin_amdgcn_cvt_pk_fp8_f32(a, b, w, false); w = __builtin_amdgcn_cvt_pk_fp8_f32(c, d, w, true); return w; }
template <class Map>
__device__ __forceinline__ void transpose_item8(const float* W, int K, int N, unsigned char* WT, const Map& dst, LAS float* scr, int item, int lane, int pitch = 0) {
    const int nblk = (N + 31) / 32, kb = item / nblk, nb = item % nblk, k0 = 64 * kb, n0 = 32 * nb;
    const int nl = n0 + (lane & 31);
#pragma unroll 8
    for (int i = 0; i < 32; ++i) { const int kk = 2 * i + (lane >> 5); scr[kk * 33 + (lane & 31)] = (nl < N) ? W[(size_t)(k0 + kk) * N + nl] * 64.f : 0.f; }
    asm volatile("s_waitcnt lgkmcnt(0)" ::: "memory");
    const int c = lane & 7;
#pragma unroll
    for (int j = 0; j < 4; ++j) { const int n = (lane >> 3) + 8 * j; const LAS float* s = scr + (8 * c) * 33 + n;
        u32x2 o; o.x = pk4_fp8(s[0 * 33], s[1 * 33], s[2 * 33], s[3 * 33]); o.y = pk4_fp8(s[4 * 33], s[5 * 33], s[6 * 33], s[7 * 33]);
        if (n0 + n < N) *(u32x2*)(WT + (size_t)dst(n0 + n) * (pitch ? pitch : K) + k0 + 8 * c) = o; }
    asm volatile("s_waitcnt lgkmcnt(0)" ::: "memory");
}
struct MapIn { __device__ int operator()(int n) const { return n < 1280 ? n : (n < 1296 ? 3072 + (n - 1280) : n - 16); } };
struct MapId { int off; __device__ int operator()(int n) const { return off + n; } };
struct MapGU { int off; __device__ int operator()(int n) const { return off + 256 * (n >> 7) + (n & 127); } };

__device__ __forceinline__ void phase_convert_weights(Frame& F, int l) {
    LAS float* scr = (LAS float*)(F.lds + F.wave * 16384);
    const int gw = F.bid * 8 + F.wave, NGW = F.G * 8;
    bf16_t* WIN = (bf16_t*)(F.ws + WS_WIN); bf16_t* WOUT = (bf16_t*)(F.ws + WS_WOUT); bf16_t* W13 = (bf16_t*)(F.ws + WS_W13); bf16_t* W2 = (bf16_t*)(F.ws + WS_W2);
    const bool moe = (l & 1) != 0; const int li = l >> 1;
    const int I_IN = (DM / 64) * ((IN_COLS + 31) / 32), I_OUT = (DM / 64) * (DM / 32);
    const int I_UP = moe ? (DM / 64) * (D_FFE / 32) : (DM / 64) * (D_FF / 32);
    const int I_DN = moe ? (D_FFE / 64) * (DM / 32) : (D_FF / 64) * (DM / 32);
    const int NE = moe ? N_EXP : 1;
    const int total = I_IN + I_OUT + NE * (2 * I_UP + I_DN);
    for (int it = gw; it < total; it += NGW) {
        int r = it;
        if (r < I_IN) { transpose_item(INF(F, I_W_IN) + (size_t)l * DM * IN_COLS, DM, IN_COLS, WIN, MapIn{}, scr, r, F.lane); continue; } r -= I_IN;
        if (r < I_OUT) { transpose_item(INF(F, I_W_OUT) + (size_t)l * DM * DM, DM, DM, WOUT, MapId{0}, scr, r, F.lane); continue; } r -= I_OUT;
        const int per_e = 2 * I_UP + I_DN, e = r / per_e; r -= e * per_e;
        if (!moe) {
            if (r < I_UP) { transpose_item8(INF(F, I_FFN_W1) + (size_t)li * DM * D_FF, DM, D_FF, (unsigned char*)W13, MapGU{0}, scr, r, F.lane); continue; } r -= I_UP;
            if (r < I_UP) { transpose_item8(INF(F, I_FFN_W3) + (size_t)li * DM * D_FF, DM, D_FF, (unsigned char*)W13, MapGU{128}, scr, r, F.lane); continue; } r -= I_UP;
            transpose_item8(INF(F, I_FFN_W2) + (size_t)li * D_FF * DM, D_FF, DM, (unsigned char*)W2, MapId{0}, scr, r, F.lane);
        } else {
            const size_t eo = (size_t)(li * N_EXP + e);
            if (r < I_UP) { transpose_item8(INF(F, I_MOE_W1) + eo * DM * D_FFE, DM, D_FFE, (unsigned char*)W13, MapGU{e * 2 * D_FFE}, scr, r, F.lane); continue; } r -= I_UP;
            if (r < I_UP) { transpose_item8(INF(F, I_MOE_W3) + eo * DM * D_FFE, DM, D_FFE, (unsigned char*)W13, MapGU{e * 2 * D_FFE + 128}, scr, r, F.lane); continue; } r -= I_UP;
            transpose_item8(INF(F, I_MOE_W2) + eo * D_FFE * DM, D_FFE, DM, (unsigned char*)W2, MapId{e * DM}, scr, r, F.lane, KP8);
        }
    }
    if (moe) {
        unsigned zz = 0u; asm volatile("" : "+v"(zz));
        for (int i = F.bid * 512 + F.tid; i < N_EXP * DM * ((KP8 - D_FFE) / 16); i += F.G * 512) { const int row = i >> 3, c = i & 7; *(u32x4*)((unsigned char*)W2 + (size_t)row * KP8 + D_FFE + 16 * c) = (u32x4){zz, zz, zz, zz}; }
    }
}

__device__ __forceinline__ void phase_rope_tables(Frame& F) {
    float* C = (float*)(F.ws + WS_ROPE_C); float* S = (float*)(F.ws + WS_ROPE_S); const int* pos = (const int*)in_ptr(F, I_POS);
    for (int idx = F.bid * 512 + F.tid; idx < NTOK * 32; idx += F.G * 512) {
        const int tok = idx >> 5, i = idx & 31;
        const float invf = exp2f(-(float)(2 * i) * (13.287712379549449f / 64.f));
        const float angf = (float)pos[tok] * invf;
        const double a = (double)angf;
        const double n = rint(a * 0.15915494309189535);
        const double r = a - n * 6.283185307179586;
        const double r2 = r * r;
        double s = -1.0 / 51090942171709440000.0;
        s = s * r2 + 1.0 / 121645100408832000.0;  s = s * r2 - 1.0 / 355687428096000.0; s = s * r2 + 1.0 / 1307674368000.0; s = s * r2 - 1.0 / 6227020800.0;
        s = s * r2 + 1.0 / 39916800.0; s = s * r2 - 1.0 / 362880.0; s = s * r2 + 1.0 / 5040.0; s = s * r2 - 1.0 / 120.0; s = s * r2 + 1.0 / 6.0; s = s * r2 - 1.0; s = -s * r;
        double c = 1.0 / 1124000727777607680000.0;
        c = c * r2 - 1.0 / 2432902008176640000.0; c = c * r2 + 1.0 / 6402373705728000.0; c = c * r2 - 1.0 / 20922789888000.0; c = c * r2 + 1.0 / 87178291200.0;
        c = c * r2 - 1.0 / 479001600.0; c = c * r2 + 1.0 / 3628800.0; c = c * r2 - 1.0 / 40320.0; c = c * r2 + 1.0 / 720.0; c = c * r2 - 1.0 / 24.0; c = c * r2 + 0.5; c = 1.0 - c * r2;
        C[idx] = (float)c; S[idx] = (float)s;
    }
}

template <int MODE, bool XF32>
__device__ __forceinline__ void phase_norm(Frame& F, const void* xin, const float* gain, bool comb, int moe_slot) {
    bf16_t* HB = (bf16_t*)(F.ws + WS_H); bf16_t* XB = (bf16_t*)((unsigned char*)F.out + XB_OFF);
    const bf16_t* Y = (const bf16_t*)(F.ws + WS_Y);
    const int* TOK_ROW = (const int*)(F.ws + WS_TOK_ROW); const float* TOK_G = (const float*)(F.ws + WS_TOK_G);
    LAS float* rts = (LAS float*)F.lds;
    LAS int* te = (LAS int*)(F.lds + 32768);
    LAS float* tg = (LAS float*)(F.lds + 32768 + 1024);
    LAS int* tl = (LAS int*)(F.lds + 32768 + 2048);
    LAS int* lcnt = (LAS int*)(F.lds + 32768 + 3072);
    if (MODE == 1) {
        const float* router = INF(F, I_ROUTER) + (size_t)moe_slot * DM * N_EXP;
        for (int i = F.tid; i < DM * N_EXP; i += 512) { const int c = i >> 3, e = i & 7; rts[e * DM + c] = router[i]; }
        if (F.tid < 16) lcnt[F.tid] = 0;
        __syncthreads();
    }
    f32x4 gv[2][2];
#pragma unroll
    for (int j = 0; j < 2; ++j) { gv[j][0] = *(const f32x4*)(gain + 8 * F.lane + 512 * j); gv[j][1] = *(const f32x4*)(gain + 8 * F.lane + 512 * j + 4); }
    for (int rr = 0; rr < 16; ++rr) {
        const int rloc = F.wave * 16 + rr; const int row = F.bid * 128 + rloc;
        if (row >= NTOK) break;
        float v[2][8];
#pragma unroll
        for (int j = 0; j < 2; ++j) {
            if (XF32) { const float* xr = (const float*)xin + (size_t)row * DM + 8 * F.lane + 512 * j; const f32x4 a = *(const f32x4*)xr, b = *(const f32x4*)(xr + 4);
                v[j][0] = a[0]; v[j][1] = a[1]; v[j][2] = a[2]; v[j][3] = a[3]; v[j][4] = b[0]; v[j][5] = b[1]; v[j][6] = b[2]; v[j][7] = b[3]; }
            else { const u32x4 w = *(const u32x4*)((const bf16_t*)xin + (size_t)row * DM + 8 * F.lane + 512 * j);
                v[j][0] = bflo(w.x); v[j][1] = bfhi(w.x); v[j][2] = bflo(w.y); v[j][3] = bfhi(w.y); v[j][4] = bflo(w.z); v[j][5] = bfhi(w.z); v[j][6] = bflo(w.w); v[j][7] = bfhi(w.w); } }
        if (comb) {
            const int r0 = TOK_ROW[row * 2], r1 = TOK_ROW[row * 2 + 1]; const float g0 = TOK_G[row * 2], g1 = TOK_G[row * 2 + 1];
#pragma unroll
            for (int j = 0; j < 2; ++j) {
                const u32x4 a = *(const u32x4*)(Y + (size_t)r0 * DM + 8 * F.lane + 512 * j), b = *(const u32x4*)(Y + (size_t)r1 * DM + 8 * F.lane + 512 * j);
                v[j][0] += g0 * bflo(a.x) + g1 * bflo(b.x); v[j][1] += g0 * bfhi(a.x) + g1 * bfhi(b.x); v[j][2] += g0 * bflo(a.y) + g1 * bflo(b.y); v[j][3] += g0 * bfhi(a.y) + g1 * bfhi(b.y);
                v[j][4] += g0 * bflo(a.z) + g1 * bflo(b.z); v[j][5] += g0 * bfhi(a.z) + g1 * bfhi(b.z); v[j][6] += g0 * bflo(a.w) + g1 * bflo(b.w); v[j][7] += g0 * bfhi(a.w) + g1 * bfhi(b.w);
                if (MODE != 2) { u32x4 o; o.x = pk2(v[j][0], v[j][1]); o.y = pk2(v[j][2], v[j][3]); o.z = pk2(v[j][4], v[j][5]); o.w = pk2(v[j][6], v[j][7]); *(u32x4*)(XB + (size_t)row * DM + 8 * F.lane + 512 * j) = o; }
            }
        }
        float ss = 0.f;
#pragma unroll
        for (int j = 0; j < 2; ++j)
#pragma unroll
            for (int i = 0; i < 8; ++i) ss += v[j][i] * v[j][i];
        const float rstd = rsqrtf(wave_sum(ss) * (1.f / DM) + NORM_EPS);
#pragma unroll
        for (int j = 0; j < 2; ++j)
#pragma unroll
            for (int i = 0; i < 8; ++i) v[j][i] = v[j][i] * rstd * gv[j][i >> 2][i & 3];
        if (MODE == 2) {
            float* dst = (row < NTOK / 2) ? F.out + (size_t)row * DM : (float*)(F.ws + WS_PROJ) + (size_t)(row - NTOK / 2) * DM;
#pragma unroll
            for (int j = 0; j < 2; ++j) { *(f32x4*)(dst + 8 * F.lane + 512 * j) = (f32x4){v[j][0], v[j][1], v[j][2], v[j][3]}; *(f32x4*)(dst + 8 * F.lane + 512 * j + 4) = (f32x4){v[j][4], v[j][5], v[j][6], v[j][7]}; }
        } else {
#pragma unroll
            for (int j = 0; j < 2; ++j) {
                if (MODE == 0 || MODE == 1) { u32x2 o; o.x = pk4_fp8(v[j][0], v[j][1], v[j][2], v[j][3]); o.y = pk4_fp8(v[j][4], v[j][5], v[j][6], v[j][7]); *(u32x2*)((unsigned char*)HB + (size_t)row * DM + 8 * F.lane + 512 * j) = o; }
                else { u32x4 o; o.x = pk2(v[j][0], v[j][1]); o.y = pk2(v[j][2], v[j][3]); o.z = pk2(v[j][4], v[j][5]); o.w = pk2(v[j][6], v[j][7]); *(u32x4*)(HB + (size_t)row * DM + 8 * F.lane + 512 * j) = o; } }
        }
        if (MODE == 1) {
            float lg[8];
#pragma unroll
            for (int e = 0; e < 8; ++e) { float a = 0.f;
#pragma unroll
                for (int j = 0; j < 2; ++j) { const f32x4 w0 = *(const LAS f32x4*)(rts + e * DM + 8 * F.lane + 512 * j), w1 = *(const LAS f32x4*)(rts + e * DM + 8 * F.lane + 512 * j + 4);
                    a += (v[j][0] * w0[0] + v[j][1] * w0[1]) + (v[j][2] * w0[2] + v[j][3] * w0[3]) + (v[j][4] * w1[0] + v[j][5] * w1[1]) + (v[j][6] * w1[2] + v[j][7] * w1[3]); }
                lg[e] = wave_sum(a); }
            int i0 = 0; float v0 = lg[0];
#pragma unroll
            for (int e = 1; e < 8; ++e) if (lg[e] > v0) { v0 = lg[e]; i0 = e; }
            int i1 = -1; float v1 = -3.0e38f;
#pragma unroll
            for (int e = 0; e < 8; ++e) if (e != i0 && lg[e] > v1) { v1 = lg[e]; i1 = e; }
            const float g0 = 1.f / (1.f + __expf(v1 - v0));
            if (F.lane == 0) { te[rloc * 2] = i0; te[rloc * 2 + 1] = i1; tg[rloc * 2] = g0; tg[rloc * 2 + 1] = 1.f - g0; }
        }
    }
    if (MODE == 1) {
        __syncthreads();
        int e = 0, li = 0;
        if (F.tid < 256) { e = te[F.tid]; li = atomicAdd((int*)&lcnt[e], 1); tl[F.tid] = li; }
        __syncthreads();
        if (F.tid < 8) lcnt[8 + F.tid] = (int)atomicAdd(F.ctl + CW_MOECNT + 64 * moe_slot + F.tid, (unsigned)lcnt[F.tid]);
        __syncthreads();
        if (F.tid < 256) {
            const int tok = F.bid * 128 + (F.tid >> 1), k = F.tid & 1;
            ((int*)(F.ws + WS_TOK_E))[tok * 2 + k] = e;
            ((int*)(F.ws + WS_TOK_SLOT))[tok * 2 + k] = lcnt[8 + e] + li;
            ((float*)(F.ws + WS_TOK_G))[tok * 2 + k] = tg[F.tid];
        }
    }
}
constexpr int NL_PITCH = 1032;
template <bool XF32, bool COMB>
__device__ __forceinline__ void phase_norm_lr(Frame& F, const void* xin, const float* gain, int l) {
    bf16_t* HB = (bf16_t*)(F.ws + WS_H); bf16_t* XB = (bf16_t*)((unsigned char*)F.out + XB_OFF); bf16_t* PROJ = (bf16_t*)(F.ws + WS_PROJ);
    const bf16_t* Y = (const bf16_t*)(F.ws + WS_Y);
    const int* TOK_ROW = (const int*)(F.ws + WS_TOK_ROW); const float* TOK_G = (const float*)(F.ws + WS_TOK_G);
    LAS bf16_t* WL = (LAS bf16_t*)F.lds;
    LAS float* GL = (LAS float*)(F.lds + 16 * NL_PITCH * 2);
    __syncthreads();
    { const float* wl = INF(F, I_W_IN) + (size_t)l * DM * IN_COLS + 1280;
#pragma unroll 1
      for (int c = F.tid; c < DM; c += 512) { const float* p = wl + (size_t)c * IN_COLS;
          const f32x4 a = *(const f32x4*)p, b = *(const f32x4*)(p + 4), cc = *(const f32x4*)(p + 8), d = *(const f32x4*)(p + 12);
#pragma unroll
          for (int j = 0; j < 4; ++j) { WL[j * NL_PITCH + c] = f2bf(a[j]); WL[(4 + j) * NL_PITCH + c] = f2bf(b[j]); WL[(8 + j) * NL_PITCH + c] = f2bf(cc[j]); WL[(12 + j) * NL_PITCH + c] = f2bf(d[j]); }
          GL[c] = gain[c]; } }
    __syncthreads();
    const int r16 = F.lane & 15, kq = F.lane >> 4;
    const int row = F.bid * 128 + F.wave * 16 + r16;
    u32x4 xs[32]; float ss = 0.f, sb = 0.f;
    if (XF32) {
        const float* xr = (const float*)xin + (size_t)row * DM + 8 * kq;
#pragma unroll
        for (int s = 0; s < 32; ++s) { const f32x4 a = *(const f32x4*)(xr + 32 * s), b = *(const f32x4*)(xr + 32 * s + 4);
            ss = __builtin_fmaf(a[0], a[0], ss); sb = __builtin_fmaf(a[1], a[1], sb); ss = __builtin_fmaf(a[2], a[2], ss); sb = __builtin_fmaf(a[3], a[3], sb); ss = __builtin_fmaf(b[0], b[0], ss); sb = __builtin_fmaf(b[1], b[1], sb); ss = __builtin_fmaf(b[2], b[2], ss); sb = __builtin_fmaf(b[3], b[3], sb);
            xs[s].x = pg8::cvt_pk_c(a[0], a[1]); xs[s].y = pg8::cvt_pk_c(a[2], a[3]); xs[s].z = pg8::cvt_pk_c(b[0], b[1]); xs[s].w = pg8::cvt_pk_c(b[2], b[3]);
            if ((s & 7) == 7) __builtin_amdgcn_sched_barrier(0); }
    } else if (!COMB) {
        const bf16_t* xr = (const bf16_t*)xin + (size_t)row * DM + 8 * kq;
#pragma unroll
        for (int s = 0; s < 32; ++s) xs[s] = *(const u32x4*)(xr + 32 * s);
#pragma unroll
        for (int s = 0; s < 32; ++s) { const u32x4 w = xs[s];
            ss = __builtin_fmaf(bflo(w.x), bflo(w.x), ss); sb = __builtin_fmaf(bfhi(w.x), bfhi(w.x), sb); ss = __builtin_fmaf(bflo(w.y), bflo(w.y), ss); sb = __builtin_fmaf(bfhi(w.y), bfhi(w.y), sb);
            ss = __builtin_fmaf(bflo(w.z), bflo(w.z), ss); sb = __builtin_fmaf(bfhi(w.z), bfhi(w.z), sb); ss = __builtin_fmaf(bflo(w.w), bflo(w.w), ss); sb = __builtin_fmaf(bfhi(w.w), bfhi(w.w), sb); }
    } else {
        const int r0 = TOK_ROW[row * 2], r1 = TOK_ROW[row * 2 + 1]; const float g0 = TOK_G[row * 2], g1 = TOK_G[row * 2 + 1];
        const bf16_t* xr = (const bf16_t*)xin + (size_t)row * DM + 8 * kq; const bf16_t* ya = Y + (size_t)r0 * DM + 8 * kq; const bf16_t* yb = Y + (size_t)r1 * DM + 8 * kq;
        bf16_t* xo = XB + (size_t)row * DM + 8 * kq;
#pragma unroll
        for (int s = 0; s < 32; ++s) { const u32x4 w = *(const u32x4*)(xr + 32 * s), a = *(const u32x4*)(ya + 32 * s), b = *(const u32x4*)(yb + 32 * s);
            float v[8];
            v[0] = bflo(w.x) + g0 * bflo(a.x) + g1 * bflo(b.x); v[1] = bfhi(w.x) + g0 * bfhi(a.x) + g1 * bfhi(b.x); v[2] = bflo(w.y) + g0 * bflo(a.y) + g1 * bflo(b.y); v[3] = bfhi(w.y) + g0 * bfhi(a.y) + g1 * bfhi(b.y);
            v[4] = bflo(w.z) + g0 * bflo(a.z) + g1 * bflo(b.z); v[5] = bfhi(w.z) + g0 * bfhi(a.z) + g1 * bfhi(b.z); v[6] = bflo(w.w) + g0 * bflo(a.w) + g1 * bflo(b.w); v[7] = bfhi(w.w) + g0 * bfhi(a.w) + g1 * bfhi(b.w);
#pragma unroll
            for (int j = 0; j < 8; j += 2) { ss = __builtin_fmaf(v[j], v[j], ss); sb = __builtin_fmaf(v[j + 1], v[j + 1], sb); }
            xs[s].x = pg8::cvt_pk_c(v[0], v[1]); xs[s].y = pg8::cvt_pk_c(v[2], v[3]); xs[s].z = pg8::cvt_pk_c(v[4], v[5]); xs[s].w = pg8::cvt_pk_c(v[6], v[7]);
            *(u32x4*)(xo + 32 * s) = xs[s];
            if ((s & 1) == 1) __builtin_amdgcn_sched_barrier(0); }
    }
    ss += sb; ss += __shfl_xor(ss, 16); ss += __shfl_xor(ss, 32);
    const float rstd = rsqrtf(ss * (1.f / DM) + NORM_EPS);
#pragma unroll
    for (int s = 0; s < 32; ++s) asm volatile("" : "+v"(xs[s].x), "+v"(xs[s].y), "+v"(xs[s].z), "+v"(xs[s].w));
    f32x4 acc = {0.f, 0.f, 0.f, 0.f};
    bf16_t* ho = HB + (size_t)row * DM + 8 * kq;
#pragma unroll
    for (int s = 0; s < 32; ++s) { const int c0 = 32 * s + 8 * kq; const f32x4 ga = *(const LAS f32x4*)(GL + c0), gb = *(const LAS f32x4*)(GL + c0 + 4); const u32x4 w = xs[s];
        u32x4 hw; hw.x = pg8::cvt_pk_c(bflo(w.x) * rstd * ga[0], bfhi(w.x) * rstd * ga[1]); hw.y = pg8::cvt_pk_c(bflo(w.y) * rstd * ga[2], bfhi(w.y) * rstd * ga[3]);
        hw.z = pg8::cvt_pk_c(bflo(w.z) * rstd * gb[0], bfhi(w.z) * rstd * gb[1]); hw.w = pg8::cvt_pk_c(bflo(w.w) * rstd * gb[2], bfhi(w.w) * rstd * gb[3]);
        *(u32x4*)(ho + 32 * s) = hw;
        acc = __builtin_amdgcn_mfma_f32_16x16x32_bf16(*(const LAS bf16x8*)(WL + r16 * NL_PITCH + c0), __builtin_bit_cast(bf16x8, hw), acc, 0, 0, 0);
        if ((s & 3) == 3) __builtin_amdgcn_sched_barrier(0); }
    { u32x2 o; o.x = pg8::cvt_pk_c(acc[0], acc[1]); o.y = pg8::cvt_pk_c(acc[2], acc[3]); *(u32x2*)(PROJ + (size_t)row * NPROJ + PB_LR + 4 * kq) = o; }
}
__device__ __forceinline__ void phase_final_copy(Frame& F) {
    const f32x4* src = (const f32x4*)(F.ws + WS_PROJ); f32x4* dst = (f32x4*)(F.out + (size_t)(NTOK / 2) * DM);
    for (int i = F.bid * 512 + F.tid; i < NTOK / 2 * DM / 4; i += F.G * 512) dst[i] = src[i];
}

__device__ __forceinline__ void moe_bases(const unsigned* cnt, int (&tb)[9]) {
    tb[0] = 0;
#pragma unroll
    for (int e = 0; e < 8; ++e) tb[e + 1] = tb[e] + __builtin_amdgcn_readfirstlane((int)((__hip_atomic_load(cnt + e, __ATOMIC_RELAXED, __HIP_MEMORY_SCOPE_AGENT) + 255u) >> 8));
}
__device__ __forceinline__ void phase_moe_map(Frame& F, int moe_slot) {
    int tb[9]; moe_bases(F.ctl + CW_MOECNT + 64 * moe_slot, tb);
    const int* TE = (const int*)(F.ws + WS_TOK_E); const int* TS = (const int*)(F.ws + WS_TOK_SLOT); int* TR = (int*)(F.ws + WS_TOK_ROW); int* RM = (int*)(F.ws + WS_ROWMAP);
    for (int a = F.bid * 512 + F.tid; a < NTOK * 2; a += F.G * 512) {
        const int e = TE[a]; int base = 0;
#pragma unroll
        for (int j = 0; j < 8; ++j) base = (e == j) ? tb[j] : base;
        const int row = base * 256 + TS[a]; TR[a] = row; RM[row] = a >> 1;
    }
    { unsigned zz = 0u; asm volatile("" : "+v"(zz)); unsigned char* A8 = F.ws + WS_PROJ;
      for (int i = F.bid * 512 + F.tid; i < tb[8] * 256 * ((KP8 - D_FFE) / 16); i += F.G * 512) { const int row = i >> 3, c = i & 7; *(u32x4*)(A8 + (size_t)row * KP8 + D_FFE + 16 * c) = (u32x4){zz, zz, zz, zz}; } }
    for (int i = F.bid * 512 + F.tid; i < N_EXP * 256; i += F.G * 512) {
        const int e = i >> 8, j = i & 255; int b0 = 0, b1 = 0;
#pragma unroll
        for (int q = 0; q < 8; ++q) { b0 = (e == q) ? tb[q] : b0; b1 = (e == q) ? tb[q + 1] : b1; }
        const int cnt = (int)__hip_atomic_load(F.ctl + CW_MOECNT + 64 * moe_slot + e, __ATOMIC_RELAXED, __HIP_MEMORY_SCOPE_AGENT);
        const int row = b0 * 256 + cnt + j; if (row < b1 * 256) RM[row] = 0;
    }
}
__device__ __forceinline__ void swa_unit(Frame& F, int l, int unit) {
    const bf16_t* P = (const bf16_t*)(F.ws + WS_PROJ); bf16_t* MIX = (bf16_t*)(F.ws + WS_MIX);
    const float* RC = (const float*)(F.ws + WS_ROPE_C); const float* RS = (const float*)(F.ws + WS_ROPE_S);
    const int qblk = unit & 31, kvh = (unit >> 5) & 1, b = unit >> 6;
    LAS float* Ks = (LAS float*)F.lds;
    LAS float* Vs = (LAS float*)(F.lds + 65536);
    const int tok0 = b * SEQ + qblk * 128;
    __syncthreads();
#pragma unroll 1
    for (int it = 0; it < 16; ++it) {
        const int idx = it * 512 + F.tid, j = idx >> 5, d = idx & 31; const int pos = qblk * 128 - 128 + j;
        float o1 = 0.f, o2 = 0.f;
        if (pos >= 0) { const int tok = b * SEQ + pos; const bf16_t* kp = P + (size_t)tok * NPROJ + PA_K + kvh * 64;
            const float k1 = bf2f(kp[d]), k2 = bf2f(kp[d + 32]), c = RC[tok * 32 + d], s = RS[tok * 32 + d]; o1 = k1 * c - k2 * s; o2 = k2 * c + k1 * s; }
        Ks[j * 64 + d] = o1; Ks[j * 64 + d + 32] = o2;
    }
#pragma unroll 1
    for (int it = 0; it < 32; ++it) {
        const int idx = it * 512 + F.tid, j = idx >> 6, d = idx & 63; const int pos = qblk * 128 - 128 + j;
        Vs[idx] = (pos >= 0) ? bf2f(P[(size_t)(b * SEQ + pos) * NPROJ + PA_V + kvh * 64 + d]) : 0.f;
    }
    const int part = F.tid >> 8, qv = F.tid & 255, g = qv >> 7, i = qv & 127, hq = kvh * 2 + g;
    const int tok = tok0 + i;
    float q[64];
    { const bf16_t* qp = P + (size_t)tok * NPROJ + PA_Q + hq * 64;
#pragma unroll
      for (int d = 0; d < 32; ++d) { const float q1 = bf2f(qp[d]), q2 = bf2f(qp[d + 32]), c = RC[tok * 32 + d], s = RS[tok * 32 + d]; q[d] = (q1 * c - q2 * s) * 0.125f; q[d + 32] = (q2 * c + q1 * s) * 0.125f; } }
    const float sink = INF(F, I_SINKS)[l * 4 + hq];
    float m = sink, lsum = (part == 0) ? 1.f : 0.f, acc[64];
#pragma unroll
    for (int d = 0; d < 64; ++d) acc[d] = 0.f;
    __syncthreads();
    for (int jj = 0; jj < 128; ++jj) {
        const int j = part * 128 + jj;
        const bool valid = (j > i) && (j <= i + 128) && (qblk > 0 || j >= 128);
        float s = 0.f;
#pragma unroll
        for (int d4 = 0; d4 < 16; ++d4) { const f32x4 kv = *(const LAS f32x4*)(Ks + j * 64 + d4 * 4); s += (q[d4 * 4] * kv[0] + q[d4 * 4 + 1] * kv[1]) + (q[d4 * 4 + 2] * kv[2] + q[d4 * 4 + 3] * kv[3]); }
        if (!valid) s = -INFINITY;
        const float mn = fmaxf(m, s), sc = __expf(m - mn), p = __expf(s - mn);
        lsum = lsum * sc + p; m = mn;
#pragma unroll
        for (int d4 = 0; d4 < 16; ++d4) { const f32x4 vv = *(const LAS f32x4*)(Vs + j * 64 + d4 * 4);
            acc[d4 * 4] = acc[d4 * 4] * sc + p * vv[0]; acc[d4 * 4 + 1] = acc[d4 * 4 + 1] * sc + p * vv[1]; acc[d4 * 4 + 2] = acc[d4 * 4 + 2] * sc + p * vv[2]; acc[d4 * 4 + 3] = acc[d4 * 4 + 3] * sc + p * vv[3]; }
    }
    __syncthreads();
    LAS float* MB = (LAS float*)F.lds;
    if (part == 1) { MB[qv * 66] = m; MB[qv * 66 + 1] = lsum;
#pragma unroll
        for (int d = 0; d < 64; ++d) MB[qv * 66 + 2 + d] = acc[d]; }
    __syncthreads();
    if (part == 0) {
        const float m1 = MB[qv * 66], l1 = MB[qv * 66 + 1]; const float M = fmaxf(m, m1), s0 = __expf(m - M), s1 = __expf(m1 - M);
        const float inv = 1.f / (lsum * s0 + l1 * s1); float ss = 0.f;
#pragma unroll
        for (int d = 0; d < 64; ++d) { acc[d] = (acc[d] * s0 + MB[qv * 66 + 2 + d] * s1) * inv; ss += acc[d] * acc[d]; }
        const float rstd = rsqrtf(ss * (1.f / 64.f) + NORM_EPS); const float* gn = INF(F, I_SWA_ON) + l * 256 + hq * 64;
        bf16_t* op = MIX + (size_t)tok * DM + hq * 64;
#pragma unroll
        for (int d8 = 0; d8 < 8; ++d8) { u32x4 w;
            w.x = pk2(acc[d8 * 8] * rstd * gn[d8 * 8], acc[d8 * 8 + 1] * rstd * gn[d8 * 8 + 1]); w.y = pk2(acc[d8 * 8 + 2] * rstd * gn[d8 * 8 + 2], acc[d8 * 8 + 3] * rstd * gn[d8 * 8 + 3]);
            w.z = pk2(acc[d8 * 8 + 4] * rstd * gn[d8 * 8 + 4], acc[d8 * 8 + 5] * rstd * gn[d8 * 8 + 5]); w.w = pk2(acc[d8 * 8 + 6] * rstd * gn[d8 * 8 + 6], acc[d8 * 8 + 7] * rstd * gn[d8 * 8 + 7]);
            *(u32x4*)(op + d8 * 8) = w; }
    }
}

__device__ __forceinline__ void sb_waveunit(Frame& F, int l, int wu) {
    const bf16_t* P = (const bf16_t*)(F.ws + WS_PROJ); bf16_t* MIX = (bf16_t*)(F.ws + WS_MIX);
    const int tb = wu & 63, h = (wu >> 6) & 3, b = wu >> 8;
    const int t0 = tb * 64, t = t0 + F.lane;
    float q[64], o[64];
    { const u32x4* qp = (const u32x4*)(P + (size_t)(b * SEQ + t) * NPROJ + PC_Q + h * 64);
#pragma unroll
      for (int d8 = 0; d8 < 8; ++d8) { const u32x4 w = qp[d8];
          q[d8 * 8] = bflo(w.x) * 0.125f; q[d8 * 8 + 1] = bfhi(w.x) * 0.125f; q[d8 * 8 + 2] = bflo(w.y) * 0.125f; q[d8 * 8 + 3] = bfhi(w.y) * 0.125f;
          q[d8 * 8 + 4] = bflo(w.z) * 0.125f; q[d8 * 8 + 5] = bfhi(w.z) * 0.125f; q[d8 * 8 + 6] = bflo(w.w) * 0.125f; q[d8 * 8 + 7] = bfhi(w.w) * 0.125f; } }
#pragma unroll
    for (int d = 0; d < 64; ++d) o[d] = 0.f;
    float R = 0.f;
    for (int s = t0 + 62; s >= 0; --s) {
        if (s < t0) { if (__all(R < -80.f)) break; }
        const size_t rowoff = (size_t)__builtin_amdgcn_readfirstlane(b * SEQ + s) * NPROJ;
        const u32x4* kp = (const u32x4*)(P + rowoff + PC_K + h * 64); const u32x4* vp = (const u32x4*)(P + rowoff + PC_V + h * 64);
        float z = 0.f;
#pragma unroll
        for (int d8 = 0; d8 < 8; ++d8) { const u32x4 w = kp[d8];
            z += (q[d8 * 8] * bflo(w.x) + q[d8 * 8 + 1] * bfhi(w.x)) + (q[d8 * 8 + 2] * bflo(w.y) + q[d8 * 8 + 3] * bfhi(w.y))
               + (q[d8 * 8 + 4] * bflo(w.z) + q[d8 * 8 + 5] * bfhi(w.z)) + (q[d8 * 8 + 6] * bflo(w.w) + q[d8 * 8 + 7] * bfhi(w.w)); }
        const bool valid = s < t;
        const float sp = softplus_f(z);
        const float p = valid ? __expf((z - sp) + R) : 0.f;
        R += valid ? -sp : 0.f;
#pragma unroll
        for (int d8 = 0; d8 < 8; ++d8) { const u32x4 w = vp[d8];
            o[d8 * 8] += p * bflo(w.x); o[d8 * 8 + 1] += p * bfhi(w.x); o[d8 * 8 + 2] += p * bflo(w.y); o[d8 * 8 + 3] += p * bfhi(w.y);
            o[d8 * 8 + 4] += p * bflo(w.z); o[d8 * 8 + 5] += p * bfhi(w.z); o[d8 * 8 + 6] += p * bflo(w.w); o[d8 * 8 + 7] += p * bfhi(w.w); }
    }
    float ss = 0.f;
#pragma unroll
    for (int d = 0; d < 64; ++d) ss += o[d] * o[d];
    const float rstd = rsqrtf(ss * (1.f / 64.f) + NORM_EPS); const float* gn = INF(F, I_SB_ON) + l * 256 + h * 64;
    bf16_t* op = MIX + (size_t)(b * SEQ + t) * DM + 512 + h * 64;
#pragma unroll
    for (int d8 = 0; d8 < 8; ++d8) { u32x4 w;
        w.x = pk2(o[d8 * 8] * rstd * gn[d8 * 8], o[d8 * 8 + 1] * rstd * gn[d8 * 8 + 1]); w.y = pk2(o[d8 * 8 + 2] * rstd * gn[d8 * 8 + 2], o[d8 * 8 + 3] * rstd * gn[d8 * 8 + 3]);
        w.z = pk2(o[d8 * 8 + 4] * rstd * gn[d8 * 8 + 4], o[d8 * 8 + 5] * rstd * gn[d8 * 8 + 5]); w.w = pk2(o[d8 * 8 + 6] * rstd * gn[d8 * 8 + 6], o[d8 * 8 + 7] * rstd * gn[d8 * 8 + 7]);
        *(u32x4*)(op + d8 * 8) = w; }
}

__device__ __forceinline__ void gla_decay_cumsum(Frame& F, int l, int b, int h, int n, LAS float* Bc) {
    const bf16_t* P = (const bf16_t*)(F.ws + WS_PROJ);
    const float* wa2 = INF(F, I_GLA_WA2) + l * 16 * 128; const float* ba = INF(F, I_GLA_BA) + l * 128;
    const int tok0 = b * SEQ + n * 64;
#pragma unroll
    for (int it = 0; it < 4; ++it) { const int idx = it * 512 + F.tid, t = idx >> 5, e = idx & 31;
        const bf16_t* lr = P + (size_t)(tok0 + t) * NPROJ + PB_LR; float a = ba[h * 32 + e];
#pragma unroll
        for (int r = 0; r < 16; ++r) a += bf2f(lr[r]) * wa2[r * 128 + h * 32 + e];
        Bc[idx] = logsigmoid_f(a) * (1.f / 16.f); }
    __syncthreads();
    if (F.tid < 32) { float c = 0.f; for (int t = 0; t < 64; ++t) { c += Bc[t * 32 + F.tid]; Bc[t * 32 + F.tid] = c; } }
    __syncthreads();
}
__device__ __forceinline__ void gla_kv_unit(Frame& F, int l, int unit) {
    const bf16_t* P = (const bf16_t*)(F.ws + WS_PROJ);
    float* KV = (float*)(F.ws + WS_GLA_KV) + (size_t)unit * 2048; float* DEC = (float*)(F.ws + WS_GLA_DEC) + unit * 32;
    const int n = unit & 63, h = (unit >> 6) & 3, b = unit >> 8, tok0 = b * SEQ + n * 64;
    LAS float* Bc = (LAS float*)F.lds; LAS float* Ke = (LAS float*)(F.lds + 8192); LAS float* Vs = (LAS float*)(F.lds + 16384);
    __syncthreads();
    gla_decay_cumsum(F, l, b, h, n, Bc);
#pragma unroll
    for (int it = 0; it < 4; ++it) { const int idx = it * 512 + F.tid, s = idx >> 5, e = idx & 31;
        Ke[idx] = bf2f(P[(size_t)(tok0 + s) * NPROJ + PB_K + h * 32 + e]) * __expf(Bc[63 * 32 + e] - Bc[idx]); }
#pragma unroll
    for (int it = 0; it < 8; ++it) { const int idx = it * 512 + F.tid, s = idx >> 6, f = idx & 63; Vs[idx] = bf2f(P[(size_t)(tok0 + s) * NPROJ + PB_V + h * 64 + f]); }
    __syncthreads();
    { const int e = F.tid >> 4, f0 = (F.tid & 15) * 4; f32x4 a = {0.f, 0.f, 0.f, 0.f};
      for (int s = 0; s < 64; ++s) { const float ke = Ke[s * 32 + e]; const f32x4 vv = *(const LAS f32x4*)(Vs + s * 64 + f0); a += ke * vv; }
      *(f32x4*)(KV + e * 64 + f0) = a; }
    if (F.tid < 32) DEC[F.tid] = __expf(Bc[63 * 32 + F.tid]);
}
__device__ __forceinline__ void gla_scan(Frame& F, int gtid) {
    const int f = gtid & 63, e = (gtid >> 6) & 31, bh = gtid >> 11;
    float* KV = (float*)(F.ws + WS_GLA_KV) + (size_t)bh * 64 * 2048 + e * 64 + f; const float* DEC = (const float*)(F.ws + WS_GLA_DEC) + bh * 64 * 32 + e;
    float st = 0.f;
#pragma unroll 8
    for (int n = 0; n < 64; ++n) { const float kv = KV[(size_t)n * 2048], d = DEC[n * 32]; KV[(size_t)n * 2048] = st; st = d * st + kv; }
}
__device__ __forceinline__ void gla_out_unit(Frame& F, int l, int unit) {
    const bf16_t* P = (const bf16_t*)(F.ws + WS_PROJ); bf16_t* MIX = (bf16_t*)(F.ws + WS_MIX);
    const float* SP = (const float*)(F.ws + WS_GLA_KV) + (size_t)unit * 2048;
    const int n = unit & 63, h = (unit >> 6) & 3, b = unit >> 8, tok0 = b * SEQ + n * 64;
    LAS float* Bc = (LAS float*)F.lds; LAS float* Qe = (LAS float*)(F.lds + 8192); LAS float* Ke = (LAS float*)(F.lds + 16384); LAS float* Qb = (LAS float*)(F.lds + 25088);
    LAS float* Vs = (LAS float*)(F.lds + 33792); LAS float* Ss = (LAS float*)(F.lds + 50176); LAS float* At = (LAS float*)(F.lds + 58368);
    __syncthreads();
    gla_decay_cumsum(F, l, b, h, n, Bc);
    const float qs = 0.17677669529663687f;
#pragma unroll
    for (int it = 0; it < 4; ++it) { const int idx = it * 512 + F.tid, t = idx >> 5, e = idx & 31;
        const float bt = Bc[idx], br = Bc[31 * 32 + e];
        const float qv = bf2f(P[(size_t)(tok0 + t) * NPROJ + PB_Q + h * 32 + e]) * qs, kv = bf2f(P[(size_t)(tok0 + t) * NPROJ + PB_K + h * 32 + e]);
        Qe[idx] = qv * __expf(bt - br); Ke[t * 33 + e] = kv * __expf(br - bt); Qb[idx] = qv * __expf(bt); }
#pragma unroll
    for (int it = 0; it < 8; ++it) { const int idx = it * 512 + F.tid, s = idx >> 6, f = idx & 63; Vs[idx] = bf2f(P[(size_t)(tok0 + s) * NPROJ + PB_V + h * 64 + f]); }
#pragma unroll
    for (int it = 0; it < 4; ++it) { const int idx = it * 512 + F.tid; Ss[idx] = SP[idx]; }
    __syncthreads();
#pragma unroll
    for (int it = 0; it < 8; ++it) { const int idx = it * 512 + F.tid, t = idx >> 6, s = idx & 63; float a = 0.f;
        if (s <= t) {
#pragma unroll
            for (int e = 0; e < 32; ++e) a += Qe[t * 32 + e] * Ke[s * 33 + e]; }
        At[t * 65 + s] = a; }
    __syncthreads();
    { const int t = F.tid >> 3, f0 = (F.tid & 7) * 8; float o[8];
#pragma unroll
      for (int j = 0; j < 8; ++j) o[j] = 0.f;
      for (int s = 0; s <= t; ++s) { const float a = At[t * 65 + s]; const f32x4 v0 = *(const LAS f32x4*)(Vs + s * 64 + f0), v1 = *(const LAS f32x4*)(Vs + s * 64 + f0 + 4);
          o[0] += a * v0[0]; o[1] += a * v0[1]; o[2] += a * v0[2]; o[3] += a * v0[3]; o[4] += a * v1[0]; o[5] += a * v1[1]; o[6] += a * v1[2]; o[7] += a * v1[3]; }
#pragma unroll
      for (int e = 0; e < 32; ++e) { const float a = Qb[t * 32 + e]; const f32x4 v0 = *(const LAS f32x4*)(Ss + e * 64 + f0), v1 = *(const LAS f32x4*)(Ss + e * 64 + f0 + 4);
          o[0] += a * v0[0]; o[1] += a * v0[1]; o[2] += a * v0[2]; o[3] += a * v0[3]; o[4] += a * v1[0]; o[5] += a * v1[1]; o[6] += a * v1[2]; o[7] += a * v1[3]; }
      float ss = 0.f;
#pragma unroll
      for (int j = 0; j < 8; ++j) ss += o[j] * o[j];
      ss += __shfl_xor(ss, 1); ss += __shfl_xor(ss, 2); ss += __shfl_xor(ss, 4);
      const float rstd = rsqrtf(ss * (1.f / 64.f) + NORM_EPS); const float* gn = INF(F, I_GLA_ON) + l * 256 + h * 64 + f0;
      const u32x4 gw = *(const u32x4*)(P + (size_t)(tok0 + t) * NPROJ + PB_G + h * 64 + f0);
      float gb[8] = {bflo(gw.x), bfhi(gw.x), bflo(gw.y), bfhi(gw.y), bflo(gw.z), bfhi(gw.z), bflo(gw.w), bfhi(gw.w)};
      float r[8];
#pragma unroll
      for (int j = 0; j < 8; ++j) r[j] = o[j] * rstd * gn[j] * (gb[j] * sigmoid_f(gb[j]));
      u32x4 w; w.x = pk2(r[0], r[1]); w.y = pk2(r[2], r[3]); w.z = pk2(r[4], r[5]); w.w = pk2(r[6], r[7]);
      *(u32x4*)(MIX + (size_t)(tok0 + t) * DM + 256 + h * 64 + f0) = w; }
}

template <int CTRL> __device__ __forceinline__ float dpp_add(float v) { return v + __builtin_bit_cast(float, __builtin_amdgcn_update_dpp(0, __builtin_bit_cast(int, v), CTRL, 0xf, 0xf, false)); }
__device__ __forceinline__ float sum16(float v) { v = dpp_add<0xB1>(v); v = dpp_add<0x4E>(v); v = dpp_add<0x141>(v); v = dpp_add<0x140>(v); return v; }
typedef float f32x16 __attribute__((ext_vector_type(16)));
__device__ __forceinline__ float other_half(float x, int hh) {
    auto t = __builtin_amdgcn_permlane32_swap(__float_as_uint(x), __float_as_uint(x), false, false);
    return __uint_as_float(hh ? t[0] : t[1]);
}
__device__ __forceinline__ unsigned cvt_pk(float lo, float hi) { unsigned r; asm volatile("v_cvt_pk_bf16_f32 %0, %1, %2" : "=v"(r) : "v"(lo), "v"(hi)); return r; }
__device__ __forceinline__ bf16x8 pack8(float p0, float p1, float p2, float p3, float p4, float p5, float p6, float p7) {
    u32x4 w; w.x = cvt_pk(p0, p1); w.y = cvt_pk(p2, p3); w.z = cvt_pk(p4, p5); w.w = cvt_pk(p6, p7); return __builtin_bit_cast(bf16x8, w);
}
#define PACK8(a, o) pack8(a[(o)], a[(o) + 1], a[(o) + 2], a[(o) + 3], a[(o) + 4], a[(o) + 5], a[(o) + 6], a[(o) + 7])
__device__ __forceinline__ bf16x8 load_vt(const bf16_t* P, size_t vrow0, int vcol, int db, int ko, int r, int hh) {
    const bf16_t* p = P + (vrow0 + 32 * db + r) * NPROJ + vcol + ko + 4 * hh;
    const u32x2 a = *(const u32x2*)p, b = *(const u32x2*)(p + 8);
    u32x4 w; w.x = a.x; w.y = a.y; w.z = b.x; w.w = b.y; return __builtin_bit_cast(bf16x8, w);
}
__device__ __forceinline__ void store_ot(bf16_t* orow, const f32x16& o0, const f32x16& o1, float rs, const float* gn, int hh) {
#pragma unroll
    for (int db = 0; db < 2; ++db)
#pragma unroll
        for (int g4 = 0; g4 < 4; ++g4) { const int d = 32 * db + 8 * g4 + 4 * hh; const f32x4 gv = *(const f32x4*)(gn + d);
            const f32x16& o = db ? o1 : o0;
            u32x2 w; w.x = cvt_pk(o[4 * g4] * rs * gv[0], o[4 * g4 + 1] * rs * gv[1]); w.y = cvt_pk(o[4 * g4 + 2] * rs * gv[2], o[4 * g4 + 3] * rs * gv[3]);
            *(u32x2*)(orow + d) = w; }
}

__device__ __forceinline__ void attn_prep_block(Frame& F, int blk) {
    bf16_t* P = (bf16_t*)(F.ws + WS_PROJ);
    const float* RC = (const float*)(F.ws + WS_ROPE_C); const float* RS = (const float*)(F.ws + WS_ROPE_S);
    LAS unsigned* T = (LAS unsigned*)F.lds;
    const int tok0 = blk * 64;
    for (int it = 0; it < 24; ++it) { const int idx = it * 512 + F.tid, d = idx & 31, hd = (idx >> 5) % 6, tt = idx / 192; const int tok = tok0 + tt;
        bf16_t* p = P + (size_t)tok * NPROJ + (hd < 4 ? PA_Q + hd * 64 : PA_K + (hd - 4) * 64); const float sc = hd < 4 ? 0.18033688011112042f : 1.f;
        const float x1 = bf2f(p[d]), x2 = bf2f(p[d + 32]), c = RC[tok * 32 + d], s = RS[tok * 32 + d];
        p[d] = f2bf((x1 * c - x2 * s) * sc); p[d + 32] = f2bf((x2 * c + x1 * s) * sc); }
    for (int vt = 0; vt < 6; ++vt) {
        const int vcol = vt < 2 ? PA_V + vt * 64 : PC_V + (vt - 2) * 64;
        __syncthreads();
        { const int tt = F.tid >> 3, c8 = F.tid & 7; const u32x4 w = *(const u32x4*)(P + (size_t)(tok0 + tt) * NPROJ + vcol + c8 * 8);
          T[tt * 33 + c8 * 4] = w.x; T[tt * 33 + c8 * 4 + 1] = w.y; T[tt * 33 + c8 * 4 + 2] = w.z; T[tt * 33 + c8 * 4 + 3] = w.w; }
        __syncthreads();
        { const int d = F.tid >> 3, t8 = F.tid & 7; unsigned e[8];
#pragma unroll
          for (int i = 0; i < 8; ++i) { const unsigned w = T[(t8 * 8 + i) * 33 + (d >> 1)]; e[i] = (d & 1) ? (w >> 16) : (w & 0xffffu); }
          u32x4 o; o.x = e[0] | (e[1] << 16); o.y = e[2] | (e[3] << 16); o.z = e[4] | (e[5] << 16); o.w = e[6] | (e[7] << 16);
          *(u32x4*)(P + (size_t)(tok0 + d) * NPROJ + vcol + t8 * 8) = o; }
    }
}

__device__ __forceinline__ void sb_task(Frame& F, int l, int task) {
    const bf16_t* P = (const bf16_t*)(F.ws + WS_PROJ); bf16_t* MIX = (bf16_t*)(F.ws + WS_MIX);
    const int qb = task & 127, h = (task >> 7) & 3, b = task >> 9;
    const int q0 = qb * 32, r = F.lane & 31, hh = F.lane >> 5, t = q0 + r;
    const size_t rowb = (size_t)b * SEQ;
    bf16x8 qf[4];
    { const bf16_t* qp = P + (rowb + t) * NPROJ + PC_Q + h * 64 + 8 * hh;
#pragma unroll
      for (int s = 0; s < 4; ++s) qf[s] = *(const bf16x8*)(qp + 16 * s); }
    f32x16 o0, o1;
#pragma unroll
    for (int i = 0; i < 16; ++i) { o0[i] = 0.f; o1[i] = 0.f; }
    float R = 0.f;
    bf16x8 kf[2][4];
#define SB_LOADK(kt_) do { _Pragma("unroll") for (int kb = 0; kb < 2; ++kb) { const bf16_t* kp = P + (rowb + 64 * (kt_) + 32 * kb + r) * NPROJ + PC_K + h * 64 + 8 * hh; \
        _Pragma("unroll") for (int s = 0; s < 4; ++s) kf[kb][s] = *(const bf16x8*)(kp + 16 * s); } } while (0)
    SB_LOADK((q0 + 30) >> 6);
    for (int kt = (q0 + 30) >> 6; kt >= 0; --kt) {
        const size_t krow0 = rowb + 64 * kt;
        bf16x8 vf[2][2][2];
#pragma unroll
        for (int kb = 0; kb < 2; ++kb)
#pragma unroll
            for (int s = 0; s < 2; ++s) { vf[0][kb][s] = load_vt(P, krow0, PC_V + h * 64, 0, 32 * kb + 16 * s, r, hh); vf[1][kb][s] = load_vt(P, krow0, PC_V + h * 64, 1, 32 * kb + 16 * s, r, hh); }
        __builtin_amdgcn_sched_barrier(0);
        f32x16 st[2];
#pragma unroll
        for (int kb = 0; kb < 2; ++kb) { f32x16 a;
#pragma unroll
            for (int i = 0; i < 16; ++i) a[i] = 0.f;
#pragma unroll
            for (int s = 0; s < 4; ++s) a = __builtin_amdgcn_mfma_f32_32x32x16_bf16(kf[kb][s], qf[s], a, 0, 0, 0);
            st[kb] = a; }
        bf16x8 kn[2][4];
        { const int ktn = kt > 0 ? kt - 1 : 0;
#pragma unroll
          for (int kb = 0; kb < 2; ++kb) { const bf16_t* kp = P + (rowb + 64 * ktn + 32 * kb + r) * NPROJ + PC_K + h * 64 + 8 * hh;
#pragma unroll
              for (int s = 0; s < 4; ++s) kn[kb][s] = *(const bf16x8*)(kp + 16 * s); } }
        float Rb = R;
#pragma unroll
        for (int kb = 1; kb >= 0; --kb) {
            float lv[16], zz[16], p[16];
#pragma unroll
            for (int i = 0; i < 16; ++i) { const int key = 64 * kt + 32 * kb + (i & 3) + 8 * (i >> 2) + 4 * hh; const float z = st[kb][i] * 0.18033688011112042f; const bool valid = key < t;
                const float sp = fmaxf(z, 0.f) + __builtin_amdgcn_logf(1.f + __builtin_amdgcn_exp2f(-fabsf(z))); lv[i] = valid ? -sp : 0.f; zz[i] = valid ? (z - sp) : -INFINITY; }
            float gown[4], suf[16];
#pragma unroll
            for (int g = 0; g < 4; ++g) { const float s3 = lv[4 * g + 3], s2 = s3 + lv[4 * g + 2], s1 = s2 + lv[4 * g + 1]; gown[g] = s1 + lv[4 * g];
                suf[4 * g + 3] = 0.f; suf[4 * g + 2] = s3; suf[4 * g + 1] = s2; suf[4 * g] = s1; }
            float run = 0.f, above[4];
#pragma unroll
            for (int g = 3; g >= 0; --g) { const float go = other_half(gown[g], hh); above[g] = run + (hh == 0 ? go : 0.f); run += gown[g] + go; }
#pragma unroll
            for (int i = 0; i < 16; ++i) p[i] = __builtin_amdgcn_exp2f(zz[i] + (Rb + above[i >> 2] + suf[i]));
            Rb += run;
#pragma unroll
            for (int s = 0; s < 2; ++s) { const bf16x8 pf = PACK8(p, 8 * s);
                o0 = __builtin_amdgcn_mfma_f32_32x32x16_bf16(vf[0][kb][s], pf, o0, 0, 0, 0);
                o1 = __builtin_amdgcn_mfma_f32_32x32x16_bf16(vf[1][kb][s], pf, o1, 0, 0, 0); }
        }
        R = Rb;
#pragma unroll
        for (int kb = 0; kb < 2; ++kb)
#pragma unroll
            for (int s = 0; s < 4; ++s) kf[kb][s] = kn[kb][s];
        if (__all(R < -115.5f)) break;
    }
#undef SB_LOADK
    float ss = 0.f;
#pragma unroll
    for (int i = 0; i < 16; ++i) ss += o0[i] * o0[i] + o1[i] * o1[i];
    ss += other_half(ss, hh);
    const float rstd = rsqrtf(ss * (1.f / 64.f) + NORM_EPS);
    store_ot(MIX + (rowb + t) * DM + 512 + h * 64, o0, o1, rstd, INF(F, I_SB_ON) + l * 256 + h * 64, hh);
}

__device__ __forceinline__ void swa_task(Frame& F, int l, int task) {
    const bf16_t* P = (const bf16_t*)(F.ws + WS_PROJ); bf16_t* MIX = (bf16_t*)(F.ws + WS_MIX);
    const int qb = task & 127, hq = (task >> 7) & 3, b = task >> 9, kvh = hq >> 1;
    const int q0 = qb * 32, r = F.lane & 31, hh = F.lane >> 5, t = q0 + r;
    const size_t rowb = (size_t)b * SEQ;
    bf16x8 qf[4];
    { const bf16_t* qp = P + (rowb + t) * NPROJ + PA_Q + hq * 64 + 8 * hh;
#pragma unroll
      for (int s = 0; s < 4; ++s) qf[s] = *(const bf16x8*)(qp + 16 * s); }
    f32x16 o0, o1;
#pragma unroll
    for (int i = 0; i < 16; ++i) { o0[i] = 0.f; o1[i] = 0.f; }
    float m = INF(F, I_SINKS)[l * 4 + hq], lsum = 1.f;
    const int ktlo = (q0 >= 127) ? ((q0 - 127) >> 6) : 0;
    for (int kt = (q0 + 31) >> 6; kt >= ktlo; --kt) {
        const size_t krow0 = rowb + 64 * kt;
        float sv[32];
        float tmax = -INFINITY;
#pragma unroll
        for (int kb = 0; kb < 2; ++kb) { const bf16_t* kp = P + (krow0 + 32 * kb + r) * NPROJ + PA_K + kvh * 64 + 8 * hh;
            f32x16 a;
#pragma unroll
            for (int i = 0; i < 16; ++i) a[i] = 0.f;
#pragma unroll
            for (int s = 0; s < 4; ++s) a = __builtin_amdgcn_mfma_f32_32x32x16_bf16(*(const bf16x8*)(kp + 16 * s), qf[s], a, 0, 0, 0);
#pragma unroll
            for (int i = 0; i < 16; ++i) { const int key = 64 * kt + 32 * kb + (i & 3) + 8 * (i >> 2) + 4 * hh; const bool valid = (key <= t) && (key + 127 >= t);
                sv[kb * 16 + i] = valid ? a[i] : -INFINITY; tmax = fmaxf(tmax, sv[kb * 16 + i]); } }
        tmax = fmaxf(tmax, other_half(tmax, hh));
        const float mn = fmaxf(m, tmax), sc = __expf(m - mn);
        float psum = 0.f;
#pragma unroll
        for (int i = 0; i < 32; ++i) { sv[i] = __expf(sv[i] - mn); psum += sv[i]; }
        psum += other_half(psum, hh);
        lsum = lsum * sc + psum; m = mn;
#pragma unroll
        for (int i = 0; i < 16; ++i) { o0[i] *= sc; o1[i] *= sc; }
#pragma unroll
        for (int kb = 0; kb < 2; ++kb)
#pragma unroll
            for (int s = 0; s < 2; ++s) { const bf16x8 pf = PACK8(sv, kb * 16 + 8 * s);
                o0 = __builtin_amdgcn_mfma_f32_32x32x16_bf16(load_vt(P, krow0, PA_V + kvh * 64, 0, 32 * kb + 16 * s, r, hh), pf, o0, 0, 0, 0);
                o1 = __builtin_amdgcn_mfma_f32_32x32x16_bf16(load_vt(P, krow0, PA_V + kvh * 64, 1, 32 * kb + 16 * s, r, hh), pf, o1, 0, 0, 0); }
    }
    const float inv = 1.f / lsum;
    float ss = 0.f;
#pragma unroll
    for (int i = 0; i < 16; ++i) { o0[i] *= inv; o1[i] *= inv; ss += o0[i] * o0[i] + o1[i] * o1[i]; }
    ss += other_half(ss, hh);
    const float rstd = rsqrtf(ss * (1.f / 64.f) + NORM_EPS);
    store_ot(MIX + (rowb + t) * DM + hq * 64, o0, o1, rstd, INF(F, I_SWA_ON) + l * 256 + hq * 64, hh);
}

__device__ __forceinline__ unsigned short hw(const u32x4& w, int j) { const unsigned d = (j >> 1) == 0 ? w.x : ((j >> 1) == 1 ? w.y : ((j >> 1) == 2 ? w.z : w.w)); return (unsigned short)((j & 1) ? (d >> 16) : (d & 0xffffu)); }
template <int V> struct IC { static constexpr int value = V; };
template <bool SWA>
__device__ __forceinline__ void attn_block(Frame& F, int l, int bt) {
    const bf16_t* P = (const bf16_t*)(F.ws + WS_PROJ); bf16_t* MIX = (bf16_t*)(F.ws + WS_MIX);
    const int qblk = bt & 15, h = (bt >> 4) & 3, b = bt >> 6;
    const int q0b = qblk * 256, q0 = q0b + 32 * F.wave, r = F.lane & 31, hh = F.lane >> 5, t = q0 + r;
    const size_t rowb = (size_t)b * SEQ;
    const int qcol = SWA ? PA_Q + h * 64 : PC_Q + h * 64, kcol = SWA ? PA_K + (h >> 1) * 64 : PC_K + h * 64, vcol = SWA ? PA_V + (h >> 1) * 64 : PC_V + h * 64;
    LAS bf16_t* Ks = (LAS bf16_t*)F.lds; LAS bf16_t* Vs = (LAS bf16_t*)(F.lds + 2 * 9216);
    const float* RC = (const float*)(F.ws + WS_ROPE_C); const float* RS = (const float*)(F.ws + WS_ROPE_S);
    bf16x8 qf[4];
    { const bf16_t* qp = P + (rowb + t) * NPROJ + qcol + 8 * hh; u32x4 qw[4];
#pragma unroll
      for (int s = 0; s < 4; ++s) qw[s] = *(const u32x4*)(qp + 16 * s);
      if (SWA) {
#pragma unroll
          for (int s = 0; s < 2; ++s) { const float* cp = RC + (rowb + t) * 32 + 16 * s + 8 * hh; const float* sp = RS + (rowb + t) * 32 + 16 * s + 8 * hh;
              const f32x4 c0 = *(const f32x4*)cp, c1 = *(const f32x4*)(cp + 4), s0 = *(const f32x4*)sp, s1 = *(const f32x4*)(sp + 4);
              const unsigned a[4] = {qw[s].x, qw[s].y, qw[s].z, qw[s].w}, bq[4] = {qw[s + 2].x, qw[s + 2].y, qw[s + 2].z, qw[s + 2].w}; float o1[8], o2[8];
#pragma unroll
              for (int j = 0; j < 8; ++j) { const float x1 = (j & 1) ? bfhi(a[j >> 1]) : bflo(a[j >> 1]), x2 = (j & 1) ? bfhi(bq[j >> 1]) : bflo(bq[j >> 1]), cc = j < 4 ? c0[j & 3] : c1[j & 3], sn = j < 4 ? s0[j & 3] : s1[j & 3];
                  o1[j] = (x1 * cc - x2 * sn) * 0.18033688011112042f; o2[j] = (x2 * cc + x1 * sn) * 0.18033688011112042f; }
              qw[s] = (u32x4){cvt_pk(o1[0], o1[1]), cvt_pk(o1[2], o1[3]), cvt_pk(o1[4], o1[5]), cvt_pk(o1[6], o1[7])}; qw[s + 2] = (u32x4){cvt_pk(o2[0], o2[1]), cvt_pk(o2[2], o2[3]), cvt_pk(o2[4], o2[5]), cvt_pk(o2[6], o2[7])}; } }
#pragma unroll
      for (int s = 0; s < 4; ++s) qf[s] = __builtin_bit_cast(bf16x8, qw[s]); }
    f32x16 o0, o1;
#pragma unroll
    for (int i = 0; i < 16; ++i) { o0[i] = 0.f; o1[i] = 0.f; }
    float R = 0.f;
    float m = SWA ? INF(F, I_SINKS)[l * 4 + h] * 1.4426950408889634f : 0.f, lsum = 1.f;
    const int kt_top = SWA ? (q0b + 255) >> 6 : (q0b + 254) >> 6;
    const int kt_lo = SWA ? ((q0b >= 127) ? ((q0b - 127) >> 6) : 0) : 0;
    const int ktw = SWA ? (q0 + 31) >> 6 : (q0 + 30) >> 6;
    const int ktl = SWA ? ((q0 >= 127) ? ((q0 - 127) >> 6) : 0) : 0;
    bool fin = false;
    const bool kside = F.wave < 4; const int srow = (F.tid & 255) >> 2, q4 = F.tid & 3;
    u32x4 pa_[2], pb_[2]; f32x4 rc0_[2], rc1_[2], rs0_[2], rs1_[2];
#pragma unroll
    for (int i_ = 0; i_ < 2; ++i_) { rc0_[i_] = (f32x4){0.f, 0.f, 0.f, 0.f}; rc1_[i_] = rc0_[i_]; rs0_[i_] = rc0_[i_]; rs1_[i_] = rc0_[i_]; }
#define AT_FETCH(kt_, S_) do { const size_t tk_ = rowb + 64 * (kt_) + srow; \
        if (kside) { const bf16_t* p_ = P + tk_ * NPROJ + kcol + 8 * q4; pa_[S_] = *(const u32x4*)p_; pb_[S_] = *(const u32x4*)(p_ + 32); \
            if (SWA) { const float* c_ = RC + tk_ * 32 + 8 * q4; const float* s_ = RS + tk_ * 32 + 8 * q4; rc0_[S_] = *(const f32x4*)c_; rc1_[S_] = *(const f32x4*)(c_ + 4); rs0_[S_] = *(const f32x4*)s_; rs1_[S_] = *(const f32x4*)(s_ + 4); } } \
        else { const bf16_t* p_ = P + tk_ * NPROJ + vcol + 16 * q4; pa_[S_] = *(const u32x4*)p_; pb_[S_] = *(const u32x4*)(p_ + 8); } } while (0)
#define AT_STORE(bufi, S_) do { if (kside) { LAS bf16_t* d_ = Ks + (bufi) * 4608 + srow * 72 + 8 * q4; \
            if (SWA) { const unsigned a_[4] = {pa_[S_].x, pa_[S_].y, pa_[S_].z, pa_[S_].w}, b_[4] = {pb_[S_].x, pb_[S_].y, pb_[S_].z, pb_[S_].w}; float o1_[8], o2_[8]; \
                _Pragma("unroll") for (int j = 0; j < 8; ++j) { const float x1 = (j & 1) ? bfhi(a_[j >> 1]) : bflo(a_[j >> 1]), x2 = (j & 1) ? bfhi(b_[j >> 1]) : bflo(b_[j >> 1]), cc = j < 4 ? rc0_[S_][j & 3] : rc1_[S_][j & 3], sn = j < 4 ? rs0_[S_][j & 3] : rs1_[S_][j & 3]; \
                    o1_[j] = x1 * cc - x2 * sn; o2_[j] = x2 * cc + x1 * sn; } \
                pa_[S_] = (u32x4){cvt_pk(o1_[0], o1_[1]), cvt_pk(o1_[2], o1_[3]), cvt_pk(o1_[4], o1_[5]), cvt_pk(o1_[6], o1_[7])}; pb_[S_] = (u32x4){cvt_pk(o2_[0], o2_[1]), cvt_pk(o2_[2], o2_[3]), cvt_pk(o2_[4], o2_[5]), cvt_pk(o2_[6], o2_[7])}; } \
            *(LAS u32x4*)d_ = pa_[S_]; *(LAS u32x4*)(d_ + 32) = pb_[S_]; } \
        else { LAS bf16_t* d_ = Vs + (bufi) * 4608 + (16 * q4) * 72 + srow; \
            _Pragma("unroll") for (int j = 0; j < 8; ++j) { d_[j * 72] = hw(pa_[S_], j); d_[(8 + j) * 72] = hw(pb_[S_], j); } } } while (0)
    volatile LAS int* vote = (volatile LAS int*)(F.lds + MISC_OFF + 16);
    __syncthreads();
    if (F.tid < 3) vote[F.tid] = 0;
    AT_FETCH(kt_top, 0); AT_STORE(0, 0);
    if (kt_top > kt_lo) AT_FETCH(kt_top - 1, 1);
    __syncthreads();
    int buf = 0, slot = 0;
    auto trip = [&](const int kt, auto fs_tag) -> bool {
        constexpr int FS_ = decltype(fs_tag)::value;
        const bool mine = !fin && kt <= ktw && kt >= ktl;
        if (mine && F.lane == 0) vote[slot] = 1;
        __syncthreads();
        const int any = vote[slot];
        if (F.tid == 0) vote[slot == 0 ? 2 : slot - 1] = 0;
        slot = slot == 2 ? 0 : slot + 1;
        if (any == 0 && kt < ((SWA ? (q0b + 31) : (q0b + 30)) >> 6)) return false;
        if (kt - 2 >= kt_lo) AT_FETCH(kt - 2, FS_);
        if (mine) {
            const LAS bf16_t* Kb = Ks + buf * 4608; const LAS bf16_t* Vb = Vs + buf * 4608;
            f32x16 st[2];
#pragma unroll
            for (int kb = 0; kb < 2; ++kb) { f32x16 a;
#pragma unroll
                for (int i = 0; i < 16; ++i) a[i] = 0.f;
#pragma unroll
                for (int s = 0; s < 4; ++s) a = __builtin_amdgcn_mfma_f32_32x32x16_bf16(*(const LAS bf16x8*)(Kb + (32 * kb + r) * 72 + 16 * s + 8 * hh), qf[s], a, 0, 0, 0);
                st[kb] = a; }
            if (!SWA) {
                float Rb = R;
#pragma unroll
                for (int kb = 1; kb >= 0; --kb) {
                    float e[16], u[16], p[16];
#pragma unroll
                    for (int i = 0; i < 16; ++i) { const int key = 64 * kt + 32 * kb + (i & 3) + 8 * (i >> 2) + 4 * hh; const float z = fminf(st[kb][i] * 0.18033688011112042f, 30.f); const bool valid = key < t;
                        const float ez = __builtin_amdgcn_exp2f(z); e[i] = valid ? ez : 0.f; u[i] = valid ? 1.f + ez : 1.f; }
                    float gown[4], iq[16];
#pragma unroll
                    for (int g = 0; g < 4; ++g) { const float q32 = u[4 * g + 3] * u[4 * g + 2], q10 = u[4 * g + 1] * u[4 * g]; gown[g] = q32 * q10;
                        const float r0 = __builtin_amdgcn_rcpf(gown[g]);
                        iq[4 * g] = r0; iq[4 * g + 1] = r0 * u[4 * g]; iq[4 * g + 2] = r0 * q10; iq[4 * g + 3] = r0 * q10 * u[4 * g + 2]; }
                    float run = 1.f, ia[4]; const float sc2 = __builtin_amdgcn_exp2f(Rb);
#pragma unroll
                    for (int g = 3; g >= 0; --g) { const float go = other_half(gown[g], hh); ia[g] = sc2 * __builtin_amdgcn_rcpf(run * (hh == 0 ? go : 1.f)); run *= gown[g] * go; }
#pragma unroll
                    for (int i = 0; i < 16; ++i) p[i] = e[i] * (iq[i] * ia[i >> 2]);
                    Rb -= __builtin_amdgcn_logf(run);
#pragma unroll
                    for (int s = 0; s < 2; ++s) { const bf16x8 pf = PACK8(p, 8 * s); const int ko = 32 * kb + 16 * s + 4 * hh;
                        const u32x2 a0 = *(const LAS u32x2*)(Vb + r * 72 + ko), a1 = *(const LAS u32x2*)(Vb + r * 72 + ko + 8), c0 = *(const LAS u32x2*)(Vb + (32 + r) * 72 + ko), c1 = *(const LAS u32x2*)(Vb + (32 + r) * 72 + ko + 8);
                        o0 = __builtin_amdgcn_mfma_f32_32x32x16_bf16(__builtin_bit_cast(bf16x8, (u32x4){a0.x, a0.y, a1.x, a1.y}), pf, o0, 0, 0, 0);
                        o1 = __builtin_amdgcn_mfma_f32_32x32x16_bf16(__builtin_bit_cast(bf16x8, (u32x4){c0.x, c0.y, c1.x, c1.y}), pf, o1, 0, 0, 0); }
                }
                R = Rb;
                fin = __all(R < -115.5f) != 0;
            } else {
                float sv[32]; float tmax = -INFINITY;
#pragma unroll
                for (int kb = 0; kb < 2; ++kb)
#pragma unroll
                    for (int i = 0; i < 16; ++i) { const int key = 64 * kt + 32 * kb + (i & 3) + 8 * (i >> 2) + 4 * hh; const bool valid = (key <= t) && (key + 127 >= t);
                        sv[kb * 16 + i] = valid ? st[kb][i] : -INFINITY; tmax = fmaxf(tmax, sv[kb * 16 + i]); }
                tmax = fmaxf(tmax, other_half(tmax, hh));
                const float mn = fmaxf(m, tmax), sc = __builtin_amdgcn_exp2f(m - mn);
                float psum = 0.f;
#pragma unroll
                for (int i = 0; i < 32; ++i) { sv[i] = __builtin_amdgcn_exp2f(sv[i] - mn); psum += sv[i]; }
                psum += other_half(psum, hh);
                lsum = lsum * sc + psum; m = mn;
#pragma unroll
                for (int i = 0; i < 16; ++i) { o0[i] *= sc; o1[i] *= sc; }
#pragma unroll
                for (int kb = 0; kb < 2; ++kb)
#pragma unroll
                    for (int s = 0; s < 2; ++s) { const bf16x8 pf = PACK8(sv, kb * 16 + 8 * s); const int ko = 32 * kb + 16 * s + 4 * hh;
                        const u32x2 a0 = *(const LAS u32x2*)(Vb + r * 72 + ko), a1 = *(const LAS u32x2*)(Vb + r * 72 + ko + 8), c0 = *(const LAS u32x2*)(Vb + (32 + r) * 72 + ko), c1 = *(const LAS u32x2*)(Vb + (32 + r) * 72 + ko + 8);
                        o0 = __builtin_amdgcn_mfma_f32_32x32x16_bf16(__builtin_bit_cast(bf16x8, (u32x4){a0.x, a0.y, a1.x, a1.y}), pf, o0, 0, 0, 0);
                        o1 = __builtin_amdgcn_mfma_f32_32x32x16_bf16(__builtin_bit_cast(bf16x8, (u32x4){c0.x, c0.y, c1.x, c1.y}), pf, o1, 0, 0, 0); }
            }
        }
        buf ^= 1;
        if (kt > kt_lo) AT_STORE(buf, 1 - FS_);
        return true;
    };
    for (int kt = kt_top; kt >= kt_lo; kt -= 2) {
        if (!trip(kt, IC<0>{})) break;
        if (kt - 1 < kt_lo) break;
        if (!trip(kt - 1, IC<1>{})) break;
    }
    if (SWA) { const float inv = 1.f / lsum;
#pragma unroll
        for (int i = 0; i < 16; ++i) { o0[i] *= inv; o1[i] *= inv; } }
    float ss = 0.f;
#pragma unroll
    for (int i = 0; i < 16; ++i) ss += o0[i] * o0[i] + o1[i] * o1[i];
    ss += other_half(ss, hh);
    const float rstd = rsqrtf(ss * (1.f / 64.f) + NORM_EPS);
    store_ot(MIX + (rowb + t) * DM + (SWA ? 0 : 512) + h * 64, o0, o1, rstd, INF(F, SWA ? I_SWA_ON : I_SB_ON) + l * 256 + h * 64, hh);
#undef AT_FETCH
#undef AT_STORE
}
__device__ __forceinline__ void rwkv_convert_small(Frame& F, int l) {
    bf16_t* W2T = (bf16_t*)(F.ws + WS_SMALLW); bf16_t* A2T = W2T + 256 * 64; bf16_t* G2T = A2T + 256 * 64;
    const float* w2 = INF(F, I_W2) + l * 64 * 256; const float* a2 = INF(F, I_A2) + l * 64 * 256; const float* g2 = INF(F, I_G2) + l * 128 * 256;
    for (int idx = F.bid * 512 + F.tid; idx < 256 * 64; idx += F.G * 512) { const int c = idx >> 6, i = idx & 63; W2T[idx] = f2bf(w2[i * 256 + c]); A2T[idx] = f2bf(a2[i * 256 + c]); }
    for (int idx = F.bid * 512 + F.tid; idx < 256 * 128; idx += F.G * 512) { const int c = idx >> 7, i = idx & 127; G2T[idx] = f2bf(g2[i * 256 + c]); }
}
__device__ __forceinline__ float tanh_f(float x) { return 1.f - 2.f * __builtin_amdgcn_rcpf(__expf(2.f * x) + 1.f); }
constexpr int LP = 72, LPG = 136;
template <int PITCH, int KS>
__device__ __forceinline__ void mm64p(f32x4 (&acc)[2], const LAS bf16_t* A, const LAS bf16_t* B, int mt, int nt0, int lane) {
    const int r16 = lane & 15, kq = lane >> 4;
#pragma unroll
    for (int s = 0; s < KS; ++s) {
        const bf16x8 a = *(const LAS bf16x8*)(A + (16 * mt + r16) * PITCH + 32 * s + 8 * kq);
#pragma unroll
        for (int j = 0; j < 2; ++j) { const bf16x8 b = *(const LAS bf16x8*)(B + (16 * (nt0 + j) + r16) * PITCH + 32 * s + 8 * kq);
            acc[j] = __builtin_amdgcn_mfma_f32_16x16x32_bf16(a, b, acc[j], 0, 0, 0); }
    }
}
__device__ __forceinline__ void mm64(f32x4 (&acc)[2], const LAS bf16_t* A, const LAS bf16_t* B, int mt, int nt0, int lane) { mm64p<LP, 2>(acc, A, B, mt, nt0, lane); }
__device__ __forceinline__ float quad_sum(float v) { v = dpp_add<0xB1>(v); v = dpp_add<0x4E>(v); return v; }
template <int CTRL> __device__ __forceinline__ float quad_bcast(float v) { return __builtin_bit_cast(float, __builtin_amdgcn_update_dpp(0, __builtin_bit_cast(int, v), CTRL, 0xf, 0xf, false)); }
__device__ __forceinline__ float oct_sum(float v) { v = dpp_add<0xB1>(v); v = dpp_add<0x4E>(v); v = dpp_add<0x141>(v); return v; }
__device__ __forceinline__ bf16_t* rw_mat(Frame& F, int unit, int q) { return (bf16_t*)(F.ws + WS_RWM) + (size_t)unit * 16384 + q * 4096; }
__device__ __forceinline__ void rw_lerp8(float (&x)[8], const bf16_t* pc, bool hasprev, const float* mu, int col) {
    const u32x4 c = *(const u32x4*)(pc + col); u32x4 p = (u32x4){0u, 0u, 0u, 0u}; if (hasprev) p = *(const u32x4*)(pc - NPROJ + col);
    const f32x4 m0 = *(const f32x4*)(mu + col), m1 = *(const f32x4*)(mu + col + 4);
    x[0] = bflo(c.x) + (bflo(p.x) - bflo(c.x)) * m0[0]; x[1] = bfhi(c.x) + (bfhi(p.x) - bfhi(c.x)) * m0[1]; x[2] = bflo(c.y) + (bflo(p.y) - bflo(c.y)) * m0[2]; x[3] = bfhi(c.y) + (bfhi(p.y) - bfhi(c.y)) * m0[3];
    x[4] = bflo(c.z) + (bflo(p.z) - bflo(c.z)) * m1[0]; x[5] = bfhi(c.z) + (bfhi(p.z) - bfhi(c.z)) * m1[1]; x[6] = bflo(c.w) + (bflo(p.w) - bflo(c.w)) * m1[2]; x[7] = bfhi(c.w) + (bfhi(p.w) - bfhi(c.w)) * m1[3];
}
struct RwRaw { u32x4 c[7], p[7]; };
__device__ __forceinline__ void rw_load_raw(Frame& F, RwRaw& raw, int unit) {
    const int n = unit & 63, h = (unit >> 6) & 3, b = unit >> 8, tokc = b * SEQ + n * 64 + (F.tid >> 3), k0 = (F.tid & 7) * 8; const bool hasprev = (tokc & (SEQ - 1)) != 0;
    const bf16_t* pc = (const bf16_t*)(F.ws + WS_PROJ) + (size_t)tokc * NPROJ + PD + k0;
    const int col[7] = {768, 832, 896, 960, h * 64, 256 + h * 64, 512 + h * 64};
#pragma unroll
    for (int g = 0; g < 7; ++g) { raw.c[g] = *(const u32x4*)(pc + col[g]); raw.p[g] = (u32x4){0u, 0u, 0u, 0u}; if (hasprev) raw.p[g] = *(const u32x4*)(pc - NPROJ + col[g]); }
}
__device__ __forceinline__ void rw_lerp8r(float (&x)[8], const u32x4 c, const u32x4 p, const LAS float* mu, int col) {
    const f32x4 m0 = *(const LAS f32x4*)(mu + col), m1 = *(const LAS f32x4*)(mu + col + 4);
    x[0] = bflo(c.x) + (bflo(p.x) - bflo(c.x)) * m0[0]; x[1] = bfhi(c.x) + (bfhi(p.x) - bfhi(c.x)) * m0[1]; x[2] = bflo(c.y) + (bflo(p.y) - bflo(c.y)) * m0[2]; x[3] = bfhi(c.y) + (bfhi(p.y) - bfhi(c.y)) * m0[3];
    x[4] = bflo(c.z) + (bflo(p.z) - bflo(c.z)) * m1[0]; x[5] = bfhi(c.z) + (bfhi(p.z) - bfhi(c.z)) * m1[1]; x[6] = bflo(c.w) + (bflo(p.w) - bflo(c.w)) * m1[2]; x[7] = bfhi(c.w) + (bfhi(p.w) - bfhi(c.w)) * m1[3];
}
__device__ __forceinline__ u32x4 pack8v(const float (&x)[8]) { u32x4 w; w.x = cvt_pk(x[0], x[1]); w.y = cvt_pk(x[2], x[3]); w.z = cvt_pk(x[4], x[5]); w.w = cvt_pk(x[6], x[7]); return w; }

constexpr int R1_TAB = 125440;
__device__ __forceinline__ void rwkv_r1_tables(Frame& F, int l) {
    LAS float* T = (LAS float*)(F.lds + R1_TAB);
    const float* mu = INF(F, I_MU) + l * 1024; const float* w0 = INF(F, I_W0) + l * 256; const float* a0 = INF(F, I_A0) + l * 256; const float* kk = INF(F, I_KK) + l * 256; const float* ka = INF(F, I_KA) + l * 256; const float* rk = INF(F, I_RK) + l * 256;
    T[F.tid] = mu[F.tid]; T[512 + F.tid] = mu[512 + F.tid];
    if (F.tid < 256) { T[1024 + F.tid] = w0[F.tid]; T[1280 + F.tid] = a0[F.tid]; T[1536 + F.tid] = kk[F.tid]; T[1792 + F.tid] = ka[F.tid]; T[2048 + F.tid] = rk[F.tid]; }
    __syncthreads();
}
__device__ __forceinline__ void rwkv_r1_unit(Frame& F, int l, int unit, int stop = 0) {
    const int n = unit & 63, h = (unit >> 6) & 3, b = unit >> 8, tok0 = b * SEQ + n * 64;
#define SLOT(i) ((LAS bf16_t*)(F.lds + (i) * 9216))
    LAS float* F0 = (LAS float*)(F.lds + 92160); LAS float* F1 = (LAS float*)(F.lds + 92160 + 16384); LAS float* GC = (LAS float*)(F.lds + 92160 + 32768);
    LAS float* F2 = (LAS float*)F.lds;
    LAS bf16_t* XG = (LAS bf16_t*)(F.lds + 55296); LAS bf16_t* WG2 = (LAS bf16_t*)(F.lds + 72704);
    const int w = F.wave, mt = w & 3, nt0 = (w >> 2) * 2, r16 = F.lane & 15, kq = F.lane >> 4;
    const int t = F.tid >> 3, k0 = (F.tid & 7) * 8;
    const LAS float* TAB = (const LAS float*)(F.lds + R1_TAB); const LAS float* mu = TAB;
    const int tokc = tok0 + t;
    float r8[8], k8[8], v8[8], lw8[8], kk8[8], b8[8];
    RwRaw raw; rw_load_raw(F, raw, unit);
    __syncthreads();
    { float x[8];
      rw_lerp8r(x, raw.c[0], raw.p[0], mu, 768 + k0);
#pragma unroll
      for (int j = 0; j < 8; ++j) x[j] = tanh_f(x[j]);
      *(LAS u32x4*)(SLOT(2) + t * LP + k0) = pack8v(x);
      rw_lerp8r(x, raw.c[1], raw.p[1], mu, 832 + k0); *(LAS u32x4*)(SLOT(3) + t * LP + k0) = pack8v(x);
#pragma unroll
      for (int hf = 0; hf < 2; ++hf) { rw_lerp8r(x, raw.c[2 + hf], raw.p[2 + hf], mu, 896 + 64 * hf + k0);
#pragma unroll
          for (int j = 0; j < 8; ++j) x[j] = sigmoid_f(x[j]);
          *(LAS u32x4*)(XG + t * LPG + 64 * hf + k0) = pack8v(x); }
      const bf16_t* W2T = (const bf16_t*)(F.ws + WS_SMALLW); const bf16_t* A2T = W2T + 256 * 64; const bf16_t* G2T = A2T + 256 * 64;
      *(LAS u32x4*)(SLOT(4) + t * LP + k0) = *(const u32x4*)(W2T + (h * 64 + t) * 64 + k0); *(LAS u32x4*)(SLOT(5) + t * LP + k0) = *(const u32x4*)(A2T + (h * 64 + t) * 64 + k0);
      *(LAS u32x4*)(WG2 + t * LPG + k0) = *(const u32x4*)(G2T + (h * 64 + t) * 128 + k0); *(LAS u32x4*)(WG2 + t * LPG + 64 + k0) = *(const u32x4*)(G2T + (h * 64 + t) * 128 + 64 + k0);
      rw_lerp8r(r8, raw.c[4], raw.p[4], mu, h * 64 + k0); rw_lerp8r(k8, raw.c[5], raw.p[5], mu, 256 + h * 64 + k0); rw_lerp8r(v8, raw.c[6], raw.p[6], mu, 512 + h * 64 + k0); }
    __syncthreads();
    if (stop == 1) return;
    { f32x4 a0[2] = {{0.f, 0.f, 0.f, 0.f}, {0.f, 0.f, 0.f, 0.f}}, a1[2] = {{0.f, 0.f, 0.f, 0.f}, {0.f, 0.f, 0.f, 0.f}}, a2[2] = {{0.f, 0.f, 0.f, 0.f}, {0.f, 0.f, 0.f, 0.f}};
      mm64(a0, SLOT(2), SLOT(4), mt, nt0, F.lane); mm64(a1, SLOT(3), SLOT(5), mt, nt0, F.lane); mm64p<LPG, 4>(a2, XG, WG2, mt, nt0, F.lane);
      __syncthreads();
#pragma unroll
      for (int j = 0; j < 2; ++j)
#pragma unroll
          for (int rg = 0; rg < 4; ++rg) { const int o = (16 * mt + 4 * kq + rg) * 64 + 16 * (nt0 + j) + r16; F0[o] = a0[j][rg]; F1[o] = a1[j][rg]; F2[o] = a2[j][rg]; } }
    __syncthreads();
    if (stop == 2) return;
    { const int col = h * 64 + k0;
      const f32x4 w0a = *(const LAS f32x4*)(TAB + 1024 + col), w0b = *(const LAS f32x4*)(TAB + 1024 + col + 4), a0a = *(const LAS f32x4*)(TAB + 1280 + col), a0b = *(const LAS f32x4*)(TAB + 1280 + col + 4);
      const f32x4 kka = *(const LAS f32x4*)(TAB + 1536 + col), kkb = *(const LAS f32x4*)(TAB + 1536 + col + 4), kaa = *(const LAS f32x4*)(TAB + 1792 + col), kab = *(const LAS f32x4*)(TAB + 1792 + col + 4);
      const f32x4 rka = *(const LAS f32x4*)(TAB + 2048 + col), rkb = *(const LAS f32x4*)(TAB + 2048 + col + 4);
      const f32x4 p0a = *(const LAS f32x4*)(F0 + t * 64 + k0), p0b = *(const LAS f32x4*)(F0 + t * 64 + k0 + 4), p1a = *(const LAS f32x4*)(F1 + t * 64 + k0), p1b = *(const LAS f32x4*)(F1 + t * 64 + k0 + 4);
      const f32x4 p2a = *(const LAS f32x4*)(F2 + t * 64 + k0), p2b = *(const LAS f32x4*)(F2 + t * 64 + k0 + 4);
      float g8[8], ssq = 0.f, srkr = 0.f;
#pragma unroll
      for (int j = 0; j < 8; ++j) { const float w0 = j < 4 ? w0a[j & 3] : w0b[j & 3], a0 = j < 4 ? a0a[j & 3] : a0b[j & 3], k_k = j < 4 ? kka[j & 3] : kkb[j & 3], k_a = j < 4 ? kaa[j & 3] : kab[j & 3], r_k = j < 4 ? rka[j & 3] : rkb[j & 3];
          const float pw = j < 4 ? p0a[j & 3] : p0b[j & 3], pa = j < 4 ? p1a[j & 3] : p1b[j & 3]; g8[j] = j < 4 ? p2a[j & 3] : p2b[j & 3];
          const float a = sigmoid_f(a0 + pa); lw8[j] = bf2f(f2bf(-0.6065306597126334f * sigmoid_f(w0 + pw)));
          kk8[j] = k8[j] * k_k; const float km = k8[j] * (1.f + (a - 1.f) * k_a); b8[j] = kk8[j] * a; k8[j] = km;
          ssq += kk8[j] * kk8[j]; srkr += r8[j] * km * r_k; }
      ssq = oct_sum(ssq); srkr = oct_sum(srkr);
      const float rs = rsqrtf(ssq + 1e-12f);
#pragma unroll
      for (int j = 0; j < 8; ++j) { kk8[j] *= rs; b8[j] *= rs; }
      *(u32x4*)((bf16_t*)(F.ws + WS_RW_V) + (size_t)tokc * 256 + col) = pack8v(v8); *(u32x4*)((bf16_t*)(F.ws + WS_RW_G) + (size_t)tokc * 256 + col) = pack8v(g8);
      if ((F.tid & 7) == 0) ((float*)(F.ws + WS_RKR))[(size_t)tokc * 4 + h] = srkr; }
    __syncthreads();
    if (stop == 3) return;
#pragma unroll
    for (int j = 0; j < 8; ++j) { SLOT(0)[(k0 + j) * LP + t] = f2bf(lw8[j]); SLOT(1)[t * LP + k0 + j] = (k0 + j <= t) ? (bf16_t)0x3F80 : (bf16_t)0; }
    __syncthreads();
    { f32x4 acc[2] = {{0.f, 0.f, 0.f, 0.f}, {0.f, 0.f, 0.f, 0.f}}; mm64(acc, SLOT(1), SLOT(0), mt, nt0, F.lane);
#pragma unroll
      for (int j = 0; j < 2; ++j)
#pragma unroll
          for (int rg = 0; rg < 4; ++rg) F0[(16 * mt + 4 * kq + rg) * 64 + 16 * (nt0 + j) + r16] = acc[j][rg]; }
    __syncthreads();
    { const f32x4 c0 = *(const LAS f32x4*)(F0 + t * 64 + k0), c1 = *(const LAS f32x4*)(F0 + t * 64 + k0 + 4);
      const float cum[8] = {c0[0], c0[1], c0[2], c0[3], c1[0], c1[1], c1[2], c1[3]};
      float ka[8], bt[8], kt[8], rt[8];
#pragma unroll
      for (int j = 0; j < 8; ++j) { const float epos = __expf(cum[j]), eneg = __expf(-cum[j]), eprev = __expf(cum[j] - lw8[j]);
          ka[j] = kk8[j] * eprev; bt[j] = b8[j] * eneg; kt[j] = k8[j] * eneg; rt[j] = r8[j] * epos;
          if (t == 63) GC[k0 + j] = epos; }
      const u32x4 pka = pack8v(ka), pb = pack8v(bt), pq = pack8v(kt), prr = pack8v(rt), pv = pack8v(v8);
      *(LAS u32x4*)(SLOT(0) + t * LP + k0) = pka; *(LAS u32x4*)(SLOT(1) + t * LP + k0) = pb; *(LAS u32x4*)(SLOT(2) + t * LP + k0) = pq; *(LAS u32x4*)(SLOT(3) + t * LP + k0) = prr;
#pragma unroll
      for (int j = 0; j < 8; ++j) { SLOT(4)[(k0 + j) * LP + t] = hw(pb, j); SLOT(5)[(k0 + j) * LP + t] = hw(pq, j); SLOT(6)[(k0 + j) * LP + t] = hw(pv, j); } }
    __syncthreads();
    if (stop == 4) return;
    { f32x4 aLb[2] = {{0.f, 0.f, 0.f, 0.f}, {0.f, 0.f, 0.f, 0.f}}, aLk[2] = {{0.f, 0.f, 0.f, 0.f}, {0.f, 0.f, 0.f, 0.f}}, aMb[2] = {{0.f, 0.f, 0.f, 0.f}, {0.f, 0.f, 0.f, 0.f}}, aMk[2] = {{0.f, 0.f, 0.f, 0.f}, {0.f, 0.f, 0.f, 0.f}};
      mm64(aLb, SLOT(0), SLOT(1), mt, nt0, F.lane); mm64(aLk, SLOT(0), SLOT(2), mt, nt0, F.lane); mm64(aMb, SLOT(3), SLOT(1), mt, nt0, F.lane); mm64(aMk, SLOT(3), SLOT(2), mt, nt0, F.lane);
#pragma unroll
      for (int j = 0; j < 2; ++j)
#pragma unroll
          for (int rg = 0; rg < 4; ++rg) { const int tt = 16 * mt + 4 * kq + rg, ii = 16 * (nt0 + j) + r16;
              F0[tt * 64 + (ii & 3) * 16 + (ii >> 2)] = (ii < tt) ? aLb[j][rg] : 0.f;
              SLOT(7)[tt * LP + ii] = f2bf((ii < tt) ? aLk[j][rg] : 0.f); SLOT(8)[tt * LP + ii] = f2bf((ii <= tt) ? aMb[j][rg] : 0.f); SLOT(9)[tt * LP + ii] = f2bf((ii <= tt) ? aMk[j][rg] : 0.f); } }
    __syncthreads();
    if (stop == 5) return;
    { f32x4 acc[2] = {{0.f, 0.f, 0.f, 0.f}, {0.f, 0.f, 0.f, 0.f}}; mm64(acc, SLOT(7), SLOT(6), mt, nt0, F.lane);
#pragma unroll
      for (int j = 0; j < 2; ++j)
#pragma unroll
          for (int rg = 0; rg < 4; ++rg) F1[(16 * mt + 4 * kq + rg) * 64 + 16 * (nt0 + j) + r16] = acc[j][rg]; }
    __syncthreads();
    if (stop == 6) return;
    { const int col = F.tid >> 2, jq = F.tid & 3; float x[16], rhs[16];
#pragma unroll
      for (int m = 0; m < 16; ++m) { x[m] = 0.f; rhs[m] = (col < 64) ? bf2f(SLOT(0)[(4 * m + jq) * LP + col]) : F1[(4 * m + jq) * 64 + (col - 64)]; }
#pragma unroll
      for (int m = 0; m < 16; ++m) { float pa[4] = {0.f, 0.f, 0.f, 0.f};
#pragma unroll
          for (int a = 0; a < 4; ++a)
#pragma unroll
              for (int m4 = 0; 4 * m4 < m; ++m4) { const f32x4 lq = *(const LAS f32x4*)(F0 + (4 * m + a) * 64 + jq * 16 + 4 * m4);
#pragma unroll
                  for (int e = 0; e < 4; ++e) if (4 * m4 + e < m) pa[a] += lq[e] * x[4 * m4 + e]; }
          const float t0 = quad_sum(pa[0]), t1 = quad_sum(pa[1]), t2 = quad_sum(pa[2]), t3 = quad_sum(pa[3]);
          const LAS float* lrow = F0 + (4 * m + jq) * 64 + m;
          const float c0 = lrow[0], c1 = lrow[16], c2 = lrow[32];
          float y = rhs[m] - (jq == 0 ? t0 : (jq == 1 ? t1 : (jq == 2 ? t2 : t3)));
          y -= c0 * quad_bcast<0x00>(y); y -= c1 * quad_bcast<0x55>(y); y -= c2 * quad_bcast<0xAA>(y);
          x[m] = y; }
      LAS bf16_t* dst = (col < 64) ? (SLOT(7) + col * LP) : (SLOT(1) + (col - 64) * LP);
#pragma unroll
      for (int m = 0; m < 16; ++m) dst[4 * m + jq] = f2bf(-x[m]); }
    __syncthreads();
    if (stop == 7) return;
    { f32x4 aG[2] = {{0.f, 0.f, 0.f, 0.f}, {0.f, 0.f, 0.f, 0.f}}, aH[2] = {{0.f, 0.f, 0.f, 0.f}, {0.f, 0.f, 0.f, 0.f}}, aR[2] = {{0.f, 0.f, 0.f, 0.f}, {0.f, 0.f, 0.f, 0.f}}, aY[2] = {{0.f, 0.f, 0.f, 0.f}, {0.f, 0.f, 0.f, 0.f}};
      mm64(aG, SLOT(7), SLOT(4), mt, nt0, F.lane);
      mm64(aH, SLOT(5), SLOT(6), mt, nt0, F.lane); mm64(aH, SLOT(4), SLOT(1), mt, nt0, F.lane);
      mm64(aR, SLOT(7), SLOT(8), mt, nt0, F.lane);
      mm64(aY, SLOT(9), SLOT(6), mt, nt0, F.lane); mm64(aY, SLOT(8), SLOT(1), mt, nt0, F.lane);
      bf16_t* MG = rw_mat(F, unit, 0); bf16_t* MR = rw_mat(F, unit, 1); bf16_t* MH = rw_mat(F, unit, 2); bf16_t* MY = rw_mat(F, unit, 3);
#pragma unroll
      for (int j = 0; j < 2; ++j) { const int cc = 16 * (nt0 + j) + r16, r0 = 16 * mt + 4 * kq;
          const float gcc = GC[cc]; const u32x2 rtw = *(const LAS u32x2*)(SLOT(3) + cc * LP + r0);
          float gv[4], hv[4], rv[4], yv[4];
#pragma unroll
          for (int rg = 0; rg < 4; ++rg) { gv[rg] = gcc * ((r0 + rg == cc ? 1.f : 0.f) + aG[j][rg]); hv[rg] = GC[r0 + rg] * aH[j][rg]; yv[rg] = aY[j][rg] * 1.0f; }
          rv[0] = bflo(rtw.x) + aR[j][0]; rv[1] = bfhi(rtw.x) + aR[j][1]; rv[2] = bflo(rtw.y) + aR[j][2]; rv[3] = bfhi(rtw.y) + aR[j][3];
          u32x2 o; o.x = pg8::cvt_pk_c(gv[0], gv[1]); o.y = pg8::cvt_pk_c(gv[2], gv[3]); *(u32x2*)(MG + cc * 64 + r0) = o;
          o.x = pg8::cvt_pk_c(rv[0], rv[1]); o.y = pg8::cvt_pk_c(rv[2], rv[3]); *(u32x2*)(MR + cc * 64 + r0) = o;
          o.x = pg8::cvt_pk_c(hv[0], hv[1]); o.y = pg8::cvt_pk_c(hv[2], hv[3]); *(u32x2*)(MH + cc * 64 + r0) = o;
          o.x = pg8::cvt_pk_c(yv[0], yv[1]); o.y = pg8::cvt_pk_c(yv[2], yv[3]); *(u32x2*)(MY + cc * 64 + r0) = o; } }
#undef SLOT
}

__device__ __forceinline__ void rwkv_r2_block(Frame& F, int bh) {
    LAS bf16_t* Sx = (LAS bf16_t*)F.lds; LAS bf16_t* Gs = (LAS bf16_t*)(F.lds + 9216);
    bf16_t* SG = (bf16_t*)(F.ws + WS_RW_S);
    const int w = F.wave, mt = w & 3, nt0 = (w >> 2) * 2, r16 = F.lane & 15, kq = F.lane >> 4;
    const int grow = F.tid >> 3, gc0 = (F.tid & 7) * 8;
    f32x4 st[2] = {{0.f, 0.f, 0.f, 0.f}, {0.f, 0.f, 0.f, 0.f}};
    constexpr int PF = 4;
    u32x4 gq[PF]; u32x2 hq[PF][2];
#define R2_FETCH(slot, n_) do { const int u_ = bh * 64 + (n_); gq[slot] = *(const u32x4*)(rw_mat(F, u_, 0) + grow * 64 + gc0); \
        _Pragma("unroll") for (int j_ = 0; j_ < 2; ++j_) hq[slot][j_] = *(const u32x2*)(rw_mat(F, u_, 2) + (16 * (nt0 + j_) + r16) * 64 + 16 * mt + 4 * kq); } while (0)
#pragma unroll
    for (int i = 0; i < PF; ++i) R2_FETCH(i, i);
    __syncthreads();
    for (int n0 = 0; n0 < 64; n0 += PF) {
#pragma unroll
        for (int i = 0; i < PF; ++i) { const int n = n0 + i; const int unit = bh * 64 + n;
#pragma unroll
            for (int j = 0; j < 2; ++j) { u32x2 ps; ps.x = pg8::cvt_pk_c(st[j][0], st[j][1]); ps.y = pg8::cvt_pk_c(st[j][2], st[j][3]);
                const int vv = 16 * (nt0 + j) + r16, kk0 = 16 * mt + 4 * kq;
                *(LAS u32x2*)(Sx + vv * LP + kk0) = ps; *(u32x2*)(SG + (size_t)unit * 4096 + vv * 64 + kk0) = ps; }
            *(LAS u32x4*)(Gs + grow * LP + gc0) = gq[i];
            f32x4 acc[2];
#pragma unroll
            for (int j = 0; j < 2; ++j) { acc[j][0] = bflo(hq[i][j].x); acc[j][1] = bfhi(hq[i][j].x); acc[j][2] = bflo(hq[i][j].y); acc[j][3] = bfhi(hq[i][j].y); }
            if (n + PF < 64) R2_FETCH(i, n + PF);
            __syncthreads();
            mm64(acc, Gs, Sx, mt, nt0, F.lane);
            st[0] = acc[0]; st[1] = acc[1];
            __syncthreads();
        }
    }
#undef R2_FETCH
}

__device__ __forceinline__ void rwkv_r3_task(Frame& F, int l, int unit) {
    const int n = unit & 63, h = (unit >> 6) & 3, b = unit >> 8, tok0 = b * SEQ + n * 64;
    const int r16 = F.lane & 15, kq = F.lane >> 4;
    const bf16_t* SG = (const bf16_t*)(F.ws + WS_RW_S) + (size_t)unit * 4096;
    const bf16_t* MR = rw_mat(F, unit, 1); const bf16_t* MY = rw_mat(F, unit, 3);
    bf16x8 sb[4][2];
#pragma unroll
    for (int nt = 0; nt < 4; ++nt)
#pragma unroll
        for (int s = 0; s < 2; ++s) sb[nt][s] = *(const bf16x8*)(SG + (16 * nt + r16) * 64 + 32 * s + 8 * kq);
    const float* lnw = INF(F, I_LNW) + l * 256 + h * 64; const float* lnb = INF(F, I_LNB) + l * 256 + h * 64;
    float lw4[4], lb4[4];
#pragma unroll
    for (int nt = 0; nt < 4; ++nt) { lw4[nt] = lnw[16 * nt + r16]; lb4[nt] = lnb[16 * nt + r16]; }
    const bf16_t* SV = (const bf16_t*)(F.ws + WS_RW_V); const bf16_t* SGt = (const bf16_t*)(F.ws + WS_RW_G); const float* RKR = (const float*)(F.ws + WS_RKR);
    bf16_t* MIX = (bf16_t*)(F.ws + WS_MIX);
#pragma unroll 1
    for (int mt = 0; mt < 4; ++mt) {
        f32x4 acc[4];
#pragma unroll
        for (int nt = 0; nt < 4; ++nt) { const u32x2 y0 = *(const u32x2*)(MY + (16 * nt + r16) * 64 + 16 * mt + 4 * kq); acc[nt][0] = bflo(y0.x); acc[nt][1] = bfhi(y0.x); acc[nt][2] = bflo(y0.y); acc[nt][3] = bfhi(y0.y); }
#pragma unroll
        for (int s = 0; s < 2; ++s) { const bf16x8 a = *(const bf16x8*)(MR + (16 * mt + r16) * 64 + 32 * s + 8 * kq);
#pragma unroll
            for (int nt = 0; nt < 4; ++nt) acc[nt] = __builtin_amdgcn_mfma_f32_16x16x32_bf16(a, sb[nt][s], acc[nt], 0, 0, 0); }
#pragma unroll
        for (int rg = 0; rg < 4; ++rg) { const int tok = tok0 + 16 * mt + 4 * kq + rg;
            const float mean = sum16((acc[0][rg] + acc[1][rg]) + (acc[2][rg] + acc[3][rg])) * (1.f / 64.f);
            float d[4], q = 0.f;
#pragma unroll
            for (int nt = 0; nt < 4; ++nt) { d[nt] = acc[nt][rg] - mean; q += d[nt] * d[nt]; }
            const float rstd = rsqrtf(sum16(q) * (1.f / 64.f) + 64e-5f);
            const float rkr = RKR[(size_t)tok * 4 + h];
#pragma unroll
            for (int nt = 0; nt < 4; ++nt) { const int col = h * 64 + 16 * nt + r16;
                const float vv = bf2f(SV[(size_t)tok * 256 + col]), gg = bf2f(SGt[(size_t)tok * 256 + col]);
                MIX[(size_t)tok * DM + 768 + col] = f2bf((d[nt] * rstd * lw4[nt] + lb4[nt] + rkr * vv) * gg); } }
    }
}
template <int PITCH, int KS>
__device__ __forceinline__ void mm_tile(f32x4& acc, const LAS bf16_t* A, const LAS bf16_t* B, int mt, int nt, int lane) {
    const int r16 = lane & 15, kq = lane >> 4;
#pragma unroll
    for (int s = 0; s < KS; ++s)
        acc = __builtin_amdgcn_mfma_f32_16x16x32_bf16(*(const LAS bf16x8*)(A + (16 * mt + r16) * PITCH + 32 * s + 8 * kq), *(const LAS bf16x8*)(B + (16 * nt + r16) * PITCH + 32 * s + 8 * kq), acc, 0, 0, 0);
}
constexpr int GP = 40;
__device__ __forceinline__ void gla_cum(Frame& F, int l, int h, int tok0, LAS bf16_t* LAhi, LAS bf16_t* LAlo, LAS float* Fc) {
    const bf16_t* P = (const bf16_t*)(F.ws + WS_PROJ);
    const float* wa2 = INF(F, I_GLA_WA2) + l * 16 * 128 + h * 32; const float* ba = INF(F, I_GLA_BA) + l * 128 + h * 32;
    const int t = F.tid >> 3, e4 = (F.tid & 7) * 4;
    { const u32x4 l0 = *(const u32x4*)(P + (size_t)(tok0 + t) * NPROJ + PB_LR), l1 = *(const u32x4*)(P + (size_t)(tok0 + t) * NPROJ + PB_LR + 8);
      const float lr[16] = {bflo(l0.x), bfhi(l0.x), bflo(l0.y), bfhi(l0.y), bflo(l0.z), bfhi(l0.z), bflo(l0.w), bfhi(l0.w), bflo(l1.x), bfhi(l1.x), bflo(l1.y), bfhi(l1.y), bflo(l1.z), bfhi(l1.z), bflo(l1.w), bfhi(l1.w)};
      f32x4 a = *(const f32x4*)(ba + e4);
#pragma unroll
      for (int r = 0; r < 16; ++r) a += lr[r] * *(const f32x4*)(wa2 + r * 128 + e4);
#pragma unroll
      for (int j = 0; j < 4; ++j) { const float la = logsigmoid_f(a[j]) * (1.f / 16.f); const bf16_t hi = f2bf(la); const bf16_t lo = f2bf(la - bf2f(hi));
          LAhi[(e4 + j) * LP + t] = hi; LAlo[(e4 + j) * LP + t] = lo; } }
    __syncthreads();
    { const int w = F.wave, mt = w & 3, nt = w >> 2, r16 = F.lane & 15, kq = F.lane >> 4; f32x4 acc = {0.f, 0.f, 0.f, 0.f};
#pragma unroll
      for (int s = 0; s < 2; ++s) { bf16x8 tri;
#pragma unroll
          for (int j = 0; j < 8; ++j) tri[j] = (32 * s + 8 * kq + j <= 16 * mt + r16) ? (short)0x3F80 : (short)0;
          acc = __builtin_amdgcn_mfma_f32_16x16x32_bf16(tri, *(const LAS bf16x8*)(LAhi + (16 * nt + r16) * LP + 32 * s + 8 * kq), acc, 0, 0, 0);
          acc = __builtin_amdgcn_mfma_f32_16x16x32_bf16(tri, *(const LAS bf16x8*)(LAlo + (16 * nt + r16) * LP + 32 * s + 8 * kq), acc, 0, 0, 0); }
#pragma unroll
      for (int rg = 0; rg < 4; ++rg) Fc[(16 * mt + 4 * kq + rg) * 32 + 16 * nt + r16] = acc[rg]; }
    __syncthreads();
}
__device__ __forceinline__ void gla_kv2(Frame& F, int l, int unit) {
    const bf16_t* P = (const bf16_t*)(F.ws + WS_PROJ);
    float* KV = (float*)(F.ws + WS_GLA_KV) + (size_t)unit * 2048; float* DEC = (float*)(F.ws + WS_GLA_DEC) + unit * 32;
    const int n = unit & 63, h = (unit >> 6) & 3, b = unit >> 8, tok0 = b * SEQ + n * 64;
    LAS bf16_t* LAhi = (LAS bf16_t*)F.lds; LAS bf16_t* LAlo = (LAS bf16_t*)(F.lds + 4608); LAS float* Fc = (LAS float*)(F.lds + 9216);
    LAS bf16_t* Ke = (LAS bf16_t*)(F.lds + 17408); LAS bf16_t* Vf = (LAS bf16_t*)(F.lds + 22016);
    const int t = F.tid >> 3, c8 = F.tid & 7;
    __syncthreads();
    gla_cum(F, l, h, tok0, LAhi, LAlo, Fc);
    { const u32x2 kw = *(const u32x2*)(P + (size_t)(tok0 + t) * NPROJ + PB_K + h * 32 + c8 * 4); const u32x4 vw = *(const u32x4*)(P + (size_t)(tok0 + t) * NPROJ + PB_V + h * 64 + c8 * 8);
      const f32x4 ct = *(const LAS f32x4*)(Fc + t * 32 + c8 * 4), cl = *(const LAS f32x4*)(Fc + 63 * 32 + c8 * 4);
      const float kf[4] = {bflo(kw.x), bfhi(kw.x), bflo(kw.y), bfhi(kw.y)};
#pragma unroll
      for (int j = 0; j < 4; ++j) { Ke[(c8 * 4 + j) * LP + t] = f2bf(kf[j] * __expf(cl[j] - ct[j])); if (t == 63) DEC[c8 * 4 + j] = __expf(cl[j]); }
#pragma unroll
      for (int j = 0; j < 8; ++j) Vf[(c8 * 8 + j) * LP + t] = hw(vw, j); }
    __syncthreads();
    { const int w = F.wave, mt = w & 1, nt = w >> 1, r16 = F.lane & 15, kq = F.lane >> 4; f32x4 acc = {0.f, 0.f, 0.f, 0.f};
      mm_tile<LP, 2>(acc, Ke, Vf, mt, nt, F.lane);
#pragma unroll
      for (int rg = 0; rg < 4; ++rg) KV[(16 * mt + 4 * kq + rg) * 64 + 16 * nt + r16] = acc[rg]; }
}
__device__ __forceinline__ void gla_out2(Frame& F, int l, int unit) {
    const bf16_t* P = (const bf16_t*)(F.ws + WS_PROJ); bf16_t* MIX = (bf16_t*)(F.ws + WS_MIX);
    const float* SP = (const float*)(F.ws + WS_GLA_KV) + (size_t)unit * 2048;
    const int n = unit & 63, h = (unit >> 6) & 3, b = unit >> 8, tok0 = b * SEQ + n * 64;
    LAS bf16_t* LAhi = (LAS bf16_t*)F.lds; LAS bf16_t* LAlo = (LAS bf16_t*)(F.lds + 4608); LAS float* Fc = (LAS float*)(F.lds + 9216);
    LAS bf16_t* Qe = (LAS bf16_t*)(F.lds + 17408); LAS bf16_t* Ke = (LAS bf16_t*)(F.lds + 22528); LAS bf16_t* Qb = (LAS bf16_t*)(F.lds + 27648); LAS bf16_t* Sf = (LAS bf16_t*)(F.lds + 32768);
    LAS bf16_t* Vf = (LAS bf16_t*)(F.lds + 37888); LAS bf16_t* At = (LAS bf16_t*)(F.lds + 47104); LAS float* Of = (LAS float*)(F.lds + 56320);
    const int t = F.tid >> 3, c8 = F.tid & 7, w = F.wave, mt = w & 3, nt0 = (w >> 2) * 2, r16 = F.lane & 15, kq = F.lane >> 4;
    __syncthreads();
    gla_cum(F, l, h, tok0, LAhi, LAlo, Fc);
    { const u32x2 qw = *(const u32x2*)(P + (size_t)(tok0 + t) * NPROJ + PB_Q + h * 32 + c8 * 4), kw = *(const u32x2*)(P + (size_t)(tok0 + t) * NPROJ + PB_K + h * 32 + c8 * 4);
      const u32x4 vw = *(const u32x4*)(P + (size_t)(tok0 + t) * NPROJ + PB_V + h * 64 + c8 * 8);
      const f32x4 ct = *(const LAS f32x4*)(Fc + t * 32 + c8 * 4), cr = *(const LAS f32x4*)(Fc + 31 * 32 + c8 * 4);
      const float qs = 0.17677669529663687f;
      const float qf[4] = {bflo(qw.x) * qs, bfhi(qw.x) * qs, bflo(qw.y) * qs, bfhi(qw.y) * qs}, kf[4] = {bflo(kw.x), bfhi(kw.x), bflo(kw.y), bfhi(kw.y)};
      float qe[4], ke[4], qb[4];
#pragma unroll
      for (int j = 0; j < 4; ++j) { qe[j] = qf[j] * __expf(ct[j] - cr[j]); ke[j] = kf[j] * __expf(cr[j] - ct[j]); qb[j] = qf[j] * __expf(ct[j]); }
      u32x2 o; o.x = cvt_pk(qe[0], qe[1]); o.y = cvt_pk(qe[2], qe[3]); *(LAS u32x2*)(Qe + t * GP + c8 * 4) = o;
      o.x = cvt_pk(ke[0], ke[1]); o.y = cvt_pk(ke[2], ke[3]); *(LAS u32x2*)(Ke + t * GP + c8 * 4) = o;
      o.x = cvt_pk(qb[0], qb[1]); o.y = cvt_pk(qb[2], qb[3]); *(LAS u32x2*)(Qb + t * GP + c8 * 4) = o;
#pragma unroll
      for (int j = 0; j < 8; ++j) Vf[(c8 * 8 + j) * LP + t] = hw(vw, j);
      const int e = F.tid >> 4, f4 = (F.tid & 15) * 4; const f32x4 sv = *(const f32x4*)(SP + e * 64 + f4);
#pragma unroll
      for (int j = 0; j < 4; ++j) Sf[(f4 + j) * GP + e] = f2bf(sv[j]); }
    __syncthreads();
    { f32x4 acc[2] = {{0.f, 0.f, 0.f, 0.f}, {0.f, 0.f, 0.f, 0.f}}; mm64p<GP, 1>(acc, Qe, Ke, mt, nt0, F.lane);
#pragma unroll
      for (int j = 0; j < 2; ++j)
#pragma unroll
          for (int rg = 0; rg < 4; ++rg) { const int tt = 16 * mt + 4 * kq + rg, ss = 16 * (nt0 + j) + r16; At[tt * LP + ss] = f2bf(ss <= tt ? acc[j][rg] : 0.f); } }
    __syncthreads();
    { f32x4 acc[2] = {{0.f, 0.f, 0.f, 0.f}, {0.f, 0.f, 0.f, 0.f}}; mm64p<LP, 2>(acc, At, Vf, mt, nt0, F.lane); mm64p<GP, 1>(acc, Qb, Sf, mt, nt0, F.lane);
#pragma unroll
      for (int j = 0; j < 2; ++j)
#pragma unroll
          for (int rg = 0; rg < 4; ++rg) Of[(16 * mt + 4 * kq + rg) * 64 + 16 * (nt0 + j) + r16] = acc[j][rg]; }
    __syncthreads();
    { const int f0 = c8 * 8; const f32x4 o0 = *(const LAS f32x4*)(Of + t * 64 + f0), o1 = *(const LAS f32x4*)(Of + t * 64 + f0 + 4);
      const float o[8] = {o0[0], o0[1], o0[2], o0[3], o1[0], o1[1], o1[2], o1[3]};
      float ss = 0.f;
#pragma unroll
      for (int j = 0; j < 8; ++j) ss += o[j] * o[j];
      ss = oct_sum(ss);
      const float rstd = rsqrtf(ss * (1.f / 64.f) + NORM_EPS); const float* gn = INF(F, I_GLA_ON) + l * 256 + h * 64 + f0;
      const f32x4 g0 = *(const f32x4*)gn, g1 = *(const f32x4*)(gn + 4);
      const u32x4 gw = *(const u32x4*)(P + (size_t)(tok0 + t) * NPROJ + PB_G + h * 64 + f0);
      const float gb[8] = {bflo(gw.x), bfhi(gw.x), bflo(gw.y), bfhi(gw.y), bflo(gw.z), bfhi(gw.z), bflo(gw.w), bfhi(gw.w)};
      float r[8];
#pragma unroll
      for (int j = 0; j < 8; ++j) r[j] = o[j] * rstd * (j < 4 ? g0[j & 3] : g1[j & 3]) * (gb[j] * sigmoid_f(gb[j]));
      *(u32x4*)(MIX + (size_t)(tok0 + t) * DM + 256 + h * 64 + f0) = pack8v(r); }
}

__device__ __forceinline__ void gla_cum_a(Frame& F, int l, int h, int tok0, LAS bf16_t* LAhi, LAS bf16_t* LAlo) {
    const bf16_t* P = (const bf16_t*)(F.ws + WS_PROJ);
    const float* wa2 = INF(F, I_GLA_WA2) + l * 16 * 128 + h * 32; const float* ba = INF(F, I_GLA_BA) + l * 128 + h * 32;
    const int t = F.tid >> 3, e4 = (F.tid & 7) * 4;
    const u32x4 l0 = *(const u32x4*)(P + (size_t)(tok0 + t) * NPROJ + PB_LR), l1 = *(const u32x4*)(P + (size_t)(tok0 + t) * NPROJ + PB_LR + 8);
    const float lr[16] = {bflo(l0.x), bfhi(l0.x), bflo(l0.y), bfhi(l0.y), bflo(l0.z), bfhi(l0.z), bflo(l0.w), bfhi(l0.w), bflo(l1.x), bfhi(l1.x), bflo(l1.y), bfhi(l1.y), bflo(l1.z), bfhi(l1.z), bflo(l1.w), bfhi(l1.w)};
    f32x4 a = *(const f32x4*)(ba + e4);
#pragma unroll
    for (int r = 0; r < 16; ++r) a += lr[r] * *(const f32x4*)(wa2 + r * 128 + e4);
#pragma unroll
    for (int j = 0; j < 4; ++j) { const float la = logsigmoid_f(a[j]) * (1.f / 16.f); const bf16_t hi = f2bf(la); const bf16_t lo = f2bf(la - bf2f(hi));
        LAhi[(e4 + j) * LP + t] = hi; LAlo[(e4 + j) * LP + t] = lo; }
}
struct GlaW2 { bf16x8 whi, wlo; float ba; };
__device__ __forceinline__ void gla_loadw2(Frame& F, int l, int h, GlaW2& W) {
    const int nt = F.wave >> 2, r16 = F.lane & 15, kq = F.lane >> 4, e = 16 * nt + r16;
    const float* wa2 = INF(F, I_GLA_WA2) + l * 16 * 128 + h * 32 + e;
    W.ba = INF(F, I_GLA_BA)[l * 128 + h * 32 + e];
#pragma unroll
    for (int j = 0; j < 8; ++j) { const float wv = (kq < 2) ? wa2[(8 * (kq & 1) + j) * 128] : 0.f; const bf16_t hi = f2bf(wv); W.whi[j] = (short)hi; W.wlo[j] = (short)f2bf(wv - bf2f(hi)); }
}
__device__ __forceinline__ void gla_cum_a2(Frame& F, const GlaW2& W, int tok0, LAS bf16_t* LAhi, LAS bf16_t* LAlo) {
    const bf16_t* P = (const bf16_t*)(F.ws + WS_PROJ);
    const int mt = F.wave & 3, nt = F.wave >> 2, r16 = F.lane & 15, kq = F.lane >> 4;
    u32x4 lw = *(const u32x4*)(P + (size_t)(tok0 + 16 * mt + r16) * NPROJ + PB_LR + 8 * (kq & 1));
    if (kq >= 2) lw = (u32x4){0u, 0u, 0u, 0u};
    f32x4 acc = {0.f, 0.f, 0.f, 0.f};
    acc = __builtin_amdgcn_mfma_f32_16x16x32_bf16(__builtin_bit_cast(bf16x8, lw), W.whi, acc, 0, 0, 0);
    acc = __builtin_amdgcn_mfma_f32_16x16x32_bf16(__builtin_bit_cast(bf16x8, lw), W.wlo, acc, 0, 0, 0);
    float la[4]; bf16_t hi[4], lo[4];
#pragma unroll
    for (int rg = 0; rg < 4; ++rg) { la[rg] = logsigmoid_f(acc[rg] + W.ba) * (1.f / 16.f); hi[rg] = f2bf(la[rg]); lo[rg] = f2bf(la[rg] - bf2f(hi[rg])); }
    const int o = (16 * nt + r16) * LP + 16 * mt + 4 * kq;
    *(LAS u32x2*)(LAhi + o) = (u32x2){(unsigned)hi[0] | ((unsigned)hi[1] << 16), (unsigned)hi[2] | ((unsigned)hi[3] << 16)};
    *(LAS u32x2*)(LAlo + o) = (u32x2){(unsigned)lo[0] | ((unsigned)lo[1] << 16), (unsigned)lo[2] | ((unsigned)lo[3] << 16)};
}
__device__ __forceinline__ void gla_cum_b(Frame& F, const LAS bf16_t* LAhi, const LAS bf16_t* LAlo, LAS float* Fc) {
    const int w = F.wave, mt = w & 3, nt = w >> 2, r16 = F.lane & 15, kq = F.lane >> 4; f32x4 acc = {0.f, 0.f, 0.f, 0.f};
#pragma unroll
    for (int s = 0; s < 2; ++s) { bf16x8 tri;
#pragma unroll
        for (int j = 0; j < 8; ++j) tri[j] = (32 * s + 8 * kq + j <= 16 * mt + r16) ? (short)0x3F80 : (short)0;
        acc = __builtin_amdgcn_mfma_f32_16x16x32_bf16(tri, *(const LAS bf16x8*)(LAhi + (16 * nt + r16) * LP + 32 * s + 8 * kq), acc, 0, 0, 0);
        acc = __builtin_amdgcn_mfma_f32_16x16x32_bf16(tri, *(const LAS bf16x8*)(LAlo + (16 * nt + r16) * LP + 32 * s + 8 * kq), acc, 0, 0, 0); }
#pragma unroll
    for (int rg = 0; rg < 4; ++rg) Fc[(16 * mt + 4 * kq + rg) * 32 + 16 * nt + r16] = acc[rg];
}
constexpr int GKV_U = 31232, GOUT_U = 56320;
__device__ __forceinline__ void gla_kv2_pair(Frame& F, int l, int unit0, const GlaW2& W) {
    const bf16_t* P = (const bf16_t*)(F.ws + WS_PROJ);
    const int n = unit0 & 63, h = (unit0 >> 6) & 3, t = F.tid >> 3, c8 = F.tid & 7;
#define GKV_PTRS(uu) const int unit = unit0 + 256 * (uu), tok0 = (unit >> 8) * SEQ + n * 64; LAS unsigned char* B_ = F.lds + (uu) * GKV_U; \
        LAS bf16_t* LAhi = (LAS bf16_t*)B_; LAS bf16_t* LAlo = (LAS bf16_t*)(B_ + 4608); LAS float* Fc = (LAS float*)(B_ + 9216); LAS bf16_t* Ke = (LAS bf16_t*)(B_ + 17408); LAS bf16_t* Vf = (LAS bf16_t*)(B_ + 22016); \
        (void)unit; (void)tok0; (void)LAhi; (void)LAlo; (void)Fc; (void)Ke; (void)Vf
    __syncthreads();
#pragma unroll
    for (int uu = 0; uu < 2; ++uu) { GKV_PTRS(uu); gla_cum_a2(F, W, tok0, LAhi, LAlo); }
    __syncthreads();
#pragma unroll
    for (int uu = 0; uu < 2; ++uu) { GKV_PTRS(uu); gla_cum_b(F, LAhi, LAlo, Fc); }
    __syncthreads();
#pragma unroll
    for (int uu = 0; uu < 2; ++uu) { GKV_PTRS(uu); float* DEC = (float*)(F.ws + WS_GLA_DEC) + unit * 32;
      const u32x2 kw = *(const u32x2*)(P + (size_t)(tok0 + t) * NPROJ + PB_K + h * 32 + c8 * 4); const u32x4 vw = *(const u32x4*)(P + (size_t)(tok0 + t) * NPROJ + PB_V + h * 64 + c8 * 8);
      const f32x4 ct = *(const LAS f32x4*)(Fc + t * 32 + c8 * 4), cl = *(const LAS f32x4*)(Fc + 63 * 32 + c8 * 4);
      const float kf[4] = {bflo(kw.x), bfhi(kw.x), bflo(kw.y), bfhi(kw.y)};
#pragma unroll
      for (int j = 0; j < 4; ++j) { Ke[(c8 * 4 + j) * LP + t] = f2bf(kf[j] * __expf(cl[j] - ct[j])); if (t == 63) DEC[c8 * 4 + j] = __expf(cl[j]); }
#pragma unroll
      for (int j = 0; j < 8; ++j) Vf[(c8 * 8 + j) * LP + t] = hw(vw, j); }
    __syncthreads();
#pragma unroll
    for (int uu = 0; uu < 2; ++uu) { GKV_PTRS(uu); float* KV = (float*)(F.ws + WS_GLA_KV) + (size_t)unit * 2048;
      const int w = F.wave, mt = w & 1, nt = w >> 1, r16 = F.lane & 15, kq = F.lane >> 4; f32x4 acc = {0.f, 0.f, 0.f, 0.f};
      mm_tile<LP, 2>(acc, Ke, Vf, mt, nt, F.lane);
#pragma unroll
      for (int rg = 0; rg < 4; ++rg) KV[(16 * mt + 4 * kq + rg) * 64 + 16 * nt + r16] = acc[rg]; }
#undef GKV_PTRS
}
__device__ __forceinline__ void gla_out2_pair(Frame& F, int l, int unit0, const GlaW2& W, int stop = 0) {
    const bf16_t* P = (const bf16_t*)(F.ws + WS_PROJ); bf16_t* MIX = (bf16_t*)(F.ws + WS_MIX);
    const int n = unit0 & 63, h = (unit0 >> 6) & 3;
    const int t = F.tid >> 3, c8 = F.tid & 7, w = F.wave, mt = w & 3, nt0 = (w >> 2) * 2, r16 = F.lane & 15, kq = F.lane >> 4;
#define GOUT_PTRS(uu) const int unit = unit0 + 256 * (uu), tok0 = (unit >> 8) * SEQ + n * 64; LAS unsigned char* B_ = F.lds + (uu) * GOUT_U; \
        LAS bf16_t* LAhi = (LAS bf16_t*)B_; LAS bf16_t* LAlo = (LAS bf16_t*)(B_ + 4608); LAS float* Fc = (LAS float*)(B_ + 9216); LAS float* Of = (LAS float*)B_; \
        LAS bf16_t* Qe = (LAS bf16_t*)(B_ + 17408); LAS bf16_t* Ke = (LAS bf16_t*)(B_ + 22528); LAS bf16_t* Qb = (LAS bf16_t*)(B_ + 27648); LAS bf16_t* Sf = (LAS bf16_t*)(B_ + 32768); \
        LAS bf16_t* Vf = (LAS bf16_t*)(B_ + 37888); LAS bf16_t* At = (LAS bf16_t*)(B_ + 47104); \
        (void)unit; (void)tok0; (void)LAhi; (void)LAlo; (void)Fc; (void)Of; (void)Qe; (void)Ke; (void)Qb; (void)Sf; (void)Vf; (void)At
    __syncthreads();
#pragma unroll
    for (int uu = 0; uu < 2; ++uu) { GOUT_PTRS(uu); gla_cum_a2(F, W, tok0, LAhi, LAlo); }
    __syncthreads();
    if (stop == 1) return;
#pragma unroll
    for (int uu = 0; uu < 2; ++uu) { GOUT_PTRS(uu); gla_cum_b(F, LAhi, LAlo, Fc); }
    __syncthreads();
    if (stop == 2) return;
#pragma unroll
    for (int uu = 0; uu < 2; ++uu) { GOUT_PTRS(uu); const float* SP = (const float*)(F.ws + WS_GLA_KV) + (size_t)unit * 2048;
      const u32x2 qw = *(const u32x2*)(P + (size_t)(tok0 + t) * NPROJ + PB_Q + h * 32 + c8 * 4), kw = *(const u32x2*)(P + (size_t)(tok0 + t) * NPROJ + PB_K + h * 32 + c8 * 4);
      const u32x4 vw = *(const u32x4*)(P + (size_t)(tok0 + t) * NPROJ + PB_V + h * 64 + c8 * 8);
      const f32x4 ct = *(const LAS f32x4*)(Fc + t * 32 + c8 * 4), cr = *(const LAS f32x4*)(Fc + 31 * 32 + c8 * 4);
      const float qs = 0.17677669529663687f;
      const float qf[4] = {bflo(qw.x) * qs, bfhi(qw.x) * qs, bflo(qw.y) * qs, bfhi(qw.y) * qs}, kf[4] = {bflo(kw.x), bfhi(kw.x), bflo(kw.y), bfhi(kw.y)};
      float qe[4], ke[4], qb[4];
#pragma unroll
      for (int j = 0; j < 4; ++j) { qe[j] = qf[j] * __expf(ct[j] - cr[j]); ke[j] = kf[j] * __expf(cr[j] - ct[j]); qb[j] = qf[j] * __expf(ct[j]); }
      u32x2 o; o.x = cvt_pk(qe[0], qe[1]); o.y = cvt_pk(qe[2], qe[3]); *(LAS u32x2*)(Qe + t * GP + c8 * 4) = o;
      o.x = cvt_pk(ke[0], ke[1]); o.y = cvt_pk(ke[2], ke[3]); *(LAS u32x2*)(Ke + t * GP + c8 * 4) = o;
      o.x = cvt_pk(qb[0], qb[1]); o.y = cvt_pk(qb[2], qb[3]); *(LAS u32x2*)(Qb + t * GP + c8 * 4) = o;
#pragma unroll
      for (int j = 0; j < 8; ++j) Vf[(c8 * 8 + j) * LP + t] = hw(vw, j);
      const int e = F.tid >> 4, f4 = (F.tid & 15) * 4; const f32x4 sv = *(const f32x4*)(SP + e * 64 + f4);
#pragma unroll
      for (int j = 0; j < 4; ++j) Sf[(f4 + j) * GP + e] = f2bf(sv[j]); }
    __syncthreads();
    if (stop == 3) return;
#pragma unroll
    for (int uu = 0; uu < 2; ++uu) { GOUT_PTRS(uu); f32x4 acc[2] = {{0.f, 0.f, 0.f, 0.f}, {0.f, 0.f, 0.f, 0.f}}; mm64p<GP, 1>(acc, Qe, Ke, mt, nt0, F.lane);
#pragma unroll
      for (int j = 0; j < 2; ++j)
#pragma unroll
          for (int rg = 0; rg < 4; ++rg) { const int tt = 16 * mt + 4 * kq + rg, ss = 16 * (nt0 + j) + r16; At[tt * LP + ss] = f2bf(ss <= tt ? acc[j][rg] : 0.f); } }
    __syncthreads();
    if (stop == 4) return;
#pragma unroll
    for (int uu = 0; uu < 2; ++uu) { GOUT_PTRS(uu); f32x4 acc[2] = {{0.f, 0.f, 0.f, 0.f}, {0.f, 0.f, 0.f, 0.f}}; mm64p<LP, 2>(acc, At, Vf, mt, nt0, F.lane); mm64p<GP, 1>(acc, Qb, Sf, mt, nt0, F.lane);
#pragma unroll
      for (int j = 0; j < 2; ++j)
#pragma unroll
          for (int rg = 0; rg < 4; ++rg) Of[(16 * mt + 4 * kq + rg) * 64 + 16 * (nt0 + j) + r16] = acc[j][rg]; }
    __syncthreads();
    if (stop == 5) return;
#pragma unroll
    for (int uu = 0; uu < 2; ++uu) { GOUT_PTRS(uu); const int f0 = c8 * 8; const f32x4 o0 = *(const LAS f32x4*)(Of + t * 64 + f0), o1 = *(const LAS f32x4*)(Of + t * 64 + f0 + 4);
      const float o[8] = {o0[0], o0[1], o0[2], o0[3], o1[0], o1[1], o1[2], o1[3]};
      float ss = 0.f;
#pragma unroll
      for (int j = 0; j < 8; ++j) ss += o[j] * o[j];
      ss = oct_sum(ss);
      const float rstd = rsqrtf(ss * (1.f / 64.f) + NORM_EPS); const float* gn = INF(F, I_GLA_ON) + l * 256 + h * 64 + f0;
      const f32x4 g0 = *(const f32x4*)gn, g1 = *(const f32x4*)(gn + 4);
      const u32x4 gw = *(const u32x4*)(P + (size_t)(tok0 + t) * NPROJ + PB_G + h * 64 + f0);
      const float gb[8] = {bflo(gw.x), bfhi(gw.x), bflo(gw.y), bfhi(gw.y), bflo(gw.z), bfhi(gw.z), bflo(gw.w), bfhi(gw.w)};
      float r[8];
#pragma unroll
      for (int j = 0; j < 8; ++j) r[j] = o[j] * rstd * (j < 4 ? g0[j & 3] : g1[j & 3]) * (gb[j] * sigmoid_f(gb[j]));
      *(u32x4*)(MIX + (size_t)(tok0 + t) * DM + 256 + h * 64 + f0) = pack8v(r); }
#undef GOUT_PTRS
}
struct Args { const void* in[N_IN]; float* out; unsigned char* ws; int ph_lo, ph_hi, sub, pad; };
constexpr int PH_PER_LAYER = 10, PH_FINAL = DEPTH * PH_PER_LAYER, PH_END = PH_FINAL + 2;
#ifndef EN_MASK
#define EN_MASK 0xFFFF
#endif
#define EN(b) ((EN_MASK >> (b)) & 1)
#ifndef DUP_MASK
#define DUP_MASK 0
#endif
#define NREP(b) (1 + ((DUP_MASK >> (b)) & 1))
enum Phase { P_PREP = 0, P_INPROJ, P_MIX1, P_MIX2, P_MIX3, P_OUTPROJ, P_NORM2, P_MAP, P_UP, P_DOWN };

__global__ void __launch_bounds__(512, 2) fwd_kernel(Args args) {
    extern __shared__ __attribute__((aligned(16))) unsigned char lds_raw[];
    Frame F;
    F.lds = (LAS unsigned char*)lds_raw;
    F.tid = threadIdx.x; F.lane = F.tid & 63; F.wave = __builtin_amdgcn_readfirstlane(F.tid >> 6);
    F.bid = blockIdx.x; F.G = gridDim.x;
    F.ws = args.ws; F.ctl = (unsigned*)(args.ws + WS_CTL); F.out = args.out;
    if (F.tid < N_IN) ((LAS unsigned long long*)(F.lds + PTR_OFF))[F.tid] = (unsigned long long)args.in[F.tid];
    volatile LAS unsigned* MISC = (volatile LAS unsigned*)(F.lds + MISC_OFF);
    if (F.tid < 8) MISC[F.tid] = 0u;
    __syncthreads();
    const int lo = args.ph_lo, hi = args.ph_hi, sub = args.sub;
    const int wave_sgpr = F.wave;
    XcdBarrier bar; bar.bar = F.ctl + CW_BAR; bar.x = 0; bar.st = MISC;
    if (hi - lo > 1) bar = xcd_barrier_post(F.ctl + CW_BAR, MISC);
#define HB ((bf16_t*)(F.ws + WS_H))
#define PROJ ((bf16_t*)(F.ws + WS_PROJ))
#define MIXB ((bf16_t*)(F.ws + WS_MIX))
#define ACT ((bf16_t*)(F.ws + WS_PROJ))
#define XBUF ((bf16_t*)((unsigned char*)F.out + XB_OFF))
#define IN(k) (lo <= (k) && (k) < hi)
#define PH_BEGIN() do { int w_i = wave_sgpr; asm volatile("" : "+s"(w_i)); unsigned m_i = ~0u; asm volatile("" : "+s"(m_i)); int l_i = (int)__builtin_amdgcn_mbcnt_hi(m_i, __builtin_amdgcn_mbcnt_lo(m_i, 0u)); asm volatile("" : "+v"(l_i)); F.wave = w_i; F.lane = l_i; F.tid = w_i * 64 + l_i; \
        GAS unsigned char* w_ = (GAS unsigned char*)args.ws; asm volatile("" : "+s"(w_)); F.ws = (unsigned char*)w_; F.ctl = (unsigned*)((unsigned char*)w_ + WS_CTL); F.out = (float*)(GAS float*)args.out; F.lds = (LAS unsigned char*)lds_raw; } while (0)
#define SEAM(k) do { if ((k) + 1 < hi) { GAS unsigned* bp_ = (GAS unsigned*)(F.ctl + CW_BAR); asm volatile("" : "+s"(bp_)); bar.bar = (unsigned*)bp_; unsigned bx_ = bar.x; asm volatile("" : "+s"(bx_)); bar.x = bx_; int w_j = wave_sgpr; asm volatile("" : "+s"(w_j)); unsigned m_j = ~0u; asm volatile("" : "+s"(m_j)); const int l_j = (int)__builtin_amdgcn_mbcnt_hi(m_j, __builtin_amdgcn_mbcnt_lo(m_j, 0u)); xcd_barrier(bar, w_j == 0 && l_j == 0); } } while (0)

    if (EN(0) && IN(0)) { PH_BEGIN(); phase_rope_tables(F); }
    { constexpr int l = 0;
        const int pb = l * PH_PER_LAYER; const bool moe = (l & 1) != 0; const int ms = l >> 1;

        if (EN(0) && IN(pb + P_PREP)) { PH_BEGIN();
            if (sub & 1) { phase_convert_weights(F, l); rwkv_convert_small(F, l); }
            __syncthreads();
            if (sub & 2) { if (l == 0) phase_norm_lr<true, false>(F, INF(F, I_X), INF(F, I_ATTN_NORM) + l * DM, l); else if (((l - 1) & 1) != 0) phase_norm_lr<false, true>(F, XBUF, INF(F, I_ATTN_NORM) + l * DM, l); else phase_norm_lr<false, false>(F, XBUF, INF(F, I_ATTN_NORM) + l * DM, l); }
            SEAM(pb + P_PREP);
        }
        if (EN(1) && IN(pb + P_INPROJ)) { PH_BEGIN();
            pg8::Gemm g{HB, (const bf16_t*)(F.ws + WS_WIN), DM, nullptr}; pg8::StaticOrder S; S.init(NTOK, 3072, F.G, F.bid);
            pg8::EpiBf16 E{PROJ, NPROJ};
            pg8::gemm_phase<pg8::EpiBf16, pg8::StaticOrder, false>(F.tid, F.lds, g, S, E);
            SEAM(pb + P_INPROJ);
        }
        if (EN(2) && IN(pb + P_MIX1)) { PH_BEGIN();
            if (sub & 1) { rwkv_r1_tables(F, l); for (int unit = F.bid; unit < 2048; unit += F.G) rwkv_r1_unit(F, l, unit, (sub >> 8) & 15); }
            if (sub & 2) { GlaW2 gw; gla_loadw2(F, l, (F.bid >> 6) & 3, gw); for (int unit = F.bid; unit < 2048; unit += 2 * F.G) gla_kv2_pair(F, l, unit, gw); }
            SEAM(pb + P_MIX1);
        }
        if (EN(3) && IN(pb + P_MIX2)) { PH_BEGIN();
            if (F.bid < 32) { if (sub & 1) rwkv_r2_block(F, F.bid); }
            else { const int ob = F.bid - 32, NO = F.G - 32;
                if (sub & 2) for (int gt = ob * 512 + F.tid; gt < 65536; gt += NO * 512) gla_scan(F, gt); }
            if (sub & 12) {
                volatile LAS int* qw = (volatile LAS int*)(F.lds + MISC_OFF + 28);
                unsigned* qctr = F.ctl + CW_ATTNQ + 64 * l + ((sub >> 4) & 1) * 32;
                int nxt = 0;
                if (F.tid == 0) nxt = (int)atomicAdd(qctr, 1u);
                for (;;) {
                    __syncthreads();
                    if (F.tid == 0) *qw = nxt;
                    __syncthreads();
                    const int task = *qw;
                    if (task >= 1024) break;
                    if (F.tid == 0) nxt = (int)atomicAdd(qctr, 1u);
                    if (task < 512) { if (sub & 4) attn_block<false>(F, l, task); } else if (sub & 8) attn_block<true>(F, l, task - 512);
                }
            }
            SEAM(pb + P_MIX2);
        }
        if (EN(4) && IN(pb + P_MIX3)) { PH_BEGIN();
            if (sub & 1) { GlaW2 gw; gla_loadw2(F, l, (F.bid >> 6) & 3, gw); for (int unit = F.bid; unit < 2048; unit += 2 * F.G) gla_out2_pair(F, l, unit, gw, (sub >> 8) & 15); }
            if (sub & 2) for (int unit = F.bid * 8 + F.wave; unit < 2048; unit += F.G * 8) rwkv_r3_task(F, l, unit);
            SEAM(pb + P_MIX3);
        }
        if (EN(5) && IN(pb + P_OUTPROJ)) { PH_BEGIN();
            __syncthreads();
            pg8::Gemm g{MIXB, (const bf16_t*)(F.ws + WS_WOUT), DM, nullptr}; pg8::StaticOrder S; S.init(NTOK, DM, F.G, F.bid);
            if (l == 0) { pg8::EpiResidB<true> E{INF(F, I_X), XBUF, DM}; pg8::gemm_phase<pg8::EpiResidB<true>, pg8::StaticOrder, false>(F.tid, F.lds, g, S, E); }
            else { pg8::EpiResidB<false> E{XBUF, XBUF, DM}; pg8::gemm_phase<pg8::EpiResidB<false>, pg8::StaticOrder, false>(F.tid, F.lds, g, S, E); }
            SEAM(pb + P_OUTPROJ);
        }
        if (EN(6) && IN(pb + P_NORM2)) { PH_BEGIN();
            if (moe) phase_norm<1, false>(F, XBUF, INF(F, I_FFN_NORM) + l * DM, false, ms);
            else phase_norm<0, false>(F, XBUF, INF(F, I_FFN_NORM) + l * DM, false, 0);
            SEAM(pb + P_NORM2);
        }
        if (EN(7) && IN(pb + P_MAP)) { PH_BEGIN();
            if (moe) { phase_moe_map(F, ms); SEAM(pb + P_MAP); }
        }
        if (EN(8) && IN(pb + P_UP)) { PH_BEGIN();
            __syncthreads();
            if (!moe) {
                pg8::Gemm g{HB, (const bf16_t*)(F.ws + WS_W13), DM / 2, nullptr}; pg8::StaticOrder S; S.init(NTOK, 2 * D_FF, F.G, F.bid);
                pg8::EpiSwiglu8 E{(unsigned char*)ACT, D_FF, 0.015625f};
                pg8::gemm_phase<pg8::EpiSwiglu8, pg8::StaticOrder, false, true>(F.tid, F.lds, g, S, E);
            } else {
                pg8::MoeOrder S; moe_bases(F.ctl + CW_MOECNT + 64 * ms, S.tb); S.ntiles = S.tb[8]; S.nNe = 2 * D_FFE / 256; S.G = F.G; S.c = F.bid;
                pg8::Gemm g{HB, (const bf16_t*)(F.ws + WS_W13), DM / 2, (const int*)(F.ws + WS_ROWMAP)};
                pg8::EpiSwiglu8 E{(unsigned char*)ACT, KP8, 0.015625f};
                pg8::gemm_phase<pg8::EpiSwiglu8, pg8::MoeOrder, true, true>(F.tid, F.lds, g, S, E);
            }
            SEAM(pb + P_UP);
        }
        if (EN(9) && IN(pb + P_DOWN)) { PH_BEGIN();
            __syncthreads();
            if (!moe) {
                pg8::Gemm g{ACT, (const bf16_t*)(F.ws + WS_W2), D_FF / 2, nullptr}; pg8::StaticOrder S; S.init(NTOK, DM, F.G, F.bid);
                pg8::EpiResidB<false> E{XBUF, XBUF, DM, 0.015625f};
                pg8::gemm_phase<pg8::EpiResidB<false>, pg8::StaticOrder, false, true>(F.tid, F.lds, g, S, E);
            } else {
                pg8::MoeOrder S; moe_bases(F.ctl + CW_MOECNT + 64 * ms, S.tb); S.ntiles = S.tb[8]; S.nNe = DM / 256; S.G = F.G; S.c = F.bid;
                pg8::Gemm g{ACT, (const bf16_t*)(F.ws + WS_W2), KP8 / 2, nullptr};
                pg8::EpiBf16 E{(bf16_t*)(F.ws + WS_Y), DM, 0.015625f};
                pg8::gemm_phase<pg8::EpiBf16, pg8::MoeOrder, false, true>(F.tid, F.lds, g, S, E);
            }
            SEAM(pb + P_DOWN);
        }
        }
    { constexpr int l = 1;
        const int pb = l * PH_PER_LAYER; const bool moe = (l & 1) != 0; const int ms = l >> 1;

        if (EN(0) && IN(pb + P_PREP)) { PH_BEGIN();
            if (sub & 1) { phase_convert_weights(F, l); rwkv_convert_small(F, l); }
            __syncthreads();
            if (sub & 2) { if (l == 0) phase_norm_lr<true, false>(F, INF(F, I_X), INF(F, I_ATTN_NORM) + l * DM, l); else if (((l - 1) & 1) != 0) phase_norm_lr<false, true>(F, XBUF, INF(F, I_ATTN_NORM) + l * DM, l); else phase_norm_lr<false, false>(F, XBUF, INF(F, I_ATTN_NORM) + l * DM, l); }
            SEAM(pb + P_PREP);
        }
        if (EN(1) && IN(pb + P_INPROJ)) { PH_BEGIN();
            pg8::Gemm g{HB, (const bf16_t*)(F.ws + WS_WIN), DM, nullptr}; pg8::StaticOrder S; S.init(NTOK, 3072, F.G, F.bid);
            pg8::EpiBf16 E{PROJ, NPROJ};
            pg8::gemm_phase<pg8::EpiBf16, pg8::StaticOrder, false>(F.tid, F.lds, g, S, E);
            SEAM(pb + P_INPROJ);
        }
        if (EN(2) && IN(pb + P_MIX1)) { PH_BEGIN();
            if (sub & 1) { rwkv_r1_tables(F, l); for (int unit = F.bid; unit < 2048; unit += F.G) rwkv_r1_unit(F, l, unit, (sub >> 8) & 15); }
            if (sub & 2) { GlaW2 gw; gla_loadw2(F, l, (F.bid >> 6) & 3, gw); for (int unit = F.bid; unit < 2048; unit += 2 * F.G) gla_kv2_pair(F, l, unit, gw); }
            SEAM(pb + P_MIX1);
        }
        if (EN(3) && IN(pb + P_MIX2)) { PH_BEGIN();
            if (F.bid < 32) { if (sub & 1) rwkv_r2_block(F, F.bid); }
            else { const int ob = F.bid - 32, NO = F.G - 32;
                if (sub & 2) for (int gt = ob * 512 + F.tid; gt < 65536; gt += NO * 512) gla_scan(F, gt); }
            if (sub & 12) {
                volatile LAS int* qw = (volatile LAS int*)(F.lds + MISC_OFF + 28);
                unsigned* qctr = F.ctl + CW_ATTNQ + 64 * l + ((sub >> 4) & 1) * 32;
                int nxt = 0;
                if (F.tid == 0) nxt = (int)atomicAdd(qctr, 1u);
                for (;;) {
                    __syncthreads();
                    if (F.tid == 0) *qw = nxt;
                    __syncthreads();
                    const int task = *qw;
                    if (task >= 1024) break;
                    if (F.tid == 0) nxt = (int)atomicAdd(qctr, 1u);
                    if (task < 512) { if (sub & 4) attn_block<false>(F, l, task); } else if (sub & 8) attn_block<true>(F, l, task - 512);
                }
            }
            SEAM(pb + P_MIX2);
        }
        if (EN(4) && IN(pb + P_MIX3)) { PH_BEGIN();
            if (sub & 1) { GlaW2 gw; gla_loadw2(F, l, (F.bid >> 6) & 3, gw); for (int unit = F.bid; unit < 2048; unit += 2 * F.G) gla_out2_pair(F, l, unit, gw, (sub >> 8) & 15); }
            if (sub & 2) for (int unit = F.bid * 8 + F.wave; unit < 2048; unit += F.G * 8) rwkv_r3_task(F, l, unit);
            SEAM(pb + P_MIX3);
        }
        if (EN(5) && IN(pb + P_OUTPROJ)) { PH_BEGIN();
            __syncthreads();
            pg8::Gemm g{MIXB, (const bf16_t*)(F.ws + WS_WOUT), DM, nullptr}; pg8::StaticOrder S; S.init(NTOK, DM, F.G, F.bid);
            if (l == 0) { pg8::EpiResidB<true> E{INF(F, I_X), XBUF, DM}; pg8::gemm_phase<pg8::EpiResidB<true>, pg8::StaticOrder, false>(F.tid, F.lds, g, S, E); }
            else { pg8::EpiResidB<false> E{XBUF, XBUF, DM}; pg8::gemm_phase<pg8::EpiResidB<false>, pg8::StaticOrder, false>(F.tid, F.lds, g, S, E); }
            SEAM(pb + P_OUTPROJ);
        }
        if (EN(6) && IN(pb + P_NORM2)) { PH_BEGIN();
            if (moe) phase_norm<1, false>(F, XBUF, INF(F, I_FFN_NORM) + l * DM, false, ms);
            else phase_norm<0, false>(F, XBUF, INF(F, I_FFN_NORM) + l * DM, false, 0);
            SEAM(pb + P_NORM2);
        }
        if (EN(7) && IN(pb + P_MAP)) { PH_BEGIN();
            if (moe) { phase_moe_map(F, ms); SEAM(pb + P_MAP); }
        }
        if (EN(8) && IN(pb + P_UP)) { PH_BEGIN();
            __syncthreads();
            if (!moe) {
                pg8::Gemm g{HB, (const bf16_t*)(F.ws + WS_W13), DM / 2, nullptr}; pg8::StaticOrder S; S.init(NTOK, 2 * D_FF, F.G, F.bid);
                pg8::EpiSwiglu8 E{(unsigned char*)ACT, D_FF, 0.015625f};
                pg8::gemm_phase<pg8::EpiSwiglu8, pg8::StaticOrder, false, true>(F.tid, F.lds, g, S, E);
            } else {
                pg8::MoeOrder S; moe_bases(F.ctl + CW_MOECNT + 64 * ms, S.tb); S.ntiles = S.tb[8]; S.nNe = 2 * D_FFE / 256; S.G = F.G; S.c = F.bid;
                pg8::Gemm g{HB, (const bf16_t*)(F.ws + WS_W13), DM / 2, (const int*)(F.ws + WS_ROWMAP)};
                pg8::EpiSwiglu8 E{(unsigned char*)ACT, KP8, 0.015625f};
                pg8::gemm_phase<pg8::EpiSwiglu8, pg8::MoeOrder, true, true>(F.tid, F.lds, g, S, E);
            }
            SEAM(pb + P_UP);
        }
        if (EN(9) && IN(pb + P_DOWN)) { PH_BEGIN();
            __syncthreads();
            if (!moe) {
                pg8::Gemm g{ACT, (const bf16_t*)(F.ws + WS_W2), D_FF / 2, nullptr}; pg8::StaticOrder S; S.init(NTOK, DM, F.G, F.bid);
                pg8::EpiResidB<false> E{XBUF, XBUF, DM, 0.015625f};
                pg8::gemm_phase<pg8::EpiResidB<false>, pg8::StaticOrder, false, true>(F.tid, F.lds, g, S, E);
            } else {
                pg8::MoeOrder S; moe_bases(F.ctl + CW_MOECNT + 64 * ms, S.tb); S.ntiles = S.tb[8]; S.nNe = DM / 256; S.G = F.G; S.c = F.bid;
                pg8::Gemm g{ACT, (const bf16_t*)(F.ws + WS_W2), KP8 / 2, nullptr};
                pg8::EpiBf16 E{(bf16_t*)(F.ws + WS_Y), DM, 0.015625f};
                pg8::gemm_phase<pg8::EpiBf16, pg8::MoeOrder, false, true>(F.tid, F.lds, g, S, E);
            }
            SEAM(pb + P_DOWN);
        }
        }
    { constexpr int l = 2;
        const int pb = l * PH_PER_LAYER; const bool moe = (l & 1) != 0; const int ms = l >> 1;

        if (EN(0) && IN(pb + P_PREP)) { PH_BEGIN();
            if (sub & 1) { phase_convert_weights(F, l); rwkv_convert_small(F, l); }
            __syncthreads();
            if (sub & 2) { if (l == 0) phase_norm_lr<true, false>(F, INF(F, I_X), INF(F, I_ATTN_NORM) + l * DM, l); else if (((l - 1) & 1) != 0) phase_norm_lr<false, true>(F, XBUF, INF(F, I_ATTN_NORM) + l * DM, l); else phase_norm_lr<false, false>(F, XBUF, INF(F, I_ATTN_NORM) + l * DM, l); }
            SEAM(pb + P_PREP);
        }
        if (EN(1) && IN(pb + P_INPROJ)) { PH_BEGIN();
            pg8::Gemm g{HB, (const bf16_t*)(F.ws + WS_WIN), DM, nullptr}; pg8::StaticOrder S; S.init(NTOK, 3072, F.G, F.bid);
            pg8::EpiBf16 E{PROJ, NPROJ};
            pg8::gemm_phase<pg8::EpiBf16, pg8::StaticOrder, false>(F.tid, F.lds, g, S, E);
            SEAM(pb + P_INPROJ);
        }
        if (EN(2) && IN(pb + P_MIX1)) { PH_BEGIN();
            if (sub & 1) { rwkv_r1_tables(F, l); for (int unit = F.bid; unit < 2048; unit += F.G) rwkv_r1_unit(F, l, unit, (sub >> 8) & 15); }
            if (sub & 2) { GlaW2 gw; gla_loadw2(F, l, (F.bid >> 6) & 3, gw); for (int unit = F.bid; unit < 2048; unit += 2 * F.G) gla_kv2_pair(F, l, unit, gw); }
            SEAM(pb + P_MIX1);
        }
        if (EN(3) && IN(pb + P_MIX2)) { PH_BEGIN();
            if (F.bid < 32) { if (sub & 1) rwkv_r2_block(F, F.bid); }
            else { const int ob = F.bid - 32, NO = F.G - 32;
                if (sub & 2) for (int gt = ob * 512 + F.tid; gt < 65536; gt += NO * 512) gla_scan(F, gt); }
            if (sub & 12) {
                volatile LAS int* qw = (volatile LAS int*)(F.lds + MISC_OFF + 28);
                unsigned* qctr = F.ctl + CW_ATTNQ + 64 * l + ((sub >> 4) & 1) * 32;
                int nxt = 0;
                if (F.tid == 0) nxt = (int)atomicAdd(qctr, 1u);
                for (;;) {
                    __syncthreads();
                    if (F.tid == 0) *qw = nxt;
                    __syncthreads();
                    const int task = *qw;
                    if (task >= 1024) break;
                    if (F.tid == 0) nxt = (int)atomicAdd(qctr, 1u);
                    if (task < 512) { if (sub & 4) attn_block<false>(F, l, task); } else if (sub & 8) attn_block<true>(F, l, task - 512);
                }
            }
            SEAM(pb + P_MIX2);
        }
        if (EN(4) && IN(pb + P_MIX3)) { PH_BEGIN();
            if (sub & 1) { GlaW2 gw; gla_loadw2(F, l, (F.bid >> 6) & 3, gw); for (int unit = F.bid; unit < 2048; unit += 2 * F.G) gla_out2_pair(F, l, unit, gw, (sub >> 8) & 15); }
            if (sub & 2) for (int unit = F.bid * 8 + F.wave; unit < 2048; unit += F.G * 8) rwkv_r3_task(F, l, unit);
            SEAM(pb + P_MIX3);
        }
        if (EN(5) && IN(pb + P_OUTPROJ)) { PH_BEGIN();
            __syncthreads();
            pg8::Gemm g{MIXB, (const bf16_t*)(F.ws + WS_WOUT), DM, nullptr}; pg8::StaticOrder S; S.init(NTOK, DM, F.G, F.bid);
            if (l == 0) { pg8::EpiResidB<true> E{INF(F, I_X), XBUF, DM}; pg8::gemm_phase<pg8::EpiResidB<true>, pg8::StaticOrder, false>(F.tid, F.lds, g, S, E); }
            else { pg8::EpiResidB<false> E{XBUF, XBUF, DM}; pg8::gemm_phase<pg8::EpiResidB<false>, pg8::StaticOrder, false>(F.tid, F.lds, g, S, E); }
            SEAM(pb + P_OUTPROJ);
        }
        if (EN(6) && IN(pb + P_NORM2)) { PH_BEGIN();
            if (moe) phase_norm<1, false>(F, XBUF, INF(F, I_FFN_NORM) + l * DM, false, ms);
            else phase_norm<0, false>(F, XBUF, INF(F, I_FFN_NORM) + l * DM, false, 0);
            SEAM(pb + P_NORM2);
        }
        if (EN(7) && IN(pb + P_MAP)) { PH_BEGIN();
            if (moe) { phase_moe_map(F, ms); SEAM(pb + P_MAP); }
        }
        if (EN(8) && IN(pb + P_UP)) { PH_BEGIN();
            __syncthreads();
            if (!moe) {
                pg8::Gemm g{HB, (const bf16_t*)(F.ws + WS_W13), DM / 2, nullptr}; pg8::StaticOrder S; S.init(NTOK, 2 * D_FF, F.G, F.bid);
                pg8::EpiSwiglu8 E{(unsigned char*)ACT, D_FF, 0.015625f};
                pg8::gemm_phase<pg8::EpiSwiglu8, pg8::StaticOrder, false, true>(F.tid, F.lds, g, S, E);
            } else {
                pg8::MoeOrder S; moe_bases(F.ctl + CW_MOECNT + 64 * ms, S.tb); S.ntiles = S.tb[8]; S.nNe = 2 * D_FFE / 256; S.G = F.G; S.c = F.bid;
                pg8::Gemm g{HB, (const bf16_t*)(F.ws + WS_W13), DM / 2, (const int*)(F.ws + WS_ROWMAP)};
                pg8::EpiSwiglu8 E{(unsigned char*)ACT, KP8, 0.015625f};
                pg8::gemm_phase<pg8::EpiSwiglu8, pg8::MoeOrder, true, true>(F.tid, F.lds, g, S, E);
            }
            SEAM(pb + P_UP);
        }
        if (EN(9) && IN(pb + P_DOWN)) { PH_BEGIN();
            __syncthreads();
            if (!moe) {
                pg8::Gemm g{ACT, (const bf16_t*)(F.ws + WS_W2), D_FF / 2, nullptr}; pg8::StaticOrder S; S.init(NTOK, DM, F.G, F.bid);
                pg8::EpiResidB<false> E{XBUF, XBUF, DM, 0.015625f};
                pg8::gemm_phase<pg8::EpiResidB<false>, pg8::StaticOrder, false, true>(F.tid, F.lds, g, S, E);
            } else {
                pg8::MoeOrder S; moe_bases(F.ctl + CW_MOECNT + 64 * ms, S.tb); S.ntiles = S.tb[8]; S.nNe = DM / 256; S.G = F.G; S.c = F.bid;
                pg8::Gemm g{ACT, (const bf16_t*)(F.ws + WS_W2), KP8 / 2, nullptr};
                pg8::EpiBf16 E{(bf16_t*)(F.ws + WS_Y), DM, 0.015625f};
                pg8::gemm_phase<pg8::EpiBf16, pg8::MoeOrder, false, true>(F.tid, F.lds, g, S, E);
            }
            SEAM(pb + P_DOWN);
        }
        }
    { constexpr int l = 3;
        const int pb = l * PH_PER_LAYER; const bool moe = (l & 1) != 0; const int ms = l >> 1;

        if (EN(0) && IN(pb + P_PREP)) { PH_BEGIN();
            if (sub & 1) { phase_convert_weights(F, l); rwkv_convert_small(F, l); }
            __syncthreads();
            if (sub & 2) { if (l == 0) phase_norm_lr<true, false>(F, INF(F, I_X), INF(F, I_ATTN_NORM) + l * DM, l); else if (((l - 1) & 1) != 0) phase_norm_lr<false, true>(F, XBUF, INF(F, I_ATTN_NORM) + l * DM, l); else phase_norm_lr<false, false>(F, XBUF, INF(F, I_ATTN_NORM) + l * DM, l); }
            SEAM(pb + P_PREP);
        }
        if (EN(1) && IN(pb + P_INPROJ)) { PH_BEGIN();
            pg8::Gemm g{HB, (const bf16_t*)(F.ws + WS_WIN), DM, nullptr}; pg8::StaticOrder S; S.init(NTOK, 3072, F.G, F.bid);
            pg8::EpiBf16 E{PROJ, NPROJ};
            pg8::gemm_phase<pg8::EpiBf16, pg8::StaticOrder, false>(F.tid, F.lds, g, S, E);
            SEAM(pb + P_INPROJ);
        }
        if (EN(2) && IN(pb + P_MIX1)) { PH_BEGIN();
            if (sub & 1) { rwkv_r1_tables(F, l); for (int unit = F.bid; unit < 2048; unit += F.G) rwkv_r1_unit(F, l, unit, (sub >> 8) & 15); }
            if (sub & 2) { GlaW2 gw; gla_loadw2(F, l, (F.bid >> 6) & 3, gw); for (int unit = F.bid; unit < 2048; unit += 2 * F.G) gla_kv2_pair(F, l, unit, gw); }
            SEAM(pb + P_MIX1);
        }
        if (EN(3) && IN(pb + P_MIX2)) { PH_BEGIN();
            if (F.bid < 32) { if (sub & 1) rwkv_r2_block(F, F.bid); }
            else { const int ob = F.bid - 32, NO = F.G - 32;
                if (sub & 2) for (int gt = ob * 512 + F.tid; gt < 65536; gt += NO * 512) gla_scan(F, gt); }
            if (sub & 12) {
                volatile LAS int* qw = (volatile LAS int*)(F.lds + MISC_OFF + 28);
                unsigned* qctr = F.ctl + CW_ATTNQ + 64 * l + ((sub >> 4) & 1) * 32;
                int nxt = 0;
                if (F.tid == 0) nxt = (int)atomicAdd(qctr, 1u);
                for (;;) {
                    __syncthreads();
                    if (F.tid == 0) *qw = nxt;
                    __syncthreads();
                    const int task = *qw;
                    if (task >= 1024) break;
                    if (F.tid == 0) nxt = (int)atomicAdd(qctr, 1u);
                    if (task < 512) { if (sub & 4) attn_block<false>(F, l, task); } else if (sub & 8) attn_block<true>(F, l, task - 512);
                }
            }
            SEAM(pb + P_MIX2);
        }
        if (EN(4) && IN(pb + P_MIX3)) { PH_BEGIN();
            if (sub & 1) { GlaW2 gw; gla_loadw2(F, l, (F.bid >> 6) & 3, gw); for (int unit = F.bid; unit < 2048; unit += 2 * F.G) gla_out2_pair(F, l, unit, gw, (sub >> 8) & 15); }
            if (sub & 2) for (int unit = F.bid * 8 + F.wave; unit < 2048; unit += F.G * 8) rwkv_r3_task(F, l, unit);
            SEAM(pb + P_MIX3);
        }
        if (EN(5) && IN(pb + P_OUTPROJ)) { PH_BEGIN();
            __syncthreads();
            pg8::Gemm g{MIXB, (const bf16_t*)(F.ws + WS_WOUT), DM, nullptr}; pg8::StaticOrder S; S.init(NTOK, DM, F.G, F.bid);
            if (l == 0) { pg8::EpiResidB<true> E{INF(F, I_X), XBUF, DM}; pg8::gemm_phase<pg8::EpiResidB<true>, pg8::StaticOrder, false>(F.tid, F.lds, g, S, E); }
            else { pg8::EpiResidB<false> E{XBUF, XBUF, DM}; pg8::gemm_phase<pg8::EpiResidB<false>, pg8::StaticOrder, false>(F.tid, F.lds, g, S, E); }
            SEAM(pb + P_OUTPROJ);
        }
        if (EN(6) && IN(pb + P_NORM2)) { PH_BEGIN();
            if (moe) phase_norm<1, false>(F, XBUF, INF(F, I_FFN_NORM) + l * DM, false, ms);
            else phase_norm<0, false>(F, XBUF, INF(F, I_FFN_NORM) + l * DM, false, 0);
            SEAM(pb + P_NORM2);
        }
        if (EN(7) && IN(pb + P_MAP)) { PH_BEGIN();
            if (moe) { phase_moe_map(F, ms); SEAM(pb + P_MAP); }
        }
        if (EN(8) && IN(pb + P_UP)) { PH_BEGIN();
            __syncthreads();
            if (!moe) {
                pg8::Gemm g{HB, (const bf16_t*)(F.ws + WS_W13), DM / 2, nullptr}; pg8::StaticOrder S; S.init(NTOK, 2 * D_FF, F.G, F.bid);
                pg8::EpiSwiglu8 E{(unsigned char*)ACT, D_FF, 0.015625f};
                pg8::gemm_phase<pg8::EpiSwiglu8, pg8::StaticOrder, false, true>(F.tid, F.lds, g, S, E);
            } else {
                pg8::MoeOrder S; moe_bases(F.ctl + CW_MOECNT + 64 * ms, S.tb); S.ntiles = S.tb[8]; S.nNe = 2 * D_FFE / 256; S.G = F.G; S.c = F.bid;
                pg8::Gemm g{HB, (const bf16_t*)(F.ws + WS_W13), DM / 2, (const int*)(F.ws + WS_ROWMAP)};
                pg8::EpiSwiglu8 E{(unsigned char*)ACT, KP8, 0.015625f};
                pg8::gemm_phase<pg8::EpiSwiglu8, pg8::MoeOrder, true, true>(F.tid, F.lds, g, S, E);
            }
            SEAM(pb + P_UP);
        }
        if (EN(9) && IN(pb + P_DOWN)) { PH_BEGIN();
            __syncthreads();
            if (!moe) {
                pg8::Gemm g{ACT, (const bf16_t*)(F.ws + WS_W2), D_FF / 2, nullptr}; pg8::StaticOrder S; S.init(NTOK, DM, F.G, F.bid);
                pg8::EpiResidB<false> E{XBUF, XBUF, DM, 0.015625f};
                pg8::gemm_phase<pg8::EpiResidB<false>, pg8::StaticOrder, false, true>(F.tid, F.lds, g, S, E);
            } else {
                pg8::MoeOrder S; moe_bases(F.ctl + CW_MOECNT + 64 * ms, S.tb); S.ntiles = S.tb[8]; S.nNe = DM / 256; S.G = F.G; S.c = F.bid;
                pg8::Gemm g{ACT, (const bf16_t*)(F.ws + WS_W2), KP8 / 2, nullptr};
                pg8::EpiBf16 E{(bf16_t*)(F.ws + WS_Y), DM, 0.015625f};
                pg8::gemm_phase<pg8::EpiBf16, pg8::MoeOrder, false, true>(F.tid, F.lds, g, S, E);
            }
            SEAM(pb + P_DOWN);
        }
        }
    if (EN(10) && IN(PH_FINAL)) { PH_BEGIN();
        __syncthreads();
        phase_norm<2, false>(F, XBUF, INF(F, I_FINAL_NORM), true, 0);
        SEAM(PH_FINAL);
    }
    if (EN(10) && IN(PH_FINAL + 1)) { PH_BEGIN(); phase_final_copy(F); }
#undef IN
#undef XBUF
#undef HB
#undef PROJ
#undef MIXB
#undef ACT
#undef PH_BEGIN
#undef SEAM
}

extern "C" void kernel_launch(void* const* d_in, const int* in_sizes, int n_in, void* d_out, int out_size, void* d_ws, size_t ws_size, hipStream_t stream) {
    static int ready = 0;
    if (ready == 0) {
        if (n_in != N_IN || in_sizes[0] != NTOK * DM || out_size != NTOK * DM || ws_size < WS_END) {
            fprintf(stderr, "kernel_launch: unexpected shapes (n_in %d, in0 %d, out %d, ws %zu); nothing launched\n", n_in, n_in > 0 ? in_sizes[0] : -1, out_size, ws_size); ready = -1; return; }
        if (hipFuncSetAttribute((const void*)fwd_kernel, hipFuncAttributeMaxDynamicSharedMemorySize, LDS_BYTES) != hipSuccess) { fprintf(stderr, "kernel_launch: hipFuncSetAttribute failed\n"); ready = -1; return; }
        int per_cu = 0;
        if (hipOccupancyMaxActiveBlocksPerMultiprocessor(&per_cu, (const void*)fwd_kernel, 512, LDS_BYTES) != hipSuccess || per_cu < 1)
            fprintf(stderr, "kernel_launch: note: occupancy query reports %d workgroups per CU\n", per_cu);
        (void)hipGetLastError();
        ready = 1;
    }
    if (ready < 0) return;
    const int grid = 256;
    if (hipMemsetAsync((char*)d_ws + WS_CTL, 0, CTL_ZERO_BYTES, stream) != hipSuccess) { fprintf(stderr, "kernel_launch: memset failed\n"); return; }
    Args a{};
    for (int i = 0; i < N_IN; ++i) a.in[i] = d_in[i];
    a.out = (float*)d_out; a.ws = (unsigned char*)d_ws; a.sub = 0xF;
#if N_LAUNCHES_ONE
    a.ph_lo = 0; a.ph_hi = PH_END;
    hipLaunchKernelGGL(fwd_kernel, dim3(grid), dim3(512), LDS_BYTES, stream, a);
#else
    for (int p = 0; p < PH_END; ++p) {
        if (p < PH_FINAL && (p % PH_PER_LAYER) == P_MAP && (((p / PH_PER_LAYER) & 1) == 0)) continue;
        a.ph_lo = p; a.ph_hi = p + 1; a.sub = 0xF;
        hipLaunchKernelGGL(fwd_kernel, dim3(grid), dim3(512), LDS_BYTES, stream, a);
#if defined(PROBE_PHASE)
        if (p < PH_FINAL && (p % PH_PER_LAYER) == PROBE_PHASE && ((PROBE_LMASK >> (p / PH_PER_LAYER)) & 1)) { a.sub = PROBE_SUB; hipLaunchKernelGGL(fwd_kernel, dim3(grid), dim3(512), LDS_BYTES, stream, a); }
#endif
    }
#endif
    const hipError_t le = hipPeekAtLastError();
    if (le != hipSuccess) fprintf(stderr, "kernel_launch: launch failed: %s\n", hipGetErrorName(le));
}
```

```cpp
#include <hip/hip_runtime.h>
#include <cstdio>
#include <cstdint>

#define LAS __attribute__((address_space(3)))
#define GAS __attribute__((address_space(1)))
typedef unsigned short bf16_t;
typedef short bf16x8 __attribute__((ext_vector_type(8)));
typedef float f32x4 __attribute__((ext_vector_type(4)));
typedef float f32x2 __attribute__((ext_vector_type(2)));
typedef unsigned u32x4 __attribute__((ext_vector_type(4)));
typedef unsigned u32x2 __attribute__((ext_vector_type(2)));

#ifndef N_LAUNCHES_ONE
#define N_LAUNCHES_ONE 1
#endif

constexpr int BATCH = 8, SEQ = 4096, DM = 1024, NTOK = BATCH * SEQ, DEPTH = 4;
constexpr int IN_COLS = 3088, NPROJ = 3328;
constexpr int D_FF = 2816, N_EXP = 8, D_FFE = 1408;
constexpr int KP8 = 1536;
constexpr int PA_Q = 0, PA_K = 256, PA_V = 384;
constexpr int PB_Q = 512, PB_K = 640, PB_V = 768, PB_G = 1024;
constexpr int PC_Q = 1280, PC_K = 1536, PC_V = 1792;
constexpr int PD = 2048;
constexpr int PB_LR = 3072;
constexpr float NORM_EPS = 1e-6f;
constexpr int MOE_ROWS = NTOK * 2 + N_EXP * 256;

constexpr size_t MiB = 1u << 20;
constexpr size_t WS_CTL = 0, CTL_ZERO_BYTES = 1 * MiB;
constexpr size_t WS_ROPE_C = 2 * MiB, WS_ROPE_S = 6 * MiB;
constexpr size_t WS_WIN = 10 * MiB, WS_WOUT = 17 * MiB, WS_W13 = 19 * MiB, WS_W2 = 63 * MiB;
constexpr size_t WS_H = 86 * MiB;
constexpr size_t WS_PROJ = 150 * MiB;
constexpr size_t WS_MIX = 358 * MiB;
constexpr size_t WS_SCR = 422 * MiB;
constexpr size_t WS_RWM = WS_H;
constexpr size_t WS_RW_V = WS_SCR, WS_RW_G = WS_SCR + 16 * MiB, WS_RW_S = WS_SCR + 32 * MiB;
constexpr size_t WS_GLA_KV = 470 * MiB, WS_GLA_DEC = 1 * MiB;
constexpr size_t WS_RKR = 486 * MiB;
constexpr size_t WS_RW_X = 488 * MiB;
constexpr size_t WS_SMALLW = 85 * MiB;
constexpr size_t WS_YRAW = 488 * MiB;
constexpr size_t WS_Y = 358 * MiB;
constexpr size_t WS_TOK_E = 520 * MiB, WS_TOK_G = WS_TOK_E + 256 * 1024, WS_TOK_SLOT = WS_TOK_G + 256 * 1024, WS_TOK_ROW = WS_TOK_SLOT + 256 * 1024, WS_ROWMAP = 521 * MiB;
constexpr size_t WS_END = 522 * MiB;
static_assert(WS_Y + (size_t)MOE_ROWS * 2048 <= WS_TOK_E && WS_YRAW + (size_t)NTOK * 256 * 4 <= WS_TOK_E && WS_W2 + 22 * MiB <= WS_H, "ws map");
constexpr int CW_BAR = 4096;
constexpr int CW_ATTNQ = 12288;
constexpr int CW_MOECNT = 8192;

constexpr size_t XB_OFF = 64 * MiB;
constexpr int LDS_BYTES = 147456;
constexpr int MISC_OFF = 131072 + 8192;

__device__ __forceinline__ float bf2f(unsigned short u) { return __uint_as_float((unsigned)u << 16); }
__device__ __forceinline__ float bflo(unsigned w) { return __uint_as_float(w << 16); }
__device__ __forceinline__ float bfhi(unsigned w) { return __uint_as_float(w & 0xffff0000u); }
__device__ __forceinline__ unsigned short f2bf(float f) { unsigned u = __float_as_uint(f); return (unsigned short)((u + 0x7fffu + ((u >> 16) & 1u)) >> 16); }
__device__ __forceinline__ unsigned pk2(float lo, float hi) { return (unsigned)f2bf(lo) | ((unsigned)f2bf(hi) << 16); }
__device__ __forceinline__ float wave_sum(float v) {
#pragma unroll
    for (int o = 1; o < 64; o <<= 1) v += __shfl_xor(v, o);
    return v;
}
__device__ __forceinline__ float sigmoid_f(float x) { return 1.f / (1.f + __expf(-x)); }
__device__ __forceinline__ float softplus_f(float z) { return fmaxf(z, 0.f) + __logf(1.f + __expf(-fabsf(z))); }
__device__ __forceinline__ float logsigmoid_f(float x) { return fminf(x, 0.f) - __logf(1.f + __expf(-fabsf(x))); }
namespace pg8 {
constexpr int BM = 256, BK = 64, HALF = 128, HTB = HALF * BK * 2  , STAGE_BYTES = 8 * HTB, NXCD = 8, WGM = 8;

__host__ __device__ __forceinline__ int lds_byte(int r, int c) { const int st = (r >> 4) * 2 + (c >> 5), rr = r & 15, cc = c & 31, ob = rr * 64 + cc * 2; return st * 1024 + (ob ^ (((ob >> 9) & 1) << 5)); }
__host__ __device__ __forceinline__ void stage_rc(int b, int& R, int& C) { const int st = b / 1024, sb = b % 1024, swz = sb ^ (((sb >> 9) & 1) << 5); R = (st >> 1) * 16 + swz / 64; C = (st & 1) * 32 + (swz % 64) / 2; }
__host__ __device__ __forceinline__ int perm32(int rho) { const int n = rho >> 4, i = rho & 15; return 8 * (i >> 2) + 4 * n + (i & 3); }

struct Unit { int pm, pn, pc; };
struct Gemm { const bf16_t* A; const bf16_t* Bt; int K; const int* rowmap; };

struct StaticOrder {
    int nM, nN, nwg, G, c;
    __device__ void init(int M, int N, int G_, int c_) { nM = M / BM; nN = N / BM; nwg = nM * nN; G = G_; c = c_; }
    __device__ bool next(int i, Unit& u) const {
        const long L = (long)i * G + c; if (L >= nwg) return false;
        int wgid = (int)L; { const int q = nwg / NXCD, r = nwg % NXCD, xcd = wgid % NXCD, off = wgid / NXCD; wgid = (xcd < r ? xcd * (q + 1) : r * (q + 1) + (xcd - r) * q) + off; }
        const int nig = WGM * nN, gid = wgid / nig, fm = gid * WGM, gsz = (nM - fm) < WGM ? (nM - fm) : WGM;
        u.pm = fm + ((wgid % nig) % gsz); u.pn = (wgid % nig) / gsz; u.pc = u.pn; return true;
    }
};
struct MoeOrder {
    int ntiles, nNe, G, c; int tb[9];
    __device__ bool next(int i, Unit& u) const {
        const long L = (long)i * G + c; if (L >= (long)ntiles * nNe) return false;
        const int pm = (int)(L / nNe), pl = (int)(L % nNe); int e = 0;
#pragma unroll
        for (int j = 1; j < 8; ++j) e += (pm >= tb[j]) ? 1 : 0;
        u.pm = pm; u.pn = e * nNe + pl; u.pc = pl; return true;
    }
};

typedef __bf16 bf16pair_t __attribute__((ext_vector_type(2)));
__device__ __forceinline__ unsigned cvt_pk_c(float lo, float hi) { bf16pair_t v; v[0] = (__bf16)lo; v[1] = (__bf16)hi; return __builtin_bit_cast(unsigned, v); }
__device__ __forceinline__ unsigned cvt_pk_bf16(float lo, float hi) { unsigned r; asm volatile("v_cvt_pk_bf16_f32 %0, %1, %2" : "=v"(r) : "v"(lo), "v"(hi)); return r; }

struct EpiBf16 {
    static constexpr bool PERM = true;
    bf16_t* O; int ldc; float sc = 1.f;
    __device__ __forceinline__ void operator()(const f32x4 (&acc)[2][2][4][2], const Unit& u, int wr, int wc, int fr, int fq) const {
        const int row0 = u.pm * BM + wr * 64 + fr; const int col0 = u.pc * BM + wc * 32 + 8 * fq;
#pragma unroll
        for (int ai = 0; ai < 2; ++ai)
#pragma unroll
            for (int m = 0; m < 4; ++m) { bf16_t* rowp = O + (size_t)(row0 + ai * HALF + m * 16) * ldc + col0;
#pragma unroll
                for (int bj = 0; bj < 2; ++bj) { const f32x4 v0 = acc[ai][bj][m][0] * sc, v1 = acc[ai][bj][m][1] * sc;
                    u32x4 w; w.x = cvt_pk_bf16(v0[0], v0[1]); w.y = cvt_pk_bf16(v0[2], v0[3]); w.z = cvt_pk_bf16(v1[0], v1[1]); w.w = cvt_pk_bf16(v1[2], v1[3]);
                    *(u32x4*)(rowp + bj * HALF) = w; } }
    }
};
struct EpiSwiglu {
    static constexpr bool PERM = true;
    bf16_t* O; int ldc; float sc;
    __device__ __forceinline__ void operator()(const f32x4 (&acc)[2][2][4][2], const Unit& u, int wr, int wc, int fr, int fq) const {
        const int row0 = u.pm * BM + wr * 64 + fr; const int col0 = u.pc * HALF + wc * 32 + 8 * fq;
#pragma unroll
        for (int ai = 0; ai < 2; ++ai)
#pragma unroll
            for (int m = 0; m < 4; ++m) { bf16_t* rowp = O + (size_t)(row0 + ai * HALF + m * 16) * ldc + col0;
                float r[8];
#pragma unroll
                for (int n = 0; n < 2; ++n)
#pragma unroll
                    for (int j = 0; j < 4; ++j) { const float g = acc[ai][0][m][n][j] * sc, up = acc[ai][1][m][n][j] * sc; r[n * 4 + j] = g * __builtin_amdgcn_rcpf(1.f + __expf(-g)) * up; }
                u32x4 w; w.x = cvt_pk_bf16(r[0], r[1]); w.y = cvt_pk_bf16(r[2], r[3]); w.z = cvt_pk_bf16(r[4], r[5]); w.w = cvt_pk_bf16(r[6], r[7]);
                *(u32x4*)rowp = w; }
    }
};
__device__ __forceinline__ unsigned pk4_fp8c(float a, float b, float c, float d) { unsigned w = 0u;
    a = __builtin_fminf(__builtin_fmaxf(a, -448.f), 448.f); b = __builtin_fminf(__builtin_fmaxf(b, -448.f), 448.f); c = __builtin_fminf(__builtin_fmaxf(c, -448.f), 448.f); d = __builtin_fminf(__builtin_fmaxf(d, -448.f), 448.f);
    w = __builtin_amdgcn_cvt_pk_fp8_f32(a, b, w, false); w = __builtin_amdgcn_cvt_pk_fp8_f32(c, d, w, true); return w; }
struct EpiSwiglu8 {
    static constexpr bool PERM = true;
    unsigned char* O8; int ldc; float sc;
    __device__ __forceinline__ void operator()(const f32x4 (&acc)[2][2][4][2], const Unit& u, int wr, int wc, int fr, int fq) const {
        const int row0 = u.pm * BM + wr * 64 + fr; const int col0 = u.pc * HALF + wc * 32 + 8 * fq;
#pragma unroll
        for (int ai = 0; ai < 2; ++ai)
#pragma unroll
            for (int m = 0; m < 4; ++m) { unsigned char* rowp = O8 + (size_t)(row0 + ai * HALF + m * 16) * ldc + col0;
                float r[8];
#pragma unroll
                for (int n = 0; n < 2; ++n)
#pragma unroll
                    for (int j = 0; j < 4; ++j) { const float g = acc[ai][0][m][n][j] * sc, up = acc[ai][1][m][n][j] * sc; r[n * 4 + j] = g * __builtin_amdgcn_rcpf(1.f + __expf(-g)) * up; }
                u32x2 w; w.x = pk4_fp8c(r[0], r[1], r[2], r[3]); w.y = pk4_fp8c(r[4], r[5], r[6], r[7]);
                *(u32x2*)rowp = w; }
    }
};
template <bool BASE_F32> struct EpiResidB {
    static constexpr bool PERM = true;
    const void* base; bf16_t* out; int ldc; float sc = 1.f;
    __device__ __forceinline__ void operator()(const f32x4 (&acc)[2][2][4][2], const Unit& u, int wr, int wc, int fr, int fq) const {
        const int row0 = u.pm * BM + wr * 64 + fr; const int col0 = u.pc * BM + wc * 32 + 8 * fq;
#pragma unroll
        for (int ai = 0; ai < 2; ++ai)
#pragma unroll
            for (int m = 0; m < 4; ++m) { const size_t off = (size_t)(row0 + ai * HALF + m * 16) * ldc + col0;
#pragma unroll
                for (int bj = 0; bj < 2; ++bj) { f32x4 v0 = acc[ai][bj][m][0] * sc, v1 = acc[ai][bj][m][1] * sc;
                    if (BASE_F32) { const float* bp = (const float*)base + off + bj * HALF; v0 += *(const f32x4*)bp; v1 += *(const f32x4*)(bp + 4); }
                    else { const u32x4 w = *(const u32x4*)((const bf16_t*)base + off + bj * HALF);
                        v0[0] += __uint_as_float(w.x << 16); v0[1] += __uint_as_float(w.x & 0xffff0000u); v0[2] += __uint_as_float(w.y << 16); v0[3] += __uint_as_float(w.y & 0xffff0000u);
                        v1[0] += __uint_as_float(w.z << 16); v1[1] += __uint_as_float(w.z & 0xffff0000u); v1[2] += __uint_as_float(w.w << 16); v1[3] += __uint_as_float(w.w & 0xffff0000u); }
                    u32x4 o; o.x = cvt_pk_bf16(v0[0], v0[1]); o.y = cvt_pk_bf16(v0[2], v0[3]); o.z = cvt_pk_bf16(v1[0], v1[1]); o.w = cvt_pk_bf16(v1[2], v1[3]);
                    *(u32x4*)(out + off + bj * HALF) = o; } }
    }
};

typedef int i32x8 __attribute__((ext_vector_type(8)));
typedef int i32x4g __attribute__((ext_vector_type(4)));
__device__ __forceinline__ i32x8 cat8(const bf16x8 a, const bf16x8 b) { return __builtin_shufflevector(__builtin_bit_cast(i32x4g, a), __builtin_bit_cast(i32x4g, b), 0, 1, 2, 3, 4, 5, 6, 7); }
template <class Epi, class Sched, bool GATHER, bool F8 = false>
__device__ __forceinline__ void gemm_phase(const int tid, LAS unsigned char* lds, const Gemm g, const Sched& S, const Epi& E) {
    const int wid = __builtin_amdgcn_readfirstlane(tid >> 6), lane = tid & 63, wr = wid >> 2, wc = wid & 3, fr = lane & 15, fq = lane >> 4;
    const int K = g.K, nt = K / BK;
    unsigned voffA, voffB;
    { int R, C; stage_rc(tid * 16, R, C); const int Rb = Epi::PERM ? ((R & ~31) + perm32(R & 31)) : R; voffA = (unsigned)(R * K + C) * 2u; voffB = (unsigned)(Rb * K + C) * 2u; }
    const size_t kstep = (size_t)(BK * 2);
    const size_t hstep = (size_t)HALF * K * 2;
    const size_t tstep = 2 * hstep;
    const unsigned ldsw = (unsigned)wid * 1024u;
    const int aoff = lds_byte(wr * 64 + fr, fq * 8), boff = lds_byte(wc * 32 + fr, fq * 8);
#define PG8_SA(b, h) (((b) * 2 + (h)) * HTB)
#define PG8_SB(b, h) ((4 + (b) * 2 + (h)) * HTB)
#define PG8_STAGE2(bufoff, gbase, v0, v1) do { _Pragma("unroll") for (int _i = 0; _i < 2; ++_i) { unsigned _v = _i ? (v1) : (v0); asm volatile("" : "+v"(_v)); \
        __builtin_amdgcn_global_load_lds((const unsigned*)((const char*)(gbase) + _v), (LAS unsigned*)(lds + (bufoff) + ldsw + _i * 8192), 16, 0, 0); } } while (0)
#define PG8_STAGE(bufoff, gbase, voff) PG8_STAGE2(bufoff, gbase, (voff), (voff) + (unsigned)(128 * K))
#define PG8_STAGE_A(bufoff, kb, h, nx) do { if constexpr (GATHER) { PG8_STAGE2(bufoff, (const char*)g.A + (kb), offC[h][0], offC[h][1]); }   \
        else { PG8_STAGE(bufoff, ((nx) ? nA : cA) + (kb) + (h) * hstep, voffA); } } while (0)
#define PG8_LDA(dst, b, h) do { _Pragma("unroll") for (int m = 0; m < 4; ++m) _Pragma("unroll") for (int k = 0; k < 2; ++k) dst[m][k] = *(const LAS bf16x8*)(lds + PG8_SA(b, h) + aoff + m * 2048 + k * 1024); } while (0)
#define PG8_LDB(dst, b, h) do { _Pragma("unroll") for (int n = 0; n < 2; ++n) _Pragma("unroll") for (int k = 0; k < 2; ++k) dst[n][k] = *(const LAS bf16x8*)(lds + PG8_SB(b, h) + boff + n * 2048 + k * 1024); } while (0)
#define PG8_MMA(ai, bj, At, Bt) do { __builtin_amdgcn_s_setprio(1); _Pragma("unroll") for (int m = 0; m < 4; ++m) _Pragma("unroll") for (int n = 0; n < 2; ++n) { \
        if constexpr (F8) acc[ai][bj][m][n] = __builtin_amdgcn_mfma_scale_f32_16x16x128_f8f6f4(cat8(Bt[n][0], Bt[n][1]), cat8(At[m][0], At[m][1]), acc[ai][bj][m][n], 0, 0, 0, 0, 0, 0);   \
        else { _Pragma("unroll") for (int k = 0; k < 2; ++k) acc[ai][bj][m][n] = __builtin_amdgcn_mfma_f32_16x16x32_bf16(Bt[n][k], At[m][k], acc[ai][bj][m][n], 0, 0, 0); } } __builtin_amdgcn_s_setprio(0); } while (0)
#define PG8_WAIT_V(n) asm volatile("s_waitcnt vmcnt(" #n ")" ::: "memory")
#define PG8_WAIT_L(n) asm volatile("s_waitcnt lgkmcnt(" #n ")" ::: "memory")
#define PG8_BAR __builtin_amdgcn_s_barrier()
#define PG8_SCHED __builtin_amdgcn_sched_barrier(0)
#define PG8_LOADOFF(dst, u) do { _Pragma("unroll") for (int _h = 0; _h < 2; ++_h) _Pragma("unroll") for (int _i = 0; _i < 2; ++_i) { \
        int _R, _C; { int _t = tid; asm volatile("" : "+v"(_t)); stage_rc(_t * 16, _R, _C); } const int _row = g.rowmap[(u).pm * BM + _h * HALF + _R + 64 * _i]; dst[_h][_i] = (unsigned)(_row * K + _C) * 2u; } } while (0)
    Unit cur, nxt; int ui = 0;
    if (!S.next(0, cur)) return;
    f32x4 acc[2][2][4][2];
#pragma unroll
    for (int a = 0; a < 2; ++a)
#pragma unroll
        for (int b = 0; b < 2; ++b)
#pragma unroll
            for (int m = 0; m < 4; ++m)
#pragma unroll
                for (int n = 0; n < 2; ++n) acc[a][b][m][n] = (f32x4){0.f, 0.f, 0.f, 0.f};
    bf16x8 At[4][2], B0[2][2], B1[2][2];
    unsigned offC[2][2] = {{0u, 0u}, {0u, 0u}};
    LAS u32x4* offslot = (LAS u32x4*)(lds + STAGE_BYTES) + tid;
    const char* cA = (const char*)g.A + (GATHER ? (size_t)0 : (size_t)cur.pm * tstep); const char* cB = (const char*)g.Bt + (size_t)cur.pn * tstep;
    const char* nA = cA;
    if constexpr (GATHER) { PG8_LOADOFF(offC, cur); }
    PG8_STAGE(PG8_SB(0, 0), cB, voffB); PG8_STAGE(PG8_SB(0, 1), cB + hstep, voffB); PG8_STAGE_A(PG8_SA(0, 0), 0, 0, false); PG8_STAGE_A(PG8_SA(0, 1), 0, 1, false);
    if (wr == 1) PG8_BAR;
    PG8_WAIT_V(2); PG8_BAR;
    PG8_STAGE(PG8_SB(1, 0), cB + kstep, voffB); PG8_STAGE_A(PG8_SA(1, 0), kstep, 0, false); PG8_STAGE(PG8_SB(1, 1), cB + hstep + kstep, voffB);
    PG8_WAIT_V(6); PG8_BAR;
    for (;;) {
        const bool has_next = S.next(ui + 1, nxt);
        nA = has_next ? (const char*)g.A + (GATHER ? (size_t)0 : (size_t)nxt.pm * tstep) : cA; const char* nB = has_next ? (const char*)g.Bt + (size_t)nxt.pn * tstep : cB;
        if constexpr (GATHER) { unsigned offN[2][2];
            if (has_next) { PG8_LOADOFF(offN, nxt); } else {
#pragma unroll
                for (int h = 0; h < 2; ++h) { offN[h][0] = offC[h][0]; offN[h][1] = offC[h][1]; } }
            *offslot = (u32x4){offN[0][0], offN[0][1], offN[1][0], offN[1][1]}; }
#pragma unroll 1
        for (int t = 0; t < nt; t += 2) {
            const bool last = (t == nt - 2);
            const size_t k1 = (size_t)(t + 1) * kstep;
            const size_t k2 = last ? (size_t)0 : (size_t)(t + 2) * kstep, k3 = k2 + kstep;
            const char* b2 = last ? nB : cB + (size_t)(t + 2) * kstep; const char* b3 = b2 + kstep;
            PG8_LDB(B0, 0, 0); PG8_LDB(B1, 0, 1); PG8_SCHED; PG8_LDA(At, 0, 0); PG8_STAGE_A(PG8_SA(1, 1), k1, 1, false);
            if constexpr (GATHER) { if (last) { const u32x4 o_ = *offslot; offC[0][0] = o_.x; offC[0][1] = o_.y; offC[1][0] = o_.z; offC[1][1] = o_.w; } }
            PG8_WAIT_V(8); PG8_WAIT_L(0); PG8_BAR; PG8_MMA(0, 0, At, B0); PG8_MMA(0, 1, At, B1); PG8_BAR; PG8_SCHED;
            PG8_LDA(At, 0, 1); PG8_STAGE(PG8_SB(0, 0), b2, voffB); PG8_STAGE(PG8_SB(0, 1), b2 + hstep, voffB); PG8_STAGE_A(PG8_SA(0, 0), k2, 0, last);
            PG8_WAIT_V(8); PG8_WAIT_L(0); PG8_BAR; PG8_MMA(1, 0, At, B0); PG8_MMA(1, 1, At, B1); PG8_BAR; PG8_SCHED;
            PG8_LDB(B0, 1, 0); PG8_LDB(B1, 1, 1); PG8_SCHED; PG8_LDA(At, 1, 0); PG8_STAGE_A(PG8_SA(0, 1), k2, 1, last);
            PG8_WAIT_V(8); PG8_WAIT_L(0); PG8_BAR; PG8_MMA(0, 0, At, B0); PG8_MMA(0, 1, At, B1); PG8_BAR; PG8_SCHED;
            PG8_LDA(At, 1, 1); PG8_STAGE(PG8_SB(1, 0), b3, voffB); PG8_STAGE(PG8_SB(1, 1), b3 + hstep, voffB); PG8_STAGE_A(PG8_SA(1, 0), k3, 0, last);
            PG8_WAIT_V(8); PG8_WAIT_L(0); PG8_BAR; PG8_MMA(1, 0, At, B0); PG8_MMA(1, 1, At, B1); PG8_BAR; PG8_SCHED;
        }
        if (wr == 0) PG8_BAR;
        asm volatile("s_nop 15\n\ts_nop 15" ::: "memory");
        { unsigned m_ = ~0u; asm volatile("" : "+s"(m_)); const int ln_ = (int)__builtin_amdgcn_mbcnt_hi(m_, __builtin_amdgcn_mbcnt_lo(m_, 0u));
          E(acc, cur, wr, wc, ln_ & 15, ln_ >> 4); }
        if (!has_next) break;
#pragma unroll
        for (int a = 0; a < 2; ++a)
#pragma unroll
            for (int b = 0; b < 2; ++b)
#pragma unroll
                for (int m = 0; m < 4; ++m)
#pragma unroll
                    for (int n = 0; n < 2; ++n) acc[a][b][m][n] = (f32x4){0.f, 0.f, 0.f, 0.f};
        cur = nxt; cA = nA; cB = nB; ++ui;
        if (wr == 1) PG8_BAR;
    }
    PG8_WAIT_V(0);
    PG8_BAR;
#undef PG8_SA
#undef PG8_SB
#undef PG8_STAGE
#undef PG8_STAGE2
#undef PG8_STAGE_A
#undef PG8_LDA
#undef PG8_LDB
#undef PG8_MMA
#undef PG8_WAIT_V
#undef PG8_WAIT_L
#undef PG8_BAR
#undef PG8_SCHED
#undef PG8_LOADOFF
}
}
#define XB_TMO      128
#define XB_XCNT(j)  (256  + 64 * (j))
#define XB_XSUB(j)  (1280 + 64 * (j))
#define XB_XGEN(j)  (2304 + 64 * (j))
#define XB_TOP      3328
#define XB_TOPGEN   3392
#define XCD_BAR_WORDS 3456
#define XB_SPIN_CAP (1u << 18)

__device__ __forceinline__ unsigned xb_ld(unsigned* p)              { return __hip_atomic_load(p, __ATOMIC_RELAXED, __HIP_MEMORY_SCOPE_AGENT); }
__device__ __forceinline__ unsigned xb_add(unsigned* p, unsigned v) { return __hip_atomic_fetch_add(p, v, __ATOMIC_RELAXED, __HIP_MEMORY_SCOPE_AGENT); }
__device__ __forceinline__ unsigned xb_xcc_id() { return (unsigned)__builtin_amdgcn_s_getreg((3 << 11) | 20) & 0xFu; }
#define XB_SPIN(cond, bar) do { unsigned _sp = 0; while (cond) { __builtin_amdgcn_s_sleep(1); \
    if ((++_sp & 255u) == 0u) { if (xb_ld(&(bar)[XB_TMO])) break; if (_sp > XB_SPIN_CAP) { atomicAdd(&(bar)[XB_TMO], 1u); break; } } } } while (0)

struct XcdBarrier {
    unsigned* bar; unsigned x;
    volatile LAS unsigned* st;
};

__device__ __forceinline__ XcdBarrier xcd_barrier_post(unsigned* bar, volatile LAS unsigned* st) {
    XcdBarrier b; b.bar = bar; b.x = xb_xcc_id(); b.st = st;
    if (threadIdx.x == 0) (void)xb_add(&bar[XB_XCNT(b.x)], 1u);
    return b;
}
__device__ __forceinline__ void xcd_barrier_complete(unsigned* bar, unsigned x, unsigned& nloc, unsigned& nx) {
    const unsigned G = gridDim.x * gridDim.y * gridDim.z;
    unsigned sum, cnt, mine, sp = 0u;
    for (;;) {
        sum = 0u; cnt = 0u; mine = 0u;
#pragma unroll
        for (unsigned j = 0; j < 16; ++j) { const unsigned c = xb_ld(&bar[XB_XCNT(j)]); sum += c; cnt += (c > 0u) ? 1u : 0u; mine = (j == x) ? c : mine; }
        if (sum == G) break;
        __builtin_amdgcn_s_sleep(1);
        if ((++sp & 255u) == 0u) { if (xb_ld(&bar[XB_TMO])) break; if (sp > XB_SPIN_CAP) { atomicAdd(&bar[XB_TMO], 1u); break; } }
    }
    nloc = mine > 0u ? mine : 1u; nx = cnt > 0u ? cnt : 1u;
}

__device__ __forceinline__ void xcd_barrier(const XcdBarrier& b, const bool leader) {
    asm volatile("s_waitcnt vmcnt(0)" ::: "memory");
    __syncthreads();
    if (leader) {
        unsigned* bar = b.bar;
        __builtin_amdgcn_s_waitcnt(0);
        unsigned nloc = b.st[0], nx = b.st[1];
        if (nloc == 0u) { xcd_barrier_complete(bar, b.x, nloc, nx); b.st[0] = nloc; b.st[1] = nx; }
        const unsigned old = xb_add(&bar[XB_XSUB(b.x)], 1u);
        const unsigned gen = old / nloc;
        if (old + 1u == (gen + 1u) * nloc) {
            __builtin_amdgcn_fence(__ATOMIC_RELEASE, "agent");
            asm volatile("s_waitcnt vmcnt(0)" ::: "memory");
            const unsigned og = xb_add(&bar[XB_TOP], 1u);
            const unsigned tg = og / nx;
            if (og + 1u == (tg + 1u) * nx) xb_add(&bar[XB_TOPGEN], 1u);
            else XB_SPIN(xb_ld(&bar[XB_TOPGEN]) == tg, bar);
            __builtin_amdgcn_fence(__ATOMIC_ACQUIRE, "agent");
            xb_add(&bar[XB_XGEN(b.x)], 1u);
            asm volatile("s_waitcnt vmcnt(0)" ::: "memory");
        } else {
            XB_SPIN(xb_ld(&bar[XB_XGEN(b.x)]) == gen, bar);
            __builtin_amdgcn_fence(__ATOMIC_ACQUIRE, "agent");
            asm volatile("s_waitcnt vmcnt(0)" ::: "memory");
        }
    }
    __syncthreads();
}
struct Frame {
    LAS unsigned char* lds;
    unsigned* ctl;
    unsigned char* ws;
    int tid, lane, wave, bid, G;
    float* out;
};
enum InIdx { I_X = 0, I_POS, I_ATTN_NORM, I_W_IN, I_SINKS, I_SWA_ON, I_GLA_WA2, I_GLA_BA, I_GLA_ON, I_SB_ON, I_MU, I_W0, I_W2, I_A0, I_A2, I_G2, I_KK, I_KA, I_RK, I_LNW, I_LNB,
             I_W_OUT, I_FFN_NORM, I_FFN_W1, I_FFN_W3, I_FFN_W2, I_ROUTER, I_MOE_W1, I_MOE_W3, I_MOE_W2, I_FINAL_NORM, N_IN };
constexpr int PTR_OFF = MISC_OFF + 64;
__device__ __forceinline__ const void* in_ptr(const Frame& F, int i) {
    const unsigned long long v = ((const LAS unsigned long long*)(F.lds + PTR_OFF))[i];
    const unsigned lo = __builtin_amdgcn_readfirstlane((unsigned)v), hi = __builtin_amdgcn_readfirstlane((unsigned)(v >> 32));
    return (const void*)(GAS const void*)(((unsigned long long)hi << 32) | lo);
}
#define INF(F, i) ((const float*)in_ptr(F, i))

template <class Map>
__device__ __forceinline__ void transpose_item(const float* W, int K, int N, bf16_t* WT, const Map& dst, LAS float* scr, int item, int lane) {
    const int nblk = (N + 31) / 32, kb = item / nblk, nb = item % nblk, k0 = 64 * kb, n0 = 32 * nb;
    const int nl = n0 + (lane & 31);
#pragma unroll 8
    for (int i = 0; i < 32; ++i) { const int kk = 2 * i + (lane >> 5); scr[kk * 33 + (lane & 31)] = (nl < N) ? W[(size_t)(k0 + kk) * N + nl] : 0.f; }
    asm volatile("s_waitcnt lgkmcnt(0)" ::: "memory");
    const int c = lane & 7;
#pragma unroll
    for (int j = 0; j < 4; ++j) { const int n = (lane >> 3) + 8 * j; const LAS float* s = scr + (8 * c) * 33 + n;
        u32x4 o; o.x = pk2(s[0 * 33], s[1 * 33]); o.y = pk2(s[2 * 33], s[3 * 33]); o.z = pk2(s[4 * 33], s[5 * 33]); o.w = pk2(s[6 * 33], s[7 * 33]);
        if (n0 + n < N) *(u32x4*)(WT + (size_t)dst(n0 + n) * K + k0 + 8 * c) = o; }
    asm volatile("s_waitcnt lgkmcnt(0)" ::: "memory");
}
__device__ __forceinline__ unsigned pk4_fp8(float a, float b, float c, float d) { unsigned w = 0u; w = __builtin_amdgcn_cvt_pk_fp8_f32(a, b, w, false); w = __builtin_amdgcn_cvt_pk_fp8_f32(c, d, w, true); return w; }
template <class Map>
__device__ __forceinline__ void transpose_item8(const float* W, int K, int N, unsigned char* WT, const Map& dst, LAS float* scr, int item, int lane, int pitch = 0) {
    const int nblk = (N + 31) / 32, kb = item / nblk, nb = item % nblk, k0 = 64 * kb, n0 = 32 * nb;
    const int nl = n0 + (lane & 31);
#pragma unroll 8
    for (int i = 0; i < 32; ++i) { const int kk = 2 * i + (lane >> 5); scr[kk * 33 + (lane & 31)] = (nl < N) ? W[(size_t)(k0 + kk) * N + nl] * 64.f : 0.f; }
    asm volatile("s_waitcnt lgkmcnt(0)" ::: "memory");
    const int c = lane & 7;
#pragma unroll
    for (int j = 0; j < 4; ++j) { const int n = (lane >> 3) + 8 * j; const LAS float* s = scr + (8 * c) * 33 + n;
        u32x2 o; o.x = pk4_fp8(s[0 * 33], s[1 * 33], s[2 * 33], s[3 * 33]); o.y = pk4_fp8(s[4 * 33], s[5 * 33], s[6 * 33], s[7 * 33]);
        if (n0 + n < N) *(u32x2*)(WT + (size_t)dst(n0 + n) * (pitch ? pitch : K) + k0 + 8 * c) = o; }
    asm volatile("s_waitcnt lgkmcnt(0)" ::: "memory");
}
struct MapIn { __device__ int operator()(int n) const { return n < 1280 ? n : (n < 1296 ? 3072 + (n - 1280) : n - 16); } };
struct MapId { int off; __device__ int operator()(int n) const { return off + n; } };
struct MapGU { int off; __device__ int operator()(int n) const { return off + 256 * (n >> 7) + (n & 127); } };

__device__ __forceinline__ void phase_convert_weights(Frame& F, int l) {
    LAS float* scr = (LAS float*)(F.lds + F.wave * 16384);
    const int gw = F.bid * 8 + F.wave, NGW = F.G * 8;
    bf16_t* WIN = (bf16_t*)(F.ws + WS_WIN); bf16_t* WOUT = (bf16_t*)(F.ws + WS_WOUT); bf16_t* W13 = (bf16_t*)(F.ws + WS_W13); bf16_t* W2 = (bf16_t*)(F.ws + WS_W2);
    const bool moe = (l & 1) != 0; const int li = l >> 1;
    const int I_IN = (DM / 64) * ((IN_COLS + 31) / 32), I_OUT = (DM / 64) * (DM / 32);
    const int I_UP = moe ? (DM / 64) * (D_FFE / 32) : (DM / 64) * (D_FF / 32);
    const int I_DN = moe ? (D_FFE / 64) * (DM / 32) : (D_FF / 64) * (DM / 32);
    const int NE = moe ? N_EXP : 1;
    const int total = I_IN + I_OUT + NE * (2 * I_UP + I_DN);
    for (int it = gw; it < total; it += NGW) {
        int r = it;
        if (r < I_IN) { transpose_item(INF(F, I_W_IN) + (size_t)l * DM * IN_COLS, DM, IN_COLS, WIN, MapIn{}, scr, r, F.lane); continue; } r -= I_IN;
        if (r < I_OUT) { transpose_item(INF(F, I_W_OUT) + (size_t)l * DM * DM, DM, DM, WOUT, MapId{0}, scr, r, F.lane); continue; } r -= I_OUT;
        const int per_e = 2 * I_UP + I_DN, e = r / per_e; r -= e * per_e;
        if (!moe) {
            if (r < I_UP) { transpose_item8(INF(F, I_FFN_W1) + (size_t)li * DM * D_FF, DM, D_FF, (unsigned char*)W13, MapGU{0}, scr, r, F.lane); continue; } r -= I_UP;
            if (r < I_UP) { transpose_item8(INF(F, I_FFN_W3) + (size_t)li * DM * D_FF, DM, D_FF, (unsigned char*)W13, MapGU{128}, scr, r, F.lane); continue; } r -= I_UP;
            transpose_item8(INF(F, I_FFN_W2) + (size_t)li * D_FF * DM, D_FF, DM, (unsigned char*)W2, MapId{0}, scr, r, F.lane);
        } else {
            const size_t eo = (size_t)(li * N_EXP + e);
            if (r < I_UP) { transpose_item8(INF(F, I_MOE_W1) + eo * DM * D_FFE, DM, D_FFE, (unsigned char*)W13, MapGU{e * 2 * D_FFE}, scr, r, F.lane); continue; } r -= I_UP;
            if (r < I_UP) { transpose_item8(INF(F, I_MOE_W3) + eo * DM * D_FFE, DM, D_FFE, (unsigned char*)W13, MapGU{e * 2 * D_FFE + 128}, scr, r, F.lane); continue; } r -= I_UP;
            transpose_item8(INF(F, I_MOE_W2) + eo * D_FFE * DM, D_FFE, DM, (unsigned char*)W2, MapId{e * DM}, scr, r, F.lane, KP8);
        }
    }
    if (moe) {
        unsigned zz = 0u; asm volatile("" : "+v"(zz));
        for (int i = F.bid * 512 + F.tid; i < N_EXP * DM * ((KP8 - D_FFE) / 16); i += F.G * 512) { const int row = i >> 3, c = i & 7; *(u32x4*)((unsigned char*)W2 + (size_t)row * KP8 + D_FFE + 16 * c) = (u32x4){zz, zz, zz, zz}; }
    }
}

__device__ __forceinline__ void phase_rope_tables(Frame& F) {
    float* C = (float*)(F.ws + WS_ROPE_C); float* S = (float*)(F.ws + WS_ROPE_S); const int* pos = (const int*)in_ptr(F, I_POS);
    for (int idx = F.bid * 512 + F.tid; idx < NTOK * 32; idx += F.G * 512) {
        const int tok = idx >> 5, i = idx & 31;
        const float invf = exp2f(-(float)(2 * i) * (13.287712379549449f / 64.f));
        const float angf = (float)pos[tok] * invf;
        const double a = (double)angf;
        const double n = rint(a * 0.15915494309189535);
        const double r = a - n * 6.283185307179586;
        const double r2 = r * r;
        double s = -1.0 / 51090942171709440000.0;
        s = s * r2 + 1.0 / 121645100408832000.0;  s = s * r2 - 1.0 / 355687428096000.0; s = s * r2 + 1.0 / 1307674368000.0; s = s * r2 - 1.0 / 6227020800.0;
        s = s * r2 + 1.0 / 39916800.0; s = s * r2 - 1.0 / 362880.0; s = s * r2 + 1.0 / 5040.0; s = s * r2 - 1.0 / 120.0; s = s * r2 + 1.0 / 6.0; s = s * r2 - 1.0; s = -s * r;
        double c = 1.0 / 1124000727777607680000.0;
        c = c * r2 - 1.0 / 2432902008176640000.0; c = c * r2 + 1.0 / 6402373705728000.0; c = c * r2 - 1.0 / 20922789888000.0; c = c * r2 + 1.0 / 87178291200.0;
        c = c * r2 - 1.0 / 479001600.0; c = c * r2 + 1.0 / 3628800.0; c = c * r2 - 1.0 / 40320.0; c = c * r2 + 1.0 / 720.0; c = c * r2 - 1.0 / 24.0; c = c * r2 + 0.5; c = 1.0 - c * r2;
        C[idx] = (float)c; S[idx] = (float)s;
    }
}

template <int MODE, bool XF32>
__device__ __forceinline__ void phase_norm(Frame& F, const void* xin, const float* gain, bool comb, int moe_slot) {
    bf16_t* HB = (bf16_t*)(F.ws + WS_H); bf16_t* XB = (bf16_t*)((unsigned char*)F.out + XB_OFF);
    const bf16_t* Y = (const bf16_t*)(F.ws + WS_Y);
    const int* TOK_ROW = (const int*)(F.ws + WS_TOK_ROW); const float* TOK_G = (const float*)(F.ws + WS_TOK_G);
    LAS float* rts = (LAS float*)F.lds;
    LAS int* te = (LAS int*)(F.lds + 32768);
    LAS float* tg = (LAS float*)(F.lds + 32768 + 1024);
    LAS int* tl = (LAS int*)(F.lds + 32768 + 2048);
    LAS int* lcnt = (LAS int*)(F.lds + 32768 + 3072);
    if (MODE == 1) {
        const float* router = INF(F, I_ROUTER) + (size_t)moe_slot * DM * N_EXP;
        for (int i = F.tid; i < DM * N_EXP; i += 512) { const int c = i >> 3, e = i & 7; rts[e * DM + c] = router[i]; }
        if (F.tid < 16) lcnt[F.tid] = 0;
        __syncthreads();
    }
    f32x4 gv[2][2];
#pragma unroll
    for (int j = 0; j < 2; ++j) { gv[j][0] = *(const f32x4*)(gain + 8 * F.lane + 512 * j); gv[j][1] = *(const f32x4*)(gain + 8 * F.lane + 512 * j + 4); }
    for (int rr = 0; rr < 16; ++rr) {
        const int rloc = F.wave * 16 + rr; const int row = F.bid * 128 + rloc;
        if (row >= NTOK) break;
        float v[2][8];
#pragma unroll
        for (int j = 0; j < 2; ++j) {
            if (XF32) { const float* xr = (const float*)xin + (size_t)row * DM + 8 * F.lane + 512 * j; const f32x4 a = *(const f32x4*)xr, b = *(const f32x4*)(xr + 4);
                v[j][0] = a[0]; v[j][1] = a[1]; v[j][2] = a[2]; v[j][3] = a[3]; v[j][4] = b[0]; v[j][5] = b[1]; v[j][6] = b[2]; v[j][7] = b[3]; }
            else { const u32x4 w = *(const u32x4*)((const bf16_t*)xin + (size_t)row * DM + 8 * F.lane + 512 * j);
                v[j][0] = bflo(w.x); v[j][1] = bfhi(w.x); v[j][2] = bflo(w.y); v[j][3] = bfhi(w.y); v[j][4] = bflo(w.z); v[j][5] = bfhi(w.z); v[j][6] = bflo(w.w); v[j][7] = bfhi(w.w); } }
        if (comb) {
            const int r0 = TOK_ROW[row * 2], r1 = TOK_ROW[row * 2 + 1]; const float g0 = TOK_G[row * 2], g1 = TOK_G[row * 2 + 1];
#pragma unroll
            for (int j = 0; j < 2; ++j) {
                const u32x4 a = *(const u32x4*)(Y + (size_t)r0 * DM + 8 * F.lane + 512 * j), b = *(const u32x4*)(Y + (size_t)r1 * DM + 8 * F.lane + 512 * j);
                v[j][0] += g0 * bflo(a.x) + g1 * bflo(b.x); v[j][1] += g0 * bfhi(a.x) + g1 * bfhi(b.x); v[j][2] += g0 * bflo(a.y) + g1 * bflo(b.y); v[j][3] += g0 * bfhi(a.y) + g1 * bfhi(b.y);
                v[j][4] += g0 * bflo(a.z) + g1 * bflo(b.z); v[j][5] += g0 * bfhi(a.z) + g1 * bfhi(b.z); v[j][6] += g0 * bflo(a.w) + g1 * bflo(b.w); v[j][7] += g0 * bfhi(a.w) + g1 * bfhi(b.w);
                if (MODE != 2) { u32x4 o; o.x = pk2(v[j][0], v[j][1]); o.y = pk2(v[j][2], v[j][3]); o.z = pk2(v[j][4], v[j][5]); o.w = pk2(v[j][6], v[j][7]); *(u32x4*)(XB + (size_t)row * DM + 8 * F.lane + 512 * j) = o; }
            }
        }
        float ss = 0.f;
#pragma unroll
        for (int j = 0; j < 2; ++j)
#pragma unroll
            for (int i = 0; i < 8; ++i) ss += v[j][i] * v[j][i];
        const float rstd = rsqrtf(wave_sum(ss) * (1.f / DM) + NORM_EPS);
#pragma unroll
        for (int j = 0; j < 2; ++j)
#pragma unroll
            for (int i = 0; i < 8; ++i) v[j][i] = v[j][i] * rstd * gv[j][i >> 2][i & 3];
        if (MODE == 2) {
            float* dst = (row < NTOK / 2) ? F.out + (size_t)row * DM : (float*)(F.ws + WS_PROJ) + (size_t)(row - NTOK / 2) * DM;
#pragma unroll
            for (int j = 0; j < 2; ++j) { *(f32x4*)(dst + 8 * F.lane + 512 * j) = (f32x4){v[j][0], v[j][1], v[j][2], v[j][3]}; *(f32x4*)(dst + 8 * F.lane + 512 * j + 4) = (f32x4){v[j][4], v[j][5], v[j][6], v[j][7]}; }
        } else {
#pragma unroll
            for (int j = 0; j < 2; ++j) {
                if (MODE == 0 || MODE == 1) { u32x2 o; o.x = pk4_fp8(v[j][0], v[j][1], v[j][2], v[j][3]); o.y = pk4_fp8(v[j][4], v[j][5], v[j][6], v[j][7]); *(u32x2*)((unsigned char*)HB + (size_t)row * DM + 8 * F.lane + 512 * j) = o; }
                else { u32x4 o; o.x = pk2(v[j][0], v[j][1]); o.y = pk2(v[j][2], v[j][3]); o.z = pk2(v[j][4], v[j][5]); o.w = pk2(v[j][6], v[j][7]); *(u32x4*)(HB + (size_t)row * DM + 8 * F.lane + 512 * j) = o; } }
        }
        if (MODE == 1) {
            float lg[8];
#pragma unroll
            for (int e = 0; e < 8; ++e) { float a = 0.f;
#pragma unroll
                for (int j = 0; j < 2; ++j) { const f32x4 w0 = *(const LAS f32x4*)(rts + e * DM + 8 * F.lane + 512 * j), w1 = *(const LAS f32x4*)(rts + e * DM + 8 * F.lane + 512 * j + 4);
                    a += (v[j][0] * w0[0] + v[j][1] * w0[1]) + (v[j][2] * w0[2] + v[j][3] * w0[3]) + (v[j][4] * w1[0] + v[j][5] * w1[1]) + (v[j][6] * w1[2] + v[j][7] * w1[3]); }
                lg[e] = wave_sum(a); }
            int i0 = 0; float v0 = lg[0];
#pragma unroll
            for (int e = 1; e < 8; ++e) if (lg[e] > v0) { v0 = lg[e]; i0 = e; }
            int i1 = -1; float v1 = -3.0e38f;
#pragma unroll
            for (int e = 0; e < 8; ++e) if (e != i0 && lg[e] > v1) { v1 = lg[e]; i1 = e; }
            const float g0 = 1.f / (1.f + __expf(v1 - v0));
            if (F.lane == 0) { te[rloc * 2] = i0; te[rloc * 2 + 1] = i1; tg[rloc * 2] = g0; tg[rloc * 2 + 1] = 1.f - g0; }
        }
    }
    if (MODE == 1) {
        __syncthreads();
        int e = 0, li = 0;
        if (F.tid < 256) { e = te[F.tid]; li = atomicAdd((int*)&lcnt[e], 1); tl[F.tid] = li; }
        __syncthreads();
        if (F.tid < 8) lcnt[8 + F.tid] = (int)atomicAdd(F.ctl + CW_MOECNT + 64 * moe_slot + F.tid, (unsigned)lcnt[F.tid]);
        __syncthreads();
        if (F.tid < 256) {
            const int tok = F.bid * 128 + (F.tid >> 1), k = F.tid & 1;
            ((int*)(F.ws + WS_TOK_E))[tok * 2 + k] = e;
            ((int*)(F.ws + WS_TOK_SLOT))[tok * 2 + k] = lcnt[8 + e] + li;
            ((float*)(F.ws + WS_TOK_G))[tok * 2 + k] = tg[F.tid];
        }
    }
}
constexpr int NL_PITCH = 1032;
template <bool XF32, bool COMB>
__device__ __forceinline__ void phase_norm_lr(Frame& F, const void* xin, const float* gain, int l) {
    bf16_t* HB = (bf16_t*)(F.ws + WS_H); bf16_t* XB = (bf16_t*)((unsigned char*)F.out + XB_OFF); bf16_t* PROJ = (bf16_t*)(F.ws + WS_PROJ);
    const bf16_t* Y = (const bf16_t*)(F.ws + WS_Y);
    const int* TOK_ROW = (const int*)(F.ws + WS_TOK_ROW); const float* TOK_G = (const float*)(F.ws + WS_TOK_G);
    LAS bf16_t* WL = (LAS bf16_t*)F.lds;
    LAS float* GL = (LAS float*)(F.lds + 16 * NL_PITCH * 2);
    __syncthreads();
    { const float* wl = INF(F, I_W_IN) + (size_t)l * DM * IN_COLS + 1280;
#pragma unroll 1
      for (int c = F.tid; c < DM; c += 512) { const float* p = wl + (size_t)c * IN_COLS;
          const f32x4 a = *(const f32x4*)p, b = *(const f32x4*)(p + 4), cc = *(const f32x4*)(p + 8), d = *(const f32x4*)(p + 12);
#pragma unroll
          for (int j = 0; j < 4; ++j) { WL[j * NL_PITCH + c] = f2bf(a[j]); WL[(4 + j) * NL_PITCH + c] = f2bf(b[j]); WL[(8 + j) * NL_PITCH + c] = f2bf(cc[j]); WL[(12 + j) * NL_PITCH + c] = f2bf(d[j]); }
          GL[c] = gain[c]; } }
    __syncthreads();
    const int r16 = F.lane & 15, kq = F.lane >> 4;
    const int row = F.bid * 128 + F.wave * 16 + r16;
    u32x4 xs[32]; float ss = 0.f, sb = 0.f;
    if (XF32) {
        const float* xr = (const float*)xin + (size_t)row * DM + 8 * kq;
#pragma unroll
        for (int s = 0; s < 32; ++s) { const f32x4 a = *(const f32x4*)(xr + 32 * s), b = *(const f32x4*)(xr + 32 * s + 4);
            ss = __builtin_fmaf(a[0], a[0], ss); sb = __builtin_fmaf(a[1], a[1], sb); ss = __builtin_fmaf(a[2], a[2], ss); sb = __builtin_fmaf(a[3], a[3], sb); ss = __builtin_fmaf(b[0], b[0], ss); sb = __builtin_fmaf(b[1], b[1], sb); ss = __builtin_fmaf(b[2], b[2], ss); sb = __builtin_fmaf(b[3], b[3], sb);
            xs[s].x = pg8::cvt_pk_c(a[0], a[1]); xs[s].y = pg8::cvt_pk_c(a[2], a[3]); xs[s].z = pg8::cvt_pk_c(b[0], b[1]); xs[s].w = pg8::cvt_pk_c(b[2], b[3]);
            if ((s & 7) == 7) __builtin_amdgcn_sched_barrier(0); }
    } else if (!COMB) {
        const bf16_t* xr = (const bf16_t*)xin + (size_t)row * DM + 8 * kq;
#pragma unroll
        for (int s = 0; s < 32; ++s) xs[s] = *(const u32x4*)(xr + 32 * s);
#pragma unroll
        for (int s = 0; s < 32; ++s) { const u32x4 w = xs[s];
            ss = __builtin_fmaf(bflo(w.x), bflo(w.x), ss); sb = __builtin_fmaf(bfhi(w.x), bfhi(w.x), sb); ss = __builtin_fmaf(bflo(w.y), bflo(w.y), ss); sb = __builtin_fmaf(bfhi(w.y), bfhi(w.y), sb);
            ss = __builtin_fmaf(bflo(w.z), bflo(w.z), ss); sb = __builtin_fmaf(bfhi(w.z), bfhi(w.z), sb); ss = __builtin_fmaf(bflo(w.w), bflo(w.w), ss); sb = __builtin_fmaf(bfhi(w.w), bfhi(w.w), sb); }
    } else {
        const int r0 = TOK_ROW[row * 2], r1 = TOK_ROW[row * 2 + 1]; const float g0 = TOK_G[row * 2], g1 = TOK_G[row * 2 + 1];
        const bf16_t* xr = (const bf16_t*)xin + (size_t)row * DM + 8 * kq; const bf16_t* ya = Y + (size_t)r0 * DM + 8 * kq; const bf16_t* yb = Y + (size_t)r1 * DM + 8 * kq;
        bf16_t* xo = XB + (size_t)row * DM + 8 * kq;
#pragma unroll
        for (int s = 0; s < 32; ++s) { const u32x4 w = *(const u32x4*)(xr + 32 * s), a = *(const u32x4*)(ya + 32 * s), b = *(const u32x4*)(yb + 32 * s);
            float v[8];
            v[0] = bflo(w.x) + g0 * bflo(a.x) + g1 * bflo(b.x); v[1] = bfhi(w.x) + g0 * bfhi(a.x) + g1 * bfhi(b.x); v[2] = bflo(w.y) + g0 * bflo(a.y) + g1 * bflo(b.y); v[3] = bfhi(w.y) + g0 * bfhi(a.y) + g1 * bfhi(b.y);
            v[4] = bflo(w.z) + g0 * bflo(a.z) + g1 * bflo(b.z); v[5] = bfhi(w.z) + g0 * bfhi(a.z) + g1 * bfhi(b.z); v[6] = bflo(w.w) + g0 * bflo(a.w) + g1 * bflo(b.w); v[7] = bfhi(w.w) + g0 * bfhi(a.w) + g1 * bfhi(b.w);
#pragma unroll
            for (int j = 0; j < 8; j += 2) { ss = __builtin_fmaf(v[j], v[j], ss); sb = __builtin_fmaf(v[j + 1], v[j + 1], sb); }
            xs[s].x = pg8::cvt_pk_c(v[0], v[1]); xs[s].y = pg8::cvt_pk_c(v[2], v[3]); xs[s].z = pg8::cvt_pk_c(v[4], v[5]); xs[s].w = pg8::cvt_pk_c(v[6], v[7]);
            *(u32x4*)(xo + 32 * s) = xs[s];
            if ((s & 1) == 1) __builtin_amdgcn_sched_barrier(0); }
    }
    ss += sb; ss += __shfl_xor(ss, 16); ss += __shfl_xor(ss, 32);
    const float rstd = rsqrtf(ss * (1.f / DM) + NORM_EPS);
#pragma unroll
    for (int s = 0; s < 32; ++s) asm volatile("" : "+v"(xs[s].x), "+v"(xs[s].y), "+v"(xs[s].z), "+v"(xs[s].w));
    f32x4 acc = {0.f, 0.f, 0.f, 0.f};
    bf16_t* ho = HB + (size_t)row * DM + 8 * kq;
#pragma unroll
    for (int s = 0; s < 32; ++s) { const int c0 = 32 * s + 8 * kq; const f32x4 ga = *(const LAS f32x4*)(GL + c0), gb = *(const LAS f32x4*)(GL + c0 + 4); const u32x4 w = xs[s];
        u32x4 hw; hw.x = pg8::cvt_pk_c(bflo(w.x) * rstd * ga[0], bfhi(w.x) * rstd * ga[1]); hw.y = pg8::cvt_pk_c(bflo(w.y) * rstd * ga[2], bfhi(w.y) * rstd * ga[3]);
        hw.z = pg8::cvt_pk_c(bflo(w.z) * rstd * gb[0], bfhi(w.z) * rstd * gb[1]); hw.w = pg8::cvt_pk_c(bflo(w.w) * rstd * gb[2], bfhi(w.w) * rstd * gb[3]);
        *(u32x4*)(ho + 32 * s) = hw;
        acc = __builtin_amdgcn_mfma_f32_16x16x32_bf16(*(const LAS bf16x8*)(WL + r16 * NL_PITCH + c0), __builtin_bit_cast(bf16x8, hw), acc, 0, 0, 0);
        if ((s & 3) == 3) __builtin_amdgcn_sched_barrier(0); }
    { u32x2 o; o.x = pg8::cvt_pk_c(acc[0], acc[1]); o.y = pg8::cvt_pk_c(acc[2], acc[3]); *(u32x2*)(PROJ + (size_t)row * NPROJ + PB_LR + 4 * kq) = o; }
}
__device__ __forceinline__ void phase_final_copy(Frame& F) {
    const f32x4* src = (const f32x4*)(F.ws + WS_PROJ); f32x4* dst = (f32x4*)(F.out + (size_t)(NTOK / 2) * DM);
    for (int i = F.bid * 512 + F.tid; i < NTOK / 2 * DM / 4; i += F.G * 512) dst[i] = src[i];
}

__device__ __forceinline__ void moe_bases(const unsigned* cnt, int (&tb)[9]) {
    tb[0] = 0;
#pragma unroll
    for (int e = 0; e < 8; ++e) tb[e + 1] = tb[e] + __builtin_amdgcn_readfirstlane((int)((__hip_atomic_load(cnt + e, __ATOMIC_RELAXED, __HIP_MEMORY_SCOPE_AGENT) + 255u) >> 8));
}
__device__ __forceinline__ void phase_moe_map(Frame& F, int moe_slot) {
    int tb[9]; moe_bases(F.ctl + CW_MOECNT + 64 * moe_slot, tb);
    const int* TE = (const int*)(F.ws + WS_TOK_E); const int* TS = (const int*)(F.ws + WS_TOK_SLOT); int* TR = (int*)(F.ws + WS_TOK_ROW); int* RM = (int*)(F.ws + WS_ROWMAP);
    for (int a = F.bid * 512 + F.tid; a < NTOK * 2; a += F.G * 512) {
        const int e = TE[a]; int base = 0;
#pragma unroll
        for (int j = 0; j < 8; ++j) base = (e == j) ? tb[j] : base;
        const int row = base * 256 + TS[a]; TR[a] = row; RM[row] = a >> 1;
    }
    { unsigned zz = 0u; asm volatile("" : "+v"(zz)); unsigned char* A8 = F.ws + WS_PROJ;
      for (int i = F.bid * 512 + F.tid; i < tb[8] * 256 * ((KP8 - D_FFE) / 16); i += F.G * 512) { const int row = i >> 3, c = i & 7; *(u32x4*)(A8 + (size_t)row * KP8 + D_FFE + 16 * c) = (u32x4){zz, zz, zz, zz}; } }
    for (int i = F.bid * 512 + F.tid; i < N_EXP * 256; i += F.G * 512) {
        const int e = i >> 8, j = i & 255; int b0 = 0, b1 = 0;
#pragma unroll
        for (int q = 0; q < 8; ++q) { b0 = (e == q) ? tb[q] : b0; b1 = (e == q) ? tb[q + 1] : b1; }
        const int cnt = (int)__hip_atomic_load(F.ctl + CW_MOECNT + 64 * moe_slot + e, __ATOMIC_RELAXED, __HIP_MEMORY_SCOPE_AGENT);
        const int row = b0 * 256 + cnt + j; if (row < b1 * 256) RM[row] = 0;
    }
}
__device__ __forceinline__ void swa_unit(Frame& F, int l, int unit) {
    const bf16_t* P = (const bf16_t*)(F.ws + WS_PROJ); bf16_t* MIX = (bf16_t*)(F.ws + WS_MIX);
    const float* RC = (const float*)(F.ws + WS_ROPE_C); const float* RS = (const float*)(F.ws + WS_ROPE_S);
    const int qblk = unit & 31, kvh = (unit >> 5) & 1, b = unit >> 6;
    LAS float* Ks = (LAS float*)F.lds;
    LAS float* Vs = (LAS float*)(F.lds + 65536);
    const int tok0 = b * SEQ + qblk * 128;
    __syncthreads();
#pragma unroll 1
    for (int it = 0; it < 16; ++it) {
        const int idx = it * 512 + F.tid, j = idx >> 5, d = idx & 31; const int pos = qblk * 128 - 128 + j;
        float o1 = 0.f, o2 = 0.f;
        if (pos >= 0) { const int tok = b * SEQ + pos; const bf16_t* kp = P + (size_t)tok * NPROJ + PA_K + kvh * 64;
            const float k1 = bf2f(kp[d]), k2 = bf2f(kp[d + 32]), c = RC[tok * 32 + d], s = RS[tok * 32 + d]; o1 = k1 * c - k2 * s; o2 = k2 * c + k1 * s; }
        Ks[j * 64 + d] = o1; Ks[j * 64 + d + 32] = o2;
    }
#pragma unroll 1
    for (int it = 0; it < 32; ++it) {
        const int idx = it * 512 + F.tid, j = idx >> 6, d = idx & 63; const int pos = qblk * 128 - 128 + j;
        Vs[idx] = (pos >= 0) ? bf2f(P[(size_t)(b * SEQ + pos) * NPROJ + PA_V + kvh * 64 + d]) : 0.f;
    }
    const int part = F.tid >> 8, qv = F.tid & 255, g = qv >> 7, i = qv & 127, hq = kvh * 2 + g;
    const int tok = tok0 + i;
    float q[64];
    { const bf16_t* qp = P + (size_t)tok * NPROJ + PA_Q + hq * 64;
#pragma unroll
      for (int d = 0; d < 32; ++d) { const float q1 = bf2f(qp[d]), q2 = bf2f(qp[d + 32]), c = RC[tok * 32 + d], s = RS[tok * 32 + d]; q[d] = (q1 * c - q2 * s) * 0.125f; q[d + 32] = (q2 * c + q1 * s) * 0.125f; } }
    const float sink = INF(F, I_SINKS)[l * 4 + hq];
    float m = sink, lsum = (part == 0) ? 1.f : 0.f, acc[64];
#pragma unroll
    for (int d = 0; d < 64; ++d) acc[d] = 0.f;
    __syncthreads();
    for (int jj = 0; jj < 128; ++jj) {
        const int j = part * 128 + jj;
        const bool valid = (j > i) && (j <= i + 128) && (qblk > 0 || j >= 128);
        float s = 0.f;
#pragma unroll
        for (int d4 = 0; d4 < 16; ++d4) { const f32x4 kv = *(const LAS f32x4*)(Ks + j * 64 + d4 * 4); s += (q[d4 * 4] * kv[0] + q[d4 * 4 + 1] * kv[1]) + (q[d4 * 4 + 2] * kv[2] + q[d4 * 4 + 3] * kv[3]); }
        if (!valid) s = -INFINITY;
        const float mn = fmaxf(m, s), sc = __expf(m - mn), p = __expf(s - mn);
        lsum = lsum * sc + p; m = mn;
#pragma unroll
        for (int d4 = 0; d4 < 16; ++d4) { const f32x4 vv = *(const LAS f32x4*)(Vs + j * 64 + d4 * 4);
            acc[d4 * 4] = acc[d4 * 4] * sc + p * vv[0]; acc[d4 * 4 + 1] = acc[d4 * 4 + 1] * sc + p * vv[1]; acc[d4 * 4 + 2] = acc[d4 * 4 + 2] * sc + p * vv[2]; acc[d4 * 4 + 3] = acc[d4 * 4 + 3] * sc + p * vv[3]; }
    }
    __syncthreads();
    LAS float* MB = (LAS float*)F.lds;
    if (part == 1) { MB[qv * 66] = m; MB[qv * 66 + 1] = lsum;
#pragma unroll
        for (int d = 0; d < 64; ++d) MB[qv * 66 + 2 + d] = acc[d]; }
    __syncthreads();
    if (part == 0) {
        const float m1 = MB[qv * 66], l1 = MB[qv * 66 + 1]; const float M = fmaxf(m, m1), s0 = __expf(m - M), s1 = __expf(m1 - M);
        const float inv = 1.f / (lsum * s0 + l1 * s1); float ss = 0.f;
#pragma unroll
        for (int d = 0; d < 64; ++d) { acc[d] = (acc[d] * s0 + MB[qv * 66 + 2 + d] * s1) * inv; ss += acc[d] * acc[d]; }
        const float rstd = rsqrtf(ss * (1.f / 64.f) + NORM_EPS); const float* gn = INF(F, I_SWA_ON) + l * 256 + hq * 64;
        bf16_t* op = MIX + (size_t)tok * DM + hq * 64;
#pragma unroll
        for (int d8 = 0; d8 < 8; ++d8) { u32x4 w;
            w.x = pk2(acc[d8 * 8] * rstd * gn[d8 * 8], acc[d8 * 8 + 1] * rstd * gn[d8 * 8 + 1]); w.y = pk2(acc[d8 * 8 + 2] * rstd * gn[d8 * 8 + 2], acc[d8 * 8 + 3] * rstd * gn[d8 * 8 + 3]);
            w.z = pk2(acc[d8 * 8 + 4] * rstd * gn[d8 * 8 + 4], acc[d8 * 8 + 5] * rstd * gn[d8 * 8 + 5]); w.w = pk2(acc[d8 * 8 + 6] * rstd * gn[d8 * 8 + 6], acc[d8 * 8 + 7] * rstd * gn[d8 * 8 + 7]);
            *(u32x4*)(op + d8 * 8) = w; }
    }
}

__device__ __forceinline__ void sb_waveunit(Frame& F, int l, int wu) {
    const bf16_t* P = (const bf16_t*)(F.ws + WS_PROJ); bf16_t* MIX = (bf16_t*)(F.ws + WS_MIX);
    const int tb = wu & 63, h = (wu >> 6) & 3, b = wu >> 8;
    const int t0 = tb * 64, t = t0 + F.lane;
    float q[64], o[64];
    { const u32x4* qp = (const u32x4*)(P + (size_t)(b * SEQ + t) * NPROJ + PC_Q + h * 64);
#pragma unroll
      for (int d8 = 0; d8 < 8; ++d8) { const u32x4 w = qp[d8];
          q[d8 * 8] = bflo(w.x) * 0.125f; q[d8 * 8 + 1] = bfhi(w.x) * 0.125f; q[d8 * 8 + 2] = bflo(w.y) * 0.125f; q[d8 * 8 + 3] = bfhi(w.y) * 0.125f;
          q[d8 * 8 + 4] = bflo(w.z) * 0.125f; q[d8 * 8 + 5] = bfhi(w.z) * 0.125f; q[d8 * 8 + 6] = bflo(w.w) * 0.125f; q[d8 * 8 + 7] = bfhi(w.w) * 0.125f; } }
#pragma unroll
    for (int d = 0; d < 64; ++d) o[d] = 0.f;
    float R = 0.f;
    for (int s = t0 + 62; s >= 0; --s) {
        if (s < t0) { if (__all(R < -80.f)) break; }
        const size_t rowoff = (size_t)__builtin_amdgcn_readfirstlane(b * SEQ + s) * NPROJ;
        const u32x4* kp = (const u32x4*)(P + rowoff + PC_K + h * 64); const u32x4* vp = (const u32x4*)(P + rowoff + PC_V + h * 64);
        float z = 0.f;
#pragma unroll
        for (int d8 = 0; d8 < 8; ++d8) { const u32x4 w = kp[d8];
            z += (q[d8 * 8] * bflo(w.x) + q[d8 * 8 + 1] * bfhi(w.x)) + (q[d8 * 8 + 2] * bflo(w.y) + q[d8 * 8 + 3] * bfhi(w.y))
               + (q[d8 * 8 + 4] * bflo(w.z) + q[d8 * 8 + 5] * bfhi(w.z)) + (q[d8 * 8 + 6] * bflo(w.w) + q[d8 * 8 + 7] * bfhi(w.w)); }
        const bool valid = s < t;
        const float sp = softplus_f(z);
        const float p = valid ? __expf((z - sp) + R) : 0.f;
        R += valid ? -sp : 0.f;
#pragma unroll
        for (int d8 = 0; d8 < 8; ++d8) { const u32x4 w = vp[d8];
            o[d8 * 8] += p * bflo(w.x); o[d8 * 8 + 1] += p * bfhi(w.x); o[d8 * 8 + 2] += p * bflo(w.y); o[d8 * 8 + 3] += p * bfhi(w.y);
            o[d8 * 8 + 4] += p * bflo(w.z); o[d8 * 8 + 5] += p * bfhi(w.z); o[d8 * 8 + 6] += p * bflo(w.w); o[d8 * 8 + 7] += p * bfhi(w.w); }
    }
    float ss = 0.f;
#pragma unroll
    for (int d = 0; d < 64; ++d) ss += o[d] * o[d];
    const float rstd = rsqrtf(ss * (1.f / 64.f) + NORM_EPS); const float* gn = INF(F, I_SB_ON) + l * 256 + h * 64;
    bf16_t* op = MIX + (size_t)(b * SEQ + t) * DM + 512 + h * 64;
#pragma unroll
    for (int d8 = 0; d8 < 8; ++d8) { u32x4 w;
        w.x = pk2(o[d8 * 8] * rstd * gn[d8 * 8], o[d8 * 8 + 1] * rstd * gn[d8 * 8 + 1]); w.y = pk2(o[d8 * 8 + 2] * rstd * gn[d8 * 8 + 2], o[d8 * 8 + 3] * rstd * gn[d8 * 8 + 3]);
        w.z = pk2(o[d8 * 8 + 4] * rstd * gn[d8 * 8 + 4], o[d8 * 8 + 5] * rstd * gn[d8 * 8 + 5]); w.w = pk2(o[d8 * 8 + 6] * rstd * gn[d8 * 8 + 6], o[d8 * 8 + 7] * rstd * gn[d8 * 8 + 7]);
        *(u32x4*)(op + d8 * 8) = w; }
}

__device__ __forceinline__ void gla_decay_cumsum(Frame& F, int l, int b, int h, int n, LAS float* Bc) {
    const bf16_t* P = (const bf16_t*)(F.ws + WS_PROJ);
    const float* wa2 = INF(F, I_GLA_WA2) + l * 16 * 128; const float* ba = INF(F, I_GLA_BA) + l * 128;
    const int tok0 = b * SEQ + n * 64;
#pragma unroll
    for (int it = 0; it < 4; ++it) { const int idx = it * 512 + F.tid, t = idx >> 5, e = idx & 31;
        const bf16_t* lr = P + (size_t)(tok0 + t) * NPROJ + PB_LR; float a = ba[h * 32 + e];
#pragma unroll
        for (int r = 0; r < 16; ++r) a += bf2f(lr[r]) * wa2[r * 128 + h * 32 + e];
        Bc[idx] = logsigmoid_f(a) * (1.f / 16.f); }
    __syncthreads();
    if (F.tid < 32) { float c = 0.f; for (int t = 0; t < 64; ++t) { c += Bc[t * 32 + F.tid]; Bc[t * 32 + F.tid] = c; } }
    __syncthreads();
}
__device__ __forceinline__ void gla_kv_unit(Frame& F, int l, int unit) {
    const bf16_t* P = (const bf16_t*)(F.ws + WS_PROJ);
    float* KV = (float*)(F.ws + WS_GLA_KV) + (size_t)unit * 2048; float* DEC = (float*)(F.ws + WS_GLA_DEC) + unit * 32;
    const int n = unit & 63, h = (unit >> 6) & 3, b = unit >> 8, tok0 = b * SEQ + n * 64;
    LAS float* Bc = (LAS float*)F.lds; LAS float* Ke = (LAS float*)(F.lds + 8192); LAS float* Vs = (LAS float*)(F.lds + 16384);
    __syncthreads();
    gla_decay_cumsum(F, l, b, h, n, Bc);
#pragma unroll
    for (int it = 0; it < 4; ++it) { const int idx = it * 512 + F.tid, s = idx >> 5, e = idx & 31;
        Ke[idx] = bf2f(P[(size_t)(tok0 + s) * NPROJ + PB_K + h * 32 + e]) * __expf(Bc[63 * 32 + e] - Bc[idx]); }
#pragma unroll
    for (int it = 0; it < 8; ++it) { const int idx = it * 512 + F.tid, s = idx >> 6, f = idx & 63; Vs[idx] = bf2f(P[(size_t)(tok0 + s) * NPROJ + PB_V + h * 64 + f]); }
    __syncthreads();
    { const int e = F.tid >> 4, f0 = (F.tid & 15) * 4; f32x4 a = {0.f, 0.f, 0.f, 0.f};
      for (int s = 0; s < 64; ++s) { const float ke = Ke[s * 32 + e]; const f32x4 vv = *(const LAS f32x4*)(Vs + s * 64 + f0); a += ke * vv; }
      *(f32x4*)(KV + e * 64 + f0) = a; }
    if (F.tid < 32) DEC[F.tid] = __expf(Bc[63 * 32 + F.tid]);
}
__device__ __forceinline__ void gla_scan(Frame& F, int gtid) {
    const int f = gtid & 63, e = (gtid >> 6) & 31, bh = gtid >> 11;
    float* KV = (float*)(F.ws + WS_GLA_KV) + (size_t)bh * 64 * 2048 + e * 64 + f; const float* DEC = (const float*)(F.ws + WS_GLA_DEC) + bh * 64 * 32 + e;
    float st = 0.f;
#pragma unroll 8
    for (int n = 0; n < 64; ++n) { const float kv = KV[(size_t)n * 2048], d = DEC[n * 32]; KV[(size_t)n * 2048] = st; st = d * st + kv; }
}
__device__ __forceinline__ void gla_out_unit(Frame& F, int l, int unit) {
    const bf16_t* P = (const bf16_t*)(F.ws + WS_PROJ); bf16_t* MIX = (bf16_t*)(F.ws + WS_MIX);
    const float* SP = (const float*)(F.ws + WS_GLA_KV) + (size_t)unit * 2048;
    const int n = unit & 63, h = (unit >> 6) & 3, b = unit >> 8, tok0 = b * SEQ + n * 64;
    LAS float* Bc = (LAS float*)F.lds; LAS float* Qe = (LAS float*)(F.lds + 8192); LAS float* Ke = (LAS float*)(F.lds + 16384); LAS float* Qb = (LAS float*)(F.lds + 25088);
    LAS float* Vs = (LAS float*)(F.lds + 33792); LAS float* Ss = (LAS float*)(F.lds + 50176); LAS float* At = (LAS float*)(F.lds + 58368);
    __syncthreads();
    gla_decay_cumsum(F, l, b, h, n, Bc);
    const float qs = 0.17677669529663687f;
#pragma unroll
    for (int it = 0; it < 4; ++it) { const int idx = it * 512 + F.tid, t = idx >> 5, e = idx & 31;
        const float bt = Bc[idx], br = Bc[31 * 32 + e];
        const float qv = bf2f(P[(size_t)(tok0 + t) * NPROJ + PB_Q + h * 32 + e]) * qs, kv = bf2f(P[(size_t)(tok0 + t) * NPROJ + PB_K + h * 32 + e]);
        Qe[idx] = qv * __expf(bt - br); Ke[t * 33 + e] = kv * __expf(br - bt); Qb[idx] = qv * __expf(bt); }
#pragma unroll
    for (int it = 0; it < 8; ++it) { const int idx = it * 512 + F.tid, s = idx >> 6, f = idx & 63; Vs[idx] = bf2f(P[(size_t)(tok0 + s) * NPROJ + PB_V + h * 64 + f]); }
#pragma unroll
    for (int it = 0; it < 4; ++it) { const int idx = it * 512 + F.tid; Ss[idx] = SP[idx]; }
    __syncthreads();
#pragma unroll
    for (int it = 0; it < 8; ++it) { const int idx = it * 512 + F.tid, t = idx >> 6, s = idx & 63; float a = 0.f;
        if (s <= t) {
#pragma unroll
            for (int e = 0; e < 32; ++e) a += Qe[t * 32 + e] * Ke[s * 33 + e]; }
        At[t * 65 + s] = a; }
    __syncthreads();
    { const int t = F.tid >> 3, f0 = (F.tid & 7) * 8; float o[8];
#pragma unroll
      for (int j = 0; j < 8; ++j) o[j] = 0.f;
      for (int s = 0; s <= t; ++s) { const float a = At[t * 65 + s]; const f32x4 v0 = *(const LAS f32x4*)(Vs + s * 64 + f0), v1 = *(const LAS f32x4*)(Vs + s * 64 + f0 + 4);
          o[0] += a * v0[0]; o[1] += a * v0[1]; o[2] += a * v0[2]; o[3] += a * v0[3]; o[4] += a * v1[0]; o[5] += a * v1[1]; o[6] += a * v1[2]; o[7] += a * v1[3]; }
#pragma unroll
      for (int e = 0; e < 32; ++e) { const float a = Qb[t * 32 + e]; const f32x4 v0 = *(const LAS f32x4*)(Ss + e * 64 + f0), v1 = *(const LAS f32x4*)(Ss + e * 64 + f0 + 4);
          o[0] += a * v0[0]; o[1] += a * v0[1]; o[2] += a * v0[2]; o[3] += a * v0[3]; o[4] += a * v1[0]; o[5] += a * v1[1]; o[6] += a * v1[2]; o[7] += a * v1[3]; }
      float ss = 0.f;
#pragma unroll
      for (int j = 0; j < 8; ++j) ss += o[j] * o[j];
      ss += __shfl_xor(ss, 1); ss += __shfl_xor(ss, 2); ss += __shfl_xor(ss, 4);
      const float rstd = rsqrtf(ss * (1.f / 64.f) + NORM_EPS); const float* gn = INF(F, I_GLA_ON) + l * 256 + h * 64 + f0;
      const u32x4 gw = *(const u32x4*)(P + (size_t)(tok0 + t) * NPROJ + PB_G + h * 64 + f0);
      float gb[8] = {bflo(gw.x), bfhi(gw.x), bflo(gw.y), bfhi(gw.y), bflo(gw.z), bfhi(gw.z), bflo(gw.w), bfhi(gw.w)};
      float r[8];
#pragma unroll
      for (int j = 0; j < 8; ++j) r[j] = o[j] * rstd * gn[j] * (gb[j] * sigmoid_f(gb[j]));
      u32x4 w; w.x = pk2(r[0], r[1]); w.y = pk2(r[2], r[3]); w.z = pk2(r[4], r[5]); w.w = pk2(r[6], r[7]);
      *(u32x4*)(MIX + (size_t)(tok0 + t) * DM + 256 + h * 64 + f0) = w; }
}

template <int CTRL> __device__ __forceinline__ float dpp_add(float v) { return v + __builtin_bit_cast(float, __builtin_amdgcn_update_dpp(0, __builtin_bit_cast(int, v), CTRL, 0xf, 0xf, false)); }
__device__ __forceinline__ float sum16(float v) { v = dpp_add<0xB1>(v); v = dpp_add<0x4E>(v); v = dpp_add<0x141>(v); v = dpp_add<0x140>(v); return v; }
typedef float f32x16 __attribute__((ext_vector_type(16)));
__device__ __forceinline__ float other_half(float x, int hh) {
    auto t = __builtin_amdgcn_permlane32_swap(__float_as_uint(x), __float_as_uint(x), false, false);
    return __uint_as_float(hh ? t[0] : t[1]);
}
__device__ __forceinline__ unsigned cvt_pk(float lo, float hi) { unsigned r; asm volatile("v_cvt_pk_bf16_f32 %0, %1, %2" : "=v"(r) : "v"(lo), "v"(hi)); return r; }
__device__ __forceinline__ bf16x8 pack8(float p0, float p1, float p2, float p3, float p4, float p5, float p6, float p7) {
    u32x4 w; w.x = cvt_pk(p0, p1); w.y = cvt_pk(p2, p3); w.z = cvt_pk(p4, p5); w.w = cvt_pk(p6, p7); return __builtin_bit_cast(bf16x8, w);
}
#define PACK8(a, o) pack8(a[(o)], a[(o) + 1], a[(o) + 2], a[(o) + 3], a[(o) + 4], a[(o) + 5], a[(o) + 6], a[(o) + 7])
__device__ __forceinline__ bf16x8 load_vt(const bf16_t* P, size_t vrow0, int vcol, int db, int ko, int r, int hh) {
    const bf16_t* p = P + (vrow0 + 32 * db + r) * NPROJ + vcol + ko + 4 * hh;
    const u32x2 a = *(const u32x2*)p, b = *(const u32x2*)(p + 8);
    u32x4 w; w.x = a.x; w.y = a.y; w.z = b.x; w.w = b.y; return __builtin_bit_cast(bf16x8, w);
}
__device__ __forceinline__ void store_ot(bf16_t* orow, const f32x16& o0, const f32x16& o1, float rs, const float* gn, int hh) {
#pragma unroll
    for (int db = 0; db < 2; ++db)
#pragma unroll
        for (int g4 = 0; g4 < 4; ++g4) { const int d = 32 * db + 8 * g4 + 4 * hh; const f32x4 gv = *(const f32x4*)(gn + d);
            const f32x16& o = db ? o1 : o0;
            u32x2 w; w.x = cvt_pk(o[4 * g4] * rs * gv[0], o[4 * g4 + 1] * rs * gv[1]); w.y = cvt_pk(o[4 * g4 + 2] * rs * gv[2], o[4 * g4 + 3] * rs * gv[3]);
            *(u32x2*)(orow + d) = w; }
}

__device__ __forceinline__ void attn_prep_block(Frame& F, int blk) {
    bf16_t* P = (bf16_t*)(F.ws + WS_PROJ);
    const float* RC = (const float*)(F.ws + WS_ROPE_C); const float* RS = (const float*)(F.ws + WS_ROPE_S);
    LAS unsigned* T = (LAS unsigned*)F.lds;
    const int tok0 = blk * 64;
    for (int it = 0; it < 24; ++it) { const int idx = it * 512 + F.tid, d = idx & 31, hd = (idx >> 5) % 6, tt = idx / 192; const int tok = tok0 + tt;
        bf16_t* p = P + (size_t)tok * NPROJ + (hd < 4 ? PA_Q + hd * 64 : PA_K + (hd - 4) * 64); const float sc = hd < 4 ? 0.18033688011112042f : 1.f;
        const float x1 = bf2f(p[d]), x2 = bf2f(p[d + 32]), c = RC[tok * 32 + d], s = RS[tok * 32 + d];
        p[d] = f2bf((x1 * c - x2 * s) * sc); p[d + 32] = f2bf((x2 * c + x1 * s) * sc); }
    for (int vt = 0; vt < 6; ++vt) {
        const int vcol = vt < 2 ? PA_V + vt * 64 : PC_V + (vt - 2) * 64;
        __syncthreads();
        { const int tt = F.tid >> 3, c8 = F.tid & 7; const u32x4 w = *(const u32x4*)(P + (size_t)(tok0 + tt) * NPROJ + vcol + c8 * 8);
          T[tt * 33 + c8 * 4] = w.x; T[tt * 33 + c8 * 4 + 1] = w.y; T[tt * 33 + c8 * 4 + 2] = w.z; T[tt * 33 + c8 * 4 + 3] = w.w; }
        __syncthreads();
        { const int d = F.tid >> 3, t8 = F.tid & 7; unsigned e[8];
#pragma unroll
          for (int i = 0; i < 8; ++i) { const unsigned w = T[(t8 * 8 + i) * 33 + (d >> 1)]; e[i] = (d & 1) ? (w >> 16) : (w & 0xffffu); }
          u32x4 o; o.x = e[0] | (e[1] << 16); o.y = e[2] | (e[3] << 16); o.z = e[4] | (e[5] << 16); o.w = e[6] | (e[7] << 16);
          *(u32x4*)(P + (size_t)(tok0 + d) * NPROJ + vcol + t8 * 8) = o; }
    }
}

__device__ __forceinline__ void sb_task(Frame& F, int l, int task) {
    const bf16_t* P = (const bf16_t*)(F.ws + WS_PROJ); bf16_t* MIX = (bf16_t*)(F.ws + WS_MIX);
    const int qb = task & 127, h = (task >> 7) & 3, b = task >> 9;
    const int q0 = qb * 32, r = F.lane & 31, hh = F.lane >> 5, t = q0 + r;
    const size_t rowb = (size_t)b * SEQ;
    bf16x8 qf[4];
    { const bf16_t* qp = P + (rowb + t) * NPROJ + PC_Q + h * 64 + 8 * hh;
#pragma unroll
      for (int s = 0; s < 4; ++s) qf[s] = *(const bf16x8*)(qp + 16 * s); }
    f32x16 o0, o1;
#pragma unroll
    for (int i = 0; i < 16; ++i) { o0[i] = 0.f; o1[i] = 0.f; }
    float R = 0.f;
    bf16x8 kf[2][4];
#define SB_LOADK(kt_) do { _Pragma("unroll") for (int kb = 0; kb < 2; ++kb) { const bf16_t* kp = P + (rowb + 64 * (kt_) + 32 * kb + r) * NPROJ + PC_K + h * 64 + 8 * hh; \
        _Pragma("unroll") for (int s = 0; s < 4; ++s) kf[kb][s] = *(const bf16x8*)(kp + 16 * s); } } while (0)
    SB_LOADK((q0 + 30) >> 6);
    for (int kt = (q0 + 30) >> 6; kt >= 0; --kt) {
        const size_t krow0 = rowb + 64 * kt;
        bf16x8 vf[2][2][2];
#pragma unroll
        for (int kb = 0; kb < 2; ++kb)
#pragma unroll
            for (int s = 0; s < 2; ++s) { vf[0][kb][s] = load_vt(P, krow0, PC_V + h * 64, 0, 32 * kb + 16 * s, r, hh); vf[1][kb][s] = load_vt(P, krow0, PC_V + h * 64, 1, 32 * kb + 16 * s, r, hh); }
        __builtin_amdgcn_sched_barrier(0);
        f32x16 st[2];
#pragma unroll
        for (int kb = 0; kb < 2; ++kb) { f32x16 a;
#pragma unroll
            for (int i = 0; i < 16; ++i) a[i] = 0.f;
#pragma unroll
            for (int s = 0; s < 4; ++s) a = __builtin_amdgcn_mfma_f32_32x32x16_bf16(kf[kb][s], qf[s], a, 0, 0, 0);
            st[kb] = a; }
        bf16x8 kn[2][4];
        { const int ktn = kt > 0 ? kt - 1 : 0;
#pragma unroll
          for (int kb = 0; kb < 2; ++kb) { const bf16_t* kp = P + (rowb + 64 * ktn + 32 * kb + r) * NPROJ + PC_K + h * 64 + 8 * hh;
#pragma unroll
              for (int s = 0; s < 4; ++s) kn[kb][s] = *(const bf16x8*)(kp + 16 * s); } }
        float Rb = R;
#pragma unroll
        for (int kb = 1; kb >= 0; --kb) {
            float lv[16], zz[16], p[16];
#pragma unroll
            for (int i = 0; i < 16; ++i) { const int key = 64 * kt + 32 * kb + (i & 3) + 8 * (i >> 2) + 4 * hh; const float z = st[kb][i] * 0.18033688011112042f; const bool valid = key < t;
                const float sp = fmaxf(z, 0.f) + __builtin_amdgcn_logf(1.f + __builtin_amdgcn_exp2f(-fabsf(z))); lv[i] = valid ? -sp : 0.f; zz[i] = valid ? (z - sp) : -INFINITY; }
            float gown[4], suf[16];
#pragma unroll
            for (int g = 0; g < 4; ++g) { const float s3 = lv[4 * g + 3], s2 = s3 + lv[4 * g + 2], s1 = s2 + lv[4 * g + 1]; gown[g] = s1 + lv[4 * g];
                suf[4 * g + 3] = 0.f; suf[4 * g + 2] = s3; suf[4 * g + 1] = s2; suf[4 * g] = s1; }
            float run = 0.f, above[4];
#pragma unroll
            for (int g = 3; g >= 0; --g) { const float go = other_half(gown[g], hh); above[g] = run + (hh == 0 ? go : 0.f); run += gown[g] + go; }
#pragma unroll
            for (int i = 0; i < 16; ++i) p[i] = __builtin_amdgcn_exp2f(zz[i] + (Rb + above[i >> 2] + suf[i]));
            Rb += run;
#pragma unroll
            for (int s = 0; s < 2; ++s) { const bf16x8 pf = PACK8(p, 8 * s);
                o0 = __builtin_amdgcn_mfma_f32_32x32x16_bf16(vf[0][kb][s], pf, o0, 0, 0, 0);
                o1 = __builtin_amdgcn_mfma_f32_32x32x16_bf16(vf[1][kb][s], pf, o1, 0, 0, 0); }
        }
        R = Rb;
#pragma unroll
        for (int kb = 0; kb < 2; ++kb)
#pragma unroll
            for (int s = 0; s < 4; ++s) kf[kb][s] = kn[kb][s];
        if (__all(R < -115.5f)) break;
    }
#undef SB_LOADK
    float ss = 0.f;
#pragma unroll
    for (int i = 0; i < 16; ++i) ss += o0[i] * o0[i] + o1[i] * o1[i];
    ss += other_half(ss, hh);
    const float rstd = rsqrtf(ss * (1.f / 64.f) + NORM_EPS);
    store_ot(MIX + (rowb + t) * DM + 512 + h * 64, o0, o1, rstd, INF(F, I_SB_ON) + l * 256 + h * 64, hh);
}

__device__ __forceinline__ void swa_task(Frame& F, int l, int task) {
    const bf16_t* P = (const bf16_t*)(F.ws + WS_PROJ); bf16_t* MIX = (bf16_t*)(F.ws + WS_MIX);
    const int qb = task & 127, hq = (task >> 7) & 3, b = task >> 9, kvh = hq >> 1;
    const int q0 = qb * 32, r = F.lane & 31, hh = F.lane >> 5, t = q0 + r;
    const size_t rowb = (size_t)b * SEQ;
    bf16x8 qf[4];
    { const bf16_t* qp = P + (rowb + t) * NPROJ + PA_Q + hq * 64 + 8 * hh;
#pragma unroll
      for (int s = 0; s < 4; ++s) qf[s] = *(const bf16x8*)(qp + 16 * s); }
    f32x16 o0, o1;
#pragma unroll
    for (int i = 0; i < 16; ++i) { o0[i] = 0.f; o1[i] = 0.f; }
    float m = INF(F, I_SINKS)[l * 4 + hq], lsum = 1.f;
    const int ktlo = (q0 >= 127) ? ((q0 - 127) >> 6) : 0;
    for (int kt = (q0 + 31) >> 6; kt >= ktlo; --kt) {
        const size_t krow0 = rowb + 64 * kt;
        float sv[32];
        float tmax = -INFINITY;
#pragma unroll
        for (int kb = 0; kb < 2; ++kb) { const bf16_t* kp = P + (krow0 + 32 * kb + r) * NPROJ + PA_K + kvh * 64 + 8 * hh;
            f32x16 a;
#pragma unroll
            for (int i = 0; i < 16; ++i) a[i] = 0.f;
#pragma unroll
            for (int s = 0; s < 4; ++s) a = __builtin_amdgcn_mfma_f32_32x32x16_bf16(*(const bf16x8*)(kp + 16 * s), qf[s], a, 0, 0, 0);
#pragma unroll
            for (int i = 0; i < 16; ++i) { const int key = 64 * kt + 32 * kb + (i & 3) + 8 * (i >> 2) + 4 * hh; const bool valid = (key <= t) && (key + 127 >= t);
                sv[kb * 16 + i] = valid ? a[i] : -INFINITY; tmax = fmaxf(tmax, sv[kb * 16 + i]); } }
        tmax = fmaxf(tmax, other_half(tmax, hh));
        const float mn = fmaxf(m, tmax), sc = __expf(m - mn);
        float psum = 0.f;
#pragma unroll
        for (int i = 0; i < 32; ++i) { sv[i] = __expf(sv[i] - mn); psum += sv[i]; }
        psum += other_half(psum, hh);
        lsum = lsum * sc + psum; m = mn;
#pragma unroll
        for (int i = 0; i < 16; ++i) { o0[i] *= sc; o1[i] *= sc; }
#pragma unroll
        for (int kb = 0; kb < 2; ++kb)
#pragma unroll
            for (int s = 0; s < 2; ++s) { const bf16x8 pf = PACK8(sv, kb * 16 + 8 * s);
                o0 = __builtin_amdgcn_mfma_f32_32x32x16_bf16(load_vt(P, krow0, PA_V + kvh * 64, 0, 32 * kb + 16 * s, r, hh), pf, o0, 0, 0, 0);
                o1 = __builtin_amdgcn_mfma_f32_32x32x16_bf16(load_vt(P, krow0, PA_V + kvh * 64, 1, 32 * kb + 16 * s, r, hh), pf, o1, 0, 0, 0); }
    }
    const float inv = 1.f / lsum;
    float ss = 0.f;
#pragma unroll
    for (int i = 0; i < 16; ++i) { o0[i] *= inv; o1[i] *= inv; ss += o0[i] * o0[i] + o1[i] * o1[i]; }
    ss += other_half(ss, hh);
    const float rstd = rsqrtf(ss * (1.f / 64.f) + NORM_EPS);
    store_ot(MIX + (rowb + t) * DM + hq * 64, o0, o1, rstd, INF(F, I_SWA_ON) + l * 256 + hq * 64, hh);
}

__device__ __forceinline__ unsigned short hw(const u32x4& w, int j) { const unsigned d = (j >> 1) == 0 ? w.x : ((j >> 1) == 1 ? w.y : ((j >> 1) == 2 ? w.z : w.w)); return (unsigned short)((j & 1) ? (d >> 16) : (d & 0xffffu)); }
template <int V> struct IC { static constexpr int value = V; };
template <bool SWA>
__device__ __forceinline__ void attn_block(Frame& F, int l, int bt) {
    const bf16_t* P = (const bf16_t*)(F.ws + WS_PROJ); bf16_t* MIX = (bf16_t*)(F.ws + WS_MIX);
    const int qblk = bt & 15, h = (bt >> 4) & 3, b = bt >> 6;
    const int q0b = qblk * 256, q0 = q0b + 32 * F.wave, r = F.lane & 31, hh = F.lane >> 5, t = q0 + r;
    const size_t rowb = (size_t)b * SEQ;
    const int qcol = SWA ? PA_Q + h * 64 : PC_Q + h * 64, kcol = SWA ? PA_K + (h >> 1) * 64 : PC_K + h * 64, vcol = SWA ? PA_V + (h >> 1) * 64 : PC_V + h * 64;
    LAS bf16_t* Ks = (LAS bf16_t*)F.lds; LAS bf16_t* Vs = (LAS bf16_t*)(F.lds + 2 * 9216);
    const float* RC = (const float*)(F.ws + WS_ROPE_C); const float* RS = (const float*)(F.ws + WS_ROPE_S);
    bf16x8 qf[4];
    { const bf16_t* qp = P + (rowb + t) * NPROJ + qcol + 8 * hh; u32x4 qw[4];
#pragma unroll
      for (int s = 0; s < 4; ++s) qw[s] = *(const u32x4*)(qp + 16 * s);
      if (SWA) {
#pragma unroll
          for (int s = 0; s < 2; ++s) { const float* cp = RC + (rowb + t) * 32 + 16 * s + 8 * hh; const float* sp = RS + (rowb + t) * 32 + 16 * s + 8 * hh;
              const f32x4 c0 = *(const f32x4*)cp, c1 = *(const f32x4*)(cp + 4), s0 = *(const f32x4*)sp, s1 = *(const f32x4*)(sp + 4);
              const unsigned a[4] = {qw[s].x, qw[s].y, qw[s].z, qw[s].w}, bq[4] = {qw[s + 2].x, qw[s + 2].y, qw[s + 2].z, qw[s + 2].w}; float o1[8], o2[8];
#pragma unroll
              for (int j = 0; j < 8; ++j) { const float x1 = (j & 1) ? bfhi(a[j >> 1]) : bflo(a[j >> 1]), x2 = (j & 1) ? bfhi(bq[j >> 1]) : bflo(bq[j >> 1]), cc = j < 4 ? c0[j & 3] : c1[j & 3], sn = j < 4 ? s0[j & 3] : s1[j & 3];
                  o1[j] = (x1 * cc - x2 * sn) * 0.18033688011112042f; o2[j] = (x2 * cc + x1 * sn) * 0.18033688011112042f; }
              qw[s] = (u32x4){cvt_pk(o1[0], o1[1]), cvt_pk(o1[2], o1[3]), cvt_pk(o1[4], o1[5]), cvt_pk(o1[6], o1[7])}; qw[s + 2] = (u32x4){cvt_pk(o2[0], o2[1]), cvt_pk(o2[2], o2[3]), cvt_pk(o2[4], o2[5]), cvt_pk(o2[6], o2[7])}; } }
#pragma unroll
      for (int s = 0; s < 4; ++s) qf[s] = __builtin_bit_cast(bf16x8, qw[s]); }
    f32x16 o0, o1;
#pragma unroll
    for (int i = 0; i < 16; ++i) { o0[i] = 0.f; o1[i] = 0.f; }
    float R = 0.f;
    float m = SWA ? INF(F, I_SINKS)[l * 4 + h] * 1.4426950408889634f : 0.f, lsum = 1.f;
    const int kt_top = SWA ? (q0b + 255) >> 6 : (q0b + 254) >> 6;
    const int kt_lo = SWA ? ((q0b >= 127) ? ((q0b - 127) >> 6) : 0) : 0;
    const int ktw = SWA ? (q0 + 31) >> 6 : (q0 + 30) >> 6;
    const int ktl = SWA ? ((q0 >= 127) ? ((q0 - 127) >> 6) : 0) : 0;
    bool fin = false;
    const bool kside = F.wave < 4; const int srow = (F.tid & 255) >> 2, q4 = F.tid & 3;
    u32x4 pa_[2], pb_[2]; f32x4 rc0_[2], rc1_[2], rs0_[2], rs1_[2];
#pragma unroll
    for (int i_ = 0; i_ < 2; ++i_) { rc0_[i_] = (f32x4){0.f, 0.f, 0.f, 0.f}; rc1_[i_] = rc0_[i_]; rs0_[i_] = rc0_[i_]; rs1_[i_] = rc0_[i_]; }
#define AT_FETCH(kt_, S_) do { const size_t tk_ = rowb + 64 * (kt_) + srow; \
        if (kside) { const bf16_t* p_ = P + tk_ * NPROJ + kcol + 8 * q4; pa_[S_] = *(const u32x4*)p_; pb_[S_] = *(const u32x4*)(p_ + 32); \
            if (SWA) { const float* c_ = RC + tk_ * 32 + 8 * q4; const float* s_ = RS + tk_ * 32 + 8 * q4; rc0_[S_] = *(const f32x4*)c_; rc1_[S_] = *(const f32x4*)(c_ + 4); rs0_[S_] = *(const f32x4*)s_; rs1_[S_] = *(const f32x4*)(s_ + 4); } } \
        else { const bf16_t* p_ = P + tk_ * NPROJ + vcol + 16 * q4; pa_[S_] = *(const u32x4*)p_; pb_[S_] = *(const u32x4*)(p_ + 8); } } while (0)
#define AT_STORE(bufi, S_) do { if (kside) { LAS bf16_t* d_ = Ks + (bufi) * 4608 + srow * 72 + 8 * q4; \
            if (SWA) { const unsigned a_[4] = {pa_[S_].x, pa_[S_].y, pa_[S_].z, pa_[S_].w}, b_[4] = {pb_[S_].x, pb_[S_].y, pb_[S_].z, pb_[S_].w}; float o1_[8], o2_[8]; \
                _Pragma("unroll") for (int j = 0; j < 8; ++j) { const float x1 = (j & 1) ? bfhi(a_[j >> 1]) : bflo(a_[j >> 1]), x2 = (j & 1) ? bfhi(b_[j >> 1]) : bflo(b_[j >> 1]), cc = j < 4 ? rc0_[S_][j & 3] : rc1_[S_][j & 3], sn = j < 4 ? rs0_[S_][j & 3] : rs1_[S_][j & 3]; \
                    o1_[j] = x1 * cc - x2 * sn; o2_[j] = x2 * cc + x1 * sn; } \
                pa_[S_] = (u32x4){cvt_pk(o1_[0], o1_[1]), cvt_pk(o1_[2], o1_[3]), cvt_pk(o1_[4], o1_[5]), cvt_pk(o1_[6], o1_[7])}; pb_[S_] = (u32x4){cvt_pk(o2_[0], o2_[1]), cvt_pk(o2_[2], o2_[3]), cvt_pk(o2_[4], o2_[5]), cvt_pk(o2_[6], o2_[7])}; } \
            *(LAS u32x4*)d_ = pa_[S_]; *(LAS u32x4*)(d_ + 32) = pb_[S_]; } \
        else { LAS bf16_t* d_ = Vs + (bufi) * 4608 + (16 * q4) * 72 + srow; \
            _Pragma("unroll") for (int j = 0; j < 8; ++j) { d_[j * 72] = hw(pa_[S_], j); d_[(8 + j) * 72] = hw(pb_[S_], j); } } } while (0)
    volatile LAS int* vote = (volatile LAS int*)(F.lds + MISC_OFF + 16);
    __syncthreads();
    if (F.tid < 3) vote[F.tid] = 0;
    AT_FETCH(kt_top, 0); AT_STORE(0, 0);
    if (kt_top > kt_lo) AT_FETCH(kt_top - 1, 1);
    __syncthreads();
    int buf = 0, slot = 0;
    auto trip = [&](const int kt, auto fs_tag) -> bool {
        constexpr int FS_ = decltype(fs_tag)::value;
        const bool mine = !fin && kt <= ktw && kt >= ktl;
        if (mine && F.lane == 0) vote[slot] = 1;
        __syncthreads();
        const int any = vote[slot];
        if (F.tid == 0) vote[slot == 0 ? 2 : slot - 1] = 0;
        slot = slot == 2 ? 0 : slot + 1;
        if (any == 0 && kt < ((SWA ? (q0b + 31) : (q0b + 30)) >> 6)) return false;
        if (kt - 2 >= kt_lo) AT_FETCH(kt - 2, FS_);
        if (mine) {
            const LAS bf16_t* Kb = Ks + buf * 4608; const LAS bf16_t* Vb = Vs + buf * 4608;
            f32x16 st[2];
#pragma unroll
            for (int kb = 0; kb < 2; ++kb) { f32x16 a;
#pragma unroll
                for (int i = 0; i < 16; ++i) a[i] = 0.f;
#pragma unroll
                for (int s = 0; s < 4; ++s) a = __builtin_amdgcn_mfma_f32_32x32x16_bf16(*(const LAS bf16x8*)(Kb + (32 * kb + r) * 72 + 16 * s + 8 * hh), qf[s], a, 0, 0, 0);
                st[kb] = a; }
            if (!SWA) {
                float Rb = R;
#pragma unroll
                for (int kb = 1; kb >= 0; --kb) {
                    float e[16], u[16], p[16];
#pragma unroll
                    for (int i = 0; i < 16; ++i) { const int key = 64 * kt + 32 * kb + (i & 3) + 8 * (i >> 2) + 4 * hh; const float z = fminf(st[kb][i] * 0.18033688011112042f, 30.f); const bool valid = key < t;
                        const float ez = __builtin_amdgcn_exp2f(z); e[i] = valid ? ez : 0.f; u[i] = valid ? 1.f + ez : 1.f; }
                    float gown[4], iq[16];
#pragma unroll
                    for (int g = 0; g < 4; ++g) { const float q32 = u[4 * g + 3] * u[4 * g + 2], q10 = u[4 * g + 1] * u[4 * g]; gown[g] = q32 * q10;
                        const float r0 = __builtin_amdgcn_rcpf(gown[g]);
                        iq[4 * g] = r0; iq[4 * g + 1] = r0 * u[4 * g]; iq[4 * g + 2] = r0 * q10; iq[4 * g + 3] = r0 * q10 * u[4 * g + 2]; }
                    float run = 1.f, ia[4]; const float sc2 = __builtin_amdgcn_exp2f(Rb);
#pragma unroll
                    for (int g = 3; g >= 0; --g) { const float go = other_half(gown[g], hh); ia[g] = sc2 * __builtin_amdgcn_rcpf(run * (hh == 0 ? go : 1.f)); run *= gown[g] * go; }
#pragma unroll
                    for (int i = 0; i < 16; ++i) p[i] = e[i] * (iq[i] * ia[i >> 2]);
                    Rb -= __builtin_amdgcn_logf(run);
#pragma unroll
                    for (int s = 0; s < 2; ++s) { const bf16x8 pf = PACK8(p, 8 * s); const int ko = 32 * kb + 16 * s + 4 * hh;
                        const u32x2 a0 = *(const LAS u32x2*)(Vb + r * 72 + ko), a1 = *(const LAS u32x2*)(Vb + r * 72 + ko + 8), c0 = *(const LAS u32x2*)(Vb + (32 + r) * 72 + ko), c1 = *(const LAS u32x2*)(Vb + (32 + r) * 72 + ko + 8);
                        o0 = __builtin_amdgcn_mfma_f32_32x32x16_bf16(__builtin_bit_cast(bf16x8, (u32x4){a0.x, a0.y, a1.x, a1.y}), pf, o0, 0, 0, 0);
                        o1 = __builtin_amdgcn_mfma_f32_32x32x16_bf16(__builtin_bit_cast(bf16x8, (u32x4){c0.x, c0.y, c1.x, c1.y}), pf, o1, 0, 0, 0); }
                }
                R = Rb;
                fin = __all(R < -115.5f) != 0;
            } else {
                float sv[32]; float tmax = -INFINITY;
#pragma unroll
                for (int kb = 0; kb < 2; ++kb)
#pragma unroll
                    for (int i = 0; i < 16; ++i) { const int key = 64 * kt + 32 * kb + (i & 3) + 8 * (i >> 2) + 4 * hh; const bool valid = (key <= t) && (key + 127 >= t);
                        sv[kb * 16 + i] = valid ? st[kb][i] : -INFINITY; tmax = fmaxf(tmax, sv[kb * 16 + i]); }
                tmax = fmaxf(tmax, other_half(tmax, hh));
                const float mn = fmaxf(m, tmax), sc = __builtin_amdgcn_exp2f(m - mn);
                float psum = 0.f;
#pragma unroll
                for (int i = 0; i < 32; ++i) { sv[i] = __builtin_amdgcn_exp2f(sv[i] - mn); psum += sv[i]; }
                psum += other_half(psum, hh);
                lsum = lsum * sc + psum; m = mn;
#pragma unroll
                for (int i = 0; i < 16; ++i) { o0[i] *= sc; o1[i] *= sc; }
#pragma unroll
                for (int kb = 0; kb < 2; ++kb)
#pragma unroll
                    for (int s = 0; s < 2; ++s) { const bf16x8 pf = PACK8(sv, kb * 16 + 8 * s); const int ko = 32 * kb + 16 * s + 4 * hh;
                        const u32x2 a0 = *(const LAS u32x2*)(Vb + r * 72 + ko), a1 = *(const LAS u32x2*)(Vb + r * 72 + ko + 8), c0 = *(const LAS u32x2*)(Vb + (32 + r) * 72 + ko), c1 = *(const LAS u32x2*)(Vb + (32 + r) * 72 + ko + 8);
                        o0 = __builtin_amdgcn_mfma_f32_32x32x16_bf16(__builtin_bit_cast(bf16x8, (u32x4){a0.x, a0.y, a1.x, a1.y}), pf, o0, 0, 0, 0);
                        o1 = __builtin_amdgcn_mfma_f32_32x32x16_bf16(__builtin_bit_cast(bf16x8, (u32x4){c0.x, c0.y, c1.x, c1.y}), pf, o1, 0, 0, 0); }
            }
        }
        buf ^= 1;
        if (kt > kt_lo) AT_STORE(buf, 1 - FS_);
        return true;
    };
    for (int kt = kt_top; kt >= kt_lo; kt -= 2) {
        if (!trip(kt, IC<0>{})) break;
        if (kt - 1 < kt_lo) break;
        if (!trip(kt - 1, IC<1>{})) break;
    }
    if (SWA) { const float inv = 1.f / lsum;
#pragma unroll
        for (int i = 0; i < 16; ++i) { o0[i] *= inv; o1[i] *= inv; } }
    float ss = 0.f;
#pragma unroll
    for (int i = 0; i < 16; ++i) ss += o0[i] * o0[i] + o1[i] * o1[i];
    ss += other_half(ss, hh);
    const float rstd = rsqrtf(ss * (1.f / 64.f) + NORM_EPS);
    store_ot(MIX + (rowb + t) * DM + (SWA ? 0 : 512) + h * 64, o0, o1, rstd, INF(F, SWA ? I_SWA_ON : I_SB_ON) + l * 256 + h * 64, hh);
#undef AT_FETCH
#undef AT_STORE
}
__device__ __forceinline__ void rwkv_convert_small(Frame& F, int l) {
    bf16_t* W2T = (bf16_t*)(F.ws + WS_SMALLW); bf16_t* A2T = W2T + 256 * 64; bf16_t* G2T = A2T + 256 * 64;
    const float* w2 = INF(F, I_W2) + l * 64 * 256; const float* a2 = INF(F, I_A2) + l * 64 * 256; const float* g2 = INF(F, I_G2) + l * 128 * 256;
    for (int idx = F.bid * 512 + F.tid; idx < 256 * 64; idx += F.G * 512) { const int c = idx >> 6, i = idx & 63; W2T[idx] = f2bf(w2[i * 256 + c]); A2T[idx] = f2bf(a2[i * 256 + c]); }
    for (int idx = F.bid * 512 + F.tid; idx < 256 * 128; idx += F.G * 512) { const int c = idx >> 7, i = idx & 127; G2T[idx] = f2bf(g2[i * 256 + c]); }
}
__device__ __forceinline__ float tanh_f(float x) { return 1.f - 2.f * __builtin_amdgcn_rcpf(__expf(2.f * x) + 1.f); }
constexpr int LP = 72, LPG = 136;
template <int PITCH, int KS>
__device__ __forceinline__ void mm64p(f32x4 (&acc)[2], const LAS bf16_t* A, const LAS bf16_t* B, int mt, int nt0, int lane) {
    const int r16 = lane & 15, kq = lane >> 4;
#pragma unroll
    for (int s = 0; s < KS; ++s) {
        const bf16x8 a = *(const LAS bf16x8*)(A + (16 * mt + r16) * PITCH + 32 * s + 8 * kq);
#pragma unroll
        for (int j = 0; j < 2; ++j) { const bf16x8 b = *(const LAS bf16x8*)(B + (16 * (nt0 + j) + r16) * PITCH + 32 * s + 8 * kq);
            acc[j] = __builtin_amdgcn_mfma_f32_16x16x32_bf16(a, b, acc[j], 0, 0, 0); }
    }
}
__device__ __forceinline__ void mm64(f32x4 (&acc)[2], const LAS bf16_t* A, const LAS bf16_t* B, int mt, int nt0, int lane) { mm64p<LP, 2>(acc, A, B, mt, nt0, lane); }
__device__ __forceinline__ float quad_sum(float v) { v = dpp_add<0xB1>(v); v = dpp_add<0x4E>(v); return v; }
template <int CTRL> __device__ __forceinline__ float quad_bcast(float v) { return __builtin_bit_cast(float, __builtin_amdgcn_update_dpp(0, __builtin_bit_cast(int, v), CTRL, 0xf, 0xf, false)); }
__device__ __forceinline__ float oct_sum(float v) { v = dpp_add<0xB1>(v); v = dpp_add<0x4E>(v); v = dpp_add<0x141>(v); return v; }
__device__ __forceinline__ bf16_t* rw_mat(Frame& F, int unit, int q) { return (bf16_t*)(F.ws + WS_RWM) + (size_t)unit * 16384 + q * 4096; }
__device__ __forceinline__ void rw_lerp8(float (&x)[8], const bf16_t* pc, bool hasprev, const float* mu, int col) {
    const u32x4 c = *(const u32x4*)(pc + col); u32x4 p = (u32x4){0u, 0u, 0u, 0u}; if (hasprev) p = *(const u32x4*)(pc - NPROJ + col);
    const f32x4 m0 = *(const f32x4*)(mu + col), m1 = *(const f32x4*)(mu + col + 4);
    x[0] = bflo(c.x) + (bflo(p.x) - bflo(c.x)) * m0[0]; x[1] = bfhi(c.x) + (bfhi(p.x) - bfhi(c.x)) * m0[1]; x[2] = bflo(c.y) + (bflo(p.y) - bflo(c.y)) * m0[2]; x[3] = bfhi(c.y) + (bfhi(p.y) - bfhi(c.y)) * m0[3];
    x[4] = bflo(c.z) + (bflo(p.z) - bflo(c.z)) * m1[0]; x[5] = bfhi(c.z) + (bfhi(p.z) - bfhi(c.z)) * m1[1]; x[6] = bflo(c.w) + (bflo(p.w) - bflo(c.w)) * m1[2]; x[7] = bfhi(c.w) + (bfhi(p.w) - bfhi(c.w)) * m1[3];
}
struct RwRaw { u32x4 c[7], p[7]; };
__device__ __forceinline__ void rw_load_raw(Frame& F, RwRaw& raw, int unit) {
    const int n = unit & 63, h = (unit >> 6) & 3, b = unit >> 8, tokc = b * SEQ + n * 64 + (F.tid >> 3), k0 = (F.tid & 7) * 8; const bool hasprev = (tokc & (SEQ - 1)) != 0;
    const bf16_t* pc = (const bf16_t*)(F.ws + WS_PROJ) + (size_t)tokc * NPROJ + PD + k0;
    const int col[7] = {768, 832, 896, 960, h * 64, 256 + h * 64, 512 + h * 64};
#pragma unroll
    for (int g = 0; g < 7; ++g) { raw.c[g] = *(const u32x4*)(pc + col[g]); raw.p[g] = (u32x4){0u, 0u, 0u, 0u}; if (hasprev) raw.p[g] = *(const u32x4*)(pc - NPROJ + col[g]); }
}
__device__ __forceinline__ void rw_lerp8r(float (&x)[8], const u32x4 c, const u32x4 p, const LAS float* mu, int col) {
    const f32x4 m0 = *(const LAS f32x4*)(mu + col), m1 = *(const LAS f32x4*)(mu + col + 4);
    x[0] = bflo(c.x) + (bflo(p.x) - bflo(c.x)) * m0[0]; x[1] = bfhi(c.x) + (bfhi(p.x) - bfhi(c.x)) * m0[1]; x[2] = bflo(c.y) + (bflo(p.y) - bflo(c.y)) * m0[2]; x[3] = bfhi(c.y) + (bfhi(p.y) - bfhi(c.y)) * m0[3];
    x[4] = bflo(c.z) + (bflo(p.z) - bflo(c.z)) * m1[0]; x[5] = bfhi(c.z) + (bfhi(p.z) - bfhi(c.z)) * m1[1]; x[6] = bflo(c.w) + (bflo(p.w) - bflo(c.w)) * m1[2]; x[7] = bfhi(c.w) + (bfhi(p.w) - bfhi(c.w)) * m1[3];
}
__device__ __forceinline__ u32x4 pack8v(const float (&x)[8]) { u32x4 w; w.x = cvt_pk(x[0], x[1]); w.y = cvt_pk(x[2], x[3]); w.z = cvt_pk(x[4], x[5]); w.w = cvt_pk(x[6], x[7]); return w; }

constexpr int R1_TAB = 125440;
__device__ __forceinline__ void rwkv_r1_tables(Frame& F, int l) {
    LAS float* T = (LAS float*)(F.lds + R1_TAB);
    const float* mu = INF(F, I_MU) + l * 1024; const float* w0 = INF(F, I_W0) + l * 256; const float* a0 = INF(F, I_A0) + l * 256; const float* kk = INF(F, I_KK) + l * 256; const float* ka = INF(F, I_KA) + l * 256; const float* rk = INF(F, I_RK) + l * 256;
    T[F.tid] = mu[F.tid]; T[512 + F.tid] = mu[512 + F.tid];
    if (F.tid < 256) { T[1024 + F.tid] = w0[F.tid]; T[1280 + F.tid] = a0[F.tid]; T[1536 + F.tid] = kk[F.tid]; T[1792 + F.tid] = ka[F.tid]; T[2048 + F.tid] = rk[F.tid]; }
    __syncthreads();
}
__device__ __forceinline__ void rwkv_r1_unit(Frame& F, int l, int unit, int stop = 0) {
    const int n = unit & 63, h = (unit >> 6) & 3, b = unit >> 8, tok0 = b * SEQ + n * 64;
#define SLOT(i) ((LAS bf16_t*)(F.lds + (i) * 9216))
    LAS float* F0 = (LAS float*)(F.lds + 92160); LAS float* F1 = (LAS float*)(F.lds + 92160 + 16384); LAS float* GC = (LAS float*)(F.lds + 92160 + 32768);
    LAS float* F2 = (LAS float*)F.lds;
    LAS bf16_t* XG = (LAS bf16_t*)(F.lds + 55296); LAS bf16_t* WG2 = (LAS bf16_t*)(F.lds + 72704);
    const int w = F.wave, mt = w & 3, nt0 = (w >> 2) * 2, r16 = F.lane & 15, kq = F.lane >> 4;
    const int t = F.tid >> 3, k0 = (F.tid & 7) * 8;
    const LAS float* TAB = (const LAS float*)(F.lds + R1_TAB); const LAS float* mu = TAB;
    const int tokc = tok0 + t;
    float r8[8], k8[8], v8[8], lw8[8], kk8[8], b8[8];
    RwRaw raw; rw_load_raw(F, raw, unit);
    __syncthreads();
    { float x[8];
      rw_lerp8r(x, raw.c[0], raw.p[0], mu, 768 + k0);
#pragma unroll
      for (int j = 0; j < 8; ++j) x[j] = tanh_f(x[j]);
      *(LAS u32x4*)(SLOT(2) + t * LP + k0) = pack8v(x);
      rw_lerp8r(x, raw.c[1], raw.p[1], mu, 832 + k0); *(LAS u32x4*)(SLOT(3) + t * LP + k0) = pack8v(x);
#pragma unroll
      for (int hf = 0; hf < 2; ++hf) { rw_lerp8r(x, raw.c[2 + hf], raw.p[2 + hf], mu, 896 + 64 * hf + k0);
#pragma unroll
          for (int j = 0; j < 8; ++j) x[j] = sigmoid_f(x[j]);
          *(LAS u32x4*)(XG + t * LPG + 64 * hf + k0) = pack8v(x); }
      const bf16_t* W2T = (const bf16_t*)(F.ws + WS_SMALLW); const bf16_t* A2T = W2T + 256 * 64; const bf16_t* G2T = A2T + 256 * 64;
      *(LAS u32x4*)(SLOT(4) + t * LP + k0) = *(const u32x4*)(W2T + (h * 64 + t) * 64 + k0); *(LAS u32x4*)(SLOT(5) + t * LP + k0) = *(const u32x4*)(A2T + (h * 64 + t) * 64 + k0);
      *(LAS u32x4*)(WG2 + t * LPG + k0) = *(const u32x4*)(G2T + (h * 64 + t) * 128 + k0); *(LAS u32x4*)(WG2 + t * LPG + 64 + k0) = *(const u32x4*)(G2T + (h * 64 + t) * 128 + 64 + k0);
      rw_lerp8r(r8, raw.c[4], raw.p[4], mu, h * 64 + k0); rw_lerp8r(k8, raw.c[5], raw.p[5], mu, 256 + h * 64 + k0); rw_lerp8r(v8, raw.c[6], raw.p[6], mu, 512 + h * 64 + k0); }
    __syncthreads();
    if (stop == 1) return;
    { f32x4 a0[2] = {{0.f, 0.f, 0.f, 0.f}, {0.f, 0.f, 0.f, 0.f}}, a1[2] = {{0.f, 0.f, 0.f, 0.f}, {0.f, 0.f, 0.f, 0.f}}, a2[2] = {{0.f, 0.f, 0.f, 0.f}, {0.f, 0.f, 0.f, 0.f}};
      mm64(a0, SLOT(2), SLOT(4), mt, nt0, F.lane); mm64(a1, SLOT(3), SLOT(5), mt, nt0, F.lane); mm64p<LPG, 4>(a2, XG, WG2, mt, nt0, F.lane);
      __syncthreads();
#pragma unroll
      for (int j = 0; j < 2; ++j)
#pragma unroll
          for (int rg = 0; rg < 4; ++rg) { const int o = (16 * mt + 4 * kq + rg) * 64 + 16 * (nt0 + j) + r16; F0[o] = a0[j][rg]; F1[o] = a1[j][rg]; F2[o] = a2[j][rg]; } }
    __syncthreads();
    if (stop == 2) return;
    { const int col = h * 64 + k0;
      const f32x4 w0a = *(const LAS f32x4*)(TAB + 1024 + col), w0b = *(const LAS f32x4*)(TAB + 1024 + col + 4), a0a = *(const LAS f32x4*)(TAB + 1280 + col), a0b = *(const LAS f32x4*)(TAB + 1280 + col + 4);
      const f32x4 kka = *(const LAS f32x4*)(TAB + 1536 + col), kkb = *(const LAS f32x4*)(TAB + 1536 + col + 4), kaa = *(const LAS f32x4*)(TAB + 1792 + col), kab = *(const LAS f32x4*)(TAB + 1792 + col + 4);
      const f32x4 rka = *(const LAS f32x4*)(TAB + 2048 + col), rkb = *(const LAS f32x4*)(TAB + 2048 + col + 4);
      const f32x4 p0a = *(const LAS f32x4*)(F0 + t * 64 + k0), p0b = *(const LAS f32x4*)(F0 + t * 64 + k0 + 4), p1a = *(const LAS f32x4*)(F1 + t * 64 + k0), p1b = *(const LAS f32x4*)(F1 + t * 64 + k0 + 4);
      const f32x4 p2a = *(const LAS f32x4*)(F2 + t * 64 + k0), p2b = *(const LAS f32x4*)(F2 + t * 64 + k0 + 4);
      float g8[8], ssq = 0.f, srkr = 0.f;
#pragma unroll
      for (int j = 0; j < 8; ++j) { const float w0 = j < 4 ? w0a[j & 3] : w0b[j & 3], a0 = j < 4 ? a0a[j & 3] : a0b[j & 3], k_k = j < 4 ? kka[j & 3] : kkb[j & 3], k_a = j < 4 ? kaa[j & 3] : kab[j & 3], r_k = j < 4 ? rka[j & 3] : rkb[j & 3];
          const float pw = j < 4 ? p0a[j & 3] : p0b[j & 3], pa = j < 4 ? p1a[j & 3] : p1b[j & 3]; g8[j] = j < 4 ? p2a[j & 3] : p2b[j & 3];
          const float a = sigmoid_f(a0 + pa); lw8[j] = bf2f(f2bf(-0.6065306597126334f * sigmoid_f(w0 + pw)));
          kk8[j] = k8[j] * k_k; const float km = k8[j] * (1.f + (a - 1.f) * k_a); b8[j] = kk8[j] * a; k8[j] = km;
          ssq += kk8[j] * kk8[j]; srkr += r8[j] * km * r_k; }
      ssq = oct_sum(ssq); srkr = oct_sum(srkr);
      const float rs = rsqrtf(ssq + 1e-12f);
#pragma unroll
      for (int j = 0; j < 8; ++j) { kk8[j] *= rs; b8[j] *= rs; }
      *(u32x4*)((bf16_t*)(F.ws + WS_RW_V) + (size_t)tokc * 256 + col) = pack8v(v8); *(u32x4*)((bf16_t*)(F.ws + WS_RW_G) + (size_t)tokc * 256 + col) = pack8v(g8);
      if ((F.tid & 7) == 0) ((float*)(F.ws + WS_RKR))[(size_t)tokc * 4 + h] = srkr; }
    __syncthreads();
    if (stop == 3) return;
#pragma unroll
    for (int j = 0; j < 8; ++j) { SLOT(0)[(k0 + j) * LP + t] = f2bf(lw8[j]); SLOT(1)[t * LP + k0 + j] = (k0 + j <= t) ? (bf16_t)0x3F80 : (bf16_t)0; }
    __syncthreads();
    { f32x4 acc[2] = {{0.f, 0.f, 0.f, 0.f}, {0.f, 0.f, 0.f, 0.f}}; mm64(acc, SLOT(1), SLOT(0), mt, nt0, F.lane);
#pragma unroll
      for (int j = 0; j < 2; ++j)
#pragma unroll
          for (int rg = 0; rg < 4; ++rg) F0[(16 * mt + 4 * kq + rg) * 64 + 16 * (nt0 + j) + r16] = acc[j][rg]; }
    __syncthreads();
    { const f32x4 c0 = *(const LAS f32x4*)(F0 + t * 64 + k0), c1 = *(const LAS f32x4*)(F0 + t * 64 + k0 + 4);
      const float cum[8] = {c0[0], c0[1], c0[2], c0[3], c1[0], c1[1], c1[2], c1[3]};
      float ka[8], bt[8], kt[8], rt[8];
#pragma unroll
      for (int j = 0; j < 8; ++j) { const float epos = __expf(cum[j]), eneg = __expf(-cum[j]), eprev = __expf(cum[j] - lw8[j]);
          ka[j] = kk8[j] * eprev; bt[j] = b8[j] * eneg; kt[j] = k8[j] * eneg; rt[j] = r8[j] * epos;
          if (t == 63) GC[k0 + j] = epos; }
      const u32x4 pka = pack8v(ka), pb = pack8v(bt), pq = pack8v(kt), prr = pack8v(rt), pv = pack8v(v8);
      *(LAS u32x4*)(SLOT(0) + t * LP + k0) = pka; *(LAS u32x4*)(SLOT(1) + t * LP + k0) = pb; *(LAS u32x4*)(SLOT(2) + t * LP + k0) = pq; *(LAS u32x4*)(SLOT(3) + t * LP + k0) = prr;
#pragma unroll
      for (int j = 0; j < 8; ++j) { SLOT(4)[(k0 + j) * LP + t] = hw(pb, j); SLOT(5)[(k0 + j) * LP + t] = hw(pq, j); SLOT(6)[(k0 + j) * LP + t] = hw(pv, j); } }
    __syncthreads();
    if (stop == 4) return;
    { f32x4 aLb[2] = {{0.f, 0.f, 0.f, 0.f}, {0.f, 0.f, 0.f, 0.f}}, aLk[2] = {{0.f, 0.f, 0.f, 0.f}, {0.f, 0.f, 0.f, 0.f}}, aMb[2] = {{0.f, 0.f, 0.f, 0.f}, {0.f, 0.f, 0.f, 0.f}}, aMk[2] = {{0.f, 0.f, 0.f, 0.f}, {0.f, 0.f, 0.f, 0.f}};
      mm64(aLb, SLOT(0), SLOT(1), mt, nt0, F.lane); mm64(aLk, SLOT(0), SLOT(2), mt, nt0, F.lane); mm64(aMb, SLOT(3), SLOT(1), mt, nt0, F.lane); mm64(aMk, SLOT(3), SLOT(2), mt, nt0, F.lane);
#pragma unroll
      for (int j = 0; j < 2; ++j)
#pragma unroll
          for (int rg = 0; rg < 4; ++rg) { const int tt = 16 * mt + 4 * kq + rg, ii = 16 * (nt0 + j) + r16;
              F0[tt * 64 + (ii & 3) * 16 + (ii >> 2)] = (ii < tt) ? aLb[j][rg] : 0.f;
              SLOT(7)[tt * LP + ii] = f2bf((ii < tt) ? aLk[j][rg] : 0.f); SLOT(8)[tt * LP + ii] = f2bf((ii <= tt) ? aMb[j][rg] : 0.f); SLOT(9)[tt * LP + ii] = f2bf((ii <= tt) ? aMk[j][rg] : 0.f); } }
    __syncthreads();
    if (stop == 5) return;
    { f32x4 acc[2] = {{0.f, 0.f, 0.f, 0.f}, {0.f, 0.f, 0.f, 0.f}}; mm64(acc, SLOT(7), SLOT(6), mt, nt0, F.lane);
#pragma unroll
      for (int j = 0; j < 2; ++j)
#pragma unroll
          for (int rg = 0; rg < 4; ++rg) F1[(16 * mt + 4 * kq + rg) * 64 + 16 * (nt0 + j) + r16] = acc[j][rg]; }
    __syncthreads();
    if (stop == 6) return;
    { const int col = F.tid >> 2, jq = F.tid & 3; float x[16], rhs[16];
#pragma unroll
      for (int m = 0; m < 16; ++m) { x[m] = 0.f; rhs[m] = (col < 64) ? bf2f(SLOT(0)[(4 * m + jq) * LP + col]) : F1[(4 * m + jq) * 64 + (col - 64)]; }
#pragma unroll
      for (int m = 0; m < 16; ++m) { float pa[4] = {0.f, 0.f, 0.f, 0.f};
#pragma unroll
          for (int a = 0; a < 4; ++a)
#pragma unroll
              for (int m4 = 0; 4 * m4 < m; ++m4) { const f32x4 lq = *(const LAS f32x4*)(F0 + (4 * m + a) * 64 + jq * 16 + 4 * m4);
#pragma unroll
                  for (int e = 0; e < 4; ++e) if (4 * m4 + e < m) pa[a] += lq[e] * x[4 * m4 + e]; }
          const float t0 = quad_sum(pa[0]), t1 = quad_sum(pa[1]), t2 = quad_sum(pa[2]), t3 = quad_sum(pa[3]);
          const LAS float* lrow = F0 + (4 * m + jq) * 64 + m;
          const float c0 = lrow[0], c1 = lrow[16], c2 = lrow[32];
          float y = rhs[m] - (jq == 0 ? t0 : (jq == 1 ? t1 : (jq == 2 ? t2 : t3)));
          y -= c0 * quad_bcast<0x00>(y); y -= c1 * quad_bcast<0x55>(y); y -= c2 * quad_bcast<0xAA>(y);
          x[m] = y; }
      LAS bf16_t* dst = (col < 64) ? (SLOT(7) + col * LP) : (SLOT(1) + (col - 64) * LP);
#pragma unroll
      for (int m = 0; m < 16; ++m) dst[4 * m + jq] = f2bf(-x[m]); }
    __syncthreads();
    if (stop == 7) return;
    { f32x4 aG[2] = {{0.f, 0.f, 0.f, 0.f}, {0.f, 0.f, 0.f, 0.f}}, aH[2] = {{0.f, 0.f, 0.f, 0.f}, {0.f, 0.f, 0.f, 0.f}}, aR[2] = {{0.f, 0.f, 0.f, 0.f}, {0.f, 0.f, 0.f, 0.f}}, aY[2] = {{0.f, 0.f, 0.f, 0.f}, {0.f, 0.f, 0.f, 0.f}};
      mm64(aG, SLOT(7), SLOT(4), mt, nt0, F.lane);
      mm64(aH, SLOT(5), SLOT(6), mt, nt0, F.lane); mm64(aH, SLOT(4), SLOT(1), mt, nt0, F.lane);
      mm64(aR, SLOT(7), SLOT(8), mt, nt0, F.lane);
      mm64(aY, SLOT(9), SLOT(6), mt, nt0, F.lane); mm64(aY, SLOT(8), SLOT(1), mt, nt0, F.lane);
      bf16_t* MG = rw_mat(F, unit, 0); bf16_t* MR = rw_mat(F, unit, 1); bf16_t* MH = rw_mat(F, unit, 2); bf16_t* MY = rw_mat(F, unit, 3);
#pragma unroll
      for (int j = 0; j < 2; ++j) { const int cc = 16 * (nt0 + j) + r16, r0 = 16 * mt + 4 * kq;
          const float gcc = GC[cc]; const u32x2 rtw = *(const LAS u32x2*)(SLOT(3) + cc * LP + r0);
          float gv[4], hv[4], rv[4], yv[4];
#pragma unroll
          for (int rg = 0; rg < 4; ++rg) { gv[rg] = gcc * ((r0 + rg == cc ? 1.f : 0.f) + aG[j][rg]); hv[rg] = GC[r0 + rg] * aH[j][rg]; yv[rg] = aY[j][rg] * 1.0f; }
          rv[0] = bflo(rtw.x) + aR[j][0]; rv[1] = bfhi(rtw.x) + aR[j][1]; rv[2] = bflo(rtw.y) + aR[j][2]; rv[3] = bfhi(rtw.y) + aR[j][3];
          u32x2 o; o.x = pg8::cvt_pk_c(gv[0], gv[1]); o.y = pg8::cvt_pk_c(gv[2], gv[3]); *(u32x2*)(MG + cc * 64 + r0) = o;
          o.x = pg8::cvt_pk_c(rv[0], rv[1]); o.y = pg8::cvt_pk_c(rv[2], rv[3]); *(u32x2*)(MR + cc * 64 + r0) = o;
          o.x = pg8::cvt_pk_c(hv[0], hv[1]); o.y = pg8::cvt_pk_c(hv[2], hv[3]); *(u32x2*)(MH + cc * 64 + r0) = o;
          o.x = pg8::cvt_pk_c(yv[0], yv[1]); o.y = pg8::cvt_pk_c(yv[2], yv[3]); *(u32x2*)(MY + cc * 64 + r0) = o; } }
#undef SLOT
}

__device__ __forceinline__ void rwkv_r2_block(Frame& F, int bh) {
    LAS bf16_t* Sx = (LAS bf16_t*)F.lds; LAS bf16_t* Gs = (LAS bf16_t*)(F.lds + 9216);
    bf16_t* SG = (bf16_t*)(F.ws + WS_RW_S);
    const int w = F.wave, mt = w & 3, nt0 = (w >> 2) * 2, r16 = F.lane & 15, kq = F.lane >> 4;
    const int grow = F.tid >> 3, gc0 = (F.tid & 7) * 8;
    f32x4 st[2] = {{0.f, 0.f, 0.f, 0.f}, {0.f, 0.f, 0.f, 0.f}};
    constexpr int PF = 4;
    u32x4 gq[PF]; u32x2 hq[PF][2];
#define R2_FETCH(slot, n_) do { const int u_ = bh * 64 + (n_); gq[slot] = *(const u32x4*)(rw_mat(F, u_, 0) + grow * 64 + gc0); \
        _Pragma("unroll") for (int j_ = 0; j_ < 2; ++j_) hq[slot][j_] = *(const u32x2*)(rw_mat(F, u_, 2) + (16 * (nt0 + j_) + r16) * 64 + 16 * mt + 4 * kq); } while (0)
#pragma unroll
    for (int i = 0; i < PF; ++i) R2_FETCH(i, i);
    __syncthreads();
    for (int n0 = 0; n0 < 64; n0 += PF) {
#pragma unroll
        for (int i = 0; i < PF; ++i) { const int n = n0 + i; const int unit = bh * 64 + n;
#pragma unroll
            for (int j = 0; j < 2; ++j) { u32x2 ps; ps.x = pg8::cvt_pk_c(st[j][0], st[j][1]); ps.y = pg8::cvt_pk_c(st[j][2], st[j][3]);
                const int vv = 16 * (nt0 + j) + r16, kk0 = 16 * mt + 4 * kq;
                *(LAS u32x2*)(Sx + vv * LP + kk0) = ps; *(u32x2*)(SG + (size_t)unit * 4096 + vv * 64 + kk0) = ps; }
            *(LAS u32x4*)(Gs + grow * LP + gc0) = gq[i];
            f32x4 acc[2];
#pragma unroll
            for (int j = 0; j < 2; ++j) { acc[j][0] = bflo(hq[i][j].x); acc[j][1] = bfhi(hq[i][j].x); acc[j][2] = bflo(hq[i][j].y); acc[j][3] = bfhi(hq[i][j].y); }
            if (n + PF < 64) R2_FETCH(i, n + PF);
            __syncthreads();
            mm64(acc, Gs, Sx, mt, nt0, F.lane);
            st[0] = acc[0]; st[1] = acc[1];
            __syncthreads();
        }
    }
#undef R2_FETCH
}

__device__ __forceinline__ void rwkv_r3_task(Frame& F, int l, int unit) {
    const int n = unit & 63, h = (unit >> 6) & 3, b = unit >> 8, tok0 = b * SEQ + n * 64;
    const int r16 = F.lane & 15, kq = F.lane >> 4;
    const bf16_t* SG = (const bf16_t*)(F.ws + WS_RW_S) + (size_t)unit * 4096;
    const bf16_t* MR = rw_mat(F, unit, 1); const bf16_t* MY = rw_mat(F, unit, 3);
    bf16x8 sb[4][2];
#pragma unroll
    for (int nt = 0; nt < 4; ++nt)
#pragma unroll
        for (int s = 0; s < 2; ++s) sb[nt][s] = *(const bf16x8*)(SG + (16 * nt + r16) * 64 + 32 * s + 8 * kq);
    const float* lnw = INF(F, I_LNW) + l * 256 + h * 64; const float* lnb = INF(F, I_LNB) + l * 256 + h * 64;
    float lw4[4], lb4[4];
#pragma unroll
    for (int nt = 0; nt < 4; ++nt) { lw4[nt] = lnw[16 * nt + r16]; lb4[nt] = lnb[16 * nt + r16]; }
    const bf16_t* SV = (const bf16_t*)(F.ws + WS_RW_V); const bf16_t* SGt = (const bf16_t*)(F.ws + WS_RW_G); const float* RKR = (const float*)(F.ws + WS_RKR);
    bf16_t* MIX = (bf16_t*)(F.ws + WS_MIX);
    LAS float* scr = (LAS float*)(F.lds + F.wave * 4352);
#pragma unroll 1
    for (int mt = 0; mt < 4; ++mt) {
        f32x4 acc[4];
#pragma unroll
        for (int nt = 0; nt < 4; ++nt) { const u32x2 y0 = *(const u32x2*)(MY + (16 * nt + r16) * 64 + 16 * mt + 4 * kq); acc[nt][0] = bflo(y0.x); acc[nt][1] = bfhi(y0.x); acc[nt][2] = bflo(y0.y); acc[nt][3] = bfhi(y0.y); }
#pragma unroll
        for (int s = 0; s < 2; ++s) { const bf16x8 a = *(const bf16x8*)(MR + (16 * mt + r16) * 64 + 32 * s + 8 * kq);
#pragma unroll
            for (int nt = 0; nt < 4; ++nt) acc[nt] = __builtin_amdgcn_mfma_f32_16x16x32_bf16(a, sb[nt][s], acc[nt], 0, 0, 0); }
#pragma unroll
        for (int rg = 0; rg < 4; ++rg) {
            const float mean = sum16((acc[0][rg] + acc[1][rg]) + (acc[2][rg] + acc[3][rg])) * (1.f / 64.f);
            float d[4], q = 0.f;
#pragma unroll
            for (int nt = 0; nt < 4; ++nt) { d[nt] = acc[nt][rg] - mean; q += d[nt] * d[nt]; }
            const float rstd = rsqrtf(sum16(q) * (1.f / 64.f) + 64e-5f);
#pragma unroll
            for (int nt = 0; nt < 4; ++nt) scr[(4 * kq + rg) * 68 + 16 * nt + r16] = d[nt] * rstd * lw4[nt] + lb4[nt]; }
        asm volatile("s_waitcnt lgkmcnt(0)" ::: "memory");
        { const int tr = F.lane >> 2, cg = F.lane & 3, tok = tok0 + 16 * mt + tr, col = h * 64 + 16 * cg;
          const float rkr = RKR[(size_t)tok * 4 + h];
          const u32x4 v0 = *(const u32x4*)(SV + (size_t)tok * 256 + col), v1 = *(const u32x4*)(SV + (size_t)tok * 256 + col + 8), g0 = *(const u32x4*)(SGt + (size_t)tok * 256 + col), g1 = *(const u32x4*)(SGt + (size_t)tok * 256 + col + 8);
          float y[16];
#pragma unroll
          for (int c4 = 0; c4 < 4; ++c4) { const f32x4 yy = *(const LAS f32x4*)(scr + tr * 68 + 16 * cg + 4 * c4); y[4 * c4] = yy[0]; y[4 * c4 + 1] = yy[1]; y[4 * c4 + 2] = yy[2]; y[4 * c4 + 3] = yy[3]; }
          float o[16];
#pragma unroll
          for (int j = 0; j < 8; ++j) { o[j] = (y[j] + rkr * bf2f(hw(v0, j))) * bf2f(hw(g0, j)); o[8 + j] = (y[8 + j] + rkr * bf2f(hw(v1, j))) * bf2f(hw(g1, j)); }
          u32x4 w0, w1; w0.x = pk2(o[0], o[1]); w0.y = pk2(o[2], o[3]); w0.z = pk2(o[4], o[5]); w0.w = pk2(o[6], o[7]); w1.x = pk2(o[8], o[9]); w1.y = pk2(o[10], o[11]); w1.z = pk2(o[12], o[13]); w1.w = pk2(o[14], o[15]);
          *(u32x4*)(MIX + (size_t)tok * DM + 768 + col) = w0; *(u32x4*)(MIX + (size_t)tok * DM + 768 + col + 8) = w1; }
        asm volatile("s_waitcnt lgkmcnt(0)" ::: "memory");
    }
}
template <int PITCH, int KS>
__device__ __forceinline__ void mm_tile(f32x4& acc, const LAS bf16_t* A, const LAS bf16_t* B, int mt, int nt, int lane) {
    const int r16 = lane & 15, kq = lane >> 4;
#pragma unroll
    for (int s = 0; s < KS; ++s)
        acc = __builtin_amdgcn_mfma_f32_16x16x32_bf16(*(const LAS bf16x8*)(A + (16 * mt + r16) * PITCH + 32 * s + 8 * kq), *(const LAS bf16x8*)(B + (16 * nt + r16) * PITCH + 32 * s + 8 * kq), acc, 0, 0, 0);
}
constexpr int GP = 40;
__device__ __forceinline__ void gla_cum(Frame& F, int l, int h, int tok0, LAS bf16_t* LAhi, LAS bf16_t* LAlo, LAS float* Fc) {
    const bf16_t* P = (const bf16_t*)(F.ws + WS_PROJ);
    const float* wa2 = INF(F, I_GLA_WA2) + l * 16 * 128 + h * 32; const float* ba = INF(F, I_GLA_BA) + l * 128 + h * 32;
    const int t = F.tid >> 3, e4 = (F.tid & 7) * 4;
    { const u32x4 l0 = *(const u32x4*)(P + (size_t)(tok0 + t) * NPROJ + PB_LR), l1 = *(const u32x4*)(P + (size_t)(tok0 + t) * NPROJ + PB_LR + 8);
      const float lr[16] = {bflo(l0.x), bfhi(l0.x), bflo(l0.y), bfhi(l0.y), bflo(l0.z), bfhi(l0.z), bflo(l0.w), bfhi(l0.w), bflo(l1.x), bfhi(l1.x), bflo(l1.y), bfhi(l1.y), bflo(l1.z), bfhi(l1.z), bflo(l1.w), bfhi(l1.w)};
      f32x4 a = *(const f32x4*)(ba + e4);
#pragma unroll
      for (int r = 0; r < 16; ++r) a += lr[r] * *(const f32x4*)(wa2 + r * 128 + e4);
#pragma unroll
      for (int j = 0; j < 4; ++j) { const float la = logsigmoid_f(a[j]) * (1.f / 16.f); const bf16_t hi = f2bf(la); const bf16_t lo = f2bf(la - bf2f(hi));
          LAhi[(e4 + j) * LP + t] = hi; LAlo[(e4 + j) * LP + t] = lo; } }
    __syncthreads();
    { const int w = F.wave, mt = w & 3, nt = w >> 2, r16 = F.lane & 15, kq = F.lane >> 4; f32x4 acc = {0.f, 0.f, 0.f, 0.f};
#pragma unroll
      for (int s = 0; s < 2; ++s) { bf16x8 tri;
#pragma unroll
          for (int j = 0; j < 8; ++j) tri[j] = (32 * s + 8 * kq + j <= 16 * mt + r16) ? (short)0x3F80 : (short)0;
          acc = __builtin_amdgcn_mfma_f32_16x16x32_bf16(tri, *(const LAS bf16x8*)(LAhi + (16 * nt + r16) * LP + 32 * s + 8 * kq), acc, 0, 0, 0);
          acc = __builtin_amdgcn_mfma_f32_16x16x32_bf16(tri, *(const LAS bf16x8*)(LAlo + (16 * nt + r16) * LP + 32 * s + 8 * kq), acc, 0, 0, 0); }
#pragma unroll
      for (int rg = 0; rg < 4; ++rg) Fc[(16 * mt + 4 * kq + rg) * 32 + 16 * nt + r16] = acc[rg]; }
    __syncthreads();
}
__device__ __forceinline__ void gla_kv2(Frame& F, int l, int unit) {
    const bf16_t* P = (const bf16_t*)(F.ws + WS_PROJ);
    float* KV = (float*)(F.ws + WS_GLA_KV) + (size_t)unit * 2048; float* DEC = (float*)(F.ws + WS_GLA_DEC) + unit * 32;
    const int n = unit & 63, h = (unit >> 6) & 3, b = unit >> 8, tok0 = b * SEQ + n * 64;
    LAS bf16_t* LAhi = (LAS bf16_t*)F.lds; LAS bf16_t* LAlo = (LAS bf16_t*)(F.lds + 4608); LAS float* Fc = (LAS float*)(F.lds + 9216);
    LAS bf16_t* Ke = (LAS bf16_t*)(F.lds + 17408); LAS bf16_t* Vf = (LAS bf16_t*)(F.lds + 22016);
    const int t = F.tid >> 3, c8 = F.tid & 7;
    __syncthreads();
    gla_cum(F, l, h, tok0, LAhi, LAlo, Fc);
    { const u32x2 kw = *(const u32x2*)(P + (size_t)(tok0 + t) * NPROJ + PB_K + h * 32 + c8 * 4); const u32x4 vw = *(const u32x4*)(P + (size_t)(tok0 + t) * NPROJ + PB_V + h * 64 + c8 * 8);
      const f32x4 ct = *(const LAS f32x4*)(Fc + t * 32 + c8 * 4), cl = *(const LAS f32x4*)(Fc + 63 * 32 + c8 * 4);
      const float kf[4] = {bflo(kw.x), bfhi(kw.x), bflo(kw.y), bfhi(kw.y)};
#pragma unroll
      for (int j = 0; j < 4; ++j) { Ke[(c8 * 4 + j) * LP + t] = f2bf(kf[j] * __expf(cl[j] - ct[j])); if (t == 63) DEC[c8 * 4 + j] = __expf(cl[j]); }
#pragma unroll
      for (int j = 0; j < 8; ++j) Vf[(c8 * 8 + j) * LP + t] = hw(vw, j); }
    __syncthreads();
    { const int w = F.wave, mt = w & 1, nt = w >> 1, r16 = F.lane & 15, kq = F.lane >> 4; f32x4 acc = {0.f, 0.f, 0.f, 0.f};
      mm_tile<LP, 2>(acc, Ke, Vf, mt, nt, F.lane);
#pragma unroll
      for (int rg = 0; rg < 4; ++rg) KV[(16 * mt + 4 * kq + rg) * 64 + 16 * nt + r16] = acc[rg]; }
}
__device__ __forceinline__ void gla_out2(Frame& F, int l, int unit) {
    const bf16_t* P = (const bf16_t*)(F.ws + WS_PROJ); bf16_t* MIX = (bf16_t*)(F.ws + WS_MIX);
    const float* SP = (const float*)(F.ws + WS_GLA_KV) + (size_t)unit * 2048;
    const int n = unit & 63, h = (unit >> 6) & 3, b = unit >> 8, tok0 = b * SEQ + n * 64;
    LAS bf16_t* LAhi = (LAS bf16_t*)F.lds; LAS bf16_t* LAlo = (LAS bf16_t*)(F.lds + 4608); LAS float* Fc = (LAS float*)(F.lds + 9216);
    LAS bf16_t* Qe = (LAS bf16_t*)(F.lds + 17408); LAS bf16_t* Ke = (LAS bf16_t*)(F.lds + 22528); LAS bf16_t* Qb = (LAS bf16_t*)(F.lds + 27648); LAS bf16_t* Sf = (LAS bf16_t*)(F.lds + 32768);
    LAS bf16_t* Vf = (LAS bf16_t*)(F.lds + 37888); LAS bf16_t* At = (LAS bf16_t*)(F.lds + 47104); LAS float* Of = (LAS float*)(F.lds + 56320);
    const int t = F.tid >> 3, c8 = F.tid & 7, w = F.wave, mt = w & 3, nt0 = (w >> 2) * 2, r16 = F.lane & 15, kq = F.lane >> 4;
    __syncthreads();
    gla_cum(F, l, h, tok0, LAhi, LAlo, Fc);
    { const u32x2 qw = *(const u32x2*)(P + (size_t)(tok0 + t) * NPROJ + PB_Q + h * 32 + c8 * 4), kw = *(const u32x2*)(P + (size_t)(tok0 + t) * NPROJ + PB_K + h * 32 + c8 * 4);
      const u32x4 vw = *(const u32x4*)(P + (size_t)(tok0 + t) * NPROJ + PB_V + h * 64 + c8 * 8);
      const f32x4 ct = *(const LAS f32x4*)(Fc + t * 32 + c8 * 4), cr = *(const LAS f32x4*)(Fc + 31 * 32 + c8 * 4);
      const float qs = 0.17677669529663687f;
      const float qf[4] = {bflo(qw.x) * qs, bfhi(qw.x) * qs, bflo(qw.y) * qs, bfhi(qw.y) * qs}, kf[4] = {bflo(kw.x), bfhi(kw.x), bflo(kw.y), bfhi(kw.y)};
      float qe[4], ke[4], qb[4];
#pragma unroll
      for (int j = 0; j < 4; ++j) { qe[j] = qf[j] * __expf(ct[j] - cr[j]); ke[j] = kf[j] * __expf(cr[j] - ct[j]); qb[j] = qf[j] * __expf(ct[j]); }
      u32x2 o; o.x = cvt_pk(qe[0], qe[1]); o.y = cvt_pk(qe[2], qe[3]); *(LAS u32x2*)(Qe + t * GP + c8 * 4) = o;
      o.x = cvt_pk(ke[0], ke[1]); o.y = cvt_pk(ke[2], ke[3]); *(LAS u32x2*)(Ke + t * GP + c8 * 4) = o;
      o.x = cvt_pk(qb[0], qb[1]); o.y = cvt_pk(qb[2], qb[3]); *(LAS u32x2*)(Qb + t * GP + c8 * 4) = o;
#pragma unroll
      for (int j = 0; j < 8; ++j) Vf[(c8 * 8 + j) * LP + t] = hw(vw, j);
      const int e = F.tid >> 4, f4 = (F.tid & 15) * 4; const f32x4 sv = *(const f32x4*)(SP + e * 64 + f4);
#pragma unroll
      for (int j = 0; j < 4; ++j) Sf[(f4 + j) * GP + e] = f2bf(sv[j]); }
    __syncthreads();
    { f32x4 acc[2] = {{0.f, 0.f, 0.f, 0.f}, {0.f, 0.f, 0.f, 0.f}}; mm64p<GP, 1>(acc, Qe, Ke, mt, nt0, F.lane);
#pragma unroll
      for (int j = 0; j < 2; ++j)
#pragma unroll
          for (int rg = 0; rg < 4; ++rg) { const int tt = 16 * mt + 4 * kq + rg, ss = 16 * (nt0 + j) + r16; At[tt * LP + ss] = f2bf(ss <= tt ? acc[j][rg] : 0.f); } }
    __syncthreads();
    { f32x4 acc[2] = {{0.f, 0.f, 0.f, 0.f}, {0.f, 0.f, 0.f, 0.f}}; mm64p<LP, 2>(acc, At, Vf, mt, nt0, F.lane); mm64p<GP, 1>(acc, Qb, Sf, mt, nt0, F.lane);
#pragma unroll
      for (int j = 0; j < 2; ++j)
#pragma unroll
          for (int rg = 0; rg < 4; ++rg) Of[(16 * mt + 4 * kq + rg) * 64 + 16 * (nt0 + j) + r16] = acc[j][rg]; }
    __syncthreads();
    { const int f0 = c8 * 8; const f32x4 o0 = *(const LAS f32x4*)(Of + t * 64 + f0), o1 = *(const LAS f32x4*)(Of + t * 64 + f0 + 4);
      const float o[8] = {o0[0], o0[1], o0[2], o0[3], o1[0], o1[1], o1[2], o1[3]};
      float ss = 0.f;
#pragma unroll
      for (int j = 0; j < 8; ++j) ss += o[j] * o[j];
      ss = oct_sum(ss);
      const float rstd = rsqrtf(ss * (1.f / 64.f) + NORM_EPS); const float* gn = INF(F, I_GLA_ON) + l * 256 + h * 64 + f0;
      const f32x4 g0 = *(const f32x4*)gn, g1 = *(const f32x4*)(gn + 4);
      const u32x4 gw = *(const u32x4*)(P + (size_t)(tok0 + t) * NPROJ + PB_G + h * 64 + f0);
      const float gb[8] = {bflo(gw.x), bfhi(gw.x), bflo(gw.y), bfhi(gw.y), bflo(gw.z), bfhi(gw.z), bflo(gw.w), bfhi(gw.w)};
      float r[8];
#pragma unroll
      for (int j = 0; j < 8; ++j) r[j] = o[j] * rstd * (j < 4 ? g0[j & 3] : g1[j & 3]) * (gb[j] * sigmoid_f(gb[j]));
      *(u32x4*)(MIX + (size_t)(tok0 + t) * DM + 256 + h * 64 + f0) = pack8v(r); }
}

__device__ __forceinline__ void gla_cum_a(Frame& F, int l, int h, int tok0, LAS bf16_t* LAhi, LAS bf16_t* LAlo) {
    const bf16_t* P = (const bf16_t*)(F.ws + WS_PROJ);
    const float* wa2 = INF(F, I_GLA_WA2) + l * 16 * 128 + h * 32; const float* ba = INF(F, I_GLA_BA) + l * 128 + h * 32;
    const int t = F.tid >> 3, e4 = (F.tid & 7) * 4;
    const u32x4 l0 = *(const u32x4*)(P + (size_t)(tok0 + t) * NPROJ + PB_LR), l1 = *(const u32x4*)(P + (size_t)(tok0 + t) * NPROJ + PB_LR + 8);
    const float lr[16] = {bflo(l0.x), bfhi(l0.x), bflo(l0.y), bfhi(l0.y), bflo(l0.z), bfhi(l0.z), bflo(l0.w), bfhi(l0.w), bflo(l1.x), bfhi(l1.x), bflo(l1.y), bfhi(l1.y), bflo(l1.z), bfhi(l1.z), bflo(l1.w), bfhi(l1.w)};
    f32x4 a = *(const f32x4*)(ba + e4);
#pragma unroll
    for (int r = 0; r < 16; ++r) a += lr[r] * *(const f32x4*)(wa2 + r * 128 + e4);
#pragma unroll
    for (int j = 0; j < 4; ++j) { const float la = logsigmoid_f(a[j]) * (1.f / 16.f); const bf16_t hi = f2bf(la); const bf16_t lo = f2bf(la - bf2f(hi));
        LAhi[(e4 + j) * LP + t] = hi; LAlo[(e4 + j) * LP + t] = lo; }
}
struct GlaW2 { bf16x8 whi, wlo; float ba; };
__device__ __forceinline__ void gla_loadw2(Frame& F, int l, int h, GlaW2& W) {
    const int nt = F.wave >> 2, r16 = F.lane & 15, kq = F.lane >> 4, e = 16 * nt + r16;
    const float* wa2 = INF(F, I_GLA_WA2) + l * 16 * 128 + h * 32 + e;
    W.ba = INF(F, I_GLA_BA)[l * 128 + h * 32 + e];
#pragma unroll
    for (int j = 0; j < 8; ++j) { const float wv = (kq < 2) ? wa2[(8 * (kq & 1) + j) * 128] : 0.f; const bf16_t hi = f2bf(wv); W.whi[j] = (short)hi; W.wlo[j] = (short)f2bf(wv - bf2f(hi)); }
}
__device__ __forceinline__ void gla_cum_a2(Frame& F, const GlaW2& W, int tok0, LAS bf16_t* LAhi, LAS bf16_t* LAlo) {
    const bf16_t* P = (const bf16_t*)(F.ws + WS_PROJ);
    const int mt = F.wave & 3, nt = F.wave >> 2, r16 = F.lane & 15, kq = F.lane >> 4;
    u32x4 lw = *(const u32x4*)(P + (size_t)(tok0 + 16 * mt + r16) * NPROJ + PB_LR + 8 * (kq & 1));
    if (kq >= 2) lw = (u32x4){0u, 0u, 0u, 0u};
    f32x4 acc = {0.f, 0.f, 0.f, 0.f};
    acc = __builtin_amdgcn_mfma_f32_16x16x32_bf16(__builtin_bit_cast(bf16x8, lw), W.whi, acc, 0, 0, 0);
    acc = __builtin_amdgcn_mfma_f32_16x16x32_bf16(__builtin_bit_cast(bf16x8, lw), W.wlo, acc, 0, 0, 0);
    float la[4]; bf16_t hi[4], lo[4];
#pragma unroll
    for (int rg = 0; rg < 4; ++rg) { la[rg] = logsigmoid_f(acc[rg] + W.ba) * (1.f / 16.f); hi[rg] = f2bf(la[rg]); lo[rg] = f2bf(la[rg] - bf2f(hi[rg])); }
    const int o = (16 * nt + r16) * LP + 16 * mt + 4 * kq;
    *(LAS u32x2*)(LAhi + o) = (u32x2){(unsigned)hi[0] | ((unsigned)hi[1] << 16), (unsigned)hi[2] | ((unsigned)hi[3] << 16)};
    *(LAS u32x2*)(LAlo + o) = (u32x2){(unsigned)lo[0] | ((unsigned)lo[1] << 16), (unsigned)lo[2] | ((unsigned)lo[3] << 16)};
}
__device__ __forceinline__ void gla_cum_b(Frame& F, const LAS bf16_t* LAhi, const LAS bf16_t* LAlo, LAS float* Fc) {
    const int w = F.wave, mt = w & 3, nt = w >> 2, r16 = F.lane & 15, kq = F.lane >> 4; f32x4 acc = {0.f, 0.f, 0.f, 0.f};
#pragma unroll
    for (int s = 0; s < 2; ++s) { bf16x8 tri;
#pragma unroll
        for (int j = 0; j < 8; ++j) tri[j] = (32 * s + 8 * kq + j <= 16 * mt + r16) ? (short)0x3F80 : (short)0;
        acc = __builtin_amdgcn_mfma_f32_16x16x32_bf16(tri, *(const LAS bf16x8*)(LAhi + (16 * nt + r16) * LP + 32 * s + 8 * kq), acc, 0, 0, 0);
        acc = __builtin_amdgcn_mfma_f32_16x16x32_bf16(tri, *(const LAS bf16x8*)(LAlo + (16 * nt + r16) * LP + 32 * s + 8 * kq), acc, 0, 0, 0); }
#pragma unroll
    for (int rg = 0; rg < 4; ++rg) Fc[(16 * mt + 4 * kq + rg) * 32 + 16 * nt + r16] = acc[rg];
}
constexpr int GKV_U = 31232, GOUT_U = 56320;
__device__ __forceinline__ void gla_kv2_pair(Frame& F, int l, int unit0, const GlaW2& W) {
    const bf16_t* P = (const bf16_t*)(F.ws + WS_PROJ);
    const int n = unit0 & 63, h = (unit0 >> 6) & 3, t = F.tid >> 3, c8 = F.tid & 7;
#define GKV_PTRS(uu) const int unit = unit0 + 256 * (uu), tok0 = (unit >> 8) * SEQ + n * 64; LAS unsigned char* B_ = F.lds + (uu) * GKV_U; \
        LAS bf16_t* LAhi = (LAS bf16_t*)B_; LAS bf16_t* LAlo = (LAS bf16_t*)(B_ + 4608); LAS float* Fc = (LAS float*)(B_ + 9216); LAS bf16_t* Ke = (LAS bf16_t*)(B_ + 17408); LAS bf16_t* Vf = (LAS bf16_t*)(B_ + 22016); \
        (void)unit; (void)tok0; (void)LAhi; (void)LAlo; (void)Fc; (void)Ke; (void)Vf
    __syncthreads();
#pragma unroll
    for (int uu = 0; uu < 2; ++uu) { GKV_PTRS(uu); gla_cum_a2(F, W, tok0, LAhi, LAlo); }
    __syncthreads();
#pragma unroll
    for (int uu = 0; uu < 2; ++uu) { GKV_PTRS(uu); gla_cum_b(F, LAhi, LAlo, Fc); }
    __syncthreads();
#pragma unroll
    for (int uu = 0; uu < 2; ++uu) { GKV_PTRS(uu); float* DEC = (float*)(F.ws + WS_GLA_DEC) + unit * 32;
      const u32x2 kw = *(const u32x2*)(P + (size_t)(tok0 + t) * NPROJ + PB_K + h * 32 + c8 * 4); const u32x4 vw = *(const u32x4*)(P + (size_t)(tok0 + t) * NPROJ + PB_V + h * 64 + c8 * 8);
      const f32x4 ct = *(const LAS f32x4*)(Fc + t * 32 + c8 * 4), cl = *(const LAS f32x4*)(Fc + 63 * 32 + c8 * 4);
      const float kf[4] = {bflo(kw.x), bfhi(kw.x), bflo(kw.y), bfhi(kw.y)};
#pragma unroll
      for (int j = 0; j < 4; ++j) { Ke[(c8 * 4 + j) * LP + t] = f2bf(kf[j] * __expf(cl[j] - ct[j])); if (t == 63) DEC[c8 * 4 + j] = __expf(cl[j]); }
#pragma unroll
      for (int j = 0; j < 8; ++j) Vf[(c8 * 8 + j) * LP + t] = hw(vw, j); }
    __syncthreads();
#pragma unroll
    for (int uu = 0; uu < 2; ++uu) { GKV_PTRS(uu); float* KV = (float*)(F.ws + WS_GLA_KV) + (size_t)unit * 2048;
      const int w = F.wave, mt = w & 1, nt = w >> 1, r16 = F.lane & 15, kq = F.lane >> 4; f32x4 acc = {0.f, 0.f, 0.f, 0.f};
      mm_tile<LP, 2>(acc, Ke, Vf, mt, nt, F.lane);
#pragma unroll
      for (int rg = 0; rg < 4; ++rg) KV[(16 * mt + 4 * kq + rg) * 64 + 16 * nt + r16] = acc[rg]; }
#undef GKV_PTRS
}
__device__ __forceinline__ void gla_out2_pair(Frame& F, int l, int unit0, const GlaW2& W, int stop = 0) {
    const bf16_t* P = (const bf16_t*)(F.ws + WS_PROJ); bf16_t* MIX = (bf16_t*)(F.ws + WS_MIX);
    const int n = unit0 & 63, h = (unit0 >> 6) & 3;
    const int t = F.tid >> 3, c8 = F.tid & 7, w = F.wave, mt = w & 3, nt0 = (w >> 2) * 2, r16 = F.lane & 15, kq = F.lane >> 4;
#define GOUT_PTRS(uu) const int unit = unit0 + 256 * (uu), tok0 = (unit >> 8) * SEQ + n * 64; LAS unsigned char* B_ = F.lds + (uu) * GOUT_U; \
        LAS bf16_t* LAhi = (LAS bf16_t*)B_; LAS bf16_t* LAlo = (LAS bf16_t*)(B_ + 4608); LAS float* Fc = (LAS float*)(B_ + 9216); LAS float* Of = (LAS float*)B_; \
        LAS bf16_t* Qe = (LAS bf16_t*)(B_ + 17408); LAS bf16_t* Ke = (LAS bf16_t*)(B_ + 22528); LAS bf16_t* Qb = (LAS bf16_t*)(B_ + 27648); LAS bf16_t* Sf = (LAS bf16_t*)(B_ + 32768); \
        LAS bf16_t* Vf = (LAS bf16_t*)(B_ + 37888); LAS bf16_t* At = (LAS bf16_t*)(B_ + 47104); \
        (void)unit; (void)tok0; (void)LAhi; (void)LAlo; (void)Fc; (void)Of; (void)Qe; (void)Ke; (void)Qb; (void)Sf; (void)Vf; (void)At
    __syncthreads();
#pragma unroll
    for (int uu = 0; uu < 2; ++uu) { GOUT_PTRS(uu); gla_cum_a2(F, W, tok0, LAhi, LAlo); }
    __syncthreads();
    if (stop == 1) return;
#pragma unroll
    for (int uu = 0; uu < 2; ++uu) { GOUT_PTRS(uu); gla_cum_b(F, LAhi, LAlo, Fc); }
    __syncthreads();
    if (stop == 2) return;
#pragma unroll
    for (int uu = 0; uu < 2; ++uu) { GOUT_PTRS(uu); const float* SP = (const float*)(F.ws + WS_GLA_KV) + (size_t)unit * 2048;
      const u32x2 qw = *(const u32x2*)(P + (size_t)(tok0 + t) * NPROJ + PB_Q + h * 32 + c8 * 4), kw = *(const u32x2*)(P + (size_t)(tok0 + t) * NPROJ + PB_K + h * 32 + c8 * 4);
      const u32x4 vw = *(const u32x4*)(P + (size_t)(tok0 + t) * NPROJ + PB_V + h * 64 + c8 * 8);
      const f32x4 ct = *(const LAS f32x4*)(Fc + t * 32 + c8 * 4), cr = *(const LAS f32x4*)(Fc + 31 * 32 + c8 * 4);
      const float qs = 0.17677669529663687f;
      const float qf[4] = {bflo(qw.x) * qs, bfhi(qw.x) * qs, bflo(qw.y) * qs, bfhi(qw.y) * qs}, kf[4] = {bflo(kw.x), bfhi(kw.x), bflo(kw.y), bfhi(kw.y)};
      float qe[4], ke[4], qb[4];
#pragma unroll
      for (int j = 0; j < 4; ++j) { qe[j] = qf[j] * __expf(ct[j] - cr[j]); ke[j] = kf[j] * __expf(cr[j] - ct[j]); qb[j] = qf[j] * __expf(ct[j]); }
      u32x2 o; o.x = cvt_pk(qe[0], qe[1]); o.y = cvt_pk(qe[2], qe[3]); *(LAS u32x2*)(Qe + t * GP + c8 * 4) = o;
      o.x = cvt_pk(ke[0], ke[1]); o.y = cvt_pk(ke[2], ke[3]); *(LAS u32x2*)(Ke + t * GP + c8 * 4) = o;
      o.x = cvt_pk(qb[0], qb[1]); o.y = cvt_pk(qb[2], qb[3]); *(LAS u32x2*)(Qb + t * GP + c8 * 4) = o;
#pragma unroll
      for (int j = 0; j < 8; ++j) Vf[(c8 * 8 + j) * LP + t] = hw(vw, j);
      const int e = F.tid >> 4, f4 = (F.tid & 15) * 4; const f32x4 sv = *(const f32x4*)(SP + e * 64 + f4);
#pragma unroll
      for (int j = 0; j < 4; ++j) Sf[(f4 + j) * GP + e] = f2bf(sv[j]); }
    __syncthreads();
    if (stop == 3) return;
#pragma unroll
    for (int uu = 0; uu < 2; ++uu) { GOUT_PTRS(uu); f32x4 acc[2] = {{0.f, 0.f, 0.f, 0.f}, {0.f, 0.f, 0.f, 0.f}}; mm64p<GP, 1>(acc, Qe, Ke, mt, nt0, F.lane);
#pragma unroll
      for (int j = 0; j < 2; ++j)
#pragma unroll
          for (int rg = 0; rg < 4; ++rg) { const int tt = 16 * mt + 4 * kq + rg, ss = 16 * (nt0 + j) + r16; At[tt * LP + ss] = f2bf(ss <= tt ? acc[j][rg] : 0.f); } }
    __syncthreads();
    if (stop == 4) return;
#pragma unroll
    for (int uu = 0; uu < 2; ++uu) { GOUT_PTRS(uu); f32x4 acc[2] = {{0.f, 0.f, 0.f, 0.f}, {0.f, 0.f, 0.f, 0.f}}; mm64p<LP, 2>(acc, At, Vf, mt, nt0, F.lane); mm64p<GP, 1>(acc, Qb, Sf, mt, nt0, F.lane);
#pragma unroll
      for (int j = 0; j < 2; ++j)
#pragma unroll
          for (int rg = 0; rg < 4; ++rg) Of[(16 * mt + 4 * kq + rg) * 64 + 16 * (nt0 + j) + r16] = acc[j][rg]; }
    __syncthreads();
    if (stop == 5) return;
#pragma unroll
    for (int uu = 0; uu < 2; ++uu) { GOUT_PTRS(uu); const int f0 = c8 * 8; const f32x4 o0 = *(const LAS f32x4*)(Of + t * 64 + f0), o1 = *(const LAS f32x4*)(Of + t * 64 + f0 + 4);
      const float o[8] = {o0[0], o0[1], o0[2], o0[3], o1[0], o1[1], o1[2], o1[3]};
      float ss = 0.f;
#pragma unroll
      for (int j = 0; j < 8; ++j) ss += o[j] * o[j];
      ss = oct_sum(ss);
      const float rstd = rsqrtf(ss * (1.f / 64.f) + NORM_EPS); const float* gn = INF(F, I_GLA_ON) + l * 256 + h * 64 + f0;
      const f32x4 g0 = *(const f32x4*)gn, g1 = *(const f32x4*)(gn + 4);
      const u32x4 gw = *(const u32x4*)(P + (size_t)(tok0 + t) * NPROJ + PB_G + h * 64 + f0);
      const float gb[8] = {bflo(gw.x), bfhi(gw.x), bflo(gw.y), bfhi(gw.y), bflo(gw.z), bfhi(gw.z), bflo(gw.w), bfhi(gw.w)};
      float r[8];
#pragma unroll
      for (int j = 0; j < 8; ++j) r[j] = o[j] * rstd * (j < 4 ? g0[j & 3] : g1[j & 3]) * (gb[j] * sigmoid_f(gb[j]));
      *(u32x4*)(MIX + (size_t)(tok0 + t) * DM + 256 + h * 64 + f0) = pack8v(r); }
#undef GOUT_PTRS
}
struct Args { const void* in[N_IN]; float* out; unsigned char* ws; int ph_lo, ph_hi, sub, pad; };
constexpr int PH_PER_LAYER = 10, PH_FINAL = DEPTH * PH_PER_LAYER, PH_END = PH_FINAL + 2;
#ifndef EN_MASK
#define EN_MASK 0xFFFF
#endif
#define EN(b) ((EN_MASK >> (b)) & 1)
#ifndef DUP_MASK
#define DUP_MASK 0
#endif
#define NREP(b) (1 + ((DUP_MASK >> (b)) & 1))
enum Phase { P_PREP = 0, P_INPROJ, P_MIX1, P_MIX2, P_MIX3, P_OUTPROJ, P_NORM2, P_MAP, P_UP, P_DOWN };

__global__ void __launch_bounds__(512, 2) fwd_kernel(Args args) {
    extern __shared__ __attribute__((aligned(16))) unsigned char lds_raw[];
    Frame F;
    F.lds = (LAS unsigned char*)lds_raw;
    F.tid = threadIdx.x; F.lane = F.tid & 63; F.wave = __builtin_amdgcn_readfirstlane(F.tid >> 6);
    F.bid = blockIdx.x; F.G = gridDim.x;
    F.ws = args.ws; F.ctl = (unsigned*)(args.ws + WS_CTL); F.out = args.out;
    if (F.tid < N_IN) ((LAS unsigned long long*)(F.lds + PTR_OFF))[F.tid] = (unsigned long long)args.in[F.tid];
    volatile LAS unsigned* MISC = (volatile LAS unsigned*)(F.lds + MISC_OFF);
    if (F.tid < 8) MISC[F.tid] = 0u;
    __syncthreads();
    const int lo = args.ph_lo, hi = args.ph_hi, sub = args.sub;
    const int wave_sgpr = F.wave;
    XcdBarrier bar; bar.bar = F.ctl + CW_BAR; bar.x = 0; bar.st = MISC;
    if (hi - lo > 1) bar = xcd_barrier_post(F.ctl + CW_BAR, MISC);
#define HB ((bf16_t*)(F.ws + WS_H))
#define PROJ ((bf16_t*)(F.ws + WS_PROJ))
#define MIXB ((bf16_t*)(F.ws + WS_MIX))
#define ACT ((bf16_t*)(F.ws + WS_PROJ))
#define XBUF ((bf16_t*)((unsigned char*)F.out + XB_OFF))
#define IN(k) (lo <= (k) && (k) < hi)
#define PH_BEGIN() do { int w_i = wave_sgpr; asm volatile("" : "+s"(w_i)); unsigned m_i = ~0u; asm volatile("" : "+s"(m_i)); int l_i = (int)__builtin_amdgcn_mbcnt_hi(m_i, __builtin_amdgcn_mbcnt_lo(m_i, 0u)); asm volatile("" : "+v"(l_i)); F.wave = w_i; F.lane = l_i; F.tid = w_i * 64 + l_i; \
        GAS unsigned char* w_ = (GAS unsigned char*)args.ws; asm volatile("" : "+s"(w_)); F.ws = (unsigned char*)w_; F.ctl = (unsigned*)((unsigned char*)w_ + WS_CTL); F.out = (float*)(GAS float*)args.out; F.lds = (LAS unsigned char*)lds_raw; } while (0)
#define SEAM(k) do { if ((k) + 1 < hi) { GAS unsigned* bp_ = (GAS unsigned*)(F.ctl + CW_BAR); asm volatile("" : "+s"(bp_)); bar.bar = (unsigned*)bp_; unsigned bx_ = bar.x; asm volatile("" : "+s"(bx_)); bar.x = bx_; int w_j = wave_sgpr; asm volatile("" : "+s"(w_j)); unsigned m_j = ~0u; asm volatile("" : "+s"(m_j)); const int l_j = (int)__builtin_amdgcn_mbcnt_hi(m_j, __builtin_amdgcn_mbcnt_lo(m_j, 0u)); xcd_barrier(bar, w_j == 0 && l_j == 0); } } while (0)

    if (EN(0) && IN(0)) { PH_BEGIN(); phase_rope_tables(F); }
    { constexpr int l = 0;
        const int pb = l * PH_PER_LAYER; const bool moe = (l & 1) != 0; const int ms = l >> 1;

        if (EN(0) && IN(pb + P_PREP)) { PH_BEGIN();
            if (sub & 1) { phase_convert_weights(F, l); rwkv_convert_small(F, l); }
            __syncthreads();
            if (sub & 2) { if (l == 0) phase_norm_lr<true, false>(F, INF(F, I_X), INF(F, I_ATTN_NORM) + l * DM, l); else if (((l - 1) & 1) != 0) phase_norm_lr<false, true>(F, XBUF, INF(F, I_ATTN_NORM) + l * DM, l); else phase_norm_lr<false, false>(F, XBUF, INF(F, I_ATTN_NORM) + l * DM, l); }
            SEAM(pb + P_PREP);
        }
        if (EN(1) && IN(pb + P_INPROJ)) { PH_BEGIN();
            pg8::Gemm g{HB, (const bf16_t*)(F.ws + WS_WIN), DM, nullptr}; pg8::StaticOrder S; S.init(NTOK, 3072, F.G, F.bid);
            pg8::EpiBf16 E{PROJ, NPROJ};
            pg8::gemm_phase<pg8::EpiBf16, pg8::StaticOrder, false>(F.tid, F.lds, g, S, E);
            SEAM(pb + P_INPROJ);
        }
        if (EN(2) && IN(pb + P_MIX1)) { PH_BEGIN();
            if (sub & 1) { rwkv_r1_tables(F, l); for (int unit = F.bid; unit < 2048; unit += F.G) rwkv_r1_unit(F, l, unit, (sub >> 8) & 15); }
            if (sub & 2) { GlaW2 gw; gla_loadw2(F, l, (F.bid >> 6) & 3, gw); for (int unit = F.bid; unit < 2048; unit += 2 * F.G) gla_kv2_pair(F, l, unit, gw); }
            SEAM(pb + P_MIX1);
        }
        if (EN(3) && IN(pb + P_MIX2)) { PH_BEGIN();
            if (F.bid < 32) { if (sub & 1) rwkv_r2_block(F, F.bid); }
            else { const int ob = F.bid - 32, NO = F.G - 32;
                if (sub & 2) for (int gt = ob * 512 + F.tid; gt < 65536; gt += NO * 512) gla_scan(F, gt); }
            if (sub & 12) {
                volatile LAS int* qw = (volatile LAS int*)(F.lds + MISC_OFF + 28);
                unsigned* qctr = F.ctl + CW_ATTNQ + 64 * l + ((sub >> 4) & 1) * 32;
                int nxt = 0;
                if (F.tid == 0) nxt = (int)atomicAdd(qctr, 1u);
                for (;;) {
                    __syncthreads();
                    if (F.tid == 0) *qw = nxt;
                    __syncthreads();
                    const int task = *qw;
                    if (task >= 1024) break;
                    if (F.tid == 0) nxt = (int)atomicAdd(qctr, 1u);
                    if (task < 512) { if (sub & 4) attn_block<false>(F, l, task); } else if (sub & 8) attn_block<true>(F, l, task - 512);
                }
            }
            SEAM(pb + P_MIX2);
        }
        if (EN(4) && IN(pb + P_MIX3)) { PH_BEGIN();
            if (sub & 1) { GlaW2 gw; gla_loadw2(F, l, (F.bid >> 6) & 3, gw); for (int unit = F.bid; unit < 2048; unit += 2 * F.G) gla_out2_pair(F, l, unit, gw, (sub >> 8) & 15); }
            __syncthreads();
            if (sub & 2) for (int unit = F.bid * 8 + F.wave; unit < 2048; unit += F.G * 8) rwkv_r3_task(F, l, unit);
            SEAM(pb + P_MIX3);
        }
        if (EN(5) && IN(pb + P_OUTPROJ)) { PH_BEGIN();
            __syncthreads();
            pg8::Gemm g{MIXB, (const bf16_t*)(F.ws + WS_WOUT), DM, nullptr}; pg8::StaticOrder S; S.init(NTOK, DM, F.G, F.bid);
            if (l == 0) { pg8::EpiResidB<true> E{INF(F, I_X), XBUF, DM}; pg8::gemm_phase<pg8::EpiResidB<true>, pg8::StaticOrder, false>(F.tid, F.lds, g, S, E); }
            else { pg8::EpiResidB<false> E{XBUF, XBUF, DM}; pg8::gemm_phase<pg8::EpiResidB<false>, pg8::StaticOrder, false>(F.tid, F.lds, g, S, E); }
            SEAM(pb + P_OUTPROJ);
        }
        if (EN(6) && IN(pb + P_NORM2)) { PH_BEGIN();
            if (moe) phase_norm<1, false>(F, XBUF, INF(F, I_FFN_NORM) + l * DM, false, ms);
            else phase_norm<0, false>(F, XBUF, INF(F, I_FFN_NORM) + l * DM, false, 0);
            SEAM(pb + P_NORM2);
        }
        if (EN(7) && IN(pb + P_MAP)) { PH_BEGIN();
            if (moe) { phase_moe_map(F, ms); SEAM(pb + P_MAP); }
        }
        if (EN(8) && IN(pb + P_UP)) { PH_BEGIN();
            __syncthreads();
            if (!moe) {
                pg8::Gemm g{HB, (const bf16_t*)(F.ws + WS_W13), DM / 2, nullptr}; pg8::StaticOrder S; S.init(NTOK, 2 * D_FF, F.G, F.bid);
                pg8::EpiSwiglu8 E{(unsigned char*)ACT, D_FF, 0.015625f};
                pg8::gemm_phase<pg8::EpiSwiglu8, pg8::StaticOrder, false, true>(F.tid, F.lds, g, S, E);
            } else {
                pg8::MoeOrder S; moe_bases(F.ctl + CW_MOECNT + 64 * ms, S.tb); S.ntiles = S.tb[8]; S.nNe = 2 * D_FFE / 256; S.G = F.G; S.c = F.bid;
                pg8::Gemm g{HB, (const bf16_t*)(F.ws + WS_W13), DM / 2, (const int*)(F.ws + WS_ROWMAP)};
                pg8::EpiSwiglu8 E{(unsigned char*)ACT, KP8, 0.015625f};
                pg8::gemm_phase<pg8::EpiSwiglu8, pg8::MoeOrder, true, true>(F.tid, F.lds, g, S, E);
            }
            SEAM(pb + P_UP);
        }
        if (EN(9) && IN(pb + P_DOWN)) { PH_BEGIN();
            __syncthreads();
            if (!moe) {
                pg8::Gemm g{ACT, (const bf16_t*)(F.ws + WS_W2), D_FF / 2, nullptr}; pg8::StaticOrder S; S.init(NTOK, DM, F.G, F.bid);
                pg8::EpiResidB<false> E{XBUF, XBUF, DM, 0.015625f};
                pg8::gemm_phase<pg8::EpiResidB<false>, pg8::StaticOrder, false, true>(F.tid, F.lds, g, S, E);
            } else {
                pg8::MoeOrder S; moe_bases(F.ctl + CW_MOECNT + 64 * ms, S.tb); S.ntiles = S.tb[8]; S.nNe = DM / 256; S.G = F.G; S.c = F.bid;
                pg8::Gemm g{ACT, (const bf16_t*)(F.ws + WS_W2), KP8 / 2, nullptr};
                pg8::EpiBf16 E{(bf16_t*)(F.ws + WS_Y), DM, 0.015625f};
                pg8::gemm_phase<pg8::EpiBf16, pg8::MoeOrder, false, true>(F.tid, F.lds, g, S, E);
            }
            SEAM(pb + P_DOWN);
        }
        }
    { constexpr int l = 1;
        const int pb = l * PH_PER_LAYER; const bool moe = (l & 1) != 0; const int ms = l >> 1;

        if (EN(0) && IN(pb + P_PREP)) { PH_BEGIN();
            if (sub & 1) { phase_convert_weights(F, l); rwkv_convert_small(F, l); }
            __syncthreads();
            if (sub & 2) { if (l == 0) phase_norm_lr<true, false>(F, INF(F, I_X), INF(F, I_ATTN_NORM) + l * DM, l); else if (((l - 1) & 1) != 0) phase_norm_lr<false, true>(F, XBUF, INF(F, I_ATTN_NORM) + l * DM, l); else phase_norm_lr<false, false>(F, XBUF, INF(F, I_ATTN_NORM) + l * DM, l); }
            SEAM(pb + P_PREP);
        }
        if (EN(1) && IN(pb + P_INPROJ)) { PH_BEGIN();
            pg8::Gemm g{HB, (const bf16_t*)(F.ws + WS_WIN), DM, nullptr}; pg8::StaticOrder S; S.init(NTOK, 3072, F.G, F.bid);
            pg8::EpiBf16 E{PROJ, NPROJ};
            pg8::gemm_phase<pg8::EpiBf16, pg8::StaticOrder, false>(F.tid, F.lds, g, S, E);
            SEAM(pb + P_INPROJ);
        }
        if (EN(2) && IN(pb + P_MIX1)) { PH_BEGIN();
            if (sub & 1) { rwkv_r1_tables(F, l); for (int unit = F.bid; unit < 2048; unit += F.G) rwkv_r1_unit(F, l, unit, (sub >> 8) & 15); }
            if (sub & 2) { GlaW2 gw; gla_loadw2(F, l, (F.bid >> 6) & 3, gw); for (int unit = F.bid; unit < 2048; unit += 2 * F.G) gla_kv2_pair(F, l, unit, gw); }
            SEAM(pb + P_MIX1);
        }
        if (EN(3) && IN(pb + P_MIX2)) { PH_BEGIN();
            if (F.bid < 32) { if (sub & 1) rwkv_r2_block(F, F.bid); }
            else { const int ob = F.bid - 32, NO = F.G - 32;
                if (sub & 2) for (int gt = ob * 512 + F.tid; gt < 65536; gt += NO * 512) gla_scan(F, gt); }
            if (sub & 12) {
                volatile LAS int* qw = (volatile LAS int*)(F.lds + MISC_OFF + 28);
                unsigned* qctr = F.ctl + CW_ATTNQ + 64 * l + ((sub >> 4) & 1) * 32;
                int nxt = 0;
                if (F.tid == 0) nxt = (int)atomicAdd(qctr, 1u);
                for (;;) {
                    __syncthreads();
                    if (F.tid == 0) *qw = nxt;
                    __syncthreads();
                    const int task = *qw;
                    if (task >= 1024) break;
                    if (F.tid == 0) nxt = (int)atomicAdd(qctr, 1u);
                    if (task < 512) { if (sub & 4) attn_block<false>(F, l, task); } else if (sub & 8) attn_block<true>(F, l, task - 512);
                }
            }
            SEAM(pb + P_MIX2);
        }
        if (EN(4) && IN(pb + P_MIX3)) { PH_BEGIN();
            if (sub & 1) { GlaW2 gw; gla_loadw2(F, l, (F.bid >> 6) & 3, gw); for (int unit = F.bid; unit < 2048; unit += 2 * F.G) gla_out2_pair(F, l, unit, gw, (sub >> 8) & 15); }
            __syncthreads();
            if (sub & 2) for (int unit = F.bid * 8 + F.wave; unit < 2048; unit += F.G * 8) rwkv_r3_task(F, l, unit);
            SEAM(pb + P_MIX3);
        }
        if (EN(5) && IN(pb + P_OUTPROJ)) { PH_BEGIN();
            __syncthreads();
            pg8::Gemm g{MIXB, (const bf16_t*)(F.ws + WS_WOUT), DM, nullptr}; pg8::StaticOrder S; S.init(NTOK, DM, F.G, F.bid);
            if (l == 0) { pg8::EpiResidB<true> E{INF(F, I_X), XBUF, DM}; pg8::gemm_phase<pg8::EpiResidB<true>, pg8::StaticOrder, false>(F.tid, F.lds, g, S, E); }
            else { pg8::EpiResidB<false> E{XBUF, XBUF, DM}; pg8::gemm_phase<pg8::EpiResidB<false>, pg8::StaticOrder, false>(F.tid, F.lds, g, S, E); }
            SEAM(pb + P_OUTPROJ);
        }
        if (EN(6) && IN(pb + P_NORM2)) { PH_BEGIN();
            if (moe) phase_norm<1, false>(F, XBUF, INF(F, I_FFN_NORM) + l * DM, false, ms);
            else phase_norm<0, false>(F, XBUF, INF(F, I_FFN_NORM) + l * DM, false, 0);
            SEAM(pb + P_NORM2);
        }
        if (EN(7) && IN(pb + P_MAP)) { PH_BEGIN();
            if (moe) { phase_moe_map(F, ms); SEAM(pb + P_MAP); }
        }
        if (EN(8) && IN(pb + P_UP)) { PH_BEGIN();
            __syncthreads();
            if (!moe) {
                pg8::Gemm g{HB, (const bf16_t*)(F.ws + WS_W13), DM / 2, nullptr}; pg8::StaticOrder S; S.init(NTOK, 2 * D_FF, F.G, F.bid);
                pg8::EpiSwiglu8 E{(unsigned char*)ACT, D_FF, 0.015625f};
                pg8::gemm_phase<pg8::EpiSwiglu8, pg8::StaticOrder, false, true>(F.tid, F.lds, g, S, E);
            } else {
                pg8::MoeOrder S; moe_bases(F.ctl + CW_MOECNT + 64 * ms, S.tb); S.ntiles = S.tb[8]; S.nNe = 2 * D_FFE / 256; S.G = F.G; S.c = F.bid;
                pg8::Gemm g{HB, (const bf16_t*)(F.ws + WS_W13), DM / 2, (const int*)(F.ws + WS_ROWMAP)};
                pg8::EpiSwiglu8 E{(unsigned char*)ACT, KP8, 0.015625f};
                pg8::gemm_phase<pg8::EpiSwiglu8, pg8::MoeOrder, true, true>(F.tid, F.lds, g, S, E);
            }
            SEAM(pb + P_UP);
        }
        if (EN(9) && IN(pb + P_DOWN)) { PH_BEGIN();
            __syncthreads();
            if (!moe) {
                pg8::Gemm g{ACT, (const bf16_t*)(F.ws + WS_W2), D_FF / 2, nullptr}; pg8::StaticOrder S; S.init(NTOK, DM, F.G, F.bid);
                pg8::EpiResidB<false> E{XBUF, XBUF, DM, 0.015625f};
                pg8::gemm_phase<pg8::EpiResidB<false>, pg8::StaticOrder, false, true>(F.tid, F.lds, g, S, E);
            } else {
                pg8::MoeOrder S; moe_bases(F.ctl + CW_MOECNT + 64 * ms, S.tb); S.ntiles = S.tb[8]; S.nNe = DM / 256; S.G = F.G; S.c = F.bid;
                pg8::Gemm g{ACT, (const bf16_t*)(F.ws + WS_W2), KP8 / 2, nullptr};
                pg8::EpiBf16 E{(bf16_t*)(F.ws + WS_Y), DM, 0.015625f};
                pg8::gemm_phase<pg8::EpiBf16, pg8::MoeOrder, false, true>(F.tid, F.lds, g, S, E);
            }
            SEAM(pb + P_DOWN);
        }
        }
    { constexpr int l = 2;
        const int pb = l * PH_PER_LAYER; const bool moe = (l & 1) != 0; const int ms = l >> 1;

        if (EN(0) && IN(pb + P_PREP)) { PH_BEGIN();
            if (sub & 1) { phase_convert_weights(F, l); rwkv_convert_small(F, l); }
            __syncthreads();
            if (sub & 2) { if (l == 0) phase_norm_lr<true, false>(F, INF(F, I_X), INF(F, I_ATTN_NORM) + l * DM, l); else if (((l - 1) & 1) != 0) phase_norm_lr<false, true>(F, XBUF, INF(F, I_ATTN_NORM) + l * DM, l); else phase_norm_lr<false, false>(F, XBUF, INF(F, I_ATTN_NORM) + l * DM, l); }
            SEAM(pb + P_PREP);
        }
        if (EN(1) && IN(pb + P_INPROJ)) { PH_BEGIN();
            pg8::Gemm g{HB, (const bf16_t*)(F.ws + WS_WIN), DM, nullptr}; pg8::StaticOrder S; S.init(NTOK, 3072, F.G, F.bid);
            pg8::EpiBf16 E{PROJ, NPROJ};
            pg8::gemm_phase<pg8::EpiBf16, pg8::StaticOrder, false>(F.tid, F.lds, g, S, E);
            SEAM(pb + P_INPROJ);
        }
        if (EN(2) && IN(pb + P_MIX1)) { PH_BEGIN();
            if (sub & 1) { rwkv_r1_tables(F, l); for (int unit = F.bid; unit < 2048; unit += F.G) rwkv_r1_unit(F, l, unit, (sub >> 8) & 15); }
            if (sub & 2) { GlaW2 gw; gla_loadw2(F, l, (F.bid >> 6) & 3, gw); for (int unit = F.bid; unit < 2048; unit += 2 * F.G) gla_kv2_pair(F, l, unit, gw); }
            SEAM(pb + P_MIX1);
        }
        if (EN(3) && IN(pb + P_MIX2)) { PH_BEGIN();
            if (F.bid < 32) { if (sub & 1) rwkv_r2_block(F, F.bid); }
            else { const int ob = F.bid - 32, NO = F.G - 32;
                if (sub & 2) for (int gt = ob * 512 + F.tid; gt < 65536; gt += NO * 512) gla_scan(F, gt); }
            if (sub & 12) {
                volatile LAS int* qw = (volatile LAS int*)(F.lds + MISC_OFF + 28);
                unsigned* qctr = F.ctl + CW_ATTNQ + 64 * l + ((sub >> 4) & 1) * 32;
                int nxt = 0;
                if (F.tid == 0) nxt = (int)atomicAdd(qctr, 1u);
                for (;;) {
                    __syncthreads();
                    if (F.tid == 0) *qw = nxt;
                    __syncthreads();
                    const int task = *qw;
                    if (task >= 1024) break;
                    if (F.tid == 0) nxt = (int)atomicAdd(qctr, 1u);
                    if (task < 512) { if (sub & 4) attn_block<false>(F, l, task); } else if (sub & 8) attn_block<true>(F, l, task - 512);
                }
            }
            SEAM(pb + P_MIX2);
        }
        if (EN(4) && IN(pb + P_MIX3)) { PH_BEGIN();
            if (sub & 1) { GlaW2 gw; gla_loadw2(F, l, (F.bid >> 6) & 3, gw); for (int unit = F.bid; unit < 2048; unit += 2 * F.G) gla_out2_pair(F, l, unit, gw, (sub >> 8) & 15); }
            __syncthreads();
            if (sub & 2) for (int unit = F.bid * 8 + F.wave; unit < 2048; unit += F.G * 8) rwkv_r3_task(F, l, unit);
            SEAM(pb + P_MIX3);
        }
        if (EN(5) && IN(pb + P_OUTPROJ)) { PH_BEGIN();
            __syncthreads();
            pg8::Gemm g{MIXB, (const bf16_t*)(F.ws + WS_WOUT), DM, nullptr}; pg8::StaticOrder S; S.init(NTOK, DM, F.G, F.bid);
            if (l == 0) { pg8::EpiResidB<true> E{INF(F, I_X), XBUF, DM}; pg8::gemm_phase<pg8::EpiResidB<true>, pg8::StaticOrder, false>(F.tid, F.lds, g, S, E); }
            else { pg8::EpiResidB<false> E{XBUF, XBUF, DM}; pg8::gemm_phase<pg8::EpiResidB<false>, pg8::StaticOrder, false>(F.tid, F.lds, g, S, E); }
            SEAM(pb + P_OUTPROJ);
        }
        if (EN(6) && IN(pb + P_NORM2)) { PH_BEGIN();
            if (moe) phase_norm<1, false>(F, XBUF, INF(F, I_FFN_NORM) + l * DM, false, ms);
            else phase_norm<0, false>(F, XBUF, INF(F, I_FFN_NORM) + l * DM, false, 0);
            SEAM(pb + P_NORM2);
        }
        if (EN(7) && IN(pb + P_MAP)) { PH_BEGIN();
            if (moe) { phase_moe_map(F, ms); SEAM(pb + P_MAP); }
        }
        if (EN(8) && IN(pb + P_UP)) { PH_BEGIN();
            __syncthreads();
            if (!moe) {
                pg8::Gemm g{HB, (const bf16_t*)(F.ws + WS_W13), DM / 2, nullptr}; pg8::StaticOrder S; S.init(NTOK, 2 * D_FF, F.G, F.bid);
                pg8::EpiSwiglu8 E{(unsigned char*)ACT, D_FF, 0.015625f};
                pg8::gemm_phase<pg8::EpiSwiglu8, pg8::StaticOrder, false, true>(F.tid, F.lds, g, S, E);
            } else {
                pg8::MoeOrder S; moe_bases(F.ctl + CW_MOECNT + 64 * ms, S.tb); S.ntiles = S.tb[8]; S.nNe = 2 * D_FFE / 256; S.G = F.G; S.c = F.bid;
                pg8::Gemm g{HB, (const bf16_t*)(F.ws + WS_W13), DM / 2, (const int*)(F.ws + WS_ROWMAP)};
                pg8::EpiSwiglu8 E{(unsigned char*)ACT, KP8, 0.015625f};
                pg8::gemm_phase<pg8::EpiSwiglu8, pg8::MoeOrder, true, true>(F.tid, F.lds, g, S, E);
            }
            SEAM(pb + P_UP);
        }
        if (EN(9) && IN(pb + P_DOWN)) { PH_BEGIN();
            __syncthreads();
            if (!moe) {
                pg8::Gemm g{ACT, (const bf16_t*)(F.ws + WS_W2), D_FF / 2, nullptr}; pg8::StaticOrder S; S.init(NTOK, DM, F.G, F.bid);
                pg8::EpiResidB<false> E{XBUF, XBUF, DM, 0.015625f};
                pg8::gemm_phase<pg8::EpiResidB<false>, pg8::StaticOrder, false, true>(F.tid, F.lds, g, S, E);
            } else {
                pg8::MoeOrder S; moe_bases(F.ctl + CW_MOECNT + 64 * ms, S.tb); S.ntiles = S.tb[8]; S.nNe = DM / 256; S.G = F.G; S.c = F.bid;
                pg8::Gemm g{ACT, (const bf16_t*)(F.ws + WS_W2), KP8 / 2, nullptr};
                pg8::EpiBf16 E{(bf16_t*)(F.ws + WS_Y), DM, 0.015625f};
                pg8::gemm_phase<pg8::EpiBf16, pg8::MoeOrder, false, true>(F.tid, F.lds, g, S, E);
            }
            SEAM(pb + P_DOWN);
        }
        }
    { constexpr int l = 3;
        const int pb = l * PH_PER_LAYER; const bool moe = (l & 1) != 0; const int ms = l >> 1;

        if (EN(0) && IN(pb + P_PREP)) { PH_BEGIN();
            if (sub & 1) { phase_convert_weights(F, l); rwkv_convert_small(F, l); }
            __syncthreads();
            if (sub & 2) { if (l == 0) phase_norm_lr<true, false>(F, INF(F, I_X), INF(F, I_ATTN_NORM) + l * DM, l); else if (((l - 1) & 1) != 0) phase_norm_lr<false, true>(F, XBUF, INF(F, I_ATTN_NORM) + l * DM, l); else phase_norm_lr<false, false>(F, XBUF, INF(F, I_ATTN_NORM) + l * DM, l); }
            SEAM(pb + P_PREP);
        }
        if (EN(1) && IN(pb + P_INPROJ)) { PH_BEGIN();
            pg8::Gemm g{HB, (const bf16_t*)(F.ws + WS_WIN), DM, nullptr}; pg8::StaticOrder S; S.init(NTOK, 3072, F.G, F.bid);
            pg8::EpiBf16 E{PROJ, NPROJ};
            pg8::gemm_phase<pg8::EpiBf16, pg8::StaticOrder, false>(F.tid, F.lds, g, S, E);
            SEAM(pb + P_INPROJ);
        }
        if (EN(2) && IN(pb + P_MIX1)) { PH_BEGIN();
            if (sub & 1) { rwkv_r1_tables(F, l); for (int unit = F.bid; unit < 2048; unit += F.G) rwkv_r1_unit(F, l, unit, (sub >> 8) & 15); }
            if (sub & 2) { GlaW2 gw; gla_loadw2(F, l, (F.bid >> 6) & 3, gw); for (int unit = F.bid; unit < 2048; unit += 2 * F.G) gla_kv2_pair(F, l, unit, gw); }
            SEAM(pb + P_MIX1);
        }
        if (EN(3) && IN(pb + P_MIX2)) { PH_BEGIN();
            if (F.bid < 32) { if (sub & 1) rwkv_r2_block(F, F.bid); }
            else { const int ob = F.bid - 32, NO = F.G - 32;
                if (sub & 2) for (int gt = ob * 512 + F.tid; gt < 65536; gt += NO * 512) gla_scan(F, gt); }
            if (sub & 12) {
                volatile LAS int* qw = (volatile LAS int*)(F.lds + MISC_OFF + 28);
                unsigned* qctr = F.ctl + CW_ATTNQ + 64 * l + ((sub >> 4) & 1) * 32;
                int nxt = 0;
                if (F.tid == 0) nxt = (int)atomicAdd(qctr, 1u);
                for (;;) {
                    __syncthreads();
                    if (F.tid == 0) *qw = nxt;
                    __syncthreads();
                    const int task = *qw;
                    if (task >= 1024) break;
                    if (F.tid == 0) nxt = (int)atomicAdd(qctr, 1u);
                    if (task < 512) { if (sub & 4) attn_block<false>(F, l, task); } else if (sub & 8) attn_block<true>(F, l, task - 512);
                }
            }
            SEAM(pb + P_MIX2);
        }
        if (EN(4) && IN(pb + P_MIX3)) { PH_BEGIN();
            if (sub & 1) { GlaW2 gw; gla_loadw2(F, l, (F.bid >> 6) & 3, gw); for (int unit = F.bid; unit < 2048; unit += 2 * F.G) gla_out2_pair(F, l, unit, gw, (sub >> 8) & 15); }
            __syncthreads();
            if (sub & 2) for (int unit = F.bid * 8 + F.wave; unit < 2048; unit += F.G * 8) rwkv_r3_task(F, l, unit);
            SEAM(pb + P_MIX3);
        }
        if (EN(5) && IN(pb + P_OUTPROJ)) { PH_BEGIN();
            __syncthreads();
            pg8::Gemm g{MIXB, (const bf16_t*)(F.ws + WS_WOUT), DM, nullptr}; pg8::StaticOrder S; S.init(NTOK, DM, F.G, F.bid);
            if (l == 0) { pg8::EpiResidB<true> E{INF(F, I_X), XBUF, DM}; pg8::gemm_phase<pg8::EpiResidB<true>, pg8::StaticOrder, false>(F.tid, F.lds, g, S, E); }
            else { pg8::EpiResidB<false> E{XBUF, XBUF, DM}; pg8::gemm_phase<pg8::EpiResidB<false>, pg8::StaticOrder, false>(F.tid, F.lds, g, S, E); }
            SEAM(pb + P_OUTPROJ);
        }
        if (EN(6) && IN(pb + P_NORM2)) { PH_BEGIN();
            if (moe) phase_norm<1, false>(F, XBUF, INF(F, I_FFN_NORM) + l * DM, false, ms);
            else phase_norm<0, false>(F, XBUF, INF(F, I_FFN_NORM) + l * DM, false, 0);
            SEAM(pb + P_NORM2);
        }
        if (EN(7) && IN(pb + P_MAP)) { PH_BEGIN();
            if (moe) { phase_moe_map(F, ms); SEAM(pb + P_MAP); }
        }
        if (EN(8) && IN(pb + P_UP)) { PH_BEGIN();
            __syncthreads();
            if (!moe) {
                pg8::Gemm g{HB, (const bf16_t*)(F.ws + WS_W13), DM / 2, nullptr}; pg8::StaticOrder S; S.init(NTOK, 2 * D_FF, F.G, F.bid);
                pg8::EpiSwiglu8 E{(unsigned char*)ACT, D_FF, 0.015625f};
                pg8::gemm_phase<pg8::EpiSwiglu8, pg8::StaticOrder, false, true>(F.tid, F.lds, g, S, E);
            } else {
                pg8::MoeOrder S; moe_bases(F.ctl + CW_MOECNT + 64 * ms, S.tb); S.ntiles = S.tb[8]; S.nNe = 2 * D_FFE / 256; S.G = F.G; S.c = F.bid;
                pg8::Gemm g{HB, (const bf16_t*)(F.ws + WS_W13), DM / 2, (const int*)(F.ws + WS_ROWMAP)};
                pg8::EpiSwiglu8 E{(unsigned char*)ACT, KP8, 0.015625f};
                pg8::gemm_phase<pg8::EpiSwiglu8, pg8::MoeOrder, true, true>(F.tid, F.lds, g, S, E);
            }
            SEAM(pb + P_UP);
        }
        if (EN(9) && IN(pb + P_DOWN)) { PH_BEGIN();
            __syncthreads();
            if (!moe) {
                pg8::Gemm g{ACT, (const bf16_t*)(F.ws + WS_W2), D_FF / 2, nullptr}; pg8::StaticOrder S; S.init(NTOK, DM, F.G, F.bid);
                pg8::EpiResidB<false> E{XBUF, XBUF, DM, 0.015625f};
                pg8::gemm_phase<pg8::EpiResidB<false>, pg8::StaticOrder, false, true>(F.tid, F.lds, g, S, E);
            } else {
                pg8::MoeOrder S; moe_bases(F.ctl + CW_MOECNT + 64 * ms, S.tb); S.ntiles = S.tb[8]; S.nNe = DM / 256; S.G = F.G; S.c = F.bid;
                pg8::Gemm g{ACT, (const bf16_t*)(F.ws + WS_W2), KP8 / 2, nullptr};
                pg8::EpiBf16 E{(bf16_t*)(F.ws + WS_Y), DM, 0.015625f};
                pg8::gemm_phase<pg8::EpiBf16, pg8::MoeOrder, false, true>(F.tid, F.lds, g, S, E);
            }
            SEAM(pb + P_DOWN);
        }
        }
    if (EN(10) && IN(PH_FINAL)) { PH_BEGIN();
        __syncthreads();
        phase_norm<2, false>(F, XBUF, INF(F, I_FINAL_NORM), true, 0);
        SEAM(PH_FINAL);
    }
    if (EN(10) && IN(PH_FINAL + 1)) { PH_BEGIN(); phase_final_copy(F); }
#undef IN
#undef XBUF
#undef HB
#undef PROJ
#undef MIXB
#undef ACT
#undef PH_BEGIN
#undef SEAM
}

extern "C" void kernel_launch(void* const* d_in, const int* in_sizes, int n_in, void* d_out, int out_size, void* d_ws, size_t ws_size, hipStream_t stream) {
    static int ready = 0;
    if (ready == 0) {
        if (n_in != N_IN || in_sizes[0] != NTOK * DM || out_size != NTOK * DM || ws_size < WS_END) {
            fprintf(stderr, "kernel_launch: unexpected shapes (n_in %d, in0 %d, out %d, ws %zu); nothing launched\n", n_in, n_in > 0 ? in_sizes[0] : -1, out_size, ws_size); ready = -1; return; }
        if (hipFuncSetAttribute((const void*)fwd_kernel, hipFuncAttributeMaxDynamicSharedMemorySize, LDS_BYTES) != hipSuccess) { fprintf(stderr, "kernel_launch: hipFuncSetAttribute failed\n"); ready = -1; return; }
        int per_cu = 0;
        if (hipOccupancyMaxActiveBlocksPerMultiprocessor(&per_cu, (const void*)fwd_kernel, 512, LDS_BYTES) != hipSuccess || per_cu < 1)
            fprintf(stderr, "kernel_launch: note: occupancy query reports %d workgroups per CU\n", per_cu);
        (void)hipGetLastError();
        ready = 1;
    }
    if (ready < 0) return;
    const int grid = 256;
    if (hipMemsetAsync((char*)d_ws + WS_CTL, 0, CTL_ZERO_BYTES, stream) != hipSuccess) { fprintf(stderr, "kernel_launch: memset failed\n"); return; }
    Args a{};
    for (int i = 0; i < N_IN; ++i) a.in[i] = d_in[i];
    a.out = (float*)d_out; a.ws = (unsigned char*)d_ws; a.sub = 0xF;
#if N_LAUNCHES_ONE
    a.ph_lo = 0; a.ph_hi = PH_END;
    hipLaunchKernelGGL(fwd_kernel, dim3(grid), dim3(512), LDS_BYTES, stream, a);
#else
    for (int p = 0; p < PH_END; ++p) {
        if (p < PH_FINAL && (p % PH_PER_LAYER) == P_MAP && (((p / PH_PER_LAYER) & 1) == 0)) continue;
        a.ph_lo = p; a.ph_hi = p + 1; a.sub = 0xF;
        hipLaunchKernelGGL(fwd_kernel, dim3(grid), dim3(512), LDS_BYTES, stream, a);
#if defined(PROBE_PHASE)
        if (p < PH_FINAL && (p % PH_PER_LAYER) == PROBE_PHASE && ((PROBE_LMASK >> (p / PH_PER_LAYER)) & 1)) { a.sub = PROBE_SUB; hipLaunchKernelGGL(fwd_kernel, dim3(grid), dim3(512), LDS_BYTES, stream, a); }
#endif
    }
#endif
    const hipError_t le = hipPeekAtLastError();
    if (le != hipSuccess) fprintf(stderr, "kernel_launch: launch failed: %s\n", hipGetErrorName(le));
}
```

```cpp
#include <hip/hip_runtime.h>
#include <cstdio>
#include <cstdint>

#define LAS __attribute__((address_space(3)))
#define GAS __attribute__((address_space(1)))
typedef unsigned short bf16_t;
typedef short bf16x8 __attribute__((ext_vector_type(8)));
typedef float f32x4 __attribute__((ext_vector_type(4)));
typedef float f32x2 __attribute__((ext_vector_type(2)));
typedef unsigned u32x4 __attribute__((ext_vector_type(4)));
typedef unsigned u32x2 __attribute__((ext_vector_type(2)));

#ifndef N_LAUNCHES_ONE
#define N_LAUNCHES_ONE 1
#endif

constexpr int BATCH = 8, SEQ = 4096, DM = 1024, NTOK = BATCH * SEQ, DEPTH = 4;
constexpr int IN_COLS = 3088, NPROJ = 3328;
constexpr int D_FF = 2816, N_EXP = 8, D_FFE = 1408;
constexpr int KP8 = 1536;
constexpr int PA_Q = 0, PA_K = 256, PA_V = 384;
constexpr int PB_Q = 512, PB_K = 640, PB_V = 768, PB_G = 1024;
constexpr int PC_Q = 1280, PC_K = 1536, PC_V = 1792;
constexpr int PD = 2048;
constexpr int PB_LR = 3072;
constexpr float NORM_EPS = 1e-6f;
constexpr int MOE_ROWS = NTOK * 2 + N_EXP * 256;

constexpr size_t MiB = 1u << 20;
constexpr size_t WS_CTL = 0, CTL_ZERO_BYTES = 1 * MiB;
constexpr size_t WS_ROPE_C = 2 * MiB, WS_ROPE_S = 6 * MiB;
constexpr size_t WS_WIN = 10 * MiB, WS_WOUT = 17 * MiB, WS_W13 = 19 * MiB, WS_W2 = 63 * MiB;
constexpr size_t WS_H = 86 * MiB;
constexpr size_t WS_PROJ = 150 * MiB;
constexpr size_t WS_MIX = 358 * MiB;
constexpr size_t WS_SCR = 422 * MiB;
constexpr size_t WS_RWM = WS_H;
constexpr size_t WS_RW_V = WS_SCR, WS_RW_G = WS_SCR + 16 * MiB, WS_RW_S = WS_SCR + 32 * MiB;
constexpr size_t WS_GLA_KV = 470 * MiB, WS_GLA_DEC = 1 * MiB;
constexpr size_t WS_RKR = 486 * MiB;
constexpr size_t WS_RW_X = 488 * MiB;
constexpr size_t WS_SMALLW = 85 * MiB;
constexpr size_t WS_YRAW = 488 * MiB;
constexpr size_t WS_Y = 358 * MiB;
constexpr size_t WS_TOK_E = 520 * MiB, WS_TOK_G = WS_TOK_E + 256 * 1024, WS_TOK_SLOT = WS_TOK_G + 256 * 1024, WS_TOK_ROW = WS_TOK_SLOT + 256 * 1024, WS_ROWMAP = 521 * MiB;
constexpr size_t WS_END = 522 * MiB;
static_assert(WS_Y + (size_t)MOE_ROWS * 2048 <= WS_TOK_E && WS_YRAW + (size_t)NTOK * 256 * 4 <= WS_TOK_E && WS_W2 + 22 * MiB <= WS_H, "ws map");
constexpr int CW_BAR = 4096;
constexpr int CW_ATTNQ = 12288;
constexpr int CW_MOECNT = 8192;

constexpr size_t XB_OFF = 64 * MiB;
constexpr int LDS_BYTES = 147456;
constexpr int MISC_OFF = 131072 + 8192;

__device__ __forceinline__ float bf2f(unsigned short u) { return __uint_as_float((unsigned)u << 16); }
__device__ __forceinline__ float bflo(unsigned w) { return __uint_as_float(w << 16); }
__device__ __forceinline__ float bfhi(unsigned w) { return __uint_as_float(w & 0xffff0000u); }
__device__ __forceinline__ unsigned short f2bf(float f) { unsigned u = __float_as_uint(f); return (unsigned short)((u + 0x7fffu + ((u >> 16) & 1u)) >> 16); }
__device__ __forceinline__ unsigned pk2(float lo, float hi) { return (unsigned)f2bf(lo) | ((unsigned)f2bf(hi) << 16); }
__device__ __forceinline__ float wave_sum(float v) {
#pragma unroll
    for (int o = 1; o < 64; o <<= 1) v += __shfl_xor(v, o);
    return v;
}
__device__ __forceinline__ float sigmoid_f(float x) { return 1.f / (1.f + __expf(-x)); }
__device__ __forceinline__ float softplus_f(float z) { return fmaxf(z, 0.f) + __logf(1.f + __expf(-fabsf(z))); }
__device__ __forceinline__ float logsigmoid_f(float x) { return fminf(x, 0.f) - __logf(1.f + __expf(-fabsf(x))); }
namespace pg8 {
constexpr int BM = 256, BK = 64, HALF = 128, HTB = HALF * BK * 2  , STAGE_BYTES = 8 * HTB, NXCD = 8, WGM = 8;

__host__ __device__ __forceinline__ int lds_byte(int r, int c) { const int st = (r >> 4) * 2 + (c >> 5), rr = r & 15, cc = c & 31, ob = rr * 64 + cc * 2; return st * 1024 + (ob ^ (((ob >> 9) & 1) << 5)); }
__host__ __device__ __forceinline__ void stage_rc(int b, int& R, int& C) { const int st = b / 1024, sb = b % 1024, swz = sb ^ (((sb >> 9) & 1) << 5); R = (st >> 1) * 16 + swz / 64; C = (st & 1) * 32 + (swz % 64) / 2; }
__host__ __device__ __forceinline__ int perm32(int rho) { const int n = rho >> 4, i = rho & 15; return 8 * (i >> 2) + 4 * n + (i & 3); }

struct Unit { int pm, pn, pc; };
struct Gemm { const bf16_t* A; const bf16_t* Bt; int K; const int* rowmap; };

struct StaticOrder {
    int nM, nN, nwg, G, c;
    __device__ void init(int M, int N, int G_, int c_) { nM = M / BM; nN = N / BM; nwg = nM * nN; G = G_; c = c_; }
    __device__ bool next(int i, Unit& u) const {
        const long L = (long)i * G + c; if (L >= nwg) return false;
        int wgid = (int)L; { const int q = nwg / NXCD, r = nwg % NXCD, xcd = wgid % NXCD, off = wgid / NXCD; wgid = (xcd < r ? xcd * (q + 1) : r * (q + 1) + (xcd - r) * q) + off; }
        const int nig = WGM * nN, gid = wgid / nig, fm = gid * WGM, gsz = (nM - fm) < WGM ? (nM - fm) : WGM;
        u.pm = fm + ((wgid % nig) % gsz); u.pn = (wgid % nig) / gsz; u.pc = u.pn; return true;
    }
};
struct MoeOrder {
    int ntiles, nNe, G, c; int tb[9];
    __device__ bool next(int i, Unit& u) const {
        const long L = (long)i * G + c; if (L >= (long)ntiles * nNe) return false;
        const int pm = (int)(L / nNe), pl = (int)(L % nNe); int e = 0;
#pragma unroll
        for (int j = 1; j < 8; ++j) e += (pm >= tb[j]) ? 1 : 0;
        u.pm = pm; u.pn = e * nNe + pl; u.pc = pl; return true;
    }
};

typedef __bf16 bf16pair_t __attribute__((ext_vector_type(2)));
__device__ __forceinline__ unsigned cvt_pk_c(float lo, float hi) { bf16pair_t v; v[0] = (__bf16)lo; v[1] = (__bf16)hi; return __builtin_bit_cast(unsigned, v); }
__device__ __forceinline__ unsigned cvt_pk_bf16(float lo, float hi) { unsigned r; asm volatile("v_cvt_pk_bf16_f32 %0, %1, %2" : "=v"(r) : "v"(lo), "v"(hi)); return r; }

struct EpiBf16 {
    static constexpr bool PERM = true;
    bf16_t* O; int ldc; float sc = 1.f;
    __device__ __forceinline__ void operator()(const f32x4 (&acc)[2][2][4][2], const Unit& u, int wr, int wc, int fr, int fq) const {
        const int row0 = u.pm * BM + wr * 64 + fr; const int col0 = u.pc * BM + wc * 32 + 8 * fq;
#pragma unroll
        for (int ai = 0; ai < 2; ++ai)
#pragma unroll
            for (int m = 0; m < 4; ++m) { bf16_t* rowp = O + (size_t)(row0 + ai * HALF + m * 16) * ldc + col0;
#pragma unroll
                for (int bj = 0; bj < 2; ++bj) { const f32x4 v0 = acc[ai][bj][m][0] * sc, v1 = acc[ai][bj][m][1] * sc;
                    u32x4 w; w.x = cvt_pk_bf16(v0[0], v0[1]); w.y = cvt_pk_bf16(v0[2], v0[3]); w.z = cvt_pk_bf16(v1[0], v1[1]); w.w = cvt_pk_bf16(v1[2], v1[3]);
                    *(u32x4*)(rowp + bj * HALF) = w; } }
    }
};
struct EpiSwiglu {
    static constexpr bool PERM = true;
    bf16_t* O; int ldc; float sc;
    __device__ __forceinline__ void operator()(const f32x4 (&acc)[2][2][4][2], const Unit& u, int wr, int wc, int fr, int fq) const {
        const int row0 = u.pm * BM + wr * 64 + fr; const int col0 = u.pc * HALF + wc * 32 + 8 * fq;
#pragma unroll
        for (int ai = 0; ai < 2; ++ai)
#pragma unroll
            for (int m = 0; m < 4; ++m) { bf16_t* rowp = O + (size_t)(row0 + ai * HALF + m * 16) * ldc + col0;
                float r[8];
#pragma unroll
                for (int n = 0; n < 2; ++n)
#pragma unroll
                    for (int j = 0; j < 4; ++j) { const float g = acc[ai][0][m][n][j] * sc, up = acc[ai][1][m][n][j] * sc; r[n * 4 + j] = g * __builtin_amdgcn_rcpf(1.f + __expf(-g)) * up; }
                u32x4 w; w.x = cvt_pk_bf16(r[0], r[1]); w.y = cvt_pk_bf16(r[2], r[3]); w.z = cvt_pk_bf16(r[4], r[5]); w.w = cvt_pk_bf16(r[6], r[7]);
                *(u32x4*)rowp = w; }
    }
};
__device__ __forceinline__ unsigned pk4_fp8c(float a, float b, float c, float d) { unsigned w = 0u;
    a = __builtin_fminf(__builtin_fmaxf(a, -448.f), 448.f); b = __builtin_fminf(__builtin_fmaxf(b, -448.f), 448.f); c = __builtin_fminf(__builtin_fmaxf(c, -448.f), 448.f); d = __builtin_fminf(__builtin_fmaxf(d, -448.f), 448.f);
    w = __builtin_amdgcn_cvt_pk_fp8_f32(a, b, w, false); w = __builtin_amdgcn_cvt_pk_fp8_f32(c, d, w, true); return w; }
struct EpiSwiglu8 {
    static constexpr bool PERM = true;
    unsigned char* O8; int ldc; float sc;
    __device__ __forceinline__ void operator()(const f32x4 (&acc)[2][2][4][2], const Unit& u, int wr, int wc, int fr, int fq) const {
        const int row0 = u.pm * BM + wr * 64 + fr; const int col0 = u.pc * HALF + wc * 32 + 8 * fq;
#pragma unroll
        for (int ai = 0; ai < 2; ++ai)
#pragma unroll
            for (int m = 0; m < 4; ++m) { unsigned char* rowp = O8 + (size_t)(row0 + ai * HALF + m * 16) * ldc + col0;
                float r[8];
#pragma unroll
                for (int n = 0; n < 2; ++n)
#pragma unroll
                    for (int j = 0; j < 4; ++j) { const float g = acc[ai][0][m][n][j] * sc, up = acc[ai][1][m][n][j] * sc; r[n * 4 + j] = g * __builtin_amdgcn_rcpf(1.f + __expf(-g)) * up; }
                u32x2 w; w.x = pk4_fp8c(r[0], r[1], r[2], r[3]); w.y = pk4_fp8c(r[4], r[5], r[6], r[7]);
                *(u32x2*)rowp = w; }
    }
};
template <bool BASE_F32> struct EpiResidB {
    static constexpr bool PERM = true;
    const void* base; bf16_t* out; int ldc; float sc = 1.f;
    __device__ __forceinline__ void operator()(const f32x4 (&acc)[2][2][4][2], const Unit& u, int wr, int wc, int fr, int fq) const {
        const int row0 = u.pm * BM + wr * 64 + fr; const int col0 = u.pc * BM + wc * 32 + 8 * fq;
#pragma unroll
        for (int ai = 0; ai < 2; ++ai)
#pragma unroll
            for (int m = 0; m < 4; ++m) { const size_t off = (size_t)(row0 + ai * HALF + m * 16) * ldc + col0;
#pragma unroll
                for (int bj = 0; bj < 2; ++bj) { f32x4 v0 = acc[ai][bj][m][0] * sc, v1 = acc[ai][bj][m][1] * sc;
                    if (BASE_F32) { const float* bp = (const float*)base + off + bj * HALF; v0 += *(const f32x4*)bp; v1 += *(const f32x4*)(bp + 4); }
                    else { const u32x4 w = *(const u32x4*)((const bf16_t*)base + off + bj * HALF);
                        v0[0] += __uint_as_float(w.x << 16); v0[1] += __uint_as_float(w.x & 0xffff0000u); v0[2] += __uint_as_float(w.y << 16); v0[3] += __uint_as_float(w.y & 0xffff0000u);
                        v1[0] += __uint_as_float(w.z << 16); v1[1] += __uint_as_float(w.z & 0xffff0000u); v1[2] += __uint_as_float(w.w << 16); v1[3] += __uint_as_float(w.w & 0xffff0000u); }
                    u32x4 o; o.x = cvt_pk_bf16(v0[0], v0[1]); o.y = cvt_pk_bf16(v0[2], v0[3]); o.z = cvt_pk_bf16(v1[0], v1[1]); o.w = cvt_pk_bf16(v1[2], v1[3]);
                    *(u32x4*)(out + off + bj * HALF) = o; } }
    }
};

typedef int i32x8 __attribute__((ext_vector_type(8)));
typedef int i32x4g __attribute__((ext_vector_type(4)));
__device__ __forceinline__ i32x8 cat8(const bf16x8 a, const bf16x8 b) { return __builtin_shufflevector(__builtin_bit_cast(i32x4g, a), __builtin_bit_cast(i32x4g, b), 0, 1, 2, 3, 4, 5, 6, 7); }
template <class Epi, class Sched, bool GATHER, bool F8 = false>
__device__ __forceinline__ void gemm_phase(const int tid, LAS unsigned char* lds, const Gemm g, const Sched& S, const Epi& E) {
    const int wid = __builtin_amdgcn_readfirstlane(tid >> 6), lane = tid & 63, wr = wid >> 2, wc = wid & 3, fr = lane & 15, fq = lane >> 4;
    const int K = g.K, nt = K / BK;
    unsigned voffA, voffB;
    { int R, C; stage_rc(tid * 16, R, C); const int Rb = Epi::PERM ? ((R & ~31) + perm32(R & 31)) : R; voffA = (unsigned)(R * K + C) * 2u; voffB = (unsigned)(Rb * K + C) * 2u; }
    const size_t kstep = (size_t)(BK * 2);
    const size_t hstep = (size_t)HALF * K * 2;
    const size_t tstep = 2 * hstep;
    const unsigned ldsw = (unsigned)wid * 1024u;
    const int aoff = lds_byte(wr * 64 + fr, fq * 8), boff = lds_byte(wc * 32 + fr, fq * 8);
#define PG8_SA(b, h) (((b) * 2 + (h)) * HTB)
#define PG8_SB(b, h) ((4 + (b) * 2 + (h)) * HTB)
#define PG8_STAGE2(bufoff, gbase, v0, v1) do { _Pragma("unroll") for (int _i = 0; _i < 2; ++_i) { unsigned _v = _i ? (v1) : (v0); asm volatile("" : "+v"(_v)); \
        __builtin_amdgcn_global_load_lds((const unsigned*)((const char*)(gbase) + _v), (LAS unsigned*)(lds + (bufoff) + ldsw + _i * 8192), 16, 0, 0); } } while (0)
#define PG8_STAGE(bufoff, gbase, voff) PG8_STAGE2(bufoff, gbase, (voff), (voff) + (unsigned)(128 * K))
#define PG8_STAGE_A(bufoff, kb, h, nx) do { if constexpr (GATHER) { PG8_STAGE2(bufoff, (const char*)g.A + (kb), offC[h][0], offC[h][1]); }   \
        else { PG8_STAGE(bufoff, ((nx) ? nA : cA) + (kb) + (h) * hstep, voffA); } } while (0)
#define PG8_LDA(dst, b, h) do { _Pragma("unroll") for (int m = 0; m < 4; ++m) _Pragma("unroll") for (int k = 0; k < 2; ++k) dst[m][k] = *(const LAS bf16x8*)(lds + PG8_SA(b, h) + aoff + m * 2048 + k * 1024); } while (0)
#define PG8_LDB(dst, b, h) do { _Pragma("unroll") for (int n = 0; n < 2; ++n) _Pragma("unroll") for (int k = 0; k < 2; ++k) dst[n][k] = *(const LAS bf16x8*)(lds + PG8_SB(b, h) + boff + n * 2048 + k * 1024); } while (0)
#define PG8_MMA(ai, bj, At, Bt) do { __builtin_amdgcn_s_setprio(1); _Pragma("unroll") for (int m = 0; m < 4; ++m) _Pragma("unroll") for (int n = 0; n < 2; ++n) { \
        if constexpr (F8) acc[ai][bj][m][n] = __builtin_amdgcn_mfma_scale_f32_16x16x128_f8f6f4(cat8(Bt[n][0], Bt[n][1]), cat8(At[m][0], At[m][1]), acc[ai][bj][m][n], 0, 0, 0, 0, 0, 0);   \
        else { _Pragma("unroll") for (int k = 0; k < 2; ++k) acc[ai][bj][m][n] = __builtin_amdgcn_mfma_f32_16x16x32_bf16(Bt[n][k], At[m][k], acc[ai][bj][m][n], 0, 0, 0); } } __builtin_amdgcn_s_setprio(0); } while (0)
#define PG8_WAIT_V(n) asm volatile("s_waitcnt vmcnt(" #n ")" ::: "memory")
#define PG8_WAIT_L(n) asm volatile("s_waitcnt lgkmcnt(" #n ")" ::: "memory")
#define PG8_BAR __builtin_amdgcn_s_barrier()
#define PG8_SCHED __builtin_amdgcn_sched_barrier(0)
#define PG8_LOADOFF(dst, u) do { _Pragma("unroll") for (int _h = 0; _h < 2; ++_h) _Pragma("unroll") for (int _i = 0; _i < 2; ++_i) { \
        int _R, _C; { int _t = tid; asm volatile("" : "+v"(_t)); stage_rc(_t * 16, _R, _C); } const int _row = g.rowmap[(u).pm * BM + _h * HALF + _R + 64 * _i]; dst[_h][_i] = (unsigned)(_row * K + _C) * 2u; } } while (0)
    Unit cur, nxt; int ui = 0;
    if (!S.next(0, cur)) return;
    f32x4 acc[2][2][4][2];
#pragma unroll
    for (int a = 0; a < 2; ++a)
#pragma unroll
        for (int b = 0; b < 2; ++b)
#pragma unroll
            for (int m = 0; m < 4; ++m)
#pragma unroll
                for (int n = 0; n < 2; ++n) acc[a][b][m][n] = (f32x4){0.f, 0.f, 0.f, 0.f};
    bf16x8 At[4][2], B0[2][2], B1[2][2];
    unsigned offC[2][2] = {{0u, 0u}, {0u, 0u}};
    LAS u32x4* offslot = (LAS u32x4*)(lds + STAGE_BYTES) + tid;
    const char* cA = (const char*)g.A + (GATHER ? (size_t)0 : (size_t)cur.pm * tstep); const char* cB = (const char*)g.Bt + (size_t)cur.pn * tstep;
    const char* nA = cA;
    if constexpr (GATHER) { PG8_LOADOFF(offC, cur); }
    PG8_STAGE(PG8_SB(0, 0), cB, voffB); PG8_STAGE(PG8_SB(0, 1), cB + hstep, voffB); PG8_STAGE_A(PG8_SA(0, 0), 0, 0, false); PG8_STAGE_A(PG8_SA(0, 1), 0, 1, false);
    if (wr == 1) PG8_BAR;
    PG8_WAIT_V(2); PG8_BAR;
    PG8_STAGE(PG8_SB(1, 0), cB + kstep, voffB); PG8_STAGE_A(PG8_SA(1, 0), kstep, 0, false); PG8_STAGE(PG8_SB(1, 1), cB + hstep + kstep, voffB);
    PG8_WAIT_V(6); PG8_BAR;
    for (;;) {
        const bool has_next = S.next(ui + 1, nxt);
        nA = has_next ? (const char*)g.A + (GATHER ? (size_t)0 : (size_t)nxt.pm * tstep) : cA; const char* nB = has_next ? (const char*)g.Bt + (size_t)nxt.pn * tstep : cB;
        if constexpr (GATHER) { unsigned offN[2][2];
            if (has_next) { PG8_LOADOFF(offN, nxt); } else {
#pragma unroll
                for (int h = 0; h < 2; ++h) { offN[h][0] = offC[h][0]; offN[h][1] = offC[h][1]; } }
            *offslot = (u32x4){offN[0][0], offN[0][1], offN[1][0], offN[1][1]}; }
#pragma unroll 1
        for (int t = 0; t < nt; t += 2) {
            const bool last = (t == nt - 2);
            const size_t k1 = (size_t)(t + 1) * kstep;
            const size_t k2 = last ? (size_t)0 : (size_t)(t + 2) * kstep, k3 = k2 + kstep;
            const char* b2 = last ? nB : cB + (size_t)(t + 2) * kstep; const char* b3 = b2 + kstep;
            PG8_LDB(B0, 0, 0); PG8_LDB(B1, 0, 1); PG8_SCHED; PG8_LDA(At, 0, 0); PG8_STAGE_A(PG8_SA(1, 1), k1, 1, false);
            if constexpr (GATHER) { if (last) { const u32x4 o_ = *offslot; offC[0][0] = o_.x; offC[0][1] = o_.y; offC[1][0] = o_.z; offC[1][1] = o_.w; } }
            PG8_WAIT_V(8); PG8_WAIT_L(0); PG8_BAR; PG8_MMA(0, 0, At, B0); PG8_MMA(0, 1, At, B1); PG8_BAR; PG8_SCHED;
            PG8_LDA(At, 0, 1); PG8_STAGE(PG8_SB(0, 0), b2, voffB); PG8_STAGE(PG8_SB(0, 1), b2 + hstep, voffB); PG8_STAGE_A(PG8_SA(0, 0), k2, 0, last);
            PG8_WAIT_V(8); PG8_WAIT_L(0); PG8_BAR; PG8_MMA(1, 0, At, B0); PG8_MMA(1, 1, At, B1); PG8_BAR; PG8_SCHED;
            PG8_LDB(B0, 1, 0); PG8_LDB(B1, 1, 1); PG8_SCHED; PG8_LDA(At, 1, 0); PG8_STAGE_A(PG8_SA(0, 1), k2, 1, last);
            PG8_WAIT_V(8); PG8_WAIT_L(0); PG8_BAR; PG8_MMA(0, 0, At, B0); PG8_MMA(0, 1, At, B1); PG8_BAR; PG8_SCHED;
            PG8_LDA(At, 1, 1); PG8_STAGE(PG8_SB(1, 0), b3, voffB); PG8_STAGE(PG8_SB(1, 1), b3 + hstep, voffB); PG8_STAGE_A(PG8_SA(1, 0), k3, 0, last);
            PG8_WAIT_V(8); PG8_WAIT_L(0); PG8_BAR; PG8_MMA(1, 0, At, B0); PG8_MMA(1, 1, At, B1); PG8_BAR; PG8_SCHED;
        }
        if (wr == 0) PG8_BAR;
        asm volatile("s_nop 15\n\ts_nop 15" ::: "memory");
        { unsigned m_ = ~0u; asm volatile("" : "+s"(m_)); const int ln_ = (int)__builtin_amdgcn_mbcnt_hi(m_, __builtin_amdgcn_mbcnt_lo(m_, 0u));
          E(acc, cur, wr, wc, ln_ & 15, ln_ >> 4); }
        if (!has_next) break;
#pragma unroll
        for (int a = 0; a < 2; ++a)
#pragma unroll
            for (int b = 0; b < 2; ++b)
#pragma unroll
                for (int m = 0; m < 4; ++m)
#pragma unroll
                    for (int n = 0; n < 2; ++n) acc[a][b][m][n] = (f32x4){0.f, 0.f, 0.f, 0.f};
        cur = nxt; cA = nA; cB = nB; ++ui;
        if (wr == 1) PG8_BAR;
    }
    PG8_WAIT_V(0);
    PG8_BAR;
#undef PG8_SA
#undef PG8_SB
#undef PG8_STAGE
#undef PG8_STAGE2
#undef PG8_STAGE_A
#undef PG8_LDA
#undef PG8_LDB
#undef PG8_MMA
#undef PG8_WAIT_V
#undef PG8_WAIT_L
#undef PG8_BAR
#undef PG8_SCHED
#undef PG8_LOADOFF
}
}
#define XB_TMO      128
#define XB_XCNT(j)  (256  + 64 * (j))
#define XB_XSUB(j)  (1280 + 64 * (j))
#define XB_XGEN(j)  (2304 + 64 * (j))
#define XB_TOP      3328
#define XB_TOPGEN   3392
#define XCD_BAR_WORDS 3456
#define XB_SPIN_CAP (1u << 18)

__device__ __forceinline__ unsigned xb_ld(unsigned* p)              { return __hip_atomic_load(p, __ATOMIC_RELAXED, __HIP_MEMORY_SCOPE_AGENT); }
__device__ __forceinline__ unsigned xb_add(unsigned* p, unsigned v) { return __hip_atomic_fetch_add(p, v, __ATOMIC_RELAXED, __HIP_MEMORY_SCOPE_AGENT); }
__device__ __forceinline__ unsigned xb_xcc_id() { return (unsigned)__builtin_amdgcn_s_getreg((3 << 11) | 20) & 0xFu; }
#define XB_SPIN(cond, bar) do { unsigned _sp = 0; while (cond) { __builtin_amdgcn_s_sleep(1); \
    if ((++_sp & 255u) == 0u) { if (xb_ld(&(bar)[XB_TMO])) break; if (_sp > XB_SPIN_CAP) { atomicAdd(&(bar)[XB_TMO], 1u); break; } } } } while (0)

struct XcdBarrier {
    unsigned* bar; unsigned x;
    volatile LAS unsigned* st;
};

__device__ __forceinline__ XcdBarrier xcd_barrier_post(unsigned* bar, volatile LAS unsigned* st) {
    XcdBarrier b; b.bar = bar; b.x = xb_xcc_id(); b.st = st;
    if (threadIdx.x == 0) (void)xb_add(&bar[XB_XCNT(b.x)], 1u);
    return b;
}
__device__ __forceinline__ void xcd_barrier_complete(unsigned* bar, unsigned x, unsigned& nloc, unsigned& nx) {
    const unsigned G = gridDim.x * gridDim.y * gridDim.z;
    unsigned sum, cnt, mine, sp = 0u;
    for (;;) {
        sum = 0u; cnt = 0u; mine = 0u;
#pragma unroll
        for (unsigned j = 0; j < 16; ++j) { const unsigned c = xb_ld(&bar[XB_XCNT(j)]); sum += c; cnt += (c > 0u) ? 1u : 0u; mine = (j == x) ? c : mine; }
        if (sum == G) break;
        __builtin_amdgcn_s_sleep(1);
        if ((++sp & 255u) == 0u) { if (xb_ld(&bar[XB_TMO])) break; if (sp > XB_SPIN_CAP) { atomicAdd(&bar[XB_TMO], 1u); break; } }
    }
    nloc = mine > 0u ? mine : 1u; nx = cnt > 0u ? cnt : 1u;
}

__device__ __forceinline__ void xcd_barrier(const XcdBarrier& b, const bool leader) {
    asm volatile("s_waitcnt vmcnt(0)" ::: "memory");
    __syncthreads();
    if (leader) {
        unsigned* bar = b.bar;
        __builtin_amdgcn_s_waitcnt(0);
        unsigned nloc = b.st[0], nx = b.st[1];
        if (nloc == 0u) { xcd_barrier_complete(bar, b.x, nloc, nx); b.st[0] = nloc; b.st[1] = nx; }
        const unsigned old = xb_add(&bar[XB_XSUB(b.x)], 1u);
        const unsigned gen = old / nloc;
        if (old + 1u == (gen + 1u) * nloc) {
            __builtin_amdgcn_fence(__ATOMIC_RELEASE, "agent");
            asm volatile("s_waitcnt vmcnt(0)" ::: "memory");
            const unsigned og = xb_add(&bar[XB_TOP], 1u);
            const unsigned tg = og / nx;
            if (og + 1u == (tg + 1u) * nx) xb_add(&bar[XB_TOPGEN], 1u);
            else XB_SPIN(xb_ld(&bar[XB_TOPGEN]) == tg, bar);
            __builtin_amdgcn_fence(__ATOMIC_ACQUIRE, "agent");
            xb_add(&bar[XB_XGEN(b.x)], 1u);
            asm volatile("s_waitcnt vmcnt(0)" ::: "memory");
        } else {
            XB_SPIN(xb_ld(&bar[XB_XGEN(b.x)]) == gen, bar);
            __builtin_amdgcn_fence(__ATOMIC_ACQUIRE, "agent");
            asm volatile("s_waitcnt vmcnt(0)" ::: "memory");
        }
    }
    __syncthreads();
}
struct Frame {
    LAS unsigned char* lds;
    unsigned* ctl;
    unsigned char* ws;
    int tid, lane, wave, bid, G;
    float* out;
};
enum InIdx { I_X = 0, I_POS, I_ATTN_NORM, I_W_IN, I_SINKS, I_SWA_ON, I_GLA_WA2, I_GLA_BA, I_GLA_ON, I_SB_ON, I_MU, I_W0, I_W2, I_A0, I_A2, I_G2, I_KK, I_KA, I_RK, I_LNW, I_LNB,
             I_W_OUT, I_FFN_NORM, I_FFN_W1, I_FFN_W3, I_FFN_W2, I_ROUTER, I_MOE_W1, I_MOE_W3, I_MOE_W2, I_FINAL_NORM, N_IN };
constexpr int PTR_OFF = MISC_OFF + 64;
__device__ __forceinline__ const void* in_ptr(const Frame& F, int i) {
    const unsigned long long v = ((const LAS unsigned long long*)(F.lds + PTR_OFF))[i];
    const unsigned lo = __builtin_amdgcn_readfirstlane((unsigned)v), hi = __builtin_amdgcn_readfirstlane((unsigned)(v >> 32));
    return (const void*)(GAS const void*)(((unsigned long long)hi << 32) | lo);
}
#define INF(F, i) ((const float*)in_ptr(F, i))

template <class Map>
__device__ __forceinline__ void transpose_item(const float* W, int K, int N, bf16_t* WT, const Map& dst, LAS float* scr, int item, int lane) {
    const int nblk = (N + 31) / 32, kb = item / nblk, nb = item % nblk, k0 = 64 * kb, n0 = 32 * nb;
    const int nl = n0 + (lane & 31);
#pragma unroll 8
    for (int i = 0; i < 32; ++i) { const int kk = 2 * i + (lane >> 5); scr[kk * 33 + (lane & 31)] = (nl < N) ? W[(size_t)(k0 + kk) * N + nl] : 0.f; }
    asm volatile("s_waitcnt lgkmcnt(0)" ::: "memory");
    const int c = lane & 7;
#pragma unroll
    for (int j = 0; j < 4; ++j) { const int n = (lane >> 3) + 8 * j; const LAS float* s = scr + (8 * c) * 33 + n;
        u32x4 o; o.x = pk2(s[0 * 33], s[1 * 33]); o.y = pk2(s[2 * 33], s[3 * 33]); o.z = pk2(s[4 * 33], s[5 * 33]); o.w = pk2(s[6 * 33], s[7 * 33]);
        if (n0 + n < N) *(u32x4*)(WT + (size_t)dst(n0 + n) * K + k0 + 8 * c) = o; }
    asm volatile("s_waitcnt lgkmcnt(0)" ::: "memory");
}
__device__ __forceinline__ unsigned pk4_fp8(float a, float b, float c, float d) { return pg8::pk4_fp8c(a, b, c, d); }
template <class Map>
__device__ __forceinline__ void transpose_item8(const float* W, int K, int N, unsigned char* WT, const Map& dst, LAS float* scr, int item, int lane, int pitch = 0) {
    const int nblk = (N + 31) / 32, kb = item / nblk, nb = item % nblk, k0 = 64 * kb, n0 = 32 * nb;
    const int nl = n0 + (lane & 31);
#pragma unroll 8
    for (int i = 0; i < 32; ++i) { const int kk = 2 * i + (lane >> 5); scr[kk * 33 + (lane & 31)] = (nl < N) ? W[(size_t)(k0 + kk) * N + nl] * 64.f : 0.f; }
    asm volatile("s_waitcnt lgkmcnt(0)" ::: "memory");
    const int c = lane & 7;
#pragma unroll
    for (int j = 0; j < 4; ++j) { const int n = (lane >> 3) + 8 * j; const LAS float* s = scr + (8 * c) * 33 + n;
        u32x2 o; o.x = pk4_fp8(s[0 * 33], s[1 * 33], s[2 * 33], s[3 * 33]); o.y = pk4_fp8(s[4 * 33], s[5 * 33], s[6 * 33], s[7 * 33]);
        if (n0 + n < N) *(u32x2*)(WT + (size_t)dst(n0 + n) * (pitch ? pitch : K) + k0 + 8 * c) = o; }
    asm volatile("s_waitcnt lgkmcnt(0)" ::: "memory");
}
struct MapIn { __device__ int operator()(int n) const { return n < 1280 ? n : (n < 1296 ? 3072 + (n - 1280) : n - 16); } };
struct MapId { int off; __device__ int operator()(int n) const { return off + n; } };
struct MapGU { int off; __device__ int operator()(int n) const { return off + 256 * (n >> 7) + (n & 127); } };

__device__ __forceinline__ void phase_convert_weights(Frame& F, int l) {
    LAS float* scr = (LAS float*)(F.lds + F.wave * 16384);
    const int gw = F.bid * 8 + F.wave, NGW = F.G * 8;
    bf16_t* WIN = (bf16_t*)(F.ws + WS_WIN); bf16_t* WOUT = (bf16_t*)(F.ws + WS_WOUT); bf16_t* W13 = (bf16_t*)(F.ws + WS_W13); bf16_t* W2 = (bf16_t*)(F.ws + WS_W2);
    const bool moe = (l & 1) != 0; const int li = l >> 1;
    const int I_IN = (DM / 64) * ((IN_COLS + 31) / 32), I_OUT = (DM / 64) * (DM / 32);
    const int I_UP = moe ? (DM / 64) * (D_FFE / 32) : (DM / 64) * (D_FF / 32);
    const int I_DN = moe ? (D_FFE / 64) * (DM / 32) : (D_FF / 64) * (DM / 32);
    const int NE = moe ? N_EXP : 1;
    const int total = I_IN + I_OUT + NE * (2 * I_UP + I_DN);
    for (int it = gw; it < total; it += NGW) {
        int r = it;
        if (r < I_IN) { transpose_item(INF(F, I_W_IN) + (size_t)l * DM * IN_COLS, DM, IN_COLS, WIN, MapIn{}, scr, r, F.lane); continue; } r -= I_IN;
        if (r < I_OUT) { transpose_item(INF(F, I_W_OUT) + (size_t)l * DM * DM, DM, DM, WOUT, MapId{0}, scr, r, F.lane); continue; } r -= I_OUT;
        const int per_e = 2 * I_UP + I_DN, e = r / per_e; r -= e * per_e;
        if (!moe) {
            if (r < I_UP) { transpose_item8(INF(F, I_FFN_W1) + (size_t)li * DM * D_FF, DM, D_FF, (unsigned char*)W13, MapGU{0}, scr, r, F.lane); continue; } r -= I_UP;
            if (r < I_UP) { transpose_item8(INF(F, I_FFN_W3) + (size_t)li * DM * D_FF, DM, D_FF, (unsigned char*)W13, MapGU{128}, scr, r, F.lane); continue; } r -= I_UP;
            transpose_item8(INF(F, I_FFN_W2) + (size_t)li * D_FF * DM, D_FF, DM, (unsigned char*)W2, MapId{0}, scr, r, F.lane);
        } else {
            const size_t eo = (size_t)(li * N_EXP + e);
            if (r < I_UP) { transpose_item8(INF(F, I_MOE_W1) + eo * DM * D_FFE, DM, D_FFE, (unsigned char*)W13, MapGU{e * 2 * D_FFE}, scr, r, F.lane); continue; } r -= I_UP;
            if (r < I_UP) { transpose_item8(INF(F, I_MOE_W3) + eo * DM * D_FFE, DM, D_FFE, (unsigned char*)W13, MapGU{e * 2 * D_FFE + 128}, scr, r, F.lane); continue; } r -= I_UP;
            transpose_item8(INF(F, I_MOE_W2) + eo * D_FFE * DM, D_FFE, DM, (unsigned char*)W2, MapId{e * DM}, scr, r, F.lane, KP8);
        }
    }
    if (moe) {
        unsigned zz = 0u; asm volatile("" : "+v"(zz));
        for (int i = F.bid * 512 + F.tid; i < N_EXP * DM * ((KP8 - D_FFE) / 16); i += F.G * 512) { const int row = i >> 3, c = i & 7; *(u32x4*)((unsigned char*)W2 + (size_t)row * KP8 + D_FFE + 16 * c) = (u32x4){zz, zz, zz, zz}; }
    }
}

__device__ __forceinline__ void phase_rope_tables(Frame& F) {
    float* C = (float*)(F.ws + WS_ROPE_C); float* S = (float*)(F.ws + WS_ROPE_S); const int* pos = (const int*)in_ptr(F, I_POS);
    for (int idx = F.bid * 512 + F.tid; idx < NTOK * 32; idx += F.G * 512) {
        const int tok = idx >> 5, i = idx & 31;
        const float invf = exp2f(-(float)(2 * i) * (13.287712379549449f / 64.f));
        const float angf = (float)pos[tok] * invf;
        const double a = (double)angf;
        const double n = rint(a * 0.15915494309189535);
        const double r = a - n * 6.283185307179586;
        const double r2 = r * r;
        double s = -1.0 / 51090942171709440000.0;
        s = s * r2 + 1.0 / 121645100408832000.0;  s = s * r2 - 1.0 / 355687428096000.0; s = s * r2 + 1.0 / 1307674368000.0; s = s * r2 - 1.0 / 6227020800.0;
        s = s * r2 + 1.0 / 39916800.0; s = s * r2 - 1.0 / 362880.0; s = s * r2 + 1.0 / 5040.0; s = s * r2 - 1.0 / 120.0; s = s * r2 + 1.0 / 6.0; s = s * r2 - 1.0; s = -s * r;
        double c = 1.0 / 1124000727777607680000.0;
        c = c * r2 - 1.0 / 2432902008176640000.0; c = c * r2 + 1.0 / 6402373705728000.0; c = c * r2 - 1.0 / 20922789888000.0; c = c * r2 + 1.0 / 87178291200.0;
        c = c * r2 - 1.0 / 479001600.0; c = c * r2 + 1.0 / 3628800.0; c = c * r2 - 1.0 / 40320.0; c = c * r2 + 1.0 / 720.0; c = c * r2 - 1.0 / 24.0; c = c * r2 + 0.5; c = 1.0 - c * r2;
        C[idx] = (float)c; S[idx] = (float)s;
    }
}

template <int MODE, bool XF32>
__device__ __forceinline__ void phase_norm(Frame& F, const void* xin, const float* gain, bool comb, int moe_slot) {
    bf16_t* HB = (bf16_t*)(F.ws + WS_H); bf16_t* XB = (bf16_t*)((unsigned char*)F.out + XB_OFF);
    const bf16_t* Y = (const bf16_t*)(F.ws + WS_Y);
    const int* TOK_ROW = (const int*)(F.ws + WS_TOK_ROW); const float* TOK_G = (const float*)(F.ws + WS_TOK_G);
    LAS float* rts = (LAS float*)F.lds;
    LAS int* te = (LAS int*)(F.lds + 32768);
    LAS float* tg = (LAS float*)(F.lds + 32768 + 1024);
    LAS int* tl = (LAS int*)(F.lds + 32768 + 2048);
    LAS int* lcnt = (LAS int*)(F.lds + 32768 + 3072);
    if (MODE == 1) {
        const float* router = INF(F, I_ROUTER) + (size_t)moe_slot * DM * N_EXP;
        for (int i = F.tid; i < DM * N_EXP; i += 512) { const int c = i >> 3, e = i & 7; rts[e * DM + c] = router[i]; }
        if (F.tid < 16) lcnt[F.tid] = 0;
        __syncthreads();
    }
    f32x4 gv[2][2];
#pragma unroll
    for (int j = 0; j < 2; ++j) { gv[j][0] = *(const f32x4*)(gain + 8 * F.lane + 512 * j); gv[j][1] = *(const f32x4*)(gain + 8 * F.lane + 512 * j + 4); }
    for (int rr = 0; rr < 16; ++rr) {
        const int rloc = F.wave * 16 + rr; const int row = F.bid * 128 + rloc;
        if (row >= NTOK) break;
        float v[2][8];
#pragma unroll
        for (int j = 0; j < 2; ++j) {
            if (XF32) { const float* xr = (const float*)xin + (size_t)row * DM + 8 * F.lane + 512 * j; const f32x4 a = *(const f32x4*)xr, b = *(const f32x4*)(xr + 4);
                v[j][0] = a[0]; v[j][1] = a[1]; v[j][2] = a[2]; v[j][3] = a[3]; v[j][4] = b[0]; v[j][5] = b[1]; v[j][6] = b[2]; v[j][7] = b[3]; }
            else { const u32x4 w = *(const u32x4*)((const bf16_t*)xin + (size_t)row * DM + 8 * F.lane + 512 * j);
                v[j][0] = bflo(w.x); v[j][1] = bfhi(w.x); v[j][2] = bflo(w.y); v[j][3] = bfhi(w.y); v[j][4] = bflo(w.z); v[j][5] = bfhi(w.z); v[j][6] = bflo(w.w); v[j][7] = bfhi(w.w); } }
        if (comb) {
            const int r0 = TOK_ROW[row * 2], r1 = TOK_ROW[row * 2 + 1]; const float g0 = TOK_G[row * 2], g1 = TOK_G[row * 2 + 1];
#pragma unroll
            for (int j = 0; j < 2; ++j) {
                const u32x4 a = *(const u32x4*)(Y + (size_t)r0 * DM + 8 * F.lane + 512 * j), b = *(const u32x4*)(Y + (size_t)r1 * DM + 8 * F.lane + 512 * j);
                v[j][0] += g0 * bflo(a.x) + g1 * bflo(b.x); v[j][1] += g0 * bfhi(a.x) + g1 * bfhi(b.x); v[j][2] += g0 * bflo(a.y) + g1 * bflo(b.y); v[j][3] += g0 * bfhi(a.y) + g1 * bfhi(b.y);
                v[j][4] += g0 * bflo(a.z) + g1 * bflo(b.z); v[j][5] += g0 * bfhi(a.z) + g1 * bfhi(b.z); v[j][6] += g0 * bflo(a.w) + g1 * bflo(b.w); v[j][7] += g0 * bfhi(a.w) + g1 * bfhi(b.w);
                if (MODE != 2) { u32x4 o; o.x = pk2(v[j][0], v[j][1]); o.y = pk2(v[j][2], v[j][3]); o.z = pk2(v[j][4], v[j][5]); o.w = pk2(v[j][6], v[j][7]); *(u32x4*)(XB + (size_t)row * DM + 8 * F.lane + 512 * j) = o; }
            }
        }
        float ss = 0.f;
#pragma unroll
        for (int j = 0; j < 2; ++j)
#pragma unroll
            for (int i = 0; i < 8; ++i) ss += v[j][i] * v[j][i];
        const float rstd = rsqrtf(wave_sum(ss) * (1.f / DM) + NORM_EPS);
#pragma unroll
        for (int j = 0; j < 2; ++j)
#pragma unroll
            for (int i = 0; i < 8; ++i) v[j][i] = v[j][i] * rstd * gv[j][i >> 2][i & 3];
        if (MODE == 2) {
            float* dst = (row < NTOK / 2) ? F.out + (size_t)row * DM : (float*)(F.ws + WS_PROJ) + (size_t)(row - NTOK / 2) * DM;
#pragma unroll
            for (int j = 0; j < 2; ++j) { *(f32x4*)(dst + 8 * F.lane + 512 * j) = (f32x4){v[j][0], v[j][1], v[j][2], v[j][3]}; *(f32x4*)(dst + 8 * F.lane + 512 * j + 4) = (f32x4){v[j][4], v[j][5], v[j][6], v[j][7]}; }
        } else {
#pragma unroll
            for (int j = 0; j < 2; ++j) {
                if (MODE == 0 || MODE == 1) { u32x2 o; o.x = pk4_fp8(v[j][0], v[j][1], v[j][2], v[j][3]); o.y = pk4_fp8(v[j][4], v[j][5], v[j][6], v[j][7]); *(u32x2*)((unsigned char*)HB + (size_t)row * DM + 8 * F.lane + 512 * j) = o; }
                else { u32x4 o; o.x = pk2(v[j][0], v[j][1]); o.y = pk2(v[j][2], v[j][3]); o.z = pk2(v[j][4], v[j][5]); o.w = pk2(v[j][6], v[j][7]); *(u32x4*)(HB + (size_t)row * DM + 8 * F.lane + 512 * j) = o; } }
        }
        if (MODE == 1) {
            float lg[8];
#pragma unroll
            for (int e = 0; e < 8; ++e) { float a = 0.f;
#pragma unroll
                for (int j = 0; j < 2; ++j) { const f32x4 w0 = *(const LAS f32x4*)(rts + e * DM + 8 * F.lane + 512 * j), w1 = *(const LAS f32x4*)(rts + e * DM + 8 * F.lane + 512 * j + 4);
                    a += (v[j][0] * w0[0] + v[j][1] * w0[1]) + (v[j][2] * w0[2] + v[j][3] * w0[3]) + (v[j][4] * w1[0] + v[j][5] * w1[1]) + (v[j][6] * w1[2] + v[j][7] * w1[3]); }
                lg[e] = wave_sum(a); }
            int i0 = 0; float v0 = lg[0];
#pragma unroll
            for (int e = 1; e < 8; ++e) if (lg[e] > v0) { v0 = lg[e]; i0 = e; }
            int i1 = -1; float v1 = -3.0e38f;
#pragma unroll
            for (int e = 0; e < 8; ++e) if (e != i0 && lg[e] > v1) { v1 = lg[e]; i1 = e; }
            const float g0 = 1.f / (1.f + __expf(v1 - v0));
            if (F.lane == 0) { te[rloc * 2] = i0; te[rloc * 2 + 1] = i1; tg[rloc * 2] = g0; tg[rloc * 2 + 1] = 1.f - g0; }
        }
    }
    if (MODE == 1) {
        __syncthreads();
        int e = 0, li = 0;
        if (F.tid < 256) { e = te[F.tid]; li = atomicAdd((int*)&lcnt[e], 1); tl[F.tid] = li; }
        __syncthreads();
        if (F.tid < 8) lcnt[8 + F.tid] = (int)atomicAdd(F.ctl + CW_MOECNT + 64 * moe_slot + F.tid, (unsigned)lcnt[F.tid]);
        __syncthreads();
        if (F.tid < 256) {
            const int tok = F.bid * 128 + (F.tid >> 1), k = F.tid & 1;
            ((int*)(F.ws + WS_TOK_E))[tok * 2 + k] = e;
            ((int*)(F.ws + WS_TOK_SLOT))[tok * 2 + k] = lcnt[8 + e] + li;
            ((float*)(F.ws + WS_TOK_G))[tok * 2 + k] = tg[F.tid];
        }
    }
}
constexpr int NL_PITCH = 1032;
template <bool XF32, bool COMB>
__device__ __forceinline__ void phase_norm_lr(Frame& F, const void* xin, const float* gain, int l) {
    bf16_t* HB = (bf16_t*)(F.ws + WS_H); bf16_t* XB = (bf16_t*)((unsigned char*)F.out + XB_OFF); bf16_t* PROJ = (bf16_t*)(F.ws + WS_PROJ);
    const bf16_t* Y = (const bf16_t*)(F.ws + WS_Y);
    const int* TOK_ROW = (const int*)(F.ws + WS_TOK_ROW); const float* TOK_G = (const float*)(F.ws + WS_TOK_G);
    LAS bf16_t* WL = (LAS bf16_t*)F.lds;
    LAS float* GL = (LAS float*)(F.lds + 16 * NL_PITCH * 2);
    __syncthreads();
    { const float* wl = INF(F, I_W_IN) + (size_t)l * DM * IN_COLS + 1280;
#pragma unroll 1
      for (int c = F.tid; c < DM; c += 512) { const float* p = wl + (size_t)c * IN_COLS;
          const f32x4 a = *(const f32x4*)p, b = *(const f32x4*)(p + 4), cc = *(const f32x4*)(p + 8), d = *(const f32x4*)(p + 12);
#pragma unroll
          for (int j = 0; j < 4; ++j) { WL[j * NL_PITCH + c] = f2bf(a[j]); WL[(4 + j) * NL_PITCH + c] = f2bf(b[j]); WL[(8 + j) * NL_PITCH + c] = f2bf(cc[j]); WL[(12 + j) * NL_PITCH + c] = f2bf(d[j]); }
          GL[c] = gain[c]; } }
    __syncthreads();
    const int r16 = F.lane & 15, kq = F.lane >> 4;
    const int row = F.bid * 128 + F.wave * 16 + r16;
    u32x4 xs[32]; float ss = 0.f, sb = 0.f;
    if (XF32) {
        const float* xr = (const float*)xin + (size_t)row * DM + 8 * kq;
#pragma unroll
        for (int s = 0; s < 32; ++s) { const f32x4 a = *(const f32x4*)(xr + 32 * s), b = *(const f32x4*)(xr + 32 * s + 4);
            ss = __builtin_fmaf(a[0], a[0], ss); sb = __builtin_fmaf(a[1], a[1], sb); ss = __builtin_fmaf(a[2], a[2], ss); sb = __builtin_fmaf(a[3], a[3], sb); ss = __builtin_fmaf(b[0], b[0], ss); sb = __builtin_fmaf(b[1], b[1], sb); ss = __builtin_fmaf(b[2], b[2], ss); sb = __builtin_fmaf(b[3], b[3], sb);
            xs[s].x = pg8::cvt_pk_c(a[0], a[1]); xs[s].y = pg8::cvt_pk_c(a[2], a[3]); xs[s].z = pg8::cvt_pk_c(b[0], b[1]); xs[s].w = pg8::cvt_pk_c(b[2], b[3]);
            if ((s & 7) == 7) __builtin_amdgcn_sched_barrier(0); }
    } else if (!COMB) {
        const bf16_t* xr = (const bf16_t*)xin + (size_t)row * DM + 8 * kq;
#pragma unroll
        for (int s = 0; s < 32; ++s) xs[s] = *(const u32x4*)(xr + 32 * s);
#pragma unroll
        for (int s = 0; s < 32; ++s) { const u32x4 w = xs[s];
            ss = __builtin_fmaf(bflo(w.x), bflo(w.x), ss); sb = __builtin_fmaf(bfhi(w.x), bfhi(w.x), sb); ss = __builtin_fmaf(bflo(w.y), bflo(w.y), ss); sb = __builtin_fmaf(bfhi(w.y), bfhi(w.y), sb);
            ss = __builtin_fmaf(bflo(w.z), bflo(w.z), ss); sb = __builtin_fmaf(bfhi(w.z), bfhi(w.z), sb); ss = __builtin_fmaf(bflo(w.w), bflo(w.w), ss); sb = __builtin_fmaf(bfhi(w.w), bfhi(w.w), sb); }
    } else {
        const int r0 = TOK_ROW[row * 2], r1 = TOK_ROW[row * 2 + 1]; const float g0 = TOK_G[row * 2], g1 = TOK_G[row * 2 + 1];
        const bf16_t* xr = (const bf16_t*)xin + (size_t)row * DM + 8 * kq; const bf16_t* ya = Y + (size_t)r0 * DM + 8 * kq; const bf16_t* yb = Y + (size_t)r1 * DM + 8 * kq;
        bf16_t* xo = XB + (size_t)row * DM + 8 * kq;
#pragma unroll
        for (int s = 0; s < 32; ++s) { const u32x4 w = *(const u32x4*)(xr + 32 * s), a = *(const u32x4*)(ya + 32 * s), b = *(const u32x4*)(yb + 32 * s);
            float v[8];
            v[0] = bflo(w.x) + g0 * bflo(a.x) + g1 * bflo(b.x); v[1] = bfhi(w.x) + g0 * bfhi(a.x) + g1 * bfhi(b.x); v[2] = bflo(w.y) + g0 * bflo(a.y) + g1 * bflo(b.y); v[3] = bfhi(w.y) + g0 * bfhi(a.y) + g1 * bfhi(b.y);
            v[4] = bflo(w.z) + g0 * bflo(a.z) + g1 * bflo(b.z); v[5] = bfhi(w.z) + g0 * bfhi(a.z) + g1 * bfhi(b.z); v[6] = bflo(w.w) + g0 * bflo(a.w) + g1 * bflo(b.w); v[7] = bfhi(w.w) + g0 * bfhi(a.w) + g1 * bfhi(b.w);
#pragma unroll
            for (int j = 0; j < 8; j += 2) { ss = __builtin_fmaf(v[j], v[j], ss); sb = __builtin_fmaf(v[j + 1], v[j + 1], sb); }
            xs[s].x = pg8::cvt_pk_c(v[0], v[1]); xs[s].y = pg8::cvt_pk_c(v[2], v[3]); xs[s].z = pg8::cvt_pk_c(v[4], v[5]); xs[s].w = pg8::cvt_pk_c(v[6], v[7]);
            *(u32x4*)(xo + 32 * s) = xs[s];
            if ((s & 1) == 1) __builtin_amdgcn_sched_barrier(0); }
    }
    ss += sb; ss += __shfl_xor(ss, 16); ss += __shfl_xor(ss, 32);
    const float rstd = rsqrtf(ss * (1.f / DM) + NORM_EPS);
#pragma unroll
    for (int s = 0; s < 32; ++s) asm volatile("" : "+v"(xs[s].x), "+v"(xs[s].y), "+v"(xs[s].z), "+v"(xs[s].w));
    f32x4 acc = {0.f, 0.f, 0.f, 0.f};
    bf16_t* ho = HB + (size_t)row * DM + 8 * kq;
#pragma unroll
    for (int s = 0; s < 32; ++s) { const int c0 = 32 * s + 8 * kq; const f32x4 ga = *(const LAS f32x4*)(GL + c0), gb = *(const LAS f32x4*)(GL + c0 + 4); const u32x4 w = xs[s];
        u32x4 hw; hw.x = pg8::cvt_pk_c(bflo(w.x) * rstd * ga[0], bfhi(w.x) * rstd * ga[1]); hw.y = pg8::cvt_pk_c(bflo(w.y) * rstd * ga[2], bfhi(w.y) * rstd * ga[3]);
        hw.z = pg8::cvt_pk_c(bflo(w.z) * rstd * gb[0], bfhi(w.z) * rstd * gb[1]); hw.w = pg8::cvt_pk_c(bflo(w.w) * rstd * gb[2], bfhi(w.w) * rstd * gb[3]);
        *(u32x4*)(ho + 32 * s) = hw;
        acc = __builtin_amdgcn_mfma_f32_16x16x32_bf16(*(const LAS bf16x8*)(WL + r16 * NL_PITCH + c0), __builtin_bit_cast(bf16x8, hw), acc, 0, 0, 0);
        if ((s & 3) == 3) __builtin_amdgcn_sched_barrier(0); }
    { u32x2 o; o.x = pg8::cvt_pk_c(acc[0], acc[1]); o.y = pg8::cvt_pk_c(acc[2], acc[3]); *(u32x2*)(PROJ + (size_t)row * NPROJ + PB_LR + 4 * kq) = o; }
}
__device__ __forceinline__ void phase_final_copy(Frame& F) {
    const f32x4* src = (const f32x4*)(F.ws + WS_PROJ); f32x4* dst = (f32x4*)(F.out + (size_t)(NTOK / 2) * DM);
    for (int i = F.bid * 512 + F.tid; i < NTOK / 2 * DM / 4; i += F.G * 512) dst[i] = src[i];
}

__device__ __forceinline__ void moe_bases(const unsigned* cnt, int (&tb)[9]) {
    tb[0] = 0;
#pragma unroll
    for (int e = 0; e < 8; ++e) tb[e + 1] = tb[e] + __builtin_amdgcn_readfirstlane((int)((__hip_atomic_load(cnt + e, __ATOMIC_RELAXED, __HIP_MEMORY_SCOPE_AGENT) + 255u) >> 8));
}
__device__ __forceinline__ void phase_moe_map(Frame& F, int moe_slot) {
    int tb[9]; moe_bases(F.ctl + CW_MOECNT + 64 * moe_slot, tb);
    const int* TE = (const int*)(F.ws + WS_TOK_E); const int* TS = (const int*)(F.ws + WS_TOK_SLOT); int* TR = (int*)(F.ws + WS_TOK_ROW); int* RM = (int*)(F.ws + WS_ROWMAP);
    for (int a = F.bid * 512 + F.tid; a < NTOK * 2; a += F.G * 512) {
        const int e = TE[a]; int base = 0;
#pragma unroll
        for (int j = 0; j < 8; ++j) base = (e == j) ? tb[j] : base;
        const int row = base * 256 + TS[a]; TR[a] = row; RM[row] = a >> 1;
    }
    { unsigned zz = 0u; asm volatile("" : "+v"(zz)); unsigned char* A8 = F.ws + WS_PROJ;
      for (int i = F.bid * 512 + F.tid; i < tb[8] * 256 * ((KP8 - D_FFE) / 16); i += F.G * 512) { const int row = i >> 3, c = i & 7; *(u32x4*)(A8 + (size_t)row * KP8 + D_FFE + 16 * c) = (u32x4){zz, zz, zz, zz}; } }
    for (int i = F.bid * 512 + F.tid; i < N_EXP * 256; i += F.G * 512) {
        const int e = i >> 8, j = i & 255; int b0 = 0, b1 = 0;
#pragma unroll
        for (int q = 0; q < 8; ++q) { b0 = (e == q) ? tb[q] : b0; b1 = (e == q) ? tb[q + 1] : b1; }
        const int cnt = (int)__hip_atomic_load(F.ctl + CW_MOECNT + 64 * moe_slot + e, __ATOMIC_RELAXED, __HIP_MEMORY_SCOPE_AGENT);
        const int row = b0 * 256 + cnt + j; if (row < b1 * 256) RM[row] = 0;
    }
}
__device__ __forceinline__ void swa_unit(Frame& F, int l, int unit) {
    const bf16_t* P = (const bf16_t*)(F.ws + WS_PROJ); bf16_t* MIX = (bf16_t*)(F.ws + WS_MIX);
    const float* RC = (const float*)(F.ws + WS_ROPE_C); const float* RS = (const float*)(F.ws + WS_ROPE_S);
    const int qblk = unit & 31, kvh = (unit >> 5) & 1, b = unit >> 6;
    LAS float* Ks = (LAS float*)F.lds;
    LAS float* Vs = (LAS float*)(F.lds + 65536);
    const int tok0 = b * SEQ + qblk * 128;
    __syncthreads();
#pragma unroll 1
    for (int it = 0; it < 16; ++it) {
        const int idx = it * 512 + F.tid, j = idx >> 5, d = idx & 31; const int pos = qblk * 128 - 128 + j;
        float o1 = 0.f, o2 = 0.f;
        if (pos >= 0) { const int tok = b * SEQ + pos; const bf16_t* kp = P + (size_t)tok * NPROJ + PA_K + kvh * 64;
            const float k1 = bf2f(kp[d]), k2 = bf2f(kp[d + 32]), c = RC[tok * 32 + d], s = RS[tok * 32 + d]; o1 = k1 * c - k2 * s; o2 = k2 * c + k1 * s; }
        Ks[j * 64 + d] = o1; Ks[j * 64 + d + 32] = o2;
    }
#pragma unroll 1
    for (int it = 0; it < 32; ++it) {
        const int idx = it * 512 + F.tid, j = idx >> 6, d = idx & 63; const int pos = qblk * 128 - 128 + j;
        Vs[idx] = (pos >= 0) ? bf2f(P[(size_t)(b * SEQ + pos) * NPROJ + PA_V + kvh * 64 + d]) : 0.f;
    }
    const int part = F.tid >> 8, qv = F.tid & 255, g = qv >> 7, i = qv & 127, hq = kvh * 2 + g;
    const int tok = tok0 + i;
    float q[64];
    { const bf16_t* qp = P + (size_t)tok * NPROJ + PA_Q + hq * 64;
#pragma unroll
      for (int d = 0; d < 32; ++d) { const float q1 = bf2f(qp[d]), q2 = bf2f(qp[d + 32]), c = RC[tok * 32 + d], s = RS[tok * 32 + d]; q[d] = (q1 * c - q2 * s) * 0.125f; q[d + 32] = (q2 * c + q1 * s) * 0.125f; } }
    const float sink = INF(F, I_SINKS)[l * 4 + hq];
    float m = sink, lsum = (part == 0) ? 1.f : 0.f, acc[64];
#pragma unroll
    for (int d = 0; d < 64; ++d) acc[d] = 0.f;
    __syncthreads();
    for (int jj = 0; jj < 128; ++jj) {
        const int j = part * 128 + jj;
        const bool valid = (j > i) && (j <= i + 128) && (qblk > 0 || j >= 128);
        float s = 0.f;
#pragma unroll
        for (int d4 = 0; d4 < 16; ++d4) { const f32x4 kv = *(const LAS f32x4*)(Ks + j * 64 + d4 * 4); s += (q[d4 * 4] * kv[0] + q[d4 * 4 + 1] * kv[1]) + (q[d4 * 4 + 2] * kv[2] + q[d4 * 4 + 3] * kv[3]); }
        if (!valid) s = -INFINITY;
        const float mn = fmaxf(m, s), sc = __expf(m - mn), p = __expf(s - mn);
        lsum = lsum * sc + p; m = mn;
#pragma unroll
        for (int d4 = 0; d4 < 16; ++d4) { const f32x4 vv = *(const LAS f32x4*)(Vs + j * 64 + d4 * 4);
            acc[d4 * 4] = acc[d4 * 4] * sc + p * vv[0]; acc[d4 * 4 + 1] = acc[d4 * 4 + 1] * sc + p * vv[1]; acc[d4 * 4 + 2] = acc[d4 * 4 + 2] * sc + p * vv[2]; acc[d4 * 4 + 3] = acc[d4 * 4 + 3] * sc + p * vv[3]; }
    }
    __syncthreads();
    LAS float* MB = (LAS float*)F.lds;
    if (part == 1) { MB[qv * 66] = m; MB[qv * 66 + 1] = lsum;
#pragma unroll
        for (int d = 0; d < 64; ++d) MB[qv * 66 + 2 + d] = acc[d]; }
    __syncthreads();
    if (part == 0) {
        const float m1 = MB[qv * 66], l1 = MB[qv * 66 + 1]; const float M = fmaxf(m, m1), s0 = __expf(m - M), s1 = __expf(m1 - M);
        const float inv = 1.f / (lsum * s0 + l1 * s1); float ss = 0.f;
#pragma unroll
        for (int d = 0; d < 64; ++d) { acc[d] = (acc[d] * s0 + MB[qv * 66 + 2 + d] * s1) * inv; ss += acc[d] * acc[d]; }
        const float rstd = rsqrtf(ss * (1.f / 64.f) + NORM_EPS); const float* gn = INF(F, I_SWA_ON) + l * 256 + hq * 64;
        bf16_t* op = MIX + (size_t)tok * DM + hq * 64;
#pragma unroll
        for (int d8 = 0; d8 < 8; ++d8) { u32x4 w;
            w.x = pk2(acc[d8 * 8] * rstd * gn[d8 * 8], acc[d8 * 8 + 1] * rstd * gn[d8 * 8 + 1]); w.y = pk2(acc[d8 * 8 + 2] * rstd * gn[d8 * 8 + 2], acc[d8 * 8 + 3] * rstd * gn[d8 * 8 + 3]);
            w.z = pk2(acc[d8 * 8 + 4] * rstd * gn[d8 * 8 + 4], acc[d8 * 8 + 5] * rstd * gn[d8 * 8 + 5]); w.w = pk2(acc[d8 * 8 + 6] * rstd * gn[d8 * 8 + 6], acc[d8 * 8 + 7] * rstd * gn[d8 * 8 + 7]);
            *(u32x4*)(op + d8 * 8) = w; }
    }
}

__device__ __forceinline__ void sb_waveunit(Frame& F, int l, int wu) {
    const bf16_t* P = (const bf16_t*)(F.ws + WS_PROJ); bf16_t* MIX = (bf16_t*)(F.ws + WS_MIX);
    const int tb = wu & 63, h = (wu >> 6) & 3, b = wu >> 8;
    const int t0 = tb * 64, t = t0 + F.lane;
    float q[64], o[64];
    { const u32x4* qp = (const u32x4*)(P + (size_t)(b * SEQ + t) * NPROJ + PC_Q + h * 64);
#pragma unroll
      for (int d8 = 0; d8 < 8; ++d8) { const u32x4 w = qp[d8];
          q[d8 * 8] = bflo(w.x) * 0.125f; q[d8 * 8 + 1] = bfhi(w.x) * 0.125f; q[d8 * 8 + 2] = bflo(w.y) * 0.125f; q[d8 * 8 + 3] = bfhi(w.y) * 0.125f;
          q[d8 * 8 + 4] = bflo(w.z) * 0.125f; q[d8 * 8 + 5] = bfhi(w.z) * 0.125f; q[d8 * 8 + 6] = bflo(w.w) * 0.125f; q[d8 * 8 + 7] = bfhi(w.w) * 0.125f; } }
#pragma unroll
    for (int d = 0; d < 64; ++d) o[d] = 0.f;
    float R = 0.f;
    for (int s = t0 + 62; s >= 0; --s) {
        if (s < t0) { if (__all(R < -80.f)) break; }
        const size_t rowoff = (size_t)__builtin_amdgcn_readfirstlane(b * SEQ + s) * NPROJ;
        const u32x4* kp = (const u32x4*)(P + rowoff + PC_K + h * 64); const u32x4* vp = (const u32x4*)(P + rowoff + PC_V + h * 64);
        float z = 0.f;
#pragma unroll
        for (int d8 = 0; d8 < 8; ++d8) { const u32x4 w = kp[d8];
            z += (q[d8 * 8] * bflo(w.x) + q[d8 * 8 + 1] * bfhi(w.x)) + (q[d8 * 8 + 2] * bflo(w.y) + q[d8 * 8 + 3] * bfhi(w.y))
               + (q[d8 * 8 + 4] * bflo(w.z) + q[d8 * 8 + 5] * bfhi(w.z)) + (q[d8 * 8 + 6] * bflo(w.w) + q[d8 * 8 + 7] * bfhi(w.w)); }
        const bool valid = s < t;
        const float sp = softplus_f(z);
        const float p = valid ? __expf((z - sp) + R) : 0.f;
        R += valid ? -sp : 0.f;
#pragma unroll
        for (int d8 = 0; d8 < 8; ++d8) { const u32x4 w = vp[d8];
            o[d8 * 8] += p * bflo(w.x); o[d8 * 8 + 1] += p * bfhi(w.x); o[d8 * 8 + 2] += p * bflo(w.y); o[d8 * 8 + 3] += p * bfhi(w.y);
            o[d8 * 8 + 4] += p * bflo(w.z); o[d8 * 8 + 5] += p * bfhi(w.z); o[d8 * 8 + 6] += p * bflo(w.w); o[d8 * 8 + 7] += p * bfhi(w.w); }
    }
    float ss = 0.f;
#pragma unroll
    for (int d = 0; d < 64; ++d) ss += o[d] * o[d];
    const float rstd = rsqrtf(ss * (1.f / 64.f) + NORM_EPS); const float* gn = INF(F, I_SB_ON) + l * 256 + h * 64;
    bf16_t* op = MIX + (size_t)(b * SEQ + t) * DM + 512 + h * 64;
#pragma unroll
    for (int d8 = 0; d8 < 8; ++d8) { u32x4 w;
        w.x = pk2(o[d8 * 8] * rstd * gn[d8 * 8], o[d8 * 8 + 1] * rstd * gn[d8 * 8 + 1]); w.y = pk2(o[d8 * 8 + 2] * rstd * gn[d8 * 8 + 2], o[d8 * 8 + 3] * rstd * gn[d8 * 8 + 3]);
        w.z = pk2(o[d8 * 8 + 4] * rstd * gn[d8 * 8 + 4], o[d8 * 8 + 5] * rstd * gn[d8 * 8 + 5]); w.w = pk2(o[d8 * 8 + 6] * rstd * gn[d8 * 8 + 6], o[d8 * 8 + 7] * rstd * gn[d8 * 8 + 7]);
        *(u32x4*)(op + d8 * 8) = w; }
}

__device__ __forceinline__ void gla_decay_cumsum(Frame& F, int l, int b, int h, int n, LAS float* Bc) {
    const bf16_t* P = (const bf16_t*)(F.ws + WS_PROJ);
    const float* wa2 = INF(F, I_GLA_WA2) + l * 16 * 128; const float* ba = INF(F, I_GLA_BA) + l * 128;
    const int tok0 = b * SEQ + n * 64;
#pragma unroll
    for (int it = 0; it < 4; ++it) { const int idx = it * 512 + F.tid, t = idx >> 5, e = idx & 31;
        const bf16_t* lr = P + (size_t)(tok0 + t) * NPROJ + PB_LR; float a = ba[h * 32 + e];
#pragma unroll
        for (int r = 0; r < 16; ++r) a += bf2f(lr[r]) * wa2[r * 128 + h * 32 + e];
        Bc[idx] = logsigmoid_f(a) * (1.f / 16.f); }
    __syncthreads();
    if (F.tid < 32) { float c = 0.f; for (int t = 0; t < 64; ++t) { c += Bc[t * 32 + F.tid]; Bc[t * 32 + F.tid] = c; } }
    __syncthreads();
}
__device__ __forceinline__ void gla_kv_unit(Frame& F, int l, int unit) {
    const bf16_t* P = (const bf16_t*)(F.ws + WS_PROJ);
    float* KV = (float*)(F.ws + WS_GLA_KV) + (size_t)unit * 2048; float* DEC = (float*)(F.ws + WS_GLA_DEC) + unit * 32;
    const int n = unit & 63, h = (unit >> 6) & 3, b = unit >> 8, tok0 = b * SEQ + n * 64;
    LAS float* Bc = (LAS float*)F.lds; LAS float* Ke = (LAS float*)(F.lds + 8192); LAS float* Vs = (LAS float*)(F.lds + 16384);
    __syncthreads();
    gla_decay_cumsum(F, l, b, h, n, Bc);
#pragma unroll
    for (int it = 0; it < 4; ++it) { const int idx = it * 512 + F.tid, s = idx >> 5, e = idx & 31;
        Ke[idx] = bf2f(P[(size_t)(tok0 + s) * NPROJ + PB_K + h * 32 + e]) * __expf(Bc[63 * 32 + e] - Bc[idx]); }
#pragma unroll
    for (int it = 0; it < 8; ++it) { const int idx = it * 512 + F.tid, s = idx >> 6, f = idx & 63; Vs[idx] = bf2f(P[(size_t)(tok0 + s) * NPROJ + PB_V + h * 64 + f]); }
    __syncthreads();
    { const int e = F.tid >> 4, f0 = (F.tid & 15) * 4; f32x4 a = {0.f, 0.f, 0.f, 0.f};
      for (int s = 0; s < 64; ++s) { const float ke = Ke[s * 32 + e]; const f32x4 vv = *(const LAS f32x4*)(Vs + s * 64 + f0); a += ke * vv; }
      *(f32x4*)(KV + e * 64 + f0) = a; }
    if (F.tid < 32) DEC[F.tid] = __expf(Bc[63 * 32 + F.tid]);
}
__device__ __forceinline__ void gla_scan(Frame& F, int gtid) {
    const int f = gtid & 63, e = (gtid >> 6) & 31, bh = gtid >> 11;
    float* KV = (float*)(F.ws + WS_GLA_KV) + (size_t)bh * 64 * 2048 + e * 64 + f; const float* DEC = (const float*)(F.ws + WS_GLA_DEC) + bh * 64 * 32 + e;
    float st = 0.f;
#pragma unroll 8
    for (int n = 0; n < 64; ++n) { const float kv = KV[(size_t)n * 2048], d = DEC[n * 32]; KV[(size_t)n * 2048] = st; st = d * st + kv; }
}
__device__ __forceinline__ void gla_out_unit(Frame& F, int l, int unit) {
    const bf16_t* P = (const bf16_t*)(F.ws + WS_PROJ); bf16_t* MIX = (bf16_t*)(F.ws + WS_MIX);
    const float* SP = (const float*)(F.ws + WS_GLA_KV) + (size_t)unit * 2048;
    const int n = unit & 63, h = (unit >> 6) & 3, b = unit >> 8, tok0 = b * SEQ + n * 64;
    LAS float* Bc = (LAS float*)F.lds; LAS float* Qe = (LAS float*)(F.lds + 8192); LAS float* Ke = (LAS float*)(F.lds + 16384); LAS float* Qb = (LAS float*)(F.lds + 25088);
    LAS float* Vs = (LAS float*)(F.lds + 33792); LAS float* Ss = (LAS float*)(F.lds + 50176); LAS float* At = (LAS float*)(F.lds + 58368);
    __syncthreads();
    gla_decay_cumsum(F, l, b, h, n, Bc);
    const float qs = 0.17677669529663687f;
#pragma unroll
    for (int it = 0; it < 4; ++it) { const int idx = it * 512 + F.tid, t = idx >> 5, e = idx & 31;
        const float bt = Bc[idx], br = Bc[31 * 32 + e];
        const float qv = bf2f(P[(size_t)(tok0 + t) * NPROJ + PB_Q + h * 32 + e]) * qs, kv = bf2f(P[(size_t)(tok0 + t) * NPROJ + PB_K + h * 32 + e]);
        Qe[idx] = qv * __expf(bt - br); Ke[t * 33 + e] = kv * __expf(br - bt); Qb[idx] = qv * __expf(bt); }
#pragma unroll
    for (int it = 0; it < 8; ++it) { const int idx = it * 512 + F.tid, s = idx >> 6, f = idx & 63; Vs[idx] = bf2f(P[(size_t)(tok0 + s) * NPROJ + PB_V + h * 64 + f]); }
#pragma unroll
    for (int it = 0; it < 4; ++it) { const int idx = it * 512 + F.tid; Ss[idx] = SP[idx]; }
    __syncthreads();
#pragma unroll
    for (int it = 0; it < 8; ++it) { const int idx = it * 512 + F.tid, t = idx >> 6, s = idx & 63; float a = 0.f;
        if (s <= t) {
#pragma unroll
            for (int e = 0; e < 32; ++e) a += Qe[t * 32 + e] * Ke[s * 33 + e]; }
        At[t * 65 + s] = a; }
    __syncthreads();
    { const int t = F.tid >> 3, f0 = (F.tid & 7) * 8; float o[8];
#pragma unroll
      for (int j = 0; j < 8; ++j) o[j] = 0.f;
      for (int s = 0; s <= t; ++s) { const float a = At[t * 65 + s]; const f32x4 v0 = *(const LAS f32x4*)(Vs + s * 64 + f0), v1 = *(const LAS f32x4*)(Vs + s * 64 + f0 + 4);
          o[0] += a * v0[0]; o[1] += a * v0[1]; o[2] += a * v0[2]; o[3] += a * v0[3]; o[4] += a * v1[0]; o[5] += a * v1[1]; o[6] += a * v1[2]; o[7] += a * v1[3]; }
#pragma unroll
      for (int e = 0; e < 32; ++e) { const float a = Qb[t * 32 + e]; const f32x4 v0 = *(const LAS f32x4*)(Ss + e * 64 + f0), v1 = *(const LAS f32x4*)(Ss + e * 64 + f0 + 4);
          o[0] += a * v0[0]; o[1] += a * v0[1]; o[2] += a * v0[2]; o[3] += a * v0[3]; o[4] += a * v1[0]; o[5] += a * v1[1]; o[6] += a * v1[2]; o[7] += a * v1[3]; }
      float ss = 0.f;
#pragma unroll
      for (int j = 0; j < 8; ++j) ss += o[j] * o[j];
      ss += __shfl_xor(ss, 1); ss += __shfl_xor(ss, 2); ss += __shfl_xor(ss, 4);
      const float rstd = rsqrtf(ss * (1.f / 64.f) + NORM_EPS); const float* gn = INF(F, I_GLA_ON) + l * 256 + h * 64 + f0;
      const u32x4 gw = *(const u32x4*)(P + (size_t)(tok0 + t) * NPROJ + PB_G + h * 64 + f0);
      float gb[8] = {bflo(gw.x), bfhi(gw.x), bflo(gw.y), bfhi(gw.y), bflo(gw.z), bfhi(gw.z), bflo(gw.w), bfhi(gw.w)};
      float r[8];
#pragma unroll
      for (int j = 0; j < 8; ++j) r[j] = o[j] * rstd * gn[j] * (gb[j] * sigmoid_f(gb[j]));
      u32x4 w; w.x = pk2(r[0], r[1]); w.y = pk2(r[2], r[3]); w.z = pk2(r[4], r[5]); w.w = pk2(r[6], r[7]);
      *(u32x4*)(MIX + (size_t)(tok0 + t) * DM + 256 + h * 64 + f0) = w; }
}

template <int CTRL> __device__ __forceinline__ float dpp_add(float v) { return v + __builtin_bit_cast(float, __builtin_amdgcn_update_dpp(0, __builtin_bit_cast(int, v), CTRL, 0xf, 0xf, false)); }
__device__ __forceinline__ float sum16(float v) { v = dpp_add<0xB1>(v); v = dpp_add<0x4E>(v); v = dpp_add<0x141>(v); v = dpp_add<0x140>(v); return v; }
typedef float f32x16 __attribute__((ext_vector_type(16)));
__device__ __forceinline__ float other_half(float x, int hh) {
    auto t = __builtin_amdgcn_permlane32_swap(__float_as_uint(x), __float_as_uint(x), false, false);
    return __uint_as_float(hh ? t[0] : t[1]);
}
__device__ __forceinline__ unsigned cvt_pk(float lo, float hi) { unsigned r; asm volatile("v_cvt_pk_bf16_f32 %0, %1, %2" : "=v"(r) : "v"(lo), "v"(hi)); return r; }
__device__ __forceinline__ bf16x8 pack8(float p0, float p1, float p2, float p3, float p4, float p5, float p6, float p7) {
    u32x4 w; w.x = cvt_pk(p0, p1); w.y = cvt_pk(p2, p3); w.z = cvt_pk(p4, p5); w.w = cvt_pk(p6, p7); return __builtin_bit_cast(bf16x8, w);
}
#define PACK8(a, o) pack8(a[(o)], a[(o) + 1], a[(o) + 2], a[(o) + 3], a[(o) + 4], a[(o) + 5], a[(o) + 6], a[(o) + 7])
__device__ __forceinline__ bf16x8 load_vt(const bf16_t* P, size_t vrow0, int vcol, int db, int ko, int r, int hh) {
    const bf16_t* p = P + (vrow0 + 32 * db + r) * NPROJ + vcol + ko + 4 * hh;
    const u32x2 a = *(const u32x2*)p, b = *(const u32x2*)(p + 8);
    u32x4 w; w.x = a.x; w.y = a.y; w.z = b.x; w.w = b.y; return __builtin_bit_cast(bf16x8, w);
}
__device__ __forceinline__ void store_ot(bf16_t* orow, const f32x16& o0, const f32x16& o1, float rs, const float* gn, int hh) {
#pragma unroll
    for (int db = 0; db < 2; ++db)
#pragma unroll
        for (int g4 = 0; g4 < 4; ++g4) { const int d = 32 * db + 8 * g4 + 4 * hh; const f32x4 gv = *(const f32x4*)(gn + d);
            const f32x16& o = db ? o1 : o0;
            u32x2 w; w.x = cvt_pk(o[4 * g4] * rs * gv[0], o[4 * g4 + 1] * rs * gv[1]); w.y = cvt_pk(o[4 * g4 + 2] * rs * gv[2], o[4 * g4 + 3] * rs * gv[3]);
            *(u32x2*)(orow + d) = w; }
}

__device__ __forceinline__ void attn_prep_block(Frame& F, int blk) {
    bf16_t* P = (bf16_t*)(F.ws + WS_PROJ);
    const float* RC = (const float*)(F.ws + WS_ROPE_C); const float* RS = (const float*)(F.ws + WS_ROPE_S);
    LAS unsigned* T = (LAS unsigned*)F.lds;
    const int tok0 = blk * 64;
    for (int it = 0; it < 24; ++it) { const int idx = it * 512 + F.tid, d = idx & 31, hd = (idx >> 5) % 6, tt = idx / 192; const int tok = tok0 + tt;
        bf16_t* p = P + (size_t)tok * NPROJ + (hd < 4 ? PA_Q + hd * 64 : PA_K + (hd - 4) * 64); const float sc = hd < 4 ? 0.18033688011112042f : 1.f;
        const float x1 = bf2f(p[d]), x2 = bf2f(p[d + 32]), c = RC[tok * 32 + d], s = RS[tok * 32 + d];
        p[d] = f2bf((x1 * c - x2 * s) * sc); p[d + 32] = f2bf((x2 * c + x1 * s) * sc); }
    for (int vt = 0; vt < 6; ++vt) {
        const int vcol = vt < 2 ? PA_V + vt * 64 : PC_V + (vt - 2) * 64;
        __syncthreads();
        { const int tt = F.tid >> 3, c8 = F.tid & 7; const u32x4 w = *(const u32x4*)(P + (size_t)(tok0 + tt) * NPROJ + vcol + c8 * 8);
          T[tt * 33 + c8 * 4] = w.x; T[tt * 33 + c8 * 4 + 1] = w.y; T[tt * 33 + c8 * 4 + 2] = w.z; T[tt * 33 + c8 * 4 + 3] = w.w; }
        __syncthreads();
        { const int d = F.tid >> 3, t8 = F.tid & 7; unsigned e[8];
#pragma unroll
          for (int i = 0; i < 8; ++i) { const unsigned w = T[(t8 * 8 + i) * 33 + (d >> 1)]; e[i] = (d & 1) ? (w >> 16) : (w & 0xffffu); }
          u32x4 o; o.x = e[0] | (e[1] << 16); o.y = e[2] | (e[3] << 16); o.z = e[4] | (e[5] << 16); o.w = e[6] | (e[7] << 16);
          *(u32x4*)(P + (size_t)(tok0 + d) * NPROJ + vcol + t8 * 8) = o; }
    }
}

__device__ __forceinline__ void sb_task(Frame& F, int l, int task) {
    const bf16_t* P = (const bf16_t*)(F.ws + WS_PROJ); bf16_t* MIX = (bf16_t*)(F.ws + WS_MIX);
    const int qb = task & 127, h = (task >> 7) & 3, b = task >> 9;
    const int q0 = qb * 32, r = F.lane & 31, hh = F.lane >> 5, t = q0 + r;
    const size_t rowb = (size_t)b * SEQ;
    bf16x8 qf[4];
    { const bf16_t* qp = P + (rowb + t) * NPROJ + PC_Q + h * 64 + 8 * hh;
#pragma unroll
      for (int s = 0; s < 4; ++s) qf[s] = *(const bf16x8*)(qp + 16 * s); }
    f32x16 o0, o1;
#pragma unroll
    for (int i = 0; i < 16; ++i) { o0[i] = 0.f; o1[i] = 0.f; }
    float R = 0.f;
    bf16x8 kf[2][4];
#define SB_LOADK(kt_) do { _Pragma("unroll") for (int kb = 0; kb < 2; ++kb) { const bf16_t* kp = P + (rowb + 64 * (kt_) + 32 * kb + r) * NPROJ + PC_K + h * 64 + 8 * hh; \
        _Pragma("unroll") for (int s = 0; s < 4; ++s) kf[kb][s] = *(const bf16x8*)(kp + 16 * s); } } while (0)
    SB_LOADK((q0 + 30) >> 6);
    for (int kt = (q0 + 30) >> 6; kt >= 0; --kt) {
        const size_t krow0 = rowb + 64 * kt;
        bf16x8 vf[2][2][2];
#pragma unroll
        for (int kb = 0; kb < 2; ++kb)
#pragma unroll
            for (int s = 0; s < 2; ++s) { vf[0][kb][s] = load_vt(P, krow0, PC_V + h * 64, 0, 32 * kb + 16 * s, r, hh); vf[1][kb][s] = load_vt(P, krow0, PC_V + h * 64, 1, 32 * kb + 16 * s, r, hh); }
        __builtin_amdgcn_sched_barrier(0);
        f32x16 st[2];
#pragma unroll
        for (int kb = 0; kb < 2; ++kb) { f32x16 a;
#pragma unroll
            for (int i = 0; i < 16; ++i) a[i] = 0.f;
#pragma unroll
            for (int s = 0; s < 4; ++s) a = __builtin_amdgcn_mfma_f32_32x32x16_bf16(kf[kb][s], qf[s], a, 0, 0, 0);
            st[kb] = a; }
        bf16x8 kn[2][4];
        { const int ktn = kt > 0 ? kt - 1 : 0;
#pragma unroll
          for (int kb = 0; kb < 2; ++kb) { const bf16_t* kp = P + (rowb + 64 * ktn + 32 * kb + r) * NPROJ + PC_K + h * 64 + 8 * hh;
#pragma unroll
              for (int s = 0; s < 4; ++s) kn[kb][s] = *(const bf16x8*)(kp + 16 * s); } }
        float Rb = R;
#pragma unroll
        for (int kb = 1; kb >= 0; --kb) {
            float lv[16], zz[16], p[16];
#pragma unroll
            for (int i = 0; i < 16; ++i) { const int key = 64 * kt + 32 * kb + (i & 3) + 8 * (i >> 2) + 4 * hh; const float z = st[kb][i] * 0.18033688011112042f; const bool valid = key < t;
                const float sp = fmaxf(z, 0.f) + __builtin_amdgcn_logf(1.f + __builtin_amdgcn_exp2f(-fabsf(z))); lv[i] = valid ? -sp : 0.f; zz[i] = valid ? (z - sp) : -INFINITY; }
            float gown[4], suf[16];
#pragma unroll
            for (int g = 0; g < 4; ++g) { const float s3 = lv[4 * g + 3], s2 = s3 + lv[4 * g + 2], s1 = s2 + lv[4 * g + 1]; gown[g] = s1 + lv[4 * g];
                suf[4 * g + 3] = 0.f; suf[4 * g + 2] = s3; suf[4 * g + 1] = s2; suf[4 * g] = s1; }
            float run = 0.f, above[4];
#pragma unroll
            for (int g = 3; g >= 0; --g) { const float go = other_half(gown[g], hh); above[g] = run + (hh == 0 ? go : 0.f); run += gown[g] + go; }
#pragma unroll
            for (int i = 0; i < 16; ++i) p[i] = __builtin_amdgcn_exp2f(zz[i] + (Rb + above[i >> 2] + suf[i]));
            Rb += run;
#pragma unroll
            for (int s = 0; s < 2; ++s) { const bf16x8 pf = PACK8(p, 8 * s);
                o0 = __builtin_amdgcn_mfma_f32_32x32x16_bf16(vf[0][kb][s], pf, o0, 0, 0, 0);
                o1 = __builtin_amdgcn_mfma_f32_32x32x16_bf16(vf[1][kb][s], pf, o1, 0, 0, 0); }
        }
        R = Rb;
#pragma unroll
        for (int kb = 0; kb < 2; ++kb)
#pragma unroll
            for (int s = 0; s < 4; ++s) kf[kb][s] = kn[kb][s];
        if (__all(R < -115.5f)) break;
    }
#undef SB_LOADK
    float ss = 0.f;
#pragma unroll
    for (int i = 0; i < 16; ++i) ss += o0[i] * o0[i] + o1[i] * o1[i];
    ss += other_half(ss, hh);
    const float rstd = rsqrtf(ss * (1.f / 64.f) + NORM_EPS);
    store_ot(MIX + (rowb + t) * DM + 512 + h * 64, o0, o1, rstd, INF(F, I_SB_ON) + l * 256 + h * 64, hh);
}

__device__ __forceinline__ void swa_task(Frame& F, int l, int task) {
    const bf16_t* P = (const bf16_t*)(F.ws + WS_PROJ); bf16_t* MIX = (bf16_t*)(F.ws + WS_MIX);
    const int qb = task & 127, hq = (task >> 7) & 3, b = task >> 9, kvh = hq >> 1;
    const int q0 = qb * 32, r = F.lane & 31, hh = F.lane >> 5, t = q0 + r;
    const size_t rowb = (size_t)b * SEQ;
    bf16x8 qf[4];
    { const bf16_t* qp = P + (rowb + t) * NPROJ + PA_Q + hq * 64 + 8 * hh;
#pragma unroll
      for (int s = 0; s < 4; ++s) qf[s] = *(const bf16x8*)(qp + 16 * s); }
    f32x16 o0, o1;
#pragma unroll
    for (int i = 0; i < 16; ++i) { o0[i] = 0.f; o1[i] = 0.f; }
    float m = INF(F, I_SINKS)[l * 4 + hq], lsum = 1.f;
    const int ktlo = (q0 >= 127) ? ((q0 - 127) >> 6) : 0;
    for (int kt = (q0 + 31) >> 6; kt >= ktlo; --kt) {
        const size_t krow0 = rowb + 64 * kt;
        float sv[32];
        float tmax = -INFINITY;
#pragma unroll
        for (int kb = 0; kb < 2; ++kb) { const bf16_t* kp = P + (krow0 + 32 * kb + r) * NPROJ + PA_K + kvh * 64 + 8 * hh;
            f32x16 a;
#pragma unroll
            for (int i = 0; i < 16; ++i) a[i] = 0.f;
#pragma unroll
            for (int s = 0; s < 4; ++s) a = __builtin_amdgcn_mfma_f32_32x32x16_bf16(*(const bf16x8*)(kp + 16 * s), qf[s], a, 0, 0, 0);
#pragma unroll
            for (int i = 0; i < 16; ++i) { const int key = 64 * kt + 32 * kb + (i & 3) + 8 * (i >> 2) + 4 * hh; const bool valid = (key <= t) && (key + 127 >= t);
                sv[kb * 16 + i] = valid ? a[i] : -INFINITY; tmax = fmaxf(tmax, sv[kb * 16 + i]); } }
        tmax = fmaxf(tmax, other_half(tmax, hh));
        const float mn = fmaxf(m, tmax), sc = __expf(m - mn);
        float psum = 0.f;
#pragma unroll
        for (int i = 0; i < 32; ++i) { sv[i] = __expf(sv[i] - mn); psum += sv[i]; }
        psum += other_half(psum, hh);
        lsum = lsum * sc + psum; m = mn;
#pragma unroll
        for (int i = 0; i < 16; ++i) { o0[i] *= sc; o1[i] *= sc; }
#pragma unroll
        for (int kb = 0; kb < 2; ++kb)
#pragma unroll
            for (int s = 0; s < 2; ++s) { const bf16x8 pf = PACK8(sv, kb * 16 + 8 * s);
                o0 = __builtin_amdgcn_mfma_f32_32x32x16_bf16(load_vt(P, krow0, PA_V + kvh * 64, 0, 32 * kb + 16 * s, r, hh), pf, o0, 0, 0, 0);
                o1 = __builtin_amdgcn_mfma_f32_32x32x16_bf16(load_vt(P, krow0, PA_V + kvh * 64, 1, 32 * kb + 16 * s, r, hh), pf, o1, 0, 0, 0); }
    }
    const float inv = 1.f / lsum;
    float ss = 0.f;
#pragma unroll
    for (int i = 0; i < 16; ++i) { o0[i] *= inv; o1[i] *= inv; ss += o0[i] * o0[i] + o1[i] * o1[i]; }
    ss += other_half(ss, hh);
    const float rstd = rsqrtf(ss * (1.f / 64.f) + NORM_EPS);
    store_ot(MIX + (rowb + t) * DM + hq * 64, o0, o1, rstd, INF(F, I_SWA_ON) + l * 256 + hq * 64, hh);
}

__device__ __forceinline__ unsigned short hw(const u32x4& w, int j) { const unsigned d = (j >> 1) == 0 ? w.x : ((j >> 1) == 1 ? w.y : ((j >> 1) == 2 ? w.z : w.w)); return (unsigned short)((j & 1) ? (d >> 16) : (d & 0xffffu)); }
template <int V> struct IC { static constexpr int value = V; };
template <bool SWA>
__device__ __forceinline__ void attn_block(Frame& F, int l, int bt) {
    const bf16_t* P = (const bf16_t*)(F.ws + WS_PROJ); bf16_t* MIX = (bf16_t*)(F.ws + WS_MIX);
    const int qblk = bt & 15, h = (bt >> 4) & 3, b = bt >> 6;
    const int q0b = qblk * 256, q0 = q0b + 32 * F.wave, r = F.lane & 31, hh = F.lane >> 5, t = q0 + r;
    const size_t rowb = (size_t)b * SEQ;
    const int qcol = SWA ? PA_Q + h * 64 : PC_Q + h * 64, kcol = SWA ? PA_K + (h >> 1) * 64 : PC_K + h * 64, vcol = SWA ? PA_V + (h >> 1) * 64 : PC_V + h * 64;
    LAS bf16_t* Ks = (LAS bf16_t*)F.lds; LAS bf16_t* Vs = (LAS bf16_t*)(F.lds + 2 * 9216);
    const float* RC = (const float*)(F.ws + WS_ROPE_C); const float* RS = (const float*)(F.ws + WS_ROPE_S);
    bf16x8 qf[4];
    { const bf16_t* qp = P + (rowb + t) * NPROJ + qcol + 8 * hh; u32x4 qw[4];
#pragma unroll
      for (int s = 0; s < 4; ++s) qw[s] = *(const u32x4*)(qp + 16 * s);
      if (SWA) {
#pragma unroll
          for (int s = 0; s < 2; ++s) { const float* cp = RC + (rowb + t) * 32 + 16 * s + 8 * hh; const float* sp = RS + (rowb + t) * 32 + 16 * s + 8 * hh;
              const f32x4 c0 = *(const f32x4*)cp, c1 = *(const f32x4*)(cp + 4), s0 = *(const f32x4*)sp, s1 = *(const f32x4*)(sp + 4);
              const unsigned a[4] = {qw[s].x, qw[s].y, qw[s].z, qw[s].w}, bq[4] = {qw[s + 2].x, qw[s + 2].y, qw[s + 2].z, qw[s + 2].w}; float o1[8], o2[8];
#pragma unroll
              for (int j = 0; j < 8; ++j) { const float x1 = (j & 1) ? bfhi(a[j >> 1]) : bflo(a[j >> 1]), x2 = (j & 1) ? bfhi(bq[j >> 1]) : bflo(bq[j >> 1]), cc = j < 4 ? c0[j & 3] : c1[j & 3], sn = j < 4 ? s0[j & 3] : s1[j & 3];
                  o1[j] = (x1 * cc - x2 * sn) * 0.18033688011112042f; o2[j] = (x2 * cc + x1 * sn) * 0.18033688011112042f; }
              qw[s] = (u32x4){cvt_pk(o1[0], o1[1]), cvt_pk(o1[2], o1[3]), cvt_pk(o1[4], o1[5]), cvt_pk(o1[6], o1[7])}; qw[s + 2] = (u32x4){cvt_pk(o2[0], o2[1]), cvt_pk(o2[2], o2[3]), cvt_pk(o2[4], o2[5]), cvt_pk(o2[6], o2[7])}; } }
#pragma unroll
      for (int s = 0; s < 4; ++s) qf[s] = __builtin_bit_cast(bf16x8, qw[s]); }
    f32x16 o0, o1;
#pragma unroll
    for (int i = 0; i < 16; ++i) { o0[i] = 0.f; o1[i] = 0.f; }
    float R = 0.f;
    float m = SWA ? INF(F, I_SINKS)[l * 4 + h] * 1.4426950408889634f : 0.f, lsum = 1.f;
    const int kt_top = SWA ? (q0b + 255) >> 6 : (q0b + 254) >> 6;
    const int kt_lo = SWA ? ((q0b >= 127) ? ((q0b - 127) >> 6) : 0) : 0;
    const int ktw = SWA ? (q0 + 31) >> 6 : (q0 + 30) >> 6;
    const int ktl = SWA ? ((q0 >= 127) ? ((q0 - 127) >> 6) : 0) : 0;
    bool fin = false;
    const bool kside = F.wave < 4; const int srow = (F.tid & 255) >> 2, q4 = F.tid & 3;
    u32x4 pa_[2], pb_[2]; f32x4 rc0_[2], rc1_[2], rs0_[2], rs1_[2];
#pragma unroll
    for (int i_ = 0; i_ < 2; ++i_) { rc0_[i_] = (f32x4){0.f, 0.f, 0.f, 0.f}; rc1_[i_] = rc0_[i_]; rs0_[i_] = rc0_[i_]; rs1_[i_] = rc0_[i_]; }
#define AT_FETCH(kt_, S_) do { const size_t tk_ = rowb + 64 * (kt_) + srow; \
        if (kside) { const bf16_t* p_ = P + tk_ * NPROJ + kcol + 8 * q4; pa_[S_] = *(const u32x4*)p_; pb_[S_] = *(const u32x4*)(p_ + 32); \
            if (SWA) { const float* c_ = RC + tk_ * 32 + 8 * q4; const float* s_ = RS + tk_ * 32 + 8 * q4; rc0_[S_] = *(const f32x4*)c_; rc1_[S_] = *(const f32x4*)(c_ + 4); rs0_[S_] = *(const f32x4*)s_; rs1_[S_] = *(const f32x4*)(s_ + 4); } } \
        else { const bf16_t* p_ = P + tk_ * NPROJ + vcol + 16 * q4; pa_[S_] = *(const u32x4*)p_; pb_[S_] = *(const u32x4*)(p_ + 8); } } while (0)
#define AT_STORE(bufi, S_) do { if (kside) { LAS bf16_t* d_ = Ks + (bufi) * 4608 + srow * 72 + 8 * q4; \
            if (SWA) { const unsigned a_[4] = {pa_[S_].x, pa_[S_].y, pa_[S_].z, pa_[S_].w}, b_[4] = {pb_[S_].x, pb_[S_].y, pb_[S_].z, pb_[S_].w}; float o1_[8], o2_[8]; \
                _Pragma("unroll") for (int j = 0; j < 8; ++j) { const float x1 = (j & 1) ? bfhi(a_[j >> 1]) : bflo(a_[j >> 1]), x2 = (j & 1) ? bfhi(b_[j >> 1]) : bflo(b_[j >> 1]), cc = j < 4 ? rc0_[S_][j & 3] : rc1_[S_][j & 3], sn = j < 4 ? rs0_[S_][j & 3] : rs1_[S_][j & 3]; \
                    o1_[j] = x1 * cc - x2 * sn; o2_[j] = x2 * cc + x1 * sn; } \
                pa_[S_] = (u32x4){cvt_pk(o1_[0], o1_[1]), cvt_pk(o1_[2], o1_[3]), cvt_pk(o1_[4], o1_[5]), cvt_pk(o1_[6], o1_[7])}; pb_[S_] = (u32x4){cvt_pk(o2_[0], o2_[1]), cvt_pk(o2_[2], o2_[3]), cvt_pk(o2_[4], o2_[5]), cvt_pk(o2_[6], o2_[7])}; } \
            *(LAS u32x4*)d_ = pa_[S_]; *(LAS u32x4*)(d_ + 32) = pb_[S_]; } \
        else { LAS bf16_t* d_ = Vs + (bufi) * 4608 + (16 * q4) * 72 + srow; \
            _Pragma("unroll") for (int j = 0; j < 8; ++j) { d_[j * 72] = hw(pa_[S_], j); d_[(8 + j) * 72] = hw(pb_[S_], j); } } } while (0)
    volatile LAS int* vote = (volatile LAS int*)(F.lds + MISC_OFF + 16);
    __syncthreads();
    if (F.tid < 3) vote[F.tid] = 0;
    AT_FETCH(kt_top, 0); AT_STORE(0, 0);
    if (kt_top > kt_lo) AT_FETCH(kt_top - 1, 1);
    __syncthreads();
    int buf = 0, slot = 0;
    auto trip = [&](const int kt, auto fs_tag) -> bool {
        constexpr int FS_ = decltype(fs_tag)::value;
        const bool mine = !fin && kt <= ktw && kt >= ktl;
        if (mine && F.lane == 0) vote[slot] = 1;
        __syncthreads();
        const int any = vote[slot];
        if (F.tid == 0) vote[slot == 0 ? 2 : slot - 1] = 0;
        slot = slot == 2 ? 0 : slot + 1;
        if (any == 0 && kt < ((SWA ? (q0b + 31) : (q0b + 30)) >> 6)) return false;
        if (kt - 2 >= kt_lo) AT_FETCH(kt - 2, FS_);
        if (mine) {
            const LAS bf16_t* Kb = Ks + buf * 4608; const LAS bf16_t* Vb = Vs + buf * 4608;
            f32x16 st[2];
#pragma unroll
            for (int kb = 0; kb < 2; ++kb) { f32x16 a;
#pragma unroll
                for (int i = 0; i < 16; ++i) a[i] = 0.f;
#pragma unroll
                for (int s = 0; s < 4; ++s) a = __builtin_amdgcn_mfma_f32_32x32x16_bf16(*(const LAS bf16x8*)(Kb + (32 * kb + r) * 72 + 16 * s + 8 * hh), qf[s], a, 0, 0, 0);
                st[kb] = a; }
            if (!SWA) {
                float Rb = R;
#pragma unroll
                for (int kb = 1; kb >= 0; --kb) {
                    float e[16], u[16], p[16];
#pragma unroll
                    for (int i = 0; i < 16; ++i) { const int key = 64 * kt + 32 * kb + (i & 3) + 8 * (i >> 2) + 4 * hh; const float z = fminf(st[kb][i] * 0.18033688011112042f, 30.f); const bool valid = key < t;
                        const float ez = __builtin_amdgcn_exp2f(z); e[i] = valid ? ez : 0.f; u[i] = valid ? 1.f + ez : 1.f; }
                    float gown[4], iq[16];
#pragma unroll
                    for (int g = 0; g < 4; ++g) { const float q32 = u[4 * g + 3] * u[4 * g + 2], q10 = u[4 * g + 1] * u[4 * g]; gown[g] = q32 * q10;
                        const float r0 = __builtin_amdgcn_rcpf(gown[g]);
                        iq[4 * g] = r0; iq[4 * g + 1] = r0 * u[4 * g]; iq[4 * g + 2] = r0 * q10; iq[4 * g + 3] = r0 * q10 * u[4 * g + 2]; }
                    float run = 1.f, ia[4]; const float sc2 = __builtin_amdgcn_exp2f(Rb);
#pragma unroll
                    for (int g = 3; g >= 0; --g) { const float go = other_half(gown[g], hh); ia[g] = sc2 * __builtin_amdgcn_rcpf(run * (hh == 0 ? go : 1.f)); run *= gown[g] * go; }
#pragma unroll
                    for (int i = 0; i < 16; ++i) p[i] = e[i] * (iq[i] * ia[i >> 2]);
                    Rb -= __builtin_amdgcn_logf(run);
#pragma unroll
                    for (int s = 0; s < 2; ++s) { const bf16x8 pf = PACK8(p, 8 * s); const int ko = 32 * kb + 16 * s + 4 * hh;
                        const u32x2 a0 = *(const LAS u32x2*)(Vb + r * 72 + ko), a1 = *(const LAS u32x2*)(Vb + r * 72 + ko + 8), c0 = *(const LAS u32x2*)(Vb + (32 + r) * 72 + ko), c1 = *(const LAS u32x2*)(Vb + (32 + r) * 72 + ko + 8);
                        o0 = __builtin_amdgcn_mfma_f32_32x32x16_bf16(__builtin_bit_cast(bf16x8, (u32x4){a0.x, a0.y, a1.x, a1.y}), pf, o0, 0, 0, 0);
                        o1 = __builtin_amdgcn_mfma_f32_32x32x16_bf16(__builtin_bit_cast(bf16x8, (u32x4){c0.x, c0.y, c1.x, c1.y}), pf, o1, 0, 0, 0); }
                }
                R = Rb;
                fin = __all(R < -115.5f) != 0;
            } else {
                float sv[32]; float tmax = -INFINITY;
#pragma unroll
                for (int kb = 0; kb < 2; ++kb)
#pragma unroll
                    for (int i = 0; i < 16; ++i) { const int key = 64 * kt + 32 * kb + (i & 3) + 8 * (i >> 2) + 4 * hh; const bool valid = (key <= t) && (key + 127 >= t);
                        sv[kb * 16 + i] = valid ? st[kb][i] : -INFINITY; tmax = fmaxf(tmax, sv[kb * 16 + i]); }
                tmax = fmaxf(tmax, other_half(tmax, hh));
                const float mn = fmaxf(m, tmax), sc = __builtin_amdgcn_exp2f(m - mn);
                float psum = 0.f;
#pragma unroll
                for (int i = 0; i < 32; ++i) { sv[i] = __builtin_amdgcn_exp2f(sv[i] - mn); psum += sv[i]; }
                psum += other_half(psum, hh);
                lsum = lsum * sc + psum; m = mn;
#pragma unroll
                for (int i = 0; i < 16; ++i) { o0[i] *= sc; o1[i] *= sc; }
#pragma unroll
                for (int kb = 0; kb < 2; ++kb)
#pragma unroll
                    for (int s = 0; s < 2; ++s) { const bf16x8 pf = PACK8(sv, kb * 16 + 8 * s); const int ko = 32 * kb + 16 * s + 4 * hh;
                        const u32x2 a0 = *(const LAS u32x2*)(Vb + r * 72 + ko), a1 = *(const LAS u32x2*)(Vb + r * 72 + ko + 8), c0 = *(const LAS u32x2*)(Vb + (32 + r) * 72 + ko), c1 = *(const LAS u32x2*)(Vb + (32 + r) * 72 + ko + 8);
                        o0 = __builtin_amdgcn_mfma_f32_32x32x16_bf16(__builtin_bit_cast(bf16x8, (u32x4){a0.x, a0.y, a1.x, a1.y}), pf, o0, 0, 0, 0);
                        o1 = __builtin_amdgcn_mfma_f32_32x32x16_bf16(__builtin_bit_cast(bf16x8, (u32x4){c0.x, c0.y, c1.x, c1.y}), pf, o1, 0, 0, 0); }
            }
        }
        buf ^= 1;
        if (kt > kt_lo) AT_STORE(buf, 1 - FS_);
        return true;
    };
    for (int kt = kt_top; kt >= kt_lo; kt -= 2) {
        if (!trip(kt, IC<0>{})) break;
        if (kt - 1 < kt_lo) break;
        if (!trip(kt - 1, IC<1>{})) break;
    }
    if (SWA) { const float inv = 1.f / lsum;
#pragma unroll
        for (int i = 0; i < 16; ++i) { o0[i] *= inv; o1[i] *= inv; } }
    float ss = 0.f;
#pragma unroll
    for (int i = 0; i < 16; ++i) ss += o0[i] * o0[i] + o1[i] * o1[i];
    ss += other_half(ss, hh);
    const float rstd = rsqrtf(ss * (1.f / 64.f) + NORM_EPS);
    store_ot(MIX + (rowb + t) * DM + (SWA ? 0 : 512) + h * 64, o0, o1, rstd, INF(F, SWA ? I_SWA_ON : I_SB_ON) + l * 256 + h * 64, hh);
#undef AT_FETCH
#undef AT_STORE
}
__device__ __forceinline__ void rwkv_convert_small(Frame& F, int l) {
    bf16_t* W2T = (bf16_t*)(F.ws + WS_SMALLW); bf16_t* A2T = W2T + 256 * 64; bf16_t* G2T = A2T + 256 * 64;
    const float* w2 = INF(F, I_W2) + l * 64 * 256; const float* a2 = INF(F, I_A2) + l * 64 * 256; const float* g2 = INF(F, I_G2) + l * 128 * 256;
    for (int idx = F.bid * 512 + F.tid; idx < 256 * 64; idx += F.G * 512) { const int c = idx >> 6, i = idx & 63; W2T[idx] = f2bf(w2[i * 256 + c]); A2T[idx] = f2bf(a2[i * 256 + c]); }
    for (int idx = F.bid * 512 + F.tid; idx < 256 * 128; idx += F.G * 512) { const int c = idx >> 7, i = idx & 127; G2T[idx] = f2bf(g2[i * 256 + c]); }
}
__device__ __forceinline__ float tanh_f(float x) { return 1.f - 2.f * __builtin_amdgcn_rcpf(__expf(2.f * x) + 1.f); }
constexpr int LP = 72, LPG = 136;
template <int PITCH, int KS>
__device__ __forceinline__ void mm64p(f32x4 (&acc)[2], const LAS bf16_t* A, const LAS bf16_t* B, int mt, int nt0, int lane) {
    const int r16 = lane & 15, kq = lane >> 4;
#pragma unroll
    for (int s = 0; s < KS; ++s) {
        const bf16x8 a = *(const LAS bf16x8*)(A + (16 * mt + r16) * PITCH + 32 * s + 8 * kq);
#pragma unroll
        for (int j = 0; j < 2; ++j) { const bf16x8 b = *(const LAS bf16x8*)(B + (16 * (nt0 + j) + r16) * PITCH + 32 * s + 8 * kq);
            acc[j] = __builtin_amdgcn_mfma_f32_16x16x32_bf16(a, b, acc[j], 0, 0, 0); }
    }
}
__device__ __forceinline__ void mm64(f32x4 (&acc)[2], const LAS bf16_t* A, const LAS bf16_t* B, int mt, int nt0, int lane) { mm64p<LP, 2>(acc, A, B, mt, nt0, lane); }
__device__ __forceinline__ float quad_sum(float v) { v = dpp_add<0xB1>(v); v = dpp_add<0x4E>(v); return v; }
template <int CTRL> __device__ __forceinline__ float quad_bcast(float v) { return __builtin_bit_cast(float, __builtin_amdgcn_update_dpp(0, __builtin_bit_cast(int, v), CTRL, 0xf, 0xf, false)); }
__device__ __forceinline__ float oct_sum(float v) { v = dpp_add<0xB1>(v); v = dpp_add<0x4E>(v); v = dpp_add<0x141>(v); return v; }
__device__ __forceinline__ bf16_t* rw_mat(Frame& F, int unit, int q) { return (bf16_t*)(F.ws + WS_RWM) + (size_t)unit * 16384 + q * 4096; }
__device__ __forceinline__ void rw_lerp8(float (&x)[8], const bf16_t* pc, bool hasprev, const float* mu, int col) {
    const u32x4 c = *(const u32x4*)(pc + col); u32x4 p = (u32x4){0u, 0u, 0u, 0u}; if (hasprev) p = *(const u32x4*)(pc - NPROJ + col);
    const f32x4 m0 = *(const f32x4*)(mu + col), m1 = *(const f32x4*)(mu + col + 4);
    x[0] = bflo(c.x) + (bflo(p.x) - bflo(c.x)) * m0[0]; x[1] = bfhi(c.x) + (bfhi(p.x) - bfhi(c.x)) * m0[1]; x[2] = bflo(c.y) + (bflo(p.y) - bflo(c.y)) * m0[2]; x[3] = bfhi(c.y) + (bfhi(p.y) - bfhi(c.y)) * m0[3];
    x[4] = bflo(c.z) + (bflo(p.z) - bflo(c.z)) * m1[0]; x[5] = bfhi(c.z) + (bfhi(p.z) - bfhi(c.z)) * m1[1]; x[6] = bflo(c.w) + (bflo(p.w) - bflo(c.w)) * m1[2]; x[7] = bfhi(c.w) + (bfhi(p.w) - bfhi(c.w)) * m1[3];
}
struct RwRaw { u32x4 c[7], p[7]; };
__device__ __forceinline__ void rw_load_raw(Frame& F, RwRaw& raw, int unit) {
    const int n = unit & 63, h = (unit >> 6) & 3, b = unit >> 8, tokc = b * SEQ + n * 64 + (F.tid >> 3), k0 = (F.tid & 7) * 8; const bool hasprev = (tokc & (SEQ - 1)) != 0;
    const bf16_t* pc = (const bf16_t*)(F.ws + WS_PROJ) + (size_t)tokc * NPROJ + PD + k0;
    const int col[7] = {768, 832, 896, 960, h * 64, 256 + h * 64, 512 + h * 64};
#pragma unroll
    for (int g = 0; g < 7; ++g) { raw.c[g] = *(const u32x4*)(pc + col[g]); raw.p[g] = (u32x4){0u, 0u, 0u, 0u}; if (hasprev) raw.p[g] = *(const u32x4*)(pc - NPROJ + col[g]); }
}
__device__ __forceinline__ void rw_lerp8r(float (&x)[8], const u32x4 c, const u32x4 p, const LAS float* mu, int col) {
    const f32x4 m0 = *(const LAS f32x4*)(mu + col), m1 = *(const LAS f32x4*)(mu + col + 4);
    x[0] = bflo(c.x) + (bflo(p.x) - bflo(c.x)) * m0[0]; x[1] = bfhi(c.x) + (bfhi(p.x) - bfhi(c.x)) * m0[1]; x[2] = bflo(c.y) + (bflo(p.y) - bflo(c.y)) * m0[2]; x[3] = bfhi(c.y) + (bfhi(p.y) - bfhi(c.y)) * m0[3];
    x[4] = bflo(c.z) + (bflo(p.z) - bflo(c.z)) * m1[0]; x[5] = bfhi(c.z) + (bfhi(p.z) - bfhi(c.z)) * m1[1]; x[6] = bflo(c.w) + (bflo(p.w) - bflo(c.w)) * m1[2]; x[7] = bfhi(c.w) + (bfhi(p.w) - bfhi(c.w)) * m1[3];
}
__device__ __forceinline__ u32x4 pack8v(const float (&x)[8]) { u32x4 w; w.x = cvt_pk(x[0], x[1]); w.y = cvt_pk(x[2], x[3]); w.z = cvt_pk(x[4], x[5]); w.w = cvt_pk(x[6], x[7]); return w; }

constexpr int R1_TAB = 125440;
__device__ __forceinline__ void rwkv_r1_tables(Frame& F, int l) {
    LAS float* T = (LAS float*)(F.lds + R1_TAB);
    const float* mu = INF(F, I_MU) + l * 1024; const float* w0 = INF(F, I_W0) + l * 256; const float* a0 = INF(F, I_A0) + l * 256; const float* kk = INF(F, I_KK) + l * 256; const float* ka = INF(F, I_KA) + l * 256; const float* rk = INF(F, I_RK) + l * 256;
    T[F.tid] = mu[F.tid]; T[512 + F.tid] = mu[512 + F.tid];
    if (F.tid < 256) { T[1024 + F.tid] = w0[F.tid]; T[1280 + F.tid] = a0[F.tid]; T[1536 + F.tid] = kk[F.tid]; T[1792 + F.tid] = ka[F.tid]; T[2048 + F.tid] = rk[F.tid]; }
    __syncthreads();
}
__device__ __forceinline__ void rwkv_r1_unit(Frame& F, int l, int unit, int stop = 0) {
    const int n = unit & 63, h = (unit >> 6) & 3, b = unit >> 8, tok0 = b * SEQ + n * 64;
#define SLOT(i) ((LAS bf16_t*)(F.lds + (i) * 9216))
    LAS float* F0 = (LAS float*)(F.lds + 92160); LAS float* F1 = (LAS float*)(F.lds + 92160 + 16384); LAS float* GC = (LAS float*)(F.lds + 92160 + 32768);
    LAS float* F2 = (LAS float*)F.lds;
    LAS bf16_t* XG = (LAS bf16_t*)(F.lds + 55296); LAS bf16_t* WG2 = (LAS bf16_t*)(F.lds + 72704);
    const int w = F.wave, mt = w & 3, nt0 = (w >> 2) * 2, r16 = F.lane & 15, kq = F.lane >> 4;
    const int t = F.tid >> 3, k0 = (F.tid & 7) * 8;
    const LAS float* TAB = (const LAS float*)(F.lds + R1_TAB); const LAS float* mu = TAB;
    const int tokc = tok0 + t;
    float r8[8], k8[8], v8[8], lw8[8], kk8[8], b8[8];
    RwRaw raw; rw_load_raw(F, raw, unit);
    __syncthreads();
    { float x[8];
      rw_lerp8r(x, raw.c[0], raw.p[0], mu, 768 + k0);
#pragma unroll
      for (int j = 0; j < 8; ++j) x[j] = tanh_f(x[j]);
      *(LAS u32x4*)(SLOT(2) + t * LP + k0) = pack8v(x);
      rw_lerp8r(x, raw.c[1], raw.p[1], mu, 832 + k0); *(LAS u32x4*)(SLOT(3) + t * LP + k0) = pack8v(x);
#pragma unroll
      for (int hf = 0; hf < 2; ++hf) { rw_lerp8r(x, raw.c[2 + hf], raw.p[2 + hf], mu, 896 + 64 * hf + k0);
#pragma unroll
          for (int j = 0; j < 8; ++j) x[j] = sigmoid_f(x[j]);
          *(LAS u32x4*)(XG + t * LPG + 64 * hf + k0) = pack8v(x); }
      const bf16_t* W2T = (const bf16_t*)(F.ws + WS_SMALLW); const bf16_t* A2T = W2T + 256 * 64; const bf16_t* G2T = A2T + 256 * 64;
      *(LAS u32x4*)(SLOT(4) + t * LP + k0) = *(const u32x4*)(W2T + (h * 64 + t) * 64 + k0); *(LAS u32x4*)(SLOT(5) + t * LP + k0) = *(const u32x4*)(A2T + (h * 64 + t) * 64 + k0);
      *(LAS u32x4*)(WG2 + t * LPG + k0) = *(const u32x4*)(G2T + (h * 64 + t) * 128 + k0); *(LAS u32x4*)(WG2 + t * LPG + 64 + k0) = *(const u32x4*)(G2T + (h * 64 + t) * 128 + 64 + k0);
      rw_lerp8r(r8, raw.c[4], raw.p[4], mu, h * 64 + k0); rw_lerp8r(k8, raw.c[5], raw.p[5], mu, 256 + h * 64 + k0); rw_lerp8r(v8, raw.c[6], raw.p[6], mu, 512 + h * 64 + k0); }
    __syncthreads();
    if (stop == 1) return;
    { f32x4 a0[2] = {{0.f, 0.f, 0.f, 0.f}, {0.f, 0.f, 0.f, 0.f}}, a1[2] = {{0.f, 0.f, 0.f, 0.f}, {0.f, 0.f, 0.f, 0.f}}, a2[2] = {{0.f, 0.f, 0.f, 0.f}, {0.f, 0.f, 0.f, 0.f}};
      mm64(a0, SLOT(2), SLOT(4), mt, nt0, F.lane); mm64(a1, SLOT(3), SLOT(5), mt, nt0, F.lane); mm64p<LPG, 4>(a2, XG, WG2, mt, nt0, F.lane);
#pragma unroll
      for (int j = 0; j < 2; ++j)
#pragma unroll
          for (int rg = 0; rg < 4; ++rg) { const int o = (16 * mt + 4 * kq + rg) * 64 + 16 * (nt0 + j) + r16; F0[o] = a0[j][rg]; F1[o] = a1[j][rg]; F2[o] = a2[j][rg]; } }
    __syncthreads();
    if (stop == 2) return;
    { const int col = h * 64 + k0;
      const f32x4 w0a = *(const LAS f32x4*)(TAB + 1024 + col), w0b = *(const LAS f32x4*)(TAB + 1024 + col + 4), a0a = *(const LAS f32x4*)(TAB + 1280 + col), a0b = *(const LAS f32x4*)(TAB + 1280 + col + 4);
      const f32x4 kka = *(const LAS f32x4*)(TAB + 1536 + col), kkb = *(const LAS f32x4*)(TAB + 1536 + col + 4), kaa = *(const LAS f32x4*)(TAB + 1792 + col), kab = *(const LAS f32x4*)(TAB + 1792 + col + 4);
      const f32x4 rka = *(const LAS f32x4*)(TAB + 2048 + col), rkb = *(const LAS f32x4*)(TAB + 2048 + col + 4);
      const f32x4 p0a = *(const LAS f32x4*)(F0 + t * 64 + k0), p0b = *(const LAS f32x4*)(F0 + t * 64 + k0 + 4), p1a = *(const LAS f32x4*)(F1 + t * 64 + k0), p1b = *(const LAS f32x4*)(F1 + t * 64 + k0 + 4);
      const f32x4 p2a = *(const LAS f32x4*)(F2 + t * 64 + k0), p2b = *(const LAS f32x4*)(F2 + t * 64 + k0 + 4);
      float g8[8], ssq = 0.f, srkr = 0.f;
#pragma unroll
      for (int j = 0; j < 8; ++j) { const float w0 = j < 4 ? w0a[j & 3] : w0b[j & 3], a0 = j < 4 ? a0a[j & 3] : a0b[j & 3], k_k = j < 4 ? kka[j & 3] : kkb[j & 3], k_a = j < 4 ? kaa[j & 3] : kab[j & 3], r_k = j < 4 ? rka[j & 3] : rkb[j & 3];
          const float pw = j < 4 ? p0a[j & 3] : p0b[j & 3], pa = j < 4 ? p1a[j & 3] : p1b[j & 3]; g8[j] = j < 4 ? p2a[j & 3] : p2b[j & 3];
          const float a = sigmoid_f(a0 + pa); lw8[j] = bf2f(f2bf(-0.6065306597126334f * sigmoid_f(w0 + pw)));
          kk8[j] = k8[j] * k_k; const float km = k8[j] * (1.f + (a - 1.f) * k_a); b8[j] = kk8[j] * a; k8[j] = km;
          ssq += kk8[j] * kk8[j]; srkr += r8[j] * km * r_k; }
      ssq = oct_sum(ssq); srkr = oct_sum(srkr);
      const float rs = rsqrtf(ssq + 1e-12f);
#pragma unroll
      for (int j = 0; j < 8; ++j) { kk8[j] *= rs; b8[j] *= rs; }
      *(u32x4*)((bf16_t*)(F.ws + WS_RW_V) + (size_t)tokc * 256 + col) = pack8v(v8); *(u32x4*)((bf16_t*)(F.ws + WS_RW_G) + (size_t)tokc * 256 + col) = pack8v(g8);
      if ((F.tid & 7) == 0) ((float*)(F.ws + WS_RKR))[(size_t)tokc * 4 + h] = srkr; }
    __syncthreads();
    if (stop == 3) return;
#pragma unroll
    for (int j = 0; j < 8; ++j) { SLOT(0)[(k0 + j) * LP + t] = f2bf(lw8[j]); SLOT(1)[t * LP + k0 + j] = (k0 + j <= t) ? (bf16_t)0x3F80 : (bf16_t)0; }
    __syncthreads();
    { f32x4 acc[2] = {{0.f, 0.f, 0.f, 0.f}, {0.f, 0.f, 0.f, 0.f}}; mm64(acc, SLOT(1), SLOT(0), mt, nt0, F.lane);
#pragma unroll
      for (int j = 0; j < 2; ++j)
#pragma unroll
          for (int rg = 0; rg < 4; ++rg) F0[(16 * mt + 4 * kq + rg) * 64 + 16 * (nt0 + j) + r16] = acc[j][rg]; }
    __syncthreads();
    { const f32x4 c0 = *(const LAS f32x4*)(F0 + t * 64 + k0), c1 = *(const LAS f32x4*)(F0 + t * 64 + k0 + 4);
      const float cum[8] = {c0[0], c0[1], c0[2], c0[3], c1[0], c1[1], c1[2], c1[3]};
      float ka[8], bt[8], kt[8], rt[8];
#pragma unroll
      for (int j = 0; j < 8; ++j) { const float epos = __expf(cum[j]), eneg = __expf(-cum[j]), eprev = __expf(cum[j] - lw8[j]);
          ka[j] = kk8[j] * eprev; bt[j] = b8[j] * eneg; kt[j] = k8[j] * eneg; rt[j] = r8[j] * epos;
          if (t == 63) GC[k0 + j] = epos; }
      const u32x4 pka = pack8v(ka), pb = pack8v(bt), pq = pack8v(kt), prr = pack8v(rt), pv = pack8v(v8);
      *(LAS u32x4*)(SLOT(0) + t * LP + k0) = pka; *(LAS u32x4*)(SLOT(1) + t * LP + k0) = pb; *(LAS u32x4*)(SLOT(2) + t * LP + k0) = pq; *(LAS u32x4*)(SLOT(3) + t * LP + k0) = prr;
#pragma unroll
      for (int j = 0; j < 8; ++j) { SLOT(4)[(k0 + j) * LP + t] = hw(pb, j); SLOT(5)[(k0 + j) * LP + t] = hw(pq, j); SLOT(6)[(k0 + j) * LP + t] = hw(pv, j); } }
    __syncthreads();
    if (stop == 4) return;
    { f32x4 aLb[2] = {{0.f, 0.f, 0.f, 0.f}, {0.f, 0.f, 0.f, 0.f}}, aLk[2] = {{0.f, 0.f, 0.f, 0.f}, {0.f, 0.f, 0.f, 0.f}}, aMb[2] = {{0.f, 0.f, 0.f, 0.f}, {0.f, 0.f, 0.f, 0.f}}, aMk[2] = {{0.f, 0.f, 0.f, 0.f}, {0.f, 0.f, 0.f, 0.f}};
      mm64(aLb, SLOT(0), SLOT(1), mt, nt0, F.lane); mm64(aLk, SLOT(0), SLOT(2), mt, nt0, F.lane); mm64(aMb, SLOT(3), SLOT(1), mt, nt0, F.lane); mm64(aMk, SLOT(3), SLOT(2), mt, nt0, F.lane);
#pragma unroll
      for (int j = 0; j < 2; ++j)
#pragma unroll
          for (int rg = 0; rg < 4; ++rg) { const int tt = 16 * mt + 4 * kq + rg, ii = 16 * (nt0 + j) + r16;
              F0[tt * 64 + (ii & 3) * 16 + (ii >> 2)] = (ii < tt) ? aLb[j][rg] : 0.f;
              SLOT(7)[tt * LP + ii] = f2bf((ii < tt) ? aLk[j][rg] : 0.f); SLOT(8)[tt * LP + ii] = f2bf((ii <= tt) ? aMb[j][rg] : 0.f); SLOT(9)[tt * LP + ii] = f2bf((ii <= tt) ? aMk[j][rg] : 0.f); } }
    __syncthreads();
    if (stop == 5) return;
    { f32x4 acc[2] = {{0.f, 0.f, 0.f, 0.f}, {0.f, 0.f, 0.f, 0.f}}; mm64(acc, SLOT(7), SLOT(6), mt, nt0, F.lane);
#pragma unroll
      for (int j = 0; j < 2; ++j)
#pragma unroll
          for (int rg = 0; rg < 4; ++rg) F1[(16 * mt + 4 * kq + rg) * 64 + 16 * (nt0 + j) + r16] = acc[j][rg]; }
    __syncthreads();
    if (stop == 6) return;
    { const int col = F.tid >> 2, jq = F.tid & 3; float x[16], rhs[16];
#pragma unroll
      for (int m = 0; m < 16; ++m) { x[m] = 0.f; rhs[m] = (col < 64) ? bf2f(SLOT(0)[(4 * m + jq) * LP + col]) : F1[(4 * m + jq) * 64 + (col - 64)]; }
#pragma unroll
      for (int m = 0; m < 16; ++m) { float pa[4] = {0.f, 0.f, 0.f, 0.f};
#pragma unroll
          for (int a = 0; a < 4; ++a)
#pragma unroll
              for (int m4 = 0; 4 * m4 < m; ++m4) { const f32x4 lq = *(const LAS f32x4*)(F0 + (4 * m + a) * 64 + jq * 16 + 4 * m4);
#pragma unroll
                  for (int e = 0; e < 4; ++e) if (4 * m4 + e < m) pa[a] += lq[e] * x[4 * m4 + e]; }
          const float t0 = quad_sum(pa[0]), t1 = quad_sum(pa[1]), t2 = quad_sum(pa[2]), t3 = quad_sum(pa[3]);
          const LAS float* lrow = F0 + (4 * m + jq) * 64 + m;
          const float c0 = lrow[0], c1 = lrow[16], c2 = lrow[32];
          float y = rhs[m] - (jq == 0 ? t0 : (jq == 1 ? t1 : (jq == 2 ? t2 : t3)));
          y -= c0 * quad_bcast<0x00>(y); y -= c1 * quad_bcast<0x55>(y); y -= c2 * quad_bcast<0xAA>(y);
          x[m] = y; }
      LAS bf16_t* dst = (col < 64) ? (SLOT(7) + col * LP) : (SLOT(1) + (col - 64) * LP);
#pragma unroll
      for (int m = 0; m < 16; ++m) dst[4 * m + jq] = f2bf(-x[m]); }
    __syncthreads();
    if (stop == 7) return;
    { f32x4 aG[2] = {{0.f, 0.f, 0.f, 0.f}, {0.f, 0.f, 0.f, 0.f}}, aH[2] = {{0.f, 0.f, 0.f, 0.f}, {0.f, 0.f, 0.f, 0.f}}, aR[2] = {{0.f, 0.f, 0.f, 0.f}, {0.f, 0.f, 0.f, 0.f}}, aY[2] = {{0.f, 0.f, 0.f, 0.f}, {0.f, 0.f, 0.f, 0.f}};
      mm64(aG, SLOT(7), SLOT(4), mt, nt0, F.lane);
      mm64(aH, SLOT(5), SLOT(6), mt, nt0, F.lane); mm64(aH, SLOT(4), SLOT(1), mt, nt0, F.lane);
      mm64(aR, SLOT(7), SLOT(8), mt, nt0, F.lane);
      mm64(aY, SLOT(9), SLOT(6), mt, nt0, F.lane); mm64(aY, SLOT(8), SLOT(1), mt, nt0, F.lane);
      bf16_t* MG = rw_mat(F, unit, 0); bf16_t* MR = rw_mat(F, unit, 1); bf16_t* MH = rw_mat(F, unit, 2); bf16_t* MY = rw_mat(F, unit, 3);
#pragma unroll
      for (int j = 0; j < 2; ++j) { const int cc = 16 * (nt0 + j) + r16, r0 = 16 * mt + 4 * kq;
          const float gcc = GC[cc]; const u32x2 rtw = *(const LAS u32x2*)(SLOT(3) + cc * LP + r0);
          float gv[4], hv[4], rv[4], yv[4];
#pragma unroll
          for (int rg = 0; rg < 4; ++rg) { gv[rg] = gcc * ((r0 + rg == cc ? 1.f : 0.f) + aG[j][rg]); hv[rg] = GC[r0 + rg] * aH[j][rg]; yv[rg] = aY[j][rg] * 1.0f; }
          rv[0] = bflo(rtw.x) + aR[j][0]; rv[1] = bfhi(rtw.x) + aR[j][1]; rv[2] = bflo(rtw.y) + aR[j][2]; rv[3] = bfhi(rtw.y) + aR[j][3];
          u32x2 o; o.x = pg8::cvt_pk_c(gv[0], gv[1]); o.y = pg8::cvt_pk_c(gv[2], gv[3]); *(u32x2*)(MG + cc * 64 + r0) = o;
          o.x = pg8::cvt_pk_c(rv[0], rv[1]); o.y = pg8::cvt_pk_c(rv[2], rv[3]); *(u32x2*)(MR + cc * 64 + r0) = o;
          o.x = pg8::cvt_pk_c(hv[0], hv[1]); o.y = pg8::cvt_pk_c(hv[2], hv[3]); *(u32x2*)(MH + cc * 64 + r0) = o;
          o.x = pg8::cvt_pk_c(yv[0], yv[1]); o.y = pg8::cvt_pk_c(yv[2], yv[3]); *(u32x2*)(MY + cc * 64 + r0) = o; } }
#undef SLOT
}

__device__ __forceinline__ void rwkv_r2_block(Frame& F, int bh) {
    LAS bf16_t* Sx = (LAS bf16_t*)F.lds; LAS bf16_t* Gs = (LAS bf16_t*)(F.lds + 9216);
    bf16_t* SG = (bf16_t*)(F.ws + WS_RW_S);
    const int w = F.wave, mt = w & 3, nt0 = (w >> 2) * 2, r16 = F.lane & 15, kq = F.lane >> 4;
    const int grow = F.tid >> 3, gc0 = (F.tid & 7) * 8;
    f32x4 st[2] = {{0.f, 0.f, 0.f, 0.f}, {0.f, 0.f, 0.f, 0.f}};
    constexpr int PF = 4;
    u32x4 gq[PF]; u32x2 hq[PF][2];
#define R2_FETCH(slot, n_) do { const int u_ = bh * 64 + (n_); gq[slot] = *(const u32x4*)(rw_mat(F, u_, 0) + grow * 64 + gc0); \
        _Pragma("unroll") for (int j_ = 0; j_ < 2; ++j_) hq[slot][j_] = *(const u32x2*)(rw_mat(F, u_, 2) + (16 * (nt0 + j_) + r16) * 64 + 16 * mt + 4 * kq); } while (0)
#pragma unroll
    for (int i = 0; i < PF; ++i) R2_FETCH(i, i);
    __syncthreads();
    for (int n0 = 0; n0 < 64; n0 += PF) {
#pragma unroll
        for (int i = 0; i < PF; ++i) { const int n = n0 + i; const int unit = bh * 64 + n;
#pragma unroll
            for (int j = 0; j < 2; ++j) { u32x2 ps; ps.x = pg8::cvt_pk_c(st[j][0], st[j][1]); ps.y = pg8::cvt_pk_c(st[j][2], st[j][3]);
                const int vv = 16 * (nt0 + j) + r16, kk0 = 16 * mt + 4 * kq;
                *(LAS u32x2*)(Sx + vv * LP + kk0) = ps; *(u32x2*)(SG + (size_t)unit * 4096 + vv * 64 + kk0) = ps; }
            *(LAS u32x4*)(Gs + grow * LP + gc0) = gq[i];
            f32x4 acc[2];
#pragma unroll
            for (int j = 0; j < 2; ++j) { acc[j][0] = bflo(hq[i][j].x); acc[j][1] = bfhi(hq[i][j].x); acc[j][2] = bflo(hq[i][j].y); acc[j][3] = bfhi(hq[i][j].y); }
            if (n + PF < 64) R2_FETCH(i, n + PF);
            __syncthreads();
            mm64(acc, Gs, Sx, mt, nt0, F.lane);
            st[0] = acc[0]; st[1] = acc[1];
            __syncthreads();
        }
    }
#undef R2_FETCH
}

__device__ __forceinline__ void rwkv_r3_task(Frame& F, int l, int unit) {
    const int n = unit & 63, h = (unit >> 6) & 3, b = unit >> 8, tok0 = b * SEQ + n * 64;
    const int r16 = F.lane & 15, kq = F.lane >> 4;
    const bf16_t* SG = (const bf16_t*)(F.ws + WS_RW_S) + (size_t)unit * 4096;
    const bf16_t* MR = rw_mat(F, unit, 1); const bf16_t* MY = rw_mat(F, unit, 3);
    bf16x8 sb[4][2];
#pragma unroll
    for (int nt = 0; nt < 4; ++nt)
#pragma unroll
        for (int s = 0; s < 2; ++s) sb[nt][s] = *(const bf16x8*)(SG + (16 * nt + r16) * 64 + 32 * s + 8 * kq);
    const float* lnw = INF(F, I_LNW) + l * 256 + h * 64; const float* lnb = INF(F, I_LNB) + l * 256 + h * 64;
    float lw4[4], lb4[4];
#pragma unroll
    for (int nt = 0; nt < 4; ++nt) { lw4[nt] = lnw[16 * nt + r16]; lb4[nt] = lnb[16 * nt + r16]; }
    const bf16_t* SV = (const bf16_t*)(F.ws + WS_RW_V); const bf16_t* SGt = (const bf16_t*)(F.ws + WS_RW_G); const float* RKR = (const float*)(F.ws + WS_RKR);
    bf16_t* MIX = (bf16_t*)(F.ws + WS_MIX);
    LAS float* scr = (LAS float*)(F.lds + F.wave * 4352);
#pragma unroll 1
    for (int mt = 0; mt < 4; ++mt) {
        f32x4 acc[4];
#pragma unroll
        for (int nt = 0; nt < 4; ++nt) { const u32x2 y0 = *(const u32x2*)(MY + (16 * nt + r16) * 64 + 16 * mt + 4 * kq); acc[nt][0] = bflo(y0.x); acc[nt][1] = bfhi(y0.x); acc[nt][2] = bflo(y0.y); acc[nt][3] = bfhi(y0.y); }
#pragma unroll
        for (int s = 0; s < 2; ++s) { const bf16x8 a = *(const bf16x8*)(MR + (16 * mt + r16) * 64 + 32 * s + 8 * kq);
#pragma unroll
            for (int nt = 0; nt < 4; ++nt) acc[nt] = __builtin_amdgcn_mfma_f32_16x16x32_bf16(a, sb[nt][s], acc[nt], 0, 0, 0); }
#pragma unroll
        for (int rg = 0; rg < 4; ++rg) {
            const float mean = sum16((acc[0][rg] + acc[1][rg]) + (acc[2][rg] + acc[3][rg])) * (1.f / 64.f);
            float d[4], q = 0.f;
#pragma unroll
            for (int nt = 0; nt < 4; ++nt) { d[nt] = acc[nt][rg] - mean; q += d[nt] * d[nt]; }
            const float rstd = rsqrtf(sum16(q) * (1.f / 64.f) + 64e-5f);
#pragma unroll
            for (int nt = 0; nt < 4; ++nt) scr[(4 * kq + rg) * 68 + 16 * nt + r16] = d[nt] * rstd * lw4[nt] + lb4[nt]; }
        asm volatile("s_waitcnt lgkmcnt(0)" ::: "memory");
        { const int tr = F.lane >> 2, cg = F.lane & 3, tok = tok0 + 16 * mt + tr, col = h * 64 + 16 * cg;
          const float rkr = RKR[(size_t)tok * 4 + h];
          const u32x4 v0 = *(const u32x4*)(SV + (size_t)tok * 256 + col), v1 = *(const u32x4*)(SV + (size_t)tok * 256 + col + 8), g0 = *(const u32x4*)(SGt + (size_t)tok * 256 + col), g1 = *(const u32x4*)(SGt + (size_t)tok * 256 + col + 8);
          float y[16];
#pragma unroll
          for (int c4 = 0; c4 < 4; ++c4) { const f32x4 yy = *(const LAS f32x4*)(scr + tr * 68 + 16 * cg + 4 * c4); y[4 * c4] = yy[0]; y[4 * c4 + 1] = yy[1]; y[4 * c4 + 2] = yy[2]; y[4 * c4 + 3] = yy[3]; }
          float o[16];
#pragma unroll
          for (int j = 0; j < 8; ++j) { o[j] = (y[j] + rkr * bf2f(hw(v0, j))) * bf2f(hw(g0, j)); o[8 + j] = (y[8 + j] + rkr * bf2f(hw(v1, j))) * bf2f(hw(g1, j)); }
          u32x4 w0, w1; w0.x = pk2(o[0], o[1]); w0.y = pk2(o[2], o[3]); w0.z = pk2(o[4], o[5]); w0.w = pk2(o[6], o[7]); w1.x = pk2(o[8], o[9]); w1.y = pk2(o[10], o[11]); w1.z = pk2(o[12], o[13]); w1.w = pk2(o[14], o[15]);
          *(u32x4*)(MIX + (size_t)tok * DM + 768 + col) = w0; *(u32x4*)(MIX + (size_t)tok * DM + 768 + col + 8) = w1; }
        asm volatile("s_waitcnt lgkmcnt(0)" ::: "memory");
    }
}
template <int PITCH, int KS>
__device__ __forceinline__ void mm_tile(f32x4& acc, const LAS bf16_t* A, const LAS bf16_t* B, int mt, int nt, int lane) {
    const int r16 = lane & 15, kq = lane >> 4;
#pragma unroll
    for (int s = 0; s < KS; ++s)
        acc = __builtin_amdgcn_mfma_f32_16x16x32_bf16(*(const LAS bf16x8*)(A + (16 * mt + r16) * PITCH + 32 * s + 8 * kq), *(const LAS bf16x8*)(B + (16 * nt + r16) * PITCH + 32 * s + 8 * kq), acc, 0, 0, 0);
}
constexpr int GP = 40;
__device__ __forceinline__ void gla_cum(Frame& F, int l, int h, int tok0, LAS bf16_t* LAhi, LAS bf16_t* LAlo, LAS float* Fc) {
    const bf16_t* P = (const bf16_t*)(F.ws + WS_PROJ);
    const float* wa2 = INF(F, I_GLA_WA2) + l * 16 * 128 + h * 32; const float* ba = INF(F, I_GLA_BA) + l * 128 + h * 32;
    const int t = F.tid >> 3, e4 = (F.tid & 7) * 4;
    { const u32x4 l0 = *(const u32x4*)(P + (size_t)(tok0 + t) * NPROJ + PB_LR), l1 = *(const u32x4*)(P + (size_t)(tok0 + t) * NPROJ + PB_LR + 8);
      const float lr[16] = {bflo(l0.x), bfhi(l0.x), bflo(l0.y), bfhi(l0.y), bflo(l0.z), bfhi(l0.z), bflo(l0.w), bfhi(l0.w), bflo(l1.x), bfhi(l1.x), bflo(l1.y), bfhi(l1.y), bflo(l1.z), bfhi(l1.z), bflo(l1.w), bfhi(l1.w)};
      f32x4 a = *(const f32x4*)(ba + e4);
#pragma unroll
      for (int r = 0; r < 16; ++r) a += lr[r] * *(const f32x4*)(wa2 + r * 128 + e4);
#pragma unroll
      for (int j = 0; j < 4; ++j) { const float la = logsigmoid_f(a[j]) * (1.f / 16.f); const bf16_t hi = f2bf(la); const bf16_t lo = f2bf(la - bf2f(hi));
          LAhi[(e4 + j) * LP + t] = hi; LAlo[(e4 + j) * LP + t] = lo; } }
    __syncthreads();
    { const int w = F.wave, mt = w & 3, nt = w >> 2, r16 = F.lane & 15, kq = F.lane >> 4; f32x4 acc = {0.f, 0.f, 0.f, 0.f};
#pragma unroll
      for (int s = 0; s < 2; ++s) { bf16x8 tri;
#pragma unroll
          for (int j = 0; j < 8; ++j) tri[j] = (32 * s + 8 * kq + j <= 16 * mt + r16) ? (short)0x3F80 : (short)0;
          acc = __builtin_amdgcn_mfma_f32_16x16x32_bf16(tri, *(const LAS bf16x8*)(LAhi + (16 * nt + r16) * LP + 32 * s + 8 * kq), acc, 0, 0, 0);
          acc = __builtin_amdgcn_mfma_f32_16x16x32_bf16(tri, *(const LAS bf16x8*)(LAlo + (16 * nt + r16) * LP + 32 * s + 8 * kq), acc, 0, 0, 0); }
#pragma unroll
      for (int rg = 0; rg < 4; ++rg) Fc[(16 * mt + 4 * kq + rg) * 32 + 16 * nt + r16] = acc[rg]; }
    __syncthreads();
}
__device__ __forceinline__ void gla_kv2(Frame& F, int l, int unit) {
    const bf16_t* P = (const bf16_t*)(F.ws + WS_PROJ);
    float* KV = (float*)(F.ws + WS_GLA_KV) + (size_t)unit * 2048; float* DEC = (float*)(F.ws + WS_GLA_DEC) + unit * 32;
    const int n = unit & 63, h = (unit >> 6) & 3, b = unit >> 8, tok0 = b * SEQ + n * 64;
    LAS bf16_t* LAhi = (LAS bf16_t*)F.lds; LAS bf16_t* LAlo = (LAS bf16_t*)(F.lds + 4608); LAS float* Fc = (LAS float*)(F.lds + 9216);
    LAS bf16_t* Ke = (LAS bf16_t*)(F.lds + 17408); LAS bf16_t* Vf = (LAS bf16_t*)(F.lds + 22016);
    const int t = F.tid >> 3, c8 = F.tid & 7;
    __syncthreads();
    gla_cum(F, l, h, tok0, LAhi, LAlo, Fc);
    { const u32x2 kw = *(const u32x2*)(P + (size_t)(tok0 + t) * NPROJ + PB_K + h * 32 + c8 * 4); const u32x4 vw = *(const u32x4*)(P + (size_t)(tok0 + t) * NPROJ + PB_V + h * 64 + c8 * 8);
      const f32x4 ct = *(const LAS f32x4*)(Fc + t * 32 + c8 * 4), cl = *(const LAS f32x4*)(Fc + 63 * 32 + c8 * 4);
      const float kf[4] = {bflo(kw.x), bfhi(kw.x), bflo(kw.y), bfhi(kw.y)};
#pragma unroll
      for (int j = 0; j < 4; ++j) { Ke[(c8 * 4 + j) * LP + t] = f2bf(kf[j] * __expf(cl[j] - ct[j])); if (t == 63) DEC[c8 * 4 + j] = __expf(cl[j]); }
#pragma unroll
      for (int j = 0; j < 8; ++j) Vf[(c8 * 8 + j) * LP + t] = hw(vw, j); }
    __syncthreads();
    { const int w = F.wave, mt = w & 1, nt = w >> 1, r16 = F.lane & 15, kq = F.lane >> 4; f32x4 acc = {0.f, 0.f, 0.f, 0.f};
      mm_tile<LP, 2>(acc, Ke, Vf, mt, nt, F.lane);
#pragma unroll
      for (int rg = 0; rg < 4; ++rg) KV[(16 * mt + 4 * kq + rg) * 64 + 16 * nt + r16] = acc[rg]; }
}
__device__ __forceinline__ void gla_out2(Frame& F, int l, int unit) {
    const bf16_t* P = (const bf16_t*)(F.ws + WS_PROJ); bf16_t* MIX = (bf16_t*)(F.ws + WS_MIX);
    const float* SP = (const float*)(F.ws + WS_GLA_KV) + (size_t)unit * 2048;
    const int n = unit & 63, h = (unit >> 6) & 3, b = unit >> 8, tok0 = b * SEQ + n * 64;
    LAS bf16_t* LAhi = (LAS bf16_t*)F.lds; LAS bf16_t* LAlo = (LAS bf16_t*)(F.lds + 4608); LAS float* Fc = (LAS float*)(F.lds + 9216);
    LAS bf16_t* Qe = (LAS bf16_t*)(F.lds + 17408); LAS bf16_t* Ke = (LAS bf16_t*)(F.lds + 22528); LAS bf16_t* Qb = (LAS bf16_t*)(F.lds + 27648); LAS bf16_t* Sf = (LAS bf16_t*)(F.lds + 32768);
    LAS bf16_t* Vf = (LAS bf16_t*)(F.lds + 37888); LAS bf16_t* At = (LAS bf16_t*)(F.lds + 47104); LAS float* Of = (LAS float*)(F.lds + 56320);
    const int t = F.tid >> 3, c8 = F.tid & 7, w = F.wave, mt = w & 3, nt0 = (w >> 2) * 2, r16 = F.lane & 15, kq = F.lane >> 4;
    __syncthreads();
    gla_cum(F, l, h, tok0, LAhi, LAlo, Fc);
    { const u32x2 qw = *(const u32x2*)(P + (size_t)(tok0 + t) * NPROJ + PB_Q + h * 32 + c8 * 4), kw = *(const u32x2*)(P + (size_t)(tok0 + t) * NPROJ + PB_K + h * 32 + c8 * 4);
      const u32x4 vw = *(const u32x4*)(P + (size_t)(tok0 + t) * NPROJ + PB_V + h * 64 + c8 * 8);
      const f32x4 ct = *(const LAS f32x4*)(Fc + t * 32 + c8 * 4), cr = *(const LAS f32x4*)(Fc + 31 * 32 + c8 * 4);
      const float qs = 0.17677669529663687f;
      const float qf[4] = {bflo(qw.x) * qs, bfhi(qw.x) * qs, bflo(qw.y) * qs, bfhi(qw.y) * qs}, kf[4] = {bflo(kw.x), bfhi(kw.x), bflo(kw.y), bfhi(kw.y)};
      float qe[4], ke[4], qb[4];
#pragma unroll
      for (int j = 0; j < 4; ++j) { qe[j] = qf[j] * __expf(ct[j] - cr[j]); ke[j] = kf[j] * __expf(cr[j] - ct[j]); qb[j] = qf[j] * __expf(ct[j]); }
      u32x2 o; o.x = cvt_pk(qe[0], qe[1]); o.y = cvt_pk(qe[2], qe[3]); *(LAS u32x2*)(Qe + t * GP + c8 * 4) = o;
      o.x = cvt_pk(ke[0], ke[1]); o.y = cvt_pk(ke[2], ke[3]); *(LAS u32x2*)(Ke + t * GP + c8 * 4) = o;
      o.x = cvt_pk(qb[0], qb[1]); o.y = cvt_pk(qb[2], qb[3]); *(LAS u32x2*)(Qb + t * GP + c8 * 4) = o;
#pragma unroll
      for (int j = 0; j < 8; ++j) Vf[(c8 * 8 + j) * LP + t] = hw(vw, j);
      const int e = F.tid >> 4, f4 = (F.tid & 15) * 4; const f32x4 sv = *(const f32x4*)(SP + e * 64 + f4);
#pragma unroll
      for (int j = 0; j < 4; ++j) Sf[(f4 + j) * GP + e] = f2bf(sv[j]); }
    __syncthreads();
    { f32x4 acc[2] = {{0.f, 0.f, 0.f, 0.f}, {0.f, 0.f, 0.f, 0.f}}; mm64p<GP, 1>(acc, Qe, Ke, mt, nt0, F.lane);
#pragma unroll
      for (int j = 0; j < 2; ++j)
#pragma unroll
          for (int rg = 0; rg < 4; ++rg) { const int tt = 16 * mt + 4 * kq + rg, ss = 16 * (nt0 + j) + r16; At[tt * LP + ss] = f2bf(ss <= tt ? acc[j][rg] : 0.f); } }
    __syncthreads();
    { f32x4 acc[2] = {{0.f, 0.f, 0.f, 0.f}, {0.f, 0.f, 0.f, 0.f}}; mm64p<LP, 2>(acc, At, Vf, mt, nt0, F.lane); mm64p<GP, 1>(acc, Qb, Sf, mt, nt0, F.lane);
#pragma unroll
      for (int j = 0; j < 2; ++j)
#pragma unroll
          for (int rg = 0; rg < 4; ++rg) Of[(16 * mt + 4 * kq + rg) * 64 + 16 * (nt0 + j) + r16] = acc[j][rg]; }
    __syncthreads();
    { const int f0 = c8 * 8; const f32x4 o0 = *(const LAS f32x4*)(Of + t * 64 + f0), o1 = *(const LAS f32x4*)(Of + t * 64 + f0 + 4);
      const float o[8] = {o0[0], o0[1], o0[2], o0[3], o1[0], o1[1], o1[2], o1[3]};
      float ss = 0.f;
#pragma unroll
      for (int j = 0; j < 8; ++j) ss += o[j] * o[j];
      ss = oct_sum(ss);
      const float rstd = rsqrtf(ss * (1.f / 64.f) + NORM_EPS); const float* gn = INF(F, I_GLA_ON) + l * 256 + h * 64 + f0;
      const f32x4 g0 = *(const f32x4*)gn, g1 = *(const f32x4*)(gn + 4);
      const u32x4 gw = *(const u32x4*)(P + (size_t)(tok0 + t) * NPROJ + PB_G + h * 64 + f0);
      const float gb[8] = {bflo(gw.x), bfhi(gw.x), bflo(gw.y), bfhi(gw.y), bflo(gw.z), bfhi(gw.z), bflo(gw.w), bfhi(gw.w)};
      float r[8];
#pragma unroll
      for (int j = 0; j < 8; ++j) r[j] = o[j] * rstd * (j < 4 ? g0[j & 3] : g1[j & 3]) * (gb[j] * sigmoid_f(gb[j]));
      *(u32x4*)(MIX + (size_t)(tok0 + t) * DM + 256 + h * 64 + f0) = pack8v(r); }
}

__device__ __forceinline__ void gla_cum_a(Frame& F, int l, int h, int tok0, LAS bf16_t* LAhi, LAS bf16_t* LAlo) {
    const bf16_t* P = (const bf16_t*)(F.ws + WS_PROJ);
    const float* wa2 = INF(F, I_GLA_WA2) + l * 16 * 128 + h * 32; const float* ba = INF(F, I_GLA_BA) + l * 128 + h * 32;
    const int t = F.tid >> 3, e4 = (F.tid & 7) * 4;
    const u32x4 l0 = *(const u32x4*)(P + (size_t)(tok0 + t) * NPROJ + PB_LR), l1 = *(const u32x4*)(P + (size_t)(tok0 + t) * NPROJ + PB_LR + 8);
    const float lr[16] = {bflo(l0.x), bfhi(l0.x), bflo(l0.y), bfhi(l0.y), bflo(l0.z), bfhi(l0.z), bflo(l0.w), bfhi(l0.w), bflo(l1.x), bfhi(l1.x), bflo(l1.y), bfhi(l1.y), bflo(l1.z), bfhi(l1.z), bflo(l1.w), bfhi(l1.w)};
    f32x4 a = *(const f32x4*)(ba + e4);
#pragma unroll
    for (int r = 0; r < 16; ++r) a += lr[r] * *(const f32x4*)(wa2 + r * 128 + e4);
#pragma unroll
    for (int j = 0; j < 4; ++j) { const float la = logsigmoid_f(a[j]) * (1.f / 16.f); const bf16_t hi = f2bf(la); const bf16_t lo = f2bf(la - bf2f(hi));
        LAhi[(e4 + j) * LP + t] = hi; LAlo[(e4 + j) * LP + t] = lo; }
}
struct GlaW2 { bf16x8 whi, wlo; float ba; };
__device__ __forceinline__ void gla_loadw2(Frame& F, int l, int h, GlaW2& W) {
    const int nt = F.wave >> 2, r16 = F.lane & 15, kq = F.lane >> 4, e = 16 * nt + r16;
    const float* wa2 = INF(F, I_GLA_WA2) + l * 16 * 128 + h * 32 + e;
    W.ba = INF(F, I_GLA_BA)[l * 128 + h * 32 + e];
#pragma unroll
    for (int j = 0; j < 8; ++j) { const float wv = (kq < 2) ? wa2[(8 * (kq & 1) + j) * 128] : 0.f; const bf16_t hi = f2bf(wv); W.whi[j] = (short)hi; W.wlo[j] = (short)f2bf(wv - bf2f(hi)); }
}
__device__ __forceinline__ void gla_cum_a2(Frame& F, const GlaW2& W, int tok0, LAS bf16_t* LAhi, LAS bf16_t* LAlo) {
    const bf16_t* P = (const bf16_t*)(F.ws + WS_PROJ);
    const int mt = F.wave & 3, nt = F.wave >> 2, r16 = F.lane & 15, kq = F.lane >> 4;
    u32x4 lw = *(const u32x4*)(P + (size_t)(tok0 + 16 * mt + r16) * NPROJ + PB_LR + 8 * (kq & 1));
    if (kq >= 2) lw = (u32x4){0u, 0u, 0u, 0u};
    f32x4 acc = {0.f, 0.f, 0.f, 0.f};
    acc = __builtin_amdgcn_mfma_f32_16x16x32_bf16(__builtin_bit_cast(bf16x8, lw), W.whi, acc, 0, 0, 0);
    acc = __builtin_amdgcn_mfma_f32_16x16x32_bf16(__builtin_bit_cast(bf16x8, lw), W.wlo, acc, 0, 0, 0);
    float la[4]; bf16_t hi[4], lo[4];
#pragma unroll
    for (int rg = 0; rg < 4; ++rg) { la[rg] = logsigmoid_f(acc[rg] + W.ba) * (1.f / 16.f); hi[rg] = f2bf(la[rg]); lo[rg] = f2bf(la[rg] - bf2f(hi[rg])); }
    const int o = (16 * nt + r16) * LP + 16 * mt + 4 * kq;
    *(LAS u32x2*)(LAhi + o) = (u32x2){(unsigned)hi[0] | ((unsigned)hi[1] << 16), (unsigned)hi[2] | ((unsigned)hi[3] << 16)};
    *(LAS u32x2*)(LAlo + o) = (u32x2){(unsigned)lo[0] | ((unsigned)lo[1] << 16), (unsigned)lo[2] | ((unsigned)lo[3] << 16)};
}
__device__ __forceinline__ void gla_cum_b(Frame& F, const LAS bf16_t* LAhi, const LAS bf16_t* LAlo, LAS float* Fc) {
    const int w = F.wave, mt = w & 3, nt = w >> 2, r16 = F.lane & 15, kq = F.lane >> 4; f32x4 acc = {0.f, 0.f, 0.f, 0.f};
#pragma unroll
    for (int s = 0; s < 2; ++s) { bf16x8 tri;
#pragma unroll
        for (int j = 0; j < 8; ++j) tri[j] = (32 * s + 8 * kq + j <= 16 * mt + r16) ? (short)0x3F80 : (short)0;
        acc = __builtin_amdgcn_mfma_f32_16x16x32_bf16(tri, *(const LAS bf16x8*)(LAhi + (16 * nt + r16) * LP + 32 * s + 8 * kq), acc, 0, 0, 0);
        acc = __builtin_amdgcn_mfma_f32_16x16x32_bf16(tri, *(const LAS bf16x8*)(LAlo + (16 * nt + r16) * LP + 32 * s + 8 * kq), acc, 0, 0, 0); }
#pragma unroll
    for (int rg = 0; rg < 4; ++rg) Fc[(16 * mt + 4 * kq + rg) * 32 + 16 * nt + r16] = acc[rg];
}
constexpr int GKV_U = 31232, GOUT_U = 56320;
__device__ __forceinline__ void gla_kv2_pair(Frame& F, int l, int unit0, const GlaW2& W) {
    const bf16_t* P = (const bf16_t*)(F.ws + WS_PROJ);
    const int n = unit0 & 63, h = (unit0 >> 6) & 3, t = F.tid >> 3, c8 = F.tid & 7;
#define GKV_PTRS(uu) const int unit = unit0 + 256 * (uu), tok0 = (unit >> 8) * SEQ + n * 64; LAS unsigned char* B_ = F.lds + (uu) * GKV_U; \
        LAS bf16_t* LAhi = (LAS bf16_t*)B_; LAS bf16_t* LAlo = (LAS bf16_t*)(B_ + 4608); LAS float* Fc = (LAS float*)(B_ + 9216); LAS bf16_t* Ke = (LAS bf16_t*)(B_ + 17408); LAS bf16_t* Vf = (LAS bf16_t*)(B_ + 22016); \
        (void)unit; (void)tok0; (void)LAhi; (void)LAlo; (void)Fc; (void)Ke; (void)Vf
    __syncthreads();
#pragma unroll
    for (int uu = 0; uu < 2; ++uu) { GKV_PTRS(uu); gla_cum_a2(F, W, tok0, LAhi, LAlo); }
    __syncthreads();
#pragma unroll
    for (int uu = 0; uu < 2; ++uu) { GKV_PTRS(uu); gla_cum_b(F, LAhi, LAlo, Fc); }
    __syncthreads();
#pragma unroll
    for (int uu = 0; uu < 2; ++uu) { GKV_PTRS(uu); float* DEC = (float*)(F.ws + WS_GLA_DEC) + unit * 32;
      const u32x2 kw = *(const u32x2*)(P + (size_t)(tok0 + t) * NPROJ + PB_K + h * 32 + c8 * 4); const u32x4 vw = *(const u32x4*)(P + (size_t)(tok0 + t) * NPROJ + PB_V + h * 64 + c8 * 8);
      const f32x4 ct = *(const LAS f32x4*)(Fc + t * 32 + c8 * 4), cl = *(const LAS f32x4*)(Fc + 63 * 32 + c8 * 4);
      const float kf[4] = {bflo(kw.x), bfhi(kw.x), bflo(kw.y), bfhi(kw.y)};
#pragma unroll
      for (int j = 0; j < 4; ++j) { Ke[(c8 * 4 + j) * LP + t] = f2bf(kf[j] * __expf(cl[j] - ct[j])); if (t == 63) DEC[c8 * 4 + j] = __expf(cl[j]); }
#pragma unroll
      for (int j = 0; j < 8; ++j) Vf[(c8 * 8 + j) * LP + t] = hw(vw, j); }
    __syncthreads();
#pragma unroll
    for (int uu = 0; uu < 2; ++uu) { GKV_PTRS(uu); float* KV = (float*)(F.ws + WS_GLA_KV) + (size_t)unit * 2048;
      const int w = F.wave, mt = w & 1, nt = w >> 1, r16 = F.lane & 15, kq = F.lane >> 4; f32x4 acc = {0.f, 0.f, 0.f, 0.f};
      mm_tile<LP, 2>(acc, Ke, Vf, mt, nt, F.lane);
#pragma unroll
      for (int rg = 0; rg < 4; ++rg) KV[(16 * mt + 4 * kq + rg) * 64 + 16 * nt + r16] = acc[rg]; }
#undef GKV_PTRS
}
__device__ __forceinline__ void gla_out2_pair(Frame& F, int l, int unit0, const GlaW2& W, int stop = 0) {
    const bf16_t* P = (const bf16_t*)(F.ws + WS_PROJ); bf16_t* MIX = (bf16_t*)(F.ws + WS_MIX);
    const int n = unit0 & 63, h = (unit0 >> 6) & 3;
    const int t = F.tid >> 3, c8 = F.tid & 7, w = F.wave, mt = w & 3, nt0 = (w >> 2) * 2, r16 = F.lane & 15, kq = F.lane >> 4;
#define GOUT_PTRS(uu) const int unit = unit0 + 256 * (uu), tok0 = (unit >> 8) * SEQ + n * 64; LAS unsigned char* B_ = F.lds + (uu) * GOUT_U; \
        LAS bf16_t* LAhi = (LAS bf16_t*)B_; LAS bf16_t* LAlo = (LAS bf16_t*)(B_ + 4608); LAS float* Fc = (LAS float*)(B_ + 9216); LAS float* Of = (LAS float*)B_; \
        LAS bf16_t* Qe = (LAS bf16_t*)(B_ + 17408); LAS bf16_t* Ke = (LAS bf16_t*)(B_ + 22528); LAS bf16_t* Qb = (LAS bf16_t*)(B_ + 27648); LAS bf16_t* Sf = (LAS bf16_t*)(B_ + 32768); \
        LAS bf16_t* Vf = (LAS bf16_t*)(B_ + 37888); LAS bf16_t* At = (LAS bf16_t*)(B_ + 47104); \
        (void)unit; (void)tok0; (void)LAhi; (void)LAlo; (void)Fc; (void)Of; (void)Qe; (void)Ke; (void)Qb; (void)Sf; (void)Vf; (void)At
    __syncthreads();
#pragma unroll
    for (int uu = 0; uu < 2; ++uu) { GOUT_PTRS(uu); gla_cum_a2(F, W, tok0, LAhi, LAlo); }
    __syncthreads();
    if (stop == 1) return;
#pragma unroll
    for (int uu = 0; uu < 2; ++uu) { GOUT_PTRS(uu); gla_cum_b(F, LAhi, LAlo, Fc); }
    __syncthreads();
    if (stop == 2) return;
#pragma unroll
    for (int uu = 0; uu < 2; ++uu) { GOUT_PTRS(uu); const float* SP = (const float*)(F.ws + WS_GLA_KV) + (size_t)unit * 2048;
      const u32x2 qw = *(const u32x2*)(P + (size_t)(tok0 + t) * NPROJ + PB_Q + h * 32 + c8 * 4), kw = *(const u32x2*)(P + (size_t)(tok0 + t) * NPROJ + PB_K + h * 32 + c8 * 4);
      const u32x4 vw = *(const u32x4*)(P + (size_t)(tok0 + t) * NPROJ + PB_V + h * 64 + c8 * 8);
      const f32x4 ct = *(const LAS f32x4*)(Fc + t * 32 + c8 * 4), cr = *(const LAS f32x4*)(Fc + 31 * 32 + c8 * 4);
      const float qs = 0.17677669529663687f;
      const float qf[4] = {bflo(qw.x) * qs, bfhi(qw.x) * qs, bflo(qw.y) * qs, bfhi(qw.y) * qs}, kf[4] = {bflo(kw.x), bfhi(kw.x), bflo(kw.y), bfhi(kw.y)};
      float qe[4], ke[4], qb[4];
#pragma unroll
      for (int j = 0; j < 4; ++j) { qe[j] = qf[j] * __expf(ct[j] - cr[j]); ke[j] = kf[j] * __expf(cr[j] - ct[j]); qb[j] = qf[j] * __expf(ct[j]); }
      u32x2 o; o.x = cvt_pk(qe[0], qe[1]); o.y = cvt_pk(qe[2], qe[3]); *(LAS u32x2*)(Qe + t * GP + c8 * 4) = o;
      o.x = cvt_pk(ke[0], ke[1]); o.y = cvt_pk(ke[2], ke[3]); *(LAS u32x2*)(Ke + t * GP + c8 * 4) = o;
      o.x = cvt_pk(qb[0], qb[1]); o.y = cvt_pk(qb[2], qb[3]); *(LAS u32x2*)(Qb + t * GP + c8 * 4) = o;
#pragma unroll
      for (int j = 0; j < 8; ++j) Vf[(c8 * 8 + j) * LP + t] = hw(vw, j);
      const int e = F.tid >> 4, f4 = (F.tid & 15) * 4; const f32x4 sv = *(const f32x4*)(SP + e * 64 + f4);
#pragma unroll
      for (int j = 0; j < 4; ++j) Sf[(f4 + j) * GP + e] = f2bf(sv[j]); }
    __syncthreads();
    if (stop == 3) return;
#pragma unroll
    for (int uu = 0; uu < 2; ++uu) { GOUT_PTRS(uu); f32x4 acc[2] = {{0.f, 0.f, 0.f, 0.f}, {0.f, 0.f, 0.f, 0.f}}; mm64p<GP, 1>(acc, Qe, Ke, mt, nt0, F.lane);
#pragma unroll
      for (int j = 0; j < 2; ++j)
#pragma unroll
          for (int rg = 0; rg < 4; ++rg) { const int tt = 16 * mt + 4 * kq + rg, ss = 16 * (nt0 + j) + r16; At[tt * LP + ss] = f2bf(ss <= tt ? acc[j][rg] : 0.f); } }
    __syncthreads();
    if (stop == 4) return;
#pragma unroll
    for (int uu = 0; uu < 2; ++uu) { GOUT_PTRS(uu); f32x4 acc[2] = {{0.f, 0.f, 0.f, 0.f}, {0.f, 0.f, 0.f, 0.f}}; mm64p<LP, 2>(acc, At, Vf, mt, nt0, F.lane); mm64p<GP, 1>(acc, Qb, Sf, mt, nt0, F.lane);
#pragma unroll
      for (int j = 0; j < 2; ++j)
#pragma unroll
          for (int rg = 0; rg < 4; ++rg) Of[(16 * mt + 4 * kq + rg) * 64 + 16 * (nt0 + j) + r16] = acc[j][rg]; }
    __syncthreads();
    if (stop == 5) return;
#pragma unroll
    for (int uu = 0; uu < 2; ++uu) { GOUT_PTRS(uu); const int f0 = c8 * 8; const f32x4 o0 = *(const LAS f32x4*)(Of + t * 64 + f0), o1 = *(const LAS f32x4*)(Of + t * 64 + f0 + 4);
      const float o[8] = {o0[0], o0[1], o0[2], o0[3], o1[0], o1[1], o1[2], o1[3]};
      float ss = 0.f;
#pragma unroll
      for (int j = 0; j < 8; ++j) ss += o[j] * o[j];
      ss = oct_sum(ss);
      const float rstd = rsqrtf(ss * (1.f / 64.f) + NORM_EPS); const float* gn = INF(F, I_GLA_ON) + l * 256 + h * 64 + f0;
      const f32x4 g0 = *(const f32x4*)gn, g1 = *(const f32x4*)(gn + 4);
      const u32x4 gw = *(const u32x4*)(P + (size_t)(tok0 + t) * NPROJ + PB_G + h * 64 + f0);
      const float gb[8] = {bflo(gw.x), bfhi(gw.x), bflo(gw.y), bfhi(gw.y), bflo(gw.z), bfhi(gw.z), bflo(gw.w), bfhi(gw.w)};
      float r[8];
#pragma unroll
      for (int j = 0; j < 8; ++j) r[j] = o[j] * rstd * (j < 4 ? g0[j & 3] : g1[j & 3]) * (gb[j] * sigmoid_f(gb[j]));
      *(u32x4*)(MIX + (size_t)(tok0 + t) * DM + 256 + h * 64 + f0) = pack8v(r); }
#undef GOUT_PTRS
}
struct Args { const void* in[N_IN]; float* out; unsigned char* ws; int ph_lo, ph_hi, sub, pad; };
constexpr int PH_PER_LAYER = 10, PH_FINAL = DEPTH * PH_PER_LAYER, PH_END = PH_FINAL + 2;
#ifndef EN_MASK
#define EN_MASK 0xFFFF
#endif
#define EN(b) ((EN_MASK >> (b)) & 1)
#ifndef DUP_MASK
#define DUP_MASK 0
#endif
#define NREP(b) (1 + ((DUP_MASK >> (b)) & 1))
enum Phase { P_PREP = 0, P_INPROJ, P_MIX1, P_MIX2, P_MIX3, P_OUTPROJ, P_NORM2, P_MAP, P_UP, P_DOWN };

__global__ void __launch_bounds__(512, 2) fwd_kernel(Args args) {
    extern __shared__ __attribute__((aligned(16))) unsigned char lds_raw[];
    Frame F;
    F.lds = (LAS unsigned char*)lds_raw;
    F.tid = threadIdx.x; F.lane = F.tid & 63; F.wave = __builtin_amdgcn_readfirstlane(F.tid >> 6);
    F.bid = blockIdx.x; F.G = gridDim.x;
    F.ws = args.ws; F.ctl = (unsigned*)(args.ws + WS_CTL); F.out = args.out;
    if (F.tid < N_IN) ((LAS unsigned long long*)(F.lds + PTR_OFF))[F.tid] = (unsigned long long)args.in[F.tid];
    volatile LAS unsigned* MISC = (volatile LAS unsigned*)(F.lds + MISC_OFF);
    if (F.tid < 8) MISC[F.tid] = 0u;
    __syncthreads();
    const int lo = args.ph_lo, hi = args.ph_hi, sub = args.sub;
    const int wave_sgpr = F.wave;
    XcdBarrier bar; bar.bar = F.ctl + CW_BAR; bar.x = 0; bar.st = MISC;
    if (hi - lo > 1) bar = xcd_barrier_post(F.ctl + CW_BAR, MISC);
#define HB ((bf16_t*)(F.ws + WS_H))
#define PROJ ((bf16_t*)(F.ws + WS_PROJ))
#define MIXB ((bf16_t*)(F.ws + WS_MIX))
#define ACT ((bf16_t*)(F.ws + WS_PROJ))
#define XBUF ((bf16_t*)((unsigned char*)F.out + XB_OFF))
#define IN(k) (lo <= (k) && (k) < hi)
#define PH_BEGIN() do { int w_i = wave_sgpr; asm volatile("" : "+s"(w_i)); unsigned m_i = ~0u; asm volatile("" : "+s"(m_i)); int l_i = (int)__builtin_amdgcn_mbcnt_hi(m_i, __builtin_amdgcn_mbcnt_lo(m_i, 0u)); asm volatile("" : "+v"(l_i)); F.wave = w_i; F.lane = l_i; F.tid = w_i * 64 + l_i; \
        GAS unsigned char* w_ = (GAS unsigned char*)args.ws; asm volatile("" : "+s"(w_)); F.ws = (unsigned char*)w_; F.ctl = (unsigned*)((unsigned char*)w_ + WS_CTL); F.out = (float*)(GAS float*)args.out; F.lds = (LAS unsigned char*)lds_raw; } while (0)
#define SEAM(k) do { if ((k) + 1 < hi) { GAS unsigned* bp_ = (GAS unsigned*)(F.ctl + CW_BAR); asm volatile("" : "+s"(bp_)); bar.bar = (unsigned*)bp_; unsigned bx_ = bar.x; asm volatile("" : "+s"(bx_)); bar.x = bx_; int w_j = wave_sgpr; asm volatile("" : "+s"(w_j)); unsigned m_j = ~0u; asm volatile("" : "+s"(m_j)); const int l_j = (int)__builtin_amdgcn_mbcnt_hi(m_j, __builtin_amdgcn_mbcnt_lo(m_j, 0u)); xcd_barrier(bar, w_j == 0 && l_j == 0); } } while (0)

    if (EN(0) && IN(0)) { PH_BEGIN(); phase_rope_tables(F); }
    { constexpr int l = 0;
        const int pb = l * PH_PER_LAYER; const bool moe = (l & 1) != 0; const int ms = l >> 1;

        if (EN(0) && IN(pb + P_PREP)) { PH_BEGIN();
            if (sub & 1) { phase_convert_weights(F, l); rwkv_convert_small(F, l); }
            __syncthreads();
            if (sub & 2) { if (l == 0) phase_norm_lr<true, false>(F, INF(F, I_X), INF(F, I_ATTN_NORM) + l * DM, l); else if (((l - 1) & 1) != 0) phase_norm_lr<false, true>(F, XBUF, INF(F, I_ATTN_NORM) + l * DM, l); else phase_norm_lr<false, false>(F, XBUF, INF(F, I_ATTN_NORM) + l * DM, l); }
            SEAM(pb + P_PREP);
        }
        if (EN(1) && IN(pb + P_INPROJ)) { PH_BEGIN();
            pg8::Gemm g{HB, (const bf16_t*)(F.ws + WS_WIN), DM, nullptr}; pg8::StaticOrder S; S.init(NTOK, 3072, F.G, F.bid);
            pg8::EpiBf16 E{PROJ, NPROJ};
            pg8::gemm_phase<pg8::EpiBf16, pg8::StaticOrder, false>(F.tid, F.lds, g, S, E);
            SEAM(pb + P_INPROJ);
        }
        if (EN(2) && IN(pb + P_MIX1)) { PH_BEGIN();
            if (sub & 1) { rwkv_r1_tables(F, l); for (int unit = F.bid; unit < 2048; unit += F.G) rwkv_r1_unit(F, l, unit, (sub >> 8) & 15); }
            if (sub & 2) { GlaW2 gw; gla_loadw2(F, l, (F.bid >> 6) & 3, gw); for (int unit = F.bid; unit < 2048; unit += 2 * F.G) gla_kv2_pair(F, l, unit, gw); }
            SEAM(pb + P_MIX1);
        }
        if (EN(3) && IN(pb + P_MIX2)) { PH_BEGIN();
            if (F.bid < 32) { if (sub & 1) rwkv_r2_block(F, F.bid); }
            else { const int ob = F.bid - 32, NO = F.G - 32;
                if (sub & 2) for (int gt = ob * 512 + F.tid; gt < 65536; gt += NO * 512) gla_scan(F, gt); }
            if (sub & 12) {
                volatile LAS int* qw = (volatile LAS int*)(F.lds + MISC_OFF + 28);
                unsigned* qctr = F.ctl + CW_ATTNQ + 64 * l + ((sub >> 4) & 1) * 32;
                int nxt = 0;
                if (F.tid == 0) nxt = (int)atomicAdd(qctr, 1u);
                for (;;) {
                    __syncthreads();
                    if (F.tid == 0) *qw = nxt;
                    __syncthreads();
                    const int task = *qw;
                    if (task >= 1024) break;
                    if (F.tid == 0) nxt = (int)atomicAdd(qctr, 1u);
                    if (task < 512) { if (sub & 4) attn_block<false>(F, l, task); } else if (sub & 8) attn_block<true>(F, l, task - 512);
                }
            }
            SEAM(pb + P_MIX2);
        }
        if (EN(4) && IN(pb + P_MIX3)) { PH_BEGIN();
            if (sub & 1) { GlaW2 gw; gla_loadw2(F, l, (F.bid >> 6) & 3, gw); for (int unit = F.bid; unit < 2048; unit += 2 * F.G) gla_out2_pair(F, l, unit, gw, (sub >> 8) & 15); }
            __syncthreads();
            if (sub & 2) for (int unit = F.bid * 8 + F.wave; unit < 2048; unit += F.G * 8) rwkv_r3_task(F, l, unit);
            SEAM(pb + P_MIX3);
        }
        if (EN(5) && IN(pb + P_OUTPROJ)) { PH_BEGIN();
            __syncthreads();
            pg8::Gemm g{MIXB, (const bf16_t*)(F.ws + WS_WOUT), DM, nullptr}; pg8::StaticOrder S; S.init(NTOK, DM, F.G, F.bid);
            if (l == 0) { pg8::EpiResidB<true> E{INF(F, I_X), XBUF, DM}; pg8::gemm_phase<pg8::EpiResidB<true>, pg8::StaticOrder, false>(F.tid, F.lds, g, S, E); }
            else { pg8::EpiResidB<false> E{XBUF, XBUF, DM}; pg8::gemm_phase<pg8::EpiResidB<false>, pg8::StaticOrder, false>(F.tid, F.lds, g, S, E); }
            SEAM(pb + P_OUTPROJ);
        }
        if (EN(6) && IN(pb + P_NORM2)) { PH_BEGIN();
            if (moe) phase_norm<1, false>(F, XBUF, INF(F, I_FFN_NORM) + l * DM, false, ms);
            else phase_norm<0, false>(F, XBUF, INF(F, I_FFN_NORM) + l * DM, false, 0);
            SEAM(pb + P_NORM2);
        }
        if (EN(7) && IN(pb + P_MAP)) { PH_BEGIN();
            if (moe) { phase_moe_map(F, ms); SEAM(pb + P_MAP); }
        }
        if (EN(8) && IN(pb + P_UP)) { PH_BEGIN();
            __syncthreads();
            if (!moe) {
                pg8::Gemm g{HB, (const bf16_t*)(F.ws + WS_W13), DM / 2, nullptr}; pg8::StaticOrder S; S.init(NTOK, 2 * D_FF, F.G, F.bid);
                pg8::EpiSwiglu8 E{(unsigned char*)ACT, D_FF, 0.015625f};
                pg8::gemm_phase<pg8::EpiSwiglu8, pg8::StaticOrder, false, true>(F.tid, F.lds, g, S, E);
            } else {
                pg8::MoeOrder S; moe_bases(F.ctl + CW_MOECNT + 64 * ms, S.tb); S.ntiles = S.tb[8]; S.nNe = 2 * D_FFE / 256; S.G = F.G; S.c = F.bid;
                pg8::Gemm g{HB, (const bf16_t*)(F.ws + WS_W13), DM / 2, (const int*)(F.ws + WS_ROWMAP)};
                pg8::EpiSwiglu8 E{(unsigned char*)ACT, KP8, 0.015625f};
                pg8::gemm_phase<pg8::EpiSwiglu8, pg8::MoeOrder, true, true>(F.tid, F.lds, g, S, E);
            }
            SEAM(pb + P_UP);
        }
        if (EN(9) && IN(pb + P_DOWN)) { PH_BEGIN();
            __syncthreads();
            if (!moe) {
                pg8::Gemm g{ACT, (const bf16_t*)(F.ws + WS_W2), D_FF / 2, nullptr}; pg8::StaticOrder S; S.init(NTOK, DM, F.G, F.bid);
                pg8::EpiResidB<false> E{XBUF, XBUF, DM, 0.015625f};
                pg8::gemm_phase<pg8::EpiResidB<false>, pg8::StaticOrder, false, true>(F.tid, F.lds, g, S, E);
            } else {
                pg8::MoeOrder S; moe_bases(F.ctl + CW_MOECNT + 64 * ms, S.tb); S.ntiles = S.tb[8]; S.nNe = DM / 256; S.G = F.G; S.c = F.bid;
                pg8::Gemm g{ACT, (const bf16_t*)(F.ws + WS_W2), KP8 / 2, nullptr};
                pg8::EpiBf16 E{(bf16_t*)(F.ws + WS_Y), DM, 0.015625f};
                pg8::gemm_phase<pg8::EpiBf16, pg8::MoeOrder, false, true>(F.tid, F.lds, g, S, E);
            }
            SEAM(pb + P_DOWN);
        }
        }
    { constexpr int l = 1;
        const int pb = l * PH_PER_LAYER; const bool moe = (l & 1) != 0; const int ms = l >> 1;

        if (EN(0) && IN(pb + P_PREP)) { PH_BEGIN();
            if (sub & 1) { phase_convert_weights(F, l); rwkv_convert_small(F, l); }
            __syncthreads();
            if (sub & 2) { if (l == 0) phase_norm_lr<true, false>(F, INF(F, I_X), INF(F, I_ATTN_NORM) + l * DM, l); else if (((l - 1) & 1) != 0) phase_norm_lr<false, true>(F, XBUF, INF(F, I_ATTN_NORM) + l * DM, l); else phase_norm_lr<false, false>(F, XBUF, INF(F, I_ATTN_NORM) + l * DM, l); }
            SEAM(pb + P_PREP);
        }
        if (EN(1) && IN(pb + P_INPROJ)) { PH_BEGIN();
            pg8::Gemm g{HB, (const bf16_t*)(F.ws + WS_WIN), DM, nullptr}; pg8::StaticOrder S; S.init(NTOK, 3072, F.G, F.bid);
            pg8::EpiBf16 E{PROJ, NPROJ};
            pg8::gemm_phase<pg8::EpiBf16, pg8::StaticOrder, false>(F.tid, F.lds, g, S, E);
            SEAM(pb + P_INPROJ);
        }
        if (EN(2) && IN(pb + P_MIX1)) { PH_BEGIN();
            if (sub & 1) { rwkv_r1_tables(F, l); for (int unit = F.bid; unit < 2048; unit += F.G) rwkv_r1_unit(F, l, unit, (sub >> 8) & 15); }
            if (sub & 2) { GlaW2 gw; gla_loadw2(F, l, (F.bid >> 6) & 3, gw); for (int unit = F.bid; unit < 2048; unit += 2 * F.G) gla_kv2_pair(F, l, unit, gw); }
            SEAM(pb + P_MIX1);
        }
        if (EN(3) && IN(pb + P_MIX2)) { PH_BEGIN();
            if (F.bid < 32) { if (sub & 1) rwkv_r2_block(F, F.bid); }
            else { const int ob = F.bid - 32, NO = F.G - 32;
                if (sub & 2) for (int gt = ob * 512 + F.tid; gt < 65536; gt += NO * 512) gla_scan(F, gt); }
            if (sub & 12) {
                volatile LAS int* qw = (volatile LAS int*)(F.lds + MISC_OFF + 28);
                unsigned* qctr = F.ctl + CW_ATTNQ + 64 * l + ((sub >> 4) & 1) * 32;
                int nxt = 0;
                if (F.tid == 0) nxt = (int)atomicAdd(qctr, 1u);
                for (;;) {
                    __syncthreads();
                    if (F.tid == 0) *qw = nxt;
                    __syncthreads();
                    const int task = *qw;
                    if (task >= 1024) break;
                    if (F.tid == 0) nxt = (int)atomicAdd(qctr, 1u);
                    if (task < 512) { if (sub & 4) attn_block<false>(F, l, task); } else if (sub & 8) attn_block<true>(F, l, task - 512);
                }
            }
            SEAM(pb + P_MIX2);
        }
        if (EN(4) && IN(pb + P_MIX3)) { PH_BEGIN();
            if (sub & 1) { GlaW2 gw; gla_loadw2(F, l, (F.bid >> 6) & 3, gw); for (int unit = F.bid; unit < 2048; unit += 2 * F.G) gla_out2_pair(F, l, unit, gw, (sub >> 8) & 15); }
            __syncthreads();
            if (sub & 2) for (int unit = F.bid * 8 + F.wave; unit < 2048; unit += F.G * 8) rwkv_r3_task(F, l, unit);
            SEAM(pb + P_MIX3);
        }
        if (EN(5) && IN(pb + P_OUTPROJ)) { PH_BEGIN();
            __syncthreads();
            pg8::Gemm g{MIXB, (const bf16_t*)(F.ws + WS_WOUT), DM, nullptr}; pg8::StaticOrder S; S.init(NTOK, DM, F.G, F.bid);
            if (l == 0) { pg8::EpiResidB<true> E{INF(F, I_X), XBUF, DM}; pg8::gemm_phase<pg8::EpiResidB<true>, pg8::StaticOrder, false>(F.tid, F.lds, g, S, E); }
            else { pg8::EpiResidB<false> E{XBUF, XBUF, DM}; pg8::gemm_phase<pg8::EpiResidB<false>, pg8::StaticOrder, false>(F.tid, F.lds, g, S, E); }
            SEAM(pb + P_OUTPROJ);
        }
        if (EN(6) && IN(pb + P_NORM2)) { PH_BEGIN();
            if (moe) phase_norm<1, false>(F, XBUF, INF(F, I_FFN_NORM) + l * DM, false, ms);
            else phase_norm<0, false>(F, XBUF, INF(F, I_FFN_NORM) + l * DM, false, 0);
            SEAM(pb + P_NORM2);
        }
        if (EN(7) && IN(pb + P_MAP)) { PH_BEGIN();
            if (moe) { phase_moe_map(F, ms); SEAM(pb + P_MAP); }
        }
        if (EN(8) && IN(pb + P_UP)) { PH_BEGIN();
            __syncthreads();
            if (!moe) {
                pg8::Gemm g{HB, (const bf16_t*)(F.ws + WS_W13), DM / 2, nullptr}; pg8::StaticOrder S; S.init(NTOK, 2 * D_FF, F.G, F.bid);
                pg8::EpiSwiglu8 E{(unsigned char*)ACT, D_FF, 0.015625f};
                pg8::gemm_phase<pg8::EpiSwiglu8, pg8::StaticOrder, false, true>(F.tid, F.lds, g, S, E);
            } else {
                pg8::MoeOrder S; moe_bases(F.ctl + CW_MOECNT + 64 * ms, S.tb); S.ntiles = S.tb[8]; S.nNe = 2 * D_FFE / 256; S.G = F.G; S.c = F.bid;
                pg8::Gemm g{HB, (const bf16_t*)(F.ws + WS_W13), DM / 2, (const int*)(F.ws + WS_ROWMAP)};
                pg8::EpiSwiglu8 E{(unsigned char*)ACT, KP8, 0.015625f};
                pg8::gemm_phase<pg8::EpiSwiglu8, pg8::MoeOrder, true, true>(F.tid, F.lds, g, S, E);
            }
            SEAM(pb + P_UP);
        }
        if (EN(9) && IN(pb + P_DOWN)) { PH_BEGIN();
            __syncthreads();
            if (!moe) {
                pg8::Gemm g{ACT, (const bf16_t*)(F.ws + WS_W2), D_FF / 2, nullptr}; pg8::StaticOrder S; S.init(NTOK, DM, F.G, F.bid);
                pg8::EpiResidB<false> E{XBUF, XBUF, DM, 0.015625f};
                pg8::gemm_phase<pg8::EpiResidB<false>, pg8::StaticOrder, false, true>(F.tid, F.lds, g, S, E);
            } else {
                pg8::MoeOrder S; moe_bases(F.ctl + CW_MOECNT + 64 * ms, S.tb); S.ntiles = S.tb[8]; S.nNe = DM / 256; S.G = F.G; S.c = F.bid;
                pg8::Gemm g{ACT, (const bf16_t*)(F.ws + WS_W2), KP8 / 2, nullptr};
                pg8::EpiBf16 E{(bf16_t*)(F.ws + WS_Y), DM, 0.015625f};
                pg8::gemm_phase<pg8::EpiBf16, pg8::MoeOrder, false, true>(F.tid, F.lds, g, S, E);
            }
            SEAM(pb + P_DOWN);
        }
        }
    { constexpr int l = 2;
        const int pb = l * PH_PER_LAYER; const bool moe = (l & 1) != 0; const int ms = l >> 1;

        if (EN(0) && IN(pb + P_PREP)) { PH_BEGIN();
            if (sub & 1) { phase_convert_weights(F, l); rwkv_convert_small(F, l); }
            __syncthreads();
            if (sub & 2) { if (l == 0) phase_norm_lr<true, false>(F, INF(F, I_X), INF(F, I_ATTN_NORM) + l * DM, l); else if (((l - 1) & 1) != 0) phase_norm_lr<false, true>(F, XBUF, INF(F, I_ATTN_NORM) + l * DM, l); else phase_norm_lr<false, false>(F, XBUF, INF(F, I_ATTN_NORM) + l * DM, l); }
            SEAM(pb + P_PREP);
        }
        if (EN(1) && IN(pb + P_INPROJ)) { PH_BEGIN();
            pg8::Gemm g{HB, (const bf16_t*)(F.ws + WS_WIN), DM, nullptr}; pg8::StaticOrder S; S.init(NTOK, 3072, F.G, F.bid);
            pg8::EpiBf16 E{PROJ, NPROJ};
            pg8::gemm_phase<pg8::EpiBf16, pg8::StaticOrder, false>(F.tid, F.lds, g, S, E);
            SEAM(pb + P_INPROJ);
        }
        if (EN(2) && IN(pb + P_MIX1)) { PH_BEGIN();
            if (sub & 1) { rwkv_r1_tables(F, l); for (int unit = F.bid; unit < 2048; unit += F.G) rwkv_r1_unit(F, l, unit, (sub >> 8) & 15); }
            if (sub & 2) { GlaW2 gw; gla_loadw2(F, l, (F.bid >> 6) & 3, gw); for (int unit = F.bid; unit < 2048; unit += 2 * F.G) gla_kv2_pair(F, l, unit, gw); }
            SEAM(pb + P_MIX1);
        }
        if (EN(3) && IN(pb + P_MIX2)) { PH_BEGIN();
            if (F.bid < 32) { if (sub & 1) rwkv_r2_block(F, F.bid); }
            else { const int ob = F.bid - 32, NO = F.G - 32;
                if (sub & 2) for (int gt = ob * 512 + F.tid; gt < 65536; gt += NO * 512) gla_scan(F, gt); }
            if (sub & 12) {
                volatile LAS int* qw = (volatile LAS int*)(F.lds + MISC_OFF + 28);
                unsigned* qctr = F.ctl + CW_ATTNQ + 64 * l + ((sub >> 4) & 1) * 32;
                int nxt = 0;
                if (F.tid == 0) nxt = (int)atomicAdd(qctr, 1u);
                for (;;) {
                    __syncthreads();
                    if (F.tid == 0) *qw = nxt;
                    __syncthreads();
                    const int task = *qw;
                    if (task >= 1024) break;
                    if (F.tid == 0) nxt = (int)atomicAdd(qctr, 1u);
                    if (task < 512) { if (sub & 4) attn_block<false>(F, l, task); } else if (sub & 8) attn_block<true>(F, l, task - 512);
                }
            }
            SEAM(pb + P_MIX2);
        }
        if (EN(4) && IN(pb + P_MIX3)) { PH_BEGIN();
            if (sub & 1) { GlaW2 gw; gla_loadw2(F, l, (F.bid >> 6) & 3, gw); for (int unit = F.bid; unit < 2048; unit += 2 * F.G) gla_out2_pair(F, l, unit, gw, (sub >> 8) & 15); }
            __syncthreads();
            if (sub & 2) for (int unit = F.bid * 8 + F.wave; unit < 2048; unit += F.G * 8) rwkv_r3_task(F, l, unit);
            SEAM(pb + P_MIX3);
        }
        if (EN(5) && IN(pb + P_OUTPROJ)) { PH_BEGIN();
            __syncthreads();
            pg8::Gemm g{MIXB, (const bf16_t*)(F.ws + WS_WOUT), DM, nullptr}; pg8::StaticOrder S; S.init(NTOK, DM, F.G, F.bid);
            if (l == 0) { pg8::EpiResidB<true> E{INF(F, I_X), XBUF, DM}; pg8::gemm_phase<pg8::EpiResidB<true>, pg8::StaticOrder, false>(F.tid, F.lds, g, S, E); }
            else { pg8::EpiResidB<false> E{XBUF, XBUF, DM}; pg8::gemm_phase<pg8::EpiResidB<false>, pg8::StaticOrder, false>(F.tid, F.lds, g, S, E); }
            SEAM(pb + P_OUTPROJ);
        }
        if (EN(6) && IN(pb + P_NORM2)) { PH_BEGIN();
            if (moe) phase_norm<1, false>(F, XBUF, INF(F, I_FFN_NORM) + l * DM, false, ms);
            else phase_norm<0, false>(F, XBUF, INF(F, I_FFN_NORM) + l * DM, false, 0);
            SEAM(pb + P_NORM2);
        }
        if (EN(7) && IN(pb + P_MAP)) { PH_BEGIN();
            if (moe) { phase_moe_map(F, ms); SEAM(pb + P_MAP); }
        }
        if (EN(8) && IN(pb + P_UP)) { PH_BEGIN();
            __syncthreads();
            if (!moe) {
                pg8::Gemm g{HB, (const bf16_t*)(F.ws + WS_W13), DM / 2, nullptr}; pg8::StaticOrder S; S.init(NTOK, 2 * D_FF, F.G, F.bid);
                pg8::EpiSwiglu8 E{(unsigned char*)ACT, D_FF, 0.015625f};
                pg8::gemm_phase<pg8::EpiSwiglu8, pg8::StaticOrder, false, true>(F.tid, F.lds, g, S, E);
            } else {
                pg8::MoeOrder S; moe_bases(F.ctl + CW_MOECNT + 64 * ms, S.tb); S.ntiles = S.tb[8]; S.nNe = 2 * D_FFE / 256; S.G = F.G; S.c = F.bid;
                pg8::Gemm g{HB, (const bf16_t*)(F.ws + WS_W13), DM / 2, (const int*)(F.ws + WS_ROWMAP)};
                pg8::EpiSwiglu8 E{(unsigned char*)ACT, KP8, 0.015625f};
                pg8::gemm_phase<pg8::EpiSwiglu8, pg8::MoeOrder, true, true>(F.tid, F.lds, g, S, E);
            }
            SEAM(pb + P_UP);
        }
        if (EN(9) && IN(pb + P_DOWN)) { PH_BEGIN();
            __syncthreads();
            if (!moe) {
                pg8::Gemm g{ACT, (const bf16_t*)(F.ws + WS_W2), D_FF / 2, nullptr}; pg8::StaticOrder S; S.init(NTOK, DM, F.G, F.bid);
                pg8::EpiResidB<false> E{XBUF, XBUF, DM, 0.015625f};
                pg8::gemm_phase<pg8::EpiResidB<false>, pg8::StaticOrder, false, true>(F.tid, F.lds, g, S, E);
            } else {
                pg8::MoeOrder S; moe_bases(F.ctl + CW_MOECNT + 64 * ms, S.tb); S.ntiles = S.tb[8]; S.nNe = DM / 256; S.G = F.G; S.c = F.bid;
                pg8::Gemm g{ACT, (const bf16_t*)(F.ws + WS_W2), KP8 / 2, nullptr};
                pg8::EpiBf16 E{(bf16_t*)(F.ws + WS_Y), DM, 0.015625f};
                pg8::gemm_phase<pg8::EpiBf16, pg8::MoeOrder, false, true>(F.tid, F.lds, g, S, E);
            }
            SEAM(pb + P_DOWN);
        }
        }
    { constexpr int l = 3;
        const int pb = l * PH_PER_LAYER; const bool moe = (l & 1) != 0; const int ms = l >> 1;

        if (EN(0) && IN(pb + P_PREP)) { PH_BEGIN();
            if (sub & 1) { phase_convert_weights(F, l); rwkv_convert_small(F, l); }
            __syncthreads();
            if (sub & 2) { if (l == 0) phase_norm_lr<true, false>(F, INF(F, I_X), INF(F, I_ATTN_NORM) + l * DM, l); else if (((l - 1) & 1) != 0) phase_norm_lr<false, true>(F, XBUF, INF(F, I_ATTN_NORM) + l * DM, l); else phase_norm_lr<false, false>(F, XBUF, INF(F, I_ATTN_NORM) + l * DM, l); }
            SEAM(pb + P_PREP);
        }
        if (EN(1) && IN(pb + P_INPROJ)) { PH_BEGIN();
            pg8::Gemm g{HB, (const bf16_t*)(F.ws + WS_WIN), DM, nullptr}; pg8::StaticOrder S; S.init(NTOK, 3072, F.G, F.bid);
            pg8::EpiBf16 E{PROJ, NPROJ};
            pg8::gemm_phase<pg8::EpiBf16, pg8::StaticOrder, false>(F.tid, F.lds, g, S, E);
            SEAM(pb + P_INPROJ);
        }
        if (EN(2) && IN(pb + P_MIX1)) { PH_BEGIN();
            if (sub & 1) { rwkv_r1_tables(F, l); for (int unit = F.bid; unit < 2048; unit += F.G) rwkv_r1_unit(F, l, unit, (sub >> 8) & 15); }
            if (sub & 2) { GlaW2 gw; gla_loadw2(F, l, (F.bid >> 6) & 3, gw); for (int unit = F.bid; unit < 2048; unit += 2 * F.G) gla_kv2_pair(F, l, unit, gw); }
            SEAM(pb + P_MIX1);
        }
        if (EN(3) && IN(pb + P_MIX2)) { PH_BEGIN();
            if (F.bid < 32) { if (sub & 1) rwkv_r2_block(F, F.bid); }
            else { const int ob = F.bid - 32, NO = F.G - 32;
                if (sub & 2) for (int gt = ob * 512 + F.tid; gt < 65536; gt += NO * 512) gla_scan(F, gt); }
            if (sub & 12) {
                volatile LAS int* qw = (volatile LAS int*)(F.lds + MISC_OFF + 28);
                unsigned* qctr = F.ctl + CW_ATTNQ + 64 * l + ((sub >> 4) & 1) * 32;
                int nxt = 0;
                if (F.tid == 0) nxt = (int)atomicAdd(qctr, 1u);
                for (;;) {
                    __syncthreads();
                    if (F.tid == 0) *qw = nxt;
                    __syncthreads();
                    const int task = *qw;
                    if (task >= 1024) break;
                    if (F.tid == 0) nxt = (int)atomicAdd(qctr, 1u);
                    if (task < 512) { if (sub & 4) attn_block<false>(F, l, task); } else if (sub & 8) attn_block<true>(F, l, task - 512);
                }
            }
            SEAM(pb + P_MIX2);
        }
        if (EN(4) && IN(pb + P_MIX3)) { PH_BEGIN();
            if (sub & 1) { GlaW2 gw; gla_loadw2(F, l, (F.bid >> 6) & 3, gw); for (int unit = F.bid; unit < 2048; unit += 2 * F.G) gla_out2_pair(F, l, unit, gw, (sub >> 8) & 15); }
            __syncthreads();
            if (sub & 2) for (int unit = F.bid * 8 + F.wave; unit < 2048; unit += F.G * 8) rwkv_r3_task(F, l, unit);
            SEAM(pb + P_MIX3);
        }
        if (EN(5) && IN(pb + P_OUTPROJ)) { PH_BEGIN();
            __syncthreads();
            pg8::Gemm g{MIXB, (const bf16_t*)(F.ws + WS_WOUT), DM, nullptr}; pg8::StaticOrder S; S.init(NTOK, DM, F.G, F.bid);
            if (l == 0) { pg8::EpiResidB<true> E{INF(F, I_X), XBUF, DM}; pg8::gemm_phase<pg8::EpiResidB<true>, pg8::StaticOrder, false>(F.tid, F.lds, g, S, E); }
            else { pg8::EpiResidB<false> E{XBUF, XBUF, DM}; pg8::gemm_phase<pg8::EpiResidB<false>, pg8::StaticOrder, false>(F.tid, F.lds, g, S, E); }
            SEAM(pb + P_OUTPROJ);
        }
        if (EN(6) && IN(pb + P_NORM2)) { PH_BEGIN();
            if (moe) phase_norm<1, false>(F, XBUF, INF(F, I_FFN_NORM) + l * DM, false, ms);
            else phase_norm<0, false>(F, XBUF, INF(F, I_FFN_NORM) + l * DM, false, 0);
            SEAM(pb + P_NORM2);
        }
        if (EN(7) && IN(pb + P_MAP)) { PH_BEGIN();
            if (moe) { phase_moe_map(F, ms); SEAM(pb + P_MAP); }
        }
        if (EN(8) && IN(pb + P_UP)) { PH_BEGIN();
            __syncthreads();
            if (!moe) {
                pg8::Gemm g{HB, (const bf16_t*)(F.ws + WS_W13), DM / 2, nullptr}; pg8::StaticOrder S; S.init(NTOK, 2 * D_FF, F.G, F.bid);
                pg8::EpiSwiglu8 E{(unsigned char*)ACT, D_FF, 0.015625f};
                pg8::gemm_phase<pg8::EpiSwiglu8, pg8::StaticOrder, false, true>(F.tid, F.lds, g, S, E);
            } else {
                pg8::MoeOrder S; moe_bases(F.ctl + CW_MOECNT + 64 * ms, S.tb); S.ntiles = S.tb[8]; S.nNe = 2 * D_FFE / 256; S.G = F.G; S.c = F.bid;
                pg8::Gemm g{HB, (const bf16_t*)(F.ws + WS_W13), DM / 2, (const int*)(F.ws + WS_ROWMAP)};
                pg8::EpiSwiglu8 E{(unsigned char*)ACT, KP8, 0.015625f};
                pg8::gemm_phase<pg8::EpiSwiglu8, pg8::MoeOrder, true, true>(F.tid, F.lds, g, S, E);
            }
            SEAM(pb + P_UP);
        }
        if (EN(9) && IN(pb + P_DOWN)) { PH_BEGIN();
            __syncthreads();
            if (!moe) {
                pg8::Gemm g{ACT, (const bf16_t*)(F.ws + WS_W2), D_FF / 2, nullptr}; pg8::StaticOrder S; S.init(NTOK, DM, F.G, F.bid);
                pg8::EpiResidB<false> E{XBUF, XBUF, DM, 0.015625f};
                pg8::gemm_phase<pg8::EpiResidB<false>, pg8::StaticOrder, false, true>(F.tid, F.lds, g, S, E);
            } else {
                pg8::MoeOrder S; moe_bases(F.ctl + CW_MOECNT + 64 * ms, S.tb); S.ntiles = S.tb[8]; S.nNe = DM / 256; S.G = F.G; S.c = F.bid;
                pg8::Gemm g{ACT, (const bf16_t*)(F.ws + WS_W2), KP8 / 2, nullptr};
                pg8::EpiBf16 E{(bf16_t*)(F.ws + WS_Y), DM, 0.015625f};
                pg8::gemm_phase<pg8::EpiBf16, pg8::MoeOrder, false, true>(F.tid, F.lds, g, S, E);
            }
            SEAM(pb + P_DOWN);
        }
        }
    if (EN(10) && IN(PH_FINAL)) { PH_BEGIN();
        __syncthreads();
        phase_norm<2, false>(F, XBUF, INF(F, I_FINAL_NORM), true, 0);
        SEAM(PH_FINAL);
    }
    if (EN(10) && IN(PH_FINAL + 1)) { PH_BEGIN(); phase_final_copy(F); }
#undef IN
#undef XBUF
#undef HB
#undef PROJ
#undef MIXB
#undef ACT
#undef PH_BEGIN
#undef SEAM
}

extern "C" void kernel_launch(void* const* d_in, const int* in_sizes, int n_in, void* d_out, int out_size, void* d_ws, size_t ws_size, hipStream_t stream) {
    static int ready = 0;
    if (ready == 0) {
        if (n_in != N_IN || in_sizes[0] != NTOK * DM || out_size != NTOK * DM || ws_size < WS_END) {
            fprintf(stderr, "kernel_launch: unexpected shapes (n_in %d, in0 %d, out %d, ws %zu); nothing launched\n", n_in, n_in > 0 ? in_sizes[0] : -1, out_size, ws_size); ready = -1; return; }
        if (hipFuncSetAttribute((const void*)fwd_kernel, hipFuncAttributeMaxDynamicSharedMemorySize, LDS_BYTES) != hipSuccess) { fprintf(stderr, "kernel_launch: hipFuncSetAttribute failed\n"); ready = -1; return; }
        int per_cu = 0;
        if (hipOccupancyMaxActiveBlocksPerMultiprocessor(&per_cu, (const void*)fwd_kernel, 512, LDS_BYTES) != hipSuccess || per_cu < 1)
            fprintf(stderr, "kernel_launch: note: occupancy query reports %d workgroups per CU\n", per_cu);
        (void)hipGetLastError();
        ready = 1;
    }
    if (ready < 0) return;
    const int grid = 256;
    if (hipMemsetAsync((char*)d_ws + WS_CTL, 0, CTL_ZERO_BYTES, stream) != hipSuccess) { fprintf(stderr, "kernel_launch: memset failed\n"); return; }
    Args a{};
    for (int i = 0; i < N_IN; ++i) a.in[i] = d_in[i];
    a.out = (float*)d_out; a.ws = (unsigned char*)d_ws; a.sub = 0xF;
#if N_LAUNCHES_ONE
    a.ph_lo = 0; a.ph_hi = PH_END;
    hipLaunchKernelGGL(fwd_kernel, dim3(grid), dim3(512), LDS_BYTES, stream, a);
#else
    for (int p = 0; p < PH_END; ++p) {
        if (p < PH_FINAL && (p % PH_PER_LAYER) == P_MAP && (((p / PH_PER_LAYER) & 1) == 0)) continue;
        a.ph_lo = p; a.ph_hi = p + 1; a.sub = 0xF;
        hipLaunchKernelGGL(fwd_kernel, dim3(grid), dim3(512), LDS_BYTES, stream, a);
#if defined(PROBE_PHASE)
        if (p < PH_FINAL && (p % PH_PER_LAYER) == PROBE_PHASE && ((PROBE_LMASK >> (p / PH_PER_LAYER)) & 1)) { a.sub = PROBE_SUB; hipLaunchKernelGGL(fwd_kernel, dim3(grid), dim3(512), LDS_BYTES, stream, a); }
#endif
    }
#endif
    const hipError_t le = hipPeekAtLastError();
    if (le != hipSuccess) fprintf(stderr, "kernel_launch: launch failed: %s\n", hipGetErrorName(le));
}
```

```cpp
#include <hip/hip_runtime.h>
#include <cstdio>
#include <cstdint>

#define LAS __attribute__((address_space(3)))
#define GAS __attribute__((address_space(1)))
typedef unsigned short bf16_t;
typedef short bf16x8 __attribute__((ext_vector_type(8)));
typedef float f32x4 __attribute__((ext_vector_type(4)));
typedef float f32x2 __attribute__((ext_vector_type(2)));
typedef unsigned u32x4 __attribute__((ext_vector_type(4)));
typedef unsigned u32x2 __attribute__((ext_vector_type(2)));

#ifndef N_LAUNCHES_ONE
#define N_LAUNCHES_ONE 1
#endif

constexpr int BATCH = 8, SEQ = 4096, DM = 1024, NTOK = BATCH * SEQ, DEPTH = 4;
constexpr int IN_COLS = 3088, NPROJ = 3328;
constexpr int D_FF = 2816, N_EXP = 8, D_FFE = 1408;
constexpr int KP8 = 1536;
constexpr int PA_Q = 0, PA_K = 256, PA_V = 384;
constexpr int PB_Q = 512, PB_K = 640, PB_V = 768, PB_G = 1024;
constexpr int PC_Q = 1280, PC_K = 1536, PC_V = 1792;
constexpr int PD = 2048;
constexpr int PB_LR = 3072;
constexpr float NORM_EPS = 1e-6f;
constexpr int MOE_ROWS = NTOK * 2 + N_EXP * 256;

constexpr size_t MiB = 1u << 20;
constexpr size_t WS_CTL = 0, CTL_ZERO_BYTES = 1 * MiB;
constexpr size_t WS_ROPE_C = 2 * MiB, WS_ROPE_S = 6 * MiB;
constexpr size_t WS_WIN = 10 * MiB, WS_WOUT = 17 * MiB, WS_W13 = 19 * MiB, WS_W2 = 63 * MiB;
constexpr size_t WS_H = 86 * MiB;
constexpr size_t WS_PROJ = 150 * MiB;
constexpr size_t WS_MIX = 358 * MiB;
constexpr size_t WS_SCR = 422 * MiB;
constexpr size_t WS_RWM = WS_H;
constexpr size_t WS_RW_V = WS_SCR, WS_RW_G = WS_SCR + 16 * MiB, WS_RW_S = WS_SCR + 32 * MiB;
constexpr size_t WS_GLA_KV = 470 * MiB, WS_GLA_DEC = 1 * MiB;
constexpr size_t WS_RKR = 486 * MiB;
constexpr size_t WS_RW_X = 488 * MiB;
constexpr size_t WS_SMALLW = 85 * MiB;
constexpr size_t WS_YRAW = 488 * MiB;
constexpr size_t WS_Y = 358 * MiB;
constexpr size_t WS_TOK_E = 520 * MiB, WS_TOK_G = WS_TOK_E + 256 * 1024, WS_TOK_SLOT = WS_TOK_G + 256 * 1024, WS_TOK_ROW = WS_TOK_SLOT + 256 * 1024, WS_ROWMAP = 521 * MiB;
constexpr size_t WS_END = 522 * MiB;
static_assert(WS_Y + (size_t)MOE_ROWS * 2048 <= WS_TOK_E && WS_YRAW + (size_t)NTOK * 256 * 4 <= WS_TOK_E && WS_W2 + 22 * MiB <= WS_H, "ws map");
constexpr int CW_BAR = 4096;
constexpr int CW_ATTNQ = 12288;
constexpr int CW_MOECNT = 8192;

constexpr size_t XB_OFF = 64 * MiB;
constexpr int LDS_BYTES = 147456;
constexpr int MISC_OFF = 131072 + 8192;

__device__ __forceinline__ float bf2f(unsigned short u) { return __uint_as_float((unsigned)u << 16); }
__device__ __forceinline__ float bflo(unsigned w) { return __uint_as_float(w << 16); }
__device__ __forceinline__ float bfhi(unsigned w) { return __uint_as_float(w & 0xffff0000u); }
__device__ __forceinline__ unsigned short f2bf(float f) { unsigned u = __float_as_uint(f); return (unsigned short)((u + 0x7fffu + ((u >> 16) & 1u)) >> 16); }
__device__ __forceinline__ unsigned pk2(float lo, float hi) { return (unsigned)f2bf(lo) | ((unsigned)f2bf(hi) << 16); }
__device__ __forceinline__ float wave_sum(float v) {
#pragma unroll
    for (int o = 1; o < 64; o <<= 1) v += __shfl_xor(v, o);
    return v;
}
__device__ __forceinline__ float sigmoid_f(float x) { return 1.f / (1.f + __expf(-x)); }
__device__ __forceinline__ float softplus_f(float z) { return fmaxf(z, 0.f) + __logf(1.f + __expf(-fabsf(z))); }
__device__ __forceinline__ float logsigmoid_f(float x) { return fminf(x, 0.f) - __logf(1.f + __expf(-fabsf(x))); }
namespace pg8 {
constexpr int BM = 256, BK = 64, HALF = 128, HTB = HALF * BK * 2  , STAGE_BYTES = 8 * HTB, NXCD = 8, WGM = 8;

__host__ __device__ __forceinline__ int lds_byte(int r, int c) { const int st = (r >> 4) * 2 + (c >> 5), rr = r & 15, cc = c & 31, ob = rr * 64 + cc * 2; return st * 1024 + (ob ^ (((ob >> 9) & 1) << 5)); }
__host__ __device__ __forceinline__ void stage_rc(int b, int& R, int& C) { const int st = b / 1024, sb = b % 1024, swz = sb ^ (((sb >> 9) & 1) << 5); R = (st >> 1) * 16 + swz / 64; C = (st & 1) * 32 + (swz % 64) / 2; }
__host__ __device__ __forceinline__ int perm32(int rho) { const int n = rho >> 4, i = rho & 15; return 8 * (i >> 2) + 4 * n + (i & 3); }

struct Unit { int pm, pn, pc; };
struct Gemm { const bf16_t* A; const bf16_t* Bt; int K; const int* rowmap; };

struct StaticOrder {
    int nM, nN, nwg, G, c;
    __device__ void init(int M, int N, int G_, int c_) { nM = M / BM; nN = N / BM; nwg = nM * nN; G = G_; c = c_; }
    __device__ bool next(int i, Unit& u) const {
        const long L = (long)i * G + c; if (L >= nwg) return false;
        int wgid = (int)L; { const int q = nwg / NXCD, r = nwg % NXCD, xcd = wgid % NXCD, off = wgid / NXCD; wgid = (xcd < r ? xcd * (q + 1) : r * (q + 1) + (xcd - r) * q) + off; }
        const int nig = WGM * nN, gid = wgid / nig, fm = gid * WGM, gsz = (nM - fm) < WGM ? (nM - fm) : WGM;
        u.pm = fm + ((wgid % nig) % gsz); u.pn = (wgid % nig) / gsz; u.pc = u.pn; return true;
    }
};
struct MoeOrder {
    int ntiles, nNe, G, c; int tb[9];
    __device__ bool next(int i, Unit& u) const {
        const long L = (long)i * G + c; if (L >= (long)ntiles * nNe) return false;
        const int pm = (int)(L / nNe), pl = (int)(L % nNe); int e = 0;
#pragma unroll
        for (int j = 1; j < 8; ++j) e += (pm >= tb[j]) ? 1 : 0;
        u.pm = pm; u.pn = e * nNe + pl; u.pc = pl; return true;
    }
};

typedef __bf16 bf16pair_t __attribute__((ext_vector_type(2)));
__device__ __forceinline__ unsigned cvt_pk_c(float lo, float hi) { bf16pair_t v; v[0] = (__bf16)lo; v[1] = (__bf16)hi; return __builtin_bit_cast(unsigned, v); }
__device__ __forceinline__ unsigned cvt_pk_bf16(float lo, float hi) { unsigned r; asm volatile("v_cvt_pk_bf16_f32 %0, %1, %2" : "=v"(r) : "v"(lo), "v"(hi)); return r; }

struct EpiBf16 {
    static constexpr bool PERM = true;
    bf16_t* O; int ldc; float sc = 1.f;
    __device__ __forceinline__ void operator()(const f32x4 (&acc)[2][2][4][2], const Unit& u, int wr, int wc, int fr, int fq) const {
        const int row0 = u.pm * BM + wr * 64 + fr; const int col0 = u.pc * BM + wc * 32 + 8 * fq;
#pragma unroll
        for (int ai = 0; ai < 2; ++ai)
#pragma unroll
            for (int m = 0; m < 4; ++m) { bf16_t* rowp = O + (size_t)(row0 + ai * HALF + m * 16) * ldc + col0;
#pragma unroll
                for (int bj = 0; bj < 2; ++bj) { const f32x4 v0 = acc[ai][bj][m][0] * sc, v1 = acc[ai][bj][m][1] * sc;
                    u32x4 w; w.x = cvt_pk_bf16(v0[0], v0[1]); w.y = cvt_pk_bf16(v0[2], v0[3]); w.z = cvt_pk_bf16(v1[0], v1[1]); w.w = cvt_pk_bf16(v1[2], v1[3]);
                    *(u32x4*)(rowp + bj * HALF) = w; } }
    }
};
struct EpiSwiglu {
    static constexpr bool PERM = true;
    bf16_t* O; int ldc; float sc;
    __device__ __forceinline__ void operator()(const f32x4 (&acc)[2][2][4][2], const Unit& u, int wr, int wc, int fr, int fq) const {
        const int row0 = u.pm * BM + wr * 64 + fr; const int col0 = u.pc * HALF + wc * 32 + 8 * fq;
#pragma unroll
        for (int ai = 0; ai < 2; ++ai)
#pragma unroll
            for (int m = 0; m < 4; ++m) { bf16_t* rowp = O + (size_t)(row0 + ai * HALF + m * 16) * ldc + col0;
                float r[8];
#pragma unroll
                for (int n = 0; n < 2; ++n)
#pragma unroll
                    for (int j = 0; j < 4; ++j) { const float g = acc[ai][0][m][n][j] * sc, up = acc[ai][1][m][n][j] * sc; r[n * 4 + j] = g * __builtin_amdgcn_rcpf(1.f + __expf(-g)) * up; }
                u32x4 w; w.x = cvt_pk_bf16(r[0], r[1]); w.y = cvt_pk_bf16(r[2], r[3]); w.z = cvt_pk_bf16(r[4], r[5]); w.w = cvt_pk_bf16(r[6], r[7]);
                *(u32x4*)rowp = w; }
    }
};
__device__ __forceinline__ unsigned pk4_fp8c(float a, float b, float c, float d) { unsigned w = 0u;
    a = __builtin_fminf(__builtin_fmaxf(a, -448.f), 448.f); b = __builtin_fminf(__builtin_fmaxf(b, -448.f), 448.f); c = __builtin_fminf(__builtin_fmaxf(c, -448.f), 448.f); d = __builtin_fminf(__builtin_fmaxf(d, -448.f), 448.f);
    w = __builtin_amdgcn_cvt_pk_fp8_f32(a, b, w, false); w = __builtin_amdgcn_cvt_pk_fp8_f32(c, d, w, true); return w; }
struct EpiSwiglu8 {
    static constexpr bool PERM = true;
    unsigned char* O8; int ldc; float sc;
    __device__ __forceinline__ void operator()(const f32x4 (&acc)[2][2][4][2], const Unit& u, int wr, int wc, int fr, int fq) const {
        const int row0 = u.pm * BM + wr * 64 + fr; const int col0 = u.pc * HALF + wc * 32 + 8 * fq;
#pragma unroll
        for (int ai = 0; ai < 2; ++ai)
#pragma unroll
            for (int m = 0; m < 4; ++m) { unsigned char* rowp = O8 + (size_t)(row0 + ai * HALF + m * 16) * ldc + col0;
                float r[8];
#pragma unroll
                for (int n = 0; n < 2; ++n)
#pragma unroll
                    for (int j = 0; j < 4; ++j) { const float g = acc[ai][0][m][n][j] * sc, up = acc[ai][1][m][n][j] * sc; r[n * 4 + j] = g * __builtin_amdgcn_rcpf(1.f + __expf(-g)) * up; }
                u32x2 w; w.x = pk4_fp8c(r[0], r[1], r[2], r[3]); w.y = pk4_fp8c(r[4], r[5], r[6], r[7]);
                *(u32x2*)rowp = w; }
    }
};
template <bool BASE_F32> struct EpiResidB {
    static constexpr bool PERM = true;
    const void* base; bf16_t* out; int ldc; float sc = 1.f;
    __device__ __forceinline__ void operator()(const f32x4 (&acc)[2][2][4][2], const Unit& u, int wr, int wc, int fr, int fq) const {
        const int row0 = u.pm * BM + wr * 64 + fr; const int col0 = u.pc * BM + wc * 32 + 8 * fq;
#pragma unroll
        for (int ai = 0; ai < 2; ++ai)
#pragma unroll
            for (int m = 0; m < 4; ++m) { const size_t off = (size_t)(row0 + ai * HALF + m * 16) * ldc + col0;
#pragma unroll
                for (int bj = 0; bj < 2; ++bj) { f32x4 v0 = acc[ai][bj][m][0] * sc, v1 = acc[ai][bj][m][1] * sc;
                    if (BASE_F32) { const float* bp = (const float*)base + off + bj * HALF; v0 += *(const f32x4*)bp; v1 += *(const f32x4*)(bp + 4); }
                    else { const u32x4 w = *(const u32x4*)((const bf16_t*)base + off + bj * HALF);
                        v0[0] += __uint_as_float(w.x << 16); v0[1] += __uint_as_float(w.x & 0xffff0000u); v0[2] += __uint_as_float(w.y << 16); v0[3] += __uint_as_float(w.y & 0xffff0000u);
                        v1[0] += __uint_as_float(w.z << 16); v1[1] += __uint_as_float(w.z & 0xffff0000u); v1[2] += __uint_as_float(w.w << 16); v1[3] += __uint_as_float(w.w & 0xffff0000u); }
                    u32x4 o; o.x = cvt_pk_bf16(v0[0], v0[1]); o.y = cvt_pk_bf16(v0[2], v0[3]); o.z = cvt_pk_bf16(v1[0], v1[1]); o.w = cvt_pk_bf16(v1[2], v1[3]);
                    *(u32x4*)(out + off + bj * HALF) = o; } }
    }
};

typedef int i32x8 __attribute__((ext_vector_type(8)));
typedef int i32x4g __attribute__((ext_vector_type(4)));
__device__ __forceinline__ i32x8 cat8(const bf16x8 a, const bf16x8 b) { return __builtin_shufflevector(__builtin_bit_cast(i32x4g, a), __builtin_bit_cast(i32x4g, b), 0, 1, 2, 3, 4, 5, 6, 7); }
template <class Epi, class Sched, bool GATHER, bool F8 = false>
__device__ __forceinline__ void gemm_phase(const int tid, LAS unsigned char* lds, const Gemm g, const Sched& S, const Epi& E) {
    const int wid = __builtin_amdgcn_readfirstlane(tid >> 6), lane = tid & 63, wr = wid >> 2, wc = wid & 3, fr = lane & 15, fq = lane >> 4;
    const int K = g.K, nt = K / BK;
    unsigned voffA, voffB;
    { int R, C; stage_rc(tid * 16, R, C); const int Rb = Epi::PERM ? ((R & ~31) + perm32(R & 31)) : R; voffA = (unsigned)(R * K + C) * 2u; voffB = (unsigned)(Rb * K + C) * 2u; }
    const size_t kstep = (size_t)(BK * 2);
    const size_t hstep = (size_t)HALF * K * 2;
    const size_t tstep = 2 * hstep;
    const unsigned ldsw = (unsigned)wid * 1024u;
    const int aoff = lds_byte(wr * 64 + fr, fq * 8), boff = lds_byte(wc * 32 + fr, fq * 8);
#define PG8_SA(b, h) (((b) * 2 + (h)) * HTB)
#define PG8_SB(b, h) ((4 + (b) * 2 + (h)) * HTB)
#define PG8_STAGE2(bufoff, gbase, v0, v1) do { _Pragma("unroll") for (int _i = 0; _i < 2; ++_i) { unsigned _v = _i ? (v1) : (v0); asm volatile("" : "+v"(_v)); \
        __builtin_amdgcn_global_load_lds((const unsigned*)((const char*)(gbase) + _v), (LAS unsigned*)(lds + (bufoff) + ldsw + _i * 8192), 16, 0, 0); } } while (0)
#define PG8_STAGE(bufoff, gbase, voff) PG8_STAGE2(bufoff, gbase, (voff), (voff) + (unsigned)(128 * K))
#define PG8_STAGE_A(bufoff, kb, h, nx) do { if constexpr (GATHER) { PG8_STAGE2(bufoff, (const char*)g.A + (kb), offC[h][0], offC[h][1]); }   \
        else { PG8_STAGE(bufoff, ((nx) ? nA : cA) + (kb) + (h) * hstep, voffA); } } while (0)
#define PG8_LDA(dst, b, h) do { _Pragma("unroll") for (int m = 0; m < 4; ++m) _Pragma("unroll") for (int k = 0; k < 2; ++k) dst[m][k] = *(const LAS bf16x8*)(lds + PG8_SA(b, h) + aoff + m * 2048 + k * 1024); } while (0)
#define PG8_LDB(dst, b, h) do { _Pragma("unroll") for (int n = 0; n < 2; ++n) _Pragma("unroll") for (int k = 0; k < 2; ++k) dst[n][k] = *(const LAS bf16x8*)(lds + PG8_SB(b, h) + boff + n * 2048 + k * 1024); } while (0)
#define PG8_MMA(ai, bj, At, Bt) do { __builtin_amdgcn_s_setprio(1); _Pragma("unroll") for (int m = 0; m < 4; ++m) _Pragma("unroll") for (int n = 0; n < 2; ++n) { \
        if constexpr (F8) acc[ai][bj][m][n] = __builtin_amdgcn_mfma_scale_f32_16x16x128_f8f6f4(cat8(Bt[n][0], Bt[n][1]), cat8(At[m][0], At[m][1]), acc[ai][bj][m][n], 0, 0, 0, 0, 0, 0);   \
        else { _Pragma("unroll") for (int k = 0; k < 2; ++k) acc[ai][bj][m][n] = __builtin_amdgcn_mfma_f32_16x16x32_bf16(Bt[n][k], At[m][k], acc[ai][bj][m][n], 0, 0, 0); } } __builtin_amdgcn_s_setprio(0); } while (0)
#define PG8_WAIT_V(n) asm volatile("s_waitcnt vmcnt(" #n ")" ::: "memory")
#define PG8_WAIT_L(n) asm volatile("s_waitcnt lgkmcnt(" #n ")" ::: "memory")
#define PG8_BAR __builtin_amdgcn_s_barrier()
#define PG8_SCHED __builtin_amdgcn_sched_barrier(0)
#define PG8_LOADOFF(dst, u) do { _Pragma("unroll") for (int _h = 0; _h < 2; ++_h) _Pragma("unroll") for (int _i = 0; _i < 2; ++_i) { \
        int _R, _C; { int _t = tid; asm volatile("" : "+v"(_t)); stage_rc(_t * 16, _R, _C); } const int _row = g.rowmap[(u).pm * BM + _h * HALF + _R + 64 * _i]; dst[_h][_i] = (unsigned)(_row * K + _C) * 2u; } } while (0)
    Unit cur, nxt; int ui = 0;
    if (!S.next(0, cur)) return;
    f32x4 acc[2][2][4][2];
#pragma unroll
    for (int a = 0; a < 2; ++a)
#pragma unroll
        for (int b = 0; b < 2; ++b)
#pragma unroll
            for (int m = 0; m < 4; ++m)
#pragma unroll
                for (int n = 0; n < 2; ++n) acc[a][b][m][n] = (f32x4){0.f, 0.f, 0.f, 0.f};
    bf16x8 At[4][2], B0[2][2], B1[2][2];
    unsigned offC[2][2] = {{0u, 0u}, {0u, 0u}};
    LAS u32x4* offslot = (LAS u32x4*)(lds + STAGE_BYTES) + tid;
    const char* cA = (const char*)g.A + (GATHER ? (size_t)0 : (size_t)cur.pm * tstep); const char* cB = (const char*)g.Bt + (size_t)cur.pn * tstep;
    const char* nA = cA;
    if constexpr (GATHER) { PG8_LOADOFF(offC, cur); }
    PG8_STAGE(PG8_SB(0, 0), cB, voffB); PG8_STAGE(PG8_SB(0, 1), cB + hstep, voffB); PG8_STAGE_A(PG8_SA(0, 0), 0, 0, false); PG8_STAGE_A(PG8_SA(0, 1), 0, 1, false);
    if (wr == 1) PG8_BAR;
    PG8_WAIT_V(2); PG8_BAR;
    PG8_STAGE(PG8_SB(1, 0), cB + kstep, voffB); PG8_STAGE_A(PG8_SA(1, 0), kstep, 0, false); PG8_STAGE(PG8_SB(1, 1), cB + hstep + kstep, voffB);
    PG8_WAIT_V(6); PG8_BAR;
    for (;;) {
        const bool has_next = S.next(ui + 1, nxt);
        nA = has_next ? (const char*)g.A + (GATHER ? (size_t)0 : (size_t)nxt.pm * tstep) : cA; const char* nB = has_next ? (const char*)g.Bt + (size_t)nxt.pn * tstep : cB;
        if constexpr (GATHER) { unsigned offN[2][2];
            if (has_next) { PG8_LOADOFF(offN, nxt); } else {
#pragma unroll
                for (int h = 0; h < 2; ++h) { offN[h][0] = offC[h][0]; offN[h][1] = offC[h][1]; } }
            *offslot = (u32x4){offN[0][0], offN[0][1], offN[1][0], offN[1][1]}; }
#pragma unroll 1
        for (int t = 0; t < nt; t += 2) {
            const bool last = (t == nt - 2);
            const size_t k1 = (size_t)(t + 1) * kstep;
            const size_t k2 = last ? (size_t)0 : (size_t)(t + 2) * kstep, k3 = k2 + kstep;
            const char* b2 = last ? nB : cB + (size_t)(t + 2) * kstep; const char* b3 = b2 + kstep;
            PG8_LDB(B0, 0, 0); PG8_LDB(B1, 0, 1); PG8_SCHED; PG8_LDA(At, 0, 0); PG8_STAGE_A(PG8_SA(1, 1), k1, 1, false);
            if constexpr (GATHER) { if (last) { const u32x4 o_ = *offslot; offC[0][0] = o_.x; offC[0][1] = o_.y; offC[1][0] = o_.z; offC[1][1] = o_.w; } }
            PG8_WAIT_V(8); PG8_WAIT_L(0); PG8_BAR; PG8_MMA(0, 0, At, B0); PG8_MMA(0, 1, At, B1); PG8_BAR; PG8_SCHED;
            PG8_LDA(At, 0, 1); PG8_STAGE(PG8_SB(0, 0), b2, voffB); PG8_STAGE(PG8_SB(0, 1), b2 + hstep, voffB); PG8_STAGE_A(PG8_SA(0, 0), k2, 0, last);
            PG8_WAIT_V(8); PG8_WAIT_L(0); PG8_BAR; PG8_MMA(1, 0, At, B0); PG8_MMA(1, 1, At, B1); PG8_BAR; PG8_SCHED;
            PG8_LDB(B0, 1, 0); PG8_LDB(B1, 1, 1); PG8_SCHED; PG8_LDA(At, 1, 0); PG8_STAGE_A(PG8_SA(0, 1), k2, 1, last);
            PG8_WAIT_V(8); PG8_WAIT_L(0); PG8_BAR; PG8_MMA(0, 0, At, B0); PG8_MMA(0, 1, At, B1); PG8_BAR; PG8_SCHED;
            PG8_LDA(At, 1, 1); PG8_STAGE(PG8_SB(1, 0), b3, voffB); PG8_STAGE(PG8_SB(1, 1), b3 + hstep, voffB); PG8_STAGE_A(PG8_SA(1, 0), k3, 0, last);
            PG8_WAIT_V(8); PG8_WAIT_L(0); PG8_BAR; PG8_MMA(1, 0, At, B0); PG8_MMA(1, 1, At, B1); PG8_BAR; PG8_SCHED;
        }
        if (wr == 0) PG8_BAR;
        asm volatile("s_nop 15\n\ts_nop 15" ::: "memory");
        { unsigned m_ = ~0u; asm volatile("" : "+s"(m_)); const int ln_ = (int)__builtin_amdgcn_mbcnt_hi(m_, __builtin_amdgcn_mbcnt_lo(m_, 0u));
          E(acc, cur, wr, wc, ln_ & 15, ln_ >> 4); }
        if (!has_next) break;
#pragma unroll
        for (int a = 0; a < 2; ++a)
#pragma unroll
            for (int b = 0; b < 2; ++b)
#pragma unroll
                for (int m = 0; m < 4; ++m)
#pragma unroll
                    for (int n = 0; n < 2; ++n) acc[a][b][m][n] = (f32x4){0.f, 0.f, 0.f, 0.f};
        cur = nxt; cA = nA; cB = nB; ++ui;
        if (wr == 1) PG8_BAR;
    }
    PG8_WAIT_V(0);
    PG8_BAR;
#undef PG8_SA
#undef PG8_SB
#undef PG8_STAGE
#undef PG8_STAGE2
#undef PG8_STAGE_A
#undef PG8_LDA
#undef PG8_LDB
#undef PG8_MMA
#undef PG8_WAIT_V
#undef PG8_WAIT_L
#undef PG8_BAR
#undef PG8_SCHED
#undef PG8_LOADOFF
}
}
#define XB_TMO      128
#define XB_XCNT(j)  (256  + 64 * (j))
#define XB_XSUB(j)  (1280 + 64 * (j))
#define XB_XGEN(j)  (2304 + 64 * (j))
#define XB_TOP      3328
#define XB_TOPGEN   3392
#define XCD_BAR_WORDS 3456
#define XB_SPIN_CAP (1u << 18)

__device__ __forceinline__ unsigned xb_ld(unsigned* p)              { return __hip_atomic_load(p, __ATOMIC_RELAXED, __HIP_MEMORY_SCOPE_AGENT); }
__device__ __forceinline__ unsigned xb_add(unsigned* p, unsigned v) { return __hip_atomic_fetch_add(p, v, __ATOMIC_RELAXED, __HIP_MEMORY_SCOPE_AGENT); }
__device__ __forceinline__ unsigned xb_xcc_id() { return (unsigned)__builtin_amdgcn_s_getreg((3 << 11) | 20) & 0xFu; }
#define XB_SPIN(cond, bar) do { unsigned _sp = 0; while (cond) { __builtin_amdgcn_s_sleep(1); \
    if ((++_sp & 255u) == 0u) { if (xb_ld(&(bar)[XB_TMO])) break; if (_sp > XB_SPIN_CAP) { atomicAdd(&(bar)[XB_TMO], 1u); break; } } } } while (0)

struct XcdBarrier {
    unsigned* bar; unsigned x;
    volatile LAS unsigned* st;
};

__device__ __forceinline__ XcdBarrier xcd_barrier_post(unsigned* bar, volatile LAS unsigned* st) {
    XcdBarrier b; b.bar = bar; b.x = xb_xcc_id(); b.st = st;
    if (threadIdx.x == 0) (void)xb_add(&bar[XB_XCNT(b.x)], 1u);
    return b;
}
__device__ __forceinline__ void xcd_barrier_complete(unsigned* bar, unsigned x, unsigned& nloc, unsigned& nx) {
    const unsigned G = gridDim.x * gridDim.y * gridDim.z;
    unsigned sum, cnt, mine, sp = 0u;
    for (;;) {
        sum = 0u; cnt = 0u; mine = 0u;
#pragma unroll
        for (unsigned j = 0; j < 16; ++j) { const unsigned c = xb_ld(&bar[XB_XCNT(j)]); sum += c; cnt += (c > 0u) ? 1u : 0u; mine = (j == x) ? c : mine; }
        if (sum == G) break;
        __builtin_amdgcn_s_sleep(1);
        if ((++sp & 255u) == 0u) { if (xb_ld(&bar[XB_TMO])) break; if (sp > XB_SPIN_CAP) { atomicAdd(&bar[XB_TMO], 1u); break; } }
    }
    nloc = mine > 0u ? mine : 1u; nx = cnt > 0u ? cnt : 1u;
}

__device__ __forceinline__ void xcd_barrier(const XcdBarrier& b, const bool leader) {
    asm volatile("s_waitcnt vmcnt(0)" ::: "memory");
    __syncthreads();
    if (leader) {
        unsigned* bar = b.bar;
        __builtin_amdgcn_s_waitcnt(0);
        unsigned nloc = b.st[0], nx = b.st[1];
        if (nloc == 0u) { xcd_barrier_complete(bar, b.x, nloc, nx); b.st[0] = nloc; b.st[1] = nx; }
        const unsigned old = xb_add(&bar[XB_XSUB(b.x)], 1u);
        const unsigned gen = old / nloc;
        if (old + 1u == (gen + 1u) * nloc) {
            __builtin_amdgcn_fence(__ATOMIC_RELEASE, "agent");
            asm volatile("s_waitcnt vmcnt(0)" ::: "memory");
            const unsigned og = xb_add(&bar[XB_TOP], 1u);
            const unsigned tg = og / nx;
            if (og + 1u == (tg + 1u) * nx) xb_add(&bar[XB_TOPGEN], 1u);
            else XB_SPIN(xb_ld(&bar[XB_TOPGEN]) == tg, bar);
            __builtin_amdgcn_fence(__ATOMIC_ACQUIRE, "agent");
            xb_add(&bar[XB_XGEN(b.x)], 1u);
            asm volatile("s_waitcnt vmcnt(0)" ::: "memory");
        } else {
            XB_SPIN(xb_ld(&bar[XB_XGEN(b.x)]) == gen, bar);
            __builtin_amdgcn_fence(__ATOMIC_ACQUIRE, "agent");
            asm volatile("s_waitcnt vmcnt(0)" ::: "memory");
        }
    }
    __syncthreads();
}
struct Frame {
    LAS unsigned char* lds;
    unsigned* ctl;
    unsigned char* ws;
    int tid, lane, wave, bid, G;
    float* out;
};
enum InIdx { I_X = 0, I_POS, I_ATTN_NORM, I_W_IN, I_SINKS, I_SWA_ON, I_GLA_WA2, I_GLA_BA, I_GLA_ON, I_SB_ON, I_MU, I_W0, I_W2, I_A0, I_A2, I_G2, I_KK, I_KA, I_RK, I_LNW, I_LNB,
             I_W_OUT, I_FFN_NORM, I_FFN_W1, I_FFN_W3, I_FFN_W2, I_ROUTER, I_MOE_W1, I_MOE_W3, I_MOE_W2, I_FINAL_NORM, N_IN };
constexpr int PTR_OFF = MISC_OFF + 64;
__device__ __forceinline__ const void* in_ptr(const Frame& F, int i) {
    const unsigned long long v = ((const LAS unsigned long long*)(F.lds + PTR_OFF))[i];
    const unsigned lo = __builtin_amdgcn_readfirstlane((unsigned)v), hi = __builtin_amdgcn_readfirstlane((unsigned)(v >> 32));
    return (const void*)(GAS const void*)(((unsigned long long)hi << 32) | lo);
}
#define INF(F, i) ((const float*)in_ptr(F, i))

template <class Map>
__device__ __forceinline__ void transpose_item(const float* W, int K, int N, bf16_t* WT, const Map& dst, LAS float* scr, int item, int lane) {
    const int nblk = (N + 31) / 32, kb = item / nblk, nb = item % nblk, k0 = 64 * kb, n0 = 32 * nb;
    const int rr = lane >> 3, q4 = (lane & 7) * 4; const bool inb = n0 + q4 < N;
#pragma unroll
    for (int i = 0; i < 8; ++i) { const int kk = 8 * i + rr; f32x4 v = {0.f, 0.f, 0.f, 0.f}; if (inb) v = *(const f32x4*)(W + (size_t)(k0 + kk) * N + n0 + q4);
        scr[kk * 33 + q4] = v[0]; scr[kk * 33 + q4 + 1] = v[1]; scr[kk * 33 + q4 + 2] = v[2]; scr[kk * 33 + q4 + 3] = v[3]; }
    asm volatile("s_waitcnt lgkmcnt(0)" ::: "memory");
    const int c = lane & 7;
#pragma unroll
    for (int j = 0; j < 4; ++j) { const int n = (lane >> 3) + 8 * j; const LAS float* s = scr + (8 * c) * 33 + n;
        u32x4 o; o.x = pk2(s[0 * 33], s[1 * 33]); o.y = pk2(s[2 * 33], s[3 * 33]); o.z = pk2(s[4 * 33], s[5 * 33]); o.w = pk2(s[6 * 33], s[7 * 33]);
        if (n0 + n < N) *(u32x4*)(WT + (size_t)dst(n0 + n) * K + k0 + 8 * c) = o; }
    asm volatile("s_waitcnt lgkmcnt(0)" ::: "memory");
}
__device__ __forceinline__ unsigned pk4_fp8(float a, float b, float c, float d) { return pg8::pk4_fp8c(a, b, c, d); }
template <class Map>
__device__ __forceinline__ void transpose_item8(const float* W, int K, int N, unsigned char* WT, const Map& dst, LAS float* scr, int item, int lane, int pitch = 0) {
    const int nblk = (N + 31) / 32, kb = item / nblk, nb = item % nblk, k0 = 64 * kb, n0 = 32 * nb;
    const int rr = lane >> 3, q4 = (lane & 7) * 4; const bool inb = n0 + q4 < N;
#pragma unroll
    for (int i = 0; i < 8; ++i) { const int kk = 8 * i + rr; f32x4 v = {0.f, 0.f, 0.f, 0.f}; if (inb) v = *(const f32x4*)(W + (size_t)(k0 + kk) * N + n0 + q4);
        scr[kk * 33 + q4] = v[0] * 64.f; scr[kk * 33 + q4 + 1] = v[1] * 64.f; scr[kk * 33 + q4 + 2] = v[2] * 64.f; scr[kk * 33 + q4 + 3] = v[3] * 64.f; }
    asm volatile("s_waitcnt lgkmcnt(0)" ::: "memory");
    const int c = lane & 7;
#pragma unroll
    for (int j = 0; j < 4; ++j) { const int n = (lane >> 3) + 8 * j; const LAS float* s = scr + (8 * c) * 33 + n;
        u32x2 o; o.x = pk4_fp8(s[0 * 33], s[1 * 33], s[2 * 33], s[3 * 33]); o.y = pk4_fp8(s[4 * 33], s[5 * 33], s[6 * 33], s[7 * 33]);
        if (n0 + n < N) *(u32x2*)(WT + (size_t)dst(n0 + n) * (pitch ? pitch : K) + k0 + 8 * c) = o; }
    asm volatile("s_waitcnt lgkmcnt(0)" ::: "memory");
}
struct MapIn { __device__ int operator()(int n) const { return n < 1280 ? n : (n < 1296 ? 3072 + (n - 1280) : n - 16); } };
struct MapId { int off; __device__ int operator()(int n) const { return off + n; } };
struct MapGU { int off; __device__ int operator()(int n) const { return off + 256 * (n >> 7) + (n & 127); } };

__device__ __forceinline__ void phase_convert_weights(Frame& F, int l) {
    LAS float* scr = (LAS float*)(F.lds + F.wave * 16384);
    const int gw = F.bid * 8 + F.wave, NGW = F.G * 8;
    bf16_t* WIN = (bf16_t*)(F.ws + WS_WIN); bf16_t* WOUT = (bf16_t*)(F.ws + WS_WOUT); bf16_t* W13 = (bf16_t*)(F.ws + WS_W13); bf16_t* W2 = (bf16_t*)(F.ws + WS_W2);
    const bool moe = (l & 1) != 0; const int li = l >> 1;
    const int I_IN = (DM / 64) * ((IN_COLS + 31) / 32), I_OUT = (DM / 64) * (DM / 32);
    const int I_UP = moe ? (DM / 64) * (D_FFE / 32) : (DM / 64) * (D_FF / 32);
    const int I_DN = moe ? (D_FFE / 64) * (DM / 32) : (D_FF / 64) * (DM / 32);
    const int NE = moe ? N_EXP : 1;
    const int total = I_IN + I_OUT + NE * (2 * I_UP + I_DN);
    for (int it = gw; it < total; it += NGW) {
        int r = it;
        if (r < I_IN) { transpose_item(INF(F, I_W_IN) + (size_t)l * DM * IN_COLS, DM, IN_COLS, WIN, MapIn{}, scr, r, F.lane); continue; } r -= I_IN;
        if (r < I_OUT) { transpose_item(INF(F, I_W_OUT) + (size_t)l * DM * DM, DM, DM, WOUT, MapId{0}, scr, r, F.lane); continue; } r -= I_OUT;
        const int per_e = 2 * I_UP + I_DN, e = r / per_e; r -= e * per_e;
        if (!moe) {
            if (r < I_UP) { transpose_item8(INF(F, I_FFN_W1) + (size_t)li * DM * D_FF, DM, D_FF, (unsigned char*)W13, MapGU{0}, scr, r, F.lane); continue; } r -= I_UP;
            if (r < I_UP) { transpose_item8(INF(F, I_FFN_W3) + (size_t)li * DM * D_FF, DM, D_FF, (unsigned char*)W13, MapGU{128}, scr, r, F.lane); continue; } r -= I_UP;
            transpose_item8(INF(F, I_FFN_W2) + (size_t)li * D_FF * DM, D_FF, DM, (unsigned char*)W2, MapId{0}, scr, r, F.lane);
        } else {
            const size_t eo = (size_t)(li * N_EXP + e);
            if (r < I_UP) { transpose_item8(INF(F, I_MOE_W1) + eo * DM * D_FFE, DM, D_FFE, (unsigned char*)W13, MapGU{e * 2 * D_FFE}, scr, r, F.lane); continue; } r -= I_UP;
            if (r < I_UP) { transpose_item8(INF(F, I_MOE_W3) + eo * DM * D_FFE, DM, D_FFE, (unsigned char*)W13, MapGU{e * 2 * D_FFE + 128}, scr, r, F.lane); continue; } r -= I_UP;
            transpose_item8(INF(F, I_MOE_W2) + eo * D_FFE * DM, D_FFE, DM, (unsigned char*)W2, MapId{e * DM}, scr, r, F.lane, KP8);
        }
    }
    if (moe) {
        unsigned zz = 0u; asm volatile("" : "+v"(zz));
        for (int i = F.bid * 512 + F.tid; i < N_EXP * DM * ((KP8 - D_FFE) / 16); i += F.G * 512) { const int row = i >> 3, c = i & 7; *(u32x4*)((unsigned char*)W2 + (size_t)row * KP8 + D_FFE + 16 * c) = (u32x4){zz, zz, zz, zz}; }
    }
}

__device__ __forceinline__ void phase_rope_tables(Frame& F) {
    float* C = (float*)(F.ws + WS_ROPE_C); float* S = (float*)(F.ws + WS_ROPE_S); const int* pos = (const int*)in_ptr(F, I_POS);
    for (int idx = F.bid * 512 + F.tid; idx < NTOK * 32; idx += F.G * 512) {
        const int tok = idx >> 5, i = idx & 31;
        const float invf = exp2f(-(float)(2 * i) * (13.287712379549449f / 64.f));
        const float angf = (float)pos[tok] * invf;
        const double a = (double)angf;
        const double n = rint(a * 0.15915494309189535);
        const double r = a - n * 6.283185307179586;
        const double r2 = r * r;
        double s = -1.0 / 51090942171709440000.0;
        s = s * r2 + 1.0 / 121645100408832000.0;  s = s * r2 - 1.0 / 355687428096000.0; s = s * r2 + 1.0 / 1307674368000.0; s = s * r2 - 1.0 / 6227020800.0;
        s = s * r2 + 1.0 / 39916800.0; s = s * r2 - 1.0 / 362880.0; s = s * r2 + 1.0 / 5040.0; s = s * r2 - 1.0 / 120.0; s = s * r2 + 1.0 / 6.0; s = s * r2 - 1.0; s = -s * r;
        double c = 1.0 / 1124000727777607680000.0;
        c = c * r2 - 1.0 / 2432902008176640000.0; c = c * r2 + 1.0 / 6402373705728000.0; c = c * r2 - 1.0 / 20922789888000.0; c = c * r2 + 1.0 / 87178291200.0;
        c = c * r2 - 1.0 / 479001600.0; c = c * r2 + 1.0 / 3628800.0; c = c * r2 - 1.0 / 40320.0; c = c * r2 + 1.0 / 720.0; c = c * r2 - 1.0 / 24.0; c = c * r2 + 0.5; c = 1.0 - c * r2;
        C[idx] = (float)c; S[idx] = (float)s;
    }
}

template <int MODE, bool XF32>
__device__ __forceinline__ void phase_norm(Frame& F, const void* xin, const float* gain, bool comb, int moe_slot) {
    bf16_t* HB = (bf16_t*)(F.ws + WS_H); bf16_t* XB = (bf16_t*)((unsigned char*)F.out + XB_OFF);
    const bf16_t* Y = (const bf16_t*)(F.ws + WS_Y);
    const int* TOK_ROW = (const int*)(F.ws + WS_TOK_ROW); const float* TOK_G = (const float*)(F.ws + WS_TOK_G);
    LAS float* rts = (LAS float*)F.lds;
    LAS int* te = (LAS int*)(F.lds + 32768);
    LAS float* tg = (LAS float*)(F.lds + 32768 + 1024);
    LAS int* tl = (LAS int*)(F.lds + 32768 + 2048);
    LAS int* lcnt = (LAS int*)(F.lds + 32768 + 3072);
    if (MODE == 1) {
        const float* router = INF(F, I_ROUTER) + (size_t)moe_slot * DM * N_EXP;
        for (int i = F.tid; i < DM * N_EXP; i += 512) { const int c = i >> 3, e = i & 7; rts[e * DM + c] = router[i]; }
        if (F.tid < 16) lcnt[F.tid] = 0;
        __syncthreads();
    }
    f32x4 gv[2][2];
#pragma unroll
    for (int j = 0; j < 2; ++j) { gv[j][0] = *(const f32x4*)(gain + 8 * F.lane + 512 * j); gv[j][1] = *(const f32x4*)(gain + 8 * F.lane + 512 * j + 4); }
    for (int rr = 0; rr < 16; ++rr) {
        const int rloc = F.wave * 16 + rr; const int row = F.bid * 128 + rloc;
        if (row >= NTOK) break;
        float v[2][8];
#pragma unroll
        for (int j = 0; j < 2; ++j) {
            if (XF32) { const float* xr = (const float*)xin + (size_t)row * DM + 8 * F.lane + 512 * j; const f32x4 a = *(const f32x4*)xr, b = *(const f32x4*)(xr + 4);
                v[j][0] = a[0]; v[j][1] = a[1]; v[j][2] = a[2]; v[j][3] = a[3]; v[j][4] = b[0]; v[j][5] = b[1]; v[j][6] = b[2]; v[j][7] = b[3]; }
            else { const u32x4 w = *(const u32x4*)((const bf16_t*)xin + (size_t)row * DM + 8 * F.lane + 512 * j);
                v[j][0] = bflo(w.x); v[j][1] = bfhi(w.x); v[j][2] = bflo(w.y); v[j][3] = bfhi(w.y); v[j][4] = bflo(w.z); v[j][5] = bfhi(w.z); v[j][6] = bflo(w.w); v[j][7] = bfhi(w.w); } }
        if (comb) {
            const int r0 = TOK_ROW[row * 2], r1 = TOK_ROW[row * 2 + 1]; const float g0 = TOK_G[row * 2], g1 = TOK_G[row * 2 + 1];
#pragma unroll
            for (int j = 0; j < 2; ++j) {
                const u32x4 a = *(const u32x4*)(Y + (size_t)r0 * DM + 8 * F.lane + 512 * j), b = *(const u32x4*)(Y + (size_t)r1 * DM + 8 * F.lane + 512 * j);
                v[j][0] += g0 * bflo(a.x) + g1 * bflo(b.x); v[j][1] += g0 * bfhi(a.x) + g1 * bfhi(b.x); v[j][2] += g0 * bflo(a.y) + g1 * bflo(b.y); v[j][3] += g0 * bfhi(a.y) + g1 * bfhi(b.y);
                v[j][4] += g0 * bflo(a.z) + g1 * bflo(b.z); v[j][5] += g0 * bfhi(a.z) + g1 * bfhi(b.z); v[j][6] += g0 * bflo(a.w) + g1 * bflo(b.w); v[j][7] += g0 * bfhi(a.w) + g1 * bfhi(b.w);
                if (MODE != 2) { u32x4 o; o.x = pk2(v[j][0], v[j][1]); o.y = pk2(v[j][2], v[j][3]); o.z = pk2(v[j][4], v[j][5]); o.w = pk2(v[j][6], v[j][7]); *(u32x4*)(XB + (size_t)row * DM + 8 * F.lane + 512 * j) = o; }
            }
        }
        float ss = 0.f;
#pragma unroll
        for (int j = 0; j < 2; ++j)
#pragma unroll
            for (int i = 0; i < 8; ++i) ss += v[j][i] * v[j][i];
        const float rstd = rsqrtf(wave_sum(ss) * (1.f / DM) + NORM_EPS);
#pragma unroll
        for (int j = 0; j < 2; ++j)
#pragma unroll
            for (int i = 0; i < 8; ++i) v[j][i] = v[j][i] * rstd * gv[j][i >> 2][i & 3];
        if (MODE == 2) {
            float* dst = (row < NTOK / 2) ? F.out + (size_t)row * DM : (float*)(F.ws + WS_PROJ) + (size_t)(row - NTOK / 2) * DM;
#pragma unroll
            for (int j = 0; j < 2; ++j) { *(f32x4*)(dst + 8 * F.lane + 512 * j) = (f32x4){v[j][0], v[j][1], v[j][2], v[j][3]}; *(f32x4*)(dst + 8 * F.lane + 512 * j + 4) = (f32x4){v[j][4], v[j][5], v[j][6], v[j][7]}; }
        } else {
#pragma unroll
            for (int j = 0; j < 2; ++j) {
                if (MODE == 0 || MODE == 1) { u32x2 o; o.x = pk4_fp8(v[j][0], v[j][1], v[j][2], v[j][3]); o.y = pk4_fp8(v[j][4], v[j][5], v[j][6], v[j][7]); *(u32x2*)((unsigned char*)HB + (size_t)row * DM + 8 * F.lane + 512 * j) = o; }
                else { u32x4 o; o.x = pk2(v[j][0], v[j][1]); o.y = pk2(v[j][2], v[j][3]); o.z = pk2(v[j][4], v[j][5]); o.w = pk2(v[j][6], v[j][7]); *(u32x4*)(HB + (size_t)row * DM + 8 * F.lane + 512 * j) = o; } }
        }
        if (MODE == 1) {
            float lg[8];
#pragma unroll
            for (int e = 0; e < 8; ++e) { float a = 0.f;
#pragma unroll
                for (int j = 0; j < 2; ++j) { const f32x4 w0 = *(const LAS f32x4*)(rts + e * DM + 8 * F.lane + 512 * j), w1 = *(const LAS f32x4*)(rts + e * DM + 8 * F.lane + 512 * j + 4);
                    a += (v[j][0] * w0[0] + v[j][1] * w0[1]) + (v[j][2] * w0[2] + v[j][3] * w0[3]) + (v[j][4] * w1[0] + v[j][5] * w1[1]) + (v[j][6] * w1[2] + v[j][7] * w1[3]); }
                lg[e] = wave_sum(a); }
            int i0 = 0; float v0 = lg[0];
#pragma unroll
            for (int e = 1; e < 8; ++e) if (lg[e] > v0) { v0 = lg[e]; i0 = e; }
            int i1 = -1; float v1 = -3.0e38f;
#pragma unroll
            for (int e = 0; e < 8; ++e) if (e != i0 && lg[e] > v1) { v1 = lg[e]; i1 = e; }
            const float g0 = 1.f / (1.f + __expf(v1 - v0));
            if (F.lane == 0) { te[rloc * 2] = i0; te[rloc * 2 + 1] = i1; tg[rloc * 2] = g0; tg[rloc * 2 + 1] = 1.f - g0; }
        }
    }
    if (MODE == 1) {
        __syncthreads();
        int e = 0, li = 0;
        if (F.tid < 256) { e = te[F.tid]; li = atomicAdd((int*)&lcnt[e], 1); tl[F.tid] = li; }
        __syncthreads();
        if (F.tid < 8) lcnt[8 + F.tid] = (int)atomicAdd(F.ctl + CW_MOECNT + 64 * moe_slot + F.tid, (unsigned)lcnt[F.tid]);
        __syncthreads();
        if (F.tid < 256) {
            const int tok = F.bid * 128 + (F.tid >> 1), k = F.tid & 1;
            ((int*)(F.ws + WS_TOK_E))[tok * 2 + k] = e;
            ((int*)(F.ws + WS_TOK_SLOT))[tok * 2 + k] = lcnt[8 + e] + li;
            ((float*)(F.ws + WS_TOK_G))[tok * 2 + k] = tg[F.tid];
        }
    }
}
constexpr int NL_PITCH = 1032;
template <bool XF32, bool COMB>
__device__ __forceinline__ void phase_norm_lr(Frame& F, const void* xin, const float* gain, int l) {
    bf16_t* HB = (bf16_t*)(F.ws + WS_H); bf16_t* XB = (bf16_t*)((unsigned char*)F.out + XB_OFF); bf16_t* PROJ = (bf16_t*)(F.ws + WS_PROJ);
    const bf16_t* Y = (const bf16_t*)(F.ws + WS_Y);
    const int* TOK_ROW = (const int*)(F.ws + WS_TOK_ROW); const float* TOK_G = (const float*)(F.ws + WS_TOK_G);
    LAS bf16_t* WL = (LAS bf16_t*)F.lds;
    LAS float* GL = (LAS float*)(F.lds + 16 * NL_PITCH * 2);
    __syncthreads();
    { const float* wl = INF(F, I_W_IN) + (size_t)l * DM * IN_COLS + 1280;
#pragma unroll 1
      for (int c = F.tid; c < DM; c += 512) { const float* p = wl + (size_t)c * IN_COLS;
          const f32x4 a = *(const f32x4*)p, b = *(const f32x4*)(p + 4), cc = *(const f32x4*)(p + 8), d = *(const f32x4*)(p + 12);
#pragma unroll
          for (int j = 0; j < 4; ++j) { WL[j * NL_PITCH + c] = f2bf(a[j]); WL[(4 + j) * NL_PITCH + c] = f2bf(b[j]); WL[(8 + j) * NL_PITCH + c] = f2bf(cc[j]); WL[(12 + j) * NL_PITCH + c] = f2bf(d[j]); }
          GL[c] = gain[c]; } }
    __syncthreads();
    const int r16 = F.lane & 15, kq = F.lane >> 4;
    const int row = F.bid * 128 + F.wave * 16 + r16;
    u32x4 xs[32]; float ss = 0.f, sb = 0.f;
    if (XF32) {
        const float* xr = (const float*)xin + (size_t)row * DM + 8 * kq;
#pragma unroll
        for (int s = 0; s < 32; ++s) { const f32x4 a = *(const f32x4*)(xr + 32 * s), b = *(const f32x4*)(xr + 32 * s + 4);
            ss = __builtin_fmaf(a[0], a[0], ss); sb = __builtin_fmaf(a[1], a[1], sb); ss = __builtin_fmaf(a[2], a[2], ss); sb = __builtin_fmaf(a[3], a[3], sb); ss = __builtin_fmaf(b[0], b[0], ss); sb = __builtin_fmaf(b[1], b[1], sb); ss = __builtin_fmaf(b[2], b[2], ss); sb = __builtin_fmaf(b[3], b[3], sb);
            xs[s].x = pg8::cvt_pk_c(a[0], a[1]); xs[s].y = pg8::cvt_pk_c(a[2], a[3]); xs[s].z = pg8::cvt_pk_c(b[0], b[1]); xs[s].w = pg8::cvt_pk_c(b[2], b[3]);
            if ((s & 7) == 7) __builtin_amdgcn_sched_barrier(0); }
    } else if (!COMB) {
        const bf16_t* xr = (const bf16_t*)xin + (size_t)row * DM + 8 * kq;
#pragma unroll
        for (int s = 0; s < 32; ++s) xs[s] = *(const u32x4*)(xr + 32 * s);
#pragma unroll
        for (int s = 0; s < 32; ++s) { const u32x4 w = xs[s];
            ss = __builtin_fmaf(bflo(w.x), bflo(w.x), ss); sb = __builtin_fmaf(bfhi(w.x), bfhi(w.x), sb); ss = __builtin_fmaf(bflo(w.y), bflo(w.y), ss); sb = __builtin_fmaf(bfhi(w.y), bfhi(w.y), sb);
            ss = __builtin_fmaf(bflo(w.z), bflo(w.z), ss); sb = __builtin_fmaf(bfhi(w.z), bfhi(w.z), sb); ss = __builtin_fmaf(bflo(w.w), bflo(w.w), ss); sb = __builtin_fmaf(bfhi(w.w), bfhi(w.w), sb); }
    } else {
        const int r0 = TOK_ROW[row * 2], r1 = TOK_ROW[row * 2 + 1]; const float g0 = TOK_G[row * 2], g1 = TOK_G[row * 2 + 1];
        const bf16_t* xr = (const bf16_t*)xin + (size_t)row * DM + 8 * kq; const bf16_t* ya = Y + (size_t)r0 * DM + 8 * kq; const bf16_t* yb = Y + (size_t)r1 * DM + 8 * kq;
        bf16_t* xo = XB + (size_t)row * DM + 8 * kq;
#pragma unroll
        for (int s = 0; s < 32; ++s) { const u32x4 w = *(const u32x4*)(xr + 32 * s), a = *(const u32x4*)(ya + 32 * s), b = *(const u32x4*)(yb + 32 * s);
            float v[8];
            v[0] = bflo(w.x) + g0 * bflo(a.x) + g1 * bflo(b.x); v[1] = bfhi(w.x) + g0 * bfhi(a.x) + g1 * bfhi(b.x); v[2] = bflo(w.y) + g0 * bflo(a.y) + g1 * bflo(b.y); v[3] = bfhi(w.y) + g0 * bfhi(a.y) + g1 * bfhi(b.y);
            v[4] = bflo(w.z) + g0 * bflo(a.z) + g1 * bflo(b.z); v[5] = bfhi(w.z) + g0 * bfhi(a.z) + g1 * bfhi(b.z); v[6] = bflo(w.w) + g0 * bflo(a.w) + g1 * bflo(b.w); v[7] = bfhi(w.w) + g0 * bfhi(a.w) + g1 * bfhi(b.w);
#pragma unroll
            for (int j = 0; j < 8; j += 2) { ss = __builtin_fmaf(v[j], v[j], ss); sb = __builtin_fmaf(v[j + 1], v[j + 1], sb); }
            xs[s].x = pg8::cvt_pk_c(v[0], v[1]); xs[s].y = pg8::cvt_pk_c(v[2], v[3]); xs[s].z = pg8::cvt_pk_c(v[4], v[5]); xs[s].w = pg8::cvt_pk_c(v[6], v[7]);
            *(u32x4*)(xo + 32 * s) = xs[s];
            if ((s & 1) == 1) __builtin_amdgcn_sched_barrier(0); }
    }
    ss += sb; ss += __shfl_xor(ss, 16); ss += __shfl_xor(ss, 32);
    const float rstd = rsqrtf(ss * (1.f / DM) + NORM_EPS);
#pragma unroll
    for (int s = 0; s < 32; ++s) asm volatile("" : "+v"(xs[s].x), "+v"(xs[s].y), "+v"(xs[s].z), "+v"(xs[s].w));
    f32x4 acc = {0.f, 0.f, 0.f, 0.f};
    bf16_t* ho = HB + (size_t)row * DM + 8 * kq;
#pragma unroll
    for (int s = 0; s < 32; ++s) { const int c0 = 32 * s + 8 * kq; const f32x4 ga = *(const LAS f32x4*)(GL + c0), gb = *(const LAS f32x4*)(GL + c0 + 4); const u32x4 w = xs[s];
        u32x4 hw; hw.x = pg8::cvt_pk_c(bflo(w.x) * rstd * ga[0], bfhi(w.x) * rstd * ga[1]); hw.y = pg8::cvt_pk_c(bflo(w.y) * rstd * ga[2], bfhi(w.y) * rstd * ga[3]);
        hw.z = pg8::cvt_pk_c(bflo(w.z) * rstd * gb[0], bfhi(w.z) * rstd * gb[1]); hw.w = pg8::cvt_pk_c(bflo(w.w) * rstd * gb[2], bfhi(w.w) * rstd * gb[3]);
        *(u32x4*)(ho + 32 * s) = hw;
        acc = __builtin_amdgcn_mfma_f32_16x16x32_bf16(*(const LAS bf16x8*)(WL + r16 * NL_PITCH + c0), __builtin_bit_cast(bf16x8, hw), acc, 0, 0, 0);
        if ((s & 3) == 3) __builtin_amdgcn_sched_barrier(0); }
    { u32x2 o; o.x = pg8::cvt_pk_c(acc[0], acc[1]); o.y = pg8::cvt_pk_c(acc[2], acc[3]); *(u32x2*)(PROJ + (size_t)row * NPROJ + PB_LR + 4 * kq) = o; }
}
struct FinalRows { u32x4 xs[32]; float rstd; };
__device__ __forceinline__ void final_load(Frame& F, const float* gain, FinalRows& R) {
    const bf16_t* XB = (const bf16_t*)((unsigned char*)F.out + XB_OFF); const bf16_t* Y = (const bf16_t*)(F.ws + WS_Y);
    const int* TOK_ROW = (const int*)(F.ws + WS_TOK_ROW); const float* TOK_G = (const float*)(F.ws + WS_TOK_G);
    LAS float* GL = (LAS float*)F.lds;
    __syncthreads();
    for (int c = F.tid; c < DM; c += 512) GL[c] = gain[c];
    const int r16 = F.lane & 15, kq = F.lane >> 4;
    const int row = F.bid * 128 + F.wave * 16 + r16;
    float ss = 0.f, sb = 0.f;
    const int r0 = TOK_ROW[row * 2], r1 = TOK_ROW[row * 2 + 1]; const float g0 = TOK_G[row * 2], g1 = TOK_G[row * 2 + 1];
    const bf16_t* xr = XB + (size_t)row * DM + 8 * kq; const bf16_t* ya = Y + (size_t)r0 * DM + 8 * kq; const bf16_t* yb = Y + (size_t)r1 * DM + 8 * kq;
#pragma unroll
    for (int s = 0; s < 32; ++s) { const u32x4 w = *(const u32x4*)(xr + 32 * s), a = *(const u32x4*)(ya + 32 * s), b = *(const u32x4*)(yb + 32 * s);
        float v[8];
        v[0] = bflo(w.x) + g0 * bflo(a.x) + g1 * bflo(b.x); v[1] = bfhi(w.x) + g0 * bfhi(a.x) + g1 * bfhi(b.x); v[2] = bflo(w.y) + g0 * bflo(a.y) + g1 * bflo(b.y); v[3] = bfhi(w.y) + g0 * bfhi(a.y) + g1 * bfhi(b.y);
        v[4] = bflo(w.z) + g0 * bflo(a.z) + g1 * bflo(b.z); v[5] = bfhi(w.z) + g0 * bfhi(a.z) + g1 * bfhi(b.z); v[6] = bflo(w.w) + g0 * bflo(a.w) + g1 * bflo(b.w); v[7] = bfhi(w.w) + g0 * bfhi(a.w) + g1 * bfhi(b.w);
#pragma unroll
        for (int j = 0; j < 8; j += 2) { ss = __builtin_fmaf(v[j], v[j], ss); sb = __builtin_fmaf(v[j + 1], v[j + 1], sb); }
        R.xs[s].x = pg8::cvt_pk_c(v[0], v[1]); R.xs[s].y = pg8::cvt_pk_c(v[2], v[3]); R.xs[s].z = pg8::cvt_pk_c(v[4], v[5]); R.xs[s].w = pg8::cvt_pk_c(v[6], v[7]);
        asm volatile("" : "+v"(ss), "+v"(sb));
        if ((s & 3) == 3) __builtin_amdgcn_sched_barrier(0); }
    ss += sb; ss += __shfl_xor(ss, 16); ss += __shfl_xor(ss, 32);
    R.rstd = rsqrtf(ss * (1.f / DM) + NORM_EPS);
#pragma unroll
    for (int s = 0; s < 32; ++s) asm volatile("" : "+v"(R.xs[s].x), "+v"(R.xs[s].y), "+v"(R.xs[s].z), "+v"(R.xs[s].w));
}
__device__ __forceinline__ void final_store(Frame& F, const FinalRows& R) {
    const LAS float* GL = (const LAS float*)F.lds;
    const int r16 = F.lane & 15, kq = F.lane >> 4;
    const int row = F.bid * 128 + F.wave * 16 + r16;
    float* po = F.out + (size_t)row * DM + 8 * kq; const float rstd = R.rstd;
#pragma unroll
    for (int s = 0; s < 32; ++s) { const int c0 = 32 * s + 8 * kq; const f32x4 ga = *(const LAS f32x4*)(GL + c0), gb = *(const LAS f32x4*)(GL + c0 + 4); const u32x4 w = R.xs[s];
        *(f32x4*)(po + 32 * s) = (f32x4){bflo(w.x) * rstd * ga[0], bfhi(w.x) * rstd * ga[1], bflo(w.y) * rstd * ga[2], bfhi(w.y) * rstd * ga[3]};
        *(f32x4*)(po + 32 * s + 4) = (f32x4){bflo(w.z) * rstd * gb[0], bfhi(w.z) * rstd * gb[1], bflo(w.w) * rstd * gb[2], bfhi(w.w) * rstd * gb[3]};
        if ((s & 3) == 3) __builtin_amdgcn_sched_barrier(0); }
}
__device__ __forceinline__ void phase_final_copy(Frame& F) {
    const f32x4* src = (const f32x4*)(F.ws + WS_PROJ); f32x4* dst = (f32x4*)(F.out + (size_t)(NTOK / 2) * DM);
    for (int i = F.bid * 512 + F.tid; i < NTOK / 2 * DM / 4; i += F.G * 512) dst[i] = src[i];
}

__device__ __forceinline__ void moe_bases(const unsigned* cnt, int (&tb)[9]) {
    tb[0] = 0;
#pragma unroll
    for (int e = 0; e < 8; ++e) tb[e + 1] = tb[e] + __builtin_amdgcn_readfirstlane((int)((__hip_atomic_load(cnt + e, __ATOMIC_RELAXED, __HIP_MEMORY_SCOPE_AGENT) + 255u) >> 8));
}
__device__ __forceinline__ void phase_moe_map(Frame& F, int moe_slot) {
    int tb[9]; moe_bases(F.ctl + CW_MOECNT + 64 * moe_slot, tb);
    const int* TE = (const int*)(F.ws + WS_TOK_E); const int* TS = (const int*)(F.ws + WS_TOK_SLOT); int* TR = (int*)(F.ws + WS_TOK_ROW); int* RM = (int*)(F.ws + WS_ROWMAP);
    for (int a = F.bid * 512 + F.tid; a < NTOK * 2; a += F.G * 512) {
        const int e = TE[a]; int base = 0;
#pragma unroll
        for (int j = 0; j < 8; ++j) base = (e == j) ? tb[j] : base;
        const int row = base * 256 + TS[a]; TR[a] = row; RM[row] = a >> 1;
    }
    { unsigned zz = 0u; asm volatile("" : "+v"(zz)); unsigned char* A8 = F.ws + WS_PROJ;
      for (int i = F.bid * 512 + F.tid; i < tb[8] * 256 * ((KP8 - D_FFE) / 16); i += F.G * 512) { const int row = i >> 3, c = i & 7; *(u32x4*)(A8 + (size_t)row * KP8 + D_FFE + 16 * c) = (u32x4){zz, zz, zz, zz}; } }
    for (int i = F.bid * 512 + F.tid; i < N_EXP * 256; i += F.G * 512) {
        const int e = i >> 8, j = i & 255; int b0 = 0, b1 = 0;
#pragma unroll
        for (int q = 0; q < 8; ++q) { b0 = (e == q) ? tb[q] : b0; b1 = (e == q) ? tb[q + 1] : b1; }
        const int cnt = (int)__hip_atomic_load(F.ctl + CW_MOECNT + 64 * moe_slot + e, __ATOMIC_RELAXED, __HIP_MEMORY_SCOPE_AGENT);
        const int row = b0 * 256 + cnt + j; if (row < b1 * 256) RM[row] = 0;
    }
}
__device__ __forceinline__ void swa_unit(Frame& F, int l, int unit) {
    const bf16_t* P = (const bf16_t*)(F.ws + WS_PROJ); bf16_t* MIX = (bf16_t*)(F.ws + WS_MIX);
    const float* RC = (const float*)(F.ws + WS_ROPE_C); const float* RS = (const float*)(F.ws + WS_ROPE_S);
    const int qblk = unit & 31, kvh = (unit >> 5) & 1, b = unit >> 6;
    LAS float* Ks = (LAS float*)F.lds;
    LAS float* Vs = (LAS float*)(F.lds + 65536);
    const int tok0 = b * SEQ + qblk * 128;
    __syncthreads();
#pragma unroll 1
    for (int it = 0; it < 16; ++it) {
        const int idx = it * 512 + F.tid, j = idx >> 5, d = idx & 31; const int pos = qblk * 128 - 128 + j;
        float o1 = 0.f, o2 = 0.f;
        if (pos >= 0) { const int tok = b * SEQ + pos; const bf16_t* kp = P + (size_t)tok * NPROJ + PA_K + kvh * 64;
            const float k1 = bf2f(kp[d]), k2 = bf2f(kp[d + 32]), c = RC[tok * 32 + d], s = RS[tok * 32 + d]; o1 = k1 * c - k2 * s; o2 = k2 * c + k1 * s; }
        Ks[j * 64 + d] = o1; Ks[j * 64 + d + 32] = o2;
    }
#pragma unroll 1
    for (int it = 0; it < 32; ++it) {
        const int idx = it * 512 + F.tid, j = idx >> 6, d = idx & 63; const int pos = qblk * 128 - 128 + j;
        Vs[idx] = (pos >= 0) ? bf2f(P[(size_t)(b * SEQ + pos) * NPROJ + PA_V + kvh * 64 + d]) : 0.f;
    }
    const int part = F.tid >> 8, qv = F.tid & 255, g = qv >> 7, i = qv & 127, hq = kvh * 2 + g;
    const int tok = tok0 + i;
    float q[64];
    { const bf16_t* qp = P + (size_t)tok * NPROJ + PA_Q + hq * 64;
#pragma unroll
      for (int d = 0; d < 32; ++d) { const float q1 = bf2f(qp[d]), q2 = bf2f(qp[d + 32]), c = RC[tok * 32 + d], s = RS[tok * 32 + d]; q[d] = (q1 * c - q2 * s) * 0.125f; q[d + 32] = (q2 * c + q1 * s) * 0.125f; } }
    const float sink = INF(F, I_SINKS)[l * 4 + hq];
    float m = sink, lsum = (part == 0) ? 1.f : 0.f, acc[64];
#pragma unroll
    for (int d = 0; d < 64; ++d) acc[d] = 0.f;
    __syncthreads();
    for (int jj = 0; jj < 128; ++jj) {
        const int j = part * 128 + jj;
        const bool valid = (j > i) && (j <= i + 128) && (qblk > 0 || j >= 128);
        float s = 0.f;
#pragma unroll
        for (int d4 = 0; d4 < 16; ++d4) { const f32x4 kv = *(const LAS f32x4*)(Ks + j * 64 + d4 * 4); s += (q[d4 * 4] * kv[0] + q[d4 * 4 + 1] * kv[1]) + (q[d4 * 4 + 2] * kv[2] + q[d4 * 4 + 3] * kv[3]); }
        if (!valid) s = -INFINITY;
        const float mn = fmaxf(m, s), sc = __expf(m - mn), p = __expf(s - mn);
        lsum = lsum * sc + p; m = mn;
#pragma unroll
        for (int d4 = 0; d4 < 16; ++d4) { const f32x4 vv = *(const LAS f32x4*)(Vs + j * 64 + d4 * 4);
            acc[d4 * 4] = acc[d4 * 4] * sc + p * vv[0]; acc[d4 * 4 + 1] = acc[d4 * 4 + 1] * sc + p * vv[1]; acc[d4 * 4 + 2] = acc[d4 * 4 + 2] * sc + p * vv[2]; acc[d4 * 4 + 3] = acc[d4 * 4 + 3] * sc + p * vv[3]; }
    }
    __syncthreads();
    LAS float* MB = (LAS float*)F.lds;
    if (part == 1) { MB[qv * 66] = m; MB[qv * 66 + 1] = lsum;
#pragma unroll
        for (int d = 0; d < 64; ++d) MB[qv * 66 + 2 + d] = acc[d]; }
    __syncthreads();
    if (part == 0) {
        const float m1 = MB[qv * 66], l1 = MB[qv * 66 + 1]; const float M = fmaxf(m, m1), s0 = __expf(m - M), s1 = __expf(m1 - M);
        const float inv = 1.f / (lsum * s0 + l1 * s1); float ss = 0.f;
#pragma unroll
        for (int d = 0; d < 64; ++d) { acc[d] = (acc[d] * s0 + MB[qv * 66 + 2 + d] * s1) * inv; ss += acc[d] * acc[d]; }
        const float rstd = rsqrtf(ss * (1.f / 64.f) + NORM_EPS); const float* gn = INF(F, I_SWA_ON) + l * 256 + hq * 64;
        bf16_t* op = MIX + (size_t)tok * DM + hq * 64;
#pragma unroll
        for (int d8 = 0; d8 < 8; ++d8) { u32x4 w;
            w.x = pk2(acc[d8 * 8] * rstd * gn[d8 * 8], acc[d8 * 8 + 1] * rstd * gn[d8 * 8 + 1]); w.y = pk2(acc[d8 * 8 + 2] * rstd * gn[d8 * 8 + 2], acc[d8 * 8 + 3] * rstd * gn[d8 * 8 + 3]);
            w.z = pk2(acc[d8 * 8 + 4] * rstd * gn[d8 * 8 + 4], acc[d8 * 8 + 5] * rstd * gn[d8 * 8 + 5]); w.w = pk2(acc[d8 * 8 + 6] * rstd * gn[d8 * 8 + 6], acc[d8 * 8 + 7] * rstd * gn[d8 * 8 + 7]);
            *(u32x4*)(op + d8 * 8) = w; }
    }
}

__device__ __forceinline__ void sb_waveunit(Frame& F, int l, int wu) {
    const bf16_t* P = (const bf16_t*)(F.ws + WS_PROJ); bf16_t* MIX = (bf16_t*)(F.ws + WS_MIX);
    const int tb = wu & 63, h = (wu >> 6) & 3, b = wu >> 8;
    const int t0 = tb * 64, t = t0 + F.lane;
    float q[64], o[64];
    { const u32x4* qp = (const u32x4*)(P + (size_t)(b * SEQ + t) * NPROJ + PC_Q + h * 64);
#pragma unroll
      for (int d8 = 0; d8 < 8; ++d8) { const u32x4 w = qp[d8];
          q[d8 * 8] = bflo(w.x) * 0.125f; q[d8 * 8 + 1] = bfhi(w.x) * 0.125f; q[d8 * 8 + 2] = bflo(w.y) * 0.125f; q[d8 * 8 + 3] = bfhi(w.y) * 0.125f;
          q[d8 * 8 + 4] = bflo(w.z) * 0.125f; q[d8 * 8 + 5] = bfhi(w.z) * 0.125f; q[d8 * 8 + 6] = bflo(w.w) * 0.125f; q[d8 * 8 + 7] = bfhi(w.w) * 0.125f; } }
#pragma unroll
    for (int d = 0; d < 64; ++d) o[d] = 0.f;
    float R = 0.f;
    for (int s = t0 + 62; s >= 0; --s) {
        if (s < t0) { if (__all(R < -80.f)) break; }
        const size_t rowoff = (size_t)__builtin_amdgcn_readfirstlane(b * SEQ + s) * NPROJ;
        const u32x4* kp = (const u32x4*)(P + rowoff + PC_K + h * 64); const u32x4* vp = (const u32x4*)(P + rowoff + PC_V + h * 64);
        float z = 0.f;
#pragma unroll
        for (int d8 = 0; d8 < 8; ++d8) { const u32x4 w = kp[d8];
            z += (q[d8 * 8] * bflo(w.x) + q[d8 * 8 + 1] * bfhi(w.x)) + (q[d8 * 8 + 2] * bflo(w.y) + q[d8 * 8 + 3] * bfhi(w.y))
               + (q[d8 * 8 + 4] * bflo(w.z) + q[d8 * 8 + 5] * bfhi(w.z)) + (q[d8 * 8 + 6] * bflo(w.w) + q[d8 * 8 + 7] * bfhi(w.w)); }
        const bool valid = s < t;
        const float sp = softplus_f(z);
        const float p = valid ? __expf((z - sp) + R) : 0.f;
        R += valid ? -sp : 0.f;
#pragma unroll
        for (int d8 = 0; d8 < 8; ++d8) { const u32x4 w = vp[d8];
            o[d8 * 8] += p * bflo(w.x); o[d8 * 8 + 1] += p * bfhi(w.x); o[d8 * 8 + 2] += p * bflo(w.y); o[d8 * 8 + 3] += p * bfhi(w.y);
            o[d8 * 8 + 4] += p * bflo(w.z); o[d8 * 8 + 5] += p * bfhi(w.z); o[d8 * 8 + 6] += p * bflo(w.w); o[d8 * 8 + 7] += p * bfhi(w.w); }
    }
    float ss = 0.f;
#pragma unroll
    for (int d = 0; d < 64; ++d) ss += o[d] * o[d];
    const float rstd = rsqrtf(ss * (1.f / 64.f) + NORM_EPS); const float* gn = INF(F, I_SB_ON) + l * 256 + h * 64;
    bf16_t* op = MIX + (size_t)(b * SEQ + t) * DM + 512 + h * 64;
#pragma unroll
    for (int d8 = 0; d8 < 8; ++d8) { u32x4 w;
        w.x = pk2(o[d8 * 8] * rstd * gn[d8 * 8], o[d8 * 8 + 1] * rstd * gn[d8 * 8 + 1]); w.y = pk2(o[d8 * 8 + 2] * rstd * gn[d8 * 8 + 2], o[d8 * 8 + 3] * rstd * gn[d8 * 8 + 3]);
        w.z = pk2(o[d8 * 8 + 4] * rstd * gn[d8 * 8 + 4], o[d8 * 8 + 5] * rstd * gn[d8 * 8 + 5]); w.w = pk2(o[d8 * 8 + 6] * rstd * gn[d8 * 8 + 6], o[d8 * 8 + 7] * rstd * gn[d8 * 8 + 7]);
        *(u32x4*)(op + d8 * 8) = w; }
}

__device__ __forceinline__ void gla_decay_cumsum(Frame& F, int l, int b, int h, int n, LAS float* Bc) {
    const bf16_t* P = (const bf16_t*)(F.ws + WS_PROJ);
    const float* wa2 = INF(F, I_GLA_WA2) + l * 16 * 128; const float* ba = INF(F, I_GLA_BA) + l * 128;
    const int tok0 = b * SEQ + n * 64;
#pragma unroll
    for (int it = 0; it < 4; ++it) { const int idx = it * 512 + F.tid, t = idx >> 5, e = idx & 31;
        const bf16_t* lr = P + (size_t)(tok0 + t) * NPROJ + PB_LR; float a = ba[h * 32 + e];
#pragma unroll
        for (int r = 0; r < 16; ++r) a += bf2f(lr[r]) * wa2[r * 128 + h * 32 + e];
        Bc[idx] = logsigmoid_f(a) * (1.f / 16.f); }
    __syncthreads();
    if (F.tid < 32) { float c = 0.f; for (int t = 0; t < 64; ++t) { c += Bc[t * 32 + F.tid]; Bc[t * 32 + F.tid] = c; } }
    __syncthreads();
}
__device__ __forceinline__ void gla_kv_unit(Frame& F, int l, int unit) {
    const bf16_t* P = (const bf16_t*)(F.ws + WS_PROJ);
    float* KV = (float*)(F.ws + WS_GLA_KV) + (size_t)unit * 2048; float* DEC = (float*)(F.ws + WS_GLA_DEC) + unit * 32;
    const int n = unit & 63, h = (unit >> 6) & 3, b = unit >> 8, tok0 = b * SEQ + n * 64;
    LAS float* Bc = (LAS float*)F.lds; LAS float* Ke = (LAS float*)(F.lds + 8192); LAS float* Vs = (LAS float*)(F.lds + 16384);
    __syncthreads();
    gla_decay_cumsum(F, l, b, h, n, Bc);
#pragma unroll
    for (int it = 0; it < 4; ++it) { const int idx = it * 512 + F.tid, s = idx >> 5, e = idx & 31;
        Ke[idx] = bf2f(P[(size_t)(tok0 + s) * NPROJ + PB_K + h * 32 + e]) * __expf(Bc[63 * 32 + e] - Bc[idx]); }
#pragma unroll
    for (int it = 0; it < 8; ++it) { const int idx = it * 512 + F.tid, s = idx >> 6, f = idx & 63; Vs[idx] = bf2f(P[(size_t)(tok0 + s) * NPROJ + PB_V + h * 64 + f]); }
    __syncthreads();
    { const int e = F.tid >> 4, f0 = (F.tid & 15) * 4; f32x4 a = {0.f, 0.f, 0.f, 0.f};
      for (int s = 0; s < 64; ++s) { const float ke = Ke[s * 32 + e]; const f32x4 vv = *(const LAS f32x4*)(Vs + s * 64 + f0); a += ke * vv; }
      *(f32x4*)(KV + e * 64 + f0) = a; }
    if (F.tid < 32) DEC[F.tid] = __expf(Bc[63 * 32 + F.tid]);
}
__device__ __forceinline__ void gla_scan(Frame& F, int gtid) {
    const int f = gtid & 63, e = (gtid >> 6) & 31, bh = gtid >> 11;
    float* KV = (float*)(F.ws + WS_GLA_KV) + (size_t)bh * 64 * 2048 + e * 64 + f; const float* DEC = (const float*)(F.ws + WS_GLA_DEC) + bh * 64 * 32 + e;
    float st = 0.f, kv[64], d[64];
#pragma unroll
    for (int n = 0; n < 64; ++n) { kv[n] = KV[(size_t)n * 2048]; d[n] = DEC[n * 32]; }
#pragma unroll
    for (int n = 0; n < 64; ++n) { KV[(size_t)n * 2048] = st; st = d[n] * st + kv[n]; }
}
__device__ __forceinline__ void gla_out_unit(Frame& F, int l, int unit) {
    const bf16_t* P = (const bf16_t*)(F.ws + WS_PROJ); bf16_t* MIX = (bf16_t*)(F.ws + WS_MIX);
    const float* SP = (const float*)(F.ws + WS_GLA_KV) + (size_t)unit * 2048;
    const int n = unit & 63, h = (unit >> 6) & 3, b = unit >> 8, tok0 = b * SEQ + n * 64;
    LAS float* Bc = (LAS float*)F.lds; LAS float* Qe = (LAS float*)(F.lds + 8192); LAS float* Ke = (LAS float*)(F.lds + 16384); LAS float* Qb = (LAS float*)(F.lds + 25088);
    LAS float* Vs = (LAS float*)(F.lds + 33792); LAS float* Ss = (LAS float*)(F.lds + 50176); LAS float* At = (LAS float*)(F.lds + 58368);
    __syncthreads();
    gla_decay_cumsum(F, l, b, h, n, Bc);
    const float qs = 0.17677669529663687f;
#pragma unroll
    for (int it = 0; it < 4; ++it) { const int idx = it * 512 + F.tid, t = idx >> 5, e = idx & 31;
        const float bt = Bc[idx], br = Bc[31 * 32 + e];
        const float qv = bf2f(P[(size_t)(tok0 + t) * NPROJ + PB_Q + h * 32 + e]) * qs, kv = bf2f(P[(size_t)(tok0 + t) * NPROJ + PB_K + h * 32 + e]);
        Qe[idx] = qv * __expf(bt - br); Ke[t * 33 + e] = kv * __expf(br - bt); Qb[idx] = qv * __expf(bt); }
#pragma unroll
    for (int it = 0; it < 8; ++it) { const int idx = it * 512 + F.tid, s = idx >> 6, f = idx & 63; Vs[idx] = bf2f(P[(size_t)(tok0 + s) * NPROJ + PB_V + h * 64 + f]); }
#pragma unroll
    for (int it = 0; it < 4; ++it) { const int idx = it * 512 + F.tid; Ss[idx] = SP[idx]; }
    __syncthreads();
#pragma unroll
    for (int it = 0; it < 8; ++it) { const int idx = it * 512 + F.tid, t = idx >> 6, s = idx & 63; float a = 0.f;
        if (s <= t) {
#pragma unroll
            for (int e = 0; e < 32; ++e) a += Qe[t * 32 + e] * Ke[s * 33 + e]; }
        At[t * 65 + s] = a; }
    __syncthreads();
    { const int t = F.tid >> 3, f0 = (F.tid & 7) * 8; float o[8];
#pragma unroll
      for (int j = 0; j < 8; ++j) o[j] = 0.f;
      for (int s = 0; s <= t; ++s) { const float a = At[t * 65 + s]; const f32x4 v0 = *(const LAS f32x4*)(Vs + s * 64 + f0), v1 = *(const LAS f32x4*)(Vs + s * 64 + f0 + 4);
          o[0] += a * v0[0]; o[1] += a * v0[1]; o[2] += a * v0[2]; o[3] += a * v0[3]; o[4] += a * v1[0]; o[5] += a * v1[1]; o[6] += a * v1[2]; o[7] += a * v1[3]; }
#pragma unroll
      for (int e = 0; e < 32; ++e) { const float a = Qb[t * 32 + e]; const f32x4 v0 = *(const LAS f32x4*)(Ss + e * 64 + f0), v1 = *(const LAS f32x4*)(Ss + e * 64 + f0 + 4);
          o[0] += a * v0[0]; o[1] += a * v0[1]; o[2] += a * v0[2]; o[3] += a * v0[3]; o[4] += a * v1[0]; o[5] += a * v1[1]; o[6] += a * v1[2]; o[7] += a * v1[3]; }
      float ss = 0.f;
#pragma unroll
      for (int j = 0; j < 8; ++j) ss += o[j] * o[j];
      ss += __shfl_xor(ss, 1); ss += __shfl_xor(ss, 2); ss += __shfl_xor(ss, 4);
      const float rstd = rsqrtf(ss * (1.f / 64.f) + NORM_EPS); const float* gn = INF(F, I_GLA_ON) + l * 256 + h * 64 + f0;
      const u32x4 gw = *(const u32x4*)(P + (size_t)(tok0 + t) * NPROJ + PB_G + h * 64 + f0);
      float gb[8] = {bflo(gw.x), bfhi(gw.x), bflo(gw.y), bfhi(gw.y), bflo(gw.z), bfhi(gw.z), bflo(gw.w), bfhi(gw.w)};
      float r[8];
#pragma unroll
      for (int j = 0; j < 8; ++j) r[j] = o[j] * rstd * gn[j] * (gb[j] * sigmoid_f(gb[j]));
      u32x4 w; w.x = pk2(r[0], r[1]); w.y = pk2(r[2], r[3]); w.z = pk2(r[4], r[5]); w.w = pk2(r[6], r[7]);
      *(u32x4*)(MIX + (size_t)(tok0 + t) * DM + 256 + h * 64 + f0) = w; }
}

template <int CTRL> __device__ __forceinline__ float dpp_add(float v) { return v + __builtin_bit_cast(float, __builtin_amdgcn_update_dpp(0, __builtin_bit_cast(int, v), CTRL, 0xf, 0xf, false)); }
__device__ __forceinline__ float sum16(float v) { v = dpp_add<0xB1>(v); v = dpp_add<0x4E>(v); v = dpp_add<0x141>(v); v = dpp_add<0x140>(v); return v; }
typedef float f32x16 __attribute__((ext_vector_type(16)));
__device__ __forceinline__ float other_half(float x, int hh) {
    auto t = __builtin_amdgcn_permlane32_swap(__float_as_uint(x), __float_as_uint(x), false, false);
    return __uint_as_float(hh ? t[0] : t[1]);
}
__device__ __forceinline__ unsigned cvt_pk(float lo, float hi) { unsigned r; asm volatile("v_cvt_pk_bf16_f32 %0, %1, %2" : "=v"(r) : "v"(lo), "v"(hi)); return r; }
__device__ __forceinline__ bf16x8 pack8(float p0, float p1, float p2, float p3, float p4, float p5, float p6, float p7) {
    u32x4 w; w.x = cvt_pk(p0, p1); w.y = cvt_pk(p2, p3); w.z = cvt_pk(p4, p5); w.w = cvt_pk(p6, p7); return __builtin_bit_cast(bf16x8, w);
}
#define PACK8(a, o) pack8(a[(o)], a[(o) + 1], a[(o) + 2], a[(o) + 3], a[(o) + 4], a[(o) + 5], a[(o) + 6], a[(o) + 7])
__device__ __forceinline__ bf16x8 load_vt(const bf16_t* P, size_t vrow0, int vcol, int db, int ko, int r, int hh) {
    const bf16_t* p = P + (vrow0 + 32 * db + r) * NPROJ + vcol + ko + 4 * hh;
    const u32x2 a = *(const u32x2*)p, b = *(const u32x2*)(p + 8);
    u32x4 w; w.x = a.x; w.y = a.y; w.z = b.x; w.w = b.y; return __builtin_bit_cast(bf16x8, w);
}
__device__ __forceinline__ void store_ot(bf16_t* orow, const f32x16& o0, const f32x16& o1, float rs, const float* gn, int hh) {
#pragma unroll
    for (int db = 0; db < 2; ++db)
#pragma unroll
        for (int g4 = 0; g4 < 4; ++g4) { const int d = 32 * db + 8 * g4 + 4 * hh; const f32x4 gv = *(const f32x4*)(gn + d);
            const f32x16& o = db ? o1 : o0;
            u32x2 w; w.x = cvt_pk(o[4 * g4] * rs * gv[0], o[4 * g4 + 1] * rs * gv[1]); w.y = cvt_pk(o[4 * g4 + 2] * rs * gv[2], o[4 * g4 + 3] * rs * gv[3]);
            *(u32x2*)(orow + d) = w; }
}

__device__ __forceinline__ void attn_prep_block(Frame& F, int blk) {
    bf16_t* P = (bf16_t*)(F.ws + WS_PROJ);
    const float* RC = (const float*)(F.ws + WS_ROPE_C); const float* RS = (const float*)(F.ws + WS_ROPE_S);
    LAS unsigned* T = (LAS unsigned*)F.lds;
    const int tok0 = blk * 64;
    for (int it = 0; it < 24; ++it) { const int idx = it * 512 + F.tid, d = idx & 31, hd = (idx >> 5) % 6, tt = idx / 192; const int tok = tok0 + tt;
        bf16_t* p = P + (size_t)tok * NPROJ + (hd < 4 ? PA_Q + hd * 64 : PA_K + (hd - 4) * 64); const float sc = hd < 4 ? 0.18033688011112042f : 1.f;
        const float x1 = bf2f(p[d]), x2 = bf2f(p[d + 32]), c = RC[tok * 32 + d], s = RS[tok * 32 + d];
        p[d] = f2bf((x1 * c - x2 * s) * sc); p[d + 32] = f2bf((x2 * c + x1 * s) * sc); }
    for (int vt = 0; vt < 6; ++vt) {
        const int vcol = vt < 2 ? PA_V + vt * 64 : PC_V + (vt - 2) * 64;
        __syncthreads();
        { const int tt = F.tid >> 3, c8 = F.tid & 7; const u32x4 w = *(const u32x4*)(P + (size_t)(tok0 + tt) * NPROJ + vcol + c8 * 8);
          T[tt * 33 + c8 * 4] = w.x; T[tt * 33 + c8 * 4 + 1] = w.y; T[tt * 33 + c8 * 4 + 2] = w.z; T[tt * 33 + c8 * 4 + 3] = w.w; }
        __syncthreads();
        { const int d = F.tid >> 3, t8 = F.tid & 7; unsigned e[8];
#pragma unroll
          for (int i = 0; i < 8; ++i) { const unsigned w = T[(t8 * 8 + i) * 33 + (d >> 1)]; e[i] = (d & 1) ? (w >> 16) : (w & 0xffffu); }
          u32x4 o; o.x = e[0] | (e[1] << 16); o.y = e[2] | (e[3] << 16); o.z = e[4] | (e[5] << 16); o.w = e[6] | (e[7] << 16);
          *(u32x4*)(P + (size_t)(tok0 + d) * NPROJ + vcol + t8 * 8) = o; }
    }
}

__device__ __forceinline__ void sb_task(Frame& F, int l, int task) {
    const bf16_t* P = (const bf16_t*)(F.ws + WS_PROJ); bf16_t* MIX = (bf16_t*)(F.ws + WS_MIX);
    const int qb = task & 127, h = (task >> 7) & 3, b = task >> 9;
    const int q0 = qb * 32, r = F.lane & 31, hh = F.lane >> 5, t = q0 + r;
    const size_t rowb = (size_t)b * SEQ;
    bf16x8 qf[4];
    { const bf16_t* qp = P + (rowb + t) * NPROJ + PC_Q + h * 64 + 8 * hh;
#pragma unroll
      for (int s = 0; s < 4; ++s) qf[s] = *(const bf16x8*)(qp + 16 * s); }
    f32x16 o0, o1;
#pragma unroll
    for (int i = 0; i < 16; ++i) { o0[i] = 0.f; o1[i] = 0.f; }
    float R = 0.f;
    bf16x8 kf[2][4];
#define SB_LOADK(kt_) do { _Pragma("unroll") for (int kb = 0; kb < 2; ++kb) { const bf16_t* kp = P + (rowb + 64 * (kt_) + 32 * kb + r) * NPROJ + PC_K + h * 64 + 8 * hh; \
        _Pragma("unroll") for (int s = 0; s < 4; ++s) kf[kb][s] = *(const bf16x8*)(kp + 16 * s); } } while (0)
    SB_LOADK((q0 + 30) >> 6);
    for (int kt = (q0 + 30) >> 6; kt >= 0; --kt) {
        const size_t krow0 = rowb + 64 * kt;
        bf16x8 vf[2][2][2];
#pragma unroll
        for (int kb = 0; kb < 2; ++kb)
#pragma unroll
            for (int s = 0; s < 2; ++s) { vf[0][kb][s] = load_vt(P, krow0, PC_V + h * 64, 0, 32 * kb + 16 * s, r, hh); vf[1][kb][s] = load_vt(P, krow0, PC_V + h * 64, 1, 32 * kb + 16 * s, r, hh); }
        __builtin_amdgcn_sched_barrier(0);
        f32x16 st[2];
#pragma unroll
        for (int kb = 0; kb < 2; ++kb) { f32x16 a;
#pragma unroll
            for (int i = 0; i < 16; ++i) a[i] = 0.f;
#pragma unroll
            for (int s = 0; s < 4; ++s) a = __builtin_amdgcn_mfma_f32_32x32x16_bf16(kf[kb][s], qf[s], a, 0, 0, 0);
            st[kb] = a; }
        bf16x8 kn[2][4];
        { const int ktn = kt > 0 ? kt - 1 : 0;
#pragma unroll
          for (int kb = 0; kb < 2; ++kb) { const bf16_t* kp = P + (rowb + 64 * ktn + 32 * kb + r) * NPROJ + PC_K + h * 64 + 8 * hh;
#pragma unroll
              for (int s = 0; s < 4; ++s) kn[kb][s] = *(const bf16x8*)(kp + 16 * s); } }
        float Rb = R;
#pragma unroll
        for (int kb = 1; kb >= 0; --kb) {
            float lv[16], zz[16], p[16];
#pragma unroll
            for (int i = 0; i < 16; ++i) { const int key = 64 * kt + 32 * kb + (i & 3) + 8 * (i >> 2) + 4 * hh; const float z = st[kb][i] * 0.18033688011112042f; const bool valid = key < t;
                const float sp = fmaxf(z, 0.f) + __builtin_amdgcn_logf(1.f + __builtin_amdgcn_exp2f(-fabsf(z))); lv[i] = valid ? -sp : 0.f; zz[i] = valid ? (z - sp) : -INFINITY; }
            float gown[4], suf[16];
#pragma unroll
            for (int g = 0; g < 4; ++g) { const float s3 = lv[4 * g + 3], s2 = s3 + lv[4 * g + 2], s1 = s2 + lv[4 * g + 1]; gown[g] = s1 + lv[4 * g];
                suf[4 * g + 3] = 0.f; suf[4 * g + 2] = s3; suf[4 * g + 1] = s2; suf[4 * g] = s1; }
            float run = 0.f, above[4];
#pragma unroll
            for (int g = 3; g >= 0; --g) { const float go = other_half(gown[g], hh); above[g] = run + (hh == 0 ? go : 0.f); run += gown[g] + go; }
#pragma unroll
            for (int i = 0; i < 16; ++i) p[i] = __builtin_amdgcn_exp2f(zz[i] + (Rb + above[i >> 2] + suf[i]));
            Rb += run;
#pragma unroll
            for (int s = 0; s < 2; ++s) { const bf16x8 pf = PACK8(p, 8 * s);
                o0 = __builtin_amdgcn_mfma_f32_32x32x16_bf16(vf[0][kb][s], pf, o0, 0, 0, 0);
                o1 = __builtin_amdgcn_mfma_f32_32x32x16_bf16(vf[1][kb][s], pf, o1, 0, 0, 0); }
        }
        R = Rb;
#pragma unroll
        for (int kb = 0; kb < 2; ++kb)
#pragma unroll
            for (int s = 0; s < 4; ++s) kf[kb][s] = kn[kb][s];
        if (__all(R < -115.5f)) break;
    }
#undef SB_LOADK
    float ss = 0.f;
#pragma unroll
    for (int i = 0; i < 16; ++i) ss += o0[i] * o0[i] + o1[i] * o1[i];
    ss += other_half(ss, hh);
    const float rstd = rsqrtf(ss * (1.f / 64.f) + NORM_EPS);
    store_ot(MIX + (rowb + t) * DM + 512 + h * 64, o0, o1, rstd, INF(F, I_SB_ON) + l * 256 + h * 64, hh);
}

__device__ __forceinline__ void swa_task(Frame& F, int l, int task) {
    const bf16_t* P = (const bf16_t*)(F.ws + WS_PROJ); bf16_t* MIX = (bf16_t*)(F.ws + WS_MIX);
    const int qb = task & 127, hq = (task >> 7) & 3, b = task >> 9, kvh = hq >> 1;
    const int q0 = qb * 32, r = F.lane & 31, hh = F.lane >> 5, t = q0 + r;
    const size_t rowb = (size_t)b * SEQ;
    bf16x8 qf[4];
    { const bf16_t* qp = P + (rowb + t) * NPROJ + PA_Q + hq * 64 + 8 * hh;
#pragma unroll
      for (int s = 0; s < 4; ++s) qf[s] = *(const bf16x8*)(qp + 16 * s); }
    f32x16 o0, o1;
#pragma unroll
    for (int i = 0; i < 16; ++i) { o0[i] = 0.f; o1[i] = 0.f; }
    float m = INF(F, I_SINKS)[l * 4 + hq], lsum = 1.f;
    const int ktlo = (q0 >= 127) ? ((q0 - 127) >> 6) : 0;
    for (int kt = (q0 + 31) >> 6; kt >= ktlo; --kt) {
        const size_t krow0 = rowb + 64 * kt;
        float sv[32];
        float tmax = -INFINITY;
#pragma unroll
        for (int kb = 0; kb < 2; ++kb) { const bf16_t* kp = P + (krow0 + 32 * kb + r) * NPROJ + PA_K + kvh * 64 + 8 * hh;
            f32x16 a;
#pragma unroll
            for (int i = 0; i < 16; ++i) a[i] = 0.f;
#pragma unroll
            for (int s = 0; s < 4; ++s) a = __builtin_amdgcn_mfma_f32_32x32x16_bf16(*(const bf16x8*)(kp + 16 * s), qf[s], a, 0, 0, 0);
#pragma unroll
            for (int i = 0; i < 16; ++i) { const int key = 64 * kt + 32 * kb + (i & 3) + 8 * (i >> 2) + 4 * hh; const bool valid = (key <= t) && (key + 127 >= t);
                sv[kb * 16 + i] = valid ? a[i] : -INFINITY; tmax = fmaxf(tmax, sv[kb * 16 + i]); } }
        tmax = fmaxf(tmax, other_half(tmax, hh));
        const float mn = fmaxf(m, tmax), sc = __expf(m - mn);
        float psum = 0.f;
#pragma unroll
        for (int i = 0; i < 32; ++i) { sv[i] = __expf(sv[i] - mn); psum += sv[i]; }
        psum += other_half(psum, hh);
        lsum = lsum * sc + psum; m = mn;
#pragma unroll
        for (int i = 0; i < 16; ++i) { o0[i] *= sc; o1[i] *= sc; }
#pragma unroll
        for (int kb = 0; kb < 2; ++kb)
#pragma unroll
            for (int s = 0; s < 2; ++s) { const bf16x8 pf = PACK8(sv, kb * 16 + 8 * s);
                o0 = __builtin_amdgcn_mfma_f32_32x32x16_bf16(load_vt(P, krow0, PA_V + kvh * 64, 0, 32 * kb + 16 * s, r, hh), pf, o0, 0, 0, 0);
                o1 = __builtin_amdgcn_mfma_f32_32x32x16_bf16(load_vt(P, krow0, PA_V + kvh * 64, 1, 32 * kb + 16 * s, r, hh), pf, o1, 0, 0, 0); }
    }
    const float inv = 1.f / lsum;
    float ss = 0.f;
#pragma unroll
    for (int i = 0; i < 16; ++i) { o0[i] *= inv; o1[i] *= inv; ss += o0[i] * o0[i] + o1[i] * o1[i]; }
    ss += other_half(ss, hh);
    const float rstd = rsqrtf(ss * (1.f / 64.f) + NORM_EPS);
    store_ot(MIX + (rowb + t) * DM + hq * 64, o0, o1, rstd, INF(F, I_SWA_ON) + l * 256 + hq * 64, hh);
}

__device__ __forceinline__ unsigned short hw(const u32x4& w, int j) { const unsigned d = (j >> 1) == 0 ? w.x : ((j >> 1) == 1 ? w.y : ((j >> 1) == 2 ? w.z : w.w)); return (unsigned short)((j & 1) ? (d >> 16) : (d & 0xffffu)); }
template <int V> struct IC { static constexpr int value = V; };
template <bool SWA>
__device__ __forceinline__ void attn_block(Frame& F, int l, int bt) {
    const bf16_t* P = (const bf16_t*)(F.ws + WS_PROJ); bf16_t* MIX = (bf16_t*)(F.ws + WS_MIX);
    const int qblk = bt & 15, h = (bt >> 4) & 3, b = bt >> 6;
    const int q0b = qblk * 256, q0 = q0b + 32 * F.wave, r = F.lane & 31, hh = F.lane >> 5, t = q0 + r;
    const size_t rowb = (size_t)b * SEQ;
    const int qcol = SWA ? PA_Q + h * 64 : PC_Q + h * 64, kcol = SWA ? PA_K + (h >> 1) * 64 : PC_K + h * 64, vcol = SWA ? PA_V + (h >> 1) * 64 : PC_V + h * 64;
    LAS bf16_t* Ks = (LAS bf16_t*)F.lds; LAS bf16_t* Vs = (LAS bf16_t*)(F.lds + 2 * 9216);
    const float* RC = (const float*)(F.ws + WS_ROPE_C); const float* RS = (const float*)(F.ws + WS_ROPE_S);
    bf16x8 qf[4];
    { const bf16_t* qp = P + (rowb + t) * NPROJ + qcol + 8 * hh; u32x4 qw[4];
#pragma unroll
      for (int s = 0; s < 4; ++s) qw[s] = *(const u32x4*)(qp + 16 * s);
      if (SWA) {
#pragma unroll
          for (int s = 0; s < 2; ++s) { const float* cp = RC + (rowb + t) * 32 + 16 * s + 8 * hh; const float* sp = RS + (rowb + t) * 32 + 16 * s + 8 * hh;
              const f32x4 c0 = *(const f32x4*)cp, c1 = *(const f32x4*)(cp + 4), s0 = *(const f32x4*)sp, s1 = *(const f32x4*)(sp + 4);
              const unsigned a[4] = {qw[s].x, qw[s].y, qw[s].z, qw[s].w}, bq[4] = {qw[s + 2].x, qw[s + 2].y, qw[s + 2].z, qw[s + 2].w}; float o1[8], o2[8];
#pragma unroll
              for (int j = 0; j < 8; ++j) { const float x1 = (j & 1) ? bfhi(a[j >> 1]) : bflo(a[j >> 1]), x2 = (j & 1) ? bfhi(bq[j >> 1]) : bflo(bq[j >> 1]), cc = j < 4 ? c0[j & 3] : c1[j & 3], sn = j < 4 ? s0[j & 3] : s1[j & 3];
                  o1[j] = (x1 * cc - x2 * sn) * 0.18033688011112042f; o2[j] = (x2 * cc + x1 * sn) * 0.18033688011112042f; }
              qw[s] = (u32x4){cvt_pk(o1[0], o1[1]), cvt_pk(o1[2], o1[3]), cvt_pk(o1[4], o1[5]), cvt_pk(o1[6], o1[7])}; qw[s + 2] = (u32x4){cvt_pk(o2[0], o2[1]), cvt_pk(o2[2], o2[3]), cvt_pk(o2[4], o2[5]), cvt_pk(o2[6], o2[7])}; } }
#pragma unroll
      for (int s = 0; s < 4; ++s) qf[s] = __builtin_bit_cast(bf16x8, qw[s]); }
    f32x16 o0, o1;
#pragma unroll
    for (int i = 0; i < 16; ++i) { o0[i] = 0.f; o1[i] = 0.f; }
    float R = 0.f;
    float m = SWA ? INF(F, I_SINKS)[l * 4 + h] * 1.4426950408889634f : 0.f, lsum = 1.f;
    const int kt_top = SWA ? (q0b + 255) >> 6 : (q0b + 254) >> 6;
    const int kt_lo = SWA ? ((q0b >= 127) ? ((q0b - 127) >> 6) : 0) : 0;
    const int ktw = SWA ? (q0 + 31) >> 6 : (q0 + 30) >> 6;
    const int ktl = SWA ? ((q0 >= 127) ? ((q0 - 127) >> 6) : 0) : 0;
    bool fin = false;
    const bool kside = F.wave < 4; const int srow = (F.tid & 255) >> 2, q4 = F.tid & 3;
    u32x4 pa_[2], pb_[2]; f32x4 rc0_[2], rc1_[2], rs0_[2], rs1_[2];
#pragma unroll
    for (int i_ = 0; i_ < 2; ++i_) { rc0_[i_] = (f32x4){0.f, 0.f, 0.f, 0.f}; rc1_[i_] = rc0_[i_]; rs0_[i_] = rc0_[i_]; rs1_[i_] = rc0_[i_]; }
#define AT_FETCH(kt_, S_) do { const size_t tk_ = rowb + 64 * (kt_) + srow; \
        if (kside) { const bf16_t* p_ = P + tk_ * NPROJ + kcol + 8 * q4; pa_[S_] = *(const u32x4*)p_; pb_[S_] = *(const u32x4*)(p_ + 32); \
            if (SWA) { const float* c_ = RC + tk_ * 32 + 8 * q4; const float* s_ = RS + tk_ * 32 + 8 * q4; rc0_[S_] = *(const f32x4*)c_; rc1_[S_] = *(const f32x4*)(c_ + 4); rs0_[S_] = *(const f32x4*)s_; rs1_[S_] = *(const f32x4*)(s_ + 4); } } \
        else { const bf16_t* p_ = P + tk_ * NPROJ + vcol + 16 * q4; pa_[S_] = *(const u32x4*)p_; pb_[S_] = *(const u32x4*)(p_ + 8); } } while (0)
#define AT_STORE(bufi, S_) do { if (kside) { LAS bf16_t* d_ = Ks + (bufi) * 4608 + srow * 72 + 8 * q4; \
            if (SWA) { const unsigned a_[4] = {pa_[S_].x, pa_[S_].y, pa_[S_].z, pa_[S_].w}, b_[4] = {pb_[S_].x, pb_[S_].y, pb_[S_].z, pb_[S_].w}; float o1_[8], o2_[8]; \
                _Pragma("unroll") for (int j = 0; j < 8; ++j) { const float x1 = (j & 1) ? bfhi(a_[j >> 1]) : bflo(a_[j >> 1]), x2 = (j & 1) ? bfhi(b_[j >> 1]) : bflo(b_[j >> 1]), cc = j < 4 ? rc0_[S_][j & 3] : rc1_[S_][j & 3], sn = j < 4 ? rs0_[S_][j & 3] : rs1_[S_][j & 3]; \
                    o1_[j] = x1 * cc - x2 * sn; o2_[j] = x2 * cc + x1 * sn; } \
                pa_[S_] = (u32x4){cvt_pk(o1_[0], o1_[1]), cvt_pk(o1_[2], o1_[3]), cvt_pk(o1_[4], o1_[5]), cvt_pk(o1_[6], o1_[7])}; pb_[S_] = (u32x4){cvt_pk(o2_[0], o2_[1]), cvt_pk(o2_[2], o2_[3]), cvt_pk(o2_[4], o2_[5]), cvt_pk(o2_[6], o2_[7])}; } \
            *(LAS u32x4*)d_ = pa_[S_]; *(LAS u32x4*)(d_ + 32) = pb_[S_]; } \
        else { LAS bf16_t* d_ = Vs + (bufi) * 4608 + (16 * q4) * 72 + srow; \
            _Pragma("unroll") for (int j = 0; j < 8; ++j) { d_[j * 72] = hw(pa_[S_], j); d_[(8 + j) * 72] = hw(pb_[S_], j); } } } while (0)
    volatile LAS int* vote = (volatile LAS int*)(F.lds + MISC_OFF + 16);
    __syncthreads();
    if (F.tid < 3) vote[F.tid] = 0;
    AT_FETCH(kt_top, 0); AT_STORE(0, 0);
    if (kt_top > kt_lo) AT_FETCH(kt_top - 1, 1);
    __syncthreads();
    int buf = 0, slot = 0;
    auto trip = [&](const int kt, auto fs_tag) -> bool {
        constexpr int FS_ = decltype(fs_tag)::value;
        const bool mine = !fin && kt <= ktw && kt >= ktl;
        if (mine && F.lane == 0) vote[slot] = 1;
        __syncthreads();
        const int any = vote[slot];
        if (F.tid == 0) vote[slot == 0 ? 2 : slot - 1] = 0;
        slot = slot == 2 ? 0 : slot + 1;
        if (any == 0 && kt < ((SWA ? (q0b + 31) : (q0b + 30)) >> 6)) return false;
        if (kt - 2 >= kt_lo) AT_FETCH(kt - 2, FS_);
        if (mine) {
            const LAS bf16_t* Kb = Ks + buf * 4608; const LAS bf16_t* Vb = Vs + buf * 4608;
            f32x16 st[2];
#pragma unroll
            for (int kb = 0; kb < 2; ++kb) { f32x16 a;
#pragma unroll
                for (int i = 0; i < 16; ++i) a[i] = 0.f;
#pragma unroll
                for (int s = 0; s < 4; ++s) a = __builtin_amdgcn_mfma_f32_32x32x16_bf16(*(const LAS bf16x8*)(Kb + (32 * kb + r) * 72 + 16 * s + 8 * hh), qf[s], a, 0, 0, 0);
                st[kb] = a; }
            if (!SWA) {
                float Rb = R;
#pragma unroll
                for (int kb = 1; kb >= 0; --kb) {
                    float e[16], u[16], p[16];
#pragma unroll
                    for (int i = 0; i < 16; ++i) { const int key = 64 * kt + 32 * kb + (i & 3) + 8 * (i >> 2) + 4 * hh; const float z = fminf(st[kb][i] * 0.18033688011112042f, 30.f); const bool valid = key < t;
                        const float ez = __builtin_amdgcn_exp2f(z); e[i] = valid ? ez : 0.f; u[i] = valid ? 1.f + ez : 1.f; }
                    float gown[4], iq[16];
#pragma unroll
                    for (int g = 0; g < 4; ++g) { const float q32 = u[4 * g + 3] * u[4 * g + 2], q10 = u[4 * g + 1] * u[4 * g]; gown[g] = q32 * q10;
                        const float r0 = __builtin_amdgcn_rcpf(gown[g]);
                        iq[4 * g] = r0; iq[4 * g + 1] = r0 * u[4 * g]; iq[4 * g + 2] = r0 * q10; iq[4 * g + 3] = r0 * q10 * u[4 * g + 2]; }
                    float run = 1.f, ia[4]; const float sc2 = __builtin_amdgcn_exp2f(Rb);
#pragma unroll
                    for (int g = 3; g >= 0; --g) { const float go = other_half(gown[g], hh); ia[g] = sc2 * __builtin_amdgcn_rcpf(run * (hh == 0 ? go : 1.f)); run *= gown[g] * go; }
#pragma unroll
                    for (int i = 0; i < 16; ++i) p[i] = e[i] * (iq[i] * ia[i >> 2]);
                    Rb -= __builtin_amdgcn_logf(run);
#pragma unroll
                    for (int s = 0; s < 2; ++s) { const bf16x8 pf = PACK8(p, 8 * s); const int ko = 32 * kb + 16 * s + 4 * hh;
                        const u32x2 a0 = *(const LAS u32x2*)(Vb + r * 72 + ko), a1 = *(const LAS u32x2*)(Vb + r * 72 + ko + 8), c0 = *(const LAS u32x2*)(Vb + (32 + r) * 72 + ko), c1 = *(const LAS u32x2*)(Vb + (32 + r) * 72 + ko + 8);
                        o0 = __builtin_amdgcn_mfma_f32_32x32x16_bf16(__builtin_bit_cast(bf16x8, (u32x4){a0.x, a0.y, a1.x, a1.y}), pf, o0, 0, 0, 0);
                        o1 = __builtin_amdgcn_mfma_f32_32x32x16_bf16(__builtin_bit_cast(bf16x8, (u32x4){c0.x, c0.y, c1.x, c1.y}), pf, o1, 0, 0, 0); }
                }
                R = Rb;
                fin = __all(R < -40.f) != 0;
            } else {
                float sv[32]; float tmax = -INFINITY;
#pragma unroll
                for (int kb = 0; kb < 2; ++kb)
#pragma unroll
                    for (int i = 0; i < 16; ++i) { const int key = 64 * kt + 32 * kb + (i & 3) + 8 * (i >> 2) + 4 * hh; const bool valid = (key <= t) && (key + 127 >= t);
                        sv[kb * 16 + i] = valid ? st[kb][i] : -INFINITY; tmax = fmaxf(tmax, sv[kb * 16 + i]); }
                tmax = fmaxf(tmax, other_half(tmax, hh));
                const float mn = fmaxf(m, tmax), sc = __builtin_amdgcn_exp2f(m - mn);
                float psum = 0.f;
#pragma unroll
                for (int i = 0; i < 32; ++i) { sv[i] = __builtin_amdgcn_exp2f(sv[i] - mn); psum += sv[i]; }
                psum += other_half(psum, hh);
                lsum = lsum * sc + psum; m = mn;
#pragma unroll
                for (int i = 0; i < 16; ++i) { o0[i] *= sc; o1[i] *= sc; }
#pragma unroll
                for (int kb = 0; kb < 2; ++kb)
#pragma unroll
                    for (int s = 0; s < 2; ++s) { const bf16x8 pf = PACK8(sv, kb * 16 + 8 * s); const int ko = 32 * kb + 16 * s + 4 * hh;
                        const u32x2 a0 = *(const LAS u32x2*)(Vb + r * 72 + ko), a1 = *(const LAS u32x2*)(Vb + r * 72 + ko + 8), c0 = *(const LAS u32x2*)(Vb + (32 + r) * 72 + ko), c1 = *(const LAS u32x2*)(Vb + (32 + r) * 72 + ko + 8);
                        o0 = __builtin_amdgcn_mfma_f32_32x32x16_bf16(__builtin_bit_cast(bf16x8, (u32x4){a0.x, a0.y, a1.x, a1.y}), pf, o0, 0, 0, 0);
                        o1 = __builtin_amdgcn_mfma_f32_32x32x16_bf16(__builtin_bit_cast(bf16x8, (u32x4){c0.x, c0.y, c1.x, c1.y}), pf, o1, 0, 0, 0); }
            }
        }
        buf ^= 1;
        if (kt > kt_lo) AT_STORE(buf, 1 - FS_);
        return true;
    };
    for (int kt = kt_top; kt >= kt_lo; kt -= 2) {
        if (!trip(kt, IC<0>{})) break;
        if (kt - 1 < kt_lo) break;
        if (!trip(kt - 1, IC<1>{})) break;
    }
    if (SWA) { const float inv = 1.f / lsum;
#pragma unroll
        for (int i = 0; i < 16; ++i) { o0[i] *= inv; o1[i] *= inv; } }
    float ss = 0.f;
#pragma unroll
    for (int i = 0; i < 16; ++i) ss += o0[i] * o0[i] + o1[i] * o1[i];
    ss += other_half(ss, hh);
    const float rstd = rsqrtf(ss * (1.f / 64.f) + NORM_EPS);
    store_ot(MIX + (rowb + t) * DM + (SWA ? 0 : 512) + h * 64, o0, o1, rstd, INF(F, SWA ? I_SWA_ON : I_SB_ON) + l * 256 + h * 64, hh);
#undef AT_FETCH
#undef AT_STORE
}
__device__ __forceinline__ void rwkv_convert_small(Frame& F, int l) {
    bf16_t* W2T = (bf16_t*)(F.ws + WS_SMALLW); bf16_t* A2T = W2T + 256 * 64; bf16_t* G2T = A2T + 256 * 64;
    const float* w2 = INF(F, I_W2) + l * 64 * 256; const float* a2 = INF(F, I_A2) + l * 64 * 256; const float* g2 = INF(F, I_G2) + l * 128 * 256;
    for (int idx = F.bid * 512 + F.tid; idx < 256 * 64; idx += F.G * 512) { const int c = idx >> 6, i = idx & 63; W2T[idx] = f2bf(w2[i * 256 + c]); A2T[idx] = f2bf(a2[i * 256 + c]); }
    for (int idx = F.bid * 512 + F.tid; idx < 256 * 128; idx += F.G * 512) { const int c = idx >> 7, i = idx & 127; G2T[idx] = f2bf(g2[i * 256 + c]); }
}
__device__ __forceinline__ float tanh_f(float x) { return 1.f - 2.f * __builtin_amdgcn_rcpf(__expf(2.f * x) + 1.f); }
constexpr int LP = 72, LPG = 136;
template <int PITCH, int KS>
__device__ __forceinline__ void mm64p(f32x4 (&acc)[2], const LAS bf16_t* A, const LAS bf16_t* B, int mt, int nt0, int lane) {
    const int r16 = lane & 15, kq = lane >> 4;
#pragma unroll
    for (int s = 0; s < KS; ++s) {
        const bf16x8 a = *(const LAS bf16x8*)(A + (16 * mt + r16) * PITCH + 32 * s + 8 * kq);
#pragma unroll
        for (int j = 0; j < 2; ++j) { const bf16x8 b = *(const LAS bf16x8*)(B + (16 * (nt0 + j) + r16) * PITCH + 32 * s + 8 * kq);
            acc[j] = __builtin_amdgcn_mfma_f32_16x16x32_bf16(a, b, acc[j], 0, 0, 0); }
    }
}
__device__ __forceinline__ void mm64(f32x4 (&acc)[2], const LAS bf16_t* A, const LAS bf16_t* B, int mt, int nt0, int lane) { mm64p<LP, 2>(acc, A, B, mt, nt0, lane); }
__device__ __forceinline__ float quad_sum(float v) { v = dpp_add<0xB1>(v); v = dpp_add<0x4E>(v); return v; }
template <int CTRL> __device__ __forceinline__ float quad_bcast(float v) { return __builtin_bit_cast(float, __builtin_amdgcn_update_dpp(0, __builtin_bit_cast(int, v), CTRL, 0xf, 0xf, false)); }
__device__ __forceinline__ float oct_sum(float v) { v = dpp_add<0xB1>(v); v = dpp_add<0x4E>(v); v = dpp_add<0x141>(v); return v; }
__device__ __forceinline__ bf16_t* rw_mat(Frame& F, int unit, int q) { return (bf16_t*)(F.ws + WS_RWM) + (size_t)unit * 16384 + q * 4096; }
__device__ __forceinline__ void rw_lerp8(float (&x)[8], const bf16_t* pc, bool hasprev, const float* mu, int col) {
    const u32x4 c = *(const u32x4*)(pc + col); u32x4 p = (u32x4){0u, 0u, 0u, 0u}; if (hasprev) p = *(const u32x4*)(pc - NPROJ + col);
    const f32x4 m0 = *(const f32x4*)(mu + col), m1 = *(const f32x4*)(mu + col + 4);
    x[0] = bflo(c.x) + (bflo(p.x) - bflo(c.x)) * m0[0]; x[1] = bfhi(c.x) + (bfhi(p.x) - bfhi(c.x)) * m0[1]; x[2] = bflo(c.y) + (bflo(p.y) - bflo(c.y)) * m0[2]; x[3] = bfhi(c.y) + (bfhi(p.y) - bfhi(c.y)) * m0[3];
    x[4] = bflo(c.z) + (bflo(p.z) - bflo(c.z)) * m1[0]; x[5] = bfhi(c.z) + (bfhi(p.z) - bfhi(c.z)) * m1[1]; x[6] = bflo(c.w) + (bflo(p.w) - bflo(c.w)) * m1[2]; x[7] = bfhi(c.w) + (bfhi(p.w) - bfhi(c.w)) * m1[3];
}
struct RwRaw { u32x4 c[7], p[7]; };
__device__ __forceinline__ void rw_load_raw(Frame& F, RwRaw& raw, int unit) {
    const int n = unit & 63, h = (unit >> 6) & 3, b = unit >> 8, tokc = b * SEQ + n * 64 + (F.tid >> 3), k0 = (F.tid & 7) * 8; const bool hasprev = (tokc & (SEQ - 1)) != 0;
    const bf16_t* pc = (const bf16_t*)(F.ws + WS_PROJ) + (size_t)tokc * NPROJ + PD + k0;
    const int col[7] = {768, 832, 896, 960, h * 64, 256 + h * 64, 512 + h * 64};
#pragma unroll
    for (int g = 0; g < 7; ++g) { raw.c[g] = *(const u32x4*)(pc + col[g]); raw.p[g] = (u32x4){0u, 0u, 0u, 0u}; if (hasprev) raw.p[g] = *(const u32x4*)(pc - NPROJ + col[g]); }
}
__device__ __forceinline__ void rw_lerp8r(float (&x)[8], const u32x4 c, const u32x4 p, const LAS float* mu, int col) {
    const f32x4 m0 = *(const LAS f32x4*)(mu + col), m1 = *(const LAS f32x4*)(mu + col + 4);
    x[0] = bflo(c.x) + (bflo(p.x) - bflo(c.x)) * m0[0]; x[1] = bfhi(c.x) + (bfhi(p.x) - bfhi(c.x)) * m0[1]; x[2] = bflo(c.y) + (bflo(p.y) - bflo(c.y)) * m0[2]; x[3] = bfhi(c.y) + (bfhi(p.y) - bfhi(c.y)) * m0[3];
    x[4] = bflo(c.z) + (bflo(p.z) - bflo(c.z)) * m1[0]; x[5] = bfhi(c.z) + (bfhi(p.z) - bfhi(c.z)) * m1[1]; x[6] = bflo(c.w) + (bflo(p.w) - bflo(c.w)) * m1[2]; x[7] = bfhi(c.w) + (bfhi(p.w) - bfhi(c.w)) * m1[3];
}
__device__ __forceinline__ u32x4 pack8v(const float (&x)[8]) { u32x4 w; w.x = cvt_pk(x[0], x[1]); w.y = cvt_pk(x[2], x[3]); w.z = cvt_pk(x[4], x[5]); w.w = cvt_pk(x[6], x[7]); return w; }

constexpr int R1_TAB = 125440;
__device__ __forceinline__ void rwkv_r1_tables(Frame& F, int l) {
    LAS float* T = (LAS float*)(F.lds + R1_TAB);
    const float* mu = INF(F, I_MU) + l * 1024; const float* w0 = INF(F, I_W0) + l * 256; const float* a0 = INF(F, I_A0) + l * 256; const float* kk = INF(F, I_KK) + l * 256; const float* ka = INF(F, I_KA) + l * 256; const float* rk = INF(F, I_RK) + l * 256;
    T[F.tid] = mu[F.tid]; T[512 + F.tid] = mu[512 + F.tid];
    if (F.tid < 256) { T[1024 + F.tid] = w0[F.tid]; T[1280 + F.tid] = a0[F.tid]; T[1536 + F.tid] = kk[F.tid]; T[1792 + F.tid] = ka[F.tid]; T[2048 + F.tid] = rk[F.tid]; }
}
__device__ __forceinline__ void rwkv_r1_unit(Frame& F, int l, int unit, int stop = 0) {
    const int n = unit & 63, h = (unit >> 6) & 3, b = unit >> 8, tok0 = b * SEQ + n * 64;
#define SLOT(i) ((LAS bf16_t*)(F.lds + (i) * 9216))
    LAS float* F0 = (LAS float*)(F.lds + 92160); LAS float* F1 = (LAS float*)(F.lds + 92160 + 16384); LAS float* GC = (LAS float*)(F.lds + 92160 + 32768);
    LAS float* F2 = (LAS float*)F.lds;
    LAS bf16_t* XG = (LAS bf16_t*)(F.lds + 55296); LAS bf16_t* WG2 = (LAS bf16_t*)(F.lds + 72704);
    const int w = F.wave, mt = w & 3, nt0 = (w >> 2) * 2, r16 = F.lane & 15, kq = F.lane >> 4;
    const int t = F.tid >> 3, k0 = (F.tid & 7) * 8;
    const LAS float* TAB = (const LAS float*)(F.lds + R1_TAB); const LAS float* mu = TAB;
    const int tokc = tok0 + t;
    float r8[8], k8[8], v8[8], lw8[8], kk8[8], b8[8];
    RwRaw raw; rw_load_raw(F, raw, unit);
    __syncthreads();
    { float x[8];
      rw_lerp8r(x, raw.c[0], raw.p[0], mu, 768 + k0);
#pragma unroll
      for (int j = 0; j < 8; ++j) x[j] = tanh_f(x[j]);
      *(LAS u32x4*)(SLOT(2) + t * LP + k0) = pack8v(x);
      rw_lerp8r(x, raw.c[1], raw.p[1], mu, 832 + k0); *(LAS u32x4*)(SLOT(3) + t * LP + k0) = pack8v(x);
#pragma unroll
      for (int hf = 0; hf < 2; ++hf) { rw_lerp8r(x, raw.c[2 + hf], raw.p[2 + hf], mu, 896 + 64 * hf + k0);
#pragma unroll
          for (int j = 0; j < 8; ++j) x[j] = sigmoid_f(x[j]);
          *(LAS u32x4*)(XG + t * LPG + 64 * hf + k0) = pack8v(x); }
      const bf16_t* W2T = (const bf16_t*)(F.ws + WS_SMALLW); const bf16_t* A2T = W2T + 256 * 64; const bf16_t* G2T = A2T + 256 * 64;
      *(LAS u32x4*)(SLOT(4) + t * LP + k0) = *(const u32x4*)(W2T + (h * 64 + t) * 64 + k0); *(LAS u32x4*)(SLOT(5) + t * LP + k0) = *(const u32x4*)(A2T + (h * 64 + t) * 64 + k0);
      *(LAS u32x4*)(WG2 + t * LPG + k0) = *(const u32x4*)(G2T + (h * 64 + t) * 128 + k0); *(LAS u32x4*)(WG2 + t * LPG + 64 + k0) = *(const u32x4*)(G2T + (h * 64 + t) * 128 + 64 + k0);
      rw_lerp8r(r8, raw.c[4], raw.p[4], mu, h * 64 + k0); rw_lerp8r(k8, raw.c[5], raw.p[5], mu, 256 + h * 64 + k0); rw_lerp8r(v8, raw.c[6], raw.p[6], mu, 512 + h * 64 + k0); }
    __syncthreads();
    if (stop == 1) return;
    { f32x4 a0[2] = {{0.f, 0.f, 0.f, 0.f}, {0.f, 0.f, 0.f, 0.f}}, a1[2] = {{0.f, 0.f, 0.f, 0.f}, {0.f, 0.f, 0.f, 0.f}}, a2[2] = {{0.f, 0.f, 0.f, 0.f}, {0.f, 0.f, 0.f, 0.f}};
      mm64(a0, SLOT(2), SLOT(4), mt, nt0, F.lane); mm64(a1, SLOT(3), SLOT(5), mt, nt0, F.lane); mm64p<LPG, 4>(a2, XG, WG2, mt, nt0, F.lane);
#pragma unroll
      for (int j = 0; j < 2; ++j)
#pragma unroll
          for (int rg = 0; rg < 4; ++rg) { const int o = (16 * mt + 4 * kq + rg) * 64 + 16 * (nt0 + j) + r16; F0[o] = a0[j][rg]; F1[o] = a1[j][rg]; F2[o] = a2[j][rg]; } }
    __syncthreads();
    if (stop == 2) return;
    { const int col = h * 64 + k0;
      const f32x4 w0a = *(const LAS f32x4*)(TAB + 1024 + col), w0b = *(const LAS f32x4*)(TAB + 1024 + col + 4), a0a = *(const LAS f32x4*)(TAB + 1280 + col), a0b = *(const LAS f32x4*)(TAB + 1280 + col + 4);
      const f32x4 kka = *(const LAS f32x4*)(TAB + 1536 + col), kkb = *(const LAS f32x4*)(TAB + 1536 + col + 4), kaa = *(const LAS f32x4*)(TAB + 1792 + col), kab = *(const LAS f32x4*)(TAB + 1792 + col + 4);
      const f32x4 rka = *(const LAS f32x4*)(TAB + 2048 + col), rkb = *(const LAS f32x4*)(TAB + 2048 + col + 4);
      const f32x4 p0a = *(const LAS f32x4*)(F0 + t * 64 + k0), p0b = *(const LAS f32x4*)(F0 + t * 64 + k0 + 4), p1a = *(const LAS f32x4*)(F1 + t * 64 + k0), p1b = *(const LAS f32x4*)(F1 + t * 64 + k0 + 4);
      const f32x4 p2a = *(const LAS f32x4*)(F2 + t * 64 + k0), p2b = *(const LAS f32x4*)(F2 + t * 64 + k0 + 4);
      float g8[8], ssq = 0.f, srkr = 0.f;
#pragma unroll
      for (int j = 0; j < 8; ++j) { const float w0 = j < 4 ? w0a[j & 3] : w0b[j & 3], a0 = j < 4 ? a0a[j & 3] : a0b[j & 3], k_k = j < 4 ? kka[j & 3] : kkb[j & 3], k_a = j < 4 ? kaa[j & 3] : kab[j & 3], r_k = j < 4 ? rka[j & 3] : rkb[j & 3];
          const float pw = j < 4 ? p0a[j & 3] : p0b[j & 3], pa = j < 4 ? p1a[j & 3] : p1b[j & 3]; g8[j] = j < 4 ? p2a[j & 3] : p2b[j & 3];
          const float a = sigmoid_f(a0 + pa); lw8[j] = bf2f(f2bf(-0.6065306597126334f * sigmoid_f(w0 + pw)));
          kk8[j] = k8[j] * k_k; const float km = k8[j] * (1.f + (a - 1.f) * k_a); b8[j] = kk8[j] * a; k8[j] = km;
          ssq += kk8[j] * kk8[j]; srkr += r8[j] * km * r_k; }
      ssq = oct_sum(ssq); srkr = oct_sum(srkr);
      const float rs = rsqrtf(ssq + 1e-12f);
#pragma unroll
      for (int j = 0; j < 8; ++j) { kk8[j] *= rs; b8[j] *= rs; }
      *(u32x4*)((bf16_t*)(F.ws + WS_RW_V) + (size_t)tokc * 256 + col) = pack8v(v8); *(u32x4*)((bf16_t*)(F.ws + WS_RW_G) + (size_t)tokc * 256 + col) = pack8v(g8);
      if ((F.tid & 7) == 0) ((float*)(F.ws + WS_RKR))[(size_t)tokc * 4 + h] = srkr; }
    __syncthreads();
    if (stop == 3) return;
#pragma unroll
    for (int j = 0; j < 8; ++j) { SLOT(0)[(k0 + j) * LP + t] = f2bf(lw8[j]); SLOT(1)[t * LP + k0 + j] = (k0 + j <= t) ? (bf16_t)0x3F80 : (bf16_t)0; }
    __syncthreads();
    { f32x4 acc[2] = {{0.f, 0.f, 0.f, 0.f}, {0.f, 0.f, 0.f, 0.f}}; mm64(acc, SLOT(1), SLOT(0), mt, nt0, F.lane);
#pragma unroll
      for (int j = 0; j < 2; ++j)
#pragma unroll
          for (int rg = 0; rg < 4; ++rg) F0[(16 * mt + 4 * kq + rg) * 64 + 16 * (nt0 + j) + r16] = acc[j][rg]; }
    __syncthreads();
    { const f32x4 c0 = *(const LAS f32x4*)(F0 + t * 64 + k0), c1 = *(const LAS f32x4*)(F0 + t * 64 + k0 + 4);
      const float cum[8] = {c0[0], c0[1], c0[2], c0[3], c1[0], c1[1], c1[2], c1[3]};
      float ka[8], bt[8], kt[8], rt[8];
#pragma unroll
      for (int j = 0; j < 8; ++j) { const float epos = __expf(cum[j]), eneg = __expf(-cum[j]), eprev = __expf(cum[j] - lw8[j]);
          ka[j] = kk8[j] * eprev; bt[j] = b8[j] * eneg; kt[j] = k8[j] * eneg; rt[j] = r8[j] * epos;
          if (t == 63) GC[k0 + j] = epos; }
      const u32x4 pka = pack8v(ka), pb = pack8v(bt), pq = pack8v(kt), prr = pack8v(rt), pv = pack8v(v8);
      *(LAS u32x4*)(SLOT(0) + t * LP + k0) = pka; *(LAS u32x4*)(SLOT(1) + t * LP + k0) = pb; *(LAS u32x4*)(SLOT(2) + t * LP + k0) = pq; *(LAS u32x4*)(SLOT(3) + t * LP + k0) = prr;
#pragma unroll
      for (int j = 0; j < 8; ++j) { SLOT(4)[(k0 + j) * LP + t] = hw(pb, j); SLOT(5)[(k0 + j) * LP + t] = hw(pq, j); SLOT(6)[(k0 + j) * LP + t] = hw(pv, j); } }
    __syncthreads();
    if (stop == 4) return;
    { f32x4 aLb[2] = {{0.f, 0.f, 0.f, 0.f}, {0.f, 0.f, 0.f, 0.f}}, aLk[2] = {{0.f, 0.f, 0.f, 0.f}, {0.f, 0.f, 0.f, 0.f}}, aMb[2] = {{0.f, 0.f, 0.f, 0.f}, {0.f, 0.f, 0.f, 0.f}}, aMk[2] = {{0.f, 0.f, 0.f, 0.f}, {0.f, 0.f, 0.f, 0.f}};
      mm64(aLb, SLOT(0), SLOT(1), mt, nt0, F.lane); mm64(aLk, SLOT(0), SLOT(2), mt, nt0, F.lane); mm64(aMb, SLOT(3), SLOT(1), mt, nt0, F.lane); mm64(aMk, SLOT(3), SLOT(2), mt, nt0, F.lane);
#pragma unroll
      for (int j = 0; j < 2; ++j)
#pragma unroll
          for (int rg = 0; rg < 4; ++rg) { const int tt = 16 * mt + 4 * kq + rg, ii = 16 * (nt0 + j) + r16;
              F0[tt * 64 + (ii & 3) * 16 + (ii >> 2)] = (ii < tt) ? aLb[j][rg] : 0.f;
              SLOT(7)[tt * LP + ii] = f2bf((ii < tt) ? aLk[j][rg] : 0.f); SLOT(8)[tt * LP + ii] = f2bf((ii <= tt) ? aMb[j][rg] : 0.f); SLOT(9)[tt * LP + ii] = f2bf((ii <= tt) ? aMk[j][rg] : 0.f); } }
    __syncthreads();
    if (stop == 5) return;
    { f32x4 acc[2] = {{0.f, 0.f, 0.f, 0.f}, {0.f, 0.f, 0.f, 0.f}}; mm64(acc, SLOT(7), SLOT(6), mt, nt0, F.lane);
#pragma unroll
      for (int j = 0; j < 2; ++j)
#pragma unroll
          for (int rg = 0; rg < 4; ++rg) F1[(16 * mt + 4 * kq + rg) * 64 + 16 * (nt0 + j) + r16] = acc[j][rg]; }
    __syncthreads();
    if (stop == 6) return;
    { const int col = F.tid >> 2, jq = F.tid & 3; float x[16], rhs[16];
#pragma unroll
      for (int m = 0; m < 16; ++m) { x[m] = 0.f; rhs[m] = (col < 64) ? bf2f(SLOT(0)[(4 * m + jq) * LP + col]) : F1[(4 * m + jq) * 64 + (col - 64)]; }
#pragma unroll
      for (int m = 0; m < 16; ++m) { float pa[4] = {0.f, 0.f, 0.f, 0.f};
#pragma unroll
          for (int a = 0; a < 4; ++a)
#pragma unroll
              for (int m4 = 0; 4 * m4 < m; ++m4) { const f32x4 lq = *(const LAS f32x4*)(F0 + (4 * m + a) * 64 + jq * 16 + 4 * m4);
#pragma unroll
                  for (int e = 0; e < 4; ++e) if (4 * m4 + e < m) pa[a] += lq[e] * x[4 * m4 + e]; }
          const float t0 = quad_sum(pa[0]), t1 = quad_sum(pa[1]), t2 = quad_sum(pa[2]), t3 = quad_sum(pa[3]);
          const LAS float* lrow = F0 + (4 * m + jq) * 64 + m;
          const float c0 = lrow[0], c1 = lrow[16], c2 = lrow[32];
          float y = rhs[m] - (jq == 0 ? t0 : (jq == 1 ? t1 : (jq == 2 ? t2 : t3)));
          y -= c0 * quad_bcast<0x00>(y); y -= c1 * quad_bcast<0x55>(y); y -= c2 * quad_bcast<0xAA>(y);
          x[m] = y; }
      LAS bf16_t* dst = (col < 64) ? (SLOT(7) + col * LP) : (SLOT(1) + (col - 64) * LP);
#pragma unroll
      for (int m = 0; m < 16; ++m) dst[4 * m + jq] = f2bf(-x[m]); }
    __syncthreads();
    if (stop == 7) return;
    { f32x4 aG[2] = {{0.f, 0.f, 0.f, 0.f}, {0.f, 0.f, 0.f, 0.f}}, aH[2] = {{0.f, 0.f, 0.f, 0.f}, {0.f, 0.f, 0.f, 0.f}}, aR[2] = {{0.f, 0.f, 0.f, 0.f}, {0.f, 0.f, 0.f, 0.f}}, aY[2] = {{0.f, 0.f, 0.f, 0.f}, {0.f, 0.f, 0.f, 0.f}};
      mm64(aG, SLOT(7), SLOT(4), mt, nt0, F.lane);
      mm64(aH, SLOT(5), SLOT(6), mt, nt0, F.lane); mm64(aH, SLOT(4), SLOT(1), mt, nt0, F.lane);
      mm64(aR, SLOT(7), SLOT(8), mt, nt0, F.lane);
      mm64(aY, SLOT(9), SLOT(6), mt, nt0, F.lane); mm64(aY, SLOT(8), SLOT(1), mt, nt0, F.lane);
      bf16_t* MG = rw_mat(F, unit, 0); bf16_t* MR = rw_mat(F, unit, 1); bf16_t* MH = rw_mat(F, unit, 2); bf16_t* MY = rw_mat(F, unit, 3);
#pragma unroll
      for (int j = 0; j < 2; ++j) { const int cc = 16 * (nt0 + j) + r16, r0 = 16 * mt + 4 * kq;
          const float gcc = GC[cc]; const u32x2 rtw = *(const LAS u32x2*)(SLOT(3) + cc * LP + r0);
          float gv[4], hv[4], rv[4], yv[4];
#pragma unroll
          for (int rg = 0; rg < 4; ++rg) { gv[rg] = gcc * ((r0 + rg == cc ? 1.f : 0.f) + aG[j][rg]); hv[rg] = GC[r0 + rg] * aH[j][rg]; yv[rg] = aY[j][rg] * 1.0f; }
          rv[0] = bflo(rtw.x) + aR[j][0]; rv[1] = bfhi(rtw.x) + aR[j][1]; rv[2] = bflo(rtw.y) + aR[j][2]; rv[3] = bfhi(rtw.y) + aR[j][3];
          u32x2 o; o.x = pg8::cvt_pk_c(gv[0], gv[1]); o.y = pg8::cvt_pk_c(gv[2], gv[3]); *(u32x2*)(MG + cc * 64 + r0) = o;
          o.x = pg8::cvt_pk_c(rv[0], rv[1]); o.y = pg8::cvt_pk_c(rv[2], rv[3]); *(u32x2*)(MR + cc * 64 + r0) = o;
          o.x = pg8::cvt_pk_c(hv[0], hv[1]); o.y = pg8::cvt_pk_c(hv[2], hv[3]); *(u32x2*)(MH + cc * 64 + r0) = o;
          o.x = pg8::cvt_pk_c(yv[0], yv[1]); o.y = pg8::cvt_pk_c(yv[2], yv[3]); *(u32x2*)(MY + cc * 64 + r0) = o; } }
#undef SLOT
}

__device__ __forceinline__ void rwkv_r2_block(Frame& F, int bh) {
    LAS bf16_t* Sx = (LAS bf16_t*)F.lds; LAS bf16_t* Gs = (LAS bf16_t*)(F.lds + 9216);
    bf16_t* SG = (bf16_t*)(F.ws + WS_RW_S);
    const int w = F.wave, mt = w & 3, nt0 = (w >> 2) * 2, r16 = F.lane & 15, kq = F.lane >> 4;
    const int grow = F.tid >> 3, gc0 = (F.tid & 7) * 8;
    f32x4 st[2] = {{0.f, 0.f, 0.f, 0.f}, {0.f, 0.f, 0.f, 0.f}};
    constexpr int PF = 4;
    u32x4 gq[PF]; u32x2 hq[PF][2];
#define R2_FETCH(slot, n_) do { const int u_ = bh * 64 + (n_); gq[slot] = *(const u32x4*)(rw_mat(F, u_, 0) + grow * 64 + gc0); \
        _Pragma("unroll") for (int j_ = 0; j_ < 2; ++j_) hq[slot][j_] = *(const u32x2*)(rw_mat(F, u_, 2) + (16 * (nt0 + j_) + r16) * 64 + 16 * mt + 4 * kq); } while (0)
#pragma unroll
    for (int i = 0; i < PF; ++i) R2_FETCH(i, i);
    __syncthreads();
    for (int n0 = 0; n0 < 64; n0 += PF) {
#pragma unroll
        for (int i = 0; i < PF; ++i) { const int n = n0 + i; const int unit = bh * 64 + n;
#pragma unroll
            for (int j = 0; j < 2; ++j) { u32x2 ps; ps.x = pg8::cvt_pk_c(st[j][0], st[j][1]); ps.y = pg8::cvt_pk_c(st[j][2], st[j][3]);
                const int vv = 16 * (nt0 + j) + r16, kk0 = 16 * mt + 4 * kq;
                *(LAS u32x2*)(Sx + vv * LP + kk0) = ps; *(u32x2*)(SG + (size_t)unit * 4096 + vv * 64 + kk0) = ps; }
            *(LAS u32x4*)(Gs + grow * LP + gc0) = gq[i];
            f32x4 acc[2];
#pragma unroll
            for (int j = 0; j < 2; ++j) { acc[j][0] = bflo(hq[i][j].x); acc[j][1] = bfhi(hq[i][j].x); acc[j][2] = bflo(hq[i][j].y); acc[j][3] = bfhi(hq[i][j].y); }
            if (n + PF < 64) R2_FETCH(i, n + PF);
            __syncthreads();
            mm64(acc, Gs, Sx, mt, nt0, F.lane);
            st[0] = acc[0]; st[1] = acc[1];
            __syncthreads();
        }
    }
#undef R2_FETCH
}

__device__ __forceinline__ void rwkv_r3_task(Frame& F, int l, int unit) {
    const int n = unit & 63, h = (unit >> 6) & 3, b = unit >> 8, tok0 = b * SEQ + n * 64;
    const int r16 = F.lane & 15, kq = F.lane >> 4;
    const bf16_t* SG = (const bf16_t*)(F.ws + WS_RW_S) + (size_t)unit * 4096;
    const bf16_t* MR = rw_mat(F, unit, 1); const bf16_t* MY = rw_mat(F, unit, 3);
    bf16x8 sb[4][2];
#pragma unroll
    for (int nt = 0; nt < 4; ++nt)
#pragma unroll
        for (int s = 0; s < 2; ++s) sb[nt][s] = *(const bf16x8*)(SG + (16 * nt + r16) * 64 + 32 * s + 8 * kq);
    const float* lnw = INF(F, I_LNW) + l * 256 + h * 64; const float* lnb = INF(F, I_LNB) + l * 256 + h * 64;
    float lw4[4], lb4[4];
#pragma unroll
    for (int nt = 0; nt < 4; ++nt) { lw4[nt] = lnw[16 * nt + r16]; lb4[nt] = lnb[16 * nt + r16]; }
    const bf16_t* SV = (const bf16_t*)(F.ws + WS_RW_V); const bf16_t* SGt = (const bf16_t*)(F.ws + WS_RW_G); const float* RKR = (const float*)(F.ws + WS_RKR);
    bf16_t* MIX = (bf16_t*)(F.ws + WS_MIX);
    LAS float* scr = (LAS float*)(F.lds + F.wave * 4352);
#pragma unroll 1
    for (int mt = 0; mt < 4; ++mt) {
        f32x4 acc[4];
#pragma unroll
        for (int nt = 0; nt < 4; ++nt) { const u32x2 y0 = *(const u32x2*)(MY + (16 * nt + r16) * 64 + 16 * mt + 4 * kq); acc[nt][0] = bflo(y0.x); acc[nt][1] = bfhi(y0.x); acc[nt][2] = bflo(y0.y); acc[nt][3] = bfhi(y0.y); }
#pragma unroll
        for (int s = 0; s < 2; ++s) { const bf16x8 a = *(const bf16x8*)(MR + (16 * mt + r16) * 64 + 32 * s + 8 * kq);
#pragma unroll
            for (int nt = 0; nt < 4; ++nt) acc[nt] = __builtin_amdgcn_mfma_f32_16x16x32_bf16(a, sb[nt][s], acc[nt], 0, 0, 0); }
#pragma unroll
        for (int rg = 0; rg < 4; ++rg) {
            const float mean = sum16((acc[0][rg] + acc[1][rg]) + (acc[2][rg] + acc[3][rg])) * (1.f / 64.f);
            float d[4], q = 0.f;
#pragma unroll
            for (int nt = 0; nt < 4; ++nt) { d[nt] = acc[nt][rg] - mean; q += d[nt] * d[nt]; }
            const float rstd = rsqrtf(sum16(q) * (1.f / 64.f) + 64e-5f);
#pragma unroll
            for (int nt = 0; nt < 4; ++nt) scr[(4 * kq + rg) * 68 + 16 * nt + r16] = d[nt] * rstd * lw4[nt] + lb4[nt]; }
        asm volatile("s_waitcnt lgkmcnt(0)" ::: "memory");
        { const int tr = F.lane >> 2, cg = F.lane & 3, tok = tok0 + 16 * mt + tr, col = h * 64 + 16 * cg;
          const float rkr = RKR[(size_t)tok * 4 + h];
          const u32x4 v0 = *(const u32x4*)(SV + (size_t)tok * 256 + col), v1 = *(const u32x4*)(SV + (size_t)tok * 256 + col + 8), g0 = *(const u32x4*)(SGt + (size_t)tok * 256 + col), g1 = *(const u32x4*)(SGt + (size_t)tok * 256 + col + 8);
          float y[16];
#pragma unroll
          for (int c4 = 0; c4 < 4; ++c4) { const f32x4 yy = *(const LAS f32x4*)(scr + tr * 68 + 16 * cg + 4 * c4); y[4 * c4] = yy[0]; y[4 * c4 + 1] = yy[1]; y[4 * c4 + 2] = yy[2]; y[4 * c4 + 3] = yy[3]; }
          float o[16];
#pragma unroll
          for (int j = 0; j < 8; ++j) { o[j] = (y[j] + rkr * bf2f(hw(v0, j))) * bf2f(hw(g0, j)); o[8 + j] = (y[8 + j] + rkr * bf2f(hw(v1, j))) * bf2f(hw(g1, j)); }
          u32x4 w0, w1; w0.x = pk2(o[0], o[1]); w0.y = pk2(o[2], o[3]); w0.z = pk2(o[4], o[5]); w0.w = pk2(o[6], o[7]); w1.x = pk2(o[8], o[9]); w1.y = pk2(o[10], o[11]); w1.z = pk2(o[12], o[13]); w1.w = pk2(o[14], o[15]);
          *(u32x4*)(MIX + (size_t)tok * DM + 768 + col) = w0; *(u32x4*)(MIX + (size_t)tok * DM + 768 + col + 8) = w1; }
        asm volatile("s_waitcnt lgkmcnt(0)" ::: "memory");
    }
}
template <int PITCH, int KS>
__device__ __forceinline__ void mm_tile(f32x4& acc, const LAS bf16_t* A, const LAS bf16_t* B, int mt, int nt, int lane) {
    const int r16 = lane & 15, kq = lane >> 4;
#pragma unroll
    for (int s = 0; s < KS; ++s)
        acc = __builtin_amdgcn_mfma_f32_16x16x32_bf16(*(const LAS bf16x8*)(A + (16 * mt + r16) * PITCH + 32 * s + 8 * kq), *(const LAS bf16x8*)(B + (16 * nt + r16) * PITCH + 32 * s + 8 * kq), acc, 0, 0, 0);
}
constexpr int GP = 40;
__device__ __forceinline__ void gla_cum(Frame& F, int l, int h, int tok0, LAS bf16_t* LAhi, LAS bf16_t* LAlo, LAS float* Fc) {
    const bf16_t* P = (const bf16_t*)(F.ws + WS_PROJ);
    const float* wa2 = INF(F, I_GLA_WA2) + l * 16 * 128 + h * 32; const float* ba = INF(F, I_GLA_BA) + l * 128 + h * 32;
    const int t = F.tid >> 3, e4 = (F.tid & 7) * 4;
    { const u32x4 l0 = *(const u32x4*)(P + (size_t)(tok0 + t) * NPROJ + PB_LR), l1 = *(const u32x4*)(P + (size_t)(tok0 + t) * NPROJ + PB_LR + 8);
      const float lr[16] = {bflo(l0.x), bfhi(l0.x), bflo(l0.y), bfhi(l0.y), bflo(l0.z), bfhi(l0.z), bflo(l0.w), bfhi(l0.w), bflo(l1.x), bfhi(l1.x), bflo(l1.y), bfhi(l1.y), bflo(l1.z), bfhi(l1.z), bflo(l1.w), bfhi(l1.w)};
      f32x4 a = *(const f32x4*)(ba + e4);
#pragma unroll
      for (int r = 0; r < 16; ++r) a += lr[r] * *(const f32x4*)(wa2 + r * 128 + e4);
#pragma unroll
      for (int j = 0; j < 4; ++j) { const float la = logsigmoid_f(a[j]) * (1.f / 16.f); const bf16_t hi = f2bf(la); const bf16_t lo = f2bf(la - bf2f(hi));
          LAhi[(e4 + j) * LP + t] = hi; LAlo[(e4 + j) * LP + t] = lo; } }
    __syncthreads();
    { const int w = F.wave, mt = w & 3, nt = w >> 2, r16 = F.lane & 15, kq = F.lane >> 4; f32x4 acc = {0.f, 0.f, 0.f, 0.f};
#pragma unroll
      for (int s = 0; s < 2; ++s) { bf16x8 tri;
#pragma unroll
          for (int j = 0; j < 8; ++j) tri[j] = (32 * s + 8 * kq + j <= 16 * mt + r16) ? (short)0x3F80 : (short)0;
          acc = __builtin_amdgcn_mfma_f32_16x16x32_bf16(tri, *(const LAS bf16x8*)(LAhi + (16 * nt + r16) * LP + 32 * s + 8 * kq), acc, 0, 0, 0);
          acc = __builtin_amdgcn_mfma_f32_16x16x32_bf16(tri, *(const LAS bf16x8*)(LAlo + (16 * nt + r16) * LP + 32 * s + 8 * kq), acc, 0, 0, 0); }
#pragma unroll
      for (int rg = 0; rg < 4; ++rg) Fc[(16 * mt + 4 * kq + rg) * 32 + 16 * nt + r16] = acc[rg]; }
    __syncthreads();
}
__device__ __forceinline__ void gla_kv2(Frame& F, int l, int unit) {
    const bf16_t* P = (const bf16_t*)(F.ws + WS_PROJ);
    float* KV = (float*)(F.ws + WS_GLA_KV) + (size_t)unit * 2048; float* DEC = (float*)(F.ws + WS_GLA_DEC) + unit * 32;
    const int n = unit & 63, h = (unit >> 6) & 3, b = unit >> 8, tok0 = b * SEQ + n * 64;
    LAS bf16_t* LAhi = (LAS bf16_t*)F.lds; LAS bf16_t* LAlo = (LAS bf16_t*)(F.lds + 4608); LAS float* Fc = (LAS float*)(F.lds + 9216);
    LAS bf16_t* Ke = (LAS bf16_t*)(F.lds + 17408); LAS bf16_t* Vf = (LAS bf16_t*)(F.lds + 22016);
    const int t = F.tid >> 3, c8 = F.tid & 7;
    __syncthreads();
    gla_cum(F, l, h, tok0, LAhi, LAlo, Fc);
    { const u32x2 kw = *(const u32x2*)(P + (size_t)(tok0 + t) * NPROJ + PB_K + h * 32 + c8 * 4); const u32x4 vw = *(const u32x4*)(P + (size_t)(tok0 + t) * NPROJ + PB_V + h * 64 + c8 * 8);
      const f32x4 ct = *(const LAS f32x4*)(Fc + t * 32 + c8 * 4), cl = *(const LAS f32x4*)(Fc + 63 * 32 + c8 * 4);
      const float kf[4] = {bflo(kw.x), bfhi(kw.x), bflo(kw.y), bfhi(kw.y)};
#pragma unroll
      for (int j = 0; j < 4; ++j) { Ke[(c8 * 4 + j) * LP + t] = f2bf(kf[j] * __expf(cl[j] - ct[j])); if (t == 63) DEC[c8 * 4 + j] = __expf(cl[j]); }
#pragma unroll
      for (int j = 0; j < 8; ++j) Vf[(c8 * 8 + j) * LP + t] = hw(vw, j); }
    __syncthreads();
    { const int w = F.wave, mt = w & 1, nt = w >> 1, r16 = F.lane & 15, kq = F.lane >> 4; f32x4 acc = {0.f, 0.f, 0.f, 0.f};
      mm_tile<LP, 2>(acc, Ke, Vf, mt, nt, F.lane);
#pragma unroll
      for (int rg = 0; rg < 4; ++rg) KV[(16 * mt + 4 * kq + rg) * 64 + 16 * nt + r16] = acc[rg]; }
}
__device__ __forceinline__ void gla_out2(Frame& F, int l, int unit) {
    const bf16_t* P = (const bf16_t*)(F.ws + WS_PROJ); bf16_t* MIX = (bf16_t*)(F.ws + WS_MIX);
    const float* SP = (const float*)(F.ws + WS_GLA_KV) + (size_t)unit * 2048;
    const int n = unit & 63, h = (unit >> 6) & 3, b = unit >> 8, tok0 = b * SEQ + n * 64;
    LAS bf16_t* LAhi = (LAS bf16_t*)F.lds; LAS bf16_t* LAlo = (LAS bf16_t*)(F.lds + 4608); LAS float* Fc = (LAS float*)(F.lds + 9216);
    LAS bf16_t* Qe = (LAS bf16_t*)(F.lds + 17408); LAS bf16_t* Ke = (LAS bf16_t*)(F.lds + 22528); LAS bf16_t* Qb = (LAS bf16_t*)(F.lds + 27648); LAS bf16_t* Sf = (LAS bf16_t*)(F.lds + 32768);
    LAS bf16_t* Vf = (LAS bf16_t*)(F.lds + 37888); LAS bf16_t* At = (LAS bf16_t*)(F.lds + 47104); LAS float* Of = (LAS float*)(F.lds + 56320);
    const int t = F.tid >> 3, c8 = F.tid & 7, w = F.wave, mt = w & 3, nt0 = (w >> 2) * 2, r16 = F.lane & 15, kq = F.lane >> 4;
    __syncthreads();
    gla_cum(F, l, h, tok0, LAhi, LAlo, Fc);
    { const u32x2 qw = *(const u32x2*)(P + (size_t)(tok0 + t) * NPROJ + PB_Q + h * 32 + c8 * 4), kw = *(const u32x2*)(P + (size_t)(tok0 + t) * NPROJ + PB_K + h * 32 + c8 * 4);
      const u32x4 vw = *(const u32x4*)(P + (size_t)(tok0 + t) * NPROJ + PB_V + h * 64 + c8 * 8);
      const f32x4 ct = *(const LAS f32x4*)(Fc + t * 32 + c8 * 4), cr = *(const LAS f32x4*)(Fc + 31 * 32 + c8 * 4);
      const float qs = 0.17677669529663687f;
      const float qf[4] = {bflo(qw.x) * qs, bfhi(qw.x) * qs, bflo(qw.y) * qs, bfhi(qw.y) * qs}, kf[4] = {bflo(kw.x), bfhi(kw.x), bflo(kw.y), bfhi(kw.y)};
      float qe[4], ke[4], qb[4];
#pragma unroll
      for (int j = 0; j < 4; ++j) { qe[j] = qf[j] * __expf(ct[j] - cr[j]); ke[j] = kf[j] * __expf(cr[j] - ct[j]); qb[j] = qf[j] * __expf(ct[j]); }
      u32x2 o; o.x = cvt_pk(qe[0], qe[1]); o.y = cvt_pk(qe[2], qe[3]); *(LAS u32x2*)(Qe + t * GP + c8 * 4) = o;
      o.x = cvt_pk(ke[0], ke[1]); o.y = cvt_pk(ke[2], ke[3]); *(LAS u32x2*)(Ke + t * GP + c8 * 4) = o;
      o.x = cvt_pk(qb[0], qb[1]); o.y = cvt_pk(qb[2], qb[3]); *(LAS u32x2*)(Qb + t * GP + c8 * 4) = o;
#pragma unroll
      for (int j = 0; j < 8; ++j) Vf[(c8 * 8 + j) * LP + t] = hw(vw, j);
      const int e = F.tid >> 4, f4 = (F.tid & 15) * 4; const f32x4 sv = *(const f32x4*)(SP + e * 64 + f4);
#pragma unroll
      for (int j = 0; j < 4; ++j) Sf[(f4 + j) * GP + e] = f2bf(sv[j]); }
    __syncthreads();
    { f32x4 acc[2] = {{0.f, 0.f, 0.f, 0.f}, {0.f, 0.f, 0.f, 0.f}}; mm64p<GP, 1>(acc, Qe, Ke, mt, nt0, F.lane);
#pragma unroll
      for (int j = 0; j < 2; ++j)
#pragma unroll
          for (int rg = 0; rg < 4; ++rg) { const int tt = 16 * mt + 4 * kq + rg, ss = 16 * (nt0 + j) + r16; At[tt * LP + ss] = f2bf(ss <= tt ? acc[j][rg] : 0.f); } }
    __syncthreads();
    { f32x4 acc[2] = {{0.f, 0.f, 0.f, 0.f}, {0.f, 0.f, 0.f, 0.f}}; mm64p<LP, 2>(acc, At, Vf, mt, nt0, F.lane); mm64p<GP, 1>(acc, Qb, Sf, mt, nt0, F.lane);
#pragma unroll
      for (int j = 0; j < 2; ++j)
#pragma unroll
          for (int rg = 0; rg < 4; ++rg) Of[(16 * mt + 4 * kq + rg) * 64 + 16 * (nt0 + j) + r16] = acc[j][rg]; }
    __syncthreads();
    { const int f0 = c8 * 8; const f32x4 o0 = *(const LAS f32x4*)(Of + t * 64 + f0), o1 = *(const LAS f32x4*)(Of + t * 64 + f0 + 4);
      const float o[8] = {o0[0], o0[1], o0[2], o0[3], o1[0], o1[1], o1[2], o1[3]};
      float ss = 0.f;
#pragma unroll
      for (int j = 0; j < 8; ++j) ss += o[j] * o[j];
      ss = oct_sum(ss);
      const float rstd = rsqrtf(ss * (1.f / 64.f) + NORM_EPS); const float* gn = INF(F, I_GLA_ON) + l * 256 + h * 64 + f0;
      const f32x4 g0 = *(const f32x4*)gn, g1 = *(const f32x4*)(gn + 4);
      const u32x4 gw = *(const u32x4*)(P + (size_t)(tok0 + t) * NPROJ + PB_G + h * 64 + f0);
      const float gb[8] = {bflo(gw.x), bfhi(gw.x), bflo(gw.y), bfhi(gw.y), bflo(gw.z), bfhi(gw.z), bflo(gw.w), bfhi(gw.w)};
      float r[8];
#pragma unroll
      for (int j = 0; j < 8; ++j) r[j] = o[j] * rstd * (j < 4 ? g0[j & 3] : g1[j & 3]) * (gb[j] * sigmoid_f(gb[j]));
      *(u32x4*)(MIX + (size_t)(tok0 + t) * DM + 256 + h * 64 + f0) = pack8v(r); }
}

__device__ __forceinline__ void gla_cum_a(Frame& F, int l, int h, int tok0, LAS bf16_t* LAhi, LAS bf16_t* LAlo) {
    const bf16_t* P = (const bf16_t*)(F.ws + WS_PROJ);
    const float* wa2 = INF(F, I_GLA_WA2) + l * 16 * 128 + h * 32; const float* ba = INF(F, I_GLA_BA) + l * 128 + h * 32;
    const int t = F.tid >> 3, e4 = (F.tid & 7) * 4;
    const u32x4 l0 = *(const u32x4*)(P + (size_t)(tok0 + t) * NPROJ + PB_LR), l1 = *(const u32x4*)(P + (size_t)(tok0 + t) * NPROJ + PB_LR + 8);
    const float lr[16] = {bflo(l0.x), bfhi(l0.x), bflo(l0.y), bfhi(l0.y), bflo(l0.z), bfhi(l0.z), bflo(l0.w), bfhi(l0.w), bflo(l1.x), bfhi(l1.x), bflo(l1.y), bfhi(l1.y), bflo(l1.z), bfhi(l1.z), bflo(l1.w), bfhi(l1.w)};
    f32x4 a = *(const f32x4*)(ba + e4);
#pragma unroll
    for (int r = 0; r < 16; ++r) a += lr[r] * *(const f32x4*)(wa2 + r * 128 + e4);
#pragma unroll
    for (int j = 0; j < 4; ++j) { const float la = logsigmoid_f(a[j]) * (1.f / 16.f); const bf16_t hi = f2bf(la); const bf16_t lo = f2bf(la - bf2f(hi));
        LAhi[(e4 + j) * LP + t] = hi; LAlo[(e4 + j) * LP + t] = lo; }
}
struct GlaW2 { bf16x8 whi, wlo; float ba; };
__device__ __forceinline__ void gla_loadw2(Frame& F, int l, int h, GlaW2& W) {
    const int nt = F.wave >> 2, r16 = F.lane & 15, kq = F.lane >> 4, e = 16 * nt + r16;
    const float* wa2 = INF(F, I_GLA_WA2) + l * 16 * 128 + h * 32 + e;
    W.ba = INF(F, I_GLA_BA)[l * 128 + h * 32 + e];
#pragma unroll
    for (int j = 0; j < 8; ++j) { const float wv = (kq < 2) ? wa2[(8 * (kq & 1) + j) * 128] : 0.f; const bf16_t hi = f2bf(wv); W.whi[j] = (short)hi; W.wlo[j] = (short)f2bf(wv - bf2f(hi)); }
}
__device__ __forceinline__ void gla_cum_a2(Frame& F, const GlaW2& W, int tok0, LAS bf16_t* LAhi, LAS bf16_t* LAlo) {
    const bf16_t* P = (const bf16_t*)(F.ws + WS_PROJ);
    const int mt = F.wave & 3, nt = F.wave >> 2, r16 = F.lane & 15, kq = F.lane >> 4;
    u32x4 lw = *(const u32x4*)(P + (size_t)(tok0 + 16 * mt + r16) * NPROJ + PB_LR + 8 * (kq & 1));
    if (kq >= 2) lw = (u32x4){0u, 0u, 0u, 0u};
    f32x4 acc = {0.f, 0.f, 0.f, 0.f};
    acc = __builtin_amdgcn_mfma_f32_16x16x32_bf16(__builtin_bit_cast(bf16x8, lw), W.whi, acc, 0, 0, 0);
    acc = __builtin_amdgcn_mfma_f32_16x16x32_bf16(__builtin_bit_cast(bf16x8, lw), W.wlo, acc, 0, 0, 0);
    float la[4]; bf16_t hi[4], lo[4];
#pragma unroll
    for (int rg = 0; rg < 4; ++rg) { la[rg] = logsigmoid_f(acc[rg] + W.ba) * (1.f / 16.f); hi[rg] = f2bf(la[rg]); lo[rg] = f2bf(la[rg] - bf2f(hi[rg])); }
    const int o = (16 * nt + r16) * LP + 16 * mt + 4 * kq;
    *(LAS u32x2*)(LAhi + o) = (u32x2){(unsigned)hi[0] | ((unsigned)hi[1] << 16), (unsigned)hi[2] | ((unsigned)hi[3] << 16)};
    *(LAS u32x2*)(LAlo + o) = (u32x2){(unsigned)lo[0] | ((unsigned)lo[1] << 16), (unsigned)lo[2] | ((unsigned)lo[3] << 16)};
}
__device__ __forceinline__ void gla_cum_b(Frame& F, const LAS bf16_t* LAhi, const LAS bf16_t* LAlo, LAS float* Fc) {
    const int w = F.wave, mt = w & 3, nt = w >> 2, r16 = F.lane & 15, kq = F.lane >> 4; f32x4 acc = {0.f, 0.f, 0.f, 0.f};
#pragma unroll
    for (int s = 0; s < 2; ++s) { bf16x8 tri;
#pragma unroll
        for (int j = 0; j < 8; ++j) tri[j] = (32 * s + 8 * kq + j <= 16 * mt + r16) ? (short)0x3F80 : (short)0;
        acc = __builtin_amdgcn_mfma_f32_16x16x32_bf16(tri, *(const LAS bf16x8*)(LAhi + (16 * nt + r16) * LP + 32 * s + 8 * kq), acc, 0, 0, 0);
        acc = __builtin_amdgcn_mfma_f32_16x16x32_bf16(tri, *(const LAS bf16x8*)(LAlo + (16 * nt + r16) * LP + 32 * s + 8 * kq), acc, 0, 0, 0); }
#pragma unroll
    for (int rg = 0; rg < 4; ++rg) Fc[(16 * mt + 4 * kq + rg) * 32 + 16 * nt + r16] = acc[rg];
}
constexpr int GKV_U = 31232, GOUT_U = 56320;
__device__ __forceinline__ void gla_kv2_pair(Frame& F, int l, int unit0, const GlaW2& W) {
    const bf16_t* P = (const bf16_t*)(F.ws + WS_PROJ);
    const int n = unit0 & 63, h = (unit0 >> 6) & 3, t = F.tid >> 3, c8 = F.tid & 7;
#define GKV_PTRS(uu) const int unit = unit0 + 256 * (uu), tok0 = (unit >> 8) * SEQ + n * 64; LAS unsigned char* B_ = F.lds + (uu) * GKV_U; \
        LAS bf16_t* LAhi = (LAS bf16_t*)B_; LAS bf16_t* LAlo = (LAS bf16_t*)(B_ + 4608); LAS float* Fc = (LAS float*)(B_ + 9216); LAS bf16_t* Ke = (LAS bf16_t*)(B_ + 17408); LAS bf16_t* Vf = (LAS bf16_t*)(B_ + 22016); \
        (void)unit; (void)tok0; (void)LAhi; (void)LAlo; (void)Fc; (void)Ke; (void)Vf
    __syncthreads();
#pragma unroll
    for (int uu = 0; uu < 2; ++uu) { GKV_PTRS(uu); gla_cum_a2(F, W, tok0, LAhi, LAlo); }
    __syncthreads();
#pragma unroll
    for (int uu = 0; uu < 2; ++uu) { GKV_PTRS(uu); gla_cum_b(F, LAhi, LAlo, Fc); }
    __syncthreads();
#pragma unroll
    for (int uu = 0; uu < 2; ++uu) { GKV_PTRS(uu); float* DEC = (float*)(F.ws + WS_GLA_DEC) + unit * 32;
      const u32x2 kw = *(const u32x2*)(P + (size_t)(tok0 + t) * NPROJ + PB_K + h * 32 + c8 * 4); const u32x4 vw = *(const u32x4*)(P + (size_t)(tok0 + t) * NPROJ + PB_V + h * 64 + c8 * 8);
      const f32x4 ct = *(const LAS f32x4*)(Fc + t * 32 + c8 * 4), cl = *(const LAS f32x4*)(Fc + 63 * 32 + c8 * 4);
      const float kf[4] = {bflo(kw.x), bfhi(kw.x), bflo(kw.y), bfhi(kw.y)};
#pragma unroll
      for (int j = 0; j < 4; ++j) { Ke[(c8 * 4 + j) * LP + t] = f2bf(kf[j] * __expf(cl[j] - ct[j])); if (t == 63) DEC[c8 * 4 + j] = __expf(cl[j]); }
#pragma unroll
      for (int j = 0; j < 8; ++j) Vf[(c8 * 8 + j) * LP + t] = hw(vw, j); }
    __syncthreads();
#pragma unroll
    for (int uu = 0; uu < 2; ++uu) { GKV_PTRS(uu); float* KV = (float*)(F.ws + WS_GLA_KV) + (size_t)unit * 2048;
      const int w = F.wave, mt = w & 1, nt = w >> 1, r16 = F.lane & 15, kq = F.lane >> 4; f32x4 acc = {0.f, 0.f, 0.f, 0.f};
      mm_tile<LP, 2>(acc, Ke, Vf, mt, nt, F.lane);
#pragma unroll
      for (int rg = 0; rg < 4; ++rg) KV[(16 * mt + 4 * kq + rg) * 64 + 16 * nt + r16] = acc[rg]; }
#undef GKV_PTRS
}
__device__ __forceinline__ void gla_out2_pair(Frame& F, int l, int unit0, const GlaW2& W, int stop = 0) {
    const bf16_t* P = (const bf16_t*)(F.ws + WS_PROJ); bf16_t* MIX = (bf16_t*)(F.ws + WS_MIX);
    const int n = unit0 & 63, h = (unit0 >> 6) & 3;
    const int t = F.tid >> 3, c8 = F.tid & 7, w = F.wave, mt = w & 3, nt0 = (w >> 2) * 2, r16 = F.lane & 15, kq = F.lane >> 4;
#define GOUT_PTRS(uu) const int unit = unit0 + 256 * (uu), tok0 = (unit >> 8) * SEQ + n * 64; LAS unsigned char* B_ = F.lds + (uu) * GOUT_U; \
        LAS bf16_t* LAhi = (LAS bf16_t*)B_; LAS bf16_t* LAlo = (LAS bf16_t*)(B_ + 4608); LAS float* Fc = (LAS float*)(B_ + 9216); LAS float* Of = (LAS float*)B_; \
        LAS bf16_t* Qe = (LAS bf16_t*)(B_ + 17408); LAS bf16_t* Ke = (LAS bf16_t*)(B_ + 22528); LAS bf16_t* Qb = (LAS bf16_t*)(B_ + 27648); LAS bf16_t* Sf = (LAS bf16_t*)(B_ + 32768); \
        LAS bf16_t* Vf = (LAS bf16_t*)(B_ + 37888); LAS bf16_t* At = (LAS bf16_t*)(B_ + 47104); \
        (void)unit; (void)tok0; (void)LAhi; (void)LAlo; (void)Fc; (void)Of; (void)Qe; (void)Ke; (void)Qb; (void)Sf; (void)Vf; (void)At
    __syncthreads();
#pragma unroll
    for (int uu = 0; uu < 2; ++uu) { GOUT_PTRS(uu); gla_cum_a2(F, W, tok0, LAhi, LAlo); }
    __syncthreads();
    if (stop == 1) return;
#pragma unroll
    for (int uu = 0; uu < 2; ++uu) { GOUT_PTRS(uu); gla_cum_b(F, LAhi, LAlo, Fc); }
    __syncthreads();
    if (stop == 2) return;
#pragma unroll
    for (int uu = 0; uu < 2; ++uu) { GOUT_PTRS(uu); const float* SP = (const float*)(F.ws + WS_GLA_KV) + (size_t)unit * 2048;
      const u32x2 qw = *(const u32x2*)(P + (size_t)(tok0 + t) * NPROJ + PB_Q + h * 32 + c8 * 4), kw = *(const u32x2*)(P + (size_t)(tok0 + t) * NPROJ + PB_K + h * 32 + c8 * 4);
      const u32x4 vw = *(const u32x4*)(P + (size_t)(tok0 + t) * NPROJ + PB_V + h * 64 + c8 * 8);
      const f32x4 ct = *(const LAS f32x4*)(Fc + t * 32 + c8 * 4), cr = *(const LAS f32x4*)(Fc + 31 * 32 + c8 * 4);
      const float qs = 0.17677669529663687f;
      const float qf[4] = {bflo(qw.x) * qs, bfhi(qw.x) * qs, bflo(qw.y) * qs, bfhi(qw.y) * qs}, kf[4] = {bflo(kw.x), bfhi(kw.x), bflo(kw.y), bfhi(kw.y)};
      float qe[4], ke[4], qb[4];
#pragma unroll
      for (int j = 0; j < 4; ++j) { qe[j] = qf[j] * __expf(ct[j] - cr[j]); ke[j] = kf[j] * __expf(cr[j] - ct[j]); qb[j] = qf[j] * __expf(ct[j]); }
      u32x2 o; o.x = cvt_pk(qe[0], qe[1]); o.y = cvt_pk(qe[2], qe[3]); *(LAS u32x2*)(Qe + t * GP + c8 * 4) = o;
      o.x = cvt_pk(ke[0], ke[1]); o.y = cvt_pk(ke[2], ke[3]); *(LAS u32x2*)(Ke + t * GP + c8 * 4) = o;
      o.x = cvt_pk(qb[0], qb[1]); o.y = cvt_pk(qb[2], qb[3]); *(LAS u32x2*)(Qb + t * GP + c8 * 4) = o;
#pragma unroll
      for (int j = 0; j < 8; ++j) Vf[(c8 * 8 + j) * LP + t] = hw(vw, j);
      const int e = F.tid >> 4, f4 = (F.tid & 15) * 4; const f32x4 sv = *(const f32x4*)(SP + e * 64 + f4);
#pragma unroll
      for (int j = 0; j < 4; ++j) Sf[(f4 + j) * GP + e] = f2bf(sv[j]); }
    __syncthreads();
    if (stop == 3) return;
#pragma unroll
    for (int uu = 0; uu < 2; ++uu) { GOUT_PTRS(uu); f32x4 acc[2] = {{0.f, 0.f, 0.f, 0.f}, {0.f, 0.f, 0.f, 0.f}}; mm64p<GP, 1>(acc, Qe, Ke, mt, nt0, F.lane);
#pragma unroll
      for (int j = 0; j < 2; ++j)
#pragma unroll
          for (int rg = 0; rg < 4; ++rg) { const int tt = 16 * mt + 4 * kq + rg, ss = 16 * (nt0 + j) + r16; At[tt * LP + ss] = f2bf(ss <= tt ? acc[j][rg] : 0.f); } }
    __syncthreads();
    if (stop == 4) return;
#pragma unroll
    for (int uu = 0; uu < 2; ++uu) { GOUT_PTRS(uu); f32x4 acc[2] = {{0.f, 0.f, 0.f, 0.f}, {0.f, 0.f, 0.f, 0.f}}; mm64p<LP, 2>(acc, At, Vf, mt, nt0, F.lane); mm64p<GP, 1>(acc, Qb, Sf, mt, nt0, F.lane);
#pragma unroll
      for (int j = 0; j < 2; ++j)
#pragma unroll
          for (int rg = 0; rg < 4; ++rg) Of[(16 * mt + 4 * kq + rg) * 64 + 16 * (nt0 + j) + r16] = acc[j][rg]; }
    __syncthreads();
    if (stop == 5) return;
#pragma unroll
    for (int uu = 0; uu < 2; ++uu) { GOUT_PTRS(uu); const int f0 = c8 * 8; const f32x4 o0 = *(const LAS f32x4*)(Of + t * 64 + f0), o1 = *(const LAS f32x4*)(Of + t * 64 + f0 + 4);
      const float o[8] = {o0[0], o0[1], o0[2], o0[3], o1[0], o1[1], o1[2], o1[3]};
      float ss = 0.f;
#pragma unroll
      for (int j = 0; j < 8; ++j) ss += o[j] * o[j];
      ss = oct_sum(ss);
      const float rstd = rsqrtf(ss * (1.f / 64.f) + NORM_EPS); const float* gn = INF(F, I_GLA_ON) + l * 256 + h * 64 + f0;
      const f32x4 g0 = *(const f32x4*)gn, g1 = *(const f32x4*)(gn + 4);
      const u32x4 gw = *(const u32x4*)(P + (size_t)(tok0 + t) * NPROJ + PB_G + h * 64 + f0);
      const float gb[8] = {bflo(gw.x), bfhi(gw.x), bflo(gw.y), bfhi(gw.y), bflo(gw.z), bfhi(gw.z), bflo(gw.w), bfhi(gw.w)};
      float r[8];
#pragma unroll
      for (int j = 0; j < 8; ++j) r[j] = o[j] * rstd * (j < 4 ? g0[j & 3] : g1[j & 3]) * (gb[j] * sigmoid_f(gb[j]));
      *(u32x4*)(MIX + (size_t)(tok0 + t) * DM + 256 + h * 64 + f0) = pack8v(r); }
#undef GOUT_PTRS
}
struct Args { const void* in[N_IN]; float* out; unsigned char* ws; int ph_lo, ph_hi, sub, pad; };
constexpr int PH_PER_LAYER = 10, PH_FINAL = DEPTH * PH_PER_LAYER, PH_END = PH_FINAL + 2;
#ifndef EN_MASK
#define EN_MASK 0xFFFF
#endif
#define EN(b) ((EN_MASK >> (b)) & 1)
#ifndef DUP_MASK
#define DUP_MASK 0
#endif
#define NREP(b) (1 + ((DUP_MASK >> (b)) & 1))
enum Phase { P_PREP = 0, P_INPROJ, P_MIX1, P_MIX2, P_MIX3, P_OUTPROJ, P_NORM2, P_MAP, P_UP, P_DOWN };

__global__ void __launch_bounds__(512, 2) fwd_kernel(Args args) {
    extern __shared__ __attribute__((aligned(16))) unsigned char lds_raw[];
    Frame F;
    F.lds = (LAS unsigned char*)lds_raw;
    F.tid = threadIdx.x; F.lane = F.tid & 63; F.wave = __builtin_amdgcn_readfirstlane(F.tid >> 6);
    F.bid = blockIdx.x; F.G = gridDim.x;
    F.ws = args.ws; F.ctl = (unsigned*)(args.ws + WS_CTL); F.out = args.out;
    if (F.tid < N_IN) ((LAS unsigned long long*)(F.lds + PTR_OFF))[F.tid] = (unsigned long long)args.in[F.tid];
    volatile LAS unsigned* MISC = (volatile LAS unsigned*)(F.lds + MISC_OFF);
    if (F.tid < 8) MISC[F.tid] = 0u;
    __syncthreads();
    const int lo = args.ph_lo, hi = args.ph_hi, sub = args.sub;
    const int wave_sgpr = F.wave;
    XcdBarrier bar; bar.bar = F.ctl + CW_BAR; bar.x = 0; bar.st = MISC;
    if (hi - lo > 1) bar = xcd_barrier_post(F.ctl + CW_BAR, MISC);
#define HB ((bf16_t*)(F.ws + WS_H))
#define PROJ ((bf16_t*)(F.ws + WS_PROJ))
#define MIXB ((bf16_t*)(F.ws + WS_MIX))
#define ACT ((bf16_t*)(F.ws + WS_PROJ))
#define XBUF ((bf16_t*)((unsigned char*)F.out + XB_OFF))
#define IN(k) (lo <= (k) && (k) < hi)
#define PH_BEGIN() do { int w_i = wave_sgpr; asm volatile("" : "+s"(w_i)); unsigned m_i = ~0u; asm volatile("" : "+s"(m_i)); int l_i = (int)__builtin_amdgcn_mbcnt_hi(m_i, __builtin_amdgcn_mbcnt_lo(m_i, 0u)); asm volatile("" : "+v"(l_i)); F.wave = w_i; F.lane = l_i; F.tid = w_i * 64 + l_i; \
        GAS unsigned char* w_ = (GAS unsigned char*)args.ws; asm volatile("" : "+s"(w_)); F.ws = (unsigned char*)w_; F.ctl = (unsigned*)((unsigned char*)w_ + WS_CTL); F.out = (float*)(GAS float*)args.out; F.lds = (LAS unsigned char*)lds_raw; } while (0)
#define SEAM(k) do { if ((k) + 1 < hi) { GAS unsigned* bp_ = (GAS unsigned*)(F.ctl + CW_BAR); asm volatile("" : "+s"(bp_)); bar.bar = (unsigned*)bp_; unsigned bx_ = bar.x; asm volatile("" : "+s"(bx_)); bar.x = bx_; int w_j = wave_sgpr; asm volatile("" : "+s"(w_j)); unsigned m_j = ~0u; asm volatile("" : "+s"(m_j)); const int l_j = (int)__builtin_amdgcn_mbcnt_hi(m_j, __builtin_amdgcn_mbcnt_lo(m_j, 0u)); xcd_barrier(bar, w_j == 0 && l_j == 0); } } while (0)

    if (EN(0) && IN(0)) { PH_BEGIN(); phase_rope_tables(F); }
    { constexpr int l = 0;
        const int pb = l * PH_PER_LAYER; const bool moe = (l & 1) != 0; const int ms = l >> 1;

        if (EN(0) && IN(pb + P_PREP)) { PH_BEGIN();
            if (sub & 1) { phase_convert_weights(F, l); rwkv_convert_small(F, l); }
            __syncthreads();
            if (sub & 2) { if (l == 0) phase_norm_lr<true, false>(F, INF(F, I_X), INF(F, I_ATTN_NORM) + l * DM, l); else if (((l - 1) & 1) != 0) phase_norm_lr<false, true>(F, XBUF, INF(F, I_ATTN_NORM) + l * DM, l); else phase_norm_lr<false, false>(F, XBUF, INF(F, I_ATTN_NORM) + l * DM, l); }
            SEAM(pb + P_PREP);
        }
        if (EN(1) && IN(pb + P_INPROJ)) { PH_BEGIN();
            pg8::Gemm g{HB, (const bf16_t*)(F.ws + WS_WIN), DM, nullptr}; pg8::StaticOrder S; S.init(NTOK, 3072, F.G, F.bid);
            pg8::EpiBf16 E{PROJ, NPROJ};
            pg8::gemm_phase<pg8::EpiBf16, pg8::StaticOrder, false>(F.tid, F.lds, g, S, E);
            SEAM(pb + P_INPROJ);
        }
        if (EN(2) && IN(pb + P_MIX1)) { PH_BEGIN();
            if (sub & 1) { rwkv_r1_tables(F, l); for (int unit = F.bid; unit < 2048; unit += F.G) rwkv_r1_unit(F, l, unit, (sub >> 8) & 15); }
            if (sub & 2) { GlaW2 gw; gla_loadw2(F, l, (F.bid >> 6) & 3, gw); for (int unit = F.bid; unit < 2048; unit += 2 * F.G) gla_kv2_pair(F, l, unit, gw); }
            SEAM(pb + P_MIX1);
        }
        if (EN(3) && IN(pb + P_MIX2)) { PH_BEGIN();
            if (F.bid < 32) { if (sub & 1) rwkv_r2_block(F, F.bid); }
            else { const int ob = F.bid - 32, NO = F.G - 32;
                if (sub & 2) for (int gt = ob * 512 + F.tid; gt < 65536; gt += NO * 512) gla_scan(F, gt); }
            if (sub & 12) {
                volatile LAS int* qw = (volatile LAS int*)(F.lds + MISC_OFF + 28);
                unsigned* qctr = F.ctl + CW_ATTNQ + 64 * l + ((sub >> 4) & 1) * 32;
                int nxt = 0;
                if (F.tid == 0) nxt = (int)atomicAdd(qctr, 1u);
                for (;;) {
                    __syncthreads();
                    if (F.tid == 0) *qw = nxt;
                    __syncthreads();
                    const int task = *qw;
                    if (task >= 1024) break;
                    if (F.tid == 0) nxt = (int)atomicAdd(qctr, 1u);
                    if (task < 512) { if (sub & 4) attn_block<false>(F, l, task); } else if (sub & 8) attn_block<true>(F, l, task - 512);
                }
            }
            SEAM(pb + P_MIX2);
        }
        if (EN(4) && IN(pb + P_MIX3)) { PH_BEGIN();
            if (sub & 1) { GlaW2 gw; gla_loadw2(F, l, (F.bid >> 6) & 3, gw); for (int unit = F.bid; unit < 2048; unit += 2 * F.G) gla_out2_pair(F, l, unit, gw, (sub >> 8) & 15); }
            __syncthreads();
            if (sub & 2) for (int unit = F.bid * 8 + F.wave; unit < 2048; unit += F.G * 8) rwkv_r3_task(F, l, unit);
            SEAM(pb + P_MIX3);
        }
        if (EN(5) && IN(pb + P_OUTPROJ)) { PH_BEGIN();
            __syncthreads();
            pg8::Gemm g{MIXB, (const bf16_t*)(F.ws + WS_WOUT), DM, nullptr}; pg8::StaticOrder S; S.init(NTOK, DM, F.G, F.bid);
            if (l == 0) { pg8::EpiResidB<true> E{INF(F, I_X), XBUF, DM}; pg8::gemm_phase<pg8::EpiResidB<true>, pg8::StaticOrder, false>(F.tid, F.lds, g, S, E); }
            else { pg8::EpiResidB<false> E{XBUF, XBUF, DM}; pg8::gemm_phase<pg8::EpiResidB<false>, pg8::StaticOrder, false>(F.tid, F.lds, g, S, E); }
            SEAM(pb + P_OUTPROJ);
        }
        if (EN(6) && IN(pb + P_NORM2)) { PH_BEGIN();
            if (moe) phase_norm<1, false>(F, XBUF, INF(F, I_FFN_NORM) + l * DM, false, ms);
            else phase_norm<0, false>(F, XBUF, INF(F, I_FFN_NORM) + l * DM, false, 0);
            SEAM(pb + P_NORM2);
        }
        if (EN(7) && IN(pb + P_MAP)) { PH_BEGIN();
            if (moe) { phase_moe_map(F, ms); SEAM(pb + P_MAP); }
        }
        if (EN(8) && IN(pb + P_UP)) { PH_BEGIN();
            __syncthreads();
            if (!moe) {
                pg8::Gemm g{HB, (const bf16_t*)(F.ws + WS_W13), DM / 2, nullptr}; pg8::StaticOrder S; S.init(NTOK, 2 * D_FF, F.G, F.bid);
                pg8::EpiSwiglu8 E{(unsigned char*)ACT, D_FF, 0.015625f};
                pg8::gemm_phase<pg8::EpiSwiglu8, pg8::StaticOrder, false, true>(F.tid, F.lds, g, S, E);
            } else {
                pg8::MoeOrder S; moe_bases(F.ctl + CW_MOECNT + 64 * ms, S.tb); S.ntiles = S.tb[8]; S.nNe = 2 * D_FFE / 256; S.G = F.G; S.c = F.bid;
                pg8::Gemm g{HB, (const bf16_t*)(F.ws + WS_W13), DM / 2, (const int*)(F.ws + WS_ROWMAP)};
                pg8::EpiSwiglu8 E{(unsigned char*)ACT, KP8, 0.015625f};
                pg8::gemm_phase<pg8::EpiSwiglu8, pg8::MoeOrder, true, true>(F.tid, F.lds, g, S, E);
            }
            SEAM(pb + P_UP);
        }
        if (EN(9) && IN(pb + P_DOWN)) { PH_BEGIN();
            __syncthreads();
            if (!moe) {
                pg8::Gemm g{ACT, (const bf16_t*)(F.ws + WS_W2), D_FF / 2, nullptr}; pg8::StaticOrder S; S.init(NTOK, DM, F.G, F.bid);
                pg8::EpiResidB<false> E{XBUF, XBUF, DM, 0.015625f};
                pg8::gemm_phase<pg8::EpiResidB<false>, pg8::StaticOrder, false, true>(F.tid, F.lds, g, S, E);
            } else {
                pg8::MoeOrder S; moe_bases(F.ctl + CW_MOECNT + 64 * ms, S.tb); S.ntiles = S.tb[8]; S.nNe = DM / 256; S.G = F.G; S.c = F.bid;
                pg8::Gemm g{ACT, (const bf16_t*)(F.ws + WS_W2), KP8 / 2, nullptr};
                pg8::EpiBf16 E{(bf16_t*)(F.ws + WS_Y), DM, 0.015625f};
                pg8::gemm_phase<pg8::EpiBf16, pg8::MoeOrder, false, true>(F.tid, F.lds, g, S, E);
            }
            SEAM(pb + P_DOWN);
        }
        }
    { constexpr int l = 1;
        const int pb = l * PH_PER_LAYER; const bool moe = (l & 1) != 0; const int ms = l >> 1;

        if (EN(0) && IN(pb + P_PREP)) { PH_BEGIN();
            if (sub & 1) { phase_convert_weights(F, l); rwkv_convert_small(F, l); }
            __syncthreads();
            if (sub & 2) { if (l == 0) phase_norm_lr<true, false>(F, INF(F, I_X), INF(F, I_ATTN_NORM) + l * DM, l); else if (((l - 1) & 1) != 0) phase_norm_lr<false, true>(F, XBUF, INF(F, I_ATTN_NORM) + l * DM, l); else phase_norm_lr<false, false>(F, XBUF, INF(F, I_ATTN_NORM) + l * DM, l); }
            SEAM(pb + P_PREP);
        }
        if (EN(1) && IN(pb + P_INPROJ)) { PH_BEGIN();
            pg8::Gemm g{HB, (const bf16_t*)(F.ws + WS_WIN), DM, nullptr}; pg8::StaticOrder S; S.init(NTOK, 3072, F.G, F.bid);
            pg8::EpiBf16 E{PROJ, NPROJ};
            pg8::gemm_phase<pg8::EpiBf16, pg8::StaticOrder, false>(F.tid, F.lds, g, S, E);
            SEAM(pb + P_INPROJ);
        }
        if (EN(2) && IN(pb + P_MIX1)) { PH_BEGIN();
            if (sub & 1) { rwkv_r1_tables(F, l); for (int unit = F.bid; unit < 2048; unit += F.G) rwkv_r1_unit(F, l, unit, (sub >> 8) & 15); }
            if (sub & 2) { GlaW2 gw; gla_loadw2(F, l, (F.bid >> 6) & 3, gw); for (int unit = F.bid; unit < 2048; unit += 2 * F.G) gla_kv2_pair(F, l, unit, gw); }
            SEAM(pb + P_MIX1);
        }
        if (EN(3) && IN(pb + P_MIX2)) { PH_BEGIN();
            if (F.bid < 32) { if (sub & 1) rwkv_r2_block(F, F.bid); }
            else { const int ob = F.bid - 32, NO = F.G - 32;
                if (sub & 2) for (int gt = ob * 512 + F.tid; gt < 65536; gt += NO * 512) gla_scan(F, gt); }
            if (sub & 12) {
                volatile LAS int* qw = (volatile LAS int*)(F.lds + MISC_OFF + 28);
                unsigned* qctr = F.ctl + CW_ATTNQ + 64 * l + ((sub >> 4) & 1) * 32;
                int nxt = 0;
                if (F.tid == 0) nxt = (int)atomicAdd(qctr, 1u);
                for (;;) {
                    __syncthreads();
                    if (F.tid == 0) *qw = nxt;
                    __syncthreads();
                    const int task = *qw;
                    if (task >= 1024) break;
                    if (F.tid == 0) nxt = (int)atomicAdd(qctr, 1u);
                    if (task < 512) { if (sub & 4) attn_block<false>(F, l, task); } else if (sub & 8) attn_block<true>(F, l, task - 512);
                }
            }
            SEAM(pb + P_MIX2);
        }
        if (EN(4) && IN(pb + P_MIX3)) { PH_BEGIN();
            if (sub & 1) { GlaW2 gw; gla_loadw2(F, l, (F.bid >> 6) & 3, gw); for (int unit = F.bid; unit < 2048; unit += 2 * F.G) gla_out2_pair(F, l, unit, gw, (sub >> 8) & 15); }
            __syncthreads();
            if (sub & 2) for (int unit = F.bid * 8 + F.wave; unit < 2048; unit += F.G * 8) rwkv_r3_task(F, l, unit);
            SEAM(pb + P_MIX3);
        }
        if (EN(5) && IN(pb + P_OUTPROJ)) { PH_BEGIN();
            __syncthreads();
            pg8::Gemm g{MIXB, (const bf16_t*)(F.ws + WS_WOUT), DM, nullptr}; pg8::StaticOrder S; S.init(NTOK, DM, F.G, F.bid);
            if (l == 0) { pg8::EpiResidB<true> E{INF(F, I_X), XBUF, DM}; pg8::gemm_phase<pg8::EpiResidB<true>, pg8::StaticOrder, false>(F.tid, F.lds, g, S, E); }
            else { pg8::EpiResidB<false> E{XBUF, XBUF, DM}; pg8::gemm_phase<pg8::EpiResidB<false>, pg8::StaticOrder, false>(F.tid, F.lds, g, S, E); }
            SEAM(pb + P_OUTPROJ);
        }
        if (EN(6) && IN(pb + P_NORM2)) { PH_BEGIN();
            if (moe) phase_norm<1, false>(F, XBUF, INF(F, I_FFN_NORM) + l * DM, false, ms);
            else phase_norm<0, false>(F, XBUF, INF(F, I_FFN_NORM) + l * DM, false, 0);
            SEAM(pb + P_NORM2);
        }
        if (EN(7) && IN(pb + P_MAP)) { PH_BEGIN();
            if (moe) { phase_moe_map(F, ms); SEAM(pb + P_MAP); }
        }
        if (EN(8) && IN(pb + P_UP)) { PH_BEGIN();
            __syncthreads();
            if (!moe) {
                pg8::Gemm g{HB, (const bf16_t*)(F.ws + WS_W13), DM / 2, nullptr}; pg8::StaticOrder S; S.init(NTOK, 2 * D_FF, F.G, F.bid);
                pg8::EpiSwiglu8 E{(unsigned char*)ACT, D_FF, 0.015625f};
                pg8::gemm_phase<pg8::EpiSwiglu8, pg8::StaticOrder, false, true>(F.tid, F.lds, g, S, E);
            } else {
                pg8::MoeOrder S; moe_bases(F.ctl + CW_MOECNT + 64 * ms, S.tb); S.ntiles = S.tb[8]; S.nNe = 2 * D_FFE / 256; S.G = F.G; S.c = F.bid;
                pg8::Gemm g{HB, (const bf16_t*)(F.ws + WS_W13), DM / 2, (const int*)(F.ws + WS_ROWMAP)};
                pg8::EpiSwiglu8 E{(unsigned char*)ACT, KP8, 0.015625f};
                pg8::gemm_phase<pg8::EpiSwiglu8, pg8::MoeOrder, true, true>(F.tid, F.lds, g, S, E);
            }
            SEAM(pb + P_UP);
        }
        if (EN(9) && IN(pb + P_DOWN)) { PH_BEGIN();
            __syncthreads();
            if (!moe) {
                pg8::Gemm g{ACT, (const bf16_t*)(F.ws + WS_W2), D_FF / 2, nullptr}; pg8::StaticOrder S; S.init(NTOK, DM, F.G, F.bid);
                pg8::EpiResidB<false> E{XBUF, XBUF, DM, 0.015625f};
                pg8::gemm_phase<pg8::EpiResidB<false>, pg8::StaticOrder, false, true>(F.tid, F.lds, g, S, E);
            } else {
                pg8::MoeOrder S; moe_bases(F.ctl + CW_MOECNT + 64 * ms, S.tb); S.ntiles = S.tb[8]; S.nNe = DM / 256; S.G = F.G; S.c = F.bid;
                pg8::Gemm g{ACT, (const bf16_t*)(F.ws + WS_W2), KP8 / 2, nullptr};
                pg8::EpiBf16 E{(bf16_t*)(F.ws + WS_Y), DM, 0.015625f};
                pg8::gemm_phase<pg8::EpiBf16, pg8::MoeOrder, false, true>(F.tid, F.lds, g, S, E);
            }
            SEAM(pb + P_DOWN);
        }
        }
    { constexpr int l = 2;
        const int pb = l * PH_PER_LAYER; const bool moe = (l & 1) != 0; const int ms = l >> 1;

        if (EN(0) && IN(pb + P_PREP)) { PH_BEGIN();
            if (sub & 1) { phase_convert_weights(F, l); rwkv_convert_small(F, l); }
            __syncthreads();
            if (sub & 2) { if (l == 0) phase_norm_lr<true, false>(F, INF(F, I_X), INF(F, I_ATTN_NORM) + l * DM, l); else if (((l - 1) & 1) != 0) phase_norm_lr<false, true>(F, XBUF, INF(F, I_ATTN_NORM) + l * DM, l); else phase_norm_lr<false, false>(F, XBUF, INF(F, I_ATTN_NORM) + l * DM, l); }
            SEAM(pb + P_PREP);
        }
        if (EN(1) && IN(pb + P_INPROJ)) { PH_BEGIN();
            pg8::Gemm g{HB, (const bf16_t*)(F.ws + WS_WIN), DM, nullptr}; pg8::StaticOrder S; S.init(NTOK, 3072, F.G, F.bid);
            pg8::EpiBf16 E{PROJ, NPROJ};
            pg8::gemm_phase<pg8::EpiBf16, pg8::StaticOrder, false>(F.tid, F.lds, g, S, E);
            SEAM(pb + P_INPROJ);
        }
        if (EN(2) && IN(pb + P_MIX1)) { PH_BEGIN();
            if (sub & 1) { rwkv_r1_tables(F, l); for (int unit = F.bid; unit < 2048; unit += F.G) rwkv_r1_unit(F, l, unit, (sub >> 8) & 15); }
            if (sub & 2) { GlaW2 gw; gla_loadw2(F, l, (F.bid >> 6) & 3, gw); for (int unit = F.bid; unit < 2048; unit += 2 * F.G) gla_kv2_pair(F, l, unit, gw); }
            SEAM(pb + P_MIX1);
        }
        if (EN(3) && IN(pb + P_MIX2)) { PH_BEGIN();
            if (F.bid < 32) { if (sub & 1) rwkv_r2_block(F, F.bid); }
            else { const int ob = F.bid - 32, NO = F.G - 32;
                if (sub & 2) for (int gt = ob * 512 + F.tid; gt < 65536; gt += NO * 512) gla_scan(F, gt); }
            if (sub & 12) {
                volatile LAS int* qw = (volatile LAS int*)(F.lds + MISC_OFF + 28);
                unsigned* qctr = F.ctl + CW_ATTNQ + 64 * l + ((sub >> 4) & 1) * 32;
                int nxt = 0;
                if (F.tid == 0) nxt = (int)atomicAdd(qctr, 1u);
                for (;;) {
                    __syncthreads();
                    if (F.tid == 0) *qw = nxt;
                    __syncthreads();
                    const int task = *qw;
                    if (task >= 1024) break;
                    if (F.tid == 0) nxt = (int)atomicAdd(qctr, 1u);
                    if (task < 512) { if (sub & 4) attn_block<false>(F, l, task); } else if (sub & 8) attn_block<true>(F, l, task - 512);
                }
            }
            SEAM(pb + P_MIX2);
        }
        if (EN(4) && IN(pb + P_MIX3)) { PH_BEGIN();
            if (sub & 1) { GlaW2 gw; gla_loadw2(F, l, (F.bid >> 6) & 3, gw); for (int unit = F.bid; unit < 2048; unit += 2 * F.G) gla_out2_pair(F, l, unit, gw, (sub >> 8) & 15); }
            __syncthreads();
            if (sub & 2) for (int unit = F.bid * 8 + F.wave; unit < 2048; unit += F.G * 8) rwkv_r3_task(F, l, unit);
            SEAM(pb + P_MIX3);
        }
        if (EN(5) && IN(pb + P_OUTPROJ)) { PH_BEGIN();
            __syncthreads();
            pg8::Gemm g{MIXB, (const bf16_t*)(F.ws + WS_WOUT), DM, nullptr}; pg8::StaticOrder S; S.init(NTOK, DM, F.G, F.bid);
            if (l == 0) { pg8::EpiResidB<true> E{INF(F, I_X), XBUF, DM}; pg8::gemm_phase<pg8::EpiResidB<true>, pg8::StaticOrder, false>(F.tid, F.lds, g, S, E); }
            else { pg8::EpiResidB<false> E{XBUF, XBUF, DM}; pg8::gemm_phase<pg8::EpiResidB<false>, pg8::StaticOrder, false>(F.tid, F.lds, g, S, E); }
            SEAM(pb + P_OUTPROJ);
        }
        if (EN(6) && IN(pb + P_NORM2)) { PH_BEGIN();
            if (moe) phase_norm<1, false>(F, XBUF, INF(F, I_FFN_NORM) + l * DM, false, ms);
            else phase_norm<0, false>(F, XBUF, INF(F, I_FFN_NORM) + l * DM, false, 0);
            SEAM(pb + P_NORM2);
        }
        if (EN(7) && IN(pb + P_MAP)) { PH_BEGIN();
            if (moe) { phase_moe_map(F, ms); SEAM(pb + P_MAP); }
        }
        if (EN(8) && IN(pb + P_UP)) { PH_BEGIN();
            __syncthreads();
            if (!moe) {
                pg8::Gemm g{HB, (const bf16_t*)(F.ws + WS_W13), DM / 2, nullptr}; pg8::StaticOrder S; S.init(NTOK, 2 * D_FF, F.G, F.bid);
                pg8::EpiSwiglu8 E{(unsigned char*)ACT, D_FF, 0.015625f};
                pg8::gemm_phase<pg8::EpiSwiglu8, pg8::StaticOrder, false, true>(F.tid, F.lds, g, S, E);
            } else {
                pg8::MoeOrder S; moe_bases(F.ctl + CW_MOECNT + 64 * ms, S.tb); S.ntiles = S.tb[8]; S.nNe = 2 * D_FFE / 256; S.G = F.G; S.c = F.bid;
                pg8::Gemm g{HB, (const bf16_t*)(F.ws + WS_W13), DM / 2, (const int*)(F.ws + WS_ROWMAP)};
                pg8::EpiSwiglu8 E{(unsigned char*)ACT, KP8, 0.015625f};
                pg8::gemm_phase<pg8::EpiSwiglu8, pg8::MoeOrder, true, true>(F.tid, F.lds, g, S, E);
            }
            SEAM(pb + P_UP);
        }
        if (EN(9) && IN(pb + P_DOWN)) { PH_BEGIN();
            __syncthreads();
            if (!moe) {
                pg8::Gemm g{ACT, (const bf16_t*)(F.ws + WS_W2), D_FF / 2, nullptr}; pg8::StaticOrder S; S.init(NTOK, DM, F.G, F.bid);
                pg8::EpiResidB<false> E{XBUF, XBUF, DM, 0.015625f};
                pg8::gemm_phase<pg8::EpiResidB<false>, pg8::StaticOrder, false, true>(F.tid, F.lds, g, S, E);
            } else {
                pg8::MoeOrder S; moe_bases(F.ctl + CW_MOECNT + 64 * ms, S.tb); S.ntiles = S.tb[8]; S.nNe = DM / 256; S.G = F.G; S.c = F.bid;
                pg8::Gemm g{ACT, (const bf16_t*)(F.ws + WS_W2), KP8 / 2, nullptr};
                pg8::EpiBf16 E{(bf16_t*)(F.ws + WS_Y), DM, 0.015625f};
                pg8::gemm_phase<pg8::EpiBf16, pg8::MoeOrder, false, true>(F.tid, F.lds, g, S, E);
            }
            SEAM(pb + P_DOWN);
        }
        }
    { constexpr int l = 3;
        const int pb = l * PH_PER_LAYER; const bool moe = (l & 1) != 0; const int ms = l >> 1;

        if (EN(0) && IN(pb + P_PREP)) { PH_BEGIN();
            if (sub & 1) { phase_convert_weights(F, l); rwkv_convert_small(F, l); }
            __syncthreads();
            if (sub & 2) { if (l == 0) phase_norm_lr<true, false>(F, INF(F, I_X), INF(F, I_ATTN_NORM) + l * DM, l); else if (((l - 1) & 1) != 0) phase_norm_lr<false, true>(F, XBUF, INF(F, I_ATTN_NORM) + l * DM, l); else phase_norm_lr<false, false>(F, XBUF, INF(F, I_ATTN_NORM) + l * DM, l); }
            SEAM(pb + P_PREP);
        }
        if (EN(1) && IN(pb + P_INPROJ)) { PH_BEGIN();
            pg8::Gemm g{HB, (const bf16_t*)(F.ws + WS_WIN), DM, nullptr}; pg8::StaticOrder S; S.init(NTOK, 3072, F.G, F.bid);
            pg8::EpiBf16 E{PROJ, NPROJ};
            pg8::gemm_phase<pg8::EpiBf16, pg8::StaticOrder, false>(F.tid, F.lds, g, S, E);
            SEAM(pb + P_INPROJ);
        }
        if (EN(2) && IN(pb + P_MIX1)) { PH_BEGIN();
            if (sub & 1) { rwkv_r1_tables(F, l); for (int unit = F.bid; unit < 2048; unit += F.G) rwkv_r1_unit(F, l, unit, (sub >> 8) & 15); }
            if (sub & 2) { GlaW2 gw; gla_loadw2(F, l, (F.bid >> 6) & 3, gw); for (int unit = F.bid; unit < 2048; unit += 2 * F.G) gla_kv2_pair(F, l, unit, gw); }
            SEAM(pb + P_MIX1);
        }
        if (EN(3) && IN(pb + P_MIX2)) { PH_BEGIN();
            if (F.bid < 32) { if (sub & 1) rwkv_r2_block(F, F.bid); }
            else { const int ob = F.bid - 32, NO = F.G - 32;
                if (sub & 2) for (int gt = ob * 512 + F.tid; gt < 65536; gt += NO * 512) gla_scan(F, gt); }
            if (sub & 12) {
                volatile LAS int* qw = (volatile LAS int*)(F.lds + MISC_OFF + 28);
                unsigned* qctr = F.ctl + CW_ATTNQ + 64 * l + ((sub >> 4) & 1) * 32;
                int nxt = 0;
                if (F.tid == 0) nxt = (int)atomicAdd(qctr, 1u);
                for (;;) {
                    __syncthreads();
                    if (F.tid == 0) *qw = nxt;
                    __syncthreads();
                    const int task = *qw;
                    if (task >= 1024) break;
                    if (F.tid == 0) nxt = (int)atomicAdd(qctr, 1u);
                    if (task < 512) { if (sub & 4) attn_block<false>(F, l, task); } else if (sub & 8) attn_block<true>(F, l, task - 512);
                }
            }
            SEAM(pb + P_MIX2);
        }
        if (EN(4) && IN(pb + P_MIX3)) { PH_BEGIN();
            if (sub & 1) { GlaW2 gw; gla_loadw2(F, l, (F.bid >> 6) & 3, gw); for (int unit = F.bid; unit < 2048; unit += 2 * F.G) gla_out2_pair(F, l, unit, gw, (sub >> 8) & 15); }
            __syncthreads();
            if (sub & 2) for (int unit = F.bid * 8 + F.wave; unit < 2048; unit += F.G * 8) rwkv_r3_task(F, l, unit);
            SEAM(pb + P_MIX3);
        }
        if (EN(5) && IN(pb + P_OUTPROJ)) { PH_BEGIN();
            __syncthreads();
            pg8::Gemm g{MIXB, (const bf16_t*)(F.ws + WS_WOUT), DM, nullptr}; pg8::StaticOrder S; S.init(NTOK, DM, F.G, F.bid);
            if (l == 0) { pg8::EpiResidB<true> E{INF(F, I_X), XBUF, DM}; pg8::gemm_phase<pg8::EpiResidB<true>, pg8::StaticOrder, false>(F.tid, F.lds, g, S, E); }
            else { pg8::EpiResidB<false> E{XBUF, XBUF, DM}; pg8::gemm_phase<pg8::EpiResidB<false>, pg8::StaticOrder, false>(F.tid, F.lds, g, S, E); }
            SEAM(pb + P_OUTPROJ);
        }
        if (EN(6) && IN(pb + P_NORM2)) { PH_BEGIN();
            if (moe) phase_norm<1, false>(F, XBUF, INF(F, I_FFN_NORM) + l * DM, false, ms);
            else phase_norm<0, false>(F, XBUF, INF(F, I_FFN_NORM) + l * DM, false, 0);
            SEAM(pb + P_NORM2);
        }
        if (EN(7) && IN(pb + P_MAP)) { PH_BEGIN();
            if (moe) { phase_moe_map(F, ms); SEAM(pb + P_MAP); }
        }
        if (EN(8) && IN(pb + P_UP)) { PH_BEGIN();
            __syncthreads();
            if (!moe) {
                pg8::Gemm g{HB, (const bf16_t*)(F.ws + WS_W13), DM / 2, nullptr}; pg8::StaticOrder S; S.init(NTOK, 2 * D_FF, F.G, F.bid);
                pg8::EpiSwiglu8 E{(unsigned char*)ACT, D_FF, 0.015625f};
                pg8::gemm_phase<pg8::EpiSwiglu8, pg8::StaticOrder, false, true>(F.tid, F.lds, g, S, E);
            } else {
                pg8::MoeOrder S; moe_bases(F.ctl + CW_MOECNT + 64 * ms, S.tb); S.ntiles = S.tb[8]; S.nNe = 2 * D_FFE / 256; S.G = F.G; S.c = F.bid;
                pg8::Gemm g{HB, (const bf16_t*)(F.ws + WS_W13), DM / 2, (const int*)(F.ws + WS_ROWMAP)};
                pg8::EpiSwiglu8 E{(unsigned char*)ACT, KP8, 0.015625f};
                pg8::gemm_phase<pg8::EpiSwiglu8, pg8::MoeOrder, true, true>(F.tid, F.lds, g, S, E);
            }
            SEAM(pb + P_UP);
        }
        if (EN(9) && IN(pb + P_DOWN)) { PH_BEGIN();
            __syncthreads();
            if (!moe) {
                pg8::Gemm g{ACT, (const bf16_t*)(F.ws + WS_W2), D_FF / 2, nullptr}; pg8::StaticOrder S; S.init(NTOK, DM, F.G, F.bid);
                pg8::EpiResidB<false> E{XBUF, XBUF, DM, 0.015625f};
                pg8::gemm_phase<pg8::EpiResidB<false>, pg8::StaticOrder, false, true>(F.tid, F.lds, g, S, E);
            } else {
                pg8::MoeOrder S; moe_bases(F.ctl + CW_MOECNT + 64 * ms, S.tb); S.ntiles = S.tb[8]; S.nNe = DM / 256; S.G = F.G; S.c = F.bid;
                pg8::Gemm g{ACT, (const bf16_t*)(F.ws + WS_W2), KP8 / 2, nullptr};
                pg8::EpiBf16 E{(bf16_t*)(F.ws + WS_Y), DM, 0.015625f};
                pg8::gemm_phase<pg8::EpiBf16, pg8::MoeOrder, false, true>(F.tid, F.lds, g, S, E);
            }
            SEAM(pb + P_DOWN);
        }
        }
#if N_LAUNCHES_ONE
    if (EN(10) && IN(PH_FINAL)) { PH_BEGIN();
        FinalRows fr; final_load(F, INF(F, I_FINAL_NORM), fr);
        SEAM(PH_FINAL);
        final_store(F, fr);
    }
#else
    if (EN(10) && IN(PH_FINAL)) { PH_BEGIN();
        __syncthreads();
        phase_norm<2, false>(F, XBUF, INF(F, I_FINAL_NORM), true, 0);
        SEAM(PH_FINAL);
    }
    if (EN(10) && IN(PH_FINAL + 1)) { PH_BEGIN(); phase_final_copy(F); }
#endif
#undef IN
#undef XBUF
#undef HB
#undef PROJ
#undef MIXB
#undef ACT
#undef PH_BEGIN
#undef SEAM
}

extern "C" void kernel_launch(void* const* d_in, const int* in_sizes, int n_in, void* d_out, int out_size, void* d_ws, size_t ws_size, hipStream_t stream) {
    static int ready = 0;
    if (ready == 0) {
        if (n_in != N_IN || in_sizes[0] != NTOK * DM || out_size != NTOK * DM || ws_size < WS_END) {
            fprintf(stderr, "kernel_launch: unexpected shapes (n_in %d, in0 %d, out %d, ws %zu); nothing launched\n", n_in, n_in > 0 ? in_sizes[0] : -1, out_size, ws_size); ready = -1; return; }
        if (hipFuncSetAttribute((const void*)fwd_kernel, hipFuncAttributeMaxDynamicSharedMemorySize, LDS_BYTES) != hipSuccess) { fprintf(stderr, "kernel_launch: hipFuncSetAttribute failed\n"); ready = -1; return; }
        int per_cu = 0;
        if (hipOccupancyMaxActiveBlocksPerMultiprocessor(&per_cu, (const void*)fwd_kernel, 512, LDS_BYTES) != hipSuccess || per_cu < 1)
            fprintf(stderr, "kernel_launch: note: occupancy query reports %d workgroups per CU\n", per_cu);
        (void)hipGetLastError();
        ready = 1;
    }
    if (ready < 0) return;
    const int grid = 256;
    if (hipMemsetAsync((char*)d_ws + WS_CTL, 0, CTL_ZERO_BYTES, stream) != hipSuccess) { fprintf(stderr, "kernel_launch: memset failed\n"); return; }
    Args a{};
    for (int i = 0; i < N_IN; ++i) a.in[i] = d_in[i];
    a.out = (float*)d_out; a.ws = (unsigned char*)d_ws; a.sub = 0xF;
#if N_LAUNCHES_ONE
    a.ph_lo = 0; a.ph_hi = PH_END;
    hipLaunchKernelGGL(fwd_kernel, dim3(grid), dim3(512), LDS_BYTES, stream, a);
#else
    for (int p = 0; p < PH_END; ++p) {
        if (p < PH_FINAL && (p % PH_PER_LAYER) == P_MAP && (((p / PH_PER_LAYER) & 1) == 0)) continue;
        a.ph_lo = p; a.ph_hi = p + 1; a.sub = 0xF;
        hipLaunchKernelGGL(fwd_kernel, dim3(grid), dim3(512), LDS_BYTES, stream, a);
#if defined(PROBE_PHASE)
        if (p < PH_FINAL && (p % PH_PER_LAYER) == PROBE_PHASE && ((PROBE_LMASK >> (p / PH_PER_LAYER)) & 1)) { a.sub = PROBE_SUB; hipLaunchKernelGGL(fwd_kernel, dim3(grid), dim3(512), LDS_BYTES, stream, a); }
#endif
    }
#endif
    const hipError_t le = hipPeekAtLastError();
    if (le != hipSuccess) fprintf(stderr, "kernel_launch: launch failed: %s\n", hipGetErrorName(le));
}
```
